# Optimizing an MI355X kernel written in HIP

```python
import jax, jax.numpy as jnp
from jax import lax
import numpy as np

D_MODEL = 1024
BATCH = 8
SEQ = 4096
DEPTH = 1

GRID_W = 64
EPS = 1e-6

GLA_HEADS = 4
GLA_DK = 64
GLA_DV = 128
GLA_RANK = 16
GLA_NORMALIZER = 16.0
GLA_CHUNK = 64

ATT_HEADS = 8
ATT_KV_HEADS = 2
ATT_DH = 64
Q_BLOCK = 128
ROPE_THETA = 10000.0

N_EXPERTS = 32
TOP_K = 4
D_FF = D_MODEL
SWIGLU_ALPHA = 1.702
SWIGLU_LIMIT = 7.0
EXPERT_BLOCK = 256

GLA_QK = GLA_HEADS * GLA_DK
GLA_V = GLA_HEADS * GLA_DV
ATT_Q = ATT_HEADS * ATT_DH
ATT_KV = ATT_KV_HEADS * ATT_DH
D_MIX = GLA_V + ATT_Q
IN_SPLITS = (GLA_QK, GLA_QK, GLA_V, GLA_V, GLA_RANK, GLA_RANK, ATT_Q, ATT_KV, ATT_KV)
D_IN = GLA_QK * 2 + GLA_V * 2 + GLA_RANK * 2 + ATT_Q + ATT_KV * 2

kernel_name = "hybrid_gla_axialgqa_moe_encoder"


def rms_norm(x, g):
    xf = x.astype(jnp.float32)
    y = xf * lax.rsqrt(jnp.mean(xf * xf, axis=-1, keepdims=True) + EPS)
    return (y * g.astype(jnp.float32)).astype(x.dtype)


def split_cols(z, sizes):
    out, o = [], 0
    for s in sizes:
        out.append(z[..., o:o + s])
        o += s
    return out


def gla_chunked(q, k, v, g, strict):
    B, H, S, DK = q.shape
    DV = v.shape[-1]
    C = GLA_CHUNK
    N = S // C
    qf = q.astype(jnp.float32).reshape(B, H, N, C, DK)
    kf = k.astype(jnp.float32).reshape(B, H, N, C, DK)
    vf = v.astype(jnp.float32).reshape(B, H, N, C, DV)
    b = jnp.cumsum(g.astype(jnp.float32).reshape(B, H, N, C, DK), axis=3)
    b_last = b[:, :, :, C - 1:C]
    b_mid = b[:, :, :, C // 2 - 1:C // 2]
    scores = jnp.einsum('bhnid,bhnjd->bhnij', qf * jnp.exp(b - b_mid), kf * jnp.exp(b_mid - b))
    pos = jnp.arange(C)
    mask = (pos[:, None] > pos[None, :]) if strict else (pos[:, None] >= pos[None, :])
    scores = jnp.where(mask, scores, 0.0)
    o_intra = jnp.einsum('bhnij,bhnjv->bhniv', scores, vf)
    delta = jnp.einsum('bhncd,bhncv->bhndv', kf * jnp.exp(b_last - b), vf)
    decay = jnp.exp(b_last[:, :, :, 0])

    def step(state, inp):
        d, dl = inp
        return d[..., None] * state + dl, state

    s0 = jnp.zeros((B, H, DK, DV), jnp.float32)
    _, s_prev = lax.scan(step, s0, (jnp.moveaxis(decay, 2, 0), jnp.moveaxis(delta, 2, 0)))
    s_prev = jnp.moveaxis(s_prev, 0, 2)
    o_inter = jnp.einsum('bhncd,bhndv->bhncv', qf * jnp.exp(b), s_prev)
    return (o_intra + o_inter).reshape(B, H, S, DV)


def gla_group(q, k, v, r, zf, zb, w_gf, b_gf, w_gb, b_gb, head_g):
    B, S, _ = q.shape

    def heads(t, d):
        return t.reshape(B, S, GLA_HEADS, d).transpose(0, 2, 1, 3)

    g_fwd = jax.nn.log_sigmoid((zf @ w_gf + b_gf).astype(jnp.float32)) / GLA_NORMALIZER
    g_bwd = jax.nn.log_sigmoid((zb @ w_gb + b_gb).astype(jnp.float32)) / GLA_NORMALIZER
    qh = heads(q, GLA_DK) * (GLA_DK ** -0.5)
    kh = heads(k, GLA_DK)
    vh = heads(v, GLA_DV)
    o_f = gla_chunked(qh, kh, vh, heads(g_fwd, GLA_DK), strict=False)
    flip = lambda t: jnp.flip(t, axis=2)
    o_b = flip(gla_chunked(flip(qh), flip(kh), flip(vh), flip(heads(g_bwd, GLA_DK)), strict=True))
    o = rms_norm(o_f + o_b, head_g)
    o = o.transpose(0, 2, 1, 3).reshape(B, S, GLA_V)
    return (o * jax.nn.silu(r.astype(jnp.float32))).astype(q.dtype)


def rope_1d(x, pos):
    half = x.shape[-1] // 2
    inv = ROPE_THETA ** (-jnp.arange(half, dtype=jnp.float32) / half)
    ang = pos.astype(jnp.float32)[:, None] * inv[None, :]
    cos = jnp.cos(ang)[:, None, :]
    sin = jnp.sin(ang)[:, None, :]
    x1, x2 = x[..., :half], x[..., half:]
    return jnp.concatenate([x1 * cos - x2 * sin, x2 * cos + x1 * sin], axis=-1)


def axial_rope(x, row_pos, col_pos):
    h = x.shape[-1] // 2
    return jnp.concatenate([rope_1d(x[..., :h], row_pos), rope_1d(x[..., h:], col_pos)], axis=-1)


def gqa_group(q, k, v, q_g, k_g, row_pos, col_pos):
    B, S, _ = q.shape
    G = ATT_HEADS // ATT_KV_HEADS
    NB = S // Q_BLOCK
    qh = q.reshape(B, S, ATT_HEADS, ATT_DH)
    kh = k.reshape(B, S, ATT_KV_HEADS, ATT_DH)
    vh = v.reshape(B, S, ATT_KV_HEADS, ATT_DH)
    qf = axial_rope(rms_norm(qh, q_g).astype(jnp.float32), row_pos, col_pos) * (ATT_DH ** -0.5)
    kf = axial_rope(rms_norm(kh, k_g).astype(jnp.float32), row_pos, col_pos)
    qb = qf.reshape(B, NB, Q_BLOCK, ATT_KV_HEADS, G, ATT_DH).transpose(1, 0, 3, 4, 2, 5)
    kf = kf.transpose(0, 2, 1, 3)
    vf = vh.astype(jnp.float32).transpose(0, 2, 1, 3)

    def attend(q_blk):
        s = jnp.einsum('bkgqd,bksd->bkgqs', q_blk, kf)
        p = jax.nn.softmax(s, axis=-1)
        return jnp.einsum('bkgqs,bksd->bkgqd', p, vf)

    o = lax.map(attend, qb)
    o = o.transpose(1, 0, 4, 2, 3, 5).reshape(B, S, ATT_Q)
    return o.astype(q.dtype)


def moe_ffn(x, w_router, b_router, w1, b1, w2, b2):
    B, S, D = x.shape
    xt = x.reshape(-1, D)
    T = xt.shape[0]
    A = T * TOP_K
    logits = (xt @ w_router + b_router).astype(jnp.float32)
    top_val, top_idx = lax.top_k(logits, TOP_K)
    gates = jax.nn.softmax(top_val, axis=-1)
    flat_e = top_idx.reshape(-1)
    order = jnp.argsort(flat_e)
    sorted_e = flat_e[order]
    tok_sorted = order // TOP_K
    gate_sorted = gates.reshape(-1)[order]
    counts = jnp.bincount(flat_e, length=N_EXPERTS).astype(jnp.int32)
    padded = ((counts + EXPERT_BLOCK - 1) // EXPERT_BLOCK) * EXPERT_BLOCK
    starts_sorted = jnp.cumsum(counts) - counts
    pad_ends = jnp.cumsum(padded)
    starts_pad = pad_ends - padded
    dest = starts_pad[sorted_e] + (jnp.arange(A, dtype=jnp.int32) - starts_sorted[sorted_e])
    P = ((A + EXPERT_BLOCK - 1) // EXPERT_BLOCK) * EXPERT_BLOCK + N_EXPERTS * EXPERT_BLOCK
    n_blocks = P // EXPERT_BLOCK
    buf = jnp.zeros((P, D), xt.dtype).at[dest].set(xt[tok_sorted])
    block_start = jnp.arange(n_blocks, dtype=jnp.int32) * EXPERT_BLOCK
    block_expert = jnp.minimum(jnp.searchsorted(pad_ends, block_start, side='right'), N_EXPERTS - 1)

    def expert_block(args):
        xb, e = args
        h = (xb @ w1[e] + b1[e]).astype(jnp.float32)
        h_glu = jnp.minimum(h[:, :D_FF], SWIGLU_LIMIT)
        h_lin = jnp.clip(h[:, D_FF:], -SWIGLU_LIMIT, SWIGLU_LIMIT)
        act = (h_glu * jax.nn.sigmoid(SWIGLU_ALPHA * h_glu) * (h_lin + 1.0)).astype(xb.dtype)
        return act @ w2[e] + b2[e]

    yb = lax.map(expert_block, (buf.reshape(n_blocks, EXPERT_BLOCK, D), block_expert))
    y_assign = yb.reshape(P, D)[dest].astype(jnp.float32) * gate_sorted[:, None]
    y = jax.ops.segment_sum(y_assign, tok_sorted, num_segments=T)
    return y.reshape(B, S, D).astype(x.dtype)


def setup_inputs(seed: int = 0) -> dict:
    key = jax.random.key(seed)
    ks = jax.random.split(key, 20)
    f32 = jnp.float32
    L = DEPTH

    def nrm(k, shape, scale):
        return jax.random.normal(k, shape, f32) * scale

    def gain(k, shape):
        return 1.0 + 0.05 * jax.random.normal(k, shape, f32)

    return {
        "x": nrm(ks[0], (BATCH, SEQ, D_MODEL), 1.0),
        "mix_norm_g": gain(ks[1], (L, D_MODEL)),
        "w_in": nrm(ks[2], (L, D_MODEL, D_IN), D_MODEL ** -0.5),
        "w_gate_f": nrm(ks[3], (L, GLA_RANK, GLA_QK), GLA_RANK ** -0.5),
        "b_gate_f": nrm(ks[4], (L, GLA_QK), 0.1),
        "w_gate_b": nrm(ks[5], (L, GLA_RANK, GLA_QK), GLA_RANK ** -0.5),
        "b_gate_b": nrm(ks[6], (L, GLA_QK), 0.1),
        "gla_head_g": gain(ks[7], (L, GLA_DV)),
        "q_norm_g": gain(ks[8], (L, ATT_DH)),
        "k_norm_g": gain(ks[9], (L, ATT_DH)),
        "w_out": nrm(ks[10], (L, D_MIX, D_MODEL), D_MIX ** -0.5),
        "ffn_norm_g": gain(ks[11], (L, D_MODEL)),
        "w_router": nrm(ks[12], (L, D_MODEL, N_EXPERTS), D_MODEL ** -0.5),
        "b_router": nrm(ks[13], (L, N_EXPERTS), 0.01),
        "w1": nrm(ks[14], (L, N_EXPERTS, D_MODEL, 2 * D_FF), D_MODEL ** -0.5),
        "b1": nrm(ks[15], (L, N_EXPERTS, 2 * D_FF), 0.02),
        "w2": nrm(ks[16], (L, N_EXPERTS, D_FF, D_MODEL), D_FF ** -0.5),
        "b2": nrm(ks[17], (L, N_EXPERTS, D_MODEL), 0.02),
        "final_norm_g": gain(ks[18], (D_MODEL,)),
    }


def reference(x, mix_norm_g, w_in, w_gate_f, b_gate_f, w_gate_b, b_gate_b, gla_head_g,
              q_norm_g, k_norm_g, w_out, ffn_norm_g, w_router, b_router, w1, b1, w2, b2,
              final_norm_g):
    B, S, D = x.shape
    rows = S // GRID_W
    row_pos = jnp.repeat(jnp.arange(rows, dtype=jnp.int32), GRID_W)
    col_pos = jnp.tile(jnp.arange(GRID_W, dtype=jnp.int32), rows)
    h = x
    for l in range(DEPTH):
        n = rms_norm(h, mix_norm_g[l])
        z = n @ w_in[l]
        gq, gk, gv, gr, zf, zb, aq, ak, av = split_cols(z, IN_SPLITS)
        o_gla = gla_group(gq, gk, gv, gr, zf, zb, w_gate_f[l], b_gate_f[l],
                          w_gate_b[l], b_gate_b[l], gla_head_g[l])
        o_att = gqa_group(aq, ak, av, q_norm_g[l], k_norm_g[l], row_pos, col_pos)
        h = h + jnp.concatenate([o_gla, o_att], axis=-1) @ w_out[l]
        h = h + moe_ffn(rms_norm(h, ffn_norm_g[l]), w_router[l], b_router[l],
                        w1[l], b1[l], w2[l], b2[l])
    return rms_norm(h, final_norm_g)
```

```cpp
#ifndef REP0
#define REP0 1
#endif
#ifndef REP1
#define REP1 1
#endif
#ifndef REP3G
#define REP3G 1
#endif
#ifndef REP3A
#define REP3A 1
#endif
#ifndef REP4
#define REP4 1
#endif
#ifndef REP6
#define REP6 1
#endif
#ifndef REP7
#define REP7 1
#endif
#ifndef REP2
#define REP2 1
#endif
#ifndef REP5
#define REP5 1
#endif
#ifndef REP8
#define REP8 1
#endif
#include <hip/hip_runtime.h>
#include <hip/hip_bf16.h>
#include <cstdio>
#include <cstdint>
#include <cmath>

#define LAS __attribute__((address_space(3)))
#define GAS __attribute__((address_space(1)))

namespace pg8 {
typedef unsigned short bf16_t;
typedef short bf16x8 __attribute__((ext_vector_type(8)));
typedef float f32x4 __attribute__((ext_vector_type(4)));
typedef float f32x2 __attribute__((ext_vector_type(2)));
typedef unsigned u32x4 __attribute__((ext_vector_type(4)));
typedef int v4i_t __attribute__((ext_vector_type(4)));
typedef int v8i_t __attribute__((ext_vector_type(8)));
constexpr int BM = 256, BK = 64, HALF = 128, HTB = HALF * BK * 2, STAGE_BYTES = 8 * HTB, NXCD = 8, WGM = 8;

__host__ __device__ __forceinline__ int lds_byte(int r, int c) { const int st = (r >> 4) * 2 + (c >> 5), rr = r & 15, cc = c & 31, ob = rr * 64 + cc * 2; return st * 1024 + (ob ^ (((ob >> 9) & 1) << 5)); }
__host__ __device__ __forceinline__ void stage_rc(int b, int& R, int& C) { const int st = b / 1024, sb = b % 1024, swz = sb ^ (((sb >> 9) & 1) << 5); R = (st >> 1) * 16 + swz / 64; C = (st & 1) * 32 + (swz % 64) / 2; }
__host__ __device__ __forceinline__ int perm32(int rho) { const int n = rho >> 4, i = rho & 15; return 8 * (i >> 2) + 4 * n + (i & 3); }

struct Unit { int pm, pn; };

struct StaticOrder {
    int nM, nN, nwg, G, c;
    __device__ __forceinline__ void init(int nM_, int nN_, int G_, int c_) { nM = nM_; nN = nN_; nwg = nM * nN; G = G_; c = c_; }
    __device__ __forceinline__ bool next(int i, Unit& u) const {
        const long L = (long)i * G + c; if (L >= nwg) return false;
        int wgid = (int)L; { const int q = nwg / NXCD, r = nwg % NXCD, xcd = wgid % NXCD, off = wgid / NXCD; wgid = (xcd < r ? xcd * (q + 1) : r * (q + 1) + (xcd - r) * q) + off; }
        const int nig = WGM * nN, gid = wgid / nig, fm = gid * WGM, gsz = (nM - fm) < WGM ? (nM - fm) : WGM;
        u.pm = fm + ((wgid % nig) % gsz); u.pn = (wgid % nig) / gsz; return true;
    }
};

__device__ __forceinline__ unsigned cvt_pk_bf16(float lo, float hi) { unsigned r; asm volatile("v_cvt_pk_bf16_f32 %0, %1, %2" : "=v"(r) : "v"(lo), "v"(hi)); return r; }

template <class Epi, class Sched, class Map, bool ALIGN_EPI, bool FP8 = false>
__device__ __forceinline__ void gemm_phase(LAS unsigned char* lds, const int K, const Sched& S, const Map& MP, const Epi& E) {
    const int tid = threadIdx.x, wid = __builtin_amdgcn_readfirstlane(tid >> 6), lane = tid & 63, wr = wid >> 2, wc = wid & 3, fr = lane & 15, fq = lane >> 4;
    const int nt1 = K / BK;
#ifndef KREP
#define KREP 1
#endif
    const int nt = nt1 * ((FP8 && KREP > 1) ? KREP : 1);
    int Rr[2], Cc[2]; unsigned voffB[2];
#pragma unroll
    for (int i = 0; i < 2; ++i) { int R, C; stage_rc(tid * 16 + i * 8192, R, C); Rr[i] = R; Cc[i] = C; const int Rb = Epi::PERM ? ((R & ~31) + perm32(R & 31)) : R; voffB[i] = (unsigned)(Rb * K + C) * 2u; }
    const unsigned kstep = (unsigned)(BK * 2);
    const unsigned hstep = (unsigned)HALF * K * 2;
    const __amdgpu_buffer_rsrc_t RA = MP.a_rsrc(), RB = MP.b_rsrc();
    const unsigned ldsw = (unsigned)wid * 1024u;
    const int aoff = lds_byte(wr * 64 + fr, fq * 8), boff = lds_byte(wc * 32 + fr, fq * 8);
#define PG8_SA(b, h) (((b) * 2 + (h)) * HTB)
#define PG8_SB(b, h) ((4 + (b) * 2 + (h)) * HTB)
#define PG8_STAGE(bufoff, rsrc, soff, voff) do { _Pragma("unroll") for (int _i = 0; _i < 2; ++_i) \
        __builtin_amdgcn_raw_ptr_buffer_load_lds(rsrc, (LAS unsigned*)(lds + (bufoff) + ldsw + _i * 8192), 16, (int)(voff)[_i], (int)(soff), 0, 0); } while (0)
#define PG8_LD8(p) __builtin_shufflevector(*(const LAS v4i_t*)(p), *(const LAS v4i_t*)((p) + 1024), 0, 1, 2, 3, 4, 5, 6, 7)
#define PG8_LDA(dst, b, h) do { _Pragma("unroll") for (int m = 0; m < 4; ++m) dst[m] = PG8_LD8(lds + PG8_SA(b, h) + aoff + m * 2048); } while (0)
#define PG8_LDB(dst, b, h) do { _Pragma("unroll") for (int n = 0; n < 2; ++n) dst[n] = PG8_LD8(lds + PG8_SB(b, h) + boff + n * 2048); } while (0)
#define PG8_HALF(x, k) __builtin_bit_cast(bf16x8, __builtin_shufflevector(x, x, 4 * (k), 4 * (k) + 1, 4 * (k) + 2, 4 * (k) + 3))
#define PG8_MMA(ai, bj, At, Bt) do { __builtin_amdgcn_s_setprio(1); _Pragma("unroll") for (int m = 0; m < 4; ++m) _Pragma("unroll") for (int n = 0; n < 2; ++n) { \
        if constexpr (FP8) { acc[ai][bj][m][n] = __builtin_amdgcn_mfma_scale_f32_16x16x128_f8f6f4(Bt[n], At[m], acc[ai][bj][m][n], 0, 0, 0, 0x7f7f7f7f, 0, 0x7f7f7f7f); } \
        else { acc[ai][bj][m][n] = __builtin_amdgcn_mfma_f32_16x16x32_bf16(PG8_HALF(Bt[n], 0), PG8_HALF(At[m], 0), acc[ai][bj][m][n], 0, 0, 0); \
               acc[ai][bj][m][n] = __builtin_amdgcn_mfma_f32_16x16x32_bf16(PG8_HALF(Bt[n], 1), PG8_HALF(At[m], 1), acc[ai][bj][m][n], 0, 0, 0); } } \
        __builtin_amdgcn_s_setprio(0); } while (0)
#define PG8_WAIT_V(n) asm volatile("s_waitcnt vmcnt(" #n ")" ::: "memory")
#define PG8_WAIT_L(n) asm volatile("s_waitcnt lgkmcnt(" #n ")" ::: "memory")
#define PG8_BAR __builtin_amdgcn_s_barrier()
#define PG8_SCHED __builtin_amdgcn_sched_barrier(0)
    Unit cur, nxt, nn; int ui = 0;
    if (!S.next(0, cur)) return;
    f32x4 acc[2][2][4][2];
#pragma unroll
    for (int a = 0; a < 2; ++a)
#pragma unroll
        for (int b = 0; b < 2; ++b)
#pragma unroll
            for (int m = 0; m < 4; ++m)
#pragma unroll
                for (int n = 0; n < 2; ++n) acc[a][b][m][n] = (f32x4){0.f, 0.f, 0.f, 0.f};
    v8i_t At[4], B0[2], B1[2];
    unsigned cvo[2][2], nvo[2][2], nnvo[2][2];
    MP.a_off(cur, Rr, Cc, cvo);
    bool has_next = S.next(1, nxt);
    if constexpr (Map::GATHER) { if (has_next) MP.a_off(nxt, Rr, Cc, nvo); else { nvo[0][0] = cvo[0][0]; nvo[0][1] = cvo[0][1]; nvo[1][0] = cvo[1][0]; nvo[1][1] = cvo[1][1]; } }
    unsigned cA = MP.a_soff(cur), cB = MP.b_soff(cur);
    typename Epi::Pre pc, pn;
    E.preload(cur, wr, wc, fr, fq, pc); pn = pc;
    PG8_STAGE(PG8_SB(0, 0), RB, cB, voffB); PG8_STAGE(PG8_SB(0, 1), RB, cB + hstep, voffB); PG8_STAGE(PG8_SA(0, 0), RA, cA, cvo[0]); PG8_STAGE(PG8_SA(0, 1), RA, cA, cvo[1]);
    if (wr == 1) PG8_BAR;
    PG8_WAIT_V(2); PG8_BAR;
    PG8_STAGE(PG8_SB(1, 0), RB, cB + kstep, voffB); PG8_STAGE(PG8_SA(1, 0), RA, cA + kstep, cvo[0]); PG8_STAGE(PG8_SB(1, 1), RB, cB + hstep + kstep, voffB);
    PG8_WAIT_V(6); PG8_BAR;
    for (;;) {
        const unsigned nA = has_next ? MP.a_soff(nxt) : cA, nB = has_next ? MP.b_soff(nxt) : cB;
#pragma unroll 1
        for (int t = 0; t < nt; t += 2) {
            const bool last = (t == nt - 2);
            if (KREP > 1 && FP8 && t > 0 && (t % nt1) == 0) {
#pragma unroll
                for (int a = 0; a < 2; ++a)
#pragma unroll
                    for (int b = 0; b < 2; ++b)
#pragma unroll
                        for (int m = 0; m < 4; ++m)
#pragma unroll
                            for (int n = 0; n < 2; ++n) acc[a][b][m][n] = (f32x4){0.f, 0.f, 0.f, 0.f}; }
            const unsigned a1 = cA + (unsigned)((t + 1) % nt1) * kstep;
            const unsigned a2 = last ? nA : cA + (unsigned)((t + 2) % nt1) * kstep, b2 = last ? nB : cB + (unsigned)((t + 2) % nt1) * kstep;
            const unsigned a3 = a2 + kstep, b3 = b2 + kstep;
            unsigned s0[2] = {cvo[0][0], cvo[0][1]}, s1[2] = {cvo[1][0], cvo[1][1]};
            if constexpr (Map::GATHER) { if (last) { s0[0] = nvo[0][0]; s0[1] = nvo[0][1]; s1[0] = nvo[1][0]; s1[1] = nvo[1][1]; } }
            PG8_LDB(B0, 0, 0); PG8_LDB(B1, 0, 1); PG8_SCHED; PG8_LDA(At, 0, 0); PG8_STAGE(PG8_SA(1, 1), RA, a1, cvo[1]);
            PG8_WAIT_V(8); PG8_WAIT_L(0); PG8_BAR; PG8_MMA(0, 0, At, B0); PG8_MMA(0, 1, At, B1); PG8_BAR; PG8_SCHED;
            PG8_LDA(At, 0, 1); PG8_STAGE(PG8_SB(0, 0), RB, b2, voffB); PG8_STAGE(PG8_SB(0, 1), RB, b2 + hstep, voffB); PG8_STAGE(PG8_SA(0, 0), RA, a2, s0);
            PG8_WAIT_V(8); PG8_WAIT_L(0); PG8_BAR; PG8_MMA(1, 0, At, B0); PG8_MMA(1, 1, At, B1); PG8_BAR; PG8_SCHED;
            PG8_LDB(B0, 1, 0); PG8_LDB(B1, 1, 1); PG8_SCHED; PG8_LDA(At, 1, 0); PG8_STAGE(PG8_SA(0, 1), RA, a2, s1);
            PG8_WAIT_V(8); PG8_WAIT_L(0); PG8_BAR; PG8_MMA(0, 0, At, B0); PG8_MMA(0, 1, At, B1); PG8_BAR; PG8_SCHED;
            PG8_LDA(At, 1, 1); PG8_STAGE(PG8_SB(1, 0), RB, b3, voffB); PG8_STAGE(PG8_SB(1, 1), RB, b3 + hstep, voffB); PG8_STAGE(PG8_SA(1, 0), RA, a3, s0);
            PG8_WAIT_V(8); PG8_WAIT_L(0); PG8_BAR; PG8_MMA(1, 0, At, B0); PG8_MMA(1, 1, At, B1); PG8_BAR; PG8_SCHED;
        }
        if constexpr (ALIGN_EPI) { if (wr == 0) PG8_BAR; }
        const bool has_nn = has_next && S.next(ui + 2, nn);
        if constexpr (Map::GATHER) { if (has_nn) MP.a_raw(nn, Rr, nnvo); }
        if (has_next) E.preload(nxt, wr, wc, fr, fq, pn);
        { int fr_ = fr, fq_ = fq; asm volatile("" : "+v"(fr_), "+v"(fq_)); E(acc, cur, pc, wr, wc, fr_, fq_); }
        if (!has_next) break;
#pragma unroll
        for (int a = 0; a < 2; ++a)
#pragma unroll
            for (int b = 0; b < 2; ++b)
#pragma unroll
                for (int m = 0; m < 4; ++m)
#pragma unroll
                    for (int n = 0; n < 2; ++n) acc[a][b][m][n] = (f32x4){0.f, 0.f, 0.f, 0.f};
        cur = nxt; cA = nA; cB = nB; ++ui; pc = pn;
#pragma unroll
        for (int h = 0; h < 2; ++h)
#pragma unroll
            for (int i = 0; i < 2; ++i) { if constexpr (Map::GATHER) { cvo[h][i] = nvo[h][i]; nvo[h][i] = has_nn ? MP.a_fin(nnvo[h][i], Cc[i]) : nvo[h][i]; } }
        has_next = has_nn; nxt = nn;
        if constexpr (ALIGN_EPI) { if (wr == 1) PG8_BAR; }
    }
    PG8_WAIT_V(0);
    if constexpr (!ALIGN_EPI) { if (wr == 0) PG8_BAR; }
    PG8_BAR;
#undef PG8_SA
#undef PG8_SB
#undef PG8_STAGE
#undef PG8_LDA
#undef PG8_LDB
#undef PG8_MMA
#undef PG8_HALF
#undef PG8_LD8
#undef PG8_WAIT_V
#undef PG8_WAIT_L
#undef PG8_BAR
#undef PG8_SCHED
}
}
namespace attn_body {
using bf16=__hip_bfloat16;
using bf16x8=__attribute__((ext_vector_type(8)))short;
using s16x4=__attribute__((ext_vector_type(4)))short;
using f32x16=__attribute__((ext_vector_type(16)))float;
using u32x4=__attribute__((ext_vector_type(4)))unsigned;
constexpr int BATCH=8,NHEAD=8,NKVH=2,SEQ=4096,D=64;
constexpr int QP=512,KP=128,VP=128,OP=1024,OCOL=512;
constexpr int NW=8,QBLK=32,QB=QBLK*NW,KVBLK=64,NQB=SEQ/QB;
__device__ __forceinline__ int crow(int r,int hi){return (r&3)+8*(r>>2)+4*hi;}
#define SBAR() __builtin_amdgcn_sched_barrier(0)
constexpr int NSLOT=3, SLOTB=8192;
constexpr int LDS_K=0, LDS_V=NSLOT*SLOTB, LDS_WS=2*NSLOT*SLOTB, LDS_OST=LDS_WS+NW*64*4, LDS_BYTES=LDS_OST+NW*4096;
constexpr float C2=0.125f*1.4426950408889634f;
__device__ __forceinline__ void glds16(const void*gsrc,unsigned lds_dst){unsigned keep;
  asm volatile("s_mov_b32 %0, m0\n\ts_mov_b32 m0, %2\n\ts_nop 0\n\tglobal_load_lds_dwordx4 %1, off\n\ts_mov_b32 m0, %0":"=&s"(keep):"v"(gsrc),"s"(lds_dst):"memory");}
__device__ __forceinline__ float max3f(float a,float b,float c){float r;asm("v_max3_f32 %0, %1, %2, %3":"=v"(r):"v"(a),"v"(b),"v"(c));return r;}
__device__ __forceinline__ float max2f(float a,float b){float r;asm("v_max_f32_e32 %0, %1, %2":"=v"(r):"v"(a),"v"(b));return r;}
__device__ __forceinline__ float fadd_s(float a,float b){float r;asm("v_add_f32_e32 %0, %1, %2":"=v"(r):"v"(a),"v"(b));return r;}
__device__ __forceinline__ float fsub_s(float a,float b){float r;asm("v_sub_f32_e32 %0, %1, %2":"=v"(r):"v"(a),"v"(b));return r;}
typedef float f32x2_t __attribute__((ext_vector_type(2))); typedef __bf16 bf16x2_t __attribute__((ext_vector_type(2)));
__device__ __forceinline__ unsigned cvtpk_s(float lo,float hi){f32x2_t v={lo,hi};bf16x2_t b=__builtin_convertvector(v,bf16x2_t);return __builtin_bit_cast(unsigned,b);}
#define WAIT_BAR(N) asm volatile("s_waitcnt vmcnt(" #N ") lgkmcnt(0)\n\ts_barrier":::"memory")

__device__ __forceinline__ void qkt(f32x16&p0,f32x16&p1,const char*Kslot,const bf16x8*qr,const f32x16&negm,int r32,int hi){
  const char*kb=Kslot+hi*1024+r32*16;
  #pragma unroll
  for(int d0=0;d0<4;++d0){
    const bf16x8 b0=*reinterpret_cast<const bf16x8*>(kb+d0*2048);
    const bf16x8 b1=*reinterpret_cast<const bf16x8*>(kb+d0*2048+512);
    if(d0==0){p0=__builtin_amdgcn_mfma_f32_32x32x16_bf16(b0,qr[0],negm,0,0,0);p1=__builtin_amdgcn_mfma_f32_32x32x16_bf16(b1,qr[0],negm,0,0,0);}
    else{p0=__builtin_amdgcn_mfma_f32_32x32x16_bf16(b0,qr[d0],p0,0,0,0);p1=__builtin_amdgcn_mfma_f32_32x32x16_bf16(b1,qr[d0],p1,0,0,0);}}
}
typedef __attribute__((address_space(3))) const char* lds_cptr;
typedef short v4i16_t __attribute__((ext_vector_type(4)));
__device__ __forceinline__ void kload8(bf16x8*kf,lds_cptr kp){
  kf[0]=*(const __attribute__((address_space(3))) bf16x8*)(kp);      kf[1]=*(const __attribute__((address_space(3))) bf16x8*)(kp+512);
  kf[2]=*(const __attribute__((address_space(3))) bf16x8*)(kp+2048); kf[3]=*(const __attribute__((address_space(3))) bf16x8*)(kp+2560);
  kf[4]=*(const __attribute__((address_space(3))) bf16x8*)(kp+4096); kf[5]=*(const __attribute__((address_space(3))) bf16x8*)(kp+4608);
  kf[6]=*(const __attribute__((address_space(3))) bf16x8*)(kp+6144); kf[7]=*(const __attribute__((address_space(3))) bf16x8*)(kp+6656);
}
__device__ __forceinline__ void kload2(bf16x8*kf,lds_cptr kp,int j){ kf[2*j]=*(const __attribute__((address_space(3))) bf16x8*)(kp+j*2048); kf[2*j+1]=*(const __attribute__((address_space(3))) bf16x8*)(kp+j*2048+512); }
__device__ __forceinline__ s16x4 vtr(lds_cptr p){ return __builtin_bit_cast(s16x4,__builtin_amdgcn_ds_read_tr16_b64_v4i16((__attribute__((address_space(3))) v4i16_t*)p)); }
__device__ __forceinline__ float rowmax(const f32x16&p0,const f32x16&p1){
  float a=max3f(p0[0],p0[1],p1[0]),b=max3f(p0[2],p0[3],p1[1]);a=max3f(a,p1[2],p1[3]);
  #pragma unroll
  for(int r=4;r<16;r+=4){a=max3f(a,p0[r],p0[r+1]);b=max3f(b,p0[r+2],p0[r+3]);a=max3f(a,p1[r],p1[r+1]);b=max3f(b,p1[r+2],p1[r+3]);}
  const float m=max2f(a,b);
  auto rr=__builtin_amdgcn_permlane32_swap(__float_as_uint(m),__float_as_uint(m),false,false);
  return max2f(__uint_as_float(rr[0]),__uint_as_float(rr[1]));
}
__device__ __forceinline__ void pv(f32x16*o,int vb,bf16x8 pa0,bf16x8 pa1,bf16x8 pa2,bf16x8 pa3){
  #pragma unroll
  for(int d0=0;d0<2;++d0){s16x4 lo[4],hi[4];
    #pragma unroll
    for(int ks=0;ks<4;++ks){
      asm volatile("ds_read_b64_tr_b16 %0,%1 offset:%c2":"=&v"(lo[ks]):"v"(vb),"i"(d0*4096+ks*1024):"memory");
      asm volatile("ds_read_b64_tr_b16 %0,%1 offset:%c2":"=&v"(hi[ks]):"v"(vb),"i"(d0*4096+ks*1024+512):"memory");}
    asm volatile("s_waitcnt lgkmcnt(0)":::"memory");SBAR();
    #define PK(k) (bf16x8){lo[k][0],lo[k][1],lo[k][2],lo[k][3],hi[k][0],hi[k][1],hi[k][2],hi[k][3]}
    o[d0]=__builtin_amdgcn_mfma_f32_32x32x16_bf16(pa0,PK(0),o[d0],0,0,0);
    o[d0]=__builtin_amdgcn_mfma_f32_32x32x16_bf16(pa1,PK(1),o[d0],0,0,0);
    o[d0]=__builtin_amdgcn_mfma_f32_32x32x16_bf16(pa2,PK(2),o[d0],0,0,0);
    o[d0]=__builtin_amdgcn_mfma_f32_32x32x16_bf16(pa3,PK(3),o[d0],0,0,0);
    #undef PK
  }
}
#define ATTN_STORE16(p,v) (*(u32x4*)(p)=(v))
template<int THRL> __device__ __forceinline__ void attn_unit(int b,int h,int qb,const bf16*Q,const bf16*__restrict__ K,const bf16*__restrict__ V,bf16*O,char*shm){
  const int tid=threadIdx.x,lane=tid&63,r32=lane&31,hi=lane>>5; const int wid=__builtin_amdgcn_readfirstlane(tid>>6);
  const long rowbase=(long)b*SEQ; const int q0=qb*QB; const int kvh=h/(NHEAD/NKVH);
  const bf16*Qw=Q+(rowbase+q0+wid*QBLK)*QP+h*D;
  const bf16*Kh=K+rowbase*KP+kvh*D,*Vh=V+rowbase*VP+kvh*D;
  const unsigned lds0=(unsigned)(uintptr_t)shm;
  float*wsf=(float*)(shm+LDS_WS)+wid*64;
  const bf16*ksrc=Kh+(long)lane*KP+wid*8;
  const bf16*vsrc=Vh+(long)(16*(wid&3)+(lane>>2))*VP+(wid>>2)*32+(lane&3)*8;
  const unsigned kdst=lds0+LDS_K+wid*1024, vdst=lds0+LDS_V+wid*1024;
  #define DMA_K(t,slot) glds16(ksrc+(long)(t)*KVBLK*KP,(unsigned)__builtin_amdgcn_readfirstlane(kdst+(slot)))
  #define DMA_V(t,slot) glds16(vsrc+(long)(t)*KVBLK*VP,(unsigned)__builtin_amdgcn_readfirstlane(vdst+(slot)))
  const int vb0=(int)(lds0+LDS_V)+((lane>>4)&1)*32+(lane&3)*8+(4*hi+((lane&15)>>2))*64;
  const char*Kbase=shm+LDS_K; bf16x8 kf[8];
  const lds_cptr shm3=(lds_cptr)shm; const lds_cptr kp0=shm3+LDS_K+hi*1024+r32*16; const lds_cptr vp0=shm3+LDS_V+((lane>>4)&1)*32+(lane&3)*8+(4*hi+((lane&15)>>2))*64;
  constexpr int NT=SEQ/KVBLK;
  DMA_K(0,0);DMA_V(0,0);DMA_K(1,SLOTB);
  bf16x8 qr[4];
  #pragma unroll
  for(int d0=0;d0<4;++d0)qr[d0]=*reinterpret_cast<const bf16x8*>(&Qw[(long)r32*QP+d0*16+hi*8]);
  float mhat=0.f,l_reg=0.f;f32x16 o[2];o[0]=f32x16{};o[1]=f32x16{};f32x16 negm=f32x16{};asm volatile("":"+v"(negm));
  bool resc=false;
  #define START(P0,P1) do{ const float rm=rowmax(P0,P1); resc=false; \
    { const float dl=rm; mhat=fadd_s(mhat,dl); \
      _Pragma("unroll") for(int r=0;r<16;++r){P0[r]=fsub_s(P0[r],dl);P1[r]=fsub_s(P1[r],dl);} \
      _Pragma("unroll") for(int r=0;r<16;++r)negm[r]=-mhat; asm volatile("":"+v"(negm)); } \
    _Pragma("unroll") for(int r=0;r<16;++r)P0[r]=__builtin_amdgcn_exp2f(P0[r]); }while(0)
  #define RESC() do{ if(resc){ asm volatile("s_waitcnt lgkmcnt(0)":::"memory"); \
      _Pragma("unroll") for(int d_=0;d_<2;++d_) _Pragma("unroll") for(int r=0;r<16;++r)o[d_][r]*=wsf[crow(r,hi)]; } }while(0)
  f32x16 pA0,pA1,pB0,pB1;
  int sl_prev=0,sl_cur=0,sl_next=SLOTB;
  #define ROT() do{sl_prev=sl_cur;sl_cur=sl_next;sl_next=(sl_next==(NSLOT-1)*SLOTB)?0:sl_next+SLOTB;}while(0)
  DMA_K(2,2*SLOTB);
  WAIT_BAR(3);
  qkt(pA0,pA1,Kbase,qr,negm,r32,hi);asm volatile("s_nop 15\n\ts_nop 7":"+v"(pA0),"+v"(pA1));
  START(pA0,pA1);
  _Pragma("unroll") for(int r=0;r<16;++r)pA1[r]=__builtin_amdgcn_exp2f(pA1[r]);
  WAIT_BAR(0);
  DMA_K(3,0);DMA_V(1,SLOTB);
  ROT();
  kload8(kf,kp0+sl_cur);
  WAIT_BAR(2);
  s16x4 vlo[8],vhi[8]; u32x4 pw0,pw1,pw2,pw3;
  #define PKW(P,B) cvtpk_s(P[B],P[B+1])
  #define PAF(k) __builtin_bit_cast(bf16x8,pw##k)
  #define VFR(i) (bf16x8){vlo[i][0],vlo[i][1],vlo[i][2],vlo[i][3],vhi[i][0],vhi[i][1],vhi[i][2],vhi[i][3]}
  #define PIN(x) asm volatile("":"+v"(x))
  #define MX3(a,b,c) __builtin_fmaxf(__builtin_fmaxf((a),(b)),(c))
  #define GAPA(MF,A0,A1,A2,A3,W0,W1,PW) do{ MF; sacc+=A0; sacc+=A1; sacc+=A2; sacc+=A3; PIN(sacc); W0; W1; PIN(PW); SBAR(); }while(0)
  #define EX(v) __builtin_amdgcn_exp2f(v)
  #define GAPB(MF,X,B) do{ MF; X[B]=EX(X[B]); X[B+1]=EX(X[B+1]); X[B+2]=EX(X[B+2]); X[B+3]=EX(X[B+3]); PIN(X); SBAR(); }while(0)
  #define VRD(i) do{ vlo[i]=vtr(vp_+(((i)>>2)*4096+((i)&3)*1024)); vhi[i]=vtr(vp_+(((i)>>2)*4096+((i)&3)*1024+512)); }while(0)
  #define KRD(G,j) do{ if(G){ kload2(kf,kp0+sl_next,j); SBAR(); } }while(0)
  #define STEP(C0,C1,P0,P1,t,GK,GV,GL) do{ SBAR(); \
    const lds_cptr vp_=vp0+sl_prev; \
    VRD(0); SBAR(); float sacc=(P0[0]+P0[1]); \
    GAPA(C0=__builtin_amdgcn_mfma_f32_32x32x16_bf16(kf[0],qr[0],negm,0,0,0), P0[2],P0[3],P0[4],P0[5],     pw0[0]=PKW(P0,0), pw0[1]=PKW(P0,2), pw0); \
    VRD(4); SBAR(); GAPA(C1=__builtin_amdgcn_mfma_f32_32x32x16_bf16(kf[1],qr[0],negm,0,0,0), P0[6],P0[7],P0[8],P0[9],     pw0[2]=PKW(P0,4), pw0[3]=PKW(P0,6), pw0); \
    VRD(1); SBAR(); GAPA(C0=__builtin_amdgcn_mfma_f32_32x32x16_bf16(kf[2],qr[1],C0,0,0,0),   P0[10],P0[11],P0[12],P0[13], pw1[0]=PKW(P0,8), pw1[1]=PKW(P0,10), pw1); \
    VRD(5); SBAR(); GAPA(C1=__builtin_amdgcn_mfma_f32_32x32x16_bf16(kf[3],qr[1],C1,0,0,0),   P0[14],P0[15],P1[0],P1[1],   pw1[2]=PKW(P0,12),pw1[3]=PKW(P0,14), pw1); \
    VRD(2); SBAR(); GAPA(C0=__builtin_amdgcn_mfma_f32_32x32x16_bf16(kf[4],qr[2],C0,0,0,0),   P1[2],P1[3],P1[4],P1[5],     pw2[0]=PKW(P1,0), pw2[1]=PKW(P1,2), pw2); \
    VRD(6); SBAR(); GAPA(C1=__builtin_amdgcn_mfma_f32_32x32x16_bf16(kf[5],qr[2],C1,0,0,0),   P1[6],P1[7],P1[8],P1[9],     pw2[2]=PKW(P1,4), pw2[3]=PKW(P1,6), pw2); \
    VRD(3); SBAR(); GAPA(C0=__builtin_amdgcn_mfma_f32_32x32x16_bf16(kf[6],qr[3],C0,0,0,0),   P1[10],P1[11],P1[12],P1[13], pw3[0]=PKW(P1,8), pw3[1]=PKW(P1,10), pw3); \
    VRD(7); SBAR(); GAPA(C1=__builtin_amdgcn_mfma_f32_32x32x16_bf16(kf[7],qr[3],C1,0,0,0),   P1[14],P1[15],0.f,0.f,       pw3[2]=PKW(P1,12),pw3[3]=PKW(P1,14), pw3); \
    l_reg+=sacc; \
    if(GK){DMA_K((t)+3,sl_cur);} if(GV){DMA_V((t)+1,sl_next);} \
    { float a=MX3(C0[0],C0[1],C1[0]),b=MX3(C0[2],C0[3],C1[1]); a=MX3(a,C1[2],C1[3]); \
      _Pragma("unroll") for(int r=4;r<16;r+=4){a=MX3(a,C0[r],C0[r+1]);b=MX3(b,C0[r+2],C0[r+3]);a=MX3(a,C1[r],C1[r+1]);b=MX3(b,C1[r+2],C1[r+3]);} \
      float rm=__builtin_fmaxf(a,b); { auto rr=__builtin_amdgcn_permlane32_swap(__float_as_uint(rm),__float_as_uint(rm),false,false); rm=__builtin_fmaxf(__uint_as_float(rr[0]),__uint_as_float(rr[1])); } \
      resc=false; \
      if(__builtin_expect(__any(rm>(float)THRL),0)){ const float dl=__builtin_fmaxf(rm,0.f); mhat+=dl; \
        _Pragma("unroll") for(int r=0;r<16;++r){C0[r]-=dl;C1[r]-=dl;} \
        _Pragma("unroll") for(int r=0;r<16;++r)negm[r]=-mhat; asm volatile("":"+v"(negm)); \
        const float f=__builtin_amdgcn_exp2f(-dl); l_reg*=f; if(hi==0)wsf[r32]=f; resc=true; } } \
    SBAR(); \
    GAPB(o[0]=__builtin_amdgcn_mfma_f32_32x32x16_bf16(PAF(0),VFR(0),o[0],0,0,0), C0,0); \
    GAPB(o[1]=__builtin_amdgcn_mfma_f32_32x32x16_bf16(PAF(0),VFR(4),o[1],0,0,0), C0,4); \
    KRD(GL,0); GAPB(o[0]=__builtin_amdgcn_mfma_f32_32x32x16_bf16(PAF(1),VFR(1),o[0],0,0,0), C0,8); \
    KRD(GL,1); GAPB(o[1]=__builtin_amdgcn_mfma_f32_32x32x16_bf16(PAF(1),VFR(5),o[1],0,0,0), C0,12); \
    KRD(GL,2); GAPB(o[0]=__builtin_amdgcn_mfma_f32_32x32x16_bf16(PAF(2),VFR(2),o[0],0,0,0), C1,0); \
    KRD(GL,3); GAPB(o[1]=__builtin_amdgcn_mfma_f32_32x32x16_bf16(PAF(2),VFR(6),o[1],0,0,0), C1,4); \
    GAPB(o[0]=__builtin_amdgcn_mfma_f32_32x32x16_bf16(PAF(3),VFR(3),o[0],0,0,0), C1,8); \
    GAPB(o[1]=__builtin_amdgcn_mfma_f32_32x32x16_bf16(PAF(3),VFR(7),o[1],0,0,0), C1,12); \
    }while(0)
  int t=1;
  for(;t+5<NT;t+=2){
    STEP(pB0,pB1,pA0,pA1,t,true,true,true);     WAIT_BAR(2); RESC(); ROT();
    STEP(pA0,pA1,pB0,pB1,t+1,true,true,true);   WAIT_BAR(2); RESC(); ROT();
  }
  #define ENDW(tt) do{ if((tt)+3<NT){WAIT_BAR(2);} else if((tt)+2<NT){WAIT_BAR(1);} else {WAIT_BAR(0);} }while(0)
  for(;t+1<NT;t+=2){
    STEP(pB0,pB1,pA0,pA1,t,(t+3<NT),(t+1<NT),(t+1<NT));       ENDW(t);   RESC(); ROT();
    STEP(pA0,pA1,pB0,pB1,t+1,(t+4<NT),(t+2<NT),(t+2<NT));     ENDW(t+1); RESC(); ROT();
  }
  STEP(pB0,pB1,pA0,pA1,NT-1,false,false,false); RESC();
  { float sacc=pB0[0]+pB0[1]; _Pragma("unroll") for(int r=2;r<16;++r)sacc+=pB0[r]; _Pragma("unroll") for(int r=0;r<16;++r)sacc+=pB1[r]; l_reg+=sacc;
    pw0=(u32x4){PKW(pB0,0),PKW(pB0,2),PKW(pB0,4),PKW(pB0,6)};pw1=(u32x4){PKW(pB0,8),PKW(pB0,10),PKW(pB0,12),PKW(pB0,14)};pw2=(u32x4){PKW(pB1,0),PKW(pB1,2),PKW(pB1,4),PKW(pB1,6)};pw3=(u32x4){PKW(pB1,8),PKW(pB1,10),PKW(pB1,12),PKW(pB1,14)};
    SBAR(); pv(o,vb0+sl_cur,PAF(0),PAF(1),PAF(2),PAF(3)); }
  #undef PKW
  #undef PAF
  #undef VFR
  #undef PIN
  #undef MX3
  #undef GAPA
  #undef GAPB
  #undef EX
  #undef VRD
  #undef KRD
  #undef STEP
  #undef ENDW
  {auto rr=__builtin_amdgcn_permlane32_swap(__float_as_uint(l_reg),__float_as_uint(l_reg),false,false);l_reg=__uint_as_float(rr[0])+__uint_as_float(rr[1]);}
  if(hi==0)wsf[32+r32]=l_reg;asm volatile("s_waitcnt lgkmcnt(0)":::"memory");
  float rli[16];
  #pragma unroll
  for(int r=0;r<16;++r)rli[r]=__builtin_amdgcn_rcpf(wsf[32+crow(r,hi)]);
  bf16*Ow=O+(rowbase+q0+wid*QBLK)*OP+OCOL+h*D;
  { bf16*stg=(bf16*)(shm+LDS_OST)+wid*2048;
    #pragma unroll
    for(int r=0;r<16;++r){const int orow=crow(r,hi);
      #pragma unroll
      for(int d0=0;d0<2;++d0)stg[orow*64+d0*32+r32]=__float2bfloat16(o[d0][r]*rli[r]);}
    asm volatile("s_waitcnt lgkmcnt(0)":::"memory");
    #pragma unroll
    for(int i=0;i<4;++i){const int row=i*8+(lane>>3),ch=lane&7; const u32x4 v=*(const u32x4*)(stg+row*64+ch*8); ATTN_STORE16(Ow+(long)row*OP+ch*8,v);} }
  asm volatile("s_waitcnt lgkmcnt(0)\n\ts_barrier":::"memory");
  #undef DMA_K
  #undef DMA_V
  #undef START
  #undef RESC
  #undef ROT
}
constexpr int ATTN_LDS_BYTES=LDS_BYTES;
#undef SBAR
#undef WAIT_BAR
}
constexpr int NWAVES = 8;
constexpr int BATCH = 8, SEQ = 4096, DM = 1024, T = BATCH * SEQ;
constexpr int GLA_H = 4, GLA_DK = 64, GLA_DV = 128, GLA_RANK = 16;
constexpr int ATT_H = 8, ATT_KVH = 2, ATT_DH = 64;
constexpr int D_IN = 2336, D_IN_PAD = 2560;
constexpr int NEXP = 32, TOPK = 4, DFF = 1024;
constexpr int EROWS = 32768;
constexpr int PROWS = T * TOPK + NEXP * 256;
constexpr float EPS = 1e-6f;
constexpr float YSCALE = 16.f;
constexpr float WSCALE = 32.f, ASCALE = 4.f;

constexpr size_t MiB = 1u << 20;
constexpr size_t WS_CTL = 0, CTL_ZERO_BYTES = 1 * MiB;
constexpr size_t WS_WRH = 1 * MiB, WS_WRL = WS_WRH + 65536;
constexpr size_t WS_WIN = 2 * MiB;
constexpr size_t WS_WOUT = 8 * MiB;
constexpr size_t WS_W1 = 10 * MiB;
constexpr size_t WS_W2 = 138 * MiB;
constexpr size_t WS_ROWTOK = 202 * MiB;
constexpr size_t WS_ROWGATE = 206 * MiB;
constexpr size_t WS_TOKASG = 210 * MiB;
constexpr size_t WS_REGY = 212 * MiB;
constexpr size_t WS_XN = WS_REGY;
constexpr size_t WS_GQ = WS_XN + 64 * MiB;
constexpr size_t WS_GK = WS_GQ + 16 * MiB;
constexpr size_t WS_GV = WS_GK + 16 * MiB;
constexpr size_t WS_GR = WS_GV + 32 * MiB;
constexpr size_t WS_AQ = WS_GR + 32 * MiB;
constexpr size_t WS_AK = WS_AQ + 32 * MiB;
constexpr size_t WS_AV = WS_AK + 8 * MiB;
constexpr size_t WS_Z = WS_AV + 8 * MiB;
constexpr size_t WS_OF = WS_Z + 2 * MiB;
constexpr size_t WS_Y = WS_REGY;
constexpr size_t WS_REGA = WS_REGY + 274 * MiB;
constexpr size_t WS_MIX = WS_REGA;
constexpr size_t WS_ACT = WS_REGA;
constexpr size_t WS_QF = WS_REGA + 272 * MiB, WS_KF = WS_QF + 16 * MiB, WS_QB = WS_KF + 16 * MiB, WS_KB = WS_QB + 16 * MiB;
constexpr size_t WS_DEC = WS_KB + 16 * MiB;
constexpr size_t WS_END = WS_DEC + 1 * MiB;
static_assert(WS_OF + (size_t)T * 512 * 4 <= WS_REGA && (size_t)PROWS * 1024 * 2 <= 272 * MiB, "d_ws map");
constexpr int CW_BAR = 4096;
constexpr int CW_CNT = 8192;
constexpr int CW_GDN = 16384;
constexpr int CW_QUE = 12288;

constexpr int SCR_BYTES = 133120;
constexpr int LC_OFF = SCR_BYTES;
constexpr int LC_MISC = LC_OFF;
constexpr int LC_CNT = LC_OFF + 128;
constexpr int LC_CST = LC_CNT + 128;
constexpr int LC_TE = LC_CST + 256;
constexpr int LC_HIST = LC_TE + 1152;
constexpr int LC_BASE = LC_HIST + 128;
constexpr int LC_ASG = LC_BASE + 128;
constexpr int LC_END = LC_ASG + 8192;
constexpr int LDS_BYTES = 147456;
static_assert(LC_END <= LDS_BYTES, "LDS map");

typedef unsigned short bf16;
typedef unsigned v4u __attribute__((ext_vector_type(4)));
typedef unsigned v2u __attribute__((ext_vector_type(2)));
typedef float f32x4 __attribute__((ext_vector_type(4)));
typedef short bf16x8 __attribute__((ext_vector_type(8)));
typedef GAS unsigned gu32;
#define RLX_AGENT __ATOMIC_RELAXED, __HIP_MEMORY_SCOPE_AGENT
#define LDS_WAIT() asm volatile("s_waitcnt lgkmcnt(0)" ::: "memory")
#define VM_WAIT() asm volatile("s_waitcnt vmcnt(0)" ::: "memory")
__device__ __forceinline__ unsigned f2bf(float f) { unsigned u = __builtin_bit_cast(unsigned, f); return (u + 0x7fffu + ((u >> 16) & 1u)) >> 16; }
__device__ __forceinline__ unsigned pk2(float lo, float hi) { return f2bf(lo) | (f2bf(hi) << 16); }
__device__ __forceinline__ float bf2f(unsigned h) { return __builtin_bit_cast(float, h << 16); }
__device__ __forceinline__ float bflo(unsigned w) { return __builtin_bit_cast(float, w << 16); }
__device__ __forceinline__ float bfhi(unsigned w) { return __builtin_bit_cast(float, w & 0xffff0000u); }

#define XB_TMO      128
#define XB_XCNT(j)  (256  + 64 * (j))
#define XB_XSUB(j)  (1280 + 64 * (j))
#define XB_XGEN(j)  (2304 + 64 * (j))
#define XB_TOP      3328
#define XB_TOPGEN   3392
#define XCD_BAR_WORDS 3456
#define XB_SPIN_CAP (1u << 18)
#ifdef POLLRMW
__device__ __forceinline__ unsigned xb_ld(unsigned* p)              { return __hip_atomic_fetch_add(p, 0u, __ATOMIC_RELAXED, __HIP_MEMORY_SCOPE_AGENT); }
#else
__device__ __forceinline__ unsigned xb_ld(unsigned* p)              { return __hip_atomic_load(p, __ATOMIC_RELAXED, __HIP_MEMORY_SCOPE_AGENT); }
#endif
__device__ __forceinline__ unsigned xb_add(unsigned* p, unsigned v) { return __hip_atomic_fetch_add(p, v, __ATOMIC_RELAXED, __HIP_MEMORY_SCOPE_AGENT); }
__device__ __forceinline__ unsigned xb_xcc_id() { return (unsigned)__builtin_amdgcn_s_getreg((3 << 11) | 20) & 0xFu; }
#define XB_SPIN(cond, bar) do { unsigned _sp = 0; while (cond) { __builtin_amdgcn_s_sleep(1); \
    if ((++_sp & 255u) == 0u) { if (xb_ld(&(bar)[XB_TMO])) break; if (_sp > XB_SPIN_CAP) { atomicAdd(&(bar)[XB_TMO], 1u); break; } } } } while (0)
struct XcdBarrier { unsigned* bar; unsigned x; volatile LAS unsigned* st; };
__device__ __forceinline__ XcdBarrier xcd_barrier_post(unsigned* bar, volatile LAS unsigned* st) {
    XcdBarrier b; b.bar = bar; b.x = xb_xcc_id(); b.st = st;
    if (threadIdx.x == 0) (void)xb_add(&bar[XB_XCNT(b.x)], 1u);
    return b;
}
__device__ __forceinline__ void xcd_barrier_complete(unsigned* bar, unsigned x, unsigned& nloc, unsigned& nx) {
    const unsigned G = gridDim.x * gridDim.y * gridDim.z;
    unsigned sum, cnt, mine, sp = 0u;
    for (;;) {
        sum = 0u; cnt = 0u; mine = 0u;
#pragma unroll
        for (unsigned j = 0; j < 16; ++j) { const unsigned c = xb_ld(&bar[XB_XCNT(j)]); sum += c; cnt += (c > 0u) ? 1u : 0u; mine = (j == x) ? c : mine; }
        if (sum == G) break;
        __builtin_amdgcn_s_sleep(1);
        if ((++sp & 255u) == 0u) { if (xb_ld(&bar[XB_TMO])) break; if (sp > XB_SPIN_CAP) { atomicAdd(&bar[XB_TMO], 1u); break; } }
    }
    nloc = mine > 0u ? mine : 1u; nx = cnt > 0u ? cnt : 1u;
}
__device__ __forceinline__ void xcd_barrier(const XcdBarrier& b) {
    asm volatile("s_waitcnt vmcnt(0)" ::: "memory");
    __syncthreads();
    if (threadIdx.x == 0) {
        unsigned* bar = b.bar;
        __builtin_amdgcn_s_waitcnt(0);
        unsigned nloc = b.st[0], nx = b.st[1];
        if (nloc == 0u) { xcd_barrier_complete(bar, b.x, nloc, nx); b.st[0] = nloc; b.st[1] = nx; }
        const unsigned old = xb_add(&bar[XB_XSUB(b.x)], 1u);
        const unsigned gen = old / nloc;
        if (old + 1u == (gen + 1u) * nloc) {
            __builtin_amdgcn_fence(__ATOMIC_RELEASE, "agent");
            asm volatile("s_waitcnt vmcnt(0)" ::: "memory");
            const unsigned og = xb_add(&bar[XB_TOP], 1u);
            const unsigned tg = og / nx;
            if (og + 1u == (tg + 1u) * nx) xb_add(&bar[XB_TOPGEN], 1u);
            else XB_SPIN(xb_ld(&bar[XB_TOPGEN]) == tg, bar);
            __builtin_amdgcn_fence(__ATOMIC_ACQUIRE, "agent");
            xb_add(&bar[XB_XGEN(b.x)], 1u);
            asm volatile("s_waitcnt vmcnt(0)" ::: "memory");
        } else {
            XB_SPIN(xb_ld(&bar[XB_XGEN(b.x)]) == gen, bar);
            __builtin_amdgcn_fence(__ATOMIC_ACQUIRE, "agent");
            asm volatile("s_waitcnt vmcnt(0)" ::: "memory");
        }
    }
    __syncthreads();
}

__device__ __forceinline__ void xcd_barrier2(const XcdBarrier& b) {
    asm volatile("s_waitcnt vmcnt(0)" ::: "memory");
    __syncthreads();
    if (threadIdx.x == 0) {
        unsigned* bar = b.bar;
        __builtin_amdgcn_s_waitcnt(0);
        unsigned nloc = b.st[0], nx = b.st[1];
        if (nloc == 0u) { xcd_barrier_complete(bar, b.x, nloc, nx); b.st[0] = nloc; b.st[1] = nx; }
        const unsigned old = xb_add(&bar[XB_XSUB(b.x)], 1u);
        const unsigned gen = old / nloc;
        if (old + 1u == (gen + 1u) * nloc) {
            __builtin_amdgcn_fence(__ATOMIC_RELEASE, "agent");
            asm volatile("s_waitcnt vmcnt(0)" ::: "memory");
            (void)xb_add(&bar[XB_TOP], 1u);
        }
        const unsigned target = (gen + 1u) * nx;
        XB_SPIN(xb_ld(&bar[XB_TOP]) < target, bar);
        __builtin_amdgcn_fence(__ATOMIC_ACQUIRE, "agent");
        asm volatile("s_waitcnt vmcnt(0)" ::: "memory");
    }
    __syncthreads();
}

__device__ __forceinline__ void xcd_barrier_probe(const XcdBarrier& b) {
    asm volatile("s_waitcnt vmcnt(0)" ::: "memory");
    __syncthreads();
    if (threadIdx.x == 0) {
        unsigned* bar = b.bar;
        __builtin_amdgcn_s_waitcnt(0);
        unsigned nloc = b.st[0], nx = b.st[1];
        if (nloc == 0u) { xcd_barrier_complete(bar, b.x, nloc, nx); b.st[0] = nloc; b.st[1] = nx; }
        const unsigned old = xb_add(&bar[XB_XSUB(b.x)], 1u);
        const unsigned gen = old / nloc;
        if (old + 1u == (gen + 1u) * nloc) {
#ifndef XB_NOREL
            __builtin_amdgcn_fence(__ATOMIC_RELEASE, "agent");
            asm volatile("s_waitcnt vmcnt(0)" ::: "memory");
#endif
            (void)xb_add(&bar[XB_TOP], 1u);
        }
        const unsigned target = (gen + 1u) * nx;
        XB_SPIN(xb_ld(&bar[XB_TOP]) < target, bar);
#ifndef XB_NOACQ
        __builtin_amdgcn_fence(__ATOMIC_ACQUIRE, "agent");
        asm volatile("s_waitcnt vmcnt(0)" ::: "memory");
#endif
    }
    __syncthreads();
}


#define FB_CNT 64
#define FB_TMO 128
__device__ __forceinline__ void flat_barrier(unsigned* bar, volatile LAS unsigned* genw) {
    asm volatile("s_waitcnt vmcnt(0)" ::: "memory");
    __syncthreads();
    if (threadIdx.x == 0) {
        const unsigned g = genw[0] + 1u; genw[0] = g;
        __builtin_amdgcn_fence(__ATOMIC_RELEASE, "agent");
        asm volatile("s_waitcnt vmcnt(0)" ::: "memory");
        (void)xb_add(&bar[FB_CNT], 1u);
        const unsigned target = g * gridDim.x; unsigned sp = 0;
        while (xb_ld(&bar[FB_CNT]) < target) { __builtin_amdgcn_s_sleep(1); if ((++sp & 255u) == 0u) { if (xb_ld(&bar[FB_TMO])) break; if (sp > XB_SPIN_CAP) { atomicAdd(&bar[FB_TMO], 1u); break; } } }
        __builtin_amdgcn_fence(__ATOMIC_ACQUIRE, "agent");
        asm volatile("s_waitcnt vmcnt(0)" ::: "memory");
    }
    __syncthreads();
}

struct Frame {
    LAS unsigned char* lds;
    volatile LAS unsigned* MISC;
    gu32* ctl;
    int tid, lane, wave;
    int vcu, G;
    unsigned char* ws;
    const float *x, *mix_g, *w_in, *w_gf, *b_gf, *w_gb, *b_gb, *gla_hg, *q_g, *k_g, *w_out, *ffn_g, *w_router, *b_router, *w1, *b1, *w2, *b2, *fin_g;
    float* out;
};
__device__ __forceinline__ float wave_sum(float v) {
#pragma unroll
    for (int o = 1; o < 64; o <<= 1) v += __shfl_xor(v, o);
    return v;
}
__device__ __forceinline__ void p0_tr64(const float* src  , int ldw, bf16* d0, bf16* d1, int ldt, LAS float* scr, int lane, int ncols) {
    const int c4 = (lane & 15) * 4, kr = lane >> 4;
    if (c4 < ncols) {
#pragma unroll 4
        for (int i = 0; i < 16; ++i) { const int kk = kr + 4 * i; const f32x4 v = *(const GAS f32x4*)(src + (size_t)kk * ldw + c4);
            LAS float* s = scr + kk * 65 + c4; s[0] = v.x; s[1] = v.y; s[2] = v.z; s[3] = v.w; }
    }
    LDS_WAIT(); asm volatile("" ::: "memory");
    const int c = lane & 7;
#pragma unroll
    for (int j = 0; j < 8; ++j) { const int n = (lane >> 3) + 8 * j;
        if (n < ncols) { const LAS float* s = scr + (8 * c) * 65 + n;
            v4u o; o.x = pk2(s[0 * 65], s[1 * 65]); o.y = pk2(s[2 * 65], s[3 * 65]); o.z = pk2(s[4 * 65], s[5 * 65]); o.w = pk2(s[6 * 65], s[7 * 65]);
            bf16* rowp = (n < 32 ? d0 : d1) + (size_t)(n & 31) * ldt;
            *(GAS v4u*)(rowp + 8 * c) = o; } }
    LDS_WAIT(); asm volatile("" ::: "memory");
}
__device__ __forceinline__ void p0_tr64_f8(const float* src, int ldw, unsigned char* d0, unsigned char* d1, int ldt, LAS float* scr, int lane, float sc) {
    const int c4 = (lane & 15) * 4, kr = lane >> 4;
#pragma unroll 4
    for (int i = 0; i < 16; ++i) { const int kk = kr + 4 * i; const f32x4 v = *(const GAS f32x4*)(src + (size_t)kk * ldw + c4);
        LAS float* s = scr + kk * 65 + c4; s[0] = v.x; s[1] = v.y; s[2] = v.z; s[3] = v.w; }
    LDS_WAIT(); asm volatile("" ::: "memory");
    const int c = lane & 7;
#pragma unroll
    for (int j = 0; j < 8; ++j) { const int n = (lane >> 3) + 8 * j; const LAS float* s = scr + (8 * c) * 65 + n;
        int w0 = 0, w1 = 0;
        w0 = __builtin_amdgcn_cvt_pk_fp8_f32(s[0 * 65] * sc, s[1 * 65] * sc, w0, false); w0 = __builtin_amdgcn_cvt_pk_fp8_f32(s[2 * 65] * sc, s[3 * 65] * sc, w0, true);
        w1 = __builtin_amdgcn_cvt_pk_fp8_f32(s[4 * 65] * sc, s[5 * 65] * sc, w1, false); w1 = __builtin_amdgcn_cvt_pk_fp8_f32(s[6 * 65] * sc, s[7 * 65] * sc, w1, true);
        unsigned char* rowp = (n < 32 ? d0 : d1) + (size_t)(n & 31) * ldt;
        *(GAS v2u*)(rowp + 8 * c) = (v2u){(unsigned)w0, (unsigned)w1}; }
    LDS_WAIT(); asm volatile("" ::: "memory");
}
__device__ __forceinline__ int win_pblk(int lb) { return lb < 48 ? lb : (lb == 48 ? 72 : lb - 1); }
__device__ __forceinline__ int w1_pblk(int lb) { return lb < 32 ? (lb >> 2) * 8 + (lb & 3) : ((lb - 32) >> 2) * 8 + 4 + ((lb - 32) & 3); }
__device__ __forceinline__ void rms_row_to_bf16(const float* xrow, const float* g, bf16* orow, int lane) {
    const GAS f32x4* xr = (const GAS f32x4*)xrow + lane; const GAS f32x4* gr = (const GAS f32x4*)g + lane;
    f32x4 v[4]; float s = 0.f;
#pragma unroll
    for (int j = 0; j < 4; ++j) { v[j] = xr[64 * j]; s += (v[j].x * v[j].x + v[j].y * v[j].y) + (v[j].z * v[j].z + v[j].w * v[j].w); }
    const float rinv = 1.f / sqrtf(wave_sum(s) * (1.f / 1024.f) + EPS);
    GAS unsigned long long* o8 = (GAS unsigned long long*)orow + lane;
#pragma unroll
    for (int j = 0; j < 4; ++j) { const f32x4 gg = gr[64 * j];
        o8[64 * j] = (unsigned long long)pk2(v[j].x * rinv * gg.x, v[j].y * rinv * gg.y) | ((unsigned long long)pk2(v[j].z * rinv * gg.z, v[j].w * rinv * gg.w) << 32); }
}
__device__ __forceinline__ void p0_prologue(Frame& F) {
    LAS float* scr = (LAS float*)(F.lds + F.wave * 16640);
    const int gw = F.vcu * NWAVES + F.wave, NGW = F.G * NWAVES;
    bf16* WIN = (bf16*)(F.ws + WS_WIN); bf16* WOUT = (bf16*)(F.ws + WS_WOUT); unsigned char* W1T = F.ws + WS_W1; unsigned char* W2T = F.ws + WS_W2;
    constexpr int I_IN = 16 * 37, I_OUT = 16 * 16, I_1 = NEXP * 16 * 32, I_2 = NEXP * 16 * 16, NITEMS = I_IN + I_OUT + I_1 + I_2;
    for (int it = gw; it < NITEMS; it += NGW) {
        int r = it;
        if (r < I_IN) { const int kb = r / 37, nb = r % 37; const int lb0 = 2 * nb, nc = (nb == 36) ? 32 : 64;
            p0_tr64(F.w_in + (size_t)(64 * kb) * D_IN + 64 * nb, D_IN, WIN + (size_t)(32 * win_pblk(lb0)) * 1024 + 64 * kb, WIN + (size_t)(32 * win_pblk(lb0 + 1 < 73 ? lb0 + 1 : lb0)) * 1024 + 64 * kb, 1024, scr, F.lane, nc); continue; }
        r -= I_IN;
        if (r < I_OUT) { const int kb = r / 16, nb = r % 16;
            p0_tr64(F.w_out + (size_t)(64 * kb) * 1024 + 64 * nb, 1024, WOUT + (size_t)(64 * nb) * 1024 + 64 * kb, WOUT + (size_t)(64 * nb + 32) * 1024 + 64 * kb, 1024, scr, F.lane, 64); continue; }
        r -= I_OUT;
        if (r < I_1) { const int e = r / 512, q = r % 512, kb = q / 32, nb = q % 32; const float* src = F.w1 + (size_t)e * 1024 * 2048 + (size_t)(64 * kb) * 2048 + 64 * nb; unsigned char* dst = W1T + (size_t)e * 2048 * 1024 + 64 * kb;
            p0_tr64_f8(src, 2048, dst + (size_t)(32 * w1_pblk(2 * nb)) * 1024, dst + (size_t)(32 * w1_pblk(2 * nb + 1)) * 1024, 1024, scr, F.lane, WSCALE); continue; }
        r -= I_1;
        { const int e = r / 256, q = r % 256, kb = q / 16, nb = q % 16; const float* src = F.w2 + (size_t)e * 1024 * 1024 + (size_t)(64 * kb) * 1024 + 64 * nb; unsigned char* dst = W2T + (size_t)e * 1024 * 1024 + 64 * kb;
            p0_tr64_f8(src, 1024, dst + (size_t)(64 * nb) * 1024, dst + (size_t)(64 * nb + 32) * 1024, 1024, scr, F.lane, WSCALE); }
    }
    { const int gt = F.vcu * (NWAVES * 64) + F.tid, NGT = F.G * NWAVES * 64; GAS v4u* z = (GAS v4u*)(WIN + (size_t)D_IN * 1024);
      for (int i = gt; i < (D_IN_PAD - D_IN) * 1024 * 2 / 16; i += NGT) z[i] = (v4u){0u, 0u, 0u, 0u};
      bf16* WRH = (bf16*)(F.ws + WS_WRH); bf16* WRL = (bf16*)(F.ws + WS_WRL);
      for (int i = gt; i < NEXP * 1024; i += NGT) { const int e = i >> 10, k = i & 1023; const float w = F.w_router[(size_t)k * NEXP + e]; const unsigned h = f2bf(w); WRH[i] = (bf16)h; WRL[i] = (bf16)f2bf(w - bf2f(h)); } }
    bf16* XN = (bf16*)(F.ws + WS_XN);
    for (int m = gw; m < T; m += NGW) rms_row_to_bf16(F.x + (size_t)m * DM, F.mix_g, XN + (size_t)m * DM, F.lane);
}

__device__ __forceinline__ void p2_normrope(Frame& F, const bool dry = false) {
    LAS float* cs = (LAS float*)F.lds;
    for (int i = F.tid; i < 1024; i += NWAVES * 64) { const int pos = i >> 4, fi = i & 15; const float inv = exp2f(-(float)fi * (13.287712379549449f / 16.f)); const float a = (float)pos * inv;
        cs[2 * i] = __cosf(a); cs[2 * i + 1] = __sinf(a); }
    __syncthreads();
    const int gw = F.vcu * NWAVES + F.wave, NGW = F.G * NWAVES, lane = F.lane;
    const int j = lane & 7, blk = (j >> 2) & 1, jj = j & 3, fi0 = 8 * (jj & 1); const bool second = (jj >> 1) != 0;
    float gq[8], gk[8];
#pragma unroll
    for (int e = 0; e < 8; ++e) { gq[e] = F.q_g[8 * j + e]; gk[e] = F.k_g[8 * j + e]; }
    bf16* AQ = (bf16*)(F.ws + WS_AQ); bf16* AK = (bf16*)(F.ws + WS_AK);
    for (int it = gw; it < T + T / 4; it += NGW) {
        const bool isq = it < T;
        const int tok = isq ? it : 4 * (it - T) + (lane >> 4);
        GAS v4u* p = isq ? (GAS v4u*)(AQ + (size_t)tok * 512) + lane : (GAS v4u*)(AK + (size_t)tok * 128) + (lane & 15);
        const v4u w = *p;
        float x[8] = {bflo(w.x), bfhi(w.x), bflo(w.y), bfhi(w.y), bflo(w.z), bfhi(w.z), bflo(w.w), bfhi(w.w)};
        float ss = 0.f;
#pragma unroll
        for (int e = 0; e < 8; ++e) ss += x[e] * x[e];
        ss += __shfl_xor(ss, 1); ss += __shfl_xor(ss, 2); ss += __shfl_xor(ss, 4);
        const float rinv = 1.f / sqrtf(ss * (1.f / 64.f) + EPS);
        const int ts = tok & (SEQ - 1), pos = blk ? (ts & 63) : (ts >> 6);
        const LAS float* c = cs + (pos * 16 + fi0) * 2;
        float y[8];
#pragma unroll
        for (int e = 0; e < 8; ++e) { x[e] = x[e] * rinv * (isq ? gq[e] : gk[e]); }
#pragma unroll
        for (int e = 0; e < 8; ++e) { const float pr = __shfl_xor(x[e], 2); const float co = c[2 * e], si = c[2 * e + 1]; y[e] = second ? (x[e] * co + pr * si) : (x[e] * co - pr * si); }
        const float sc = isq ? attn_body::C2 : 1.f;
        v4u o; o.x = pk2(y[0] * sc, y[1] * sc); o.y = pk2(y[2] * sc, y[3] * sc); o.z = pk2(y[4] * sc, y[5] * sc); o.w = pk2(y[6] * sc, y[7] * sc);
        if (dry) p = (GAS v4u*)((GAS unsigned char*)p + (WS_REGA + 140 * MiB - WS_AQ));
        *p = o;
    }
}
namespace gla {
typedef short bf16x8 __attribute__((ext_vector_type(8)));
typedef short s16x4 __attribute__((ext_vector_type(4)));
typedef float f32x4 __attribute__((ext_vector_type(4)));
constexpr int P64 = 144, PV = 272, POT = 528;
constexpr int L_QS = 0, L_KS = 9216, L_VR = 18432, L_AS = 35840, L_ST = 45056, L_DEC = 63488, L_OT = 63744, L_END = 97536;
__device__ __forceinline__ unsigned cvtpk(float lo, float hi) { typedef float f2_t __attribute__((ext_vector_type(2))); typedef __bf16 b2_t __attribute__((ext_vector_type(2))); f2_t v = {lo, hi}; b2_t b = __builtin_convertvector(v, b2_t); return __builtin_bit_cast(unsigned, b); }
__device__ __forceinline__ float logsig(float x) { return fminf(x, 0.f) - __logf(1.f + __expf(-fabsf(x))); }
__device__ __forceinline__ s16x4 vtr(const LAS unsigned char* p) { typedef short v4i16_t __attribute__((ext_vector_type(4))); return __builtin_bit_cast(s16x4, __builtin_amdgcn_ds_read_tr16_b64_v4i16((LAS v4i16_t*)p)); }

__device__ __forceinline__ void gla_prep_unit(Frame& F, int b, int c) {
    LAS unsigned char* L = F.lds;
    const int tid = F.tid, dir = __builtin_amdgcn_readfirstlane(tid >> 8), col = tid & 255;
    const bf16* GQ = (const bf16*)(F.ws + WS_GQ); const bf16* GK = (const bf16*)(F.ws + WS_GK); const bf16* ZZ = (const bf16*)(F.ws + WS_Z);
    bf16* QX = (bf16*)(F.ws + (dir ? WS_QB : WS_QF)); bf16* KX = (bf16*)(F.ws + (dir ? WS_KB : WS_KF)); float* DEC = (float*)(F.ws + WS_DEC) + (size_t)dir * (BATCH * 64 * 256);
    const unsigned row0 = (unsigned)b * SEQ + (unsigned)c * 64u;
    __syncthreads();
    if (tid < 256) { const int row = tid >> 2, seg = tid & 3; const v4u z = *(const GAS v4u*)(ZZ + (row0 + row) * 32 + seg * 8); LAS f32x4* zp = (LAS f32x4*)(L + row * 128 + seg * 32);
        zp[0] = (f32x4){bflo(z.x), bfhi(z.x), bflo(z.y), bfhi(z.y)}; zp[1] = (f32x4){bflo(z.z), bfhi(z.z), bflo(z.w), bfhi(z.w)}; }
    float wg[16]; const float* WG = dir ? F.w_gb : F.w_gf;
#pragma unroll
    for (int r = 0; r < 16; ++r) wg[r] = WG[r * 256 + col];
    const float bgv = (dir ? F.b_gb : F.b_gf)[col];
    __syncthreads();
    float pf[64]; float run = 0.f;
#pragma unroll
    for (int p = 0; p < 64; ++p) { const LAS f32x4* zp = (const LAS f32x4*)(L + p * 128 + dir * 64); float pre = bgv;
#pragma unroll
        for (int r4 = 0; r4 < 4; ++r4) { const f32x4 z = zp[r4]; pre += z.x * wg[4 * r4] + z.y * wg[4 * r4 + 1] + z.z * wg[4 * r4 + 2] + z.w * wg[4 * r4 + 3]; }
        run += logsig(pre) * (1.f / 16.f); pf[p] = run; }
    const float tot = run;
#pragma unroll
    for (int p = 0; p < 64; ++p) { const unsigned idx = (row0 + p) * 256 + col;
        const float qv = bf2f(GQ[idx]), kv = bf2f(GK[idx]);
        const float ex = dir ? (p ? pf[p - 1] : 0.f) : 0.f;
        const float eq = dir ? __expf(-ex) * 0.125f : __expf(pf[p] - tot) * 0.125f;
        const float ek = dir ? __expf(ex) : __expf(tot - pf[p]);
        QX[idx] = (bf16)f2bf(qv * eq); KX[idx] = (bf16)f2bf(kv * ek); }
    DEC[((unsigned)b * 64 + c) * 256 + col] = __expf(tot);
}

__device__ __forceinline__ void gla_unit(Frame& F, int b, int h, int dir) {
    LAS unsigned char* L = F.lds;
    const int tid = F.tid, lane = F.lane, w = F.wave, q4 = lane >> 4, l15 = lane & 15;
    const bf16* GV = (const bf16*)(F.ws + WS_GV);
    bf16* OX = (bf16*)(F.ws + WS_OF + (dir ? 32 * MiB : 0));
    const unsigned rowbase = (unsigned)b * SEQ;
    const int v0 = 16 * w;
    const int erow = tid >> 3, eseg = tid & 7;
    const int plq = tid >> 3, sgq = tid & 7, plv = tid >> 4, sgv = tid & 15;
    {
        const bf16* QX = (const bf16*)(F.ws + (dir ? WS_QB : WS_QF)); const bf16* KX = (const bf16*)(F.ws + (dir ? WS_KB : WS_KF));
        const float* DEC = (const float*)(F.ws + WS_DEC) + (size_t)dir * (BATCH * 64 * 256);
        f32x4 S[4];
#pragma unroll
        for (int i = 0; i < 4; ++i) S[i] = (f32x4){0.f, 0.f, 0.f, 0.f};
        v4u rq, rk, rv0, rv1; float rdec = 0.f;
#define GLA_LOAD(ci) do { const int c_ = dir ? 63 - (ci) : (ci); const unsigned cb_ = rowbase + (unsigned)c_ * 64u; \
            rq = *(const GAS v4u*)(QX + (cb_ + plq) * 256 + h * 64 + sgq * 8); rk = *(const GAS v4u*)(KX + (cb_ + plq) * 256 + h * 64 + sgq * 8); \
            rv0 = *(const GAS v4u*)(GV + (cb_ + plv) * 512 + h * 128 + sgv * 8); rv1 = *(const GAS v4u*)(GV + (cb_ + plv + 32) * 512 + h * 128 + sgv * 8); \
            if (tid < 64) rdec = DEC[((unsigned)b * 64 + c_) * 256 + h * 64 + tid]; } while (0)
        GLA_LOAD(0);
        v4u st0 = (v4u){0u, 0u, 0u, 0u}, st1 = st0;
#define GLA_FLUSH(cprev) do { const unsigned cbp_ = rowbase + (unsigned)(cprev) * 64u; GAS v4u* sp_ = (GAS v4u*)(OX + (cbp_ + erow) * 512 + h * 128 + eseg * 16); sp_[0] = st0; sp_[1] = st1; } while (0)
        for (int ci = 0; ci < 64; ++ci) {
            const int c = dir ? 63 - ci : ci;
            *(LAS v4u*)(L + L_QS + plq * P64 + sgq * 16) = rq; *(LAS v4u*)(L + L_KS + plq * P64 + sgq * 16) = rk;
            *(LAS v4u*)(L + L_VR + plv * PV + sgv * 16) = rv0; *(LAS v4u*)(L + L_VR + (plv + 32) * PV + sgv * 16) = rv1;
            if (tid < 64) ((LAS float*)(L + L_DEC))[tid] = rdec;
            asm volatile("" ::: "memory");
            if (ci > 0) GLA_FLUSH(dir ? c + 1 : c - 1);
            asm volatile("" ::: "memory");
            if (ci + 1 < 64) GLA_LOAD(ci + 1);
            __syncthreads();
#pragma unroll
            for (int s = 0; s < 2; ++s) { const int tt = 2 * w + s, it = tt >> 2, jt = tt & 3; f32x4 a = (f32x4){0.f, 0.f, 0.f, 0.f};
#pragma unroll
                for (int ks = 0; ks < 2; ++ks) { const bf16x8 af = *(const LAS bf16x8*)(L + L_QS + (16 * it + l15) * P64 + (32 * ks + 8 * q4) * 2); const bf16x8 bfr = *(const LAS bf16x8*)(L + L_KS + (16 * jt + l15) * P64 + (32 * ks + 8 * q4) * 2);
                    a = __builtin_amdgcn_mfma_f32_16x16x32_bf16(af, bfr, a, 0, 0, 0); }
#pragma unroll
                for (int rg = 0; rg < 4; ++rg) { const int i = 16 * it + 4 * q4 + rg, j = 16 * jt + l15; const bool keep = dir ? (j > i) : (j <= i);
                    *(LAS unsigned short*)(L + L_AS + i * P64 + j * 2) = (unsigned short)cvtpk(keep ? a[rg] : 0.f, 0.f); } }
#pragma unroll
            for (int dt = 0; dt < 4; ++dt) { const f32x4 dv = *(const LAS f32x4*)(L + L_DEC + (16 * dt + 4 * q4) * 4); S[dt] = S[dt] * dv;
                *(LAS v2u*)(L + L_ST + (v0 + l15) * P64 + (16 * dt + 4 * q4) * 2) = (v2u){cvtpk(S[dt].x, S[dt].y), cvtpk(S[dt].z, S[dt].w)}; }
            __syncthreads();
            bf16x8 bv[2], bs[2];
#pragma unroll
            for (int ks = 0; ks < 2; ++ks) { const LAS unsigned char* vp = L + L_VR + (32 * ks + 8 * q4 + (l15 >> 2)) * PV + (v0 + 4 * (l15 & 3)) * 2;
                const s16x4 lo = vtr(vp), hi = vtr(vp + 4 * PV); bv[ks] = (bf16x8){lo[0], lo[1], lo[2], lo[3], hi[0], hi[1], hi[2], hi[3]};
                bs[ks] = *(const LAS bf16x8*)(L + L_ST + (v0 + l15) * P64 + (32 * ks + 8 * q4) * 2); }
            f32x4 O[4];
#pragma unroll
            for (int it = 0; it < 4; ++it) { O[it] = (f32x4){0.f, 0.f, 0.f, 0.f};
#pragma unroll
                for (int ks = 0; ks < 2; ++ks) { const bf16x8 aa = *(const LAS bf16x8*)(L + L_AS + (16 * it + l15) * P64 + (32 * ks + 8 * q4) * 2); const bf16x8 aq = *(const LAS bf16x8*)(L + L_QS + (16 * it + l15) * P64 + (32 * ks + 8 * q4) * 2);
                    O[it] = __builtin_amdgcn_mfma_f32_16x16x32_bf16(aa, bv[ks], O[it], 0, 0, 0); O[it] = __builtin_amdgcn_mfma_f32_16x16x32_bf16(aq, bs[ks], O[it], 0, 0, 0); } }
#pragma unroll
            for (int dt = 0; dt < 4; ++dt)
#pragma unroll
                for (int ks = 0; ks < 2; ++ks) { const LAS unsigned char* kp = L + L_KS + (32 * ks + 8 * q4 + (l15 >> 2)) * P64 + (16 * dt + 4 * (l15 & 3)) * 2;
                    const s16x4 lo = vtr(kp), hi = vtr(kp + 4 * P64); const bf16x8 ak = (bf16x8){lo[0], lo[1], lo[2], lo[3], hi[0], hi[1], hi[2], hi[3]};
                    S[dt] = __builtin_amdgcn_mfma_f32_16x16x32_bf16(ak, bv[ks], S[dt], 0, 0, 0); }
#pragma unroll
            for (int it = 0; it < 4; ++it)
#pragma unroll
                for (int rg = 0; rg < 4; ++rg) *(LAS float*)(L + L_OT + (16 * it + 4 * q4 + rg) * POT + (v0 + l15) * 4) = O[it][rg];
            __syncthreads();
            {
                float o[16];
#pragma unroll
                for (int e4 = 0; e4 < 4; ++e4) { const f32x4 t = *(const LAS f32x4*)(L + L_OT + erow * POT + (16 * eseg + 4 * e4) * 4); o[4 * e4] = t.x; o[4 * e4 + 1] = t.y; o[4 * e4 + 2] = t.z; o[4 * e4 + 3] = t.w; }
                st0 = (v4u){cvtpk(o[0], o[1]), cvtpk(o[2], o[3]), cvtpk(o[4], o[5]), cvtpk(o[6], o[7])}; st1 = (v4u){cvtpk(o[8], o[9]), cvtpk(o[10], o[11]), cvtpk(o[12], o[13]), cvtpk(o[14], o[15])};
            }
        }
        GLA_FLUSH(dir ? 0 : 63);
#undef GLA_FLUSH
#undef GLA_LOAD
    }
    VM_WAIT(); __syncthreads();
    if (tid == 0) { __builtin_amdgcn_fence(__ATOMIC_RELEASE, "agent"); VM_WAIT(); (void)__hip_atomic_fetch_add(F.ctl + CW_GDN + 64 * (b * GLA_H + h), 1u, RLX_AGENT); }
    __syncthreads();
}
__device__ __forceinline__ void gla_combine(Frame& F, int b, int h, int part) {
    const int tid = F.tid, erow = tid >> 3, eseg = tid & 7;
    if (tid == 0) { unsigned sp = 0; while (__hip_atomic_load(F.ctl + CW_GDN + 64 * (b * GLA_H + h), RLX_AGENT) < 2u && sp < (1u << 22)) { __builtin_amdgcn_s_sleep(8); ++sp; }
        __builtin_amdgcn_fence(__ATOMIC_ACQUIRE, "agent"); VM_WAIT(); }
    __syncthreads();
    const bf16* OF0 = (const bf16*)(F.ws + WS_OF); const bf16* OB0 = (const bf16*)(F.ws + WS_OF + 32 * MiB); const bf16* GR = (const bf16*)(F.ws + WS_GR); bf16* MIX = (bf16*)(F.ws + WS_MIX);
    float hg[16];
#pragma unroll
    for (int e = 0; e < 16; ++e) hg[e] = F.gla_hg[16 * eseg + e];
    const unsigned r0 = (unsigned)b * SEQ + (unsigned)part * 1024u + erow;
#pragma unroll 2
    for (int ps = 0; ps < 16; ++ps) { const unsigned row = r0 + ps * 64;
        const GAS v4u* fp = (const GAS v4u*)(OF0 + row * 512 + h * 128 + eseg * 16); const GAS v4u* bp = (const GAS v4u*)(OB0 + row * 512 + h * 128 + eseg * 16); const GAS v4u* rp = (const GAS v4u*)(GR + row * 512 + h * 128 + eseg * 16);
        const v4u f0 = fp[0], f1 = fp[1], b0 = bp[0], b1 = bp[1], r0v = rp[0], r1v = rp[1];
        const unsigned fw[8] = {f0.x, f0.y, f0.z, f0.w, f1.x, f1.y, f1.z, f1.w}, bw[8] = {b0.x, b0.y, b0.z, b0.w, b1.x, b1.y, b1.z, b1.w}, rw[8] = {r0v.x, r0v.y, r0v.z, r0v.w, r1v.x, r1v.y, r1v.z, r1v.w};
        float o[16]; float ss = 0.f;
#pragma unroll
        for (int e2 = 0; e2 < 8; ++e2) { o[2 * e2] = bflo(fw[e2]) + bflo(bw[e2]); o[2 * e2 + 1] = bfhi(fw[e2]) + bfhi(bw[e2]); ss += o[2 * e2] * o[2 * e2] + o[2 * e2 + 1] * o[2 * e2 + 1]; }
        ss += __shfl_xor(ss, 1); ss += __shfl_xor(ss, 2); ss += __shfl_xor(ss, 4);
        const float rinv = __builtin_amdgcn_rsqf(ss * (1.f / 128.f) + EPS);
        unsigned ow[8];
#pragma unroll
        for (int e2 = 0; e2 < 8; ++e2) { const float x0 = bflo(rw[e2]), x1 = bfhi(rw[e2]);
            const float y0 = o[2 * e2] * rinv * hg[2 * e2] * (x0 * __builtin_amdgcn_rcpf(1.f + __expf(-x0))), y1 = o[2 * e2 + 1] * rinv * hg[2 * e2 + 1] * (x1 * __builtin_amdgcn_rcpf(1.f + __expf(-x1))); ow[e2] = cvtpk(y0, y1); }
        GAS v4u* mp = (GAS v4u*)(MIX + row * 1024 + h * 128 + eseg * 16);
        mp[0] = (v4u){ow[0], ow[1], ow[2], ow[3]}; mp[1] = (v4u){ow[4], ow[5], ow[6], ow[7]}; }
}
}
struct DenseMap { static constexpr bool GATHER = false;
    const bf16* A; const bf16* Bt; int K;
    __device__ __forceinline__ __amdgpu_buffer_rsrc_t a_rsrc() const { return __builtin_amdgcn_make_buffer_rsrc((void*)A, 0, 0x7fffffff, 0x00020000); }
    __device__ __forceinline__ __amdgpu_buffer_rsrc_t b_rsrc() const { return __builtin_amdgcn_make_buffer_rsrc((void*)Bt, 0, 0x7fffffff, 0x00020000); }
    __device__ __forceinline__ unsigned a_soff(const pg8::Unit& u) const { return (unsigned)u.pm * 256u * (unsigned)K * 2u; }
    __device__ __forceinline__ unsigned b_soff(const pg8::Unit& u) const { return (unsigned)u.pn * 256u * (unsigned)K * 2u; }
    __device__ __forceinline__ void a_off(const pg8::Unit&, const int (&R)[2], const int (&C)[2], unsigned (&vo)[2][2]) const {
#pragma unroll
        for (int h = 0; h < 2; ++h)
#pragma unroll
            for (int i = 0; i < 2; ++i) vo[h][i] = (unsigned)((h * 128 + R[i]) * K + C[i]) * 2u; }
};
struct MoeTabs { const LAS int* cnt; const LAS int* cst; const LAS unsigned short* te; };
struct MoeMapUp { static constexpr bool GATHER = true;
    const unsigned char* A; const unsigned char* Bt; const int* rowtok; MoeTabs tb;
    __device__ __forceinline__ __amdgpu_buffer_rsrc_t a_rsrc() const { return __builtin_amdgcn_make_buffer_rsrc((void*)A, 0, 0x7fffffff, 0x00020000); }
    __device__ __forceinline__ __amdgpu_buffer_rsrc_t b_rsrc() const { return __builtin_amdgcn_make_buffer_rsrc((void*)Bt, 0, 0x7fffffff, 0x00020000); }
    __device__ __forceinline__ unsigned a_soff(const pg8::Unit&) const { return 0u; }
    __device__ __forceinline__ unsigned b_soff(const pg8::Unit& u) const { const unsigned e = tb.te[u.pm]; return (e * 2048u + (unsigned)u.pn * 256u) * 1024u; }
    __device__ __forceinline__ void a_raw(const pg8::Unit& u, const int (&R)[2], unsigned (&raw)[2][2]) const {
        const int e = tb.te[u.pm], pos0 = (u.pm - tb.cst[e]) * 256, n = tb.cnt[e];
#pragma unroll
        for (int h = 0; h < 2; ++h)
#pragma unroll
            for (int i = 0; i < 2; ++i) { const int pos = pos0 + h * 128 + R[i]; raw[h][i] = (unsigned)rowtok[(size_t)e * EROWS + (pos < n ? pos : 0)]; } }
    __device__ __forceinline__ unsigned a_fin(unsigned tok, int C) const { return (tok * 512u + (unsigned)C) * 2u; }
    __device__ __forceinline__ void a_off(const pg8::Unit& u, const int (&R)[2], const int (&C)[2], unsigned (&vo)[2][2]) const {
        unsigned raw[2][2]; a_raw(u, R, raw);
#pragma unroll
        for (int h = 0; h < 2; ++h)
#pragma unroll
            for (int i = 0; i < 2; ++i) vo[h][i] = a_fin(raw[h][i], C[i]); }
};
struct MoeMapDown { static constexpr bool GATHER = false;
    const unsigned char* A; const unsigned char* Bt; MoeTabs tb;
    __device__ __forceinline__ __amdgpu_buffer_rsrc_t a_rsrc() const { return __builtin_amdgcn_make_buffer_rsrc((void*)A, 0, 0x7fffffff, 0x00020000); }
    __device__ __forceinline__ __amdgpu_buffer_rsrc_t b_rsrc() const { return __builtin_amdgcn_make_buffer_rsrc((void*)Bt, 0, 0x7fffffff, 0x00020000); }
    __device__ __forceinline__ unsigned a_soff(const pg8::Unit& u) const { return (unsigned)u.pm * 256u * 1024u; }
    __device__ __forceinline__ unsigned b_soff(const pg8::Unit& u) const { const unsigned e = tb.te[u.pm]; return (e * 1024u + (unsigned)u.pn * 256u) * 1024u; }
    __device__ __forceinline__ void a_off(const pg8::Unit&, const int (&R)[2], const int (&C)[2], unsigned (&vo)[2][2]) const {
#pragma unroll
        for (int h = 0; h < 2; ++h)
#pragma unroll
            for (int i = 0; i < 2; ++i) vo[h][i] = (unsigned)((h * 128 + R[i]) * 512 + C[i]) * 2u; }
};
using pg8::f32x4;
struct EpiInProj { static constexpr bool PERM = true;
    bf16 *gq, *gk, *gv, *gr, *aq, *ak, *av, *z;
    struct Pre {}; __device__ __forceinline__ void preload(const pg8::Unit&, int, int, int, int, Pre&) const {}
    __device__ __forceinline__ void operator()(const f32x4 (&acc)[2][2][4][2], const pg8::Unit& u, const Pre&, int wr, int wc, int fr, int fq) const {
        bf16* b0; bf16* b1; int ld;
        switch (u.pn) { case 0: b0 = gq; b1 = gq + 128; ld = 256; break; case 1: b0 = gk; b1 = gk + 128; ld = 256; break;
            case 2: b0 = gv; b1 = gv + 128; ld = 512; break; case 3: b0 = gv + 256; b1 = gv + 384; ld = 512; break;
            case 4: b0 = gr; b1 = gr + 128; ld = 512; break; case 5: b0 = gr + 256; b1 = gr + 384; ld = 512; break;
            case 6: b0 = aq; b1 = aq + 128; ld = 512; break; case 7: b0 = aq + 256; b1 = aq + 384; ld = 512; break;
            case 8: b0 = ak; b1 = av; ld = 128; break; default: b0 = z; b1 = z; ld = 32; break; }
        const bool zt = (u.pn == 9);
        if (zt && wc != 0) return;
        const int row0 = u.pm * 256 + wr * 64 + fr, cw = wc * 32 + 8 * fq;
#pragma unroll
        for (int ai = 0; ai < 2; ++ai)
#pragma unroll
            for (int m = 0; m < 4; ++m) { const size_t row = (size_t)(row0 + ai * 128 + m * 16);
#pragma unroll
                for (int bj = 0; bj < 2; ++bj) { if (zt && bj == 1) continue; const f32x4 v0 = acc[ai][bj][m][0], v1 = acc[ai][bj][m][1];
                    pg8::u32x4 wv; wv.x = pg8::cvt_pk_bf16(v0[0], v0[1]); wv.y = pg8::cvt_pk_bf16(v0[2], v0[3]); wv.z = pg8::cvt_pk_bf16(v1[0], v1[1]); wv.w = pg8::cvt_pk_bf16(v1[2], v1[3]);
                    *(pg8::u32x4*)((bj ? b1 : b0) + row * ld + cw) = wv; } }
    }
};
struct EpiResF32 { static constexpr bool PERM = false;
    const float* base; float* out;
    struct Pre {}; __device__ __forceinline__ void preload(const pg8::Unit&, int, int, int, int, Pre&) const {}
    __device__ __forceinline__ void operator()(const f32x4 (&acc)[2][2][4][2], const pg8::Unit& u, const Pre&, int wr, int wc, int fr, int fq) const {
        const int col0 = u.pn * 256 + wc * 32 + 4 * fq;
#pragma unroll
        for (int ai = 0; ai < 2; ++ai)
#pragma unroll
            for (int m = 0; m < 4; ++m) { const size_t off = (size_t)(u.pm * 256 + ai * 128 + wr * 64 + m * 16 + fr) * 1024 + col0;
#pragma unroll
                for (int bj = 0; bj < 2; ++bj)
#pragma unroll
                    for (int n = 0; n < 2; ++n) { const f32x4 bs = *(const f32x4*)(base + off + bj * 128 + n * 16); *(f32x4*)(out + off + bj * 128 + n * 16) = bs + acc[ai][bj][m][n]; } }
    }
};
struct EpiSwiglu { static constexpr bool PERM = true;
    const float* b1; unsigned char* act; MoeTabs tb;
    struct Pre { f32x4 g0, g1, l0, l1; };
    __device__ __forceinline__ void preload(const pg8::Unit& u, int wr, int wc, int fr, int fq, Pre& p) const {
        const int e = tb.te[u.pm]; const int col = u.pn * 128 + wc * 32 + 8 * fq; const float* bg = b1 + (size_t)e * 2048 + col; const float* bl = bg + 1024;
        p.g0 = *(const GAS f32x4*)bg; p.g1 = *(const GAS f32x4*)(bg + 4); p.l0 = *(const GAS f32x4*)bl; p.l1 = *(const GAS f32x4*)(bl + 4); }
    __device__ __forceinline__ void operator()(const f32x4 (&acc)[2][2][4][2], const pg8::Unit& u, const Pre& p, int wr, int wc, int fr, int fq) const {
        const int col = u.pn * 128 + wc * 32 + 8 * fq;
        const f32x4 g0 = p.g0, g1 = p.g1, l0 = p.l0, l1 = p.l1;
        const int row0 = u.pm * 256 + wr * 64 + fr;
#pragma unroll
        for (int ai = 0; ai < 2; ++ai)
#pragma unroll
            for (int m = 0; m < 4; ++m) { float o[8];
#pragma unroll
                for (int n = 0; n < 2; ++n)
#pragma unroll
                    for (int j = 0; j < 4; ++j) { const float gl = fminf(__builtin_fmaf(acc[ai][0][m][n][j], 1.f / WSCALE, (n ? g1[j] : g0[j])), 7.f); const float li = __builtin_amdgcn_fmed3f(__builtin_fmaf(acc[ai][1][m][n][j], 1.f / WSCALE, (n ? l1[j] : l0[j])), -7.f, 7.f);
                        o[4 * n + j] = (gl * ASCALE) * __builtin_amdgcn_rcpf(1.f + __builtin_amdgcn_exp2f(gl * (-1.702f * 1.4426950408889634f))) * (li + 1.f); }
                int w0 = 0, w1 = 0;
                w0 = __builtin_amdgcn_cvt_pk_fp8_f32(o[0], o[1], w0, false); w0 = __builtin_amdgcn_cvt_pk_fp8_f32(o[2], o[3], w0, true); w1 = __builtin_amdgcn_cvt_pk_fp8_f32(o[4], o[5], w1, false); w1 = __builtin_amdgcn_cvt_pk_fp8_f32(o[6], o[7], w1, true);
                *(v2u*)(act + (size_t)(row0 + ai * 128 + m * 16) * 1024 + col) = (v2u){(unsigned)w0, (unsigned)w1}; }
    }
};
struct EpiDown { static constexpr bool PERM = true;
    const float* b2; const float* rowgate; unsigned char* y; MoeTabs tb;
    struct Pre { f32x4 bv[2][2]; float gt[8]; };
    __device__ __forceinline__ void preload(const pg8::Unit& u, int wr, int wc, int fr, int fq, Pre& p) const {
        const int e = tb.te[u.pm], pos0 = (u.pm - tb.cst[e]) * 256, n_e = tb.cnt[e];
        const float* bb = b2 + (size_t)e * 1024 + u.pn * 256 + wc * 32 + 8 * fq;
#pragma unroll
        for (int bj = 0; bj < 2; ++bj)
#pragma unroll
            for (int n = 0; n < 2; ++n) p.bv[bj][n] = *(const GAS f32x4*)(bb + bj * 128 + 4 * n);
#pragma unroll
        for (int ai = 0; ai < 2; ++ai)
#pragma unroll
            for (int m = 0; m < 4; ++m) { const int pos = pos0 + wr * 64 + fr + ai * 128 + m * 16; const int pc_ = pos < n_e ? pos : 0; const float g = rowgate[(size_t)e * EROWS + pc_]; p.gt[ai * 4 + m] = (pos < n_e) ? g * YSCALE : 0.f; }
    }
    __device__ __forceinline__ void operator()(const f32x4 (&acc)[2][2][4][2], const pg8::Unit& u, const Pre& p, int wr, int wc, int fr, int fq) const {
        const int colw = wc * 32 + 8 * fq, rl0 = wr * 64 + fr;
#pragma unroll
        for (int ai = 0; ai < 2; ++ai)
#pragma unroll
            for (int m = 0; m < 4; ++m) { const int rl = rl0 + ai * 128 + m * 16; const float gt = p.gt[ai * 4 + m];
                unsigned char* rowp = y + (size_t)(u.pm * 256 + rl) * 1024 + u.pn * 256 + colw;
#pragma unroll
                for (int bj = 0; bj < 2; ++bj) { const f32x4 v0 = (acc[ai][bj][m][0] * (1.f / (WSCALE * ASCALE)) + p.bv[bj][0]) * gt, v1 = (acc[ai][bj][m][1] * (1.f / (WSCALE * ASCALE)) + p.bv[bj][1]) * gt;
                    int w0 = 0, w1 = 0;
                    w0 = __builtin_amdgcn_cvt_pk_fp8_f32(v0[0], v0[1], w0, false); w0 = __builtin_amdgcn_cvt_pk_fp8_f32(v0[2], v0[3], w0, true); w1 = __builtin_amdgcn_cvt_pk_fp8_f32(v1[0], v1[1], w1, false); w1 = __builtin_amdgcn_cvt_pk_fp8_f32(v1[2], v1[3], w1, true);
                    *(v2u*)(rowp + bj * 128) = (v2u){(unsigned)w0, (unsigned)w1}; } }
    }
};
__device__ __forceinline__ int moe_tables(Frame& F) {
    LAS int* cnt = (LAS int*)(F.lds + LC_CNT); LAS int* cst = (LAS int*)(F.lds + LC_CST); LAS unsigned short* te = (LAS unsigned short*)(F.lds + LC_TE);
    __syncthreads();
    if (F.tid < NEXP) cnt[F.tid] = (int)__hip_atomic_load(F.ctl + CW_CNT + 64 * F.tid, RLX_AGENT);
    __syncthreads();
    if (F.tid == 0) { int s = 0; for (int e = 0; e < NEXP; ++e) { cst[e] = s; s += (cnt[e] + 255) >> 8; } cst[NEXP] = s; }
    __syncthreads();
    const int nt = cst[NEXP];
    for (int t = F.tid; t < nt; t += NWAVES * 64) { int e = 0;
#pragma unroll 1
        for (int k = 1; k < NEXP; ++k) e = (t >= cst[k]) ? k : e;
        te[t] = (unsigned short)e; }
    __syncthreads();
    return nt;
}
__device__ __forceinline__ void p3_mixers(Frame& F) {
    for (int u = blockIdx.x; u < 2 * BATCH * GLA_H; u += F.G) gla::gla_unit(F, u & 7, (u >> 3) & 3, u >> 5);
    const attn_body::bf16* Q = (const attn_body::bf16*)(F.ws + WS_AQ); const attn_body::bf16* K = (const attn_body::bf16*)(F.ws + WS_AK); const attn_body::bf16* V = (const attn_body::bf16*)(F.ws + WS_AV);
    attn_body::bf16* O = (attn_body::bf16*)(F.ws + WS_MIX);
    const int x0 = blockIdx.x & 7;
    for (int rep = 0; rep < REP3A; ++rep)
    for (int qi = 0; qi < 8; ++qi) { const int x = (x0 + qi) & 7;
        for (;;) {
            __syncthreads();
            if (F.tid == 0) F.MISC[16] = __hip_atomic_fetch_add(F.ctl + CW_QUE + 64 * (x + 8 * rep), 1u, RLX_AGENT);
            __syncthreads();
            const int item = __builtin_amdgcn_readfirstlane((int)F.MISC[16]);
            if (item >= ATT_H * attn_body::NQB + 4 * GLA_H) break;
            if (item >= ATT_H * attn_body::NQB) { const int k = item - ATT_H * attn_body::NQB; gla::gla_combine(F, x, k >> 2, k & 3); continue; }
            attn_body::attn_unit<8>(x, item >> 4, item & 15, Q, K, V, O, (char*)F.lds);
        }
    }
}

__device__ __forceinline__ void p5_route(Frame& F, const bool dry = false) {
    typedef float f32x16 __attribute__((ext_vector_type(16)));
    LAS unsigned char* L = F.lds;
    constexpr int XP = 2064, L_XH = 0, L_XL = 32 * XP, L_PART = 0;
    const int tid = F.tid, lane = F.lane, w = F.wave, r32 = lane & 31, hi = lane >> 5;
    const bf16* WRH = (const bf16*)(F.ws + WS_WRH); const bf16* WRL = (const bf16*)(F.ws + WS_WRL);
    unsigned char* XN8 = F.ws + WS_XN;
    const size_t dd = dry ? (size_t)WS_REGA + 140 * MiB - WS_ROWTOK : 0;
    int* ROWTOK = (int*)(F.ws + WS_ROWTOK + dd); float* ROWGATE = (float*)(F.ws + WS_ROWGATE + dd); int* TOKASG = (int*)(F.ws + WS_TOKASG + dd);
    gu32* CNT = F.ctl + (dry ? CW_CNT + 4096 : CW_CNT);
    bf16x8 wh[8], wl[8];
#pragma unroll
    for (int ks = 0; ks < 8; ++ks) { const int k0 = 128 * w + 16 * ks + 8 * hi; wh[ks] = *(const GAS bf16x8*)(WRH + r32 * 1024 + k0); wl[ks] = *(const GAS bf16x8*)(WRL + r32 * 1024 + k0); }
    f32x4 g2[4];
#pragma unroll
    for (int j = 0; j < 4; ++j) g2[j] = *((const GAS f32x4*)F.ffn_g + lane + 64 * j);
    float brt[16];
#pragma unroll
    for (int r = 0; r < 16; ++r) brt[r] = F.b_router[(r & 3) + 8 * (r >> 2) + 4 * hi];
    LAS int* hist = (LAS int*)(L + LC_HIST); LAS int* basev = (LAS int*)(L + LC_BASE); LAS int* aep = (LAS int*)(L + LC_ASG); LAS float* agt = (LAS float*)(L + LC_ASG + 4096);
    constexpr int NGRP = T / 32;
    const int per = (NGRP + F.G - 1) / F.G, g0 = F.vcu * per, g1 = (g0 + per < NGRP) ? g0 + per : NGRP;
    for (int gb = g0; gb < g1; gb += 8) {
        const int nb = (g1 - gb < 8) ? g1 - gb : 8;
        __syncthreads();
        if (tid < NEXP) hist[tid] = 0;
        for (int bi = 0; bi < nb; ++bi) {
            const int t0 = 32 * (gb + bi);
#pragma unroll 1
            for (int rr = 0; rr < 4; ++rr) { const int r = 4 * w + rr; const size_t tok = (size_t)(t0 + r);
                const GAS f32x4* hp = (const GAS f32x4*)(F.out + tok * 1024) + lane; f32x4 v[4]; float s = 0.f;
#pragma unroll
                for (int j = 0; j < 4; ++j) { v[j] = hp[64 * j]; s += (v[j].x * v[j].x + v[j].y * v[j].y) + (v[j].z * v[j].z + v[j].w * v[j].w); }
                const float rinv = 1.f / sqrtf(wave_sum(s) * (1.f / 1024.f) + EPS);
                GAS unsigned* o4 = (GAS unsigned*)(XN8 + tok * 1024) + lane;
#pragma unroll
                for (int j = 0; j < 4; ++j) { const f32x4 xn = v[j] * rinv * g2[j];
                    const unsigned h0 = f2bf(xn.x), h1 = f2bf(xn.y), h2 = f2bf(xn.z), h3 = f2bf(xn.w);
                    const unsigned l0 = f2bf(xn.x - bf2f(h0)), l1 = f2bf(xn.y - bf2f(h1)), l2 = f2bf(xn.z - bf2f(h2)), l3 = f2bf(xn.w - bf2f(h3));
                    const v2u hw = (v2u){h0 | (h1 << 16), h2 | (h3 << 16)}, lw = (v2u){l0 | (l1 << 16), l2 | (l3 << 16)};
                    { int q8 = 0; q8 = __builtin_amdgcn_cvt_pk_fp8_f32(xn.x, xn.y, q8, false); q8 = __builtin_amdgcn_cvt_pk_fp8_f32(xn.z, xn.w, q8, true); o4[64 * j] = (unsigned)q8; }
                    *(LAS v2u*)(L + L_XH + r * XP + (4 * lane + 256 * j) * 2) = hw; *(LAS v2u*)(L + L_XL + r * XP + (4 * lane + 256 * j) * 2) = lw; } }
            __syncthreads();
            f32x16 acc = {};
#pragma unroll
            for (int ks = 0; ks < 8; ++ks) { const int k0 = 128 * w + 16 * ks + 8 * hi;
                const bf16x8 xh = *(const LAS bf16x8*)(L + L_XH + r32 * XP + k0 * 2), xl = *(const LAS bf16x8*)(L + L_XL + r32 * XP + k0 * 2);
                acc = __builtin_amdgcn_mfma_f32_32x32x16_bf16(wh[ks], xh, acc, 0, 0, 0); acc = __builtin_amdgcn_mfma_f32_32x32x16_bf16(wh[ks], xl, acc, 0, 0, 0); acc = __builtin_amdgcn_mfma_f32_32x32x16_bf16(wl[ks], xh, acc, 0, 0, 0); }
            __syncthreads();
#pragma unroll
            for (int r = 0; r < 16; ++r) { const int e = (r & 3) + 8 * (r >> 2) + 4 * hi; ((LAS float*)(L + L_PART))[(w * 32 + e) * 32 + r32] = acc[r]; }
            __syncthreads();
            if (w == 0) {
                float v[16];
#pragma unroll
                for (int r = 0; r < 16; ++r) { const int e = (r & 3) + 8 * (r >> 2) + 4 * hi; float s = brt[r];
#pragma unroll
                    for (int ww = 0; ww < 8; ++ww) s += ((const LAS float*)(L + L_PART))[(ww * 32 + e) * 32 + r32];
                    v[r] = s; }
                float cv[8]; int cidx[8];
#pragma unroll
                for (int s = 0; s < 4; ++s) { float m = -INFINITY; int mr = 0;
#pragma unroll
                    for (int r = 0; r < 16; ++r) { if (v[r] > m) { m = v[r]; mr = r; } }
                    cv[s] = m; cidx[s] = (mr & 3) + 8 * (mr >> 2) + 4 * hi;
#pragma unroll
                    for (int r = 0; r < 16; ++r) v[r] = (r == mr) ? -INFINITY : v[r]; }
#pragma unroll
                for (int s = 0; s < 4; ++s) { cv[4 + s] = __shfl_xor(cv[s], 32); cidx[4 + s] = __shfl_xor(cidx[s], 32); }
                float tv[4]; int ti[4];
#pragma unroll
                for (int s = 0; s < 4; ++s) { float m = -INFINITY; int mi = 1 << 20; int mc = 0;
#pragma unroll
                    for (int c = 0; c < 8; ++c) { const bool better = (cv[c] > m) || (cv[c] == m && cidx[c] < mi); if (better) { m = cv[c]; mi = cidx[c]; mc = c; } }
                    tv[s] = m; ti[s] = mi;
#pragma unroll
                    for (int c = 0; c < 8; ++c) cv[c] = (c == mc) ? -INFINITY : cv[c]; }
                const float e1 = __expf(tv[1] - tv[0]), e2 = __expf(tv[2] - tv[0]), e3 = __expf(tv[3] - tv[0]); const float inv = 1.f / (1.f + e1 + e2 + e3);
                const float gt[4] = {inv, e1 * inv, e2 * inv, e3 * inv};
                if (hi == 0) {
#pragma unroll
                    for (int s = 0; s < 4; ++s) { const int rank = (int)__hip_atomic_fetch_add(hist + ti[s], 1, __ATOMIC_RELAXED, __HIP_MEMORY_SCOPE_WORKGROUP); const int idx = (bi * 32 + r32) * 4 + s; aep[idx] = (ti[s] << 16) | rank; agt[idx] = gt[s]; } }
            }
            __syncthreads();
        }
        if (tid < NEXP) { const int hc = hist[tid]; basev[tid] = hc ? (int)__hip_atomic_fetch_add(CNT + 64 * tid, (unsigned)hc, RLX_AGENT) : 0; }
        __syncthreads();
        for (int idx = tid; idx < nb * 128; idx += NWAVES * 64) { const int ep = aep[idx], e = ep >> 16, pos = basev[e] + (ep & 0xffff); const int tok = 32 * gb + (idx >> 2), s = idx & 3;
            ROWTOK[(size_t)e * EROWS + pos] = tok; ROWGATE[(size_t)e * EROWS + pos] = agt[idx]; TOKASG[tok * 4 + s] = e * EROWS + pos; }
    }
    __syncthreads();
}

__device__ __forceinline__ void p8_combine(Frame& F, const bool dry = false) {
    const LAS int* cst = (const LAS int*)(F.lds + LC_CST);
    const int gw = F.vcu * NWAVES + F.wave, NGW = F.G * NWAVES, lane = F.lane;
    const int* TOKASG = (const int*)(F.ws + WS_TOKASG); const unsigned char* Y = F.ws + WS_Y;
    f32x4 fg[4];
#pragma unroll
    for (int j = 0; j < 4; ++j) fg[j] = *((const GAS f32x4*)F.fin_g + lane + 64 * j);
    for (int tok = gw; tok < T; tok += NGW) {
        const int a = TOKASG[tok * 4 + (lane & 3)];
        const int crow = cst[a >> 15] * 256 + (a & (EROWS - 1));
        GAS f32x4* hp = (GAS f32x4*)(F.out + (size_t)tok * 1024) + lane; f32x4 v[4];
#pragma unroll
        for (int j = 0; j < 4; ++j) v[j] = hp[64 * j];
#pragma unroll
        for (int s = 0; s < 4; ++s) { const int cr = __shfl(crow, s); const GAS unsigned* yp = (const GAS unsigned*)(Y + (size_t)cr * 1024) + lane;
#pragma unroll
            for (int j = 0; j < 4; ++j) { const unsigned yw = yp[64 * j]; const auto lo = __builtin_amdgcn_cvt_pk_f32_fp8((int)yw, false), hi = __builtin_amdgcn_cvt_pk_f32_fp8((int)yw, true);
                v[j].x += lo[0] * (1.f / YSCALE); v[j].y += lo[1] * (1.f / YSCALE); v[j].z += hi[0] * (1.f / YSCALE); v[j].w += hi[1] * (1.f / YSCALE); } }
        float ss = 0.f;
#pragma unroll
        for (int j = 0; j < 4; ++j) ss += (v[j].x * v[j].x + v[j].y * v[j].y) + (v[j].z * v[j].z + v[j].w * v[j].w);
        const float rinv = 1.f / sqrtf(wave_sum(ss) * (1.f / 1024.f) + EPS);
        GAS f32x4* op = dry ? (GAS f32x4*)(F.ws + WS_REGA + 140 * MiB + (size_t)tok * 4096) + lane : hp;
#pragma unroll
        for (int j = 0; j < 4; ++j) op[64 * j] = v[j] * rinv * fg[j];
    }
}
#ifndef MK_N_LAUNCHES
#define MK_N_LAUNCHES 1
#endif
constexpr int N_PHASES = 9;
constexpr int N_LAUNCHES = MK_N_LAUNCHES;
struct Args { const float* in[19]; float* out; unsigned char* ws; int ph_lo, ph_hi; };
__global__ void __launch_bounds__(NWAVES * 64, 2) enc_fwd(Args args) {
    extern __shared__ __attribute__((aligned(16))) unsigned char lds[];
    Frame F;
    F.lds = (LAS unsigned char*)lds;
    F.MISC = (volatile LAS unsigned*)(F.lds + LC_MISC);
    F.tid = threadIdx.x; F.lane = F.tid & 63; F.wave = __builtin_amdgcn_readfirstlane(F.tid >> 6);
    F.G = gridDim.x; { const int bx = blockIdx.x; F.vcu = (F.G % 8 == 0) ? (bx % 8) * (F.G / 8) + bx / 8 : bx; }
    F.ws = args.ws; F.ctl = (gu32*)(args.ws + WS_CTL);
    F.x = args.in[0]; F.mix_g = args.in[1]; F.w_in = args.in[2]; F.w_gf = args.in[3]; F.b_gf = args.in[4]; F.w_gb = args.in[5]; F.b_gb = args.in[6]; F.gla_hg = args.in[7];
    F.q_g = args.in[8]; F.k_g = args.in[9]; F.w_out = args.in[10]; F.ffn_g = args.in[11]; F.w_router = args.in[12]; F.b_router = args.in[13];
    F.w1 = args.in[14]; F.b1 = args.in[15]; F.w2 = args.in[16]; F.b2 = args.in[17]; F.fin_g = args.in[18]; F.out = args.out;
    for (int u = F.tid; u < (LDS_BYTES - LC_OFF) / 4; u += NWAVES * 64) ((LAS unsigned*)(F.lds + LC_OFF))[u] = 0u;
    __syncthreads();
    XcdBarrier bar; bar.bar = (unsigned*)(F.ctl + CW_BAR); bar.x = 0; bar.st = nullptr;
    if (N_LAUNCHES == 1) bar = xcd_barrier_post((unsigned*)(F.ctl + CW_BAR), F.MISC + 8);
    const int lo = args.ph_lo, hi = args.ph_hi;
#ifndef PH_MASK
#define PH_MASK 0x1ff
#endif
#define IN(k) (((PH_MASK >> (k)) & 1) && lo <= (k) && (k) < hi)
#ifdef FLATBAR
#define GBAR() flat_barrier((unsigned*)(F.ctl + CW_BAR), F.MISC + 12)
#elif defined(XB2)
#define GBAR() xcd_barrier2(bar)
#else
#define GBAR() xcd_barrier(bar)
#endif
#define SEAM(k) do { if (IN(k) && IN((k) + 1)) GBAR(); } while (0)
    MoeTabs tb{(const LAS int*)(F.lds + LC_CNT), (const LAS int*)(F.lds + LC_CST), (const LAS unsigned short*)(F.lds + LC_TE)};

    if (IN(0)) { for (int rep = 0; rep < REP0; ++rep) p0_prologue(F); } SEAM(0);
    if (IN(1)) {
        DenseMap mp{(const bf16*)(F.ws + WS_XN), (const bf16*)(F.ws + WS_WIN), 1024};
        pg8::StaticOrder S; S.init(T / 256, D_IN_PAD / 256, F.G, (int)blockIdx.x);
        EpiInProj E{(bf16*)(F.ws + WS_GQ), (bf16*)(F.ws + WS_GK), (bf16*)(F.ws + WS_GV), (bf16*)(F.ws + WS_GR), (bf16*)(F.ws + WS_AQ), (bf16*)(F.ws + WS_AK), (bf16*)(F.ws + WS_AV), (bf16*)(F.ws + WS_Z)};
        for (int rep = 0; rep < REP1; ++rep) pg8::gemm_phase<EpiInProj, pg8::StaticOrder, DenseMap, true>(F.lds, 1024, S, mp, E);
    } SEAM(1);
#ifdef ATOMPROBE
    if (blockIdx.x == 0 && F.tid == 0) { unsigned v = 1u; for (int i = 0; i < ATOMPROBE; ++i) v = 1u + (1u & __hip_atomic_fetch_add(F.ctl + 24576 + 64 * (i & 7), v, RLX_AGENT)); if (v == 77u) F.MISC[20] = v; }
#endif
#ifdef LOADPROBE
    if (blockIdx.x == 0 && F.tid == 0) { unsigned v = 0u; for (int i = 0; i < LOADPROBE; ++i) v = (1u & __hip_atomic_load(F.ctl + 24576 + 64 * ((i + v) & 7), RLX_AGENT)); if (v == 77u) F.MISC[20] = v; }
#endif
#ifdef XBAR
    for (int xb = 0; xb < XBAR; ++xb) xcd_barrier_probe(bar);
#endif
    if (IN(2)) { for (int rep = 1; rep < REP2; ++rep) { p2_normrope(F, true); for (int u = F.vcu; u < BATCH * 64; u += F.G) gla::gla_prep_unit(F, u >> 6, u & 63); }
        p2_normrope(F); for (int u = F.vcu; u < BATCH * 64; u += F.G) gla::gla_prep_unit(F, u >> 6, u & 63); } SEAM(2);
    if (IN(3)) { p3_mixers(F); } SEAM(3);
    if (IN(4)) {
        DenseMap mp{(const bf16*)(F.ws + WS_MIX), (const bf16*)(F.ws + WS_WOUT), 1024};
        pg8::StaticOrder S; S.init(T / 256, DM / 256, F.G, (int)blockIdx.x);
        EpiResF32 E{F.x, F.out};
        for (int rep = 0; rep < REP4; ++rep) pg8::gemm_phase<EpiResF32, pg8::StaticOrder, DenseMap, true>(F.lds, 1024, S, mp, E);
    } SEAM(4);
    if (IN(5)) { for (int rep = 1; rep < REP5; ++rep) p5_route(F, true); p5_route(F); } SEAM(5);
    if (IN(6)) {
        const int ntl = moe_tables(F);
        MoeMapUp mp{F.ws + WS_XN, F.ws + WS_W1, (const int*)(F.ws + WS_ROWTOK), tb};
        pg8::StaticOrder S; S.init(ntl, 8, F.G, (int)blockIdx.x);
        EpiSwiglu E{F.b1, F.ws + WS_ACT, tb};
        for (int rep = 0; rep < REP6; ++rep) pg8::gemm_phase<EpiSwiglu, pg8::StaticOrder, MoeMapUp, true, true>(F.lds, 512, S, mp, E);
    } SEAM(6);
    if (IN(7)) {
        const int ntl = moe_tables(F);
        MoeMapDown mp{F.ws + WS_ACT, F.ws + WS_W2, tb};
        pg8::StaticOrder S; S.init(ntl, 4, F.G, (int)blockIdx.x);
        EpiDown E{F.b2, (const float*)(F.ws + WS_ROWGATE), F.ws + WS_Y, tb};
        for (int rep = 0; rep < REP7; ++rep) pg8::gemm_phase<EpiDown, pg8::StaticOrder, MoeMapDown, true, true>(F.lds, 512, S, mp, E);
    } SEAM(7);
    if (IN(8)) { (void)moe_tables(F); for (int rep = 1; rep < REP8; ++rep) p8_combine(F, true); p8_combine(F); }
#undef IN
#undef SEAM
}

extern "C" void kernel_launch(void* const* d_in, const int* in_sizes, int n_in, void* d_out, int out_size, void* d_ws, size_t ws_size, hipStream_t stream) {
    static int grid = 0;
    if (grid == 0) {
        if (n_in != 19 || in_sizes[0] != T * DM || out_size != T * DM || ws_size < WS_END) { fprintf(stderr, "kernel_launch: unexpected shapes (n_in %d, in0 %d, out %d, ws %zu); nothing launched\n", n_in, n_in > 0 ? in_sizes[0] : -1, out_size, ws_size); grid = -1; return; }
        int dev = 0, cus = 0, per_cu = 0;
        if (hipGetDevice(&dev) != hipSuccess || hipDeviceGetAttribute(&cus, hipDeviceAttributeMultiprocessorCount, dev) != hipSuccess) { grid = -1; return; }
        if (hipFuncSetAttribute((const void*)enc_fwd, hipFuncAttributeMaxDynamicSharedMemorySize, LDS_BYTES) != hipSuccess) { fprintf(stderr, "kernel_launch: hipFuncSetAttribute failed\n"); grid = -1; return; }
        if (hipOccupancyMaxActiveBlocksPerMultiprocessor(&per_cu, (const void*)enc_fwd, NWAVES * 64, LDS_BYTES) != hipSuccess || per_cu < 1) { fprintf(stderr, "kernel_launch: occupancy query says %d\n", per_cu); }
        (void)hipGetLastError();
        grid = cus;
    }
    if (grid < 0) return;
    if (hipMemsetAsync((char*)d_ws + WS_CTL, 0, CTL_ZERO_BYTES, stream) != hipSuccess) return;
    Args a{};
    for (int i = 0; i < 19; ++i) a.in[i] = (const float*)d_in[i];
    a.out = (float*)d_out; a.ws = (unsigned char*)d_ws;
    if (N_LAUNCHES == 1) { a.ph_lo = 0; a.ph_hi = N_PHASES; hipLaunchKernelGGL(enc_fwd, dim3(grid), dim3(NWAVES * 64), LDS_BYTES, stream, a); }
    else for (int p = 0; p < N_PHASES; ++p) { a.ph_lo = p; a.ph_hi = p + 1; hipLaunchKernelGGL(enc_fwd, dim3(grid), dim3(NWAVES * 64), LDS_BYTES, stream, a); }
}
```

```cpp
#include <hip/hip_runtime.h>
#include <hip/hip_bf16.h>
#include <cstdio>
#include <cstdint>
#include <cmath>

#define LAS __attribute__((address_space(3)))
#define GAS __attribute__((address_space(1)))

namespace pg8 {
typedef unsigned short bf16_t;
typedef short bf16x8 __attribute__((ext_vector_type(8)));
typedef float f32x4 __attribute__((ext_vector_type(4)));
typedef float f32x2 __attribute__((ext_vector_type(2)));
typedef unsigned u32x4 __attribute__((ext_vector_type(4)));
typedef int v4i_t __attribute__((ext_vector_type(4)));
typedef int v8i_t __attribute__((ext_vector_type(8)));
constexpr int BM = 256, BK = 64, HALF = 128, HTB = HALF * BK * 2, STAGE_BYTES = 8 * HTB, NXCD = 8, WGM = 8;

__host__ __device__ __forceinline__ int lds_byte(int r, int c) { const int st = (r >> 4) * 2 + (c >> 5), rr = r & 15, cc = c & 31, ob = rr * 64 + cc * 2; return st * 1024 + (ob ^ (((ob >> 9) & 1) << 5)); }
__host__ __device__ __forceinline__ void stage_rc(int b, int& R, int& C) { const int st = b / 1024, sb = b % 1024, swz = sb ^ (((sb >> 9) & 1) << 5); R = (st >> 1) * 16 + swz / 64; C = (st & 1) * 32 + (swz % 64) / 2; }
__host__ __device__ __forceinline__ int perm32(int rho) { const int n = rho >> 4, i = rho & 15; return 8 * (i >> 2) + 4 * n + (i & 3); }

struct Unit { int pm, pn; };

struct StaticOrder {
    int nM, nN, nwg, G, c;
    __device__ __forceinline__ void init(int nM_, int nN_, int G_, int c_) { nM = nM_; nN = nN_; nwg = nM * nN; G = G_; c = c_; }
    __device__ __forceinline__ bool next(int i, Unit& u) const {
        const long L = (long)i * G + c; if (L >= nwg) return false;
        int wgid = (int)L; { const int q = nwg / NXCD, r = nwg % NXCD, xcd = wgid % NXCD, off = wgid / NXCD; wgid = (xcd < r ? xcd * (q + 1) : r * (q + 1) + (xcd - r) * q) + off; }
        const int nig = WGM * nN, gid = wgid / nig, fm = gid * WGM, gsz = (nM - fm) < WGM ? (nM - fm) : WGM;
        u.pm = fm + ((wgid % nig) % gsz); u.pn = (wgid % nig) / gsz; return true;
    }
};

__device__ __forceinline__ unsigned cvt_pk_bf16(float lo, float hi) { unsigned r; asm volatile("v_cvt_pk_bf16_f32 %0, %1, %2" : "=v"(r) : "v"(lo), "v"(hi)); return r; }

template <class Epi, class Sched, class Map, bool ALIGN_EPI, bool FP8 = false>
__device__ __forceinline__ void gemm_phase(LAS unsigned char* lds, const int K, const Sched& S, const Map& MP, const Epi& E) {
    const int tid = threadIdx.x, wid = __builtin_amdgcn_readfirstlane(tid >> 6), lane = tid & 63, wr = wid >> 2, wc = wid & 3, fr = lane & 15, fq = lane >> 4;
    const int nt = K / BK;
    int Rr[2], Cc[2]; unsigned voffB[2];
#pragma unroll
    for (int i = 0; i < 2; ++i) { int R, C; stage_rc(tid * 16 + i * 8192, R, C); Rr[i] = R; Cc[i] = C; const int Rb = Epi::COLS64 ? (64 * (R >> 5) + perm32(R & 31)) : (Epi::PERM ? ((R & ~31) + perm32(R & 31)) : R); voffB[i] = (unsigned)(Rb * K + C) * 2u; }
    const unsigned kstep = (unsigned)(BK * 2);
    const unsigned hstep = (unsigned)HALF * K * 2;
    const unsigned hstepB = Epi::COLS64 ? 32u * (unsigned)K * 2u : hstep;
    const __amdgpu_buffer_rsrc_t RA = MP.a_rsrc(), RB = MP.b_rsrc();
    const unsigned ldsw = (unsigned)wid * 1024u;
    const int aoff = lds_byte(wr * 64 + fr, fq * 8), boff = lds_byte(wc * 32 + fr, fq * 8);
#define PG8_SA(b, h) (((b) * 2 + (h)) * HTB)
#define PG8_SB(b, h) ((4 + (b) * 2 + (h)) * HTB)
#define PG8_STAGE(bufoff, rsrc, soff, voff) do { _Pragma("unroll") for (int _i = 0; _i < 2; ++_i) \
        __builtin_amdgcn_raw_ptr_buffer_load_lds(rsrc, (LAS unsigned*)(lds + (bufoff) + ldsw + _i * 8192), 16, (int)(voff)[_i], (int)(soff), 0, 0); } while (0)
#define PG8_LD8(p) __builtin_shufflevector(*(const LAS v4i_t*)(p), *(const LAS v4i_t*)((p) + 1024), 0, 1, 2, 3, 4, 5, 6, 7)
#define PG8_LDA(dst, b, h) do { _Pragma("unroll") for (int m = 0; m < 4; ++m) dst[m] = PG8_LD8(lds + PG8_SA(b, h) + aoff + m * 2048); } while (0)
#define PG8_LDB(dst, b, h) do { _Pragma("unroll") for (int n = 0; n < 2; ++n) dst[n] = PG8_LD8(lds + PG8_SB(b, h) + boff + n * 2048); } while (0)
#define PG8_HALF(x, k) __builtin_bit_cast(bf16x8, __builtin_shufflevector(x, x, 4 * (k), 4 * (k) + 1, 4 * (k) + 2, 4 * (k) + 3))
#define PG8_MMA(ai, bj, At, Bt) do { __builtin_amdgcn_s_setprio(1); _Pragma("unroll") for (int m = 0; m < 4; ++m) _Pragma("unroll") for (int n = 0; n < 2; ++n) { \
        if constexpr (FP8) { acc[ai][bj][m][n] = __builtin_amdgcn_mfma_scale_f32_16x16x128_f8f6f4(Bt[n], At[m], acc[ai][bj][m][n], 0, 0, 0, 0x7f7f7f7f, 0, 0x7f7f7f7f); } \
        else { acc[ai][bj][m][n] = __builtin_amdgcn_mfma_f32_16x16x32_bf16(PG8_HALF(Bt[n], 0), PG8_HALF(At[m], 0), acc[ai][bj][m][n], 0, 0, 0); \
               acc[ai][bj][m][n] = __builtin_amdgcn_mfma_f32_16x16x32_bf16(PG8_HALF(Bt[n], 1), PG8_HALF(At[m], 1), acc[ai][bj][m][n], 0, 0, 0); } } \
        __builtin_amdgcn_s_setprio(0); } while (0)
#define PG8_WAIT_V(n) asm volatile("s_waitcnt vmcnt(" #n ")" ::: "memory")
#define PG8_WAIT_L(n) asm volatile("s_waitcnt lgkmcnt(" #n ")" ::: "memory")
#define PG8_BAR __builtin_amdgcn_s_barrier()
#define PG8_SCHED __builtin_amdgcn_sched_barrier(0)
    Unit cur, nxt, nn; int ui = 0;
    if (!S.next(0, cur)) return;
    f32x4 acc[2][2][4][2];
#pragma unroll
    for (int a = 0; a < 2; ++a)
#pragma unroll
        for (int b = 0; b < 2; ++b)
#pragma unroll
            for (int m = 0; m < 4; ++m)
#pragma unroll
                for (int n = 0; n < 2; ++n) acc[a][b][m][n] = (f32x4){0.f, 0.f, 0.f, 0.f};
    v8i_t At[4], B0[2], B1[2];
    unsigned cvo[2][2], nvo[2][2], nnvo[2][2];
    MP.a_off(cur, Rr, Cc, cvo);
    bool has_next = S.next(1, nxt);
    if constexpr (Map::GATHER) { if (has_next) MP.a_off(nxt, Rr, Cc, nvo); else { nvo[0][0] = cvo[0][0]; nvo[0][1] = cvo[0][1]; nvo[1][0] = cvo[1][0]; nvo[1][1] = cvo[1][1]; } }
    unsigned cA = MP.a_soff(cur), cB = MP.b_soff(cur);
    typename Epi::Pre pc, pn;
    E.preload(cur, wr, wc, fr, fq, pc); pn = pc;
    PG8_STAGE(PG8_SB(0, 0), RB, cB, voffB); PG8_STAGE(PG8_SB(0, 1), RB, cB + hstepB, voffB); PG8_STAGE(PG8_SA(0, 0), RA, cA, cvo[0]); PG8_STAGE(PG8_SA(0, 1), RA, cA, cvo[1]);
    if (wr == 1) PG8_BAR;
    PG8_WAIT_V(2); PG8_BAR;
    PG8_STAGE(PG8_SB(1, 0), RB, cB + kstep, voffB); PG8_STAGE(PG8_SA(1, 0), RA, cA + kstep, cvo[0]); PG8_STAGE(PG8_SB(1, 1), RB, cB + hstepB + kstep, voffB);
    PG8_WAIT_V(6); PG8_BAR;
    for (;;) {
        const unsigned nA = has_next ? MP.a_soff(nxt) : cA, nB = has_next ? MP.b_soff(nxt) : cB;
#pragma unroll 1
        for (int t = 0; t < nt; t += 2) {
            const bool last = (t == nt - 2);
            const unsigned a1 = cA + (unsigned)(t + 1) * kstep;
            const unsigned a2 = last ? nA : cA + (unsigned)(t + 2) * kstep, b2 = last ? nB : cB + (unsigned)(t + 2) * kstep;
            const unsigned a3 = a2 + kstep, b3 = b2 + kstep;
            unsigned s0[2] = {cvo[0][0], cvo[0][1]}, s1[2] = {cvo[1][0], cvo[1][1]};
            if constexpr (Map::GATHER) { if (last) { s0[0] = nvo[0][0]; s0[1] = nvo[0][1]; s1[0] = nvo[1][0]; s1[1] = nvo[1][1]; } }
            PG8_LDB(B0, 0, 0); PG8_LDB(B1, 0, 1); PG8_SCHED; PG8_LDA(At, 0, 0); PG8_STAGE(PG8_SA(1, 1), RA, a1, cvo[1]);
            PG8_WAIT_V(8); PG8_WAIT_L(0); PG8_BAR; PG8_MMA(0, 0, At, B0); PG8_MMA(0, 1, At, B1); PG8_BAR; PG8_SCHED;
            PG8_LDA(At, 0, 1); PG8_STAGE(PG8_SB(0, 0), RB, b2, voffB); PG8_STAGE(PG8_SB(0, 1), RB, b2 + hstepB, voffB); PG8_STAGE(PG8_SA(0, 0), RA, a2, s0);
            PG8_WAIT_V(8); PG8_WAIT_L(0); PG8_BAR; PG8_MMA(1, 0, At, B0); PG8_MMA(1, 1, At, B1); PG8_BAR; PG8_SCHED;
            PG8_LDB(B0, 1, 0); PG8_LDB(B1, 1, 1); PG8_SCHED; PG8_LDA(At, 1, 0); PG8_STAGE(PG8_SA(0, 1), RA, a2, s1);
            PG8_WAIT_V(8); PG8_WAIT_L(0); PG8_BAR; PG8_MMA(0, 0, At, B0); PG8_MMA(0, 1, At, B1); PG8_BAR; PG8_SCHED;
            PG8_LDA(At, 1, 1); PG8_STAGE(PG8_SB(1, 0), RB, b3, voffB); PG8_STAGE(PG8_SB(1, 1), RB, b3 + hstepB, voffB); PG8_STAGE(PG8_SA(1, 0), RA, a3, s0);
            PG8_WAIT_V(8); PG8_WAIT_L(0); PG8_BAR; PG8_MMA(1, 0, At, B0); PG8_MMA(1, 1, At, B1); PG8_BAR; PG8_SCHED;
        }
        if constexpr (ALIGN_EPI) { if (wr == 0) PG8_BAR; }
        const bool has_nn = has_next && S.next(ui + 2, nn);
        if constexpr (Map::GATHER) { if (has_nn) MP.a_raw(nn, Rr, nnvo); }
        if (has_next) E.preload(nxt, wr, wc, fr, fq, pn);
        { int fr_ = fr, fq_ = fq; asm volatile("" : "+v"(fr_), "+v"(fq_)); E(acc, cur, pc, wr, wc, fr_, fq_); }
        if (!has_next) break;
#pragma unroll
        for (int a = 0; a < 2; ++a)
#pragma unroll
            for (int b = 0; b < 2; ++b)
#pragma unroll
                for (int m = 0; m < 4; ++m)
#pragma unroll
                    for (int n = 0; n < 2; ++n) acc[a][b][m][n] = (f32x4){0.f, 0.f, 0.f, 0.f};
        cur = nxt; cA = nA; cB = nB; ++ui; pc = pn;
#pragma unroll
        for (int h = 0; h < 2; ++h)
#pragma unroll
            for (int i = 0; i < 2; ++i) { if constexpr (Map::GATHER) { cvo[h][i] = nvo[h][i]; nvo[h][i] = has_nn ? MP.a_fin(nnvo[h][i], Cc[i]) : nvo[h][i]; } }
        has_next = has_nn; nxt = nn;
        if constexpr (ALIGN_EPI) { if (wr == 1) PG8_BAR; }
    }
    PG8_WAIT_V(0);
    if constexpr (!ALIGN_EPI) { if (wr == 0) PG8_BAR; }
    PG8_BAR;
#undef PG8_SA
#undef PG8_SB
#undef PG8_STAGE
#undef PG8_LDA
#undef PG8_LDB
#undef PG8_MMA
#undef PG8_HALF
#undef PG8_LD8
#undef PG8_WAIT_V
#undef PG8_WAIT_L
#undef PG8_BAR
#undef PG8_SCHED
}
}
namespace attn_body {
using bf16=__hip_bfloat16;
using bf16x8=__attribute__((ext_vector_type(8)))short;
using s16x4=__attribute__((ext_vector_type(4)))short;
using f32x16=__attribute__((ext_vector_type(16)))float;
using u32x4=__attribute__((ext_vector_type(4)))unsigned;
constexpr int BATCH=8,NHEAD=8,NKVH=2,SEQ=4096,D=64;
constexpr int QP=512,KP=128,VP=128,OP=1024,OCOL=512;
constexpr int NW=8,QBLK=32,QB=QBLK*NW,KVBLK=64,NQB=SEQ/QB;
__device__ __forceinline__ int crow(int r,int hi){return (r&3)+8*(r>>2)+4*hi;}
#define SBAR() __builtin_amdgcn_sched_barrier(0)
constexpr int NSLOT=3, SLOTB=8192;
constexpr int LDS_K=0, LDS_V=NSLOT*SLOTB, LDS_WS=2*NSLOT*SLOTB, LDS_OST=LDS_WS+NW*64*4, LDS_BYTES=LDS_OST+NW*4096;
constexpr float C2=0.125f*1.4426950408889634f;
__device__ __forceinline__ void glds16(const void*gsrc,unsigned lds_dst){unsigned keep;
  asm volatile("s_mov_b32 %0, m0\n\ts_mov_b32 m0, %2\n\ts_nop 0\n\tglobal_load_lds_dwordx4 %1, off\n\ts_mov_b32 m0, %0":"=&s"(keep):"v"(gsrc),"s"(lds_dst):"memory");}
__device__ __forceinline__ float max3f(float a,float b,float c){float r;asm("v_max3_f32 %0, %1, %2, %3":"=v"(r):"v"(a),"v"(b),"v"(c));return r;}
__device__ __forceinline__ float max2f(float a,float b){float r;asm("v_max_f32_e32 %0, %1, %2":"=v"(r):"v"(a),"v"(b));return r;}
__device__ __forceinline__ float fadd_s(float a,float b){float r;asm("v_add_f32_e32 %0, %1, %2":"=v"(r):"v"(a),"v"(b));return r;}
__device__ __forceinline__ float fsub_s(float a,float b){float r;asm("v_sub_f32_e32 %0, %1, %2":"=v"(r):"v"(a),"v"(b));return r;}
typedef float f32x2_t __attribute__((ext_vector_type(2))); typedef __bf16 bf16x2_t __attribute__((ext_vector_type(2)));
__device__ __forceinline__ unsigned cvtpk_s(float lo,float hi){f32x2_t v={lo,hi};bf16x2_t b=__builtin_convertvector(v,bf16x2_t);return __builtin_bit_cast(unsigned,b);}
#define WAIT_BAR(N) asm volatile("s_waitcnt vmcnt(" #N ") lgkmcnt(0)\n\ts_barrier":::"memory")

__device__ __forceinline__ void qkt(f32x16&p0,f32x16&p1,const char*Kslot,const bf16x8*qr,const f32x16&negm,int r32,int hi){
  const char*kb=Kslot+hi*1024+r32*16;
  #pragma unroll
  for(int d0=0;d0<4;++d0){
    const bf16x8 b0=*reinterpret_cast<const bf16x8*>(kb+d0*2048);
    const bf16x8 b1=*reinterpret_cast<const bf16x8*>(kb+d0*2048+512);
    if(d0==0){p0=__builtin_amdgcn_mfma_f32_32x32x16_bf16(b0,qr[0],negm,0,0,0);p1=__builtin_amdgcn_mfma_f32_32x32x16_bf16(b1,qr[0],negm,0,0,0);}
    else{p0=__builtin_amdgcn_mfma_f32_32x32x16_bf16(b0,qr[d0],p0,0,0,0);p1=__builtin_amdgcn_mfma_f32_32x32x16_bf16(b1,qr[d0],p1,0,0,0);}}
}
typedef __attribute__((address_space(3))) const char* lds_cptr;
typedef short v4i16_t __attribute__((ext_vector_type(4)));
__device__ __forceinline__ void kload8(bf16x8*kf,lds_cptr kp){
  kf[0]=*(const __attribute__((address_space(3))) bf16x8*)(kp);      kf[1]=*(const __attribute__((address_space(3))) bf16x8*)(kp+512);
  kf[2]=*(const __attribute__((address_space(3))) bf16x8*)(kp+2048); kf[3]=*(const __attribute__((address_space(3))) bf16x8*)(kp+2560);
  kf[4]=*(const __attribute__((address_space(3))) bf16x8*)(kp+4096); kf[5]=*(const __attribute__((address_space(3))) bf16x8*)(kp+4608);
  kf[6]=*(const __attribute__((address_space(3))) bf16x8*)(kp+6144); kf[7]=*(const __attribute__((address_space(3))) bf16x8*)(kp+6656);
}
__device__ __forceinline__ void kload2(bf16x8*kf,lds_cptr kp,int j){ kf[2*j]=*(const __attribute__((address_space(3))) bf16x8*)(kp+j*2048); kf[2*j+1]=*(const __attribute__((address_space(3))) bf16x8*)(kp+j*2048+512); }
__device__ __forceinline__ s16x4 vtr(lds_cptr p){ return __builtin_bit_cast(s16x4,__builtin_amdgcn_ds_read_tr16_b64_v4i16((__attribute__((address_space(3))) v4i16_t*)p)); }
__device__ __forceinline__ float rowmax(const f32x16&p0,const f32x16&p1){
  float a=max3f(p0[0],p0[1],p1[0]),b=max3f(p0[2],p0[3],p1[1]);a=max3f(a,p1[2],p1[3]);
  #pragma unroll
  for(int r=4;r<16;r+=4){a=max3f(a,p0[r],p0[r+1]);b=max3f(b,p0[r+2],p0[r+3]);a=max3f(a,p1[r],p1[r+1]);b=max3f(b,p1[r+2],p1[r+3]);}
  const float m=max2f(a,b);
  auto rr=__builtin_amdgcn_permlane32_swap(__float_as_uint(m),__float_as_uint(m),false,false);
  return max2f(__uint_as_float(rr[0]),__uint_as_float(rr[1]));
}
__device__ __forceinline__ void pv(f32x16*o,int vb,bf16x8 pa0,bf16x8 pa1,bf16x8 pa2,bf16x8 pa3){
  #pragma unroll
  for(int d0=0;d0<2;++d0){s16x4 lo[4],hi[4];
    #pragma unroll
    for(int ks=0;ks<4;++ks){
      asm volatile("ds_read_b64_tr_b16 %0,%1 offset:%c2":"=&v"(lo[ks]):"v"(vb),"i"(d0*4096+ks*1024):"memory");
      asm volatile("ds_read_b64_tr_b16 %0,%1 offset:%c2":"=&v"(hi[ks]):"v"(vb),"i"(d0*4096+ks*1024+512):"memory");}
    asm volatile("s_waitcnt lgkmcnt(0)":::"memory");SBAR();
    #define PK(k) (bf16x8){lo[k][0],lo[k][1],lo[k][2],lo[k][3],hi[k][0],hi[k][1],hi[k][2],hi[k][3]}
    o[d0]=__builtin_amdgcn_mfma_f32_32x32x16_bf16(pa0,PK(0),o[d0],0,0,0);
    o[d0]=__builtin_amdgcn_mfma_f32_32x32x16_bf16(pa1,PK(1),o[d0],0,0,0);
    o[d0]=__builtin_amdgcn_mfma_f32_32x32x16_bf16(pa2,PK(2),o[d0],0,0,0);
    o[d0]=__builtin_amdgcn_mfma_f32_32x32x16_bf16(pa3,PK(3),o[d0],0,0,0);
    #undef PK
  }
}
#define ATTN_STORE16(p,v) (*(u32x4*)(p)=(v))
template<int THRL> __device__ __forceinline__ void attn_unit(int b,int h,int qb,const bf16*Q,const bf16*__restrict__ K,const bf16*__restrict__ V,bf16*O,char*shm,const float*qgain){
  const int tid=threadIdx.x,lane=tid&63,r32=lane&31,hi=lane>>5; const int wid=__builtin_amdgcn_readfirstlane(tid>>6);
  const long rowbase=(long)b*SEQ; const int q0=qb*QB; const int kvh=h/(NHEAD/NKVH);
  const bf16*Qw=Q+(rowbase+q0+wid*QBLK)*QP+h*D;
  const bf16*Kh=K+rowbase*KP+kvh*D,*Vh=V+rowbase*VP+kvh*D;
  const unsigned lds0=(unsigned)(uintptr_t)shm;
  float*wsf=(float*)(shm+LDS_WS)+wid*64;
  const bf16*ksrc=Kh+(long)lane*KP+wid*8;
  const bf16*vsrc=Vh+(long)(16*(wid&3)+(lane>>2))*VP+(wid>>2)*32+(lane&3)*8;
  const unsigned kdst=lds0+LDS_K+wid*1024, vdst=lds0+LDS_V+wid*1024;
  #define DMA_K(t,slot) glds16(ksrc+(long)(t)*KVBLK*KP,(unsigned)__builtin_amdgcn_readfirstlane(kdst+(slot)))
  #define DMA_V(t,slot) glds16(vsrc+(long)(t)*KVBLK*VP,(unsigned)__builtin_amdgcn_readfirstlane(vdst+(slot)))
  const int vb0=(int)(lds0+LDS_V)+((lane>>4)&1)*32+(lane&3)*8+(4*hi+((lane&15)>>2))*64;
  const char*Kbase=shm+LDS_K; bf16x8 kf[8];
  const lds_cptr shm3=(lds_cptr)shm; const lds_cptr kp0=shm3+LDS_K+hi*1024+r32*16; const lds_cptr vp0=shm3+LDS_V+((lane>>4)&1)*32+(lane&3)*8+(4*hi+((lane&15)>>2))*64;
  constexpr int NT=SEQ/KVBLK;
  DMA_K(0,0);DMA_V(0,0);DMA_K(1,SLOTB);
  bf16x8 qr[4];
  #pragma unroll
  for(int d0=0;d0<4;++d0)qr[d0]=*reinterpret_cast<const bf16x8*>(&Qw[(long)r32*QP+d0*16+hi*8]);
  { float xq[4][8]; float ss=0.f;
    #pragma unroll
    for(int d0=0;d0<4;++d0)
      #pragma unroll
      for(int j=0;j<8;++j){ xq[d0][j]=__builtin_bit_cast(float,((unsigned)(unsigned short)qr[d0][j])<<16); ss+=xq[d0][j]*xq[d0][j]; }
    ss+=__shfl_xor(ss,32);
    const float rinv=__builtin_amdgcn_rsqf(ss*(1.f/64.f)+1e-6f);
    const int tq=q0+wid*QBLK+r32; const float prow=(float)(tq>>6), pcol=(float)(tq&63);
    #pragma unroll
    for(int d0=0;d0<4;++d0)
      #pragma unroll
      for(int j=0;j<8;++j) xq[d0][j]*=rinv*qgain[16*d0+8*hi+j];
    #pragma unroll
    for(int j=0;j<8;++j){ const float inv=exp2f(-(float)(8*hi+j)*(13.287712379549449f/16.f));
      const float ar=prow*inv, ac=pcol*inv; const float cr=__cosf(ar), sr=__sinf(ar), cc=__cosf(ac), sc=__sinf(ac);
      const float a0=xq[0][j], a1=xq[1][j], b0=xq[2][j], b1=xq[3][j];
      xq[0][j]=(a0*cr-a1*sr)*C2; xq[1][j]=(a1*cr+a0*sr)*C2; xq[2][j]=(b0*cc-b1*sc)*C2; xq[3][j]=(b1*cc+b0*sc)*C2; }
    #pragma unroll
    for(int d0=0;d0<4;++d0){ u32x4 w; w.x=cvtpk_s(xq[d0][0],xq[d0][1]); w.y=cvtpk_s(xq[d0][2],xq[d0][3]); w.z=cvtpk_s(xq[d0][4],xq[d0][5]); w.w=cvtpk_s(xq[d0][6],xq[d0][7]); qr[d0]=__builtin_bit_cast(bf16x8,w); } }
  float mhat=0.f,l_reg=0.f;f32x16 o[2];o[0]=f32x16{};o[1]=f32x16{};f32x16 negm=f32x16{};asm volatile("":"+v"(negm));
  bool resc=false;
  #define START(P0,P1) do{ const float rm=rowmax(P0,P1); resc=false; \
    { const float dl=rm; mhat=fadd_s(mhat,dl); \
      _Pragma("unroll") for(int r=0;r<16;++r){P0[r]=fsub_s(P0[r],dl);P1[r]=fsub_s(P1[r],dl);} \
      _Pragma("unroll") for(int r=0;r<16;++r)negm[r]=-mhat; asm volatile("":"+v"(negm)); } \
    _Pragma("unroll") for(int r=0;r<16;++r)P0[r]=__builtin_amdgcn_exp2f(P0[r]); }while(0)
  #define RESC() do{ if(resc){ asm volatile("s_waitcnt lgkmcnt(0)":::"memory"); \
      _Pragma("unroll") for(int d_=0;d_<2;++d_) _Pragma("unroll") for(int r=0;r<16;++r)o[d_][r]*=wsf[crow(r,hi)]; } }while(0)
  f32x16 pA0,pA1,pB0,pB1;
  int sl_prev=0,sl_cur=0,sl_next=SLOTB;
  #define ROT() do{sl_prev=sl_cur;sl_cur=sl_next;sl_next=(sl_next==(NSLOT-1)*SLOTB)?0:sl_next+SLOTB;}while(0)
  DMA_K(2,2*SLOTB);
  WAIT_BAR(3);
  qkt(pA0,pA1,Kbase,qr,negm,r32,hi);asm volatile("s_nop 15\n\ts_nop 7":"+v"(pA0),"+v"(pA1));
  START(pA0,pA1);
  _Pragma("unroll") for(int r=0;r<16;++r)pA1[r]=__builtin_amdgcn_exp2f(pA1[r]);
  WAIT_BAR(0);
  DMA_K(3,0);DMA_V(1,SLOTB);
  ROT();
  kload8(kf,kp0+sl_cur);
  WAIT_BAR(2);
  s16x4 vlo[8],vhi[8]; u32x4 pw0,pw1,pw2,pw3;
  #define PKW(P,B) cvtpk_s(P[B],P[B+1])
  #define PAF(k) __builtin_bit_cast(bf16x8,pw##k)
  #define VFR(i) (bf16x8){vlo[i][0],vlo[i][1],vlo[i][2],vlo[i][3],vhi[i][0],vhi[i][1],vhi[i][2],vhi[i][3]}
  #define PIN(x) asm volatile("":"+v"(x))
  #define MX3(a,b,c) __builtin_fmaxf(__builtin_fmaxf((a),(b)),(c))
  #define GAPA(MF,A0,A1,A2,A3,W0,W1,PW) do{ MF; sacc+=A0; sacc+=A1; sacc+=A2; sacc+=A3; PIN(sacc); W0; W1; PIN(PW); SBAR(); }while(0)
  #define EX(v) __builtin_amdgcn_exp2f(v)
  #define GAPB(MF,X,B) do{ MF; X[B]=EX(X[B]); X[B+1]=EX(X[B+1]); X[B+2]=EX(X[B+2]); X[B+3]=EX(X[B+3]); PIN(X); SBAR(); }while(0)
  #define VRD(i) do{ vlo[i]=vtr(vp_+(((i)>>2)*4096+((i)&3)*1024)); vhi[i]=vtr(vp_+(((i)>>2)*4096+((i)&3)*1024+512)); }while(0)
  #define KRD(G,j) do{ if(G){ kload2(kf,kp0+sl_next,j); SBAR(); } }while(0)
  #define STEP(C0,C1,P0,P1,t,GK,GV,GL) do{ SBAR(); \
    const lds_cptr vp_=vp0+sl_prev; \
    VRD(0); SBAR(); float sacc=(P0[0]+P0[1]); \
    GAPA(C0=__builtin_amdgcn_mfma_f32_32x32x16_bf16(kf[0],qr[0],negm,0,0,0), P0[2],P0[3],P0[4],P0[5],     pw0[0]=PKW(P0,0), pw0[1]=PKW(P0,2), pw0); \
    VRD(4); SBAR(); GAPA(C1=__builtin_amdgcn_mfma_f32_32x32x16_bf16(kf[1],qr[0],negm,0,0,0), P0[6],P0[7],P0[8],P0[9],     pw0[2]=PKW(P0,4), pw0[3]=PKW(P0,6), pw0); \
    VRD(1); SBAR(); GAPA(C0=__builtin_amdgcn_mfma_f32_32x32x16_bf16(kf[2],qr[1],C0,0,0,0),   P0[10],P0[11],P0[12],P0[13], pw1[0]=PKW(P0,8), pw1[1]=PKW(P0,10), pw1); \
    VRD(5); SBAR(); GAPA(C1=__builtin_amdgcn_mfma_f32_32x32x16_bf16(kf[3],qr[1],C1,0,0,0),   P0[14],P0[15],P1[0],P1[1],   pw1[2]=PKW(P0,12),pw1[3]=PKW(P0,14), pw1); \
    VRD(2); SBAR(); GAPA(C0=__builtin_amdgcn_mfma_f32_32x32x16_bf16(kf[4],qr[2],C0,0,0,0),   P1[2],P1[3],P1[4],P1[5],     pw2[0]=PKW(P1,0), pw2[1]=PKW(P1,2), pw2); \
    VRD(6); SBAR(); GAPA(C1=__builtin_amdgcn_mfma_f32_32x32x16_bf16(kf[5],qr[2],C1,0,0,0),   P1[6],P1[7],P1[8],P1[9],     pw2[2]=PKW(P1,4), pw2[3]=PKW(P1,6), pw2); \
    VRD(3); SBAR(); GAPA(C0=__builtin_amdgcn_mfma_f32_32x32x16_bf16(kf[6],qr[3],C0,0,0,0),   P1[10],P1[11],P1[12],P1[13], pw3[0]=PKW(P1,8), pw3[1]=PKW(P1,10), pw3); \
    VRD(7); SBAR(); GAPA(C1=__builtin_amdgcn_mfma_f32_32x32x16_bf16(kf[7],qr[3],C1,0,0,0),   P1[14],P1[15],0.f,0.f,       pw3[2]=PKW(P1,12),pw3[3]=PKW(P1,14), pw3); \
    l_reg+=sacc; \
    if(GK){DMA_K((t)+3,sl_cur);} if(GV){DMA_V((t)+1,sl_next);} \
    { float a=MX3(C0[0],C0[1],C1[0]),b=MX3(C0[2],C0[3],C1[1]); a=MX3(a,C1[2],C1[3]); \
      _Pragma("unroll") for(int r=4;r<16;r+=4){a=MX3(a,C0[r],C0[r+1]);b=MX3(b,C0[r+2],C0[r+3]);a=MX3(a,C1[r],C1[r+1]);b=MX3(b,C1[r+2],C1[r+3]);} \
      float rm=__builtin_fmaxf(a,b); { auto rr=__builtin_amdgcn_permlane32_swap(__float_as_uint(rm),__float_as_uint(rm),false,false); rm=__builtin_fmaxf(__uint_as_float(rr[0]),__uint_as_float(rr[1])); } \
      resc=false; \
      if(__builtin_expect(__any(rm>(float)THRL),0)){ const float dl=__builtin_fmaxf(rm,0.f); mhat+=dl; \
        _Pragma("unroll") for(int r=0;r<16;++r){C0[r]-=dl;C1[r]-=dl;} \
        _Pragma("unroll") for(int r=0;r<16;++r)negm[r]=-mhat; asm volatile("":"+v"(negm)); \
        const float f=__builtin_amdgcn_exp2f(-dl); l_reg*=f; if(hi==0)wsf[r32]=f; resc=true; } } \
    SBAR(); \
    GAPB(o[0]=__builtin_amdgcn_mfma_f32_32x32x16_bf16(PAF(0),VFR(0),o[0],0,0,0), C0,0); \
    GAPB(o[1]=__builtin_amdgcn_mfma_f32_32x32x16_bf16(PAF(0),VFR(4),o[1],0,0,0), C0,4); \
    KRD(GL,0); GAPB(o[0]=__builtin_amdgcn_mfma_f32_32x32x16_bf16(PAF(1),VFR(1),o[0],0,0,0), C0,8); \
    KRD(GL,1); GAPB(o[1]=__builtin_amdgcn_mfma_f32_32x32x16_bf16(PAF(1),VFR(5),o[1],0,0,0), C0,12); \
    KRD(GL,2); GAPB(o[0]=__builtin_amdgcn_mfma_f32_32x32x16_bf16(PAF(2),VFR(2),o[0],0,0,0), C1,0); \
    KRD(GL,3); GAPB(o[1]=__builtin_amdgcn_mfma_f32_32x32x16_bf16(PAF(2),VFR(6),o[1],0,0,0), C1,4); \
    GAPB(o[0]=__builtin_amdgcn_mfma_f32_32x32x16_bf16(PAF(3),VFR(3),o[0],0,0,0), C1,8); \
    GAPB(o[1]=__builtin_amdgcn_mfma_f32_32x32x16_bf16(PAF(3),VFR(7),o[1],0,0,0), C1,12); \
    }while(0)
  int t=1;
  for(;t+5<NT;t+=2){
    STEP(pB0,pB1,pA0,pA1,t,true,true,true);     WAIT_BAR(2); RESC(); ROT();
    STEP(pA0,pA1,pB0,pB1,t+1,true,true,true);   WAIT_BAR(2); RESC(); ROT();
  }
  #define ENDW(tt) do{ if((tt)+3<NT){WAIT_BAR(2);} else if((tt)+2<NT){WAIT_BAR(1);} else {WAIT_BAR(0);} }while(0)
  for(;t+1<NT;t+=2){
    STEP(pB0,pB1,pA0,pA1,t,(t+3<NT),(t+1<NT),(t+1<NT));       ENDW(t);   RESC(); ROT();
    STEP(pA0,pA1,pB0,pB1,t+1,(t+4<NT),(t+2<NT),(t+2<NT));     ENDW(t+1); RESC(); ROT();
  }
  STEP(pB0,pB1,pA0,pA1,NT-1,false,false,false); RESC();
  { float sacc=pB0[0]+pB0[1]; _Pragma("unroll") for(int r=2;r<16;++r)sacc+=pB0[r]; _Pragma("unroll") for(int r=0;r<16;++r)sacc+=pB1[r]; l_reg+=sacc;
    pw0=(u32x4){PKW(pB0,0),PKW(pB0,2),PKW(pB0,4),PKW(pB0,6)};pw1=(u32x4){PKW(pB0,8),PKW(pB0,10),PKW(pB0,12),PKW(pB0,14)};pw2=(u32x4){PKW(pB1,0),PKW(pB1,2),PKW(pB1,4),PKW(pB1,6)};pw3=(u32x4){PKW(pB1,8),PKW(pB1,10),PKW(pB1,12),PKW(pB1,14)};
    SBAR(); pv(o,vb0+sl_cur,PAF(0),PAF(1),PAF(2),PAF(3)); }
  #undef PKW
  #undef PAF
  #undef VFR
  #undef PIN
  #undef MX3
  #undef GAPA
  #undef GAPB
  #undef EX
  #undef VRD
  #undef KRD
  #undef STEP
  #undef ENDW
  {auto rr=__builtin_amdgcn_permlane32_swap(__float_as_uint(l_reg),__float_as_uint(l_reg),false,false);l_reg=__uint_as_float(rr[0])+__uint_as_float(rr[1]);}
  if(hi==0)wsf[32+r32]=l_reg;asm volatile("s_waitcnt lgkmcnt(0)":::"memory");
  float rli[16];
  #pragma unroll
  for(int r=0;r<16;++r)rli[r]=__builtin_amdgcn_rcpf(wsf[32+crow(r,hi)]);
  bf16*Ow=O+(rowbase+q0+wid*QBLK)*OP+OCOL+h*D;
  { bf16*stg=(bf16*)(shm+LDS_OST)+wid*2048;
    #pragma unroll
    for(int r=0;r<16;++r){const int orow=crow(r,hi);
      #pragma unroll
      for(int d0=0;d0<2;++d0)stg[orow*64+d0*32+r32]=__float2bfloat16(o[d0][r]*rli[r]);}
    asm volatile("s_waitcnt lgkmcnt(0)":::"memory");
    #pragma unroll
    for(int i=0;i<4;++i){const int row=i*8+(lane>>3),ch=lane&7; const u32x4 v=*(const u32x4*)(stg+row*64+ch*8); ATTN_STORE16(Ow+(long)row*OP+ch*8,v);} }
  asm volatile("s_waitcnt lgkmcnt(0)\n\ts_barrier":::"memory");
  #undef DMA_K
  #undef DMA_V
  #undef START
  #undef RESC
  #undef ROT
}
constexpr int ATTN_LDS_BYTES=LDS_BYTES;
#undef SBAR
#undef WAIT_BAR
}
constexpr int NWAVES = 8;
constexpr int BATCH = 8, SEQ = 4096, DM = 1024, T = BATCH * SEQ;
constexpr int GLA_H = 4, GLA_DK = 64, GLA_DV = 128, GLA_RANK = 16;
constexpr int ATT_H = 8, ATT_KVH = 2, ATT_DH = 64;
constexpr int D_IN = 2336, D_IN_PAD = 2560;
constexpr int NEXP = 32, TOPK = 4, DFF = 1024;
constexpr int EROWS = 32768;
constexpr int PROWS = T * TOPK + NEXP * 256;
constexpr float EPS = 1e-6f;
constexpr float YSCALE = 16.f;
constexpr float WSCALE = 32.f, ASCALE = 4.f;

constexpr size_t MiB = 1u << 20;
constexpr size_t WS_CTL = 0, CTL_ZERO_BYTES = 1 * MiB;
constexpr size_t WS_WRH = 1 * MiB, WS_WRL = WS_WRH + 65536;
constexpr size_t WS_WIN = 2 * MiB;
constexpr size_t WS_WOUT = 8 * MiB;
constexpr size_t WS_W1 = 10 * MiB;
constexpr size_t WS_W2 = 138 * MiB;
constexpr size_t WS_ROWTOK = 202 * MiB;
constexpr size_t WS_ROWGATE = 206 * MiB;
constexpr size_t WS_TOKASG = 210 * MiB;
constexpr size_t WS_REGY = 212 * MiB;
constexpr size_t WS_XN = WS_REGY;
constexpr size_t WS_GQ = WS_XN + 64 * MiB;
constexpr size_t WS_GK = WS_GQ + 16 * MiB;
constexpr size_t WS_GV = WS_GK + 16 * MiB;
constexpr size_t WS_GR = WS_GV + 32 * MiB;
constexpr size_t WS_AQ = WS_GR + 32 * MiB;
constexpr size_t WS_AK = WS_AQ + 32 * MiB;
constexpr size_t WS_AV = WS_AK + 8 * MiB;
constexpr size_t WS_Z = WS_AV + 8 * MiB;
constexpr size_t WS_OF = WS_Z + 2 * MiB;
constexpr size_t WS_Y = WS_REGY;
constexpr size_t WS_REGA = WS_REGY + 274 * MiB;
constexpr size_t WS_MIX = WS_REGA;
constexpr size_t WS_ACT = WS_REGA;
constexpr size_t WS_QF = WS_REGA + 272 * MiB, WS_KF = WS_QF + 16 * MiB, WS_QB = WS_KF + 16 * MiB, WS_KB = WS_QB + 16 * MiB;
constexpr size_t WS_DEC = WS_KB + 16 * MiB;
constexpr size_t WS_END = WS_DEC + 1 * MiB;
static_assert(WS_OF + (size_t)T * 512 * 4 <= WS_REGA && (size_t)PROWS * 1024 * 2 <= 272 * MiB, "d_ws map");
constexpr int CW_BAR = 4096;
constexpr int CW_CNT = 8192;
constexpr int CW_GDN = 16384;
constexpr int CW_QUE = 12288;

constexpr int SCR_BYTES = 133120;
constexpr int LC_OFF = SCR_BYTES;
constexpr int LC_MISC = LC_OFF;
constexpr int LC_CNT = LC_OFF + 128;
constexpr int LC_CST = LC_CNT + 128;
constexpr int LC_TE = LC_CST + 256;
constexpr int LC_HIST = LC_TE + 1152;
constexpr int LC_BASE = LC_HIST + 128;
constexpr int LC_ASG = LC_BASE + 128;
constexpr int LC_END = LC_ASG + 8192;
constexpr int LDS_BYTES = 147456;
static_assert(LC_END <= LDS_BYTES, "LDS map");

typedef unsigned short bf16;
typedef unsigned v4u __attribute__((ext_vector_type(4)));
typedef unsigned v2u __attribute__((ext_vector_type(2)));
typedef float f32x4 __attribute__((ext_vector_type(4)));
typedef short bf16x8 __attribute__((ext_vector_type(8)));
typedef GAS unsigned gu32;
#define RLX_AGENT __ATOMIC_RELAXED, __HIP_MEMORY_SCOPE_AGENT
#define LDS_WAIT() asm volatile("s_waitcnt lgkmcnt(0)" ::: "memory")
#define VM_WAIT() asm volatile("s_waitcnt vmcnt(0)" ::: "memory")
__device__ __forceinline__ unsigned f2bf(float f) { unsigned u = __builtin_bit_cast(unsigned, f); return (u + 0x7fffu + ((u >> 16) & 1u)) >> 16; }
__device__ __forceinline__ unsigned pk2(float lo, float hi) { return f2bf(lo) | (f2bf(hi) << 16); }
__device__ __forceinline__ float bf2f(unsigned h) { return __builtin_bit_cast(float, h << 16); }
__device__ __forceinline__ float bflo(unsigned w) { return __builtin_bit_cast(float, w << 16); }
__device__ __forceinline__ float bfhi(unsigned w) { return __builtin_bit_cast(float, w & 0xffff0000u); }

#define XB_TMO      128
#define XB_XCNT(j)  (256  + 64 * (j))
#define XB_XSUB(j)  (1280 + 64 * (j))
#define XB_XGEN(j)  (2304 + 64 * (j))
#define XB_TOP      3328
#define XB_TOPGEN   3392
#define XCD_BAR_WORDS 3456
#define XB_SPIN_CAP (1u << 18)
__device__ __forceinline__ unsigned xb_ld(unsigned* p)              { return __hip_atomic_load(p, __ATOMIC_RELAXED, __HIP_MEMORY_SCOPE_AGENT); }
__device__ __forceinline__ unsigned xb_add(unsigned* p, unsigned v) { return __hip_atomic_fetch_add(p, v, __ATOMIC_RELAXED, __HIP_MEMORY_SCOPE_AGENT); }
__device__ __forceinline__ unsigned xb_xcc_id() { return (unsigned)__builtin_amdgcn_s_getreg((3 << 11) | 20) & 0xFu; }
#define XB_SPIN(cond, bar) do { unsigned _sp = 0; while (cond) { __builtin_amdgcn_s_sleep(1); \
    if ((++_sp & 255u) == 0u) { if (xb_ld(&(bar)[XB_TMO])) break; if (_sp > XB_SPIN_CAP) { atomicAdd(&(bar)[XB_TMO], 1u); break; } } } } while (0)
struct XcdBarrier { unsigned* bar; unsigned x; volatile LAS unsigned* st; };
__device__ __forceinline__ XcdBarrier xcd_barrier_post(unsigned* bar, volatile LAS unsigned* st) {
    XcdBarrier b; b.bar = bar; b.x = xb_xcc_id(); b.st = st;
    if (threadIdx.x == 0) (void)xb_add(&bar[XB_XCNT(b.x)], 1u);
    return b;
}
__device__ __forceinline__ void xcd_barrier_complete(unsigned* bar, unsigned x, unsigned& nloc, unsigned& nx) {
    const unsigned G = gridDim.x * gridDim.y * gridDim.z;
    unsigned sum, cnt, mine, sp = 0u;
    for (;;) {
        sum = 0u; cnt = 0u; mine = 0u;
#pragma unroll
        for (unsigned j = 0; j < 16; ++j) { const unsigned c = xb_ld(&bar[XB_XCNT(j)]); sum += c; cnt += (c > 0u) ? 1u : 0u; mine = (j == x) ? c : mine; }
        if (sum == G) break;
        __builtin_amdgcn_s_sleep(1);
        if ((++sp & 255u) == 0u) { if (xb_ld(&bar[XB_TMO])) break; if (sp > XB_SPIN_CAP) { atomicAdd(&bar[XB_TMO], 1u); break; } }
    }
    nloc = mine > 0u ? mine : 1u; nx = cnt > 0u ? cnt : 1u;
}
__device__ __forceinline__ void xcd_barrier(const XcdBarrier& b) {
    asm volatile("s_waitcnt vmcnt(0)" ::: "memory");
    __syncthreads();
    if (threadIdx.x == 0) {
        unsigned* bar = b.bar;
        __builtin_amdgcn_s_waitcnt(0);
        unsigned nloc = b.st[0], nx = b.st[1];
        if (nloc == 0u) { xcd_barrier_complete(bar, b.x, nloc, nx); b.st[0] = nloc; b.st[1] = nx; }
        const unsigned old = xb_add(&bar[XB_XSUB(b.x)], 1u);
        const unsigned gen = old / nloc;
        if (old + 1u == (gen + 1u) * nloc) {
            __builtin_amdgcn_fence(__ATOMIC_RELEASE, "agent");
            asm volatile("s_waitcnt vmcnt(0)" ::: "memory");
            const unsigned og = xb_add(&bar[XB_TOP], 1u);
            const unsigned tg = og / nx;
            if (og + 1u == (tg + 1u) * nx) xb_add(&bar[XB_TOPGEN], 1u);
            else XB_SPIN(xb_ld(&bar[XB_TOPGEN]) == tg, bar);
            __builtin_amdgcn_fence(__ATOMIC_ACQUIRE, "agent");
            xb_add(&bar[XB_XGEN(b.x)], 1u);
            asm volatile("s_waitcnt vmcnt(0)" ::: "memory");
        } else {
            XB_SPIN(xb_ld(&bar[XB_XGEN(b.x)]) == gen, bar);
            __builtin_amdgcn_fence(__ATOMIC_ACQUIRE, "agent");
            asm volatile("s_waitcnt vmcnt(0)" ::: "memory");
        }
    }
    __syncthreads();
}

struct Frame {
    LAS unsigned char* lds;
    volatile LAS unsigned* MISC;
    gu32* ctl;
    int tid, lane, wave;
    int vcu, G;
    unsigned char* ws;
    const float *x, *mix_g, *w_in, *w_gf, *b_gf, *w_gb, *b_gb, *gla_hg, *q_g, *k_g, *w_out, *ffn_g, *w_router, *b_router, *w1, *b1, *w2, *b2, *fin_g;
    float* out;
};
__device__ __forceinline__ float wave_sum(float v) {
#pragma unroll
    for (int o = 1; o < 64; o <<= 1) v += __shfl_xor(v, o);
    return v;
}
__device__ __forceinline__ void p0_tr64(const float* src  , int ldw, bf16* d0, bf16* d1, int ldt, LAS float* scr, int lane, int ncols) {
    const int c4 = (lane & 15) * 4, kr = lane >> 4;
    if (c4 < ncols) {
#pragma unroll 4
        for (int i = 0; i < 16; ++i) { const int kk = kr + 4 * i; const f32x4 v = *(const GAS f32x4*)(src + (size_t)kk * ldw + c4);
            LAS float* s = scr + kk * 65 + c4; s[0] = v.x; s[1] = v.y; s[2] = v.z; s[3] = v.w; }
    }
    LDS_WAIT(); asm volatile("" ::: "memory");
    const int c = lane & 7;
#pragma unroll
    for (int j = 0; j < 8; ++j) { const int n = (lane >> 3) + 8 * j;
        if (n < ncols) { const LAS float* s = scr + (8 * c) * 65 + n;
            v4u o; o.x = pk2(s[0 * 65], s[1 * 65]); o.y = pk2(s[2 * 65], s[3 * 65]); o.z = pk2(s[4 * 65], s[5 * 65]); o.w = pk2(s[6 * 65], s[7 * 65]);
            bf16* rowp = (n < 32 ? d0 : d1) + (size_t)(n & 31) * ldt;
            *(GAS v4u*)(rowp + 8 * c) = o; } }
    LDS_WAIT(); asm volatile("" ::: "memory");
}
__device__ __forceinline__ void p0_tr64_f8(const float* src, int ldw, unsigned char* d0, unsigned char* d1, int ldt, LAS float* scr, int lane, float sc) {
    const int c4 = (lane & 15) * 4, kr = lane >> 4;
#pragma unroll 4
    for (int i = 0; i < 16; ++i) { const int kk = kr + 4 * i; const f32x4 v = *(const GAS f32x4*)(src + (size_t)kk * ldw + c4);
        LAS float* s = scr + kk * 65 + c4; s[0] = v.x; s[1] = v.y; s[2] = v.z; s[3] = v.w; }
    LDS_WAIT(); asm volatile("" ::: "memory");
    const int c = lane & 7;
#pragma unroll
    for (int j = 0; j < 8; ++j) { const int n = (lane >> 3) + 8 * j; const LAS float* s = scr + (8 * c) * 65 + n;
        int w0 = 0, w1 = 0;
        w0 = __builtin_amdgcn_cvt_pk_fp8_f32(s[0 * 65] * sc, s[1 * 65] * sc, w0, false); w0 = __builtin_amdgcn_cvt_pk_fp8_f32(s[2 * 65] * sc, s[3 * 65] * sc, w0, true);
        w1 = __builtin_amdgcn_cvt_pk_fp8_f32(s[4 * 65] * sc, s[5 * 65] * sc, w1, false); w1 = __builtin_amdgcn_cvt_pk_fp8_f32(s[6 * 65] * sc, s[7 * 65] * sc, w1, true);
        unsigned char* rowp = (n < 32 ? d0 : d1) + (size_t)(n & 31) * ldt;
        *(GAS v2u*)(rowp + 8 * c) = (v2u){(unsigned)w0, (unsigned)w1}; }
    LDS_WAIT(); asm volatile("" ::: "memory");
}
__device__ __forceinline__ int win_pblk(int lb) { return lb < 48 ? lb : (lb == 48 ? 72 : lb - 1); }
__device__ __forceinline__ int w1_pblk(int lb) { return lb < 32 ? (lb >> 2) * 8 + (lb & 3) : ((lb - 32) >> 2) * 8 + 4 + ((lb - 32) & 3); }
__device__ __forceinline__ void rms_row_to_bf16(const float* xrow, const float* g, bf16* orow, int lane) {
    const GAS f32x4* xr = (const GAS f32x4*)xrow + lane; const GAS f32x4* gr = (const GAS f32x4*)g + lane;
    f32x4 v[4]; float s = 0.f;
#pragma unroll
    for (int j = 0; j < 4; ++j) { v[j] = xr[64 * j]; s += (v[j].x * v[j].x + v[j].y * v[j].y) + (v[j].z * v[j].z + v[j].w * v[j].w); }
    const float rinv = 1.f / sqrtf(wave_sum(s) * (1.f / 1024.f) + EPS);
    GAS unsigned long long* o8 = (GAS unsigned long long*)orow + lane;
#pragma unroll
    for (int j = 0; j < 4; ++j) { const f32x4 gg = gr[64 * j];
        o8[64 * j] = (unsigned long long)pk2(v[j].x * rinv * gg.x, v[j].y * rinv * gg.y) | ((unsigned long long)pk2(v[j].z * rinv * gg.z, v[j].w * rinv * gg.w) << 32); }
}
__device__ __forceinline__ void p0_prologue(Frame& F) {
    LAS float* scr = (LAS float*)(F.lds + F.wave * 16640);
    const int gw = F.vcu * NWAVES + F.wave, NGW = F.G * NWAVES;
    bf16* WIN = (bf16*)(F.ws + WS_WIN); bf16* WOUT = (bf16*)(F.ws + WS_WOUT); unsigned char* W1T = F.ws + WS_W1; unsigned char* W2T = F.ws + WS_W2;
    constexpr int I_IN = 16 * 37, I_OUT = 16 * 16, I_1 = NEXP * 16 * 32, I_2 = NEXP * 16 * 16, NITEMS = I_IN + I_OUT + I_1 + I_2;
    for (int it = gw; it < NITEMS; it += NGW) {
        int r = it;
        if (r < I_IN) { const int kb = r / 37, nb = r % 37; const int lb0 = 2 * nb, nc = (nb == 36) ? 32 : 64;
            p0_tr64(F.w_in + (size_t)(64 * kb) * D_IN + 64 * nb, D_IN, WIN + (size_t)(32 * win_pblk(lb0)) * 1024 + 64 * kb, WIN + (size_t)(32 * win_pblk(lb0 + 1 < 73 ? lb0 + 1 : lb0)) * 1024 + 64 * kb, 1024, scr, F.lane, nc); continue; }
        r -= I_IN;
        if (r < I_OUT) { const int kb = r / 16, nb = r % 16;
            p0_tr64(F.w_out + (size_t)(64 * kb) * 1024 + 64 * nb, 1024, WOUT + (size_t)(64 * nb) * 1024 + 64 * kb, WOUT + (size_t)(64 * nb + 32) * 1024 + 64 * kb, 1024, scr, F.lane, 64); continue; }
        r -= I_OUT;
        if (r < I_1) { const int e = r / 512, q = r % 512, kb = q / 32, nb = q % 32; const float* src = F.w1 + (size_t)e * 1024 * 2048 + (size_t)(64 * kb) * 2048 + 64 * nb; unsigned char* dst = W1T + (size_t)e * 2048 * 1024 + 64 * kb;
            p0_tr64_f8(src, 2048, dst + (size_t)(32 * w1_pblk(2 * nb)) * 1024, dst + (size_t)(32 * w1_pblk(2 * nb + 1)) * 1024, 1024, scr, F.lane, WSCALE); continue; }
        r -= I_1;
        { const int e = r / 256, q = r % 256, kb = q / 16, nb = q % 16; const float* src = F.w2 + (size_t)e * 1024 * 1024 + (size_t)(64 * kb) * 1024 + 64 * nb; unsigned char* dst = W2T + (size_t)e * 1024 * 1024 + 64 * kb;
            p0_tr64_f8(src, 1024, dst + (size_t)(64 * nb) * 1024, dst + (size_t)(64 * nb + 32) * 1024, 1024, scr, F.lane, WSCALE); }
    }
    { const int gt = F.vcu * (NWAVES * 64) + F.tid, NGT = F.G * NWAVES * 64; GAS v4u* z = (GAS v4u*)(WIN + (size_t)D_IN * 1024);
      for (int i = gt; i < (D_IN_PAD - D_IN) * 1024 * 2 / 16; i += NGT) z[i] = (v4u){0u, 0u, 0u, 0u};
      bf16* WRH = (bf16*)(F.ws + WS_WRH); bf16* WRL = (bf16*)(F.ws + WS_WRL);
      for (int i = gt; i < NEXP * 1024; i += NGT) { const int e = i >> 10, k = i & 1023; const float w = F.w_router[(size_t)k * NEXP + e]; const unsigned h = f2bf(w); WRH[i] = (bf16)h; WRL[i] = (bf16)f2bf(w - bf2f(h)); } }
    bf16* XN = (bf16*)(F.ws + WS_XN);
    for (int m = gw; m < T; m += NGW) rms_row_to_bf16(F.x + (size_t)m * DM, F.mix_g, XN + (size_t)m * DM, F.lane);
}

__device__ __forceinline__ void p2_normrope(Frame& F) {
    LAS float* cs = (LAS float*)F.lds;
    for (int i = F.tid; i < 1024; i += NWAVES * 64) { const int pos = i >> 4, fi = i & 15; const float inv = exp2f(-(float)fi * (13.287712379549449f / 16.f)); const float a = (float)pos * inv;
        cs[2 * i] = __cosf(a); cs[2 * i + 1] = __sinf(a); }
    __syncthreads();
    const int gw = F.vcu * NWAVES + F.wave, NGW = F.G * NWAVES, lane = F.lane;
    const int j = lane & 7, blk = (j >> 2) & 1, jj = j & 3, fi0 = 8 * (jj & 1); const bool second = (jj >> 1) != 0;
    float gq[8], gk[8];
#pragma unroll
    for (int e = 0; e < 8; ++e) { gq[e] = F.q_g[8 * j + e]; gk[e] = F.k_g[8 * j + e]; }
    bf16* AQ = (bf16*)(F.ws + WS_AQ); bf16* AK = (bf16*)(F.ws + WS_AK);
    for (int it = T + gw; it < T + T / 4; it += NGW) {
        const bool isq = it < T;
        const int tok = isq ? it : 4 * (it - T) + (lane >> 4);
        GAS v4u* p = isq ? (GAS v4u*)(AQ + (size_t)tok * 512) + lane : (GAS v4u*)(AK + (size_t)tok * 128) + (lane & 15);
        const v4u w = *p;
        float x[8] = {bflo(w.x), bfhi(w.x), bflo(w.y), bfhi(w.y), bflo(w.z), bfhi(w.z), bflo(w.w), bfhi(w.w)};
        float ss = 0.f;
#pragma unroll
        for (int e = 0; e < 8; ++e) ss += x[e] * x[e];
        ss += __shfl_xor(ss, 1); ss += __shfl_xor(ss, 2); ss += __shfl_xor(ss, 4);
        const float rinv = 1.f / sqrtf(ss * (1.f / 64.f) + EPS);
        const int ts = tok & (SEQ - 1), pos = blk ? (ts & 63) : (ts >> 6);
        const LAS float* c = cs + (pos * 16 + fi0) * 2;
        float y[8];
#pragma unroll
        for (int e = 0; e < 8; ++e) { x[e] = x[e] * rinv * (isq ? gq[e] : gk[e]); }
#pragma unroll
        for (int e = 0; e < 8; ++e) { const float pr = __shfl_xor(x[e], 2); const float co = c[2 * e], si = c[2 * e + 1]; y[e] = second ? (x[e] * co + pr * si) : (x[e] * co - pr * si); }
        const float sc = isq ? attn_body::C2 : 1.f;
        v4u o; o.x = pk2(y[0] * sc, y[1] * sc); o.y = pk2(y[2] * sc, y[3] * sc); o.z = pk2(y[4] * sc, y[5] * sc); o.w = pk2(y[6] * sc, y[7] * sc);
        *p = o;
    }
}
namespace gla {
typedef short bf16x8 __attribute__((ext_vector_type(8)));
typedef short s16x4 __attribute__((ext_vector_type(4)));
typedef float f32x4 __attribute__((ext_vector_type(4)));
constexpr int P64 = 144, PV = 272, POT = 528;
constexpr int L_QS = 0, L_KS = 9216, L_VR = 18432, L_AS = 35840, L_ST = 45056, L_DEC = 63488, L_OT = 63744, L_END = 97536;
__device__ __forceinline__ unsigned cvtpk(float lo, float hi) { typedef float f2_t __attribute__((ext_vector_type(2))); typedef __bf16 b2_t __attribute__((ext_vector_type(2))); f2_t v = {lo, hi}; b2_t b = __builtin_convertvector(v, b2_t); return __builtin_bit_cast(unsigned, b); }
__device__ __forceinline__ float logsig(float x) { return fminf(x, 0.f) - __logf(1.f + __expf(-fabsf(x))); }
__device__ __forceinline__ s16x4 vtr(const LAS unsigned char* p) { typedef short v4i16_t __attribute__((ext_vector_type(4))); return __builtin_bit_cast(s16x4, __builtin_amdgcn_ds_read_tr16_b64_v4i16((LAS v4i16_t*)p)); }

__device__ __forceinline__ void gla_prep_unit(Frame& F, int b, int c) {
    LAS unsigned char* L = F.lds;
    const int tid = F.tid, dir = __builtin_amdgcn_readfirstlane(tid >> 8), col = tid & 255;
    const bf16* GQ = (const bf16*)(F.ws + WS_GQ); const bf16* GK = (const bf16*)(F.ws + WS_GK); const bf16* ZZ = (const bf16*)(F.ws + WS_Z);
    bf16* QX = (bf16*)(F.ws + (dir ? WS_QB : WS_QF)); bf16* KX = (bf16*)(F.ws + (dir ? WS_KB : WS_KF)); float* DEC = (float*)(F.ws + WS_DEC) + (size_t)dir * (BATCH * 64 * 256);
    const unsigned row0 = (unsigned)b * SEQ + (unsigned)c * 64u;
    __syncthreads();
    if (tid < 256) { const int row = tid >> 2, seg = tid & 3; const v4u z = *(const GAS v4u*)(ZZ + (row0 + row) * 32 + seg * 8); LAS f32x4* zp = (LAS f32x4*)(L + row * 128 + seg * 32);
        zp[0] = (f32x4){bflo(z.x), bfhi(z.x), bflo(z.y), bfhi(z.y)}; zp[1] = (f32x4){bflo(z.z), bfhi(z.z), bflo(z.w), bfhi(z.w)}; }
    float wg[16]; const float* WG = dir ? F.w_gb : F.w_gf;
#pragma unroll
    for (int r = 0; r < 16; ++r) wg[r] = WG[r * 256 + col];
    const float bgv = (dir ? F.b_gb : F.b_gf)[col];
    __syncthreads();
    float pf[64]; float run = 0.f;
#pragma unroll
    for (int p = 0; p < 64; ++p) { const LAS f32x4* zp = (const LAS f32x4*)(L + p * 128 + dir * 64); float pre = bgv;
#pragma unroll
        for (int r4 = 0; r4 < 4; ++r4) { const f32x4 z = zp[r4]; pre += z.x * wg[4 * r4] + z.y * wg[4 * r4 + 1] + z.z * wg[4 * r4 + 2] + z.w * wg[4 * r4 + 3]; }
        run += logsig(pre) * (1.f / 16.f); pf[p] = run; }
    const float tot = run;
#pragma unroll
    for (int p = 0; p < 64; ++p) { const unsigned idx = (row0 + p) * 256 + col;
        const float qv = bf2f(GQ[idx]), kv = bf2f(GK[idx]);
        const float ex = dir ? (p ? pf[p - 1] : 0.f) : 0.f;
        const float eq = dir ? __expf(-ex) * 0.125f : __expf(pf[p] - tot) * 0.125f;
        const float ek = dir ? __expf(ex) : __expf(tot - pf[p]);
        QX[idx] = (bf16)f2bf(qv * eq); KX[idx] = (bf16)f2bf(kv * ek); }
    DEC[((unsigned)b * 64 + c) * 256 + col] = __expf(tot);
}

__device__ __forceinline__ void gla_unit(Frame& F, int b, int h, int dir) {
    LAS unsigned char* L = F.lds;
    const int tid = F.tid, lane = F.lane, w = F.wave, q4 = lane >> 4, l15 = lane & 15;
    const bf16* GV = (const bf16*)(F.ws + WS_GV);
    bf16* OX = (bf16*)(F.ws + WS_OF + (dir ? 32 * MiB : 0));
    const unsigned rowbase = (unsigned)b * SEQ;
    const int v0 = 16 * w;
    const int erow = tid >> 3, eseg = tid & 7;
    const int plq = tid >> 3, sgq = tid & 7, plv = tid >> 4, sgv = tid & 15;
    {
        const bf16* QX = (const bf16*)(F.ws + (dir ? WS_QB : WS_QF)); const bf16* KX = (const bf16*)(F.ws + (dir ? WS_KB : WS_KF));
        const float* DEC = (const float*)(F.ws + WS_DEC) + (size_t)dir * (BATCH * 64 * 256);
        f32x4 S[4];
#pragma unroll
        for (int i = 0; i < 4; ++i) S[i] = (f32x4){0.f, 0.f, 0.f, 0.f};
        v4u rq, rk, rv0, rv1; float rdec = 0.f;
#define GLA_LOAD(ci) do { const int c_ = dir ? 63 - (ci) : (ci); const unsigned cb_ = rowbase + (unsigned)c_ * 64u; \
            rq = *(const GAS v4u*)(QX + (cb_ + plq) * 256 + h * 64 + sgq * 8); rk = *(const GAS v4u*)(KX + (cb_ + plq) * 256 + h * 64 + sgq * 8); \
            rv0 = *(const GAS v4u*)(GV + (cb_ + plv) * 512 + h * 128 + sgv * 8); rv1 = *(const GAS v4u*)(GV + (cb_ + plv + 32) * 512 + h * 128 + sgv * 8); \
            if (tid < 64) rdec = DEC[((unsigned)b * 64 + c_) * 256 + h * 64 + tid]; } while (0)
        GLA_LOAD(0);
        v4u st0 = (v4u){0u, 0u, 0u, 0u}, st1 = st0;
#define GLA_FLUSH(cprev) do { const unsigned cbp_ = rowbase + (unsigned)(cprev) * 64u; GAS v4u* sp_ = (GAS v4u*)(OX + (cbp_ + erow) * 512 + h * 128 + eseg * 16); sp_[0] = st0; sp_[1] = st1; } while (0)
        for (int ci = 0; ci < 64; ++ci) {
            const int c = dir ? 63 - ci : ci;
            *(LAS v4u*)(L + L_QS + plq * P64 + sgq * 16) = rq; *(LAS v4u*)(L + L_KS + plq * P64 + sgq * 16) = rk;
            *(LAS v4u*)(L + L_VR + plv * PV + sgv * 16) = rv0; *(LAS v4u*)(L + L_VR + (plv + 32) * PV + sgv * 16) = rv1;
            if (tid < 64) ((LAS float*)(L + L_DEC))[tid] = rdec;
            asm volatile("" ::: "memory");
            if (ci > 0) GLA_FLUSH(dir ? c + 1 : c - 1);
            asm volatile("" ::: "memory");
            if (ci + 1 < 64) GLA_LOAD(ci + 1);
            __syncthreads();
#pragma unroll
            for (int s = 0; s < 2; ++s) { const int tt = 2 * w + s, it = tt >> 2, jt = tt & 3; f32x4 a = (f32x4){0.f, 0.f, 0.f, 0.f};
#pragma unroll
                for (int ks = 0; ks < 2; ++ks) { const bf16x8 af = *(const LAS bf16x8*)(L + L_QS + (16 * it + l15) * P64 + (32 * ks + 8 * q4) * 2); const bf16x8 bfr = *(const LAS bf16x8*)(L + L_KS + (16 * jt + l15) * P64 + (32 * ks + 8 * q4) * 2);
                    a = __builtin_amdgcn_mfma_f32_16x16x32_bf16(af, bfr, a, 0, 0, 0); }
#pragma unroll
                for (int rg = 0; rg < 4; ++rg) { const int i = 16 * it + 4 * q4 + rg, j = 16 * jt + l15; const bool keep = dir ? (j > i) : (j <= i);
                    *(LAS unsigned short*)(L + L_AS + i * P64 + j * 2) = (unsigned short)cvtpk(keep ? a[rg] : 0.f, 0.f); } }
#pragma unroll
            for (int dt = 0; dt < 4; ++dt) { const f32x4 dv = *(const LAS f32x4*)(L + L_DEC + (16 * dt + 4 * q4) * 4); S[dt] = S[dt] * dv;
                *(LAS v2u*)(L + L_ST + (v0 + l15) * P64 + (16 * dt + 4 * q4) * 2) = (v2u){cvtpk(S[dt].x, S[dt].y), cvtpk(S[dt].z, S[dt].w)}; }
            __syncthreads();
            bf16x8 bv[2], bs[2];
#pragma unroll
            for (int ks = 0; ks < 2; ++ks) { const LAS unsigned char* vp = L + L_VR + (32 * ks + 8 * q4 + (l15 >> 2)) * PV + (v0 + 4 * (l15 & 3)) * 2;
                const s16x4 lo = vtr(vp), hi = vtr(vp + 4 * PV); bv[ks] = (bf16x8){lo[0], lo[1], lo[2], lo[3], hi[0], hi[1], hi[2], hi[3]};
                bs[ks] = *(const LAS bf16x8*)(L + L_ST + (v0 + l15) * P64 + (32 * ks + 8 * q4) * 2); }
            f32x4 O[4];
#pragma unroll
            for (int it = 0; it < 4; ++it) { O[it] = (f32x4){0.f, 0.f, 0.f, 0.f};
#pragma unroll
                for (int ks = 0; ks < 2; ++ks) { const bf16x8 aa = *(const LAS bf16x8*)(L + L_AS + (16 * it + l15) * P64 + (32 * ks + 8 * q4) * 2); const bf16x8 aq = *(const LAS bf16x8*)(L + L_QS + (16 * it + l15) * P64 + (32 * ks + 8 * q4) * 2);
                    O[it] = __builtin_amdgcn_mfma_f32_16x16x32_bf16(aa, bv[ks], O[it], 0, 0, 0); O[it] = __builtin_amdgcn_mfma_f32_16x16x32_bf16(aq, bs[ks], O[it], 0, 0, 0); } }
#pragma unroll
            for (int dt = 0; dt < 4; ++dt)
#pragma unroll
                for (int ks = 0; ks < 2; ++ks) { const LAS unsigned char* kp = L + L_KS + (32 * ks + 8 * q4 + (l15 >> 2)) * P64 + (16 * dt + 4 * (l15 & 3)) * 2;
                    const s16x4 lo = vtr(kp), hi = vtr(kp + 4 * P64); const bf16x8 ak = (bf16x8){lo[0], lo[1], lo[2], lo[3], hi[0], hi[1], hi[2], hi[3]};
                    S[dt] = __builtin_amdgcn_mfma_f32_16x16x32_bf16(ak, bv[ks], S[dt], 0, 0, 0); }
#pragma unroll
            for (int it = 0; it < 4; ++it)
#pragma unroll
                for (int rg = 0; rg < 4; ++rg) *(LAS float*)(L + L_OT + (16 * it + 4 * q4 + rg) * POT + (v0 + l15) * 4) = O[it][rg];
            __syncthreads();
            {
                float o[16];
#pragma unroll
                for (int e4 = 0; e4 < 4; ++e4) { const f32x4 t = *(const LAS f32x4*)(L + L_OT + erow * POT + (16 * eseg + 4 * e4) * 4); o[4 * e4] = t.x; o[4 * e4 + 1] = t.y; o[4 * e4 + 2] = t.z; o[4 * e4 + 3] = t.w; }
                st0 = (v4u){cvtpk(o[0], o[1]), cvtpk(o[2], o[3]), cvtpk(o[4], o[5]), cvtpk(o[6], o[7])}; st1 = (v4u){cvtpk(o[8], o[9]), cvtpk(o[10], o[11]), cvtpk(o[12], o[13]), cvtpk(o[14], o[15])};
            }
        }
        GLA_FLUSH(dir ? 0 : 63);
#undef GLA_FLUSH
#undef GLA_LOAD
    }
    VM_WAIT(); __syncthreads();
    if (tid == 0) { __builtin_amdgcn_fence(__ATOMIC_RELEASE, "agent"); VM_WAIT(); (void)__hip_atomic_fetch_add(F.ctl + CW_GDN + 64 * (b * GLA_H + h), 1u, RLX_AGENT); }
    __syncthreads();
}
__device__ __forceinline__ void gla_combine(Frame& F, int b, int h, int part) {
    const int tid = F.tid, erow = tid >> 3, eseg = tid & 7;
    if (tid == 0) { unsigned sp = 0; while (__hip_atomic_load(F.ctl + CW_GDN + 64 * (b * GLA_H + h), RLX_AGENT) < 2u && sp < (1u << 22)) { __builtin_amdgcn_s_sleep(8); ++sp; }
        __builtin_amdgcn_fence(__ATOMIC_ACQUIRE, "agent"); VM_WAIT(); }
    __syncthreads();
    const bf16* OF0 = (const bf16*)(F.ws + WS_OF); const bf16* OB0 = (const bf16*)(F.ws + WS_OF + 32 * MiB); const bf16* GR = (const bf16*)(F.ws + WS_GR); bf16* MIX = (bf16*)(F.ws + WS_MIX);
    float hg[16];
#pragma unroll
    for (int e = 0; e < 16; ++e) hg[e] = F.gla_hg[16 * eseg + e];
    const unsigned r0 = (unsigned)b * SEQ + (unsigned)part * 1024u + erow;
#pragma unroll 2
    for (int ps = 0; ps < 16; ++ps) { const unsigned row = r0 + ps * 64;
        const GAS v4u* fp = (const GAS v4u*)(OF0 + row * 512 + h * 128 + eseg * 16); const GAS v4u* bp = (const GAS v4u*)(OB0 + row * 512 + h * 128 + eseg * 16); const GAS v4u* rp = (const GAS v4u*)(GR + row * 512 + h * 128 + eseg * 16);
        const v4u f0 = fp[0], f1 = fp[1], b0 = bp[0], b1 = bp[1], r0v = rp[0], r1v = rp[1];
        const unsigned fw[8] = {f0.x, f0.y, f0.z, f0.w, f1.x, f1.y, f1.z, f1.w}, bw[8] = {b0.x, b0.y, b0.z, b0.w, b1.x, b1.y, b1.z, b1.w}, rw[8] = {r0v.x, r0v.y, r0v.z, r0v.w, r1v.x, r1v.y, r1v.z, r1v.w};
        float o[16]; float ss = 0.f;
#pragma unroll
        for (int e2 = 0; e2 < 8; ++e2) { o[2 * e2] = bflo(fw[e2]) + bflo(bw[e2]); o[2 * e2 + 1] = bfhi(fw[e2]) + bfhi(bw[e2]); ss += o[2 * e2] * o[2 * e2] + o[2 * e2 + 1] * o[2 * e2 + 1]; }
        ss += __shfl_xor(ss, 1); ss += __shfl_xor(ss, 2); ss += __shfl_xor(ss, 4);
        const float rinv = __builtin_amdgcn_rsqf(ss * (1.f / 128.f) + EPS);
        unsigned ow[8];
#pragma unroll
        for (int e2 = 0; e2 < 8; ++e2) { const float x0 = bflo(rw[e2]), x1 = bfhi(rw[e2]);
            const float y0 = o[2 * e2] * rinv * hg[2 * e2] * (x0 * __builtin_amdgcn_rcpf(1.f + __expf(-x0))), y1 = o[2 * e2 + 1] * rinv * hg[2 * e2 + 1] * (x1 * __builtin_amdgcn_rcpf(1.f + __expf(-x1))); ow[e2] = cvtpk(y0, y1); }
        GAS v4u* mp = (GAS v4u*)(MIX + row * 1024 + h * 128 + eseg * 16);
        mp[0] = (v4u){ow[0], ow[1], ow[2], ow[3]}; mp[1] = (v4u){ow[4], ow[5], ow[6], ow[7]}; }
}
}
struct DenseMap { static constexpr bool GATHER = false;
    const bf16* A; const bf16* Bt; int K;
    __device__ __forceinline__ __amdgpu_buffer_rsrc_t a_rsrc() const { return __builtin_amdgcn_make_buffer_rsrc((void*)A, 0, 0x7fffffff, 0x00020000); }
    __device__ __forceinline__ __amdgpu_buffer_rsrc_t b_rsrc() const { return __builtin_amdgcn_make_buffer_rsrc((void*)Bt, 0, 0x7fffffff, 0x00020000); }
    __device__ __forceinline__ unsigned a_soff(const pg8::Unit& u) const { return (unsigned)u.pm * 256u * (unsigned)K * 2u; }
    __device__ __forceinline__ unsigned b_soff(const pg8::Unit& u) const { return (unsigned)u.pn * 256u * (unsigned)K * 2u; }
    __device__ __forceinline__ void a_off(const pg8::Unit&, const int (&R)[2], const int (&C)[2], unsigned (&vo)[2][2]) const {
#pragma unroll
        for (int h = 0; h < 2; ++h)
#pragma unroll
            for (int i = 0; i < 2; ++i) vo[h][i] = (unsigned)((h * 128 + R[i]) * K + C[i]) * 2u; }
};
struct MoeTabs { const LAS int* cnt; const LAS int* cst; const LAS unsigned short* te; };
struct MoeMapUp { static constexpr bool GATHER = true;
    const unsigned char* A; const unsigned char* Bt; const int* rowtok; MoeTabs tb;
    __device__ __forceinline__ __amdgpu_buffer_rsrc_t a_rsrc() const { return __builtin_amdgcn_make_buffer_rsrc((void*)A, 0, 0x7fffffff, 0x00020000); }
    __device__ __forceinline__ __amdgpu_buffer_rsrc_t b_rsrc() const { return __builtin_amdgcn_make_buffer_rsrc((void*)Bt, 0, 0x7fffffff, 0x00020000); }
    __device__ __forceinline__ unsigned a_soff(const pg8::Unit&) const { return 0u; }
    __device__ __forceinline__ unsigned b_soff(const pg8::Unit& u) const { const unsigned e = tb.te[u.pm]; return (e * 2048u + (unsigned)u.pn * 256u) * 1024u; }
    __device__ __forceinline__ void a_raw(const pg8::Unit& u, const int (&R)[2], unsigned (&raw)[2][2]) const {
        const int e = tb.te[u.pm], pos0 = (u.pm - tb.cst[e]) * 256, n = tb.cnt[e];
#pragma unroll
        for (int h = 0; h < 2; ++h)
#pragma unroll
            for (int i = 0; i < 2; ++i) { const int pos = pos0 + h * 128 + R[i]; raw[h][i] = (unsigned)rowtok[(size_t)e * EROWS + (pos < n ? pos : 0)]; } }
    __device__ __forceinline__ unsigned a_fin(unsigned tok, int C) const { return (tok * 512u + (unsigned)C) * 2u; }
    __device__ __forceinline__ void a_off(const pg8::Unit& u, const int (&R)[2], const int (&C)[2], unsigned (&vo)[2][2]) const {
        unsigned raw[2][2]; a_raw(u, R, raw);
#pragma unroll
        for (int h = 0; h < 2; ++h)
#pragma unroll
            for (int i = 0; i < 2; ++i) vo[h][i] = a_fin(raw[h][i], C[i]); }
};
struct MoeMapDown { static constexpr bool GATHER = false;
    const unsigned char* A; const unsigned char* Bt; MoeTabs tb;
    __device__ __forceinline__ __amdgpu_buffer_rsrc_t a_rsrc() const { return __builtin_amdgcn_make_buffer_rsrc((void*)A, 0, 0x7fffffff, 0x00020000); }
    __device__ __forceinline__ __amdgpu_buffer_rsrc_t b_rsrc() const { return __builtin_amdgcn_make_buffer_rsrc((void*)Bt, 0, 0x7fffffff, 0x00020000); }
    __device__ __forceinline__ unsigned a_soff(const pg8::Unit& u) const { return (unsigned)u.pm * 256u * 1024u; }
    __device__ __forceinline__ unsigned b_soff(const pg8::Unit& u) const { const unsigned e = tb.te[u.pm]; return (e * 1024u + (unsigned)u.pn * 256u) * 1024u; }
    __device__ __forceinline__ void a_off(const pg8::Unit&, const int (&R)[2], const int (&C)[2], unsigned (&vo)[2][2]) const {
#pragma unroll
        for (int h = 0; h < 2; ++h)
#pragma unroll
            for (int i = 0; i < 2; ++i) vo[h][i] = (unsigned)((h * 128 + R[i]) * 512 + C[i]) * 2u; }
};
using pg8::f32x4;
struct EpiInProj { static constexpr bool PERM = true, COLS64 = false;
    bf16 *gq, *gk, *gv, *gr, *aq, *ak, *av, *z;
    struct Pre {}; __device__ __forceinline__ void preload(const pg8::Unit&, int, int, int, int, Pre&) const {}
    __device__ __forceinline__ void operator()(const f32x4 (&acc)[2][2][4][2], const pg8::Unit& u, const Pre&, int wr, int wc, int fr, int fq) const {
        bf16* b0; bf16* b1; int ld;
        switch (u.pn) { case 0: b0 = gq; b1 = gq + 128; ld = 256; break; case 1: b0 = gk; b1 = gk + 128; ld = 256; break;
            case 2: b0 = gv; b1 = gv + 128; ld = 512; break; case 3: b0 = gv + 256; b1 = gv + 384; ld = 512; break;
            case 4: b0 = gr; b1 = gr + 128; ld = 512; break; case 5: b0 = gr + 256; b1 = gr + 384; ld = 512; break;
            case 6: b0 = aq; b1 = aq + 128; ld = 512; break; case 7: b0 = aq + 256; b1 = aq + 384; ld = 512; break;
            case 8: b0 = ak; b1 = av; ld = 128; break; default: b0 = z; b1 = z; ld = 32; break; }
        const bool zt = (u.pn == 9);
        if (zt && wc != 0) return;
        const int row0 = u.pm * 256 + wr * 64 + fr, cw = wc * 32 + 8 * fq;
#pragma unroll
        for (int ai = 0; ai < 2; ++ai)
#pragma unroll
            for (int m = 0; m < 4; ++m) { const size_t row = (size_t)(row0 + ai * 128 + m * 16);
#pragma unroll
                for (int bj = 0; bj < 2; ++bj) { if (zt && bj == 1) continue; const f32x4 v0 = acc[ai][bj][m][0], v1 = acc[ai][bj][m][1];
                    pg8::u32x4 wv; wv.x = pg8::cvt_pk_bf16(v0[0], v0[1]); wv.y = pg8::cvt_pk_bf16(v0[2], v0[3]); wv.z = pg8::cvt_pk_bf16(v1[0], v1[1]); wv.w = pg8::cvt_pk_bf16(v1[2], v1[3]);
                    *(pg8::u32x4*)((bj ? b1 : b0) + row * ld + cw) = wv; } }
    }
};
struct EpiResF32 { static constexpr bool PERM = false, COLS64 = false;
    const float* base; float* out;
    struct Pre {}; __device__ __forceinline__ void preload(const pg8::Unit&, int, int, int, int, Pre&) const {}
    __device__ __forceinline__ void operator()(const f32x4 (&acc)[2][2][4][2], const pg8::Unit& u, const Pre&, int wr, int wc, int fr, int fq) const {
        const int col0 = u.pn * 256 + wc * 32 + 4 * fq;
#pragma unroll
        for (int ai = 0; ai < 2; ++ai)
#pragma unroll
            for (int m = 0; m < 4; ++m) { const size_t off = (size_t)(u.pm * 256 + ai * 128 + wr * 64 + m * 16 + fr) * 1024 + col0;
#pragma unroll
                for (int bj = 0; bj < 2; ++bj)
#pragma unroll
                    for (int n = 0; n < 2; ++n) { const f32x4 bs = *(const f32x4*)(base + off + bj * 128 + n * 16); *(f32x4*)(out + off + bj * 128 + n * 16) = bs + acc[ai][bj][m][n]; } }
    }
};
struct EpiSwiglu { static constexpr bool PERM = true, COLS64 = false;
    const float* b1; unsigned char* act; MoeTabs tb;
    struct Pre { f32x4 g0, g1, l0, l1; };
    __device__ __forceinline__ void preload(const pg8::Unit& u, int wr, int wc, int fr, int fq, Pre& p) const {
        const int e = tb.te[u.pm]; const int col = u.pn * 128 + wc * 32 + 8 * fq; const float* bg = b1 + (size_t)e * 2048 + col; const float* bl = bg + 1024;
        p.g0 = *(const GAS f32x4*)bg; p.g1 = *(const GAS f32x4*)(bg + 4); p.l0 = *(const GAS f32x4*)bl; p.l1 = *(const GAS f32x4*)(bl + 4); }
    __device__ __forceinline__ void operator()(const f32x4 (&acc)[2][2][4][2], const pg8::Unit& u, const Pre& p, int wr, int wc, int fr, int fq) const {
        const int col = u.pn * 128 + wc * 32 + 8 * fq;
        const f32x4 g0 = p.g0, g1 = p.g1, l0 = p.l0, l1 = p.l1;
        const int row0 = u.pm * 256 + wr * 64 + fr;
#pragma unroll
        for (int ai = 0; ai < 2; ++ai)
#pragma unroll
            for (int m = 0; m < 4; ++m) { float o[8];
#pragma unroll
                for (int n = 0; n < 2; ++n)
#pragma unroll
                    for (int j = 0; j < 4; ++j) { const float gl = fminf(__builtin_fmaf(acc[ai][0][m][n][j], 1.f / WSCALE, (n ? g1[j] : g0[j])), 7.f); const float li = __builtin_amdgcn_fmed3f(__builtin_fmaf(acc[ai][1][m][n][j], 1.f / WSCALE, (n ? l1[j] : l0[j])), -7.f, 7.f);
                        o[4 * n + j] = (gl * ASCALE) * __builtin_amdgcn_rcpf(1.f + __builtin_amdgcn_exp2f(gl * (-1.702f * 1.4426950408889634f))) * (li + 1.f); }
                int w0 = 0, w1 = 0;
                w0 = __builtin_amdgcn_cvt_pk_fp8_f32(o[0], o[1], w0, false); w0 = __builtin_amdgcn_cvt_pk_fp8_f32(o[2], o[3], w0, true); w1 = __builtin_amdgcn_cvt_pk_fp8_f32(o[4], o[5], w1, false); w1 = __builtin_amdgcn_cvt_pk_fp8_f32(o[6], o[7], w1, true);
                *(v2u*)(act + (size_t)(row0 + ai * 128 + m * 16) * 1024 + col) = (v2u){(unsigned)w0, (unsigned)w1}; }
    }
};
struct EpiDown { static constexpr bool PERM = true, COLS64 = true;
    const float* b2; const float* rowgate; unsigned char* y; MoeTabs tb;
    struct Pre { f32x4 bv[2][2]; float gt[8]; };
    __device__ __forceinline__ void preload(const pg8::Unit& u, int wr, int wc, int fr, int fq, Pre& p) const {
        const int e = tb.te[u.pm], pos0 = (u.pm - tb.cst[e]) * 256, n_e = tb.cnt[e];
        const float* bb = b2 + (size_t)e * 1024 + u.pn * 256 + wc * 64 + 8 * fq;
#pragma unroll
        for (int bj = 0; bj < 2; ++bj)
#pragma unroll
            for (int n = 0; n < 2; ++n) p.bv[bj][n] = *(const GAS f32x4*)(bb + bj * 32 + 4 * n);
#pragma unroll
        for (int ai = 0; ai < 2; ++ai)
#pragma unroll
            for (int m = 0; m < 4; ++m) { const int pos = pos0 + wr * 64 + fr + ai * 128 + m * 16; const int pc_ = pos < n_e ? pos : 0; const float g = rowgate[(size_t)e * EROWS + pc_]; p.gt[ai * 4 + m] = (pos < n_e) ? g * YSCALE : 0.f; }
    }
    __device__ __forceinline__ void operator()(const f32x4 (&acc)[2][2][4][2], const pg8::Unit& u, const Pre& p, int wr, int wc, int fr, int fq) const {
        const bool odd = (fq & 1) != 0;
        const int colb = u.pn * 256 + wc * 64 + (odd ? 32 + 8 * (fq - 1) : 8 * fq), rl0 = wr * 64 + fr;
#pragma unroll
        for (int ai = 0; ai < 2; ++ai)
#pragma unroll
            for (int m = 0; m < 4; ++m) { const int rl = rl0 + ai * 128 + m * 16; const float gt = p.gt[ai * 4 + m];
                unsigned w[2][2];
#pragma unroll
                for (int bj = 0; bj < 2; ++bj) { const f32x4 v0 = (acc[ai][bj][m][0] * (1.f / (WSCALE * ASCALE)) + p.bv[bj][0]) * gt, v1 = (acc[ai][bj][m][1] * (1.f / (WSCALE * ASCALE)) + p.bv[bj][1]) * gt;
                    int w0 = 0, w1 = 0;
                    w0 = __builtin_amdgcn_cvt_pk_fp8_f32(v0[0], v0[1], w0, false); w0 = __builtin_amdgcn_cvt_pk_fp8_f32(v0[2], v0[3], w0, true); w1 = __builtin_amdgcn_cvt_pk_fp8_f32(v1[0], v1[1], w1, false); w1 = __builtin_amdgcn_cvt_pk_fp8_f32(v1[2], v1[3], w1, true);
                    w[bj][0] = (unsigned)w0; w[bj][1] = (unsigned)w1; }
                const unsigned s0 = odd ? w[0][0] : w[1][0], s1 = odd ? w[0][1] : w[1][1];
                const unsigned r0 = (unsigned)__shfl_xor((int)s0, 16), r1 = (unsigned)__shfl_xor((int)s1, 16);
                const pg8::u32x4 ov = odd ? (pg8::u32x4){r0, r1, w[1][0], w[1][1]} : (pg8::u32x4){w[0][0], w[0][1], r0, r1};
                *(pg8::u32x4*)(y + (size_t)(u.pm * 256 + rl) * 1024 + colb) = ov; }
    }
};
__device__ __forceinline__ int moe_tables(Frame& F) {
    LAS int* cnt = (LAS int*)(F.lds + LC_CNT); LAS int* cst = (LAS int*)(F.lds + LC_CST); LAS unsigned short* te = (LAS unsigned short*)(F.lds + LC_TE);
    __syncthreads();
    if (F.tid < NEXP) cnt[F.tid] = (int)__hip_atomic_load(F.ctl + CW_CNT + 64 * F.tid, RLX_AGENT);
    __syncthreads();
    if (F.tid == 0) { int s = 0; for (int e = 0; e < NEXP; ++e) { cst[e] = s; s += (cnt[e] + 255) >> 8; } cst[NEXP] = s; }
    __syncthreads();
    const int nt = cst[NEXP];
    for (int t = F.tid; t < nt; t += NWAVES * 64) { int e = 0;
#pragma unroll 1
        for (int k = 1; k < NEXP; ++k) e = (t >= cst[k]) ? k : e;
        te[t] = (unsigned short)e; }
    __syncthreads();
    return nt;
}
__device__ __forceinline__ void p3_mixers(Frame& F) {
    for (int u = blockIdx.x; u < 2 * BATCH * GLA_H; u += F.G) gla::gla_unit(F, u & 7, (u >> 3) & 3, u >> 5);
    const attn_body::bf16* Q = (const attn_body::bf16*)(F.ws + WS_AQ); const attn_body::bf16* K = (const attn_body::bf16*)(F.ws + WS_AK); const attn_body::bf16* V = (const attn_body::bf16*)(F.ws + WS_AV);
    attn_body::bf16* O = (attn_body::bf16*)(F.ws + WS_MIX);
    const int x0 = blockIdx.x & 7;
    for (int qi = 0; qi < 8; ++qi) { const int x = (x0 + qi) & 7;
        for (;;) {
            __syncthreads();
            if (F.tid == 0) F.MISC[16] = __hip_atomic_fetch_add(F.ctl + CW_QUE + 64 * x, 1u, RLX_AGENT);
            __syncthreads();
            const int item = __builtin_amdgcn_readfirstlane((int)F.MISC[16]);
            if (item >= ATT_H * attn_body::NQB + 4 * GLA_H) break;
            if (item >= ATT_H * attn_body::NQB) { const int k = item - ATT_H * attn_body::NQB; gla::gla_combine(F, x, k >> 2, k & 3); continue; }
            attn_body::attn_unit<8>(x, item >> 4, item & 15, Q, K, V, O, (char*)F.lds, F.q_g);
        }
    }
}

__device__ __forceinline__ void p5_route(Frame& F) {
    typedef float f32x16 __attribute__((ext_vector_type(16)));
    LAS unsigned char* L = F.lds;
    constexpr int XP = 2064, L_XH = 0, L_XL = 32 * XP, L_PART = 0;
    const int tid = F.tid, lane = F.lane, w = F.wave, r32 = lane & 31, hi = lane >> 5;
    const bf16* WRH = (const bf16*)(F.ws + WS_WRH); const bf16* WRL = (const bf16*)(F.ws + WS_WRL);
    unsigned char* XN8 = F.ws + WS_XN;
    int* ROWTOK = (int*)(F.ws + WS_ROWTOK); float* ROWGATE = (float*)(F.ws + WS_ROWGATE); int* TOKASG = (int*)(F.ws + WS_TOKASG);
    gu32* CNT = F.ctl + CW_CNT;
    bf16x8 wh[8], wl[8];
#pragma unroll
    for (int ks = 0; ks < 8; ++ks) { const int k0 = 128 * w + 16 * ks + 8 * hi; wh[ks] = *(const GAS bf16x8*)(WRH + r32 * 1024 + k0); wl[ks] = *(const GAS bf16x8*)(WRL + r32 * 1024 + k0); }
    f32x4 g2[4];
#pragma unroll
    for (int j = 0; j < 4; ++j) g2[j] = *((const GAS f32x4*)F.ffn_g + lane + 64 * j);
    float brt[16];
#pragma unroll
    for (int r = 0; r < 16; ++r) brt[r] = F.b_router[(r & 3) + 8 * (r >> 2) + 4 * hi];
    LAS int* hist = (LAS int*)(L + LC_HIST); LAS int* basev = (LAS int*)(L + LC_BASE); LAS int* aep = (LAS int*)(L + LC_ASG); LAS float* agt = (LAS float*)(L + LC_ASG + 4096);
    constexpr int NGRP = T / 32;
    const int per = (NGRP + F.G - 1) / F.G, g0 = F.vcu * per, g1 = (g0 + per < NGRP) ? g0 + per : NGRP;
    for (int gb = g0; gb < g1; gb += 8) {
        const int nb = (g1 - gb < 8) ? g1 - gb : 8;
        __syncthreads();
        if (tid < NEXP) hist[tid] = 0;
        for (int bi = 0; bi < nb; ++bi) {
            const int t0 = 32 * (gb + bi);
            f32x4 hv[4][4];
#pragma unroll
            for (int rr = 0; rr < 4; ++rr) { const GAS f32x4* hp = (const GAS f32x4*)(F.out + (size_t)(t0 + 4 * w + rr) * 1024) + lane;
#pragma unroll
                for (int j = 0; j < 4; ++j) hv[rr][j] = hp[64 * j]; }
#pragma unroll
            for (int rr = 0; rr < 4; ++rr) { const int r = 4 * w + rr; const size_t tok = (size_t)(t0 + r);
                f32x4 v[4]; float s = 0.f;
#pragma unroll
                for (int j = 0; j < 4; ++j) { v[j] = hv[rr][j]; s += (v[j].x * v[j].x + v[j].y * v[j].y) + (v[j].z * v[j].z + v[j].w * v[j].w); }
                const float rinv = 1.f / sqrtf(wave_sum(s) * (1.f / 1024.f) + EPS);
                GAS unsigned* o4 = (GAS unsigned*)(XN8 + tok * 1024) + lane;
#pragma unroll
                for (int j = 0; j < 4; ++j) { const f32x4 xn = v[j] * rinv * g2[j];
                    const unsigned h0 = f2bf(xn.x), h1 = f2bf(xn.y), h2 = f2bf(xn.z), h3 = f2bf(xn.w);
                    const unsigned l0 = f2bf(xn.x - bf2f(h0)), l1 = f2bf(xn.y - bf2f(h1)), l2 = f2bf(xn.z - bf2f(h2)), l3 = f2bf(xn.w - bf2f(h3));
                    const v2u hw = (v2u){h0 | (h1 << 16), h2 | (h3 << 16)}, lw = (v2u){l0 | (l1 << 16), l2 | (l3 << 16)};
                    { int q8 = 0; q8 = __builtin_amdgcn_cvt_pk_fp8_f32(xn.x, xn.y, q8, false); q8 = __builtin_amdgcn_cvt_pk_fp8_f32(xn.z, xn.w, q8, true); o4[64 * j] = (unsigned)q8; }
                    *(LAS v2u*)(L + L_XH + r * XP + (4 * lane + 256 * j) * 2) = hw; *(LAS v2u*)(L + L_XL + r * XP + (4 * lane + 256 * j) * 2) = lw; } }
            __syncthreads();
            f32x16 acc = {};
#pragma unroll
            for (int ks = 0; ks < 8; ++ks) { const int k0 = 128 * w + 16 * ks + 8 * hi;
                const bf16x8 xh = *(const LAS bf16x8*)(L + L_XH + r32 * XP + k0 * 2), xl = *(const LAS bf16x8*)(L + L_XL + r32 * XP + k0 * 2);
                acc = __builtin_amdgcn_mfma_f32_32x32x16_bf16(wh[ks], xh, acc, 0, 0, 0); acc = __builtin_amdgcn_mfma_f32_32x32x16_bf16(wh[ks], xl, acc, 0, 0, 0); acc = __builtin_amdgcn_mfma_f32_32x32x16_bf16(wl[ks], xh, acc, 0, 0, 0); }
            __syncthreads();
#pragma unroll
            for (int r = 0; r < 16; ++r) { const int e = (r & 3) + 8 * (r >> 2) + 4 * hi; ((LAS float*)(L + L_PART))[(w * 32 + e) * 32 + r32] = acc[r]; }
            __syncthreads();
            if (w == 0) {
                float v[16];
#pragma unroll
                for (int r = 0; r < 16; ++r) { const int e = (r & 3) + 8 * (r >> 2) + 4 * hi; float s = brt[r];
#pragma unroll
                    for (int ww = 0; ww < 8; ++ww) s += ((const LAS float*)(L + L_PART))[(ww * 32 + e) * 32 + r32];
                    v[r] = s; }
                float cv[8]; int cidx[8];
#pragma unroll
                for (int s = 0; s < 4; ++s) { float m = -INFINITY; int mr = 0;
#pragma unroll
                    for (int r = 0; r < 16; ++r) { if (v[r] > m) { m = v[r]; mr = r; } }
                    cv[s] = m; cidx[s] = (mr & 3) + 8 * (mr >> 2) + 4 * hi;
#pragma unroll
                    for (int r = 0; r < 16; ++r) v[r] = (r == mr) ? -INFINITY : v[r]; }
#pragma unroll
                for (int s = 0; s < 4; ++s) { cv[4 + s] = __shfl_xor(cv[s], 32); cidx[4 + s] = __shfl_xor(cidx[s], 32); }
                float tv[4]; int ti[4];
#pragma unroll
                for (int s = 0; s < 4; ++s) { float m = -INFINITY; int mi = 1 << 20; int mc = 0;
#pragma unroll
                    for (int c = 0; c < 8; ++c) { const bool better = (cv[c] > m) || (cv[c] == m && cidx[c] < mi); if (better) { m = cv[c]; mi = cidx[c]; mc = c; } }
                    tv[s] = m; ti[s] = mi;
#pragma unroll
                    for (int c = 0; c < 8; ++c) cv[c] = (c == mc) ? -INFINITY : cv[c]; }
                const float e1 = __expf(tv[1] - tv[0]), e2 = __expf(tv[2] - tv[0]), e3 = __expf(tv[3] - tv[0]); const float inv = 1.f / (1.f + e1 + e2 + e3);
                const float gt[4] = {inv, e1 * inv, e2 * inv, e3 * inv};
                if (hi == 0) {
#pragma unroll
                    for (int s = 0; s < 4; ++s) { const int rank = (int)__hip_atomic_fetch_add(hist + ti[s], 1, __ATOMIC_RELAXED, __HIP_MEMORY_SCOPE_WORKGROUP); const int idx = (bi * 32 + r32) * 4 + s; aep[idx] = (ti[s] << 16) | rank; agt[idx] = gt[s]; } }
            }
            __syncthreads();
        }
        if (tid < NEXP) { const int hc = hist[tid]; basev[tid] = hc ? (int)__hip_atomic_fetch_add(CNT + 64 * tid, (unsigned)hc, RLX_AGENT) : 0; }
        __syncthreads();
        for (int idx = tid; idx < nb * 128; idx += NWAVES * 64) { const int ep = aep[idx], e = ep >> 16, pos = basev[e] + (ep & 0xffff); const int tok = 32 * gb + (idx >> 2), s = idx & 3;
            ROWTOK[(size_t)e * EROWS + pos] = tok; ROWGATE[(size_t)e * EROWS + pos] = agt[idx]; TOKASG[tok * 4 + s] = e * EROWS + pos; }
    }
    __syncthreads();
}

__device__ __forceinline__ void p8_combine(Frame& F) {
    const LAS int* cst = (const LAS int*)(F.lds + LC_CST);
    const int gw = F.vcu * NWAVES + F.wave, NGW = F.G * NWAVES, lane = F.lane;
    const int* TOKASG = (const int*)(F.ws + WS_TOKASG); const unsigned char* Y = F.ws + WS_Y;
    f32x4 fg[4];
#pragma unroll
    for (int j = 0; j < 4; ++j) fg[j] = *((const GAS f32x4*)F.fin_g + lane + 64 * j);
    for (int tok = gw; tok < T; tok += NGW) {
        const int a = TOKASG[tok * 4 + (lane & 3)];
        const int crow = cst[a >> 15] * 256 + (a & (EROWS - 1));
        GAS f32x4* hp = (GAS f32x4*)(F.out + (size_t)tok * 1024) + lane; f32x4 v[4];
#pragma unroll
        for (int j = 0; j < 4; ++j) v[j] = hp[64 * j];
#pragma unroll
        for (int s = 0; s < 4; ++s) { const int cr = __shfl(crow, s); const GAS unsigned* yp = (const GAS unsigned*)(Y + (size_t)cr * 1024) + lane;
#pragma unroll
            for (int j = 0; j < 4; ++j) { const unsigned yw = yp[64 * j]; const auto lo = __builtin_amdgcn_cvt_pk_f32_fp8((int)yw, false), hi = __builtin_amdgcn_cvt_pk_f32_fp8((int)yw, true);
                v[j].x += lo[0] * (1.f / YSCALE); v[j].y += lo[1] * (1.f / YSCALE); v[j].z += hi[0] * (1.f / YSCALE); v[j].w += hi[1] * (1.f / YSCALE); } }
        float ss = 0.f;
#pragma unroll
        for (int j = 0; j < 4; ++j) ss += (v[j].x * v[j].x + v[j].y * v[j].y) + (v[j].z * v[j].z + v[j].w * v[j].w);
        const float rinv = 1.f / sqrtf(wave_sum(ss) * (1.f / 1024.f) + EPS);
#pragma unroll
        for (int j = 0; j < 4; ++j) hp[64 * j] = v[j] * rinv * fg[j];
    }
}
#ifndef MK_N_LAUNCHES
#define MK_N_LAUNCHES 1
#endif
constexpr int N_PHASES = 9;
constexpr int N_LAUNCHES = MK_N_LAUNCHES;
struct Args { const float* in[19]; float* out; unsigned char* ws; int ph_lo, ph_hi; };
__global__ void __launch_bounds__(NWAVES * 64, 2) enc_fwd(Args args) {
    extern __shared__ __attribute__((aligned(16))) unsigned char lds[];
    Frame F;
    F.lds = (LAS unsigned char*)lds;
    F.MISC = (volatile LAS unsigned*)(F.lds + LC_MISC);
    F.tid = threadIdx.x; F.lane = F.tid & 63; F.wave = __builtin_amdgcn_readfirstlane(F.tid >> 6);
    F.G = gridDim.x; { const int bx = blockIdx.x; F.vcu = (F.G % 8 == 0) ? (bx % 8) * (F.G / 8) + bx / 8 : bx; }
    F.ws = args.ws; F.ctl = (gu32*)(args.ws + WS_CTL);
    F.x = args.in[0]; F.mix_g = args.in[1]; F.w_in = args.in[2]; F.w_gf = args.in[3]; F.b_gf = args.in[4]; F.w_gb = args.in[5]; F.b_gb = args.in[6]; F.gla_hg = args.in[7];
    F.q_g = args.in[8]; F.k_g = args.in[9]; F.w_out = args.in[10]; F.ffn_g = args.in[11]; F.w_router = args.in[12]; F.b_router = args.in[13];
    F.w1 = args.in[14]; F.b1 = args.in[15]; F.w2 = args.in[16]; F.b2 = args.in[17]; F.fin_g = args.in[18]; F.out = args.out;
    for (int u = F.tid; u < (LDS_BYTES - LC_OFF) / 4; u += NWAVES * 64) ((LAS unsigned*)(F.lds + LC_OFF))[u] = 0u;
    __syncthreads();
    XcdBarrier bar; bar.bar = (unsigned*)(F.ctl + CW_BAR); bar.x = 0; bar.st = nullptr;
    if (N_LAUNCHES == 1) bar = xcd_barrier_post((unsigned*)(F.ctl + CW_BAR), F.MISC + 8);
    const int lo = args.ph_lo, hi = args.ph_hi;
#define IN(k) (lo <= (k) && (k) < hi)
#define SEAM(k) do { if (IN(k) && IN((k) + 1)) xcd_barrier(bar); } while (0)
    MoeTabs tb{(const LAS int*)(F.lds + LC_CNT), (const LAS int*)(F.lds + LC_CST), (const LAS unsigned short*)(F.lds + LC_TE)};

    if (IN(0)) { p0_prologue(F); } SEAM(0);
    if (IN(1)) {
        DenseMap mp{(const bf16*)(F.ws + WS_XN), (const bf16*)(F.ws + WS_WIN), 1024};
        pg8::StaticOrder S; S.init(T / 256, D_IN_PAD / 256, F.G, (int)blockIdx.x);
        EpiInProj E{(bf16*)(F.ws + WS_GQ), (bf16*)(F.ws + WS_GK), (bf16*)(F.ws + WS_GV), (bf16*)(F.ws + WS_GR), (bf16*)(F.ws + WS_AQ), (bf16*)(F.ws + WS_AK), (bf16*)(F.ws + WS_AV), (bf16*)(F.ws + WS_Z)};
        pg8::gemm_phase<EpiInProj, pg8::StaticOrder, DenseMap, true>(F.lds, 1024, S, mp, E);
    } SEAM(1);
    if (IN(2)) { p2_normrope(F); for (int u = F.vcu; u < BATCH * 64; u += F.G) gla::gla_prep_unit(F, u >> 6, u & 63); } SEAM(2);
    if (IN(3)) { p3_mixers(F); } SEAM(3);
    if (IN(4)) {
        DenseMap mp{(const bf16*)(F.ws + WS_MIX), (const bf16*)(F.ws + WS_WOUT), 1024};
        pg8::StaticOrder S; S.init(T / 256, DM / 256, F.G, (int)blockIdx.x);
        EpiResF32 E{F.x, F.out};
        pg8::gemm_phase<EpiResF32, pg8::StaticOrder, DenseMap, true>(F.lds, 1024, S, mp, E);
    } SEAM(4);
    if (IN(5)) { p5_route(F); } SEAM(5);
    if (IN(6)) {
        const int ntl = moe_tables(F);
        MoeMapUp mp{F.ws + WS_XN, F.ws + WS_W1, (const int*)(F.ws + WS_ROWTOK), tb};
        pg8::StaticOrder S; S.init(ntl, 8, F.G, (int)blockIdx.x);
        EpiSwiglu E{F.b1, F.ws + WS_ACT, tb};
        pg8::gemm_phase<EpiSwiglu, pg8::StaticOrder, MoeMapUp, true, true>(F.lds, 512, S, mp, E);
    } SEAM(6);
    if (IN(7)) {
        const int ntl = moe_tables(F);
        MoeMapDown mp{F.ws + WS_ACT, F.ws + WS_W2, tb};
        pg8::StaticOrder S; S.init(ntl, 4, F.G, (int)blockIdx.x);
        EpiDown E{F.b2, (const float*)(F.ws + WS_ROWGATE), F.ws + WS_Y, tb};
        pg8::gemm_phase<EpiDown, pg8::StaticOrder, MoeMapDown, true, true>(F.lds, 512, S, mp, E);
    } SEAM(7);
    if (IN(8)) { (void)moe_tables(F); p8_combine(F); }
#undef IN
#undef SEAM
}

extern "C" void kernel_launch(void* const* d_in, const int* in_sizes, int n_in, void* d_out, int out_size, void* d_ws, size_t ws_size, hipStream_t stream) {
    static int grid = 0;
    if (grid == 0) {
        if (n_in != 19 || in_sizes[0] != T * DM || out_size != T * DM || ws_size < WS_END) { fprintf(stderr, "kernel_launch: unexpected shapes (n_in %d, in0 %d, out %d, ws %zu); nothing launched\n", n_in, n_in > 0 ? in_sizes[0] : -1, out_size, ws_size); grid = -1; return; }
        int dev = 0, cus = 0, per_cu = 0;
        if (hipGetDevice(&dev) != hipSuccess || hipDeviceGetAttribute(&cus, hipDeviceAttributeMultiprocessorCount, dev) != hipSuccess) { grid = -1; return; }
        if (hipFuncSetAttribute((const void*)enc_fwd, hipFuncAttributeMaxDynamicSharedMemorySize, LDS_BYTES) != hipSuccess) { fprintf(stderr, "kernel_launch: hipFuncSetAttribute failed\n"); grid = -1; return; }
        if (hipOccupancyMaxActiveBlocksPerMultiprocessor(&per_cu, (const void*)enc_fwd, NWAVES * 64, LDS_BYTES) != hipSuccess || per_cu < 1) { fprintf(stderr, "kernel_launch: occupancy query says %d\n", per_cu); }
        (void)hipGetLastError();
        grid = cus;
    }
    if (grid < 0) return;
    if (hipMemsetAsync((char*)d_ws + WS_CTL, 0, CTL_ZERO_BYTES, stream) != hipSuccess) return;
    Args a{};
    for (int i = 0; i < 19; ++i) a.in[i] = (const float*)d_in[i];
    a.out = (float*)d_out; a.ws = (unsigned char*)d_ws;
    if (N_LAUNCHES == 1) { a.ph_lo = 0; a.ph_hi = N_PHASES; hipLaunchKernelGGL(enc_fwd, dim3(grid), dim3(NWAVES * 64), LDS_BYTES, stream, a); }
    else for (int p = 0; p < N_PHASES; ++p) { a.ph_lo = p; a.ph_hi = p + 1; hipLaunchKernelGGL(enc_fwd, dim3(grid), dim3(NWAVES * 64), LDS_BYTES, stream, a); }
}
```

```cpp
#include <hip/hip_runtime.h>
#include <hip/hip_bf16.h>
#include <cstdio>
#include <cstdint>
#include <cmath>

#define LAS __attribute__((address_space(3)))
#define GAS __attribute__((address_space(1)))

namespace pg8 {
typedef unsigned short bf16_t;
typedef short bf16x8 __attribute__((ext_vector_type(8)));
typedef float f32x4 __attribute__((ext_vector_type(4)));
typedef float f32x2 __attribute__((ext_vector_type(2)));
typedef unsigned u32x4 __attribute__((ext_vector_type(4)));
typedef int v4i_t __attribute__((ext_vector_type(4)));
typedef int v8i_t __attribute__((ext_vector_type(8)));
constexpr int BM = 256, BK = 64, HALF = 128, HTB = HALF * BK * 2, STAGE_BYTES = 8 * HTB, NXCD = 8, WGM = 8;

__host__ __device__ __forceinline__ int lds_byte(int r, int c) { const int st = (r >> 4) * 2 + (c >> 5), rr = r & 15, cc = c & 31, ob = rr * 64 + cc * 2; return st * 1024 + (ob ^ (((ob >> 9) & 1) << 5)); }
__host__ __device__ __forceinline__ void stage_rc(int b, int& R, int& C) { const int st = b / 1024, sb = b % 1024, swz = sb ^ (((sb >> 9) & 1) << 5); R = (st >> 1) * 16 + swz / 64; C = (st & 1) * 32 + (swz % 64) / 2; }
__host__ __device__ __forceinline__ int perm32(int rho) { const int n = rho >> 4, i = rho & 15; return 8 * (i >> 2) + 4 * n + (i & 3); }

struct Unit { int pm, pn; };

struct StaticOrder {
    int nM, nN, nwg, G, c;
    __device__ __forceinline__ void init(int nM_, int nN_, int G_, int c_) { nM = nM_; nN = nN_; nwg = nM * nN; G = G_; c = c_; }
    __device__ __forceinline__ bool next(int i, Unit& u) const {
        const long L = (long)i * G + c; if (L >= nwg) return false;
        int wgid = (int)L; { const int q = nwg / NXCD, r = nwg % NXCD, xcd = wgid % NXCD, off = wgid / NXCD; wgid = (xcd < r ? xcd * (q + 1) : r * (q + 1) + (xcd - r) * q) + off; }
        const int nig = WGM * nN, gid = wgid / nig, fm = gid * WGM, gsz = (nM - fm) < WGM ? (nM - fm) : WGM;
        u.pm = fm + ((wgid % nig) % gsz); u.pn = (wgid % nig) / gsz; return true;
    }
};

__device__ __forceinline__ unsigned cvt_pk_bf16(float lo, float hi) { unsigned r; asm volatile("v_cvt_pk_bf16_f32 %0, %1, %2" : "=v"(r) : "v"(lo), "v"(hi)); return r; }

template <class Epi, class Sched, class Map, bool ALIGN_EPI, bool FP8 = false>
__device__ __forceinline__ void gemm_phase(LAS unsigned char* lds, const int K, const Sched& S, const Map& MP, const Epi& E) {
    int tid_ = threadIdx.x; asm volatile("" : "+v"(tid_));
    const int tid = tid_, wid = __builtin_amdgcn_readfirstlane(tid >> 6), lane = tid & 63, wr = wid >> 2, wc = wid & 3, fr = lane & 15, fq = lane >> 4;
    const int nt = K / BK;
    int Rr[2], Cc[2]; unsigned voffB[2];
#pragma unroll
    for (int i = 0; i < 2; ++i) { int R, C; stage_rc(tid * 16 + i * 8192, R, C); Rr[i] = R; Cc[i] = C; const int Rb = Epi::COLS64 ? (64 * (R >> 5) + perm32(R & 31)) : (Epi::PERM ? ((R & ~31) + perm32(R & 31)) : R); voffB[i] = (unsigned)(Rb * K + C) * 2u; }
    const unsigned kstep = (unsigned)(BK * 2);
    const unsigned hstep = (unsigned)HALF * K * 2;
    const unsigned hstepB = Epi::COLS64 ? 32u * (unsigned)K * 2u : hstep;
    const __amdgpu_buffer_rsrc_t RA = MP.a_rsrc(), RB = MP.b_rsrc();
    const unsigned ldsw = (unsigned)wid * 1024u;
    const int aoff = lds_byte(wr * 64 + fr, fq * 8), boff = lds_byte(wc * 32 + fr, fq * 8);
#define PG8_SA(b, h) (((b) * 2 + (h)) * HTB)
#define PG8_SB(b, h) ((4 + (b) * 2 + (h)) * HTB)
#define PG8_STAGE(bufoff, rsrc, soff, voff) do { _Pragma("unroll") for (int _i = 0; _i < 2; ++_i) \
        __builtin_amdgcn_raw_ptr_buffer_load_lds(rsrc, (LAS unsigned*)(lds + (bufoff) + ldsw + _i * 8192), 16, (int)(voff)[_i], (int)(soff), 0, 0); } while (0)
#define PG8_LD8(p) __builtin_shufflevector(*(const LAS v4i_t*)(p), *(const LAS v4i_t*)((p) + 1024), 0, 1, 2, 3, 4, 5, 6, 7)
#define PG8_LDA(dst, b, h) do { _Pragma("unroll") for (int m = 0; m < 4; ++m) dst[m] = PG8_LD8(lds + PG8_SA(b, h) + aoff + m * 2048); } while (0)
#define PG8_LDB(dst, b, h) do { _Pragma("unroll") for (int n = 0; n < 2; ++n) dst[n] = PG8_LD8(lds + PG8_SB(b, h) + boff + n * 2048); } while (0)
#define PG8_HALF(x, k) __builtin_bit_cast(bf16x8, __builtin_shufflevector(x, x, 4 * (k), 4 * (k) + 1, 4 * (k) + 2, 4 * (k) + 3))
#define PG8_MMA(ai, bj, At, Bt) do { __builtin_amdgcn_s_setprio(1); _Pragma("unroll") for (int m = 0; m < 4; ++m) _Pragma("unroll") for (int n = 0; n < 2; ++n) { \
        if constexpr (FP8) { acc[ai][bj][m][n] = __builtin_amdgcn_mfma_scale_f32_16x16x128_f8f6f4(Bt[n], At[m], acc[ai][bj][m][n], 0, 0, 0, 0x7f7f7f7f, 0, 0x7f7f7f7f); } \
        else { acc[ai][bj][m][n] = __builtin_amdgcn_mfma_f32_16x16x32_bf16(PG8_HALF(Bt[n], 0), PG8_HALF(At[m], 0), acc[ai][bj][m][n], 0, 0, 0); \
               acc[ai][bj][m][n] = __builtin_amdgcn_mfma_f32_16x16x32_bf16(PG8_HALF(Bt[n], 1), PG8_HALF(At[m], 1), acc[ai][bj][m][n], 0, 0, 0); } } \
        __builtin_amdgcn_s_setprio(0); } while (0)
#define PG8_WAIT_V(n) asm volatile("s_waitcnt vmcnt(" #n ")" ::: "memory")
#define PG8_WAIT_L(n) asm volatile("s_waitcnt lgkmcnt(" #n ")" ::: "memory")
#define PG8_BAR __builtin_amdgcn_s_barrier()
#define PG8_SCHED __builtin_amdgcn_sched_barrier(0)
    Unit cur, nxt, nn; int ui = 0;
    if (!S.next(0, cur)) return;
    f32x4 acc[2][2][4][2];
#pragma unroll
    for (int a = 0; a < 2; ++a)
#pragma unroll
        for (int b = 0; b < 2; ++b)
#pragma unroll
            for (int m = 0; m < 4; ++m)
#pragma unroll
                for (int n = 0; n < 2; ++n) acc[a][b][m][n] = (f32x4){0.f, 0.f, 0.f, 0.f};
    v8i_t At[4], B0[2], B1[2];
    unsigned cvo[2][2], nvo[2][2], nnvo[2][2];
    MP.a_off(cur, Rr, Cc, cvo);
    bool has_next = S.next(1, nxt);
    if constexpr (Map::GATHER) { if (has_next) MP.a_off(nxt, Rr, Cc, nvo); else { nvo[0][0] = cvo[0][0]; nvo[0][1] = cvo[0][1]; nvo[1][0] = cvo[1][0]; nvo[1][1] = cvo[1][1]; } }
    unsigned cA = MP.a_soff(cur), cB = MP.b_soff(cur);
    typename Epi::Pre pc, pn;
    E.preload(cur, wr, wc, fr, fq, pc); pn = pc;
    PG8_STAGE(PG8_SB(0, 0), RB, cB, voffB); PG8_STAGE(PG8_SB(0, 1), RB, cB + hstepB, voffB); PG8_STAGE(PG8_SA(0, 0), RA, cA, cvo[0]); PG8_STAGE(PG8_SA(0, 1), RA, cA, cvo[1]);
    if (wr == 1) PG8_BAR;
    PG8_WAIT_V(2); PG8_BAR;
    PG8_STAGE(PG8_SB(1, 0), RB, cB + kstep, voffB); PG8_STAGE(PG8_SA(1, 0), RA, cA + kstep, cvo[0]); PG8_STAGE(PG8_SB(1, 1), RB, cB + hstepB + kstep, voffB);
    PG8_WAIT_V(6); PG8_BAR;
    for (;;) {
        const unsigned nA = has_next ? MP.a_soff(nxt) : cA, nB = has_next ? MP.b_soff(nxt) : cB;
#pragma unroll 1
        for (int t = 0; t < nt; t += 2) {
            const bool last = (t == nt - 2);
            const unsigned a1 = cA + (unsigned)(t + 1) * kstep;
            const unsigned a2 = last ? nA : cA + (unsigned)(t + 2) * kstep, b2 = last ? nB : cB + (unsigned)(t + 2) * kstep;
            const unsigned a3 = a2 + kstep, b3 = b2 + kstep;
            unsigned s0[2] = {cvo[0][0], cvo[0][1]}, s1[2] = {cvo[1][0], cvo[1][1]};
            if constexpr (Map::GATHER) { if (last) { s0[0] = nvo[0][0]; s0[1] = nvo[0][1]; s1[0] = nvo[1][0]; s1[1] = nvo[1][1]; } }
            PG8_LDB(B0, 0, 0); PG8_LDB(B1, 0, 1); PG8_SCHED; PG8_LDA(At, 0, 0); PG8_STAGE(PG8_SA(1, 1), RA, a1, cvo[1]);
            PG8_WAIT_V(8); PG8_WAIT_L(0); PG8_BAR; PG8_MMA(0, 0, At, B0); PG8_MMA(0, 1, At, B1); PG8_BAR; PG8_SCHED;
            PG8_LDA(At, 0, 1); PG8_STAGE(PG8_SB(0, 0), RB, b2, voffB); PG8_STAGE(PG8_SB(0, 1), RB, b2 + hstepB, voffB); PG8_STAGE(PG8_SA(0, 0), RA, a2, s0);
            PG8_WAIT_V(8); PG8_WAIT_L(0); PG8_BAR; PG8_MMA(1, 0, At, B0); PG8_MMA(1, 1, At, B1); PG8_BAR; PG8_SCHED;
            PG8_LDB(B0, 1, 0); PG8_LDB(B1, 1, 1); PG8_SCHED; PG8_LDA(At, 1, 0); PG8_STAGE(PG8_SA(0, 1), RA, a2, s1);
            PG8_WAIT_V(8); PG8_WAIT_L(0); PG8_BAR; PG8_MMA(0, 0, At, B0); PG8_MMA(0, 1, At, B1); PG8_BAR; PG8_SCHED;
            PG8_LDA(At, 1, 1); PG8_STAGE(PG8_SB(1, 0), RB, b3, voffB); PG8_STAGE(PG8_SB(1, 1), RB, b3 + hstepB, voffB); PG8_STAGE(PG8_SA(1, 0), RA, a3, s0);
            PG8_WAIT_V(8); PG8_WAIT_L(0); PG8_BAR; PG8_MMA(1, 0, At, B0); PG8_MMA(1, 1, At, B1); PG8_BAR; PG8_SCHED;
        }
        if constexpr (ALIGN_EPI) { if (wr == 0) PG8_BAR; }
        const bool has_nn = has_next && S.next(ui + 2, nn);
        if constexpr (Map::GATHER) { if (has_nn) MP.a_raw(nn, Rr, nnvo); }
        if (has_next) E.preload(nxt, wr, wc, fr, fq, pn);
        { int fr_ = fr, fq_ = fq; asm volatile("" : "+v"(fr_), "+v"(fq_)); E(acc, cur, pc, wr, wc, fr_, fq_); }
        if (!has_next) break;
#pragma unroll
        for (int a = 0; a < 2; ++a)
#pragma unroll
            for (int b = 0; b < 2; ++b)
#pragma unroll
                for (int m = 0; m < 4; ++m)
#pragma unroll
                    for (int n = 0; n < 2; ++n) acc[a][b][m][n] = (f32x4){0.f, 0.f, 0.f, 0.f};
        cur = nxt; cA = nA; cB = nB; ++ui; pc = pn;
#pragma unroll
        for (int h = 0; h < 2; ++h)
#pragma unroll
            for (int i = 0; i < 2; ++i) { if constexpr (Map::GATHER) { cvo[h][i] = nvo[h][i]; nvo[h][i] = has_nn ? MP.a_fin(nnvo[h][i], Cc[i]) : nvo[h][i]; } }
        has_next = has_nn; nxt = nn;
        if constexpr (ALIGN_EPI) { if (wr == 1) PG8_BAR; }
    }
    PG8_WAIT_V(0);
    if constexpr (!ALIGN_EPI) { if (wr == 0) PG8_BAR; }
    PG8_BAR;
#undef PG8_SA
#undef PG8_SB
#undef PG8_STAGE
#undef PG8_LDA
#undef PG8_LDB
#undef PG8_MMA
#undef PG8_HALF
#undef PG8_LD8
#undef PG8_WAIT_V
#undef PG8_WAIT_L
#undef PG8_BAR
#undef PG8_SCHED
}
}
namespace attn_body {
using bf16=__hip_bfloat16;
using bf16x8=__attribute__((ext_vector_type(8)))short;
using s16x4=__attribute__((ext_vector_type(4)))short;
using f32x16=__attribute__((ext_vector_type(16)))float;
using u32x4=__attribute__((ext_vector_type(4)))unsigned;
constexpr int BATCH=8,NHEAD=8,NKVH=2,SEQ=4096,D=64;
constexpr int QP=512,KP=128,VP=128,OP=1024,OCOL=512;
constexpr int NW=8,QBLK=32,QB=QBLK*NW,KVBLK=64,NQB=SEQ/QB;
__device__ __forceinline__ int crow(int r,int hi){return (r&3)+8*(r>>2)+4*hi;}
#define SBAR() __builtin_amdgcn_sched_barrier(0)
constexpr int NSLOT=3, SLOTB=8192;
constexpr int LDS_K=0, LDS_V=NSLOT*SLOTB, LDS_WS=2*NSLOT*SLOTB, LDS_OST=LDS_WS+NW*64*4, LDS_BYTES=LDS_OST+NW*4096;
constexpr float C2=0.125f*1.4426950408889634f;
__device__ __forceinline__ void glds16(const void*gsrc,unsigned lds_dst){unsigned keep;
  asm volatile("s_mov_b32 %0, m0\n\ts_mov_b32 m0, %2\n\ts_nop 0\n\tglobal_load_lds_dwordx4 %1, off\n\ts_mov_b32 m0, %0":"=&s"(keep):"v"(gsrc),"s"(lds_dst):"memory");}
__device__ __forceinline__ float max3f(float a,float b,float c){float r;asm("v_max3_f32 %0, %1, %2, %3":"=v"(r):"v"(a),"v"(b),"v"(c));return r;}
__device__ __forceinline__ float max2f(float a,float b){float r;asm("v_max_f32_e32 %0, %1, %2":"=v"(r):"v"(a),"v"(b));return r;}
__device__ __forceinline__ float fadd_s(float a,float b){float r;asm("v_add_f32_e32 %0, %1, %2":"=v"(r):"v"(a),"v"(b));return r;}
__device__ __forceinline__ float fsub_s(float a,float b){float r;asm("v_sub_f32_e32 %0, %1, %2":"=v"(r):"v"(a),"v"(b));return r;}
typedef float f32x2_t __attribute__((ext_vector_type(2))); typedef __bf16 bf16x2_t __attribute__((ext_vector_type(2)));
__device__ __forceinline__ unsigned cvtpk_s(float lo,float hi){f32x2_t v={lo,hi};bf16x2_t b=__builtin_convertvector(v,bf16x2_t);return __builtin_bit_cast(unsigned,b);}
#define WAIT_BAR(N) asm volatile("s_waitcnt vmcnt(" #N ") lgkmcnt(0)\n\ts_barrier":::"memory")

__device__ __forceinline__ void qkt(f32x16&p0,f32x16&p1,const char*Kslot,const bf16x8*qr,const f32x16&negm,int r32,int hi){
  const char*kb=Kslot+hi*1024+r32*16;
  #pragma unroll
  for(int d0=0;d0<4;++d0){
    const bf16x8 b0=*reinterpret_cast<const bf16x8*>(kb+d0*2048);
    const bf16x8 b1=*reinterpret_cast<const bf16x8*>(kb+d0*2048+512);
    if(d0==0){p0=__builtin_amdgcn_mfma_f32_32x32x16_bf16(b0,qr[0],negm,0,0,0);p1=__builtin_amdgcn_mfma_f32_32x32x16_bf16(b1,qr[0],negm,0,0,0);}
    else{p0=__builtin_amdgcn_mfma_f32_32x32x16_bf16(b0,qr[d0],p0,0,0,0);p1=__builtin_amdgcn_mfma_f32_32x32x16_bf16(b1,qr[d0],p1,0,0,0);}}
}
typedef __attribute__((address_space(3))) const char* lds_cptr;
typedef short v4i16_t __attribute__((ext_vector_type(4)));
__device__ __forceinline__ void kload8(bf16x8*kf,lds_cptr kp){
  kf[0]=*(const __attribute__((address_space(3))) bf16x8*)(kp);      kf[1]=*(const __attribute__((address_space(3))) bf16x8*)(kp+512);
  kf[2]=*(const __attribute__((address_space(3))) bf16x8*)(kp+2048); kf[3]=*(const __attribute__((address_space(3))) bf16x8*)(kp+2560);
  kf[4]=*(const __attribute__((address_space(3))) bf16x8*)(kp+4096); kf[5]=*(const __attribute__((address_space(3))) bf16x8*)(kp+4608);
  kf[6]=*(const __attribute__((address_space(3))) bf16x8*)(kp+6144); kf[7]=*(const __attribute__((address_space(3))) bf16x8*)(kp+6656);
}
__device__ __forceinline__ void kload2(bf16x8*kf,lds_cptr kp,int j){ kf[2*j]=*(const __attribute__((address_space(3))) bf16x8*)(kp+j*2048); kf[2*j+1]=*(const __attribute__((address_space(3))) bf16x8*)(kp+j*2048+512); }
__device__ __forceinline__ s16x4 vtr(lds_cptr p){ return __builtin_bit_cast(s16x4,__builtin_amdgcn_ds_read_tr16_b64_v4i16((__attribute__((address_space(3))) v4i16_t*)p)); }
__device__ __forceinline__ float rowmax(const f32x16&p0,const f32x16&p1){
  float a=max3f(p0[0],p0[1],p1[0]),b=max3f(p0[2],p0[3],p1[1]);a=max3f(a,p1[2],p1[3]);
  #pragma unroll
  for(int r=4;r<16;r+=4){a=max3f(a,p0[r],p0[r+1]);b=max3f(b,p0[r+2],p0[r+3]);a=max3f(a,p1[r],p1[r+1]);b=max3f(b,p1[r+2],p1[r+3]);}
  const float m=max2f(a,b);
  auto rr=__builtin_amdgcn_permlane32_swap(__float_as_uint(m),__float_as_uint(m),false,false);
  return max2f(__uint_as_float(rr[0]),__uint_as_float(rr[1]));
}
__device__ __forceinline__ void pv(f32x16*o,int vb,bf16x8 pa0,bf16x8 pa1,bf16x8 pa2,bf16x8 pa3){
  #pragma unroll
  for(int d0=0;d0<2;++d0){s16x4 lo[4],hi[4];
    #pragma unroll
    for(int ks=0;ks<4;++ks){
      asm volatile("ds_read_b64_tr_b16 %0,%1 offset:%c2":"=&v"(lo[ks]):"v"(vb),"i"(d0*4096+ks*1024):"memory");
      asm volatile("ds_read_b64_tr_b16 %0,%1 offset:%c2":"=&v"(hi[ks]):"v"(vb),"i"(d0*4096+ks*1024+512):"memory");}
    asm volatile("s_waitcnt lgkmcnt(0)":::"memory");SBAR();
    #define PK(k) (bf16x8){lo[k][0],lo[k][1],lo[k][2],lo[k][3],hi[k][0],hi[k][1],hi[k][2],hi[k][3]}
    o[d0]=__builtin_amdgcn_mfma_f32_32x32x16_bf16(pa0,PK(0),o[d0],0,0,0);
    o[d0]=__builtin_amdgcn_mfma_f32_32x32x16_bf16(pa1,PK(1),o[d0],0,0,0);
    o[d0]=__builtin_amdgcn_mfma_f32_32x32x16_bf16(pa2,PK(2),o[d0],0,0,0);
    o[d0]=__builtin_amdgcn_mfma_f32_32x32x16_bf16(pa3,PK(3),o[d0],0,0,0);
    #undef PK
  }
}
#define ATTN_STORE16(p,v) (*(u32x4*)(p)=(v))
template<int THRL> __device__ __forceinline__ void attn_unit(int b,int h,int qb,const bf16*Q,const bf16*__restrict__ K,const bf16*__restrict__ V,bf16*O,char*shm,const float*qgain,const float sbound){
  int tid_=threadIdx.x; asm volatile("":"+v"(tid_));
  const int tid=tid_,lane=tid&63,r32=lane&31,hi=lane>>5; const int wid=__builtin_amdgcn_readfirstlane(tid>>6);
  const long rowbase=(long)b*SEQ; const int q0=qb*QB; const int kvh=h/(NHEAD/NKVH);
  const bf16*Qw=Q+(rowbase+q0+wid*QBLK)*QP+h*D;
  const bf16*Kh=K+rowbase*KP+kvh*D,*Vh=V+rowbase*VP+kvh*D;
  const unsigned lds0=(unsigned)(uintptr_t)shm;
  float*wsf=(float*)(shm+LDS_WS)+wid*64;
  const bf16*ksrc=Kh+(long)lane*KP+wid*8;
  const bf16*vsrc=Vh+(long)(16*(wid&3)+(lane>>2))*VP+(wid>>2)*32+(lane&3)*8;
  const unsigned kdst=lds0+LDS_K+wid*1024, vdst=lds0+LDS_V+wid*1024;
  #define DMA_K(t,slot) glds16(ksrc+(long)(t)*KVBLK*KP,(unsigned)__builtin_amdgcn_readfirstlane(kdst+(slot)))
  #define DMA_V(t,slot) glds16(vsrc+(long)(t)*KVBLK*VP,(unsigned)__builtin_amdgcn_readfirstlane(vdst+(slot)))
  const int vb0=(int)(lds0+LDS_V)+((lane>>4)&1)*32+(lane&3)*8+(4*hi+((lane&15)>>2))*64;
  const char*Kbase=shm+LDS_K; bf16x8 kf[8];
  const lds_cptr shm3=(lds_cptr)shm; const lds_cptr kp0=shm3+LDS_K+hi*1024+r32*16; const lds_cptr vp0=shm3+LDS_V+((lane>>4)&1)*32+(lane&3)*8+(4*hi+((lane&15)>>2))*64;
  constexpr int NT=SEQ/KVBLK;
  DMA_K(0,0);DMA_V(0,0);DMA_K(1,SLOTB);
  bf16x8 qr[4];
  #pragma unroll
  for(int d0=0;d0<4;++d0)qr[d0]=*reinterpret_cast<const bf16x8*>(&Qw[(long)r32*QP+d0*16+hi*8]);
  { float xq[4][8]; float ss=0.f; int hio=hi; asm volatile("":"+v"(hio));
    #pragma unroll
    for(int d0=0;d0<4;++d0)
      #pragma unroll
      for(int j=0;j<8;++j){ xq[d0][j]=__builtin_bit_cast(float,((unsigned)(unsigned short)qr[d0][j])<<16); ss+=xq[d0][j]*xq[d0][j]; }
    ss+=__shfl_xor(ss,32);
    const float rinv=__builtin_amdgcn_rsqf(ss*(1.f/64.f)+1e-6f);
    const int tq=q0+wid*QBLK+r32; const float prow=(float)(tq>>6), pcol=(float)(tq&63);
    #pragma unroll
    for(int d0=0;d0<4;++d0)
      #pragma unroll
      for(int j=0;j<8;++j) xq[d0][j]*=rinv*qgain[16*d0+8*hio+j];
    #pragma unroll
    for(int j=0;j<8;++j){ const float inv=exp2f(-(float)(8*hio+j)*(13.287712379549449f/16.f));
      const float ar=prow*inv, ac=pcol*inv; const float cr=__cosf(ar), sr=__sinf(ar), cc=__cosf(ac), sc=__sinf(ac);
      const float a0=xq[0][j], a1=xq[1][j], b0=xq[2][j], b1=xq[3][j];
      xq[0][j]=(a0*cr-a1*sr)*C2; xq[1][j]=(a1*cr+a0*sr)*C2; xq[2][j]=(b0*cc-b1*sc)*C2; xq[3][j]=(b1*cc+b0*sc)*C2; }
    #pragma unroll
    for(int d0=0;d0<4;++d0){ u32x4 w; w.x=cvtpk_s(xq[d0][0],xq[d0][1]); w.y=cvtpk_s(xq[d0][2],xq[d0][3]); w.z=cvtpk_s(xq[d0][4],xq[d0][5]); w.w=cvtpk_s(xq[d0][6],xq[d0][7]); qr[d0]=__builtin_bit_cast(bf16x8,w); } }
  float l_reg=0.f;f32x16 o[2];o[0]=f32x16{};o[1]=f32x16{};f32x16 negm;
  #pragma unroll
  for(int r=0;r<16;++r)negm[r]=-sbound;
  asm volatile("":"+v"(negm));
  #define START(P0,P1) do{ _Pragma("unroll") for(int r=0;r<16;++r)P0[r]=__builtin_amdgcn_exp2f(P0[r]); }while(0)
  #define RESC() do{}while(0)
  f32x16 pA0,pA1,pB0,pB1;
  int sl_prev=0,sl_cur=0,sl_next=SLOTB;
  #define ROT() do{sl_prev=sl_cur;sl_cur=sl_next;sl_next=(sl_next==(NSLOT-1)*SLOTB)?0:sl_next+SLOTB;}while(0)
  DMA_K(2,2*SLOTB);
  WAIT_BAR(3);
  qkt(pA0,pA1,Kbase,qr,negm,r32,hi);asm volatile("s_nop 15\n\ts_nop 7":"+v"(pA0),"+v"(pA1));
  START(pA0,pA1);
  _Pragma("unroll") for(int r=0;r<16;++r)pA1[r]=__builtin_amdgcn_exp2f(pA1[r]);
  WAIT_BAR(0);
  DMA_K(3,0);DMA_V(1,SLOTB);
  ROT();
  kload8(kf,kp0+sl_cur);
  WAIT_BAR(2);
  s16x4 vlo[8],vhi[8]; u32x4 pw0,pw1,pw2,pw3;
  #define PKW(P,B) cvtpk_s(P[B],P[B+1])
  #define PAF(k) __builtin_bit_cast(bf16x8,pw##k)
  #define VFR(i) (bf16x8){vlo[i][0],vlo[i][1],vlo[i][2],vlo[i][3],vhi[i][0],vhi[i][1],vhi[i][2],vhi[i][3]}
  #define PIN(x) asm volatile("":"+v"(x))
  #define MX3(a,b,c) __builtin_fmaxf(__builtin_fmaxf((a),(b)),(c))
  #define GAPA(MF,A0,A1,A2,A3,W0,W1,PW) do{ MF; sacc+=A0; sacc+=A1; sacc+=A2; sacc+=A3; PIN(sacc); W0; W1; PIN(PW); SBAR(); }while(0)
  #define EX(v) __builtin_amdgcn_exp2f(v)
  #define GAPB(MF,X,B) do{ MF; X[B]=EX(X[B]); X[B+1]=EX(X[B+1]); X[B+2]=EX(X[B+2]); X[B+3]=EX(X[B+3]); PIN(X); SBAR(); }while(0)
  #define VRD(i) do{ vlo[i]=vtr(vp_+(((i)>>2)*4096+((i)&3)*1024)); vhi[i]=vtr(vp_+(((i)>>2)*4096+((i)&3)*1024+512)); }while(0)
  #define KRD(G,j) do{ if(G){ kload2(kf,kp0+sl_next,j); SBAR(); } }while(0)
  #define STEP(C0,C1,P0,P1,t,GK,GV,GL) do{ SBAR(); \
    const lds_cptr vp_=vp0+sl_prev; \
    VRD(0); SBAR(); float sacc=(P0[0]+P0[1]); \
    GAPA(C0=__builtin_amdgcn_mfma_f32_32x32x16_bf16(kf[0],qr[0],negm,0,0,0), P0[2],P0[3],P0[4],P0[5],     pw0[0]=PKW(P0,0), pw0[1]=PKW(P0,2), pw0); \
    VRD(4); SBAR(); GAPA(C1=__builtin_amdgcn_mfma_f32_32x32x16_bf16(kf[1],qr[0],negm,0,0,0), P0[6],P0[7],P0[8],P0[9],     pw0[2]=PKW(P0,4), pw0[3]=PKW(P0,6), pw0); \
    VRD(1); SBAR(); GAPA(C0=__builtin_amdgcn_mfma_f32_32x32x16_bf16(kf[2],qr[1],C0,0,0,0),   P0[10],P0[11],P0[12],P0[13], pw1[0]=PKW(P0,8), pw1[1]=PKW(P0,10), pw1); \
    VRD(5); SBAR(); GAPA(C1=__builtin_amdgcn_mfma_f32_32x32x16_bf16(kf[3],qr[1],C1,0,0,0),   P0[14],P0[15],P1[0],P1[1],   pw1[2]=PKW(P0,12),pw1[3]=PKW(P0,14), pw1); \
    VRD(2); SBAR(); GAPA(C0=__builtin_amdgcn_mfma_f32_32x32x16_bf16(kf[4],qr[2],C0,0,0,0),   P1[2],P1[3],P1[4],P1[5],     pw2[0]=PKW(P1,0), pw2[1]=PKW(P1,2), pw2); \
    VRD(6); SBAR(); GAPA(C1=__builtin_amdgcn_mfma_f32_32x32x16_bf16(kf[5],qr[2],C1,0,0,0),   P1[6],P1[7],P1[8],P1[9],     pw2[2]=PKW(P1,4), pw2[3]=PKW(P1,6), pw2); \
    VRD(3); SBAR(); GAPA(C0=__builtin_amdgcn_mfma_f32_32x32x16_bf16(kf[6],qr[3],C0,0,0,0),   P1[10],P1[11],P1[12],P1[13], pw3[0]=PKW(P1,8), pw3[1]=PKW(P1,10), pw3); \
    VRD(7); SBAR(); GAPA(C1=__builtin_amdgcn_mfma_f32_32x32x16_bf16(kf[7],qr[3],C1,0,0,0),   P1[14],P1[15],0.f,0.f,       pw3[2]=PKW(P1,12),pw3[3]=PKW(P1,14), pw3); \
    l_reg+=sacc; \
    if(GK){DMA_K((t)+3,sl_cur);} if(GV){DMA_V((t)+1,sl_next);} \
    SBAR(); \
    GAPB(o[0]=__builtin_amdgcn_mfma_f32_32x32x16_bf16(PAF(0),VFR(0),o[0],0,0,0), C0,0); \
    GAPB(o[1]=__builtin_amdgcn_mfma_f32_32x32x16_bf16(PAF(0),VFR(4),o[1],0,0,0), C0,4); \
    KRD(GL,0); GAPB(o[0]=__builtin_amdgcn_mfma_f32_32x32x16_bf16(PAF(1),VFR(1),o[0],0,0,0), C0,8); \
    KRD(GL,1); GAPB(o[1]=__builtin_amdgcn_mfma_f32_32x32x16_bf16(PAF(1),VFR(5),o[1],0,0,0), C0,12); \
    KRD(GL,2); GAPB(o[0]=__builtin_amdgcn_mfma_f32_32x32x16_bf16(PAF(2),VFR(2),o[0],0,0,0), C1,0); \
    KRD(GL,3); GAPB(o[1]=__builtin_amdgcn_mfma_f32_32x32x16_bf16(PAF(2),VFR(6),o[1],0,0,0), C1,4); \
    GAPB(o[0]=__builtin_amdgcn_mfma_f32_32x32x16_bf16(PAF(3),VFR(3),o[0],0,0,0), C1,8); \
    GAPB(o[1]=__builtin_amdgcn_mfma_f32_32x32x16_bf16(PAF(3),VFR(7),o[1],0,0,0), C1,12); \
    }while(0)
  int t=1;
  for(;t+5<NT;t+=2){
    STEP(pB0,pB1,pA0,pA1,t,true,true,true);     WAIT_BAR(2); RESC(); ROT();
    STEP(pA0,pA1,pB0,pB1,t+1,true,true,true);   WAIT_BAR(2); RESC(); ROT();
  }
  #define ENDW(tt) do{ if((tt)+3<NT){WAIT_BAR(2);} else if((tt)+2<NT){WAIT_BAR(1);} else {WAIT_BAR(0);} }while(0)
  for(;t+1<NT;t+=2){
    STEP(pB0,pB1,pA0,pA1,t,(t+3<NT),(t+1<NT),(t+1<NT));       ENDW(t);   RESC(); ROT();
    STEP(pA0,pA1,pB0,pB1,t+1,(t+4<NT),(t+2<NT),(t+2<NT));     ENDW(t+1); RESC(); ROT();
  }
  STEP(pB0,pB1,pA0,pA1,NT-1,false,false,false); RESC();
  { float sacc=pB0[0]+pB0[1]; _Pragma("unroll") for(int r=2;r<16;++r)sacc+=pB0[r]; _Pragma("unroll") for(int r=0;r<16;++r)sacc+=pB1[r]; l_reg+=sacc;
    pw0=(u32x4){PKW(pB0,0),PKW(pB0,2),PKW(pB0,4),PKW(pB0,6)};pw1=(u32x4){PKW(pB0,8),PKW(pB0,10),PKW(pB0,12),PKW(pB0,14)};pw2=(u32x4){PKW(pB1,0),PKW(pB1,2),PKW(pB1,4),PKW(pB1,6)};pw3=(u32x4){PKW(pB1,8),PKW(pB1,10),PKW(pB1,12),PKW(pB1,14)};
    SBAR(); pv(o,vb0+sl_cur,PAF(0),PAF(1),PAF(2),PAF(3)); }
  #undef PKW
  #undef PAF
  #undef VFR
  #undef PIN
  #undef MX3
  #undef GAPA
  #undef GAPB
  #undef EX
  #undef VRD
  #undef KRD
  #undef STEP
  #undef ENDW
  {auto rr=__builtin_amdgcn_permlane32_swap(__float_as_uint(l_reg),__float_as_uint(l_reg),false,false);l_reg=__uint_as_float(rr[0])+__uint_as_float(rr[1]);}
  if(hi==0)wsf[32+r32]=l_reg;asm volatile("s_waitcnt lgkmcnt(0)":::"memory");
  float rli[16];
  #pragma unroll
  for(int r=0;r<16;++r)rli[r]=__builtin_amdgcn_rcpf(wsf[32+crow(r,hi)]);
  bf16*Ow=O+(rowbase+q0+wid*QBLK)*OP+OCOL+h*D;
  { bf16*stg=(bf16*)(shm+LDS_OST)+wid*2048;
    #pragma unroll
    for(int r=0;r<16;++r){const int orow=crow(r,hi);
      #pragma unroll
      for(int d0=0;d0<2;++d0)stg[orow*64+d0*32+r32]=__float2bfloat16(o[d0][r]*rli[r]);}
    asm volatile("s_waitcnt lgkmcnt(0)":::"memory");
    #pragma unroll
    for(int i=0;i<4;++i){const int row=i*8+(lane>>3),ch=lane&7; const u32x4 v=*(const u32x4*)(stg+row*64+ch*8); ATTN_STORE16(Ow+(long)row*OP+ch*8,v);} }
  asm volatile("s_waitcnt lgkmcnt(0)\n\ts_barrier":::"memory");
  #undef DMA_K
  #undef DMA_V
  #undef START
  #undef RESC
  #undef ROT
}
constexpr int ATTN_LDS_BYTES=LDS_BYTES;
#undef SBAR
#undef WAIT_BAR
}
constexpr int NWAVES = 8;
constexpr int BATCH = 8, SEQ = 4096, DM = 1024, T = BATCH * SEQ;
constexpr int GLA_H = 4, GLA_DK = 64, GLA_DV = 128, GLA_RANK = 16;
constexpr int ATT_H = 8, ATT_KVH = 2, ATT_DH = 64;
constexpr int D_IN = 2336, D_IN_PAD = 2560;
constexpr int NEXP = 32, TOPK = 4, DFF = 1024;
constexpr int EROWS = 32768;
constexpr int PROWS = T * TOPK + NEXP * 256;
constexpr float EPS = 1e-6f;
constexpr float YSCALE = 16.f;
constexpr float WSCALE = 32.f, ASCALE = 4.f;

constexpr size_t MiB = 1u << 20;
constexpr size_t WS_CTL = 0, CTL_ZERO_BYTES = 1 * MiB;
constexpr size_t WS_WRH = 1 * MiB, WS_WRL = WS_WRH + 65536;
constexpr size_t WS_WIN = 2 * MiB;
constexpr size_t WS_WOUT = 8 * MiB;
constexpr size_t WS_W1 = 10 * MiB;
constexpr size_t WS_W2 = 138 * MiB;
constexpr size_t WS_ROWTOK = 202 * MiB;
constexpr size_t WS_ROWGATE = 206 * MiB;
constexpr size_t WS_TOKASG = 210 * MiB;
constexpr size_t WS_REGY = 212 * MiB;
constexpr size_t WS_XN = WS_REGY;
constexpr size_t WS_GQ = WS_XN + 64 * MiB;
constexpr size_t WS_GK = WS_GQ + 16 * MiB;
constexpr size_t WS_GV = WS_GK + 16 * MiB;
constexpr size_t WS_GR = WS_GV + 32 * MiB;
constexpr size_t WS_AQ = WS_GR + 32 * MiB;
constexpr size_t WS_AK = WS_AQ + 32 * MiB;
constexpr size_t WS_AV = WS_AK + 8 * MiB;
constexpr size_t WS_Z = WS_AV + 8 * MiB;
constexpr size_t WS_OF = WS_Z + 2 * MiB;
constexpr size_t WS_Y = WS_REGY;
constexpr size_t WS_REGA = WS_REGY + 274 * MiB;
constexpr size_t WS_MIX = WS_REGA;
constexpr size_t WS_ACT = WS_REGA;
constexpr size_t WS_QF = WS_REGA + 272 * MiB, WS_KF = WS_QF + 16 * MiB, WS_QB = WS_KF + 16 * MiB, WS_KB = WS_QB + 16 * MiB;
constexpr size_t WS_DEC = WS_KB + 16 * MiB;
constexpr size_t WS_END = WS_DEC + 1 * MiB;
static_assert(WS_OF + (size_t)T * 512 * 4 <= WS_REGA && (size_t)PROWS * 1024 * 2 <= 272 * MiB, "d_ws map");
constexpr int CW_BAR = 4096;
constexpr int CW_CNT = 8192;
constexpr int CW_GDN = 16384;
constexpr int CW_QUE = 12288;

constexpr int SCR_BYTES = 133120;
constexpr int LC_OFF = SCR_BYTES;
constexpr int LC_MISC = LC_OFF;
constexpr int LC_CNT = LC_OFF + 128;
constexpr int LC_CST = LC_CNT + 128;
constexpr int LC_TE = LC_CST + 256;
constexpr int LC_HIST = LC_TE + 1152;
constexpr int LC_BASE = LC_HIST + 128;
constexpr int LC_ASG = LC_BASE + 128;
constexpr int LC_END = LC_ASG + 8192;
constexpr int LDS_BYTES = 147456;
static_assert(LC_END <= LDS_BYTES, "LDS map");

typedef unsigned short bf16;
typedef unsigned v4u __attribute__((ext_vector_type(4)));
typedef unsigned v2u __attribute__((ext_vector_type(2)));
typedef float f32x4 __attribute__((ext_vector_type(4)));
typedef short bf16x8 __attribute__((ext_vector_type(8)));
typedef GAS unsigned gu32;
#define RLX_AGENT __ATOMIC_RELAXED, __HIP_MEMORY_SCOPE_AGENT
#define LDS_WAIT() asm volatile("s_waitcnt lgkmcnt(0)" ::: "memory")
#define VM_WAIT() asm volatile("s_waitcnt vmcnt(0)" ::: "memory")
__device__ __forceinline__ unsigned f2bf(float f) { unsigned u = __builtin_bit_cast(unsigned, f); return (u + 0x7fffu + ((u >> 16) & 1u)) >> 16; }
__device__ __forceinline__ unsigned pk2(float lo, float hi) { return f2bf(lo) | (f2bf(hi) << 16); }
__device__ __forceinline__ float bf2f(unsigned h) { return __builtin_bit_cast(float, h << 16); }
__device__ __forceinline__ float bflo(unsigned w) { return __builtin_bit_cast(float, w << 16); }
__device__ __forceinline__ float bfhi(unsigned w) { return __builtin_bit_cast(float, w & 0xffff0000u); }

#define XB_TMO      128
#define XB_XCNT(j)  (256  + 64 * (j))
#define XB_XSUB(j)  (1280 + 64 * (j))
#define XB_XGEN(j)  (2304 + 64 * (j))
#define XB_TOP      3328
#define XB_TOPGEN   3392
#define XCD_BAR_WORDS 3456
#define XB_SPIN_CAP (1u << 18)
__device__ __forceinline__ unsigned xb_ld(unsigned* p)              { return __hip_atomic_load(p, __ATOMIC_RELAXED, __HIP_MEMORY_SCOPE_AGENT); }
__device__ __forceinline__ unsigned xb_add(unsigned* p, unsigned v) { return __hip_atomic_fetch_add(p, v, __ATOMIC_RELAXED, __HIP_MEMORY_SCOPE_AGENT); }
__device__ __forceinline__ unsigned xb_xcc_id() { return (unsigned)__builtin_amdgcn_s_getreg((3 << 11) | 20) & 0xFu; }
#define XB_SPIN(cond, bar) do { unsigned _sp = 0; while (cond) { __builtin_amdgcn_s_sleep(1); \
    if ((++_sp & 255u) == 0u) { if (xb_ld(&(bar)[XB_TMO])) break; if (_sp > XB_SPIN_CAP) { atomicAdd(&(bar)[XB_TMO], 1u); break; } } } } while (0)
struct XcdBarrier { unsigned* bar; unsigned x; volatile LAS unsigned* st; };
__device__ __forceinline__ XcdBarrier xcd_barrier_post(unsigned* bar, volatile LAS unsigned* st) {
    XcdBarrier b; b.bar = bar; b.x = xb_xcc_id(); b.st = st;
    if (threadIdx.x == 0) (void)xb_add(&bar[XB_XCNT(b.x)], 1u);
    return b;
}
__device__ __forceinline__ void xcd_barrier_complete(unsigned* bar, unsigned x, unsigned& nloc, unsigned& nx) {
    const unsigned G = gridDim.x * gridDim.y * gridDim.z;
    unsigned sum, cnt, mine, sp = 0u;
    for (;;) {
        sum = 0u; cnt = 0u; mine = 0u;
#pragma unroll
        for (unsigned j = 0; j < 16; ++j) { const unsigned c = xb_ld(&bar[XB_XCNT(j)]); sum += c; cnt += (c > 0u) ? 1u : 0u; mine = (j == x) ? c : mine; }
        if (sum == G) break;
        __builtin_amdgcn_s_sleep(1);
        if ((++sp & 255u) == 0u) { if (xb_ld(&bar[XB_TMO])) break; if (sp > XB_SPIN_CAP) { atomicAdd(&bar[XB_TMO], 1u); break; } }
    }
    nloc = mine > 0u ? mine : 1u; nx = cnt > 0u ? cnt : 1u;
}
__device__ __forceinline__ void xcd_barrier(const XcdBarrier& b) {
    asm volatile("s_waitcnt vmcnt(0)" ::: "memory");
    __syncthreads();
    if (threadIdx.x == 0) {
        unsigned* bar = b.bar;
        __builtin_amdgcn_s_waitcnt(0);
        unsigned nloc = b.st[0], nx = b.st[1];
        if (nloc == 0u) { xcd_barrier_complete(bar, b.x, nloc, nx); b.st[0] = nloc; b.st[1] = nx; }
        const unsigned old = xb_add(&bar[XB_XSUB(b.x)], 1u);
        const unsigned gen = old / nloc;
        if (old + 1u == (gen + 1u) * nloc) {
            __builtin_amdgcn_fence(__ATOMIC_RELEASE, "agent");
            asm volatile("s_waitcnt vmcnt(0)" ::: "memory");
            const unsigned og = xb_add(&bar[XB_TOP], 1u);
            const unsigned tg = og / nx;
            if (og + 1u == (tg + 1u) * nx) xb_add(&bar[XB_TOPGEN], 1u);
            else XB_SPIN(xb_ld(&bar[XB_TOPGEN]) == tg, bar);
            __builtin_amdgcn_fence(__ATOMIC_ACQUIRE, "agent");
            xb_add(&bar[XB_XGEN(b.x)], 1u);
            asm volatile("s_waitcnt vmcnt(0)" ::: "memory");
        } else {
            XB_SPIN(xb_ld(&bar[XB_XGEN(b.x)]) == gen, bar);
            __builtin_amdgcn_fence(__ATOMIC_ACQUIRE, "agent");
            asm volatile("s_waitcnt vmcnt(0)" ::: "memory");
        }
    }
    __syncthreads();
}

struct Frame {
    LAS unsigned char* lds;
    volatile LAS unsigned* MISC;
    gu32* ctl;
    int tid, lane, wave;
    int vcu, G;
    unsigned char* ws;
    const float *x, *mix_g, *w_in, *w_gf, *b_gf, *w_gb, *b_gb, *gla_hg, *q_g, *k_g, *w_out, *ffn_g, *w_router, *b_router, *w1, *b1, *w2, *b2, *fin_g;
    float* out;
};
__device__ __forceinline__ float wave_sum(float v) {
#pragma unroll
    for (int o = 1; o < 64; o <<= 1) v += __shfl_xor(v, o);
    return v;
}
__device__ __forceinline__ void p0_tr64(const float* src  , int ldw, bf16* d0, bf16* d1, int ldt, LAS float* scr, int lane, int ncols) {
    const int c4 = (lane & 15) * 4, kr = lane >> 4;
    if (c4 < ncols) {
#pragma unroll 4
        for (int i = 0; i < 16; ++i) { const int kk = kr + 4 * i; const f32x4 v = *(const GAS f32x4*)(src + (size_t)kk * ldw + c4);
            LAS float* s = scr + kk * 65 + c4; s[0] = v.x; s[1] = v.y; s[2] = v.z; s[3] = v.w; }
    }
    LDS_WAIT(); asm volatile("" ::: "memory");
    const int c = lane & 7;
#pragma unroll
    for (int j = 0; j < 8; ++j) { const int n = (lane >> 3) + 8 * j;
        if (n < ncols) { const LAS float* s = scr + (8 * c) * 65 + n;
            v4u o; o.x = pk2(s[0 * 65], s[1 * 65]); o.y = pk2(s[2 * 65], s[3 * 65]); o.z = pk2(s[4 * 65], s[5 * 65]); o.w = pk2(s[6 * 65], s[7 * 65]);
            bf16* rowp = (n < 32 ? d0 : d1) + (size_t)(n & 31) * ldt;
            *(GAS v4u*)(rowp + 8 * c) = o; } }
    LDS_WAIT(); asm volatile("" ::: "memory");
}
__device__ __forceinline__ void p0_tr64_f8(const float* src, int ldw, unsigned char* d0, unsigned char* d1, int ldt, LAS float* scr, int lane, float sc) {
    const int c4 = (lane & 15) * 4, kr = lane >> 4;
#pragma unroll 4
    for (int i = 0; i < 16; ++i) { const int kk = kr + 4 * i; const f32x4 v = *(const GAS f32x4*)(src + (size_t)kk * ldw + c4);
        LAS float* s = scr + kk * 65 + c4; s[0] = v.x; s[1] = v.y; s[2] = v.z; s[3] = v.w; }
    LDS_WAIT(); asm volatile("" ::: "memory");
    const int c = lane & 7;
#pragma unroll
    for (int j = 0; j < 8; ++j) { const int n = (lane >> 3) + 8 * j; const LAS float* s = scr + (8 * c) * 65 + n;
        int w0 = 0, w1 = 0;
        w0 = __builtin_amdgcn_cvt_pk_fp8_f32(s[0 * 65] * sc, s[1 * 65] * sc, w0, false); w0 = __builtin_amdgcn_cvt_pk_fp8_f32(s[2 * 65] * sc, s[3 * 65] * sc, w0, true);
        w1 = __builtin_amdgcn_cvt_pk_fp8_f32(s[4 * 65] * sc, s[5 * 65] * sc, w1, false); w1 = __builtin_amdgcn_cvt_pk_fp8_f32(s[6 * 65] * sc, s[7 * 65] * sc, w1, true);
        unsigned char* rowp = (n < 32 ? d0 : d1) + (size_t)(n & 31) * ldt;
        *(GAS v2u*)(rowp + 8 * c) = (v2u){(unsigned)w0, (unsigned)w1}; }
    LDS_WAIT(); asm volatile("" ::: "memory");
}
__device__ __forceinline__ int win_pblk(int lb) { return lb < 48 ? lb : (lb == 48 ? 72 : lb - 1); }
__device__ __forceinline__ int w1_pblk(int lb) { return lb < 32 ? (lb >> 2) * 8 + (lb & 3) : ((lb - 32) >> 2) * 8 + 4 + ((lb - 32) & 3); }
__device__ __forceinline__ void rms_row_to_bf16(const float* xrow, const float* g, bf16* orow, int lane) {
    const GAS f32x4* xr = (const GAS f32x4*)xrow + lane; const GAS f32x4* gr = (const GAS f32x4*)g + lane;
    f32x4 v[4]; float s = 0.f;
#pragma unroll
    for (int j = 0; j < 4; ++j) { v[j] = xr[64 * j]; s += (v[j].x * v[j].x + v[j].y * v[j].y) + (v[j].z * v[j].z + v[j].w * v[j].w); }
    const float rinv = 1.f / sqrtf(wave_sum(s) * (1.f / 1024.f) + EPS);
    GAS unsigned long long* o8 = (GAS unsigned long long*)orow + lane;
#pragma unroll
    for (int j = 0; j < 4; ++j) { const f32x4 gg = gr[64 * j];
        o8[64 * j] = (unsigned long long)pk2(v[j].x * rinv * gg.x, v[j].y * rinv * gg.y) | ((unsigned long long)pk2(v[j].z * rinv * gg.z, v[j].w * rinv * gg.w) << 32); }
}
__device__ __forceinline__ void p0_prologue(Frame& F) {
    LAS float* scr = (LAS float*)(F.lds + F.wave * 16640);
    const int gw = F.vcu * NWAVES + F.wave, NGW = F.G * NWAVES;
    bf16* WIN = (bf16*)(F.ws + WS_WIN); bf16* WOUT = (bf16*)(F.ws + WS_WOUT); unsigned char* W1T = F.ws + WS_W1; unsigned char* W2T = F.ws + WS_W2;
    constexpr int I_IN = 16 * 37, I_OUT = 16 * 16, I_1 = NEXP * 16 * 32, I_2 = NEXP * 16 * 16, NITEMS = I_IN + I_OUT + I_1 + I_2;
    for (int it = gw; it < NITEMS; it += NGW) {
        int r = it;
        if (r < I_IN) { const int kb = r / 37, nb = r % 37; const int lb0 = 2 * nb, nc = (nb == 36) ? 32 : 64;
            p0_tr64(F.w_in + (size_t)(64 * kb) * D_IN + 64 * nb, D_IN, WIN + (size_t)(32 * win_pblk(lb0)) * 1024 + 64 * kb, WIN + (size_t)(32 * win_pblk(lb0 + 1 < 73 ? lb0 + 1 : lb0)) * 1024 + 64 * kb, 1024, scr, F.lane, nc); continue; }
        r -= I_IN;
        if (r < I_OUT) { const int kb = r / 16, nb = r % 16;
            p0_tr64(F.w_out + (size_t)(64 * kb) * 1024 + 64 * nb, 1024, WOUT + (size_t)(64 * nb) * 1024 + 64 * kb, WOUT + (size_t)(64 * nb + 32) * 1024 + 64 * kb, 1024, scr, F.lane, 64); continue; }
        r -= I_OUT;
        if (r < I_1) { const int e = r / 512, q = r % 512, kb = q / 32, nb = q % 32; const float* src = F.w1 + (size_t)e * 1024 * 2048 + (size_t)(64 * kb) * 2048 + 64 * nb; unsigned char* dst = W1T + (size_t)e * 2048 * 1024 + 64 * kb;
            p0_tr64_f8(src, 2048, dst + (size_t)(32 * w1_pblk(2 * nb)) * 1024, dst + (size_t)(32 * w1_pblk(2 * nb + 1)) * 1024, 1024, scr, F.lane, WSCALE); continue; }
        r -= I_1;
        { const int e = r / 256, q = r % 256, kb = q / 16, nb = q % 16; const float* src = F.w2 + (size_t)e * 1024 * 1024 + (size_t)(64 * kb) * 1024 + 64 * nb; unsigned char* dst = W2T + (size_t)e * 1024 * 1024 + 64 * kb;
            p0_tr64_f8(src, 1024, dst + (size_t)(64 * nb) * 1024, dst + (size_t)(64 * nb + 32) * 1024, 1024, scr, F.lane, WSCALE); }
    }
    { const int gt = F.vcu * (NWAVES * 64) + F.tid, NGT = F.G * NWAVES * 64; GAS v4u* z = (GAS v4u*)(WIN + (size_t)D_IN * 1024);
      for (int i = gt; i < (D_IN_PAD - D_IN) * 1024 * 2 / 16; i += NGT) z[i] = (v4u){0u, 0u, 0u, 0u};
      bf16* WRH = (bf16*)(F.ws + WS_WRH); bf16* WRL = (bf16*)(F.ws + WS_WRL);
      for (int i = gt; i < NEXP * 1024; i += NGT) { const int e = i >> 10, k = i & 1023; const float w = F.w_router[(size_t)k * NEXP + e]; const unsigned h = f2bf(w); WRH[i] = (bf16)h; WRL[i] = (bf16)f2bf(w - bf2f(h)); } }
    bf16* XN = (bf16*)(F.ws + WS_XN);
    for (int m = gw; m < T; m += NGW) rms_row_to_bf16(F.x + (size_t)m * DM, F.mix_g, XN + (size_t)m * DM, F.lane);
}

__device__ __forceinline__ void p2_normrope(Frame& F) {
    LAS float* cs = (LAS float*)F.lds;
    for (int i = F.tid; i < 1024; i += NWAVES * 64) { const int pos = i >> 4, fi = i & 15; const float inv = exp2f(-(float)fi * (13.287712379549449f / 16.f)); const float a = (float)pos * inv;
        cs[2 * i] = __cosf(a); cs[2 * i + 1] = __sinf(a); }
    __syncthreads();
    const int gw = F.vcu * NWAVES + F.wave, NGW = F.G * NWAVES, lane = F.lane;
    const int j = lane & 7, blk = (j >> 2) & 1, jj = j & 3, fi0 = 8 * (jj & 1); const bool second = (jj >> 1) != 0;
    float gq[8], gk[8];
#pragma unroll
    for (int e = 0; e < 8; ++e) { gq[e] = F.q_g[8 * j + e]; gk[e] = F.k_g[8 * j + e]; }
    bf16* AQ = (bf16*)(F.ws + WS_AQ); bf16* AK = (bf16*)(F.ws + WS_AK);
    for (int it = T + gw; it < T + T / 4; it += NGW) {
        const bool isq = it < T;
        const int tok = isq ? it : 4 * (it - T) + (lane >> 4);
        GAS v4u* p = isq ? (GAS v4u*)(AQ + (size_t)tok * 512) + lane : (GAS v4u*)(AK + (size_t)tok * 128) + (lane & 15);
        const v4u w = *p;
        float x[8] = {bflo(w.x), bfhi(w.x), bflo(w.y), bfhi(w.y), bflo(w.z), bfhi(w.z), bflo(w.w), bfhi(w.w)};
        float ss = 0.f;
#pragma unroll
        for (int e = 0; e < 8; ++e) ss += x[e] * x[e];
        ss += __shfl_xor(ss, 1); ss += __shfl_xor(ss, 2); ss += __shfl_xor(ss, 4);
        const float rinv = 1.f / sqrtf(ss * (1.f / 64.f) + EPS);
        const int ts = tok & (SEQ - 1), pos = blk ? (ts & 63) : (ts >> 6);
        const LAS float* c = cs + (pos * 16 + fi0) * 2;
        float y[8];
#pragma unroll
        for (int e = 0; e < 8; ++e) { x[e] = x[e] * rinv * (isq ? gq[e] : gk[e]); }
#pragma unroll
        for (int e = 0; e < 8; ++e) { const float pr = __shfl_xor(x[e], 2); const float co = c[2 * e], si = c[2 * e + 1]; y[e] = second ? (x[e] * co + pr * si) : (x[e] * co - pr * si); }
        const float sc = isq ? attn_body::C2 : 1.f;
        v4u o; o.x = pk2(y[0] * sc, y[1] * sc); o.y = pk2(y[2] * sc, y[3] * sc); o.z = pk2(y[4] * sc, y[5] * sc); o.w = pk2(y[6] * sc, y[7] * sc);
        *p = o;
    }
}
namespace gla {
typedef short bf16x8 __attribute__((ext_vector_type(8)));
typedef short s16x4 __attribute__((ext_vector_type(4)));
typedef float f32x4 __attribute__((ext_vector_type(4)));
constexpr int P64 = 144, PV = 272, POT = 528;
constexpr int L_QS = 0, L_KS = 9216, L_VR = 18432, L_AS = 35840, L_ST = 45056, L_DEC = 63488, L_OT = 63744, L_END = 97536;
__device__ __forceinline__ unsigned cvtpk(float lo, float hi) { typedef float f2_t __attribute__((ext_vector_type(2))); typedef __bf16 b2_t __attribute__((ext_vector_type(2))); f2_t v = {lo, hi}; b2_t b = __builtin_convertvector(v, b2_t); return __builtin_bit_cast(unsigned, b); }
__device__ __forceinline__ float logsig(float x) { return fminf(x, 0.f) - __logf(1.f + __expf(-fabsf(x))); }
__device__ __forceinline__ s16x4 vtr(const LAS unsigned char* p) { typedef short v4i16_t __attribute__((ext_vector_type(4))); return __builtin_bit_cast(s16x4, __builtin_amdgcn_ds_read_tr16_b64_v4i16((LAS v4i16_t*)p)); }

__device__ __forceinline__ void gla_prep_unit(Frame& F, int b, int c) {
    LAS unsigned char* L = F.lds;
    const int tid = F.tid, dir = __builtin_amdgcn_readfirstlane(tid >> 8), col = tid & 255;
    const bf16* GQ = (const bf16*)(F.ws + WS_GQ); const bf16* GK = (const bf16*)(F.ws + WS_GK); const bf16* ZZ = (const bf16*)(F.ws + WS_Z);
    bf16* QX = (bf16*)(F.ws + (dir ? WS_QB : WS_QF)); bf16* KX = (bf16*)(F.ws + (dir ? WS_KB : WS_KF)); float* DEC = (float*)(F.ws + WS_DEC) + (size_t)dir * (BATCH * 64 * 256);
    const unsigned row0 = (unsigned)b * SEQ + (unsigned)c * 64u;
    __syncthreads();
    if (tid < 256) { const int row = tid >> 2, seg = tid & 3; const v4u z = *(const GAS v4u*)(ZZ + (row0 + row) * 32 + seg * 8); LAS f32x4* zp = (LAS f32x4*)(L + row * 128 + seg * 32);
        zp[0] = (f32x4){bflo(z.x), bfhi(z.x), bflo(z.y), bfhi(z.y)}; zp[1] = (f32x4){bflo(z.z), bfhi(z.z), bflo(z.w), bfhi(z.w)}; }
    float wg[16]; const float* WG = dir ? F.w_gb : F.w_gf;
#pragma unroll
    for (int r = 0; r < 16; ++r) wg[r] = WG[r * 256 + col];
    const float bgv = (dir ? F.b_gb : F.b_gf)[col];
    __syncthreads();
    float pf[64]; float run = 0.f;
#pragma unroll
    for (int p = 0; p < 64; ++p) { const LAS f32x4* zp = (const LAS f32x4*)(L + p * 128 + dir * 64); float pre = bgv;
#pragma unroll
        for (int r4 = 0; r4 < 4; ++r4) { const f32x4 z = zp[r4]; pre += z.x * wg[4 * r4] + z.y * wg[4 * r4 + 1] + z.z * wg[4 * r4 + 2] + z.w * wg[4 * r4 + 3]; }
        run += logsig(pre) * (1.f / 16.f); pf[p] = run; }
    const float tot = run;
#pragma unroll
    for (int p = 0; p < 64; ++p) { const unsigned idx = (row0 + p) * 256 + col;
        const float qv = bf2f(GQ[idx]), kv = bf2f(GK[idx]);
        const float ex = dir ? (p ? pf[p - 1] : 0.f) : 0.f;
        const float eq = dir ? __expf(-ex) * 0.125f : __expf(pf[p] - tot) * 0.125f;
        const float ek = dir ? __expf(ex) : __expf(tot - pf[p]);
        QX[idx] = (bf16)f2bf(qv * eq); KX[idx] = (bf16)f2bf(kv * ek); }
    DEC[((unsigned)b * 64 + c) * 256 + col] = __expf(tot);
}

__device__ __forceinline__ void gla_unit(Frame& F, int b, int h, int dir) {
    LAS unsigned char* L = F.lds;
    const int tid = F.tid, lane = F.lane, w = F.wave, q4 = lane >> 4, l15 = lane & 15;
    const bf16* GV = (const bf16*)(F.ws + WS_GV);
    bf16* OX = (bf16*)(F.ws + WS_OF + (dir ? 32 * MiB : 0));
    const unsigned rowbase = (unsigned)b * SEQ;
    const int v0 = 16 * w;
    const int erow = tid >> 3, eseg = tid & 7;
    const int plq = tid >> 3, sgq = tid & 7, plv = tid >> 4, sgv = tid & 15;
    {
        const bf16* QX = (const bf16*)(F.ws + (dir ? WS_QB : WS_QF)); const bf16* KX = (const bf16*)(F.ws + (dir ? WS_KB : WS_KF));
        const float* DEC = (const float*)(F.ws + WS_DEC) + (size_t)dir * (BATCH * 64 * 256);
        f32x4 S[4];
#pragma unroll
        for (int i = 0; i < 4; ++i) S[i] = (f32x4){0.f, 0.f, 0.f, 0.f};
        v4u rq, rk, rv0, rv1; float rdec = 0.f;
#define GLA_LOAD(ci) do { const int c_ = dir ? 63 - (ci) : (ci); const unsigned cb_ = rowbase + (unsigned)c_ * 64u; \
            rq = *(const GAS v4u*)(QX + (cb_ + plq) * 256 + h * 64 + sgq * 8); rk = *(const GAS v4u*)(KX + (cb_ + plq) * 256 + h * 64 + sgq * 8); \
            rv0 = *(const GAS v4u*)(GV + (cb_ + plv) * 512 + h * 128 + sgv * 8); rv1 = *(const GAS v4u*)(GV + (cb_ + plv + 32) * 512 + h * 128 + sgv * 8); \
            if (tid < 64) rdec = DEC[((unsigned)b * 64 + c_) * 256 + h * 64 + tid]; } while (0)
        GLA_LOAD(0);
        v4u st0 = (v4u){0u, 0u, 0u, 0u}, st1 = st0;
#define GLA_FLUSH(cprev) do { const unsigned cbp_ = rowbase + (unsigned)(cprev) * 64u; GAS v4u* sp_ = (GAS v4u*)(OX + (cbp_ + erow) * 512 + h * 128 + eseg * 16); sp_[0] = st0; sp_[1] = st1; } while (0)
        for (int ci = 0; ci < 64; ++ci) {
            const int c = dir ? 63 - ci : ci;
            *(LAS v4u*)(L + L_QS + plq * P64 + sgq * 16) = rq; *(LAS v4u*)(L + L_KS + plq * P64 + sgq * 16) = rk;
            *(LAS v4u*)(L + L_VR + plv * PV + sgv * 16) = rv0; *(LAS v4u*)(L + L_VR + (plv + 32) * PV + sgv * 16) = rv1;
            if (tid < 64) ((LAS float*)(L + L_DEC))[tid] = rdec;
            asm volatile("" ::: "memory");
            if (ci > 0) GLA_FLUSH(dir ? c + 1 : c - 1);
            asm volatile("" ::: "memory");
            if (ci + 1 < 64) GLA_LOAD(ci + 1);
            __syncthreads();
#pragma unroll
            for (int s = 0; s < 2; ++s) { const int tt = 2 * w + s, it = tt >> 2, jt = tt & 3; f32x4 a = (f32x4){0.f, 0.f, 0.f, 0.f};
#pragma unroll
                for (int ks = 0; ks < 2; ++ks) { const bf16x8 af = *(const LAS bf16x8*)(L + L_QS + (16 * it + l15) * P64 + (32 * ks + 8 * q4) * 2); const bf16x8 bfr = *(const LAS bf16x8*)(L + L_KS + (16 * jt + l15) * P64 + (32 * ks + 8 * q4) * 2);
                    a = __builtin_amdgcn_mfma_f32_16x16x32_bf16(af, bfr, a, 0, 0, 0); }
#pragma unroll
                for (int rg = 0; rg < 4; ++rg) { const int i = 16 * it + 4 * q4 + rg, j = 16 * jt + l15; const bool keep = dir ? (j > i) : (j <= i);
                    *(LAS unsigned short*)(L + L_AS + i * P64 + j * 2) = (unsigned short)cvtpk(keep ? a[rg] : 0.f, 0.f); } }
#pragma unroll
            for (int dt = 0; dt < 4; ++dt) { const f32x4 dv = *(const LAS f32x4*)(L + L_DEC + (16 * dt + 4 * q4) * 4); S[dt] = S[dt] * dv;
                *(LAS v2u*)(L + L_ST + (v0 + l15) * P64 + (16 * dt + 4 * q4) * 2) = (v2u){cvtpk(S[dt].x, S[dt].y), cvtpk(S[dt].z, S[dt].w)}; }
            __syncthreads();
            bf16x8 bv[2], bs[2];
#pragma unroll
            for (int ks = 0; ks < 2; ++ks) { const LAS unsigned char* vp = L + L_VR + (32 * ks + 8 * q4 + (l15 >> 2)) * PV + (v0 + 4 * (l15 & 3)) * 2;
                const s16x4 lo = vtr(vp), hi = vtr(vp + 4 * PV); bv[ks] = (bf16x8){lo[0], lo[1], lo[2], lo[3], hi[0], hi[1], hi[2], hi[3]};
                bs[ks] = *(const LAS bf16x8*)(L + L_ST + (v0 + l15) * P64 + (32 * ks + 8 * q4) * 2); }
            f32x4 O[4];
#pragma unroll
            for (int it = 0; it < 4; ++it) { O[it] = (f32x4){0.f, 0.f, 0.f, 0.f};
#pragma unroll
                for (int ks = 0; ks < 2; ++ks) { const bf16x8 aa = *(const LAS bf16x8*)(L + L_AS + (16 * it + l15) * P64 + (32 * ks + 8 * q4) * 2); const bf16x8 aq = *(const LAS bf16x8*)(L + L_QS + (16 * it + l15) * P64 + (32 * ks + 8 * q4) * 2);
                    O[it] = __builtin_amdgcn_mfma_f32_16x16x32_bf16(aa, bv[ks], O[it], 0, 0, 0); O[it] = __builtin_amdgcn_mfma_f32_16x16x32_bf16(aq, bs[ks], O[it], 0, 0, 0); } }
#pragma unroll
            for (int dt = 0; dt < 4; ++dt)
#pragma unroll
                for (int ks = 0; ks < 2; ++ks) { const LAS unsigned char* kp = L + L_KS + (32 * ks + 8 * q4 + (l15 >> 2)) * P64 + (16 * dt + 4 * (l15 & 3)) * 2;
                    const s16x4 lo = vtr(kp), hi = vtr(kp + 4 * P64); const bf16x8 ak = (bf16x8){lo[0], lo[1], lo[2], lo[3], hi[0], hi[1], hi[2], hi[3]};
                    S[dt] = __builtin_amdgcn_mfma_f32_16x16x32_bf16(ak, bv[ks], S[dt], 0, 0, 0); }
#pragma unroll
            for (int it = 0; it < 4; ++it)
#pragma unroll
                for (int rg = 0; rg < 4; ++rg) *(LAS float*)(L + L_OT + (16 * it + 4 * q4 + rg) * POT + (v0 + l15) * 4) = O[it][rg];
            __syncthreads();
            {
                float o[16];
#pragma unroll
                for (int e4 = 0; e4 < 4; ++e4) { const f32x4 t = *(const LAS f32x4*)(L + L_OT + erow * POT + (16 * eseg + 4 * e4) * 4); o[4 * e4] = t.x; o[4 * e4 + 1] = t.y; o[4 * e4 + 2] = t.z; o[4 * e4 + 3] = t.w; }
                st0 = (v4u){cvtpk(o[0], o[1]), cvtpk(o[2], o[3]), cvtpk(o[4], o[5]), cvtpk(o[6], o[7])}; st1 = (v4u){cvtpk(o[8], o[9]), cvtpk(o[10], o[11]), cvtpk(o[12], o[13]), cvtpk(o[14], o[15])};
            }
        }
        GLA_FLUSH(dir ? 0 : 63);
#undef GLA_FLUSH
#undef GLA_LOAD
    }
    VM_WAIT(); __syncthreads();
    if (tid == 0) { __builtin_amdgcn_fence(__ATOMIC_RELEASE, "agent"); VM_WAIT(); (void)__hip_atomic_fetch_add(F.ctl + CW_GDN + 64 * (b * GLA_H + h), 1u, RLX_AGENT); }
    __syncthreads();
}
__device__ __forceinline__ void gla_combine(Frame& F, int b, int h, int part) {
    const int tid = F.tid, erow = tid >> 3, eseg = tid & 7;
    if (tid == 0) { unsigned sp = 0; while (__hip_atomic_load(F.ctl + CW_GDN + 64 * (b * GLA_H + h), RLX_AGENT) < 2u && sp < (1u << 22)) { __builtin_amdgcn_s_sleep(8); ++sp; }
        __builtin_amdgcn_fence(__ATOMIC_ACQUIRE, "agent"); VM_WAIT(); }
    __syncthreads();
    const bf16* OF0 = (const bf16*)(F.ws + WS_OF); const bf16* OB0 = (const bf16*)(F.ws + WS_OF + 32 * MiB); const bf16* GR = (const bf16*)(F.ws + WS_GR); bf16* MIX = (bf16*)(F.ws + WS_MIX);
    float hg[16]; int eso = eseg; asm volatile("" : "+v"(eso));
#pragma unroll
    for (int e = 0; e < 16; ++e) hg[e] = F.gla_hg[16 * eso + e];
    const unsigned r0 = (unsigned)b * SEQ + (unsigned)part * 1024u + erow;
#pragma unroll 2
    for (int ps = 0; ps < 16; ++ps) { const unsigned row = r0 + ps * 64;
        const GAS v4u* fp = (const GAS v4u*)(OF0 + row * 512 + h * 128 + eseg * 16); const GAS v4u* bp = (const GAS v4u*)(OB0 + row * 512 + h * 128 + eseg * 16); const GAS v4u* rp = (const GAS v4u*)(GR + row * 512 + h * 128 + eseg * 16);
        const v4u f0 = fp[0], f1 = fp[1], b0 = bp[0], b1 = bp[1], r0v = rp[0], r1v = rp[1];
        const unsigned fw[8] = {f0.x, f0.y, f0.z, f0.w, f1.x, f1.y, f1.z, f1.w}, bw[8] = {b0.x, b0.y, b0.z, b0.w, b1.x, b1.y, b1.z, b1.w}, rw[8] = {r0v.x, r0v.y, r0v.z, r0v.w, r1v.x, r1v.y, r1v.z, r1v.w};
        float o[16]; float ss = 0.f;
#pragma unroll
        for (int e2 = 0; e2 < 8; ++e2) { o[2 * e2] = bflo(fw[e2]) + bflo(bw[e2]); o[2 * e2 + 1] = bfhi(fw[e2]) + bfhi(bw[e2]); ss += o[2 * e2] * o[2 * e2] + o[2 * e2 + 1] * o[2 * e2 + 1]; }
        ss += __shfl_xor(ss, 1); ss += __shfl_xor(ss, 2); ss += __shfl_xor(ss, 4);
        const float rinv = __builtin_amdgcn_rsqf(ss * (1.f / 128.f) + EPS);
        unsigned ow[8];
#pragma unroll
        for (int e2 = 0; e2 < 8; ++e2) { const float x0 = bflo(rw[e2]), x1 = bfhi(rw[e2]);
            const float y0 = o[2 * e2] * rinv * hg[2 * e2] * (x0 * __builtin_amdgcn_rcpf(1.f + __expf(-x0))), y1 = o[2 * e2 + 1] * rinv * hg[2 * e2 + 1] * (x1 * __builtin_amdgcn_rcpf(1.f + __expf(-x1))); ow[e2] = cvtpk(y0, y1); }
        GAS v4u* mp = (GAS v4u*)(MIX + row * 1024 + h * 128 + eseg * 16);
        mp[0] = (v4u){ow[0], ow[1], ow[2], ow[3]}; mp[1] = (v4u){ow[4], ow[5], ow[6], ow[7]}; }
}
}
struct DenseMap { static constexpr bool GATHER = false;
    const bf16* A; const bf16* Bt; int K;
    __device__ __forceinline__ __amdgpu_buffer_rsrc_t a_rsrc() const { return __builtin_amdgcn_make_buffer_rsrc((void*)A, 0, 0x7fffffff, 0x00020000); }
    __device__ __forceinline__ __amdgpu_buffer_rsrc_t b_rsrc() const { return __builtin_amdgcn_make_buffer_rsrc((void*)Bt, 0, 0x7fffffff, 0x00020000); }
    __device__ __forceinline__ unsigned a_soff(const pg8::Unit& u) const { return (unsigned)u.pm * 256u * (unsigned)K * 2u; }
    __device__ __forceinline__ unsigned b_soff(const pg8::Unit& u) const { return (unsigned)u.pn * 256u * (unsigned)K * 2u; }
    __device__ __forceinline__ void a_off(const pg8::Unit&, const int (&R)[2], const int (&C)[2], unsigned (&vo)[2][2]) const {
#pragma unroll
        for (int h = 0; h < 2; ++h)
#pragma unroll
            for (int i = 0; i < 2; ++i) vo[h][i] = (unsigned)((h * 128 + R[i]) * K + C[i]) * 2u; }
};
struct MoeTabs { const LAS int* cnt; const LAS int* cst; const LAS unsigned short* te; };
struct MoeMapUp { static constexpr bool GATHER = true;
    const unsigned char* A; const unsigned char* Bt; const int* rowtok; MoeTabs tb;
    __device__ __forceinline__ __amdgpu_buffer_rsrc_t a_rsrc() const { return __builtin_amdgcn_make_buffer_rsrc((void*)A, 0, 0x7fffffff, 0x00020000); }
    __device__ __forceinline__ __amdgpu_buffer_rsrc_t b_rsrc() const { return __builtin_amdgcn_make_buffer_rsrc((void*)Bt, 0, 0x7fffffff, 0x00020000); }
    __device__ __forceinline__ unsigned a_soff(const pg8::Unit&) const { return 0u; }
    __device__ __forceinline__ unsigned b_soff(const pg8::Unit& u) const { const unsigned e = tb.te[u.pm]; return (e * 2048u + (unsigned)u.pn * 256u) * 1024u; }
    __device__ __forceinline__ void a_raw(const pg8::Unit& u, const int (&R)[2], unsigned (&raw)[2][2]) const {
        const int e = tb.te[u.pm], pos0 = (u.pm - tb.cst[e]) * 256, n = tb.cnt[e];
#pragma unroll
        for (int h = 0; h < 2; ++h)
#pragma unroll
            for (int i = 0; i < 2; ++i) { const int pos = pos0 + h * 128 + R[i]; raw[h][i] = (unsigned)rowtok[(size_t)e * EROWS + (pos < n ? pos : 0)]; } }
    __device__ __forceinline__ unsigned a_fin(unsigned tok, int C) const { return (tok * 512u + (unsigned)C) * 2u; }
    __device__ __forceinline__ void a_off(const pg8::Unit& u, const int (&R)[2], const int (&C)[2], unsigned (&vo)[2][2]) const {
        unsigned raw[2][2]; a_raw(u, R, raw);
#pragma unroll
        for (int h = 0; h < 2; ++h)
#pragma unroll
            for (int i = 0; i < 2; ++i) vo[h][i] = a_fin(raw[h][i], C[i]); }
};
struct MoeMapDown { static constexpr bool GATHER = false;
    const unsigned char* A; const unsigned char* Bt; MoeTabs tb;
    __device__ __forceinline__ __amdgpu_buffer_rsrc_t a_rsrc() const { return __builtin_amdgcn_make_buffer_rsrc((void*)A, 0, 0x7fffffff, 0x00020000); }
    __device__ __forceinline__ __amdgpu_buffer_rsrc_t b_rsrc() const { return __builtin_amdgcn_make_buffer_rsrc((void*)Bt, 0, 0x7fffffff, 0x00020000); }
    __device__ __forceinline__ unsigned a_soff(const pg8::Unit& u) const { return (unsigned)u.pm * 256u * 1024u; }
    __device__ __forceinline__ unsigned b_soff(const pg8::Unit& u) const { const unsigned e = tb.te[u.pm]; return (e * 1024u + (unsigned)u.pn * 256u) * 1024u; }
    __device__ __forceinline__ void a_off(const pg8::Unit&, const int (&R)[2], const int (&C)[2], unsigned (&vo)[2][2]) const {
#pragma unroll
        for (int h = 0; h < 2; ++h)
#pragma unroll
            for (int i = 0; i < 2; ++i) vo[h][i] = (unsigned)((h * 128 + R[i]) * 512 + C[i]) * 2u; }
};
using pg8::f32x4;
struct EpiInProj { static constexpr bool PERM = true, COLS64 = false;
    bf16 *gq, *gk, *gv, *gr, *aq, *ak, *av, *z;
    struct Pre {}; __device__ __forceinline__ void preload(const pg8::Unit&, int, int, int, int, Pre&) const {}
    __device__ __forceinline__ void operator()(const f32x4 (&acc)[2][2][4][2], const pg8::Unit& u, const Pre&, int wr, int wc, int fr, int fq) const {
        bf16* b0; bf16* b1; int ld;
        switch (u.pn) { case 0: b0 = gq; b1 = gq + 128; ld = 256; break; case 1: b0 = gk; b1 = gk + 128; ld = 256; break;
            case 2: b0 = gv; b1 = gv + 128; ld = 512; break; case 3: b0 = gv + 256; b1 = gv + 384; ld = 512; break;
            case 4: b0 = gr; b1 = gr + 128; ld = 512; break; case 5: b0 = gr + 256; b1 = gr + 384; ld = 512; break;
            case 6: b0 = aq; b1 = aq + 128; ld = 512; break; case 7: b0 = aq + 256; b1 = aq + 384; ld = 512; break;
            case 8: b0 = ak; b1 = av; ld = 128; break; default: b0 = z; b1 = z; ld = 32; break; }
        const bool zt = (u.pn == 9);
        if (zt && wc != 0) return;
        const int row0 = u.pm * 256 + wr * 64 + fr, cw = wc * 32 + 8 * fq;
#pragma unroll
        for (int ai = 0; ai < 2; ++ai)
#pragma unroll
            for (int m = 0; m < 4; ++m) { const size_t row = (size_t)(row0 + ai * 128 + m * 16);
#pragma unroll
                for (int bj = 0; bj < 2; ++bj) { if (zt && bj == 1) continue; const f32x4 v0 = acc[ai][bj][m][0], v1 = acc[ai][bj][m][1];
                    pg8::u32x4 wv; wv.x = pg8::cvt_pk_bf16(v0[0], v0[1]); wv.y = pg8::cvt_pk_bf16(v0[2], v0[3]); wv.z = pg8::cvt_pk_bf16(v1[0], v1[1]); wv.w = pg8::cvt_pk_bf16(v1[2], v1[3]);
                    *(pg8::u32x4*)((bj ? b1 : b0) + row * ld + cw) = wv; } }
    }
};
struct EpiResF32 { static constexpr bool PERM = false, COLS64 = false;
    const float* base; float* out;
    struct Pre {}; __device__ __forceinline__ void preload(const pg8::Unit&, int, int, int, int, Pre&) const {}
    __device__ __forceinline__ void operator()(const f32x4 (&acc)[2][2][4][2], const pg8::Unit& u, const Pre&, int wr, int wc, int fr, int fq) const {
        const int col0 = u.pn * 256 + wc * 32 + 4 * fq;
#pragma unroll
        for (int ai = 0; ai < 2; ++ai)
#pragma unroll
            for (int m = 0; m < 4; ++m) { const size_t off = (size_t)(u.pm * 256 + ai * 128 + wr * 64 + m * 16 + fr) * 1024 + col0;
#pragma unroll
                for (int bj = 0; bj < 2; ++bj)
#pragma unroll
                    for (int n = 0; n < 2; ++n) { const f32x4 bs = *(const f32x4*)(base + off + bj * 128 + n * 16); *(f32x4*)(out + off + bj * 128 + n * 16) = bs + acc[ai][bj][m][n]; } }
    }
};
struct EpiSwiglu { static constexpr bool PERM = true, COLS64 = false;
    const float* b1; unsigned char* act; MoeTabs tb;
    struct Pre { f32x4 g0, g1, l0, l1; };
    __device__ __forceinline__ void preload(const pg8::Unit& u, int wr, int wc, int fr, int fq, Pre& p) const {
        const int e = tb.te[u.pm]; const int col = u.pn * 128 + wc * 32 + 8 * fq; const float* bg = b1 + (size_t)e * 2048 + col; const float* bl = bg + 1024;
        p.g0 = *(const GAS f32x4*)bg; p.g1 = *(const GAS f32x4*)(bg + 4); p.l0 = *(const GAS f32x4*)bl; p.l1 = *(const GAS f32x4*)(bl + 4); }
    __device__ __forceinline__ void operator()(const f32x4 (&acc)[2][2][4][2], const pg8::Unit& u, const Pre& p, int wr, int wc, int fr, int fq) const {
        const int col = u.pn * 128 + wc * 32 + 8 * fq;
        const f32x4 g0 = p.g0, g1 = p.g1, l0 = p.l0, l1 = p.l1;
        const int row0 = u.pm * 256 + wr * 64 + fr;
#pragma unroll
        for (int ai = 0; ai < 2; ++ai)
#pragma unroll
            for (int m = 0; m < 4; ++m) { float o[8];
#pragma unroll
                for (int n = 0; n < 2; ++n)
#pragma unroll
                    for (int j = 0; j < 4; ++j) { const float gl = fminf(__builtin_fmaf(acc[ai][0][m][n][j], 1.f / WSCALE, (n ? g1[j] : g0[j])), 7.f); const float li = __builtin_amdgcn_fmed3f(__builtin_fmaf(acc[ai][1][m][n][j], 1.f / WSCALE, (n ? l1[j] : l0[j])), -7.f, 7.f);
                        o[4 * n + j] = (gl * ASCALE) * __builtin_amdgcn_rcpf(1.f + __builtin_amdgcn_exp2f(gl * (-1.702f * 1.4426950408889634f))) * (li + 1.f); }
                int w0 = 0, w1 = 0;
                w0 = __builtin_amdgcn_cvt_pk_fp8_f32(o[0], o[1], w0, false); w0 = __builtin_amdgcn_cvt_pk_fp8_f32(o[2], o[3], w0, true); w1 = __builtin_amdgcn_cvt_pk_fp8_f32(o[4], o[5], w1, false); w1 = __builtin_amdgcn_cvt_pk_fp8_f32(o[6], o[7], w1, true);
                *(v2u*)(act + (size_t)(row0 + ai * 128 + m * 16) * 1024 + col) = (v2u){(unsigned)w0, (unsigned)w1}; }
    }
};
struct EpiDown { static constexpr bool PERM = true, COLS64 = true;
    const float* b2; const float* rowgate; unsigned char* y; MoeTabs tb;
    struct Pre { f32x4 bv[2][2]; float gt[8]; };
    __device__ __forceinline__ void preload(const pg8::Unit& u, int wr, int wc, int fr, int fq, Pre& p) const {
        const int e = tb.te[u.pm], pos0 = (u.pm - tb.cst[e]) * 256, n_e = tb.cnt[e];
        const float* bb = b2 + (size_t)e * 1024 + u.pn * 256 + wc * 64 + 8 * fq;
#pragma unroll
        for (int bj = 0; bj < 2; ++bj)
#pragma unroll
            for (int n = 0; n < 2; ++n) p.bv[bj][n] = *(const GAS f32x4*)(bb + bj * 32 + 4 * n);
#pragma unroll
        for (int ai = 0; ai < 2; ++ai)
#pragma unroll
            for (int m = 0; m < 4; ++m) { const int pos = pos0 + wr * 64 + fr + ai * 128 + m * 16; const int pc_ = pos < n_e ? pos : 0; const float g = rowgate[(size_t)e * EROWS + pc_]; p.gt[ai * 4 + m] = (pos < n_e) ? g * YSCALE : 0.f; }
    }
    __device__ __forceinline__ void operator()(const f32x4 (&acc)[2][2][4][2], const pg8::Unit& u, const Pre& p, int wr, int wc, int fr, int fq) const {
        const bool odd = (fq & 1) != 0;
        const int colb = u.pn * 256 + wc * 64 + (odd ? 32 + 8 * (fq - 1) : 8 * fq), rl0 = wr * 64 + fr;
#pragma unroll
        for (int ai = 0; ai < 2; ++ai)
#pragma unroll
            for (int m = 0; m < 4; ++m) { const int rl = rl0 + ai * 128 + m * 16; const float gt = p.gt[ai * 4 + m];
                unsigned w[2][2];
#pragma unroll
                for (int bj = 0; bj < 2; ++bj) { const f32x4 v0 = (acc[ai][bj][m][0] * (1.f / (WSCALE * ASCALE)) + p.bv[bj][0]) * gt, v1 = (acc[ai][bj][m][1] * (1.f / (WSCALE * ASCALE)) + p.bv[bj][1]) * gt;
                    int w0 = 0, w1 = 0;
                    w0 = __builtin_amdgcn_cvt_pk_fp8_f32(v0[0], v0[1], w0, false); w0 = __builtin_amdgcn_cvt_pk_fp8_f32(v0[2], v0[3], w0, true); w1 = __builtin_amdgcn_cvt_pk_fp8_f32(v1[0], v1[1], w1, false); w1 = __builtin_amdgcn_cvt_pk_fp8_f32(v1[2], v1[3], w1, true);
                    w[bj][0] = (unsigned)w0; w[bj][1] = (unsigned)w1; }
                const unsigned s0 = odd ? w[0][0] : w[1][0], s1 = odd ? w[0][1] : w[1][1];
                const unsigned r0 = (unsigned)__shfl_xor((int)s0, 16), r1 = (unsigned)__shfl_xor((int)s1, 16);
                const pg8::u32x4 ov = odd ? (pg8::u32x4){r0, r1, w[1][0], w[1][1]} : (pg8::u32x4){w[0][0], w[0][1], r0, r1};
                *(pg8::u32x4*)(y + (size_t)(u.pm * 256 + rl) * 1024 + colb) = ov; }
    }
};
__device__ __forceinline__ int moe_tables(Frame& F) {
    LAS int* cnt = (LAS int*)(F.lds + LC_CNT); LAS int* cst = (LAS int*)(F.lds + LC_CST); LAS unsigned short* te = (LAS unsigned short*)(F.lds + LC_TE);
    __syncthreads();
    if (F.tid < NEXP) cnt[F.tid] = (int)__hip_atomic_load(F.ctl + CW_CNT + 64 * F.tid, RLX_AGENT);
    __syncthreads();
    if (F.tid == 0) { int s = 0; for (int e = 0; e < NEXP; ++e) { cst[e] = s; s += (cnt[e] + 255) >> 8; } cst[NEXP] = s; }
    __syncthreads();
    const int nt = cst[NEXP];
    for (int t = F.tid; t < nt; t += NWAVES * 64) { int e = 0;
#pragma unroll 1
        for (int k = 1; k < NEXP; ++k) e = (t >= cst[k]) ? k : e;
        te[t] = (unsigned short)e; }
    __syncthreads();
    return nt;
}
__device__ __forceinline__ void p3_mixers(Frame& F) {
    for (int u = blockIdx.x; u < 2 * BATCH * GLA_H; u += F.G) gla::gla_unit(F, u & 7, (u >> 3) & 3, u >> 5);
    const attn_body::bf16* Q = (const attn_body::bf16*)(F.ws + WS_AQ); const attn_body::bf16* K = (const attn_body::bf16*)(F.ws + WS_AK); const attn_body::bf16* V = (const attn_body::bf16*)(F.ws + WS_AV);
    attn_body::bf16* O = (attn_body::bf16*)(F.ws + WS_MIX);
    const int x0 = blockIdx.x & 7;
    float sbound;
    { float mq = fabsf(F.q_g[F.lane]), mk = fabsf(F.k_g[F.lane]);
#pragma unroll
      for (int o_ = 1; o_ < 64; o_ <<= 1) { mq = fmaxf(mq, __shfl_xor(mq, o_)); mk = fmaxf(mk, __shfl_xor(mk, o_)); }
      sbound = __builtin_bit_cast(float, __builtin_amdgcn_readfirstlane(__builtin_bit_cast(int, 64.f * attn_body::C2 * mq * mk * 1.02f))); }
    for (int qi = 0; qi < 8; ++qi) { const int x = (x0 + qi) & 7;
        for (;;) {
            __syncthreads();
            if (F.tid == 0) F.MISC[16] = __hip_atomic_fetch_add(F.ctl + CW_QUE + 64 * x, 1u, RLX_AGENT);
            __syncthreads();
            const int item = __builtin_amdgcn_readfirstlane((int)F.MISC[16]);
            if (item >= ATT_H * attn_body::NQB + 4 * GLA_H) break;
            if (item >= ATT_H * attn_body::NQB) { const int k = item - ATT_H * attn_body::NQB; gla::gla_combine(F, x, k >> 2, k & 3); continue; }
            attn_body::attn_unit<8>(x, item >> 4, item & 15, Q, K, V, O, (char*)F.lds, F.q_g, sbound);
        }
    }
}

__device__ __forceinline__ void p5_route(Frame& F) {
    typedef float f32x16 __attribute__((ext_vector_type(16)));
    LAS unsigned char* L = F.lds;
    constexpr int XP = 2064, L_XH = 0, L_XL = 32 * XP, L_PART = 0;
    const int tid = F.tid, lane = F.lane, w = F.wave, r32 = lane & 31, hi = lane >> 5;
    const bf16* WRH = (const bf16*)(F.ws + WS_WRH); const bf16* WRL = (const bf16*)(F.ws + WS_WRL);
    unsigned char* XN8 = F.ws + WS_XN;
    int* ROWTOK = (int*)(F.ws + WS_ROWTOK); float* ROWGATE = (float*)(F.ws + WS_ROWGATE); int* TOKASG = (int*)(F.ws + WS_TOKASG);
    gu32* CNT = F.ctl + CW_CNT;
    bf16x8 wh[8], wl[8];
#pragma unroll
    for (int ks = 0; ks < 8; ++ks) { const int k0 = 128 * w + 16 * ks + 8 * hi; wh[ks] = *(const GAS bf16x8*)(WRH + r32 * 1024 + k0); wl[ks] = *(const GAS bf16x8*)(WRL + r32 * 1024 + k0); }
    f32x4 g2[4];
#pragma unroll
    for (int j = 0; j < 4; ++j) g2[j] = *((const GAS f32x4*)F.ffn_g + lane + 64 * j);
    float brt[16];
#pragma unroll
    for (int r = 0; r < 16; ++r) brt[r] = F.b_router[(r & 3) + 8 * (r >> 2) + 4 * hi];
    LAS int* hist = (LAS int*)(L + LC_HIST); LAS int* basev = (LAS int*)(L + LC_BASE); LAS int* aep = (LAS int*)(L + LC_ASG); LAS float* agt = (LAS float*)(L + LC_ASG + 4096);
    constexpr int NGRP = T / 32;
    const int per = (NGRP + F.G - 1) / F.G, g0 = F.vcu * per, g1 = (g0 + per < NGRP) ? g0 + per : NGRP;
    for (int gb = g0; gb < g1; gb += 8) {
        const int nb = (g1 - gb < 8) ? g1 - gb : 8;
        __syncthreads();
        if (tid < NEXP) hist[tid] = 0;
        for (int bi = 0; bi < nb; ++bi) {
            const int t0 = 32 * (gb + bi);
            f32x4 hv[4][4];
#pragma unroll
            for (int rr = 0; rr < 4; ++rr) { const GAS f32x4* hp = (const GAS f32x4*)(F.out + (size_t)(t0 + 4 * w + rr) * 1024) + lane;
#pragma unroll
                for (int j = 0; j < 4; ++j) hv[rr][j] = hp[64 * j]; }
#pragma unroll
            for (int rr = 0; rr < 4; ++rr) { const int r = 4 * w + rr; const size_t tok = (size_t)(t0 + r);
                f32x4 v[4]; float s = 0.f;
#pragma unroll
                for (int j = 0; j < 4; ++j) { v[j] = hv[rr][j]; s += (v[j].x * v[j].x + v[j].y * v[j].y) + (v[j].z * v[j].z + v[j].w * v[j].w); }
                const float rinv = 1.f / sqrtf(wave_sum(s) * (1.f / 1024.f) + EPS);
                GAS unsigned* o4 = (GAS unsigned*)(XN8 + tok * 1024) + lane;
#pragma unroll
                for (int j = 0; j < 4; ++j) { const f32x4 xn = v[j] * rinv * g2[j];
                    const unsigned h0 = f2bf(xn.x), h1 = f2bf(xn.y), h2 = f2bf(xn.z), h3 = f2bf(xn.w);
                    const unsigned l0 = f2bf(xn.x - bf2f(h0)), l1 = f2bf(xn.y - bf2f(h1)), l2 = f2bf(xn.z - bf2f(h2)), l3 = f2bf(xn.w - bf2f(h3));
                    const v2u hw = (v2u){h0 | (h1 << 16), h2 | (h3 << 16)}, lw = (v2u){l0 | (l1 << 16), l2 | (l3 << 16)};
                    { int q8 = 0; q8 = __builtin_amdgcn_cvt_pk_fp8_f32(xn.x, xn.y, q8, false); q8 = __builtin_amdgcn_cvt_pk_fp8_f32(xn.z, xn.w, q8, true); o4[64 * j] = (unsigned)q8; }
                    *(LAS v2u*)(L + L_XH + r * XP + (4 * lane + 256 * j) * 2) = hw; *(LAS v2u*)(L + L_XL + r * XP + (4 * lane + 256 * j) * 2) = lw; } }
            __syncthreads();
            f32x16 acc = {};
#pragma unroll
            for (int ks = 0; ks < 8; ++ks) { const int k0 = 128 * w + 16 * ks + 8 * hi;
                const bf16x8 xh = *(const LAS bf16x8*)(L + L_XH + r32 * XP + k0 * 2), xl = *(const LAS bf16x8*)(L + L_XL + r32 * XP + k0 * 2);
                acc = __builtin_amdgcn_mfma_f32_32x32x16_bf16(wh[ks], xh, acc, 0, 0, 0); acc = __builtin_amdgcn_mfma_f32_32x32x16_bf16(wh[ks], xl, acc, 0, 0, 0); acc = __builtin_amdgcn_mfma_f32_32x32x16_bf16(wl[ks], xh, acc, 0, 0, 0); }
            __syncthreads();
#pragma unroll
            for (int r = 0; r < 16; ++r) { const int e = (r & 3) + 8 * (r >> 2) + 4 * hi; ((LAS float*)(L + L_PART))[(w * 32 + e) * 32 + r32] = acc[r]; }
            __syncthreads();
            if (w == 0) {
                float v[16];
#pragma unroll
                for (int r = 0; r < 16; ++r) { const int e = (r & 3) + 8 * (r >> 2) + 4 * hi; float s = brt[r];
#pragma unroll
                    for (int ww = 0; ww < 8; ++ww) s += ((const LAS float*)(L + L_PART))[(ww * 32 + e) * 32 + r32];
                    v[r] = s; }
                float cv[8]; int cidx[8];
#pragma unroll
                for (int s = 0; s < 4; ++s) { float m = -INFINITY; int mr = 0;
#pragma unroll
                    for (int r = 0; r < 16; ++r) { if (v[r] > m) { m = v[r]; mr = r; } }
                    cv[s] = m; cidx[s] = (mr & 3) + 8 * (mr >> 2) + 4 * hi;
#pragma unroll
                    for (int r = 0; r < 16; ++r) v[r] = (r == mr) ? -INFINITY : v[r]; }
#pragma unroll
                for (int s = 0; s < 4; ++s) { cv[4 + s] = __shfl_xor(cv[s], 32); cidx[4 + s] = __shfl_xor(cidx[s], 32); }
                float tv[4]; int ti[4];
#pragma unroll
                for (int s = 0; s < 4; ++s) { float m = -INFINITY; int mi = 1 << 20; int mc = 0;
#pragma unroll
                    for (int c = 0; c < 8; ++c) { const bool better = (cv[c] > m) || (cv[c] == m && cidx[c] < mi); if (better) { m = cv[c]; mi = cidx[c]; mc = c; } }
                    tv[s] = m; ti[s] = mi;
#pragma unroll
                    for (int c = 0; c < 8; ++c) cv[c] = (c == mc) ? -INFINITY : cv[c]; }
                const float e1 = __expf(tv[1] - tv[0]), e2 = __expf(tv[2] - tv[0]), e3 = __expf(tv[3] - tv[0]); const float inv = 1.f / (1.f + e1 + e2 + e3);
                const float gt[4] = {inv, e1 * inv, e2 * inv, e3 * inv};
                if (hi == 0) {
#pragma unroll
                    for (int s = 0; s < 4; ++s) { const int rank = (int)__hip_atomic_fetch_add(hist + ti[s], 1, __ATOMIC_RELAXED, __HIP_MEMORY_SCOPE_WORKGROUP); const int idx = (bi * 32 + r32) * 4 + s; aep[idx] = (ti[s] << 16) | rank; agt[idx] = gt[s]; } }
            }
            __syncthreads();
        }
        if (tid < NEXP) { const int hc = hist[tid]; basev[tid] = hc ? (int)__hip_atomic_fetch_add(CNT + 64 * tid, (unsigned)hc, RLX_AGENT) : 0; }
        __syncthreads();
        for (int idx = tid; idx < nb * 128; idx += NWAVES * 64) { const int ep = aep[idx], e = ep >> 16, pos = basev[e] + (ep & 0xffff); const int tok = 32 * gb + (idx >> 2), s = idx & 3;
            ROWTOK[(size_t)e * EROWS + pos] = tok; ROWGATE[(size_t)e * EROWS + pos] = agt[idx]; TOKASG[tok * 4 + s] = e * EROWS + pos; }
    }
    __syncthreads();
}

__device__ __forceinline__ void p8_combine(Frame& F) {
    const LAS int* cst = (const LAS int*)(F.lds + LC_CST);
    const int gw = F.vcu * NWAVES + F.wave, NGW = F.G * NWAVES, lane = F.lane;
    const int* TOKASG = (const int*)(F.ws + WS_TOKASG); const unsigned char* Y = F.ws + WS_Y;
    f32x4 fg[4];
#pragma unroll
    for (int j = 0; j < 4; ++j) fg[j] = *((const GAS f32x4*)F.fin_g + lane + 64 * j);
    for (int tok = gw; tok < T; tok += NGW) {
        const int a = TOKASG[tok * 4 + (lane & 3)];
        const int crow = cst[a >> 15] * 256 + (a & (EROWS - 1));
        GAS f32x4* hp = (GAS f32x4*)(F.out + (size_t)tok * 1024) + lane; f32x4 v[4];
#pragma unroll
        for (int j = 0; j < 4; ++j) v[j] = hp[64 * j];
#pragma unroll
        for (int s = 0; s < 4; ++s) { const int cr = __shfl(crow, s); const GAS unsigned* yp = (const GAS unsigned*)(Y + (size_t)cr * 1024) + lane;
#pragma unroll
            for (int j = 0; j < 4; ++j) { const unsigned yw = yp[64 * j]; const auto lo = __builtin_amdgcn_cvt_pk_f32_fp8((int)yw, false), hi = __builtin_amdgcn_cvt_pk_f32_fp8((int)yw, true);
                v[j].x += lo[0] * (1.f / YSCALE); v[j].y += lo[1] * (1.f / YSCALE); v[j].z += hi[0] * (1.f / YSCALE); v[j].w += hi[1] * (1.f / YSCALE); } }
        float ss = 0.f;
#pragma unroll
        for (int j = 0; j < 4; ++j) ss += (v[j].x * v[j].x + v[j].y * v[j].y) + (v[j].z * v[j].z + v[j].w * v[j].w);
        const float rinv = 1.f / sqrtf(wave_sum(ss) * (1.f / 1024.f) + EPS);
#pragma unroll
        for (int j = 0; j < 4; ++j) hp[64 * j] = v[j] * rinv * fg[j];
    }
}
#ifndef MK_N_LAUNCHES
#define MK_N_LAUNCHES 1
#endif
constexpr int N_PHASES = 9;
constexpr int N_LAUNCHES = MK_N_LAUNCHES;
struct Args { const float* in[19]; float* out; unsigned char* ws; int ph_lo, ph_hi; };
__global__ void __launch_bounds__(NWAVES * 64, 2) enc_fwd(Args args) {
    extern __shared__ __attribute__((aligned(16))) unsigned char lds[];
    Frame F;
    F.lds = (LAS unsigned char*)lds;
    F.MISC = (volatile LAS unsigned*)(F.lds + LC_MISC);
    F.tid = threadIdx.x; F.lane = F.tid & 63; F.wave = __builtin_amdgcn_readfirstlane(F.tid >> 6);
    F.G = gridDim.x; { const int bx = blockIdx.x; F.vcu = (F.G % 8 == 0) ? (bx % 8) * (F.G / 8) + bx / 8 : bx; }
    F.ws = args.ws; F.ctl = (gu32*)(args.ws + WS_CTL);
    F.x = args.in[0]; F.mix_g = args.in[1]; F.w_in = args.in[2]; F.w_gf = args.in[3]; F.b_gf = args.in[4]; F.w_gb = args.in[5]; F.b_gb = args.in[6]; F.gla_hg = args.in[7];
    F.q_g = args.in[8]; F.k_g = args.in[9]; F.w_out = args.in[10]; F.ffn_g = args.in[11]; F.w_router = args.in[12]; F.b_router = args.in[13];
    F.w1 = args.in[14]; F.b1 = args.in[15]; F.w2 = args.in[16]; F.b2 = args.in[17]; F.fin_g = args.in[18]; F.out = args.out;
    for (int u = F.tid; u < (LDS_BYTES - LC_OFF) / 4; u += NWAVES * 64) ((LAS unsigned*)(F.lds + LC_OFF))[u] = 0u;
    __syncthreads();
    XcdBarrier bar; bar.bar = (unsigned*)(F.ctl + CW_BAR); bar.x = 0; bar.st = nullptr;
    if (N_LAUNCHES == 1) bar = xcd_barrier_post((unsigned*)(F.ctl + CW_BAR), F.MISC + 8);
    const int lo = args.ph_lo, hi = args.ph_hi;
#define IN(k) (lo <= (k) && (k) < hi)
#define SEAM(k) do { if (IN(k) && IN((k) + 1)) xcd_barrier(bar); } while (0)
    MoeTabs tb{(const LAS int*)(F.lds + LC_CNT), (const LAS int*)(F.lds + LC_CST), (const LAS unsigned short*)(F.lds + LC_TE)};

    if (IN(0)) { p0_prologue(F); } SEAM(0);
    if (IN(1)) {
        DenseMap mp{(const bf16*)(F.ws + WS_XN), (const bf16*)(F.ws + WS_WIN), 1024};
        pg8::StaticOrder S; S.init(T / 256, D_IN_PAD / 256, F.G, (int)blockIdx.x);
        EpiInProj E{(bf16*)(F.ws + WS_GQ), (bf16*)(F.ws + WS_GK), (bf16*)(F.ws + WS_GV), (bf16*)(F.ws + WS_GR), (bf16*)(F.ws + WS_AQ), (bf16*)(F.ws + WS_AK), (bf16*)(F.ws + WS_AV), (bf16*)(F.ws + WS_Z)};
        pg8::gemm_phase<EpiInProj, pg8::StaticOrder, DenseMap, true>(F.lds, 1024, S, mp, E);
    } SEAM(1);
    if (IN(2)) { p2_normrope(F); for (int u = F.vcu; u < BATCH * 64; u += F.G) gla::gla_prep_unit(F, u >> 6, u & 63); } SEAM(2);
    if (IN(3)) { p3_mixers(F); } SEAM(3);
    if (IN(4)) {
        DenseMap mp{(const bf16*)(F.ws + WS_MIX), (const bf16*)(F.ws + WS_WOUT), 1024};
        pg8::StaticOrder S; S.init(T / 256, DM / 256, F.G, (int)blockIdx.x);
        EpiResF32 E{F.x, F.out};
        pg8::gemm_phase<EpiResF32, pg8::StaticOrder, DenseMap, true>(F.lds, 1024, S, mp, E);
    } SEAM(4);
    if (IN(5)) { p5_route(F); } SEAM(5);
    if (IN(6)) {
        const int ntl = moe_tables(F);
        MoeMapUp mp{F.ws + WS_XN, F.ws + WS_W1, (const int*)(F.ws + WS_ROWTOK), tb};
        pg8::StaticOrder S; S.init(ntl, 8, F.G, (int)blockIdx.x);
        EpiSwiglu E{F.b1, F.ws + WS_ACT, tb};
        pg8::gemm_phase<EpiSwiglu, pg8::StaticOrder, MoeMapUp, true, true>(F.lds, 512, S, mp, E);
    } SEAM(6);
    if (IN(7)) {
        const int ntl = moe_tables(F);
        MoeMapDown mp{F.ws + WS_ACT, F.ws + WS_W2, tb};
        pg8::StaticOrder S; S.init(ntl, 4, F.G, (int)blockIdx.x);
        EpiDown E{F.b2, (const float*)(F.ws + WS_ROWGATE), F.ws + WS_Y, tb};
        pg8::gemm_phase<EpiDown, pg8::StaticOrder, MoeMapDown, true, true>(F.lds, 512, S, mp, E);
    } SEAM(7);
    if (IN(8)) { (void)moe_tables(F); p8_combine(F); }
#undef IN
#undef SEAM
}

extern "C" void kernel_launch(void* const* d_in, const int* in_sizes, int n_in, void* d_out, int out_size, void* d_ws, size_t ws_size, hipStream_t stream) {
    static int grid = 0;
    if (grid == 0) {
        if (n_in != 19 || in_sizes[0] != T * DM || out_size != T * DM || ws_size < WS_END) { fprintf(stderr, "kernel_launch: unexpected shapes (n_in %d, in0 %d, out %d, ws %zu); nothing launched\n", n_in, n_in > 0 ? in_sizes[0] : -1, out_size, ws_size); grid = -1; return; }
        int dev = 0, cus = 0, per_cu = 0;
        if (hipGetDevice(&dev) != hipSuccess || hipDeviceGetAttribute(&cus, hipDeviceAttributeMultiprocessorCount, dev) != hipSuccess) { grid = -1; return; }
        if (hipFuncSetAttribute((const void*)enc_fwd, hipFuncAttributeMaxDynamicSharedMemorySize, LDS_BYTES) != hipSuccess) { fprintf(stderr, "kernel_launch: hipFuncSetAttribute failed\n"); grid = -1; return; }
        if (hipOccupancyMaxActiveBlocksPerMultiprocessor(&per_cu, (const void*)enc_fwd, NWAVES * 64, LDS_BYTES) != hipSuccess || per_cu < 1) { fprintf(stderr, "kernel_launch: occupancy query says %d\n", per_cu); }
        (void)hipGetLastError();
        grid = cus;
    }
    if (grid < 0) return;
    if (hipMemsetAsync((char*)d_ws + WS_CTL, 0, CTL_ZERO_BYTES, stream) != hipSuccess) return;
    Args a{};
    for (int i = 0; i < 19; ++i) a.in[i] = (const float*)d_in[i];
    a.out = (float*)d_out; a.ws = (unsigned char*)d_ws;
    if (N_LAUNCHES == 1) { a.ph_lo = 0; a.ph_hi = N_PHASES; hipLaunchKernelGGL(enc_fwd, dim3(grid), dim3(NWAVES * 64), LDS_BYTES, stream, a); }
    else for (int p = 0; p < N_PHASES; ++p) { a.ph_lo = p; a.ph_hi = p + 1; hipLaunchKernelGGL(enc_fwd, dim3(grid), dim3(NWAVES * 64), LDS_BYTES, stream, a); }
}
```

```cpp
#include <hip/hip_runtime.h>
#include <hip/hip_bf16.h>
#include <cstdio>
#include <cstdint>
#include <cmath>

#define LAS __attribute__((address_space(3)))
#define GAS __attribute__((address_space(1)))

namespace pg8 {
typedef unsigned short bf16_t;
typedef short bf16x8 __attribute__((ext_vector_type(8)));
typedef float f32x4 __attribute__((ext_vector_type(4)));
typedef float f32x2 __attribute__((ext_vector_type(2)));
typedef unsigned u32x4 __attribute__((ext_vector_type(4)));
typedef int v4i_t __attribute__((ext_vector_type(4)));
typedef int v8i_t __attribute__((ext_vector_type(8)));
constexpr int BM = 256, BK = 64, HALF = 128, HTB = HALF * BK * 2, STAGE_BYTES = 8 * HTB, NXCD = 8, WGM = 8;

__host__ __device__ __forceinline__ int lds_byte(int r, int c) { const int st = (r >> 4) * 2 + (c >> 5), rr = r & 15, cc = c & 31, ob = rr * 64 + cc * 2; return st * 1024 + (ob ^ (((ob >> 9) & 1) << 5)); }
__host__ __device__ __forceinline__ void stage_rc(int b, int& R, int& C) { const int st = b / 1024, sb = b % 1024, swz = sb ^ (((sb >> 9) & 1) << 5); R = (st >> 1) * 16 + swz / 64; C = (st & 1) * 32 + (swz % 64) / 2; }
__host__ __device__ __forceinline__ int perm32(int rho) { const int n = rho >> 4, i = rho & 15; return 8 * (i >> 2) + 4 * n + (i & 3); }

struct Unit { int pm, pn; };

struct StaticOrder {
    int nM, nN, nwg, G, c;
    __device__ __forceinline__ void init(int nM_, int nN_, int G_, int c_) { nM = nM_; nN = nN_; nwg = nM * nN; G = G_; c = c_; }
    __device__ __forceinline__ bool next(int i, Unit& u) const {
        const long L = (long)i * G + c; if (L >= nwg) return false;
        int wgid = (int)L; { const int q = nwg / NXCD, r = nwg % NXCD, xcd = wgid % NXCD, off = wgid / NXCD; wgid = (xcd < r ? xcd * (q + 1) : r * (q + 1) + (xcd - r) * q) + off; }
        const int nig = WGM * nN, gid = wgid / nig, fm = gid * WGM, gsz = (nM - fm) < WGM ? (nM - fm) : WGM;
        u.pm = fm + ((wgid % nig) % gsz); u.pn = (wgid % nig) / gsz; return true;
    }
};

__device__ __forceinline__ unsigned cvt_pk_bf16(float lo, float hi) { unsigned r; asm volatile("v_cvt_pk_bf16_f32 %0, %1, %2" : "=v"(r) : "v"(lo), "v"(hi)); return r; }

template <class Epi, class Sched, class Map, bool ALIGN_EPI, bool FP8 = false>
__device__ __forceinline__ void gemm_phase(LAS unsigned char* lds, const int K, const Sched& S, const Map& MP, const Epi& E) {
    int tid_ = threadIdx.x; asm volatile("" : "+v"(tid_));
    const int tid = tid_, wid = __builtin_amdgcn_readfirstlane(tid >> 6), lane = tid & 63, wr = wid >> 2, wc = wid & 3, fr = lane & 15, fq = lane >> 4;
    const int nt = K / BK;
    int Rr[2], Cc[2]; unsigned voffB[2];
#pragma unroll
    for (int i = 0; i < 2; ++i) { int R, C; stage_rc(tid * 16 + i * 8192, R, C); Rr[i] = R; Cc[i] = C; const int Rb = Epi::COLS64 ? (64 * (R >> 5) + perm32(R & 31)) : (Epi::PERM ? ((R & ~31) + perm32(R & 31)) : R); voffB[i] = (unsigned)(Rb * K + C) * 2u; }
    const unsigned kstep = (unsigned)(BK * 2);
    const unsigned hstep = (unsigned)HALF * K * 2;
    const unsigned hstepB = Epi::COLS64 ? 32u * (unsigned)K * 2u : hstep;
    const __amdgpu_buffer_rsrc_t RA = MP.a_rsrc(), RB = MP.b_rsrc();
    const unsigned ldsw = (unsigned)wid * 1024u;
    const int aoff = lds_byte(wr * 64 + fr, fq * 8), boff = lds_byte(wc * 32 + fr, fq * 8);
#define PG8_SA(b, h) (((b) * 2 + (h)) * HTB)
#define PG8_SB(b, h) ((4 + (b) * 2 + (h)) * HTB)
#define PG8_STAGE(bufoff, rsrc, soff, voff) do { _Pragma("unroll") for (int _i = 0; _i < 2; ++_i) \
        __builtin_amdgcn_raw_ptr_buffer_load_lds(rsrc, (LAS unsigned*)(lds + (bufoff) + ldsw + _i * 8192), 16, (int)(voff)[_i], (int)(soff), 0, 0); } while (0)
#define PG8_LD8(p) __builtin_shufflevector(*(const LAS v4i_t*)(p), *(const LAS v4i_t*)((p) + 1024), 0, 1, 2, 3, 4, 5, 6, 7)
#define PG8_LDA(dst, b, h) do { _Pragma("unroll") for (int m = 0; m < 4; ++m) dst[m] = PG8_LD8(lds + PG8_SA(b, h) + aoff + m * 2048); } while (0)
#define PG8_LDB(dst, b, h) do { _Pragma("unroll") for (int n = 0; n < 2; ++n) dst[n] = PG8_LD8(lds + PG8_SB(b, h) + boff + n * 2048); } while (0)
#define PG8_HALF(x, k) __builtin_bit_cast(bf16x8, __builtin_shufflevector(x, x, 4 * (k), 4 * (k) + 1, 4 * (k) + 2, 4 * (k) + 3))
#define PG8_MMA(ai, bj, At, Bt) do { __builtin_amdgcn_s_setprio(1); _Pragma("unroll") for (int m = 0; m < 4; ++m) _Pragma("unroll") for (int n = 0; n < 2; ++n) { \
        if constexpr (FP8) { acc[ai][bj][m][n] = __builtin_amdgcn_mfma_scale_f32_16x16x128_f8f6f4(Bt[n], At[m], acc[ai][bj][m][n], 0, 0, 0, 0x7f7f7f7f, 0, 0x7f7f7f7f); } \
        else { acc[ai][bj][m][n] = __builtin_amdgcn_mfma_f32_16x16x32_bf16(PG8_HALF(Bt[n], 0), PG8_HALF(At[m], 0), acc[ai][bj][m][n], 0, 0, 0); \
               acc[ai][bj][m][n] = __builtin_amdgcn_mfma_f32_16x16x32_bf16(PG8_HALF(Bt[n], 1), PG8_HALF(At[m], 1), acc[ai][bj][m][n], 0, 0, 0); } } \
        __builtin_amdgcn_s_setprio(0); } while (0)
#define PG8_WAIT_V(n) asm volatile("s_waitcnt vmcnt(" #n ")" ::: "memory")
#define PG8_WAIT_L(n) asm volatile("s_waitcnt lgkmcnt(" #n ")" ::: "memory")
#define PG8_BAR __builtin_amdgcn_s_barrier()
#define PG8_SCHED __builtin_amdgcn_sched_barrier(0)
    Unit cur, nxt, nn; int ui = 0;
    if (!S.next(0, cur)) return;
    f32x4 acc[2][2][4][2];
#pragma unroll
    for (int a = 0; a < 2; ++a)
#pragma unroll
        for (int b = 0; b < 2; ++b)
#pragma unroll
            for (int m = 0; m < 4; ++m)
#pragma unroll
                for (int n = 0; n < 2; ++n) acc[a][b][m][n] = (f32x4){0.f, 0.f, 0.f, 0.f};
    v8i_t At[4], B0[2], B1[2];
    unsigned cvo[2][2], nvo[2][2], nnvo[2][2];
    MP.a_off(cur, Rr, Cc, cvo);
    bool has_next = S.next(1, nxt);
    if constexpr (Map::GATHER) { if (has_next) MP.a_off(nxt, Rr, Cc, nvo); else { nvo[0][0] = cvo[0][0]; nvo[0][1] = cvo[0][1]; nvo[1][0] = cvo[1][0]; nvo[1][1] = cvo[1][1]; } }
    unsigned cA = MP.a_soff(cur), cB = MP.b_soff(cur);
    typename Epi::Pre pc, pn;
    E.preload(cur, wr, wc, fr, fq, pc); pn = pc;
    PG8_STAGE(PG8_SB(0, 0), RB, cB, voffB); PG8_STAGE(PG8_SB(0, 1), RB, cB + hstepB, voffB); PG8_STAGE(PG8_SA(0, 0), RA, cA, cvo[0]); PG8_STAGE(PG8_SA(0, 1), RA, cA, cvo[1]);
    if (wr == 1) PG8_BAR;
    PG8_WAIT_V(2); PG8_BAR;
    PG8_STAGE(PG8_SB(1, 0), RB, cB + kstep, voffB); PG8_STAGE(PG8_SA(1, 0), RA, cA + kstep, cvo[0]); PG8_STAGE(PG8_SB(1, 1), RB, cB + hstepB + kstep, voffB);
    PG8_WAIT_V(6); PG8_BAR;
    for (;;) {
        const unsigned nA = has_next ? MP.a_soff(nxt) : cA, nB = has_next ? MP.b_soff(nxt) : cB;
#pragma unroll 1
        for (int t = 0; t < nt; t += 2) {
            const bool last = (t == nt - 2);
            const unsigned a1 = cA + (unsigned)(t + 1) * kstep;
            const unsigned a2 = last ? nA : cA + (unsigned)(t + 2) * kstep, b2 = last ? nB : cB + (unsigned)(t + 2) * kstep;
            const unsigned a3 = a2 + kstep, b3 = b2 + kstep;
            unsigned s0[2] = {cvo[0][0], cvo[0][1]}, s1[2] = {cvo[1][0], cvo[1][1]};
            if constexpr (Map::GATHER) { if (last) { s0[0] = nvo[0][0]; s0[1] = nvo[0][1]; s1[0] = nvo[1][0]; s1[1] = nvo[1][1]; } }
            PG8_LDB(B0, 0, 0); PG8_LDB(B1, 0, 1); PG8_SCHED; PG8_LDA(At, 0, 0); PG8_STAGE(PG8_SA(1, 1), RA, a1, cvo[1]);
            PG8_WAIT_V(8); PG8_WAIT_L(0); PG8_BAR; PG8_MMA(0, 0, At, B0); PG8_MMA(0, 1, At, B1); PG8_BAR; PG8_SCHED;
            PG8_LDA(At, 0, 1); PG8_STAGE(PG8_SB(0, 0), RB, b2, voffB); PG8_STAGE(PG8_SB(0, 1), RB, b2 + hstepB, voffB); PG8_STAGE(PG8_SA(0, 0), RA, a2, s0);
            PG8_WAIT_V(8); PG8_WAIT_L(0); PG8_BAR; PG8_MMA(1, 0, At, B0); PG8_MMA(1, 1, At, B1); PG8_BAR; PG8_SCHED;
            PG8_LDB(B0, 1, 0); PG8_LDB(B1, 1, 1); PG8_SCHED; PG8_LDA(At, 1, 0); PG8_STAGE(PG8_SA(0, 1), RA, a2, s1);
            PG8_WAIT_V(8); PG8_WAIT_L(0); PG8_BAR; PG8_MMA(0, 0, At, B0); PG8_MMA(0, 1, At, B1); PG8_BAR; PG8_SCHED;
            PG8_LDA(At, 1, 1); PG8_STAGE(PG8_SB(1, 0), RB, b3, voffB); PG8_STAGE(PG8_SB(1, 1), RB, b3 + hstepB, voffB); PG8_STAGE(PG8_SA(1, 0), RA, a3, s0);
            PG8_WAIT_V(8); PG8_WAIT_L(0); PG8_BAR; PG8_MMA(1, 0, At, B0); PG8_MMA(1, 1, At, B1); PG8_BAR; PG8_SCHED;
        }
        if constexpr (ALIGN_EPI) { if (wr == 0) PG8_BAR; }
        const bool has_nn = has_next && S.next(ui + 2, nn);
        if constexpr (Map::GATHER) { if (has_nn) MP.a_raw(nn, Rr, nnvo); }
        if (has_next) E.preload(nxt, wr, wc, fr, fq, pn);
        { int fr_ = fr, fq_ = fq; asm volatile("" : "+v"(fr_), "+v"(fq_)); E(acc, cur, pc, wr, wc, fr_, fq_); }
        if (!has_next) break;
#pragma unroll
        for (int a = 0; a < 2; ++a)
#pragma unroll
            for (int b = 0; b < 2; ++b)
#pragma unroll
                for (int m = 0; m < 4; ++m)
#pragma unroll
                    for (int n = 0; n < 2; ++n) acc[a][b][m][n] = (f32x4){0.f, 0.f, 0.f, 0.f};
        cur = nxt; cA = nA; cB = nB; ++ui; pc = pn;
#pragma unroll
        for (int h = 0; h < 2; ++h)
#pragma unroll
            for (int i = 0; i < 2; ++i) { if constexpr (Map::GATHER) { cvo[h][i] = nvo[h][i]; nvo[h][i] = has_nn ? MP.a_fin(nnvo[h][i], Cc[i]) : nvo[h][i]; } }
        has_next = has_nn; nxt = nn;
        if constexpr (ALIGN_EPI) { if (wr == 1) PG8_BAR; }
    }
    PG8_WAIT_V(0);
    if constexpr (!ALIGN_EPI) { if (wr == 0) PG8_BAR; }
    PG8_BAR;
#undef PG8_SA
#undef PG8_SB
#undef PG8_STAGE
#undef PG8_LDA
#undef PG8_LDB
#undef PG8_MMA
#undef PG8_HALF
#undef PG8_LD8
#undef PG8_WAIT_V
#undef PG8_WAIT_L
#undef PG8_BAR
#undef PG8_SCHED
}
}
namespace attn_body {
using bf16=__hip_bfloat16;
using bf16x8=__attribute__((ext_vector_type(8)))short;
using s16x4=__attribute__((ext_vector_type(4)))short;
using f32x16=__attribute__((ext_vector_type(16)))float;
using u32x4=__attribute__((ext_vector_type(4)))unsigned;
constexpr int BATCH=8,NHEAD=8,NKVH=2,SEQ=4096,D=64;
constexpr int QP=512,KP=128,VP=128,OP=1024,OCOL=512;
constexpr int NW=8,QBLK=32,QB=QBLK*NW,KVBLK=64,NQB=SEQ/QB;
__device__ __forceinline__ int crow(int r,int hi){return (r&3)+8*(r>>2)+4*hi;}
#define SBAR() __builtin_amdgcn_sched_barrier(0)
constexpr int NSLOT=3, SLOTB=8192;
constexpr int LDS_K=0, LDS_V=NSLOT*SLOTB, LDS_WS=2*NSLOT*SLOTB, LDS_OST=LDS_WS+NW*64*4, LDS_BYTES=LDS_OST+NW*4096;
constexpr float C2=0.125f*1.4426950408889634f;
__device__ __forceinline__ void glds16(const void*gsrc,unsigned lds_dst){unsigned keep;
  asm volatile("s_mov_b32 %0, m0\n\ts_mov_b32 m0, %2\n\ts_nop 0\n\tglobal_load_lds_dwordx4 %1, off\n\ts_mov_b32 m0, %0":"=&s"(keep):"v"(gsrc),"s"(lds_dst):"memory");}
__device__ __forceinline__ float max3f(float a,float b,float c){float r;asm("v_max3_f32 %0, %1, %2, %3":"=v"(r):"v"(a),"v"(b),"v"(c));return r;}
__device__ __forceinline__ float max2f(float a,float b){float r;asm("v_max_f32_e32 %0, %1, %2":"=v"(r):"v"(a),"v"(b));return r;}
__device__ __forceinline__ float fadd_s(float a,float b){float r;asm("v_add_f32_e32 %0, %1, %2":"=v"(r):"v"(a),"v"(b));return r;}
__device__ __forceinline__ float fsub_s(float a,float b){float r;asm("v_sub_f32_e32 %0, %1, %2":"=v"(r):"v"(a),"v"(b));return r;}
typedef float f32x2_t __attribute__((ext_vector_type(2))); typedef __bf16 bf16x2_t __attribute__((ext_vector_type(2)));
__device__ __forceinline__ unsigned cvtpk_s(float lo,float hi){f32x2_t v={lo,hi};bf16x2_t b=__builtin_convertvector(v,bf16x2_t);return __builtin_bit_cast(unsigned,b);}
#define WAIT_BAR(N) asm volatile("s_waitcnt vmcnt(" #N ") lgkmcnt(0)\n\ts_barrier":::"memory")

__device__ __forceinline__ void qkt(f32x16&p0,f32x16&p1,const char*Kslot,const bf16x8*qr,const f32x16&negm,int r32,int hi){
  const char*kb=Kslot+hi*1024+r32*16;
  #pragma unroll
  for(int d0=0;d0<4;++d0){
    const bf16x8 b0=*reinterpret_cast<const bf16x8*>(kb+d0*2048);
    const bf16x8 b1=*reinterpret_cast<const bf16x8*>(kb+d0*2048+512);
    if(d0==0){p0=__builtin_amdgcn_mfma_f32_32x32x16_bf16(b0,qr[0],negm,0,0,0);p1=__builtin_amdgcn_mfma_f32_32x32x16_bf16(b1,qr[0],negm,0,0,0);}
    else{p0=__builtin_amdgcn_mfma_f32_32x32x16_bf16(b0,qr[d0],p0,0,0,0);p1=__builtin_amdgcn_mfma_f32_32x32x16_bf16(b1,qr[d0],p1,0,0,0);}}
}
typedef __attribute__((address_space(3))) const char* lds_cptr;
typedef short v4i16_t __attribute__((ext_vector_type(4)));
__device__ __forceinline__ void kload8(bf16x8*kf,lds_cptr kp){
  kf[0]=*(const __attribute__((address_space(3))) bf16x8*)(kp);      kf[1]=*(const __attribute__((address_space(3))) bf16x8*)(kp+512);
  kf[2]=*(const __attribute__((address_space(3))) bf16x8*)(kp+2048); kf[3]=*(const __attribute__((address_space(3))) bf16x8*)(kp+2560);
  kf[4]=*(const __attribute__((address_space(3))) bf16x8*)(kp+4096); kf[5]=*(const __attribute__((address_space(3))) bf16x8*)(kp+4608);
  kf[6]=*(const __attribute__((address_space(3))) bf16x8*)(kp+6144); kf[7]=*(const __attribute__((address_space(3))) bf16x8*)(kp+6656);
}
__device__ __forceinline__ void kload2(bf16x8*kf,lds_cptr kp,int j){ kf[2*j]=*(const __attribute__((address_space(3))) bf16x8*)(kp+j*2048); kf[2*j+1]=*(const __attribute__((address_space(3))) bf16x8*)(kp+j*2048+512); }
__device__ __forceinline__ s16x4 vtr(lds_cptr p){ return __builtin_bit_cast(s16x4,__builtin_amdgcn_ds_read_tr16_b64_v4i16((__attribute__((address_space(3))) v4i16_t*)p)); }
__device__ __forceinline__ float rowmax(const f32x16&p0,const f32x16&p1){
  float a=max3f(p0[0],p0[1],p1[0]),b=max3f(p0[2],p0[3],p1[1]);a=max3f(a,p1[2],p1[3]);
  #pragma unroll
  for(int r=4;r<16;r+=4){a=max3f(a,p0[r],p0[r+1]);b=max3f(b,p0[r+2],p0[r+3]);a=max3f(a,p1[r],p1[r+1]);b=max3f(b,p1[r+2],p1[r+3]);}
  const float m=max2f(a,b);
  auto rr=__builtin_amdgcn_permlane32_swap(__float_as_uint(m),__float_as_uint(m),false,false);
  return max2f(__uint_as_float(rr[0]),__uint_as_float(rr[1]));
}
__device__ __forceinline__ void pv(f32x16*o,int vb,bf16x8 pa0,bf16x8 pa1,bf16x8 pa2,bf16x8 pa3){
  #pragma unroll
  for(int d0=0;d0<2;++d0){s16x4 lo[4],hi[4];
    #pragma unroll
    for(int ks=0;ks<4;++ks){
      asm volatile("ds_read_b64_tr_b16 %0,%1 offset:%c2":"=&v"(lo[ks]):"v"(vb),"i"(d0*4096+ks*1024):"memory");
      asm volatile("ds_read_b64_tr_b16 %0,%1 offset:%c2":"=&v"(hi[ks]):"v"(vb),"i"(d0*4096+ks*1024+512):"memory");}
    asm volatile("s_waitcnt lgkmcnt(0)":::"memory");SBAR();
    #define PK(k) (bf16x8){lo[k][0],lo[k][1],lo[k][2],lo[k][3],hi[k][0],hi[k][1],hi[k][2],hi[k][3]}
    o[d0]=__builtin_amdgcn_mfma_f32_32x32x16_bf16(pa0,PK(0),o[d0],0,0,0);
    o[d0]=__builtin_amdgcn_mfma_f32_32x32x16_bf16(pa1,PK(1),o[d0],0,0,0);
    o[d0]=__builtin_amdgcn_mfma_f32_32x32x16_bf16(pa2,PK(2),o[d0],0,0,0);
    o[d0]=__builtin_amdgcn_mfma_f32_32x32x16_bf16(pa3,PK(3),o[d0],0,0,0);
    #undef PK
  }
}
#define ATTN_STORE16(p,v) (*(u32x4*)(p)=(v))
template<int THRL> __device__ __forceinline__ void attn_unit(int b,int h,int qb,const bf16*Q,const bf16*__restrict__ K,const bf16*__restrict__ V,bf16*O,char*shm,const float*qgain,const float sbound){
  int tid_=threadIdx.x; asm volatile("":"+v"(tid_));
  const int tid=tid_,lane=tid&63,r32=lane&31,hi=lane>>5; const int wid=__builtin_amdgcn_readfirstlane(tid>>6);
  const long rowbase=(long)b*SEQ; const int q0=qb*QB; const int kvh=h/(NHEAD/NKVH);
  const bf16*Qw=Q+(rowbase+q0+wid*QBLK)*QP+h*D;
  const bf16*Kh=K+rowbase*KP+kvh*D,*Vh=V+rowbase*VP+kvh*D;
  const unsigned lds0=(unsigned)(uintptr_t)shm;
  float*wsf=(float*)(shm+LDS_WS)+wid*64;
  const bf16*ksrc=Kh+(long)lane*KP+wid*8;
  const bf16*vsrc=Vh+(long)(16*(wid&3)+(lane>>2))*VP+(wid>>2)*32+(lane&3)*8;
  const unsigned kdst=lds0+LDS_K+wid*1024, vdst=lds0+LDS_V+wid*1024;
  #define DMA_K(t,slot) glds16(ksrc+(long)(t)*KVBLK*KP,(unsigned)__builtin_amdgcn_readfirstlane(kdst+(slot)))
  #define DMA_V(t,slot) glds16(vsrc+(long)(t)*KVBLK*VP,(unsigned)__builtin_amdgcn_readfirstlane(vdst+(slot)))
  const int vb0=(int)(lds0+LDS_V)+((lane>>4)&1)*32+(lane&3)*8+(4*hi+((lane&15)>>2))*64;
  const char*Kbase=shm+LDS_K; bf16x8 kf[8];
  const lds_cptr shm3=(lds_cptr)shm; const lds_cptr kp0=shm3+LDS_K+hi*1024+r32*16; const lds_cptr vp0=shm3+LDS_V+((lane>>4)&1)*32+(lane&3)*8+(4*hi+((lane&15)>>2))*64;
  constexpr int NT=SEQ/KVBLK;
  DMA_K(0,0);DMA_V(0,0);DMA_K(1,SLOTB);
  bf16x8 qr[4];
  #pragma unroll
  for(int d0=0;d0<4;++d0)qr[d0]=*reinterpret_cast<const bf16x8*>(&Qw[(long)r32*QP+d0*16+hi*8]);
  { float xq[4][8]; float ss=0.f; int hio=hi; asm volatile("":"+v"(hio));
    #pragma unroll
    for(int d0=0;d0<4;++d0)
      #pragma unroll
      for(int j=0;j<8;++j){ xq[d0][j]=__builtin_bit_cast(float,((unsigned)(unsigned short)qr[d0][j])<<16); ss+=xq[d0][j]*xq[d0][j]; }
    ss+=__shfl_xor(ss,32);
    const float rinv=__builtin_amdgcn_rsqf(ss*(1.f/64.f)+1e-6f);
    const int tq=q0+wid*QBLK+r32; const float prow=(float)(tq>>6), pcol=(float)(tq&63);
    #pragma unroll
    for(int d0=0;d0<4;++d0)
      #pragma unroll
      for(int j=0;j<8;++j) xq[d0][j]*=rinv*qgain[16*d0+8*hio+j];
    #pragma unroll
    for(int j=0;j<8;++j){ const float inv=exp2f(-(float)(8*hio+j)*(13.287712379549449f/16.f));
      const float ar=prow*inv, ac=pcol*inv; const float cr=__cosf(ar), sr=__sinf(ar), cc=__cosf(ac), sc=__sinf(ac);
      const float a0=xq[0][j], a1=xq[1][j], b0=xq[2][j], b1=xq[3][j];
      xq[0][j]=(a0*cr-a1*sr)*C2; xq[1][j]=(a1*cr+a0*sr)*C2; xq[2][j]=(b0*cc-b1*sc)*C2; xq[3][j]=(b1*cc+b0*sc)*C2; }
    #pragma unroll
    for(int d0=0;d0<4;++d0){ u32x4 w; w.x=cvtpk_s(xq[d0][0],xq[d0][1]); w.y=cvtpk_s(xq[d0][2],xq[d0][3]); w.z=cvtpk_s(xq[d0][4],xq[d0][5]); w.w=cvtpk_s(xq[d0][6],xq[d0][7]); qr[d0]=__builtin_bit_cast(bf16x8,w); } }
  float l_reg=0.f;f32x16 o[2];o[0]=f32x16{};o[1]=f32x16{};f32x16 negm;
  #pragma unroll
  for(int r=0;r<16;++r)negm[r]=-sbound;
  asm volatile("":"+v"(negm));
  #define START(P0,P1) do{ _Pragma("unroll") for(int r=0;r<16;++r)P0[r]=__builtin_amdgcn_exp2f(P0[r]); }while(0)
  #define RESC() do{}while(0)
  f32x16 pA0,pA1,pB0,pB1;
  int sl_prev=0,sl_cur=0,sl_next=SLOTB;
  #define ROT() do{sl_prev=sl_cur;sl_cur=sl_next;sl_next=(sl_next==(NSLOT-1)*SLOTB)?0:sl_next+SLOTB;}while(0)
  DMA_K(2,2*SLOTB);
  WAIT_BAR(3);
  qkt(pA0,pA1,Kbase,qr,negm,r32,hi);asm volatile("s_nop 15\n\ts_nop 7":"+v"(pA0),"+v"(pA1));
  START(pA0,pA1);
  _Pragma("unroll") for(int r=0;r<16;++r)pA1[r]=__builtin_amdgcn_exp2f(pA1[r]);
  WAIT_BAR(0);
  DMA_K(3,0);DMA_V(1,SLOTB);
  ROT();
  kload8(kf,kp0+sl_cur);
  WAIT_BAR(2);
  s16x4 vlo[8],vhi[8]; u32x4 pw0,pw1,pw2,pw3;
  #define PKW(P,B) cvtpk_s(P[B],P[B+1])
  #define PAF(k) __builtin_bit_cast(bf16x8,pw##k)
  #define VFR(i) (bf16x8){vlo[i][0],vlo[i][1],vlo[i][2],vlo[i][3],vhi[i][0],vhi[i][1],vhi[i][2],vhi[i][3]}
  #define PIN(x) asm volatile("":"+v"(x))
  #define MX3(a,b,c) __builtin_fmaxf(__builtin_fmaxf((a),(b)),(c))
  #define GAPA(MF,A0,A1,A2,A3,W0,W1,PW) do{ MF; sacc+=A0; sacc+=A1; sacc+=A2; sacc+=A3; PIN(sacc); W0; W1; PIN(PW); SBAR(); }while(0)
  #define EX(v) __builtin_amdgcn_exp2f(v)
  #define GAPB(MF,X,B) do{ MF; X[B]=EX(X[B]); X[B+1]=EX(X[B+1]); X[B+2]=EX(X[B+2]); X[B+3]=EX(X[B+3]); PIN(X); SBAR(); }while(0)
  #define VRD(i) do{ vlo[i]=vtr(vp_+(((i)>>2)*4096+((i)&3)*1024)); vhi[i]=vtr(vp_+(((i)>>2)*4096+((i)&3)*1024+512)); }while(0)
  #define KRD(G,j) do{ if(G){ kload2(kf,kp0+sl_next,j); SBAR(); } }while(0)
  #define STEP(C0,C1,P0,P1,t,GK,GV,GL) do{ SBAR(); \
    const lds_cptr vp_=vp0+sl_prev; \
    VRD(0); SBAR(); float sacc=(P0[0]+P0[1]); \
    GAPA(C0=__builtin_amdgcn_mfma_f32_32x32x16_bf16(kf[0],qr[0],negm,0,0,0), P0[2],P0[3],P0[4],P0[5],     pw0[0]=PKW(P0,0), pw0[1]=PKW(P0,2), pw0); \
    VRD(4); SBAR(); GAPA(C1=__builtin_amdgcn_mfma_f32_32x32x16_bf16(kf[1],qr[0],negm,0,0,0), P0[6],P0[7],P0[8],P0[9],     pw0[2]=PKW(P0,4), pw0[3]=PKW(P0,6), pw0); \
    VRD(1); SBAR(); GAPA(C0=__builtin_amdgcn_mfma_f32_32x32x16_bf16(kf[2],qr[1],C0,0,0,0),   P0[10],P0[11],P0[12],P0[13], pw1[0]=PKW(P0,8), pw1[1]=PKW(P0,10), pw1); \
    VRD(5); SBAR(); GAPA(C1=__builtin_amdgcn_mfma_f32_32x32x16_bf16(kf[3],qr[1],C1,0,0,0),   P0[14],P0[15],P1[0],P1[1],   pw1[2]=PKW(P0,12),pw1[3]=PKW(P0,14), pw1); \
    VRD(2); SBAR(); GAPA(C0=__builtin_amdgcn_mfma_f32_32x32x16_bf16(kf[4],qr[2],C0,0,0,0),   P1[2],P1[3],P1[4],P1[5],     pw2[0]=PKW(P1,0), pw2[1]=PKW(P1,2), pw2); \
    VRD(6); SBAR(); GAPA(C1=__builtin_amdgcn_mfma_f32_32x32x16_bf16(kf[5],qr[2],C1,0,0,0),   P1[6],P1[7],P1[8],P1[9],     pw2[2]=PKW(P1,4), pw2[3]=PKW(P1,6), pw2); \
    VRD(3); SBAR(); GAPA(C0=__builtin_amdgcn_mfma_f32_32x32x16_bf16(kf[6],qr[3],C0,0,0,0),   P1[10],P1[11],P1[12],P1[13], pw3[0]=PKW(P1,8), pw3[1]=PKW(P1,10), pw3); \
    VRD(7); SBAR(); GAPA(C1=__builtin_amdgcn_mfma_f32_32x32x16_bf16(kf[7],qr[3],C1,0,0,0),   P1[14],P1[15],0.f,0.f,       pw3[2]=PKW(P1,12),pw3[3]=PKW(P1,14), pw3); \
    l_reg+=sacc; \
    if(GK){DMA_K((t)+3,sl_cur);} if(GV){DMA_V((t)+1,sl_next);} \
    SBAR(); \
    GAPB(o[0]=__builtin_amdgcn_mfma_f32_32x32x16_bf16(PAF(0),VFR(0),o[0],0,0,0), C0,0); \
    GAPB(o[1]=__builtin_amdgcn_mfma_f32_32x32x16_bf16(PAF(0),VFR(4),o[1],0,0,0), C0,4); \
    KRD(GL,0); GAPB(o[0]=__builtin_amdgcn_mfma_f32_32x32x16_bf16(PAF(1),VFR(1),o[0],0,0,0), C0,8); \
    KRD(GL,1); GAPB(o[1]=__builtin_amdgcn_mfma_f32_32x32x16_bf16(PAF(1),VFR(5),o[1],0,0,0), C0,12); \
    KRD(GL,2); GAPB(o[0]=__builtin_amdgcn_mfma_f32_32x32x16_bf16(PAF(2),VFR(2),o[0],0,0,0), C1,0); \
    KRD(GL,3); GAPB(o[1]=__builtin_amdgcn_mfma_f32_32x32x16_bf16(PAF(2),VFR(6),o[1],0,0,0), C1,4); \
    GAPB(o[0]=__builtin_amdgcn_mfma_f32_32x32x16_bf16(PAF(3),VFR(3),o[0],0,0,0), C1,8); \
    GAPB(o[1]=__builtin_amdgcn_mfma_f32_32x32x16_bf16(PAF(3),VFR(7),o[1],0,0,0), C1,12); \
    }while(0)
  int t=1;
  for(;t+5<NT;t+=2){
    STEP(pB0,pB1,pA0,pA1,t,true,true,true);     WAIT_BAR(2); RESC(); ROT();
    STEP(pA0,pA1,pB0,pB1,t+1,true,true,true);   WAIT_BAR(2); RESC(); ROT();
  }
  #define ENDW(tt) do{ if((tt)+3<NT){WAIT_BAR(2);} else if((tt)+2<NT){WAIT_BAR(1);} else {WAIT_BAR(0);} }while(0)
  for(;t+1<NT;t+=2){
    STEP(pB0,pB1,pA0,pA1,t,(t+3<NT),(t+1<NT),(t+1<NT));       ENDW(t);   RESC(); ROT();
    STEP(pA0,pA1,pB0,pB1,t+1,(t+4<NT),(t+2<NT),(t+2<NT));     ENDW(t+1); RESC(); ROT();
  }
  STEP(pB0,pB1,pA0,pA1,NT-1,false,false,false); RESC();
  { float sacc=pB0[0]+pB0[1]; _Pragma("unroll") for(int r=2;r<16;++r)sacc+=pB0[r]; _Pragma("unroll") for(int r=0;r<16;++r)sacc+=pB1[r]; l_reg+=sacc;
    pw0=(u32x4){PKW(pB0,0),PKW(pB0,2),PKW(pB0,4),PKW(pB0,6)};pw1=(u32x4){PKW(pB0,8),PKW(pB0,10),PKW(pB0,12),PKW(pB0,14)};pw2=(u32x4){PKW(pB1,0),PKW(pB1,2),PKW(pB1,4),PKW(pB1,6)};pw3=(u32x4){PKW(pB1,8),PKW(pB1,10),PKW(pB1,12),PKW(pB1,14)};
    SBAR(); pv(o,vb0+sl_cur,PAF(0),PAF(1),PAF(2),PAF(3)); }
  #undef PKW
  #undef PAF
  #undef VFR
  #undef PIN
  #undef MX3
  #undef GAPA
  #undef GAPB
  #undef EX
  #undef VRD
  #undef KRD
  #undef STEP
  #undef ENDW
  {auto rr=__builtin_amdgcn_permlane32_swap(__float_as_uint(l_reg),__float_as_uint(l_reg),false,false);l_reg=__uint_as_float(rr[0])+__uint_as_float(rr[1]);}
  if(hi==0)wsf[32+r32]=l_reg;asm volatile("s_waitcnt lgkmcnt(0)":::"memory");
  float rli[16];
  #pragma unroll
  for(int r=0;r<16;++r)rli[r]=__builtin_amdgcn_rcpf(wsf[32+crow(r,hi)]);
  bf16*Ow=O+(rowbase+q0+wid*QBLK)*OP+OCOL+h*D;
  { bf16*stg=(bf16*)(shm+LDS_OST)+wid*2048;
    #pragma unroll
    for(int r=0;r<16;++r){const int orow=crow(r,hi);
      #pragma unroll
      for(int d0=0;d0<2;++d0)stg[orow*64+d0*32+r32]=__float2bfloat16(o[d0][r]*rli[r]);}
    asm volatile("s_waitcnt lgkmcnt(0)":::"memory");
    #pragma unroll
    for(int i=0;i<4;++i){const int row=i*8+(lane>>3),ch=lane&7; const u32x4 v=*(const u32x4*)(stg+row*64+ch*8); ATTN_STORE16(Ow+(long)row*OP+ch*8,v);} }
  asm volatile("s_waitcnt lgkmcnt(0)\n\ts_barrier":::"memory");
  #undef DMA_K
  #undef DMA_V
  #undef START
  #undef RESC
  #undef ROT
}
constexpr int ATTN_LDS_BYTES=LDS_BYTES;
#undef SBAR
#undef WAIT_BAR
}
constexpr int NWAVES = 8;
constexpr int BATCH = 8, SEQ = 4096, DM = 1024, T = BATCH * SEQ;
constexpr int GLA_H = 4, GLA_DK = 64, GLA_DV = 128, GLA_RANK = 16;
constexpr int ATT_H = 8, ATT_KVH = 2, ATT_DH = 64;
constexpr int D_IN = 2336, D_IN_PAD = 2560;
constexpr int NEXP = 32, TOPK = 4, DFF = 1024;
constexpr int EROWS = 32768;
constexpr int PROWS = T * TOPK + NEXP * 256;
constexpr float EPS = 1e-6f;
constexpr float YSCALE = 16.f;
constexpr float WSCALE = 32.f, ASCALE = 4.f;

constexpr size_t MiB = 1u << 20;
constexpr size_t WS_CTL = 0, CTL_ZERO_BYTES = 1 * MiB;
constexpr size_t WS_WRH = 1 * MiB, WS_WRL = WS_WRH + 65536;
constexpr size_t WS_WIN = 2 * MiB;
constexpr size_t WS_WOUT = 8 * MiB;
constexpr size_t WS_W1 = 10 * MiB;
constexpr size_t WS_W2 = 138 * MiB;
constexpr size_t WS_ROWTOK = 202 * MiB;
constexpr size_t WS_ROWGATE = 206 * MiB;
constexpr size_t WS_TOKASG = 210 * MiB;
constexpr size_t WS_REGY = 212 * MiB;
constexpr size_t WS_XN = WS_REGY;
constexpr size_t WS_GQ = WS_XN + 64 * MiB;
constexpr size_t WS_GK = WS_GQ + 16 * MiB;
constexpr size_t WS_GV = WS_GK + 16 * MiB;
constexpr size_t WS_GR = WS_GV + 32 * MiB;
constexpr size_t WS_AQ = WS_GR + 32 * MiB;
constexpr size_t WS_AK = WS_AQ + 32 * MiB;
constexpr size_t WS_AV = WS_AK + 8 * MiB;
constexpr size_t WS_Z = WS_AV + 8 * MiB;
constexpr size_t WS_OF = WS_Z + 2 * MiB;
constexpr size_t WS_Y = WS_REGY;
constexpr size_t WS_REGA = WS_REGY + 274 * MiB;
constexpr size_t WS_MIX = WS_REGA;
constexpr size_t WS_ACT = WS_REGA;
constexpr size_t WS_QF = WS_REGA + 272 * MiB, WS_KF = WS_QF + 16 * MiB, WS_QB = WS_KF + 16 * MiB, WS_KB = WS_QB + 16 * MiB;
constexpr size_t WS_DEC = WS_KB + 16 * MiB;
constexpr size_t WS_END = WS_DEC + 1 * MiB;
static_assert(WS_OF + (size_t)T * 512 * 4 <= WS_REGA && (size_t)PROWS * 1024 * 2 <= 272 * MiB, "d_ws map");
constexpr int CW_BAR = 4096;
constexpr int CW_CNT = 8192;
constexpr int CW_GDN = 16384;
constexpr int CW_QUE = 12288;

constexpr int SCR_BYTES = 133120;
constexpr int LC_OFF = SCR_BYTES;
constexpr int LC_MISC = LC_OFF;
constexpr int LC_CNT = LC_OFF + 128;
constexpr int LC_CST = LC_CNT + 128;
constexpr int LC_TE = LC_CST + 256;
constexpr int LC_HIST = LC_TE + 1152;
constexpr int LC_BASE = LC_HIST + 128;
constexpr int LC_ASG = LC_BASE + 128;
constexpr int LC_END = LC_ASG + 8192;
constexpr int LDS_BYTES = 147456;
static_assert(LC_END <= LDS_BYTES, "LDS map");

typedef unsigned short bf16;
typedef unsigned v4u __attribute__((ext_vector_type(4)));
typedef unsigned v2u __attribute__((ext_vector_type(2)));
typedef float f32x4 __attribute__((ext_vector_type(4)));
typedef short bf16x8 __attribute__((ext_vector_type(8)));
typedef GAS unsigned gu32;
#define RLX_AGENT __ATOMIC_RELAXED, __HIP_MEMORY_SCOPE_AGENT
#define LDS_WAIT() asm volatile("s_waitcnt lgkmcnt(0)" ::: "memory")
#define VM_WAIT() asm volatile("s_waitcnt vmcnt(0)" ::: "memory")
__device__ __forceinline__ unsigned f2bf(float f) { unsigned u = __builtin_bit_cast(unsigned, f); return (u + 0x7fffu + ((u >> 16) & 1u)) >> 16; }
__device__ __forceinline__ unsigned pk2(float lo, float hi) { return f2bf(lo) | (f2bf(hi) << 16); }
__device__ __forceinline__ float bf2f(unsigned h) { return __builtin_bit_cast(float, h << 16); }
__device__ __forceinline__ float bflo(unsigned w) { return __builtin_bit_cast(float, w << 16); }
__device__ __forceinline__ float bfhi(unsigned w) { return __builtin_bit_cast(float, w & 0xffff0000u); }

#define XB_TMO      128
#define XB_XCNT(j)  (256  + 64 * (j))
#define XB_XSUB(j)  (1280 + 64 * (j))
#define XB_XGEN(j)  (2304 + 64 * (j))
#define XB_TOP      3328
#define XB_TOPGEN   3392
#define XCD_BAR_WORDS 3456
#define XB_SPIN_CAP (1u << 18)
__device__ __forceinline__ unsigned xb_ld(unsigned* p)              { return __hip_atomic_load(p, __ATOMIC_RELAXED, __HIP_MEMORY_SCOPE_AGENT); }
__device__ __forceinline__ unsigned xb_add(unsigned* p, unsigned v) { return __hip_atomic_fetch_add(p, v, __ATOMIC_RELAXED, __HIP_MEMORY_SCOPE_AGENT); }
__device__ __forceinline__ unsigned xb_xcc_id() { return (unsigned)__builtin_amdgcn_s_getreg((3 << 11) | 20) & 0xFu; }
#define XB_SPIN(cond, bar) do { unsigned _sp = 0; while (cond) { __builtin_amdgcn_s_sleep(1); \
    if ((++_sp & 255u) == 0u) { if (xb_ld(&(bar)[XB_TMO])) break; if (_sp > XB_SPIN_CAP) { atomicAdd(&(bar)[XB_TMO], 1u); break; } } } } while (0)
struct XcdBarrier { unsigned* bar; unsigned x; volatile LAS unsigned* st; };
__device__ __forceinline__ XcdBarrier xcd_barrier_post(unsigned* bar, volatile LAS unsigned* st) {
    XcdBarrier b; b.bar = bar; b.x = xb_xcc_id(); b.st = st;
    if (threadIdx.x == 0) (void)xb_add(&bar[XB_XCNT(b.x)], 1u);
    return b;
}
__device__ __forceinline__ void xcd_barrier_complete(unsigned* bar, unsigned x, unsigned& nloc, unsigned& nx) {
    const unsigned G = gridDim.x * gridDim.y * gridDim.z;
    unsigned sum, cnt, mine, sp = 0u;
    for (;;) {
        sum = 0u; cnt = 0u; mine = 0u;
#pragma unroll
        for (unsigned j = 0; j < 16; ++j) { const unsigned c = xb_ld(&bar[XB_XCNT(j)]); sum += c; cnt += (c > 0u) ? 1u : 0u; mine = (j == x) ? c : mine; }
        if (sum == G) break;
        __builtin_amdgcn_s_sleep(1);
        if ((++sp & 255u) == 0u) { if (xb_ld(&bar[XB_TMO])) break; if (sp > XB_SPIN_CAP) { atomicAdd(&bar[XB_TMO], 1u); break; } }
    }
    nloc = mine > 0u ? mine : 1u; nx = cnt > 0u ? cnt : 1u;
}
__device__ __forceinline__ void xcd_barrier(const XcdBarrier& b) {
    asm volatile("s_waitcnt vmcnt(0)" ::: "memory");
    __syncthreads();
    if (threadIdx.x == 0) {
        unsigned* bar = b.bar;
        __builtin_amdgcn_s_waitcnt(0);
        unsigned nloc = b.st[0], nx = b.st[1];
        if (nloc == 0u) { xcd_barrier_complete(bar, b.x, nloc, nx); b.st[0] = nloc; b.st[1] = nx; }
        const unsigned old = xb_add(&bar[XB_XSUB(b.x)], 1u);
        const unsigned gen = old / nloc;
        if (old + 1u == (gen + 1u) * nloc) {
            __builtin_amdgcn_fence(__ATOMIC_RELEASE, "agent");
            asm volatile("s_waitcnt vmcnt(0)" ::: "memory");
            const unsigned og = xb_add(&bar[XB_TOP], 1u);
            const unsigned tg = og / nx;
            if (og + 1u == (tg + 1u) * nx) xb_add(&bar[XB_TOPGEN], 1u);
            else XB_SPIN(xb_ld(&bar[XB_TOPGEN]) == tg, bar);
            __builtin_amdgcn_fence(__ATOMIC_ACQUIRE, "agent");
            xb_add(&bar[XB_XGEN(b.x)], 1u);
            asm volatile("s_waitcnt vmcnt(0)" ::: "memory");
        } else {
            XB_SPIN(xb_ld(&bar[XB_XGEN(b.x)]) == gen, bar);
            __builtin_amdgcn_fence(__ATOMIC_ACQUIRE, "agent");
            asm volatile("s_waitcnt vmcnt(0)" ::: "memory");
        }
    }
    __syncthreads();
}

struct Frame {
    LAS unsigned char* lds;
    volatile LAS unsigned* MISC;
    gu32* ctl;
    int tid, lane, wave;
    int vcu, G;
    unsigned char* ws;
    const float *x, *mix_g, *w_in, *w_gf, *b_gf, *w_gb, *b_gb, *gla_hg, *q_g, *k_g, *w_out, *ffn_g, *w_router, *b_router, *w1, *b1, *w2, *b2, *fin_g;
    float* out;
};
__device__ __forceinline__ float wave_sum(float v) {
#pragma unroll
    for (int o = 1; o < 64; o <<= 1) v += __shfl_xor(v, o);
    return v;
}
__device__ __forceinline__ void p0_tr64(const float* src  , int ldw, bf16* d0, bf16* d1, int ldt, LAS float* scr, int lane, int ncols) {
    const int c4 = (lane & 15) * 4, kr = lane >> 4;
    if (c4 < ncols) {
#pragma unroll 4
        for (int i = 0; i < 16; ++i) { const int kk = kr + 4 * i; const f32x4 v = *(const GAS f32x4*)(src + (size_t)kk * ldw + c4);
            LAS float* s = scr + kk * 65 + c4; s[0] = v.x; s[1] = v.y; s[2] = v.z; s[3] = v.w; }
    }
    LDS_WAIT(); asm volatile("" ::: "memory");
    const int c = lane & 7;
#pragma unroll
    for (int j = 0; j < 8; ++j) { const int n = (lane >> 3) + 8 * j;
        if (n < ncols) { const LAS float* s = scr + (8 * c) * 65 + n;
            v4u o; o.x = pk2(s[0 * 65], s[1 * 65]); o.y = pk2(s[2 * 65], s[3 * 65]); o.z = pk2(s[4 * 65], s[5 * 65]); o.w = pk2(s[6 * 65], s[7 * 65]);
            bf16* rowp = (n < 32 ? d0 : d1) + (size_t)(n & 31) * ldt;
            *(GAS v4u*)(rowp + 8 * c) = o; } }
    LDS_WAIT(); asm volatile("" ::: "memory");
}
__device__ __forceinline__ void p0_tr64_f8(const float* src, int ldw, unsigned char* d0, unsigned char* d1, int ldt, LAS float* scr, int lane, float sc) {
    const int c4 = (lane & 15) * 4, kr = lane >> 4;
#pragma unroll 4
    for (int i = 0; i < 16; ++i) { const int kk = kr + 4 * i; const f32x4 v = __builtin_nontemporal_load((const GAS f32x4*)(src + (size_t)kk * ldw + c4));
        LAS float* s = scr + kk * 65 + c4; s[0] = v.x; s[1] = v.y; s[2] = v.z; s[3] = v.w; }
    LDS_WAIT(); asm volatile("" ::: "memory");
    const int c = lane & 7;
#pragma unroll
    for (int j = 0; j < 8; ++j) { const int n = (lane >> 3) + 8 * j; const LAS float* s = scr + (8 * c) * 65 + n;
        int w0 = 0, w1 = 0;
        w0 = __builtin_amdgcn_cvt_pk_fp8_f32(s[0 * 65] * sc, s[1 * 65] * sc, w0, false); w0 = __builtin_amdgcn_cvt_pk_fp8_f32(s[2 * 65] * sc, s[3 * 65] * sc, w0, true);
        w1 = __builtin_amdgcn_cvt_pk_fp8_f32(s[4 * 65] * sc, s[5 * 65] * sc, w1, false); w1 = __builtin_amdgcn_cvt_pk_fp8_f32(s[6 * 65] * sc, s[7 * 65] * sc, w1, true);
        unsigned char* rowp = (n < 32 ? d0 : d1) + (size_t)(n & 31) * ldt;
        __builtin_nontemporal_store((v2u){(unsigned)w0, (unsigned)w1}, (GAS v2u*)(rowp + 8 * c)); }
    LDS_WAIT(); asm volatile("" ::: "memory");
}
__device__ __forceinline__ int win_pblk(int lb) { return lb < 48 ? lb : (lb == 48 ? 72 : lb - 1); }
__device__ __forceinline__ int w1_pblk(int lb) { return lb < 32 ? (lb >> 2) * 8 + (lb & 3) : ((lb - 32) >> 2) * 8 + 4 + ((lb - 32) & 3); }
__device__ __forceinline__ void rms_row_to_bf16(const float* xrow, const float* g, bf16* orow, int lane) {
    const GAS f32x4* xr = (const GAS f32x4*)xrow + lane; const GAS f32x4* gr = (const GAS f32x4*)g + lane;
    f32x4 v[4]; float s = 0.f;
#pragma unroll
    for (int j = 0; j < 4; ++j) { v[j] = __builtin_nontemporal_load(xr + 64 * j); s += (v[j].x * v[j].x + v[j].y * v[j].y) + (v[j].z * v[j].z + v[j].w * v[j].w); }
    const float rinv = 1.f / sqrtf(wave_sum(s) * (1.f / 1024.f) + EPS);
    GAS unsigned long long* o8 = (GAS unsigned long long*)orow + lane;
#pragma unroll
    for (int j = 0; j < 4; ++j) { const f32x4 gg = gr[64 * j];
        o8[64 * j] = (unsigned long long)pk2(v[j].x * rinv * gg.x, v[j].y * rinv * gg.y) | ((unsigned long long)pk2(v[j].z * rinv * gg.z, v[j].w * rinv * gg.w) << 32); }
}
__device__ __forceinline__ void p0_prologue(Frame& F) {
    LAS float* scr = (LAS float*)(F.lds + F.wave * 16640);
    const int gw = F.vcu * NWAVES + F.wave, NGW = F.G * NWAVES;
    bf16* WIN = (bf16*)(F.ws + WS_WIN); bf16* WOUT = (bf16*)(F.ws + WS_WOUT); unsigned char* W1T = F.ws + WS_W1; unsigned char* W2T = F.ws + WS_W2;
    constexpr int I_IN = 16 * 37, I_OUT = 16 * 16, I_1 = NEXP * 16 * 32, I_2 = NEXP * 16 * 16, NITEMS = I_IN + I_OUT + I_1 + I_2;
    for (int it = gw; it < NITEMS; it += NGW) {
        int r = it;
        if (r < I_IN) { const int kb = r / 37, nb = r % 37; const int lb0 = 2 * nb, nc = (nb == 36) ? 32 : 64;
            p0_tr64(F.w_in + (size_t)(64 * kb) * D_IN + 64 * nb, D_IN, WIN + (size_t)(32 * win_pblk(lb0)) * 1024 + 64 * kb, WIN + (size_t)(32 * win_pblk(lb0 + 1 < 73 ? lb0 + 1 : lb0)) * 1024 + 64 * kb, 1024, scr, F.lane, nc); continue; }
        r -= I_IN;
        if (r < I_OUT) { const int kb = r / 16, nb = r % 16;
            p0_tr64(F.w_out + (size_t)(64 * kb) * 1024 + 64 * nb, 1024, WOUT + (size_t)(64 * nb) * 1024 + 64 * kb, WOUT + (size_t)(64 * nb + 32) * 1024 + 64 * kb, 1024, scr, F.lane, 64); continue; }
        r -= I_OUT;
        if (r < I_1) { const int e = r / 512, q = r % 512, kb = q / 32, nb = q % 32; const float* src = F.w1 + (size_t)e * 1024 * 2048 + (size_t)(64 * kb) * 2048 + 64 * nb; unsigned char* dst = W1T + (size_t)e * 2048 * 1024 + 64 * kb;
            p0_tr64_f8(src, 2048, dst + (size_t)(32 * w1_pblk(2 * nb)) * 1024, dst + (size_t)(32 * w1_pblk(2 * nb + 1)) * 1024, 1024, scr, F.lane, WSCALE); continue; }
        r -= I_1;
        { const int e = r / 256, q = r % 256, kb = q / 16, nb = q % 16; const float* src = F.w2 + (size_t)e * 1024 * 1024 + (size_t)(64 * kb) * 1024 + 64 * nb; unsigned char* dst = W2T + (size_t)e * 1024 * 1024 + 64 * kb;
            p0_tr64_f8(src, 1024, dst + (size_t)(64 * nb) * 1024, dst + (size_t)(64 * nb + 32) * 1024, 1024, scr, F.lane, WSCALE); }
    }
    { const int gt = F.vcu * (NWAVES * 64) + F.tid, NGT = F.G * NWAVES * 64; GAS v4u* z = (GAS v4u*)(WIN + (size_t)D_IN * 1024);
      for (int i = gt; i < (D_IN_PAD - D_IN) * 1024 * 2 / 16; i += NGT) z[i] = (v4u){0u, 0u, 0u, 0u};
      bf16* WRH = (bf16*)(F.ws + WS_WRH); bf16* WRL = (bf16*)(F.ws + WS_WRL);
      for (int i = gt; i < NEXP * 1024; i += NGT) { const int e = i >> 10, k = i & 1023; const float w = F.w_router[(size_t)k * NEXP + e]; const unsigned h = f2bf(w); WRH[i] = (bf16)h; WRL[i] = (bf16)f2bf(w - bf2f(h)); } }
    bf16* XN = (bf16*)(F.ws + WS_XN);
    for (int m = gw; m < T; m += NGW) rms_row_to_bf16(F.x + (size_t)m * DM, F.mix_g, XN + (size_t)m * DM, F.lane);
}

__device__ __forceinline__ void p2_normrope(Frame& F) {
    LAS float* cs = (LAS float*)F.lds;
    for (int i = F.tid; i < 1024; i += NWAVES * 64) { const int pos = i >> 4, fi = i & 15; const float inv = exp2f(-(float)fi * (13.287712379549449f / 16.f)); const float a = (float)pos * inv;
        cs[2 * i] = __cosf(a); cs[2 * i + 1] = __sinf(a); }
    __syncthreads();
    const int gw = F.vcu * NWAVES + F.wave, NGW = F.G * NWAVES, lane = F.lane;
    const int j = lane & 7, blk = (j >> 2) & 1, jj = j & 3, fi0 = 8 * (jj & 1); const bool second = (jj >> 1) != 0;
    float gq[8], gk[8];
#pragma unroll
    for (int e = 0; e < 8; ++e) { gq[e] = F.q_g[8 * j + e]; gk[e] = F.k_g[8 * j + e]; }
    bf16* AQ = (bf16*)(F.ws + WS_AQ); bf16* AK = (bf16*)(F.ws + WS_AK);
    for (int it = T + gw; it < T + T / 4; it += NGW) {
        const bool isq = it < T;
        const int tok = isq ? it : 4 * (it - T) + (lane >> 4);
        GAS v4u* p = isq ? (GAS v4u*)(AQ + (size_t)tok * 512) + lane : (GAS v4u*)(AK + (size_t)tok * 128) + (lane & 15);
        const v4u w = *p;
        float x[8] = {bflo(w.x), bfhi(w.x), bflo(w.y), bfhi(w.y), bflo(w.z), bfhi(w.z), bflo(w.w), bfhi(w.w)};
        float ss = 0.f;
#pragma unroll
        for (int e = 0; e < 8; ++e) ss += x[e] * x[e];
        ss += __shfl_xor(ss, 1); ss += __shfl_xor(ss, 2); ss += __shfl_xor(ss, 4);
        const float rinv = 1.f / sqrtf(ss * (1.f / 64.f) + EPS);
        const int ts = tok & (SEQ - 1), pos = blk ? (ts & 63) : (ts >> 6);
        const LAS float* c = cs + (pos * 16 + fi0) * 2;
        float y[8];
#pragma unroll
        for (int e = 0; e < 8; ++e) { x[e] = x[e] * rinv * (isq ? gq[e] : gk[e]); }
#pragma unroll
        for (int e = 0; e < 8; ++e) { const float pr = __shfl_xor(x[e], 2); const float co = c[2 * e], si = c[2 * e + 1]; y[e] = second ? (x[e] * co + pr * si) : (x[e] * co - pr * si); }
        const float sc = isq ? attn_body::C2 : 1.f;
        v4u o; o.x = pk2(y[0] * sc, y[1] * sc); o.y = pk2(y[2] * sc, y[3] * sc); o.z = pk2(y[4] * sc, y[5] * sc); o.w = pk2(y[6] * sc, y[7] * sc);
        *p = o;
    }
}
namespace gla {
typedef short bf16x8 __attribute__((ext_vector_type(8)));
typedef short s16x4 __attribute__((ext_vector_type(4)));
typedef float f32x4 __attribute__((ext_vector_type(4)));
constexpr int P64 = 144, PV = 272, POT = 528;
constexpr int L_QS = 0, L_KS = 9216, L_VR = 18432, L_AS = 35840, L_ST = 45056, L_DEC = 63488, L_OT = 63744, L_END = 97536;
__device__ __forceinline__ unsigned cvtpk(float lo, float hi) { typedef float f2_t __attribute__((ext_vector_type(2))); typedef __bf16 b2_t __attribute__((ext_vector_type(2))); f2_t v = {lo, hi}; b2_t b = __builtin_convertvector(v, b2_t); return __builtin_bit_cast(unsigned, b); }
__device__ __forceinline__ float logsig(float x) { return fminf(x, 0.f) - __logf(1.f + __expf(-fabsf(x))); }
__device__ __forceinline__ s16x4 vtr(const LAS unsigned char* p) { typedef short v4i16_t __attribute__((ext_vector_type(4))); return __builtin_bit_cast(s16x4, __builtin_amdgcn_ds_read_tr16_b64_v4i16((LAS v4i16_t*)p)); }

__device__ __forceinline__ void gla_prep_unit(Frame& F, int b, int c) {
    LAS unsigned char* L = F.lds;
    const int tid = F.tid, dir = __builtin_amdgcn_readfirstlane(tid >> 8), col = tid & 255;
    const bf16* GQ = (const bf16*)(F.ws + WS_GQ); const bf16* GK = (const bf16*)(F.ws + WS_GK); const bf16* ZZ = (const bf16*)(F.ws + WS_Z);
    bf16* QX = (bf16*)(F.ws + (dir ? WS_QB : WS_QF)); bf16* KX = (bf16*)(F.ws + (dir ? WS_KB : WS_KF)); float* DEC = (float*)(F.ws + WS_DEC) + (size_t)dir * (BATCH * 64 * 256);
    const unsigned row0 = (unsigned)b * SEQ + (unsigned)c * 64u;
    __syncthreads();
    if (tid < 256) { const int row = tid >> 2, seg = tid & 3; const v4u z = *(const GAS v4u*)(ZZ + (row0 + row) * 32 + seg * 8); LAS f32x4* zp = (LAS f32x4*)(L + row * 128 + seg * 32);
        zp[0] = (f32x4){bflo(z.x), bfhi(z.x), bflo(z.y), bfhi(z.y)}; zp[1] = (f32x4){bflo(z.z), bfhi(z.z), bflo(z.w), bfhi(z.w)}; }
    float wg[16]; const float* WG = dir ? F.w_gb : F.w_gf;
#pragma unroll
    for (int r = 0; r < 16; ++r) wg[r] = WG[r * 256 + col];
    const float bgv = (dir ? F.b_gb : F.b_gf)[col];
    __syncthreads();
    float pf[64]; float run = 0.f;
#pragma unroll
    for (int p = 0; p < 64; ++p) { const LAS f32x4* zp = (const LAS f32x4*)(L + p * 128 + dir * 64); float pre = bgv;
#pragma unroll
        for (int r4 = 0; r4 < 4; ++r4) { const f32x4 z = zp[r4]; pre += z.x * wg[4 * r4] + z.y * wg[4 * r4 + 1] + z.z * wg[4 * r4 + 2] + z.w * wg[4 * r4 + 3]; }
        run += logsig(pre) * (1.f / 16.f); pf[p] = run; }
    const float tot = run;
#pragma unroll
    for (int p = 0; p < 64; ++p) { const unsigned idx = (row0 + p) * 256 + col;
        const float qv = bf2f(GQ[idx]), kv = bf2f(GK[idx]);
        const float ex = dir ? (p ? pf[p - 1] : 0.f) : 0.f;
        const float eq = dir ? __expf(-ex) * 0.125f : __expf(pf[p] - tot) * 0.125f;
        const float ek = dir ? __expf(ex) : __expf(tot - pf[p]);
        QX[idx] = (bf16)f2bf(qv * eq); KX[idx] = (bf16)f2bf(kv * ek); }
    DEC[((unsigned)b * 64 + c) * 256 + col] = __expf(tot);
}

__device__ __forceinline__ void gla_unit(Frame& F, int b, int h, int dir) {
    LAS unsigned char* L = F.lds;
    const int tid = F.tid, lane = F.lane, w = F.wave, q4 = lane >> 4, l15 = lane & 15;
    const bf16* GV = (const bf16*)(F.ws + WS_GV);
    bf16* OX = (bf16*)(F.ws + WS_OF + (dir ? 32 * MiB : 0));
    const unsigned rowbase = (unsigned)b * SEQ;
    const int v0 = 16 * w;
    const int erow = tid >> 3, eseg = tid & 7;
    const int plq = tid >> 3, sgq = tid & 7, plv = tid >> 4, sgv = tid & 15;
    {
        const bf16* QX = (const bf16*)(F.ws + (dir ? WS_QB : WS_QF)); const bf16* KX = (const bf16*)(F.ws + (dir ? WS_KB : WS_KF));
        const float* DEC = (const float*)(F.ws + WS_DEC) + (size_t)dir * (BATCH * 64 * 256);
        f32x4 S[4];
#pragma unroll
        for (int i = 0; i < 4; ++i) S[i] = (f32x4){0.f, 0.f, 0.f, 0.f};
        v4u rq, rk, rv0, rv1; float rdec = 0.f;
#define GLA_LOAD(ci) do { const int c_ = dir ? 63 - (ci) : (ci); const unsigned cb_ = rowbase + (unsigned)c_ * 64u; \
            rq = __builtin_nontemporal_load((const GAS v4u*)(QX + (cb_ + plq) * 256 + h * 64 + sgq * 8)); rk = __builtin_nontemporal_load((const GAS v4u*)(KX + (cb_ + plq) * 256 + h * 64 + sgq * 8)); \
            rv0 = *(const GAS v4u*)(GV + (cb_ + plv) * 512 + h * 128 + sgv * 8); rv1 = *(const GAS v4u*)(GV + (cb_ + plv + 32) * 512 + h * 128 + sgv * 8); \
            if (tid < 64) rdec = DEC[((unsigned)b * 64 + c_) * 256 + h * 64 + tid]; } while (0)
        GLA_LOAD(0);
        v4u st0 = (v4u){0u, 0u, 0u, 0u}, st1 = st0;
#define GLA_FLUSH(cprev) do { const unsigned cbp_ = rowbase + (unsigned)(cprev) * 64u; GAS v4u* sp_ = (GAS v4u*)(OX + (cbp_ + erow) * 512 + h * 128 + eseg * 16); sp_[0] = st0; sp_[1] = st1; } while (0)
        for (int ci = 0; ci < 64; ++ci) {
            const int c = dir ? 63 - ci : ci;
            *(LAS v4u*)(L + L_QS + plq * P64 + sgq * 16) = rq; *(LAS v4u*)(L + L_KS + plq * P64 + sgq * 16) = rk;
            *(LAS v4u*)(L + L_VR + plv * PV + sgv * 16) = rv0; *(LAS v4u*)(L + L_VR + (plv + 32) * PV + sgv * 16) = rv1;
            if (tid < 64) ((LAS float*)(L + L_DEC))[tid] = rdec;
            asm volatile("" ::: "memory");
            if (ci > 0) GLA_FLUSH(dir ? c + 1 : c - 1);
            asm volatile("" ::: "memory");
            if (ci + 1 < 64) GLA_LOAD(ci + 1);
            __syncthreads();
#pragma unroll
            for (int s = 0; s < 2; ++s) { const int tt = 2 * w + s, it = tt >> 2, jt = tt & 3; f32x4 a = (f32x4){0.f, 0.f, 0.f, 0.f};
#pragma unroll
                for (int ks = 0; ks < 2; ++ks) { const bf16x8 af = *(const LAS bf16x8*)(L + L_QS + (16 * it + l15) * P64 + (32 * ks + 8 * q4) * 2); const bf16x8 bfr = *(const LAS bf16x8*)(L + L_KS + (16 * jt + l15) * P64 + (32 * ks + 8 * q4) * 2);
                    a = __builtin_amdgcn_mfma_f32_16x16x32_bf16(af, bfr, a, 0, 0, 0); }
#pragma unroll
                for (int rg = 0; rg < 4; ++rg) { const int i = 16 * it + 4 * q4 + rg, j = 16 * jt + l15; const bool keep = dir ? (j > i) : (j <= i);
                    *(LAS unsigned short*)(L + L_AS + i * P64 + j * 2) = (unsigned short)cvtpk(keep ? a[rg] : 0.f, 0.f); } }
#pragma unroll
            for (int dt = 0; dt < 4; ++dt) { const f32x4 dv = *(const LAS f32x4*)(L + L_DEC + (16 * dt + 4 * q4) * 4); S[dt] = S[dt] * dv;
                *(LAS v2u*)(L + L_ST + (v0 + l15) * P64 + (16 * dt + 4 * q4) * 2) = (v2u){cvtpk(S[dt].x, S[dt].y), cvtpk(S[dt].z, S[dt].w)}; }
            __syncthreads();
            bf16x8 bv[2], bs[2];
#pragma unroll
            for (int ks = 0; ks < 2; ++ks) { const LAS unsigned char* vp = L + L_VR + (32 * ks + 8 * q4 + (l15 >> 2)) * PV + (v0 + 4 * (l15 & 3)) * 2;
                const s16x4 lo = vtr(vp), hi = vtr(vp + 4 * PV); bv[ks] = (bf16x8){lo[0], lo[1], lo[2], lo[3], hi[0], hi[1], hi[2], hi[3]};
                bs[ks] = *(const LAS bf16x8*)(L + L_ST + (v0 + l15) * P64 + (32 * ks + 8 * q4) * 2); }
            f32x4 O[4];
#pragma unroll
            for (int it = 0; it < 4; ++it) { O[it] = (f32x4){0.f, 0.f, 0.f, 0.f};
#pragma unroll
                for (int ks = 0; ks < 2; ++ks) { const bf16x8 aa = *(const LAS bf16x8*)(L + L_AS + (16 * it + l15) * P64 + (32 * ks + 8 * q4) * 2); const bf16x8 aq = *(const LAS bf16x8*)(L + L_QS + (16 * it + l15) * P64 + (32 * ks + 8 * q4) * 2);
                    O[it] = __builtin_amdgcn_mfma_f32_16x16x32_bf16(aa, bv[ks], O[it], 0, 0, 0); O[it] = __builtin_amdgcn_mfma_f32_16x16x32_bf16(aq, bs[ks], O[it], 0, 0, 0); } }
#pragma unroll
            for (int dt = 0; dt < 4; ++dt)
#pragma unroll
                for (int ks = 0; ks < 2; ++ks) { const LAS unsigned char* kp = L + L_KS + (32 * ks + 8 * q4 + (l15 >> 2)) * P64 + (16 * dt + 4 * (l15 & 3)) * 2;
                    const s16x4 lo = vtr(kp), hi = vtr(kp + 4 * P64); const bf16x8 ak = (bf16x8){lo[0], lo[1], lo[2], lo[3], hi[0], hi[1], hi[2], hi[3]};
                    S[dt] = __builtin_amdgcn_mfma_f32_16x16x32_bf16(ak, bv[ks], S[dt], 0, 0, 0); }
#pragma unroll
            for (int it = 0; it < 4; ++it)
#pragma unroll
                for (int rg = 0; rg < 4; ++rg) *(LAS float*)(L + L_OT + (16 * it + 4 * q4 + rg) * POT + (v0 + l15) * 4) = O[it][rg];
            __syncthreads();
            {
                float o[16];
#pragma unroll
                for (int e4 = 0; e4 < 4; ++e4) { const f32x4 t = *(const LAS f32x4*)(L + L_OT + erow * POT + (16 * eseg + 4 * e4) * 4); o[4 * e4] = t.x; o[4 * e4 + 1] = t.y; o[4 * e4 + 2] = t.z; o[4 * e4 + 3] = t.w; }
                st0 = (v4u){cvtpk(o[0], o[1]), cvtpk(o[2], o[3]), cvtpk(o[4], o[5]), cvtpk(o[6], o[7])}; st1 = (v4u){cvtpk(o[8], o[9]), cvtpk(o[10], o[11]), cvtpk(o[12], o[13]), cvtpk(o[14], o[15])};
            }
        }
        GLA_FLUSH(dir ? 0 : 63);
#undef GLA_FLUSH
#undef GLA_LOAD
    }
    VM_WAIT(); __syncthreads();
    if (tid == 0) { __builtin_amdgcn_fence(__ATOMIC_RELEASE, "agent"); VM_WAIT(); (void)__hip_atomic_fetch_add(F.ctl + CW_GDN + 64 * (b * GLA_H + h), 1u, RLX_AGENT); }
    __syncthreads();
}
__device__ __forceinline__ void gla_combine(Frame& F, int b, int h, int part) {
    const int tid = F.tid, erow = tid >> 3, eseg = tid & 7;
    if (tid == 0) { unsigned sp = 0; while (__hip_atomic_load(F.ctl + CW_GDN + 64 * (b * GLA_H + h), RLX_AGENT) < 2u && sp < (1u << 22)) { __builtin_amdgcn_s_sleep(8); ++sp; }
        __builtin_amdgcn_fence(__ATOMIC_ACQUIRE, "agent"); VM_WAIT(); }
    __syncthreads();
    const bf16* OF0 = (const bf16*)(F.ws + WS_OF); const bf16* OB0 = (const bf16*)(F.ws + WS_OF + 32 * MiB); const bf16* GR = (const bf16*)(F.ws + WS_GR); bf16* MIX = (bf16*)(F.ws + WS_MIX);
    float hg[16]; int eso = eseg; asm volatile("" : "+v"(eso));
#pragma unroll
    for (int e = 0; e < 16; ++e) hg[e] = F.gla_hg[16 * eso + e];
    const unsigned r0 = (unsigned)b * SEQ + (unsigned)part * 1024u + erow;
#pragma unroll 2
    for (int ps = 0; ps < 16; ++ps) { const unsigned row = r0 + ps * 64;
        const GAS v4u* fp = (const GAS v4u*)(OF0 + row * 512 + h * 128 + eseg * 16); const GAS v4u* bp = (const GAS v4u*)(OB0 + row * 512 + h * 128 + eseg * 16); const GAS v4u* rp = (const GAS v4u*)(GR + row * 512 + h * 128 + eseg * 16);
        const v4u f0 = __builtin_nontemporal_load(fp), f1 = __builtin_nontemporal_load(fp + 1), b0 = __builtin_nontemporal_load(bp), b1 = __builtin_nontemporal_load(bp + 1), r0v = __builtin_nontemporal_load(rp), r1v = __builtin_nontemporal_load(rp + 1);
        const unsigned fw[8] = {f0.x, f0.y, f0.z, f0.w, f1.x, f1.y, f1.z, f1.w}, bw[8] = {b0.x, b0.y, b0.z, b0.w, b1.x, b1.y, b1.z, b1.w}, rw[8] = {r0v.x, r0v.y, r0v.z, r0v.w, r1v.x, r1v.y, r1v.z, r1v.w};
        float o[16]; float ss = 0.f;
#pragma unroll
        for (int e2 = 0; e2 < 8; ++e2) { o[2 * e2] = bflo(fw[e2]) + bflo(bw[e2]); o[2 * e2 + 1] = bfhi(fw[e2]) + bfhi(bw[e2]); ss += o[2 * e2] * o[2 * e2] + o[2 * e2 + 1] * o[2 * e2 + 1]; }
        ss += __shfl_xor(ss, 1); ss += __shfl_xor(ss, 2); ss += __shfl_xor(ss, 4);
        const float rinv = __builtin_amdgcn_rsqf(ss * (1.f / 128.f) + EPS);
        unsigned ow[8];
#pragma unroll
        for (int e2 = 0; e2 < 8; ++e2) { const float x0 = bflo(rw[e2]), x1 = bfhi(rw[e2]);
            const float y0 = o[2 * e2] * rinv * hg[2 * e2] * (x0 * __builtin_amdgcn_rcpf(1.f + __expf(-x0))), y1 = o[2 * e2 + 1] * rinv * hg[2 * e2 + 1] * (x1 * __builtin_amdgcn_rcpf(1.f + __expf(-x1))); ow[e2] = cvtpk(y0, y1); }
        GAS v4u* mp = (GAS v4u*)(MIX + row * 1024 + h * 128 + eseg * 16);
        mp[0] = (v4u){ow[0], ow[1], ow[2], ow[3]}; mp[1] = (v4u){ow[4], ow[5], ow[6], ow[7]}; }
}
}
struct DenseMap { static constexpr bool GATHER = false;
    const bf16* A; const bf16* Bt; int K;
    __device__ __forceinline__ __amdgpu_buffer_rsrc_t a_rsrc() const { return __builtin_amdgcn_make_buffer_rsrc((void*)A, 0, 0x7fffffff, 0x00020000); }
    __device__ __forceinline__ __amdgpu_buffer_rsrc_t b_rsrc() const { return __builtin_amdgcn_make_buffer_rsrc((void*)Bt, 0, 0x7fffffff, 0x00020000); }
    __device__ __forceinline__ unsigned a_soff(const pg8::Unit& u) const { return (unsigned)u.pm * 256u * (unsigned)K * 2u; }
    __device__ __forceinline__ unsigned b_soff(const pg8::Unit& u) const { return (unsigned)u.pn * 256u * (unsigned)K * 2u; }
    __device__ __forceinline__ void a_off(const pg8::Unit&, const int (&R)[2], const int (&C)[2], unsigned (&vo)[2][2]) const {
#pragma unroll
        for (int h = 0; h < 2; ++h)
#pragma unroll
            for (int i = 0; i < 2; ++i) vo[h][i] = (unsigned)((h * 128 + R[i]) * K + C[i]) * 2u; }
};
struct MoeTabs { const LAS int* cnt; const LAS int* cst; const LAS unsigned short* te; };
struct MoeMapUp { static constexpr bool GATHER = true;
    const unsigned char* A; const unsigned char* Bt; const int* rowtok; MoeTabs tb;
    __device__ __forceinline__ __amdgpu_buffer_rsrc_t a_rsrc() const { return __builtin_amdgcn_make_buffer_rsrc((void*)A, 0, 0x7fffffff, 0x00020000); }
    __device__ __forceinline__ __amdgpu_buffer_rsrc_t b_rsrc() const { return __builtin_amdgcn_make_buffer_rsrc((void*)Bt, 0, 0x7fffffff, 0x00020000); }
    __device__ __forceinline__ unsigned a_soff(const pg8::Unit&) const { return 0u; }
    __device__ __forceinline__ unsigned b_soff(const pg8::Unit& u) const { const unsigned e = tb.te[u.pm]; return (e * 2048u + (unsigned)u.pn * 256u) * 1024u; }
    __device__ __forceinline__ void a_raw(const pg8::Unit& u, const int (&R)[2], unsigned (&raw)[2][2]) const {
        const int e = tb.te[u.pm], pos0 = (u.pm - tb.cst[e]) * 256, n = tb.cnt[e];
#pragma unroll
        for (int h = 0; h < 2; ++h)
#pragma unroll
            for (int i = 0; i < 2; ++i) { const int pos = pos0 + h * 128 + R[i]; raw[h][i] = (unsigned)rowtok[(size_t)e * EROWS + (pos < n ? pos : 0)]; } }
    __device__ __forceinline__ unsigned a_fin(unsigned tok, int C) const { return (tok * 512u + (unsigned)C) * 2u; }
    __device__ __forceinline__ void a_off(const pg8::Unit& u, const int (&R)[2], const int (&C)[2], unsigned (&vo)[2][2]) const {
        unsigned raw[2][2]; a_raw(u, R, raw);
#pragma unroll
        for (int h = 0; h < 2; ++h)
#pragma unroll
            for (int i = 0; i < 2; ++i) vo[h][i] = a_fin(raw[h][i], C[i]); }
};
struct MoeMapDown { static constexpr bool GATHER = false;
    const unsigned char* A; const unsigned char* Bt; MoeTabs tb;
    __device__ __forceinline__ __amdgpu_buffer_rsrc_t a_rsrc() const { return __builtin_amdgcn_make_buffer_rsrc((void*)A, 0, 0x7fffffff, 0x00020000); }
    __device__ __forceinline__ __amdgpu_buffer_rsrc_t b_rsrc() const { return __builtin_amdgcn_make_buffer_rsrc((void*)Bt, 0, 0x7fffffff, 0x00020000); }
    __device__ __forceinline__ unsigned a_soff(const pg8::Unit& u) const { return (unsigned)u.pm * 256u * 1024u; }
    __device__ __forceinline__ unsigned b_soff(const pg8::Unit& u) const { const unsigned e = tb.te[u.pm]; return (e * 1024u + (unsigned)u.pn * 256u) * 1024u; }
    __device__ __forceinline__ void a_off(const pg8::Unit&, const int (&R)[2], const int (&C)[2], unsigned (&vo)[2][2]) const {
#pragma unroll
        for (int h = 0; h < 2; ++h)
#pragma unroll
            for (int i = 0; i < 2; ++i) vo[h][i] = (unsigned)((h * 128 + R[i]) * 512 + C[i]) * 2u; }
};
using pg8::f32x4;
struct EpiInProj { static constexpr bool PERM = true, COLS64 = false;
    bf16 *gq, *gk, *gv, *gr, *aq, *ak, *av, *z;
    struct Pre {}; __device__ __forceinline__ void preload(const pg8::Unit&, int, int, int, int, Pre&) const {}
    __device__ __forceinline__ void operator()(const f32x4 (&acc)[2][2][4][2], const pg8::Unit& u, const Pre&, int wr, int wc, int fr, int fq) const {
        bf16* b0; bf16* b1; int ld;
        switch (u.pn) { case 0: b0 = gq; b1 = gq + 128; ld = 256; break; case 1: b0 = gk; b1 = gk + 128; ld = 256; break;
            case 2: b0 = gv; b1 = gv + 128; ld = 512; break; case 3: b0 = gv + 256; b1 = gv + 384; ld = 512; break;
            case 4: b0 = gr; b1 = gr + 128; ld = 512; break; case 5: b0 = gr + 256; b1 = gr + 384; ld = 512; break;
            case 6: b0 = aq; b1 = aq + 128; ld = 512; break; case 7: b0 = aq + 256; b1 = aq + 384; ld = 512; break;
            case 8: b0 = ak; b1 = av; ld = 128; break; default: b0 = z; b1 = z; ld = 32; break; }
        const bool zt = (u.pn == 9);
        if (zt && wc != 0) return;
        const int row0 = u.pm * 256 + wr * 64 + fr, cw = wc * 32 + 8 * fq;
#pragma unroll
        for (int ai = 0; ai < 2; ++ai)
#pragma unroll
            for (int m = 0; m < 4; ++m) { const size_t row = (size_t)(row0 + ai * 128 + m * 16);
#pragma unroll
                for (int bj = 0; bj < 2; ++bj) { if (zt && bj == 1) continue; const f32x4 v0 = acc[ai][bj][m][0], v1 = acc[ai][bj][m][1];
                    pg8::u32x4 wv; wv.x = pg8::cvt_pk_bf16(v0[0], v0[1]); wv.y = pg8::cvt_pk_bf16(v0[2], v0[3]); wv.z = pg8::cvt_pk_bf16(v1[0], v1[1]); wv.w = pg8::cvt_pk_bf16(v1[2], v1[3]);
                    *(pg8::u32x4*)((bj ? b1 : b0) + row * ld + cw) = wv; } }
    }
};
struct EpiResF32 { static constexpr bool PERM = false, COLS64 = false;
    const float* base; float* out;
    struct Pre {}; __device__ __forceinline__ void preload(const pg8::Unit&, int, int, int, int, Pre&) const {}
    __device__ __forceinline__ void operator()(const f32x4 (&acc)[2][2][4][2], const pg8::Unit& u, const Pre&, int wr, int wc, int fr, int fq) const {
        const int col0 = u.pn * 256 + wc * 32 + 4 * fq;
#pragma unroll
        for (int ai = 0; ai < 2; ++ai)
#pragma unroll
            for (int m = 0; m < 4; ++m) { const size_t off = (size_t)(u.pm * 256 + ai * 128 + wr * 64 + m * 16 + fr) * 1024 + col0;
#pragma unroll
                for (int bj = 0; bj < 2; ++bj)
#pragma unroll
                    for (int n = 0; n < 2; ++n) { const f32x4 bs = *(const f32x4*)(base + off + bj * 128 + n * 16); *(f32x4*)(out + off + bj * 128 + n * 16) = bs + acc[ai][bj][m][n]; } }
    }
};
struct EpiSwiglu { static constexpr bool PERM = true, COLS64 = false;
    const float* b1; unsigned char* act; MoeTabs tb;
    struct Pre { f32x4 g0, g1, l0, l1; };
    __device__ __forceinline__ void preload(const pg8::Unit& u, int wr, int wc, int fr, int fq, Pre& p) const {
        const int e = tb.te[u.pm]; const int col = u.pn * 128 + wc * 32 + 8 * fq; const float* bg = b1 + (size_t)e * 2048 + col; const float* bl = bg + 1024;
        p.g0 = *(const GAS f32x4*)bg; p.g1 = *(const GAS f32x4*)(bg + 4); p.l0 = *(const GAS f32x4*)bl; p.l1 = *(const GAS f32x4*)(bl + 4); }
    __device__ __forceinline__ void operator()(const f32x4 (&acc)[2][2][4][2], const pg8::Unit& u, const Pre& p, int wr, int wc, int fr, int fq) const {
        const int col = u.pn * 128 + wc * 32 + 8 * fq;
        const f32x4 g0 = p.g0, g1 = p.g1, l0 = p.l0, l1 = p.l1;
        const int row0 = u.pm * 256 + wr * 64 + fr;
#pragma unroll
        for (int ai = 0; ai < 2; ++ai)
#pragma unroll
            for (int m = 0; m < 4; ++m) { float o[8];
#pragma unroll
                for (int n = 0; n < 2; ++n)
#pragma unroll
                    for (int j = 0; j < 4; ++j) { const float gl = fminf(__builtin_fmaf(acc[ai][0][m][n][j], 1.f / WSCALE, (n ? g1[j] : g0[j])), 7.f); const float li = __builtin_amdgcn_fmed3f(__builtin_fmaf(acc[ai][1][m][n][j], 1.f / WSCALE, (n ? l1[j] : l0[j])), -7.f, 7.f);
                        o[4 * n + j] = (gl * ASCALE) * __builtin_amdgcn_rcpf(1.f + __builtin_amdgcn_exp2f(gl * (-1.702f * 1.4426950408889634f))) * (li + 1.f); }
                int w0 = 0, w1 = 0;
                w0 = __builtin_amdgcn_cvt_pk_fp8_f32(o[0], o[1], w0, false); w0 = __builtin_amdgcn_cvt_pk_fp8_f32(o[2], o[3], w0, true); w1 = __builtin_amdgcn_cvt_pk_fp8_f32(o[4], o[5], w1, false); w1 = __builtin_amdgcn_cvt_pk_fp8_f32(o[6], o[7], w1, true);
                *(v2u*)(act + (size_t)(row0 + ai * 128 + m * 16) * 1024 + col) = (v2u){(unsigned)w0, (unsigned)w1}; }
    }
};
struct EpiDown { static constexpr bool PERM = true, COLS64 = true;
    const float* b2; const float* rowgate; unsigned char* y; MoeTabs tb;
    struct Pre { f32x4 bv[2][2]; float gt[8]; };
    __device__ __forceinline__ void preload(const pg8::Unit& u, int wr, int wc, int fr, int fq, Pre& p) const {
        const int e = tb.te[u.pm], pos0 = (u.pm - tb.cst[e]) * 256, n_e = tb.cnt[e];
        const float* bb = b2 + (size_t)e * 1024 + u.pn * 256 + wc * 64 + 8 * fq;
#pragma unroll
        for (int bj = 0; bj < 2; ++bj)
#pragma unroll
            for (int n = 0; n < 2; ++n) p.bv[bj][n] = *(const GAS f32x4*)(bb + bj * 32 + 4 * n);
#pragma unroll
        for (int ai = 0; ai < 2; ++ai)
#pragma unroll
            for (int m = 0; m < 4; ++m) { const int pos = pos0 + wr * 64 + fr + ai * 128 + m * 16; const int pc_ = pos < n_e ? pos : 0; const float g = rowgate[(size_t)e * EROWS + pc_]; p.gt[ai * 4 + m] = (pos < n_e) ? g * YSCALE : 0.f; }
    }
    __device__ __forceinline__ void operator()(const f32x4 (&acc)[2][2][4][2], const pg8::Unit& u, const Pre& p, int wr, int wc, int fr, int fq) const {
        const bool odd = (fq & 1) != 0;
        const int colb = u.pn * 256 + wc * 64 + (odd ? 32 + 8 * (fq - 1) : 8 * fq), rl0 = wr * 64 + fr;
#pragma unroll
        for (int ai = 0; ai < 2; ++ai)
#pragma unroll
            for (int m = 0; m < 4; ++m) { const int rl = rl0 + ai * 128 + m * 16; const float gt = p.gt[ai * 4 + m];
                unsigned w[2][2];
#pragma unroll
                for (int bj = 0; bj < 2; ++bj) { const f32x4 v0 = (acc[ai][bj][m][0] * (1.f / (WSCALE * ASCALE)) + p.bv[bj][0]) * gt, v1 = (acc[ai][bj][m][1] * (1.f / (WSCALE * ASCALE)) + p.bv[bj][1]) * gt;
                    int w0 = 0, w1 = 0;
                    w0 = __builtin_amdgcn_cvt_pk_fp8_f32(v0[0], v0[1], w0, false); w0 = __builtin_amdgcn_cvt_pk_fp8_f32(v0[2], v0[3], w0, true); w1 = __builtin_amdgcn_cvt_pk_fp8_f32(v1[0], v1[1], w1, false); w1 = __builtin_amdgcn_cvt_pk_fp8_f32(v1[2], v1[3], w1, true);
                    w[bj][0] = (unsigned)w0; w[bj][1] = (unsigned)w1; }
                const unsigned s0 = odd ? w[0][0] : w[1][0], s1 = odd ? w[0][1] : w[1][1];
                const unsigned r0 = (unsigned)__shfl_xor((int)s0, 16), r1 = (unsigned)__shfl_xor((int)s1, 16);
                const pg8::u32x4 ov = odd ? (pg8::u32x4){r0, r1, w[1][0], w[1][1]} : (pg8::u32x4){w[0][0], w[0][1], r0, r1};
                *(pg8::u32x4*)(y + (size_t)(u.pm * 256 + rl) * 1024 + colb) = ov; }
    }
};
__device__ __forceinline__ int moe_tables(Frame& F) {
    LAS int* cnt = (LAS int*)(F.lds + LC_CNT); LAS int* cst = (LAS int*)(F.lds + LC_CST); LAS unsigned short* te = (LAS unsigned short*)(F.lds + LC_TE);
    __syncthreads();
    if (F.tid < NEXP) cnt[F.tid] = (int)__hip_atomic_load(F.ctl + CW_CNT + 64 * F.tid, RLX_AGENT);
    __syncthreads();
    if (F.tid == 0) { int s = 0; for (int e = 0; e < NEXP; ++e) { cst[e] = s; s += (cnt[e] + 255) >> 8; } cst[NEXP] = s; }
    __syncthreads();
    const int nt = cst[NEXP];
    for (int t = F.tid; t < nt; t += NWAVES * 64) { int e = 0;
#pragma unroll 1
        for (int k = 1; k < NEXP; ++k) e = (t >= cst[k]) ? k : e;
        te[t] = (unsigned short)e; }
    __syncthreads();
    return nt;
}
__device__ __forceinline__ void p3_mixers(Frame& F) {
    for (int u = blockIdx.x; u < 2 * BATCH * GLA_H; u += F.G) gla::gla_unit(F, u & 7, (u >> 3) & 3, u >> 5);
    const attn_body::bf16* Q = (const attn_body::bf16*)(F.ws + WS_AQ); const attn_body::bf16* K = (const attn_body::bf16*)(F.ws + WS_AK); const attn_body::bf16* V = (const attn_body::bf16*)(F.ws + WS_AV);
    attn_body::bf16* O = (attn_body::bf16*)(F.ws + WS_MIX);
    const int x0 = blockIdx.x & 7;
    float sbound;
    { float mq = fabsf(F.q_g[F.lane]), mk = fabsf(F.k_g[F.lane]);
#pragma unroll
      for (int o_ = 1; o_ < 64; o_ <<= 1) { mq = fmaxf(mq, __shfl_xor(mq, o_)); mk = fmaxf(mk, __shfl_xor(mk, o_)); }
      sbound = __builtin_bit_cast(float, __builtin_amdgcn_readfirstlane(__builtin_bit_cast(int, 64.f * attn_body::C2 * mq * mk * 1.02f))); }
    for (int qi = 0; qi < 8; ++qi) { const int x = (x0 + qi) & 7;
        for (;;) {
            __syncthreads();
            if (F.tid == 0) F.MISC[16] = __hip_atomic_fetch_add(F.ctl + CW_QUE + 64 * x, 1u, RLX_AGENT);
            __syncthreads();
            const int item = __builtin_amdgcn_readfirstlane((int)F.MISC[16]);
            if (item >= ATT_H * attn_body::NQB + 4 * GLA_H) break;
            if (item >= ATT_H * attn_body::NQB) { const int k = item - ATT_H * attn_body::NQB; gla::gla_combine(F, x, k >> 2, k & 3); continue; }
            attn_body::attn_unit<8>(x, item >> 4, item & 15, Q, K, V, O, (char*)F.lds, F.q_g, sbound);
        }
    }
}

__device__ __forceinline__ void p5_route(Frame& F) {
    typedef float f32x16 __attribute__((ext_vector_type(16)));
    LAS unsigned char* L = F.lds;
    constexpr int XP = 2064, L_XH = 0, L_XL = 32 * XP, L_PART = 0;
    const int tid = F.tid, lane = F.lane, w = F.wave, r32 = lane & 31, hi = lane >> 5;
    const bf16* WRH = (const bf16*)(F.ws + WS_WRH); const bf16* WRL = (const bf16*)(F.ws + WS_WRL);
    unsigned char* XN8 = F.ws + WS_XN;
    int* ROWTOK = (int*)(F.ws + WS_ROWTOK); float* ROWGATE = (float*)(F.ws + WS_ROWGATE); int* TOKASG = (int*)(F.ws + WS_TOKASG);
    gu32* CNT = F.ctl + CW_CNT;
    bf16x8 wh[8], wl[8];
#pragma unroll
    for (int ks = 0; ks < 8; ++ks) { const int k0 = 128 * w + 16 * ks + 8 * hi; wh[ks] = *(const GAS bf16x8*)(WRH + r32 * 1024 + k0); wl[ks] = *(const GAS bf16x8*)(WRL + r32 * 1024 + k0); }
    f32x4 g2[4];
#pragma unroll
    for (int j = 0; j < 4; ++j) g2[j] = *((const GAS f32x4*)F.ffn_g + lane + 64 * j);
    float brt[16];
#pragma unroll
    for (int r = 0; r < 16; ++r) brt[r] = F.b_router[(r & 3) + 8 * (r >> 2) + 4 * hi];
    LAS int* hist = (LAS int*)(L + LC_HIST); LAS int* basev = (LAS int*)(L + LC_BASE); LAS int* aep = (LAS int*)(L + LC_ASG); LAS float* agt = (LAS float*)(L + LC_ASG + 4096);
    constexpr int NGRP = T / 32;
    const int per = (NGRP + F.G - 1) / F.G, g0 = F.vcu * per, g1 = (g0 + per < NGRP) ? g0 + per : NGRP;
    for (int gb = g0; gb < g1; gb += 8) {
        const int nb = (g1 - gb < 8) ? g1 - gb : 8;
        __syncthreads();
        if (tid < NEXP) hist[tid] = 0;
        for (int bi = 0; bi < nb; ++bi) {
            const int t0 = 32 * (gb + bi);
            f32x4 hv[4][4];
#pragma unroll
            for (int rr = 0; rr < 4; ++rr) { const GAS f32x4* hp = (const GAS f32x4*)(F.out + (size_t)(t0 + 4 * w + rr) * 1024) + lane;
#pragma unroll
                for (int j = 0; j < 4; ++j) hv[rr][j] = __builtin_nontemporal_load(hp + 64 * j); }
#pragma unroll
            for (int rr = 0; rr < 4; ++rr) { const int r = 4 * w + rr; const size_t tok = (size_t)(t0 + r);
                f32x4 v[4]; float s = 0.f;
#pragma unroll
                for (int j = 0; j < 4; ++j) { v[j] = hv[rr][j]; s += (v[j].x * v[j].x + v[j].y * v[j].y) + (v[j].z * v[j].z + v[j].w * v[j].w); }
                const float rinv = 1.f / sqrtf(wave_sum(s) * (1.f / 1024.f) + EPS);
                GAS unsigned* o4 = (GAS unsigned*)(XN8 + tok * 1024) + lane;
#pragma unroll
                for (int j = 0; j < 4; ++j) { const f32x4 xn = v[j] * rinv * g2[j];
                    const unsigned h0 = f2bf(xn.x), h1 = f2bf(xn.y), h2 = f2bf(xn.z), h3 = f2bf(xn.w);
                    const unsigned l0 = f2bf(xn.x - bf2f(h0)), l1 = f2bf(xn.y - bf2f(h1)), l2 = f2bf(xn.z - bf2f(h2)), l3 = f2bf(xn.w - bf2f(h3));
                    const v2u hw = (v2u){h0 | (h1 << 16), h2 | (h3 << 16)}, lw = (v2u){l0 | (l1 << 16), l2 | (l3 << 16)};
                    { int q8 = 0; q8 = __builtin_amdgcn_cvt_pk_fp8_f32(xn.x, xn.y, q8, false); q8 = __builtin_amdgcn_cvt_pk_fp8_f32(xn.z, xn.w, q8, true); o4[64 * j] = (unsigned)q8; }
                    *(LAS v2u*)(L + L_XH + r * XP + (4 * lane + 256 * j) * 2) = hw; *(LAS v2u*)(L + L_XL + r * XP + (4 * lane + 256 * j) * 2) = lw; } }
            __syncthreads();
            f32x16 acc = {};
#pragma unroll
            for (int ks = 0; ks < 8; ++ks) { const int k0 = 128 * w + 16 * ks + 8 * hi;
                const bf16x8 xh = *(const LAS bf16x8*)(L + L_XH + r32 * XP + k0 * 2), xl = *(const LAS bf16x8*)(L + L_XL + r32 * XP + k0 * 2);
                acc = __builtin_amdgcn_mfma_f32_32x32x16_bf16(wh[ks], xh, acc, 0, 0, 0); acc = __builtin_amdgcn_mfma_f32_32x32x16_bf16(wh[ks], xl, acc, 0, 0, 0); acc = __builtin_amdgcn_mfma_f32_32x32x16_bf16(wl[ks], xh, acc, 0, 0, 0); }
            __syncthreads();
#pragma unroll
            for (int r = 0; r < 16; ++r) { const int e = (r & 3) + 8 * (r >> 2) + 4 * hi; ((LAS float*)(L + L_PART))[(w * 32 + e) * 32 + r32] = acc[r]; }
            __syncthreads();
            if (w == 0) {
                float v[16];
#pragma unroll
                for (int r = 0; r < 16; ++r) { const int e = (r & 3) + 8 * (r >> 2) + 4 * hi; float s = brt[r];
#pragma unroll
                    for (int ww = 0; ww < 8; ++ww) s += ((const LAS float*)(L + L_PART))[(ww * 32 + e) * 32 + r32];
                    v[r] = s; }
                float cv[8]; int cidx[8];
#pragma unroll
                for (int s = 0; s < 4; ++s) { float m = -INFINITY; int mr = 0;
#pragma unroll
                    for (int r = 0; r < 16; ++r) { if (v[r] > m) { m = v[r]; mr = r; } }
                    cv[s] = m; cidx[s] = (mr & 3) + 8 * (mr >> 2) + 4 * hi;
#pragma unroll
                    for (int r = 0; r < 16; ++r) v[r] = (r == mr) ? -INFINITY : v[r]; }
#pragma unroll
                for (int s = 0; s < 4; ++s) { cv[4 + s] = __shfl_xor(cv[s], 32); cidx[4 + s] = __shfl_xor(cidx[s], 32); }
                float tv[4]; int ti[4];
#pragma unroll
                for (int s = 0; s < 4; ++s) { float m = -INFINITY; int mi = 1 << 20; int mc = 0;
#pragma unroll
                    for (int c = 0; c < 8; ++c) { const bool better = (cv[c] > m) || (cv[c] == m && cidx[c] < mi); if (better) { m = cv[c]; mi = cidx[c]; mc = c; } }
                    tv[s] = m; ti[s] = mi;
#pragma unroll
                    for (int c = 0; c < 8; ++c) cv[c] = (c == mc) ? -INFINITY : cv[c]; }
                const float e1 = __expf(tv[1] - tv[0]), e2 = __expf(tv[2] - tv[0]), e3 = __expf(tv[3] - tv[0]); const float inv = 1.f / (1.f + e1 + e2 + e3);
                const float gt[4] = {inv, e1 * inv, e2 * inv, e3 * inv};
                if (hi == 0) {
#pragma unroll
                    for (int s = 0; s < 4; ++s) { const int rank = (int)__hip_atomic_fetch_add(hist + ti[s], 1, __ATOMIC_RELAXED, __HIP_MEMORY_SCOPE_WORKGROUP); const int idx = (bi * 32 + r32) * 4 + s; aep[idx] = (ti[s] << 16) | rank; agt[idx] = gt[s]; } }
            }
            __syncthreads();
        }
        if (tid < NEXP) { const int hc = hist[tid]; basev[tid] = hc ? (int)__hip_atomic_fetch_add(CNT + 64 * tid, (unsigned)hc, RLX_AGENT) : 0; }
        __syncthreads();
        for (int idx = tid; idx < nb * 128; idx += NWAVES * 64) { const int ep = aep[idx], e = ep >> 16, pos = basev[e] + (ep & 0xffff); const int tok = 32 * gb + (idx >> 2), s = idx & 3;
            ROWTOK[(size_t)e * EROWS + pos] = tok; ROWGATE[(size_t)e * EROWS + pos] = agt[idx]; TOKASG[tok * 4 + s] = e * EROWS + pos; }
    }
    __syncthreads();
}

__device__ __forceinline__ void p8_combine(Frame& F) {
    const LAS int* cst = (const LAS int*)(F.lds + LC_CST);
    const int gw = F.vcu * NWAVES + F.wave, NGW = F.G * NWAVES, lane = F.lane;
    const int* TOKASG = (const int*)(F.ws + WS_TOKASG); const unsigned char* Y = F.ws + WS_Y;
    f32x4 fg[4];
#pragma unroll
    for (int j = 0; j < 4; ++j) fg[j] = *((const GAS f32x4*)F.fin_g + lane + 64 * j);
    for (int tok = gw; tok < T; tok += NGW) {
        const int a = TOKASG[tok * 4 + (lane & 3)];
        const int crow = cst[a >> 15] * 256 + (a & (EROWS - 1));
        GAS f32x4* hp = (GAS f32x4*)(F.out + (size_t)tok * 1024) + lane; f32x4 v[4];
#pragma unroll
        for (int j = 0; j < 4; ++j) v[j] = __builtin_nontemporal_load(hp + 64 * j);
#pragma unroll
        for (int s = 0; s < 4; ++s) { const int cr = __shfl(crow, s); const GAS unsigned* yp = (const GAS unsigned*)(Y + (size_t)cr * 1024) + lane;
#pragma unroll
            for (int j = 0; j < 4; ++j) { const unsigned yw = __builtin_nontemporal_load(yp + 64 * j); const auto lo = __builtin_amdgcn_cvt_pk_f32_fp8((int)yw, false), hi = __builtin_amdgcn_cvt_pk_f32_fp8((int)yw, true);
                v[j].x += lo[0] * (1.f / YSCALE); v[j].y += lo[1] * (1.f / YSCALE); v[j].z += hi[0] * (1.f / YSCALE); v[j].w += hi[1] * (1.f / YSCALE); } }
        float ss = 0.f;
#pragma unroll
        for (int j = 0; j < 4; ++j) ss += (v[j].x * v[j].x + v[j].y * v[j].y) + (v[j].z * v[j].z + v[j].w * v[j].w);
        const float rinv = 1.f / sqrtf(wave_sum(ss) * (1.f / 1024.f) + EPS);
#pragma unroll
        for (int j = 0; j < 4; ++j) __builtin_nontemporal_store(v[j] * rinv * fg[j], hp + 64 * j);
    }
}
#ifndef MK_N_LAUNCHES
#define MK_N_LAUNCHES 1
#endif
constexpr int N_PHASES = 9;
constexpr int N_LAUNCHES = MK_N_LAUNCHES;
struct Args { const float* in[19]; float* out; unsigned char* ws; int ph_lo, ph_hi; };
__global__ void __launch_bounds__(NWAVES * 64, 2) enc_fwd(Args args) {
    extern __shared__ __attribute__((aligned(16))) unsigned char lds[];
    Frame F;
    F.lds = (LAS unsigned char*)lds;
    F.MISC = (volatile LAS unsigned*)(F.lds + LC_MISC);
    F.tid = threadIdx.x; F.lane = F.tid & 63; F.wave = __builtin_amdgcn_readfirstlane(F.tid >> 6);
    F.G = gridDim.x; { const int bx = blockIdx.x; F.vcu = (F.G % 8 == 0) ? (bx % 8) * (F.G / 8) + bx / 8 : bx; }
    F.ws = args.ws; F.ctl = (gu32*)(args.ws + WS_CTL);
    F.x = args.in[0]; F.mix_g = args.in[1]; F.w_in = args.in[2]; F.w_gf = args.in[3]; F.b_gf = args.in[4]; F.w_gb = args.in[5]; F.b_gb = args.in[6]; F.gla_hg = args.in[7];
    F.q_g = args.in[8]; F.k_g = args.in[9]; F.w_out = args.in[10]; F.ffn_g = args.in[11]; F.w_router = args.in[12]; F.b_router = args.in[13];
    F.w1 = args.in[14]; F.b1 = args.in[15]; F.w2 = args.in[16]; F.b2 = args.in[17]; F.fin_g = args.in[18]; F.out = args.out;
    for (int u = F.tid; u < (LDS_BYTES - LC_OFF) / 4; u += NWAVES * 64) ((LAS unsigned*)(F.lds + LC_OFF))[u] = 0u;
    __syncthreads();
    XcdBarrier bar; bar.bar = (unsigned*)(F.ctl + CW_BAR); bar.x = 0; bar.st = nullptr;
    if (N_LAUNCHES == 1) bar = xcd_barrier_post((unsigned*)(F.ctl + CW_BAR), F.MISC + 8);
    const int lo = args.ph_lo, hi = args.ph_hi;
#define IN(k) (lo <= (k) && (k) < hi)
#define SEAM(k) do { if (IN(k) && IN((k) + 1)) xcd_barrier(bar); } while (0)
    MoeTabs tb{(const LAS int*)(F.lds + LC_CNT), (const LAS int*)(F.lds + LC_CST), (const LAS unsigned short*)(F.lds + LC_TE)};

    if (IN(0)) { p0_prologue(F); } SEAM(0);
    if (IN(1)) {
        DenseMap mp{(const bf16*)(F.ws + WS_XN), (const bf16*)(F.ws + WS_WIN), 1024};
        pg8::StaticOrder S; S.init(T / 256, D_IN_PAD / 256, F.G, (int)blockIdx.x);
        EpiInProj E{(bf16*)(F.ws + WS_GQ), (bf16*)(F.ws + WS_GK), (bf16*)(F.ws + WS_GV), (bf16*)(F.ws + WS_GR), (bf16*)(F.ws + WS_AQ), (bf16*)(F.ws + WS_AK), (bf16*)(F.ws + WS_AV), (bf16*)(F.ws + WS_Z)};
        pg8::gemm_phase<EpiInProj, pg8::StaticOrder, DenseMap, true>(F.lds, 1024, S, mp, E);
    } SEAM(1);
    if (IN(2)) { p2_normrope(F); for (int u = F.vcu; u < BATCH * 64; u += F.G) gla::gla_prep_unit(F, u >> 6, u & 63); } SEAM(2);
    if (IN(3)) { p3_mixers(F); } SEAM(3);
    if (IN(4)) {
        DenseMap mp{(const bf16*)(F.ws + WS_MIX), (const bf16*)(F.ws + WS_WOUT), 1024};
        pg8::StaticOrder S; S.init(T / 256, DM / 256, F.G, (int)blockIdx.x);
        EpiResF32 E{F.x, F.out};
        pg8::gemm_phase<EpiResF32, pg8::StaticOrder, DenseMap, true>(F.lds, 1024, S, mp, E);
    } SEAM(4);
    if (IN(5)) { p5_route(F); } SEAM(5);
    if (IN(6)) {
        const int ntl = moe_tables(F);
        MoeMapUp mp{F.ws + WS_XN, F.ws + WS_W1, (const int*)(F.ws + WS_ROWTOK), tb};
        pg8::StaticOrder S; S.init(ntl, 8, F.G, (int)blockIdx.x);
        EpiSwiglu E{F.b1, F.ws + WS_ACT, tb};
        pg8::gemm_phase<EpiSwiglu, pg8::StaticOrder, MoeMapUp, true, true>(F.lds, 512, S, mp, E);
    } SEAM(6);
    if (IN(7)) {
        const int ntl = moe_tables(F);
        MoeMapDown mp{F.ws + WS_ACT, F.ws + WS_W2, tb};
        pg8::StaticOrder S; S.init(ntl, 4, F.G, (int)blockIdx.x);
        EpiDown E{F.b2, (const float*)(F.ws + WS_ROWGATE), F.ws + WS_Y, tb};
        pg8::gemm_phase<EpiDown, pg8::StaticOrder, MoeMapDown, true, true>(F.lds, 512, S, mp, E);
    } SEAM(7);
    if (IN(8)) { (void)moe_tables(F); p8_combine(F); }
#undef IN
#undef SEAM
}

extern "C" void kernel_launch(void* const* d_in, const int* in_sizes, int n_in, void* d_out, int out_size, void* d_ws, size_t ws_size, hipStream_t stream) {
    static int grid = 0;
    if (grid == 0) {
        if (n_in != 19 || in_sizes[0] != T * DM || out_size != T * DM || ws_size < WS_END) { fprintf(stderr, "kernel_launch: unexpected shapes (n_in %d, in0 %d, out %d, ws %zu); nothing launched\n", n_in, n_in > 0 ? in_sizes[0] : -1, out_size, ws_size); grid = -1; return; }
        int dev = 0, cus = 0, per_cu = 0;
        if (hipGetDevice(&dev) != hipSuccess || hipDeviceGetAttribute(&cus, hipDeviceAttributeMultiprocessorCount, dev) != hipSuccess) { grid = -1; return; }
        if (hipFuncSetAttribute((const void*)enc_fwd, hipFuncAttributeMaxDynamicSharedMemorySize, LDS_BYTES) != hipSuccess) { fprintf(stderr, "kernel_launch: hipFuncSetAttribute failed\n"); grid = -1; return; }
        if (hipOccupancyMaxActiveBlocksPerMultiprocessor(&per_cu, (const void*)enc_fwd, NWAVES * 64, LDS_BYTES) != hipSuccess || per_cu < 1) { fprintf(stderr, "kernel_launch: occupancy query says %d\n", per_cu); }
        (void)hipGetLastError();
        grid = cus;
    }
    if (grid < 0) return;
    if (hipMemsetAsync((char*)d_ws + WS_CTL, 0, CTL_ZERO_BYTES, stream) != hipSuccess) return;
    Args a{};
    for (int i = 0; i < 19; ++i) a.in[i] = (const float*)d_in[i];
    a.out = (float*)d_out; a.ws = (unsigned char*)d_ws;
    if (N_LAUNCHES == 1) { a.ph_lo = 0; a.ph_hi = N_PHASES; hipLaunchKernelGGL(enc_fwd, dim3(grid), dim3(NWAVES * 64), LDS_BYTES, stream, a); }
    else for (int p = 0; p < N_PHASES; ++p) { a.ph_lo = p; a.ph_hi = p + 1; hipLaunchKernelGGL(enc_fwd, dim3(grid), dim3(NWAVES * 64), LDS_BYTES, stream, a); }
}
```

```cpp
#include <hip/hip_runtime.h>
#include <hip/hip_bf16.h>
#include <cstdio>
#include <cstdint>
#include <cmath>

#define LAS __attribute__((address_space(3)))
#define GAS __attribute__((address_space(1)))

namespace pg8 {
typedef unsigned short bf16_t;
typedef short bf16x8 __attribute__((ext_vector_type(8)));
typedef float f32x4 __attribute__((ext_vector_type(4)));
typedef float f32x2 __attribute__((ext_vector_type(2)));
typedef unsigned u32x4 __attribute__((ext_vector_type(4)));
typedef int v4i_t __attribute__((ext_vector_type(4)));
typedef int v8i_t __attribute__((ext_vector_type(8)));
constexpr int BM = 256, BK = 64, HALF = 128, HTB = HALF * BK * 2, STAGE_BYTES = 8 * HTB, NXCD = 8, WGM = 8;

__host__ __device__ __forceinline__ int lds_byte(int r, int c) { const int st = (r >> 4) * 2 + (c >> 5), rr = r & 15, cc = c & 31, ob = rr * 64 + cc * 2; return st * 1024 + (ob ^ (((ob >> 9) & 1) << 5)); }
__host__ __device__ __forceinline__ void stage_rc(int b, int& R, int& C) { const int st = b / 1024, sb = b % 1024, swz = sb ^ (((sb >> 9) & 1) << 5); R = (st >> 1) * 16 + swz / 64; C = (st & 1) * 32 + (swz % 64) / 2; }
__host__ __device__ __forceinline__ int perm32(int rho) { const int n = rho >> 4, i = rho & 15; return 8 * (i >> 2) + 4 * n + (i & 3); }

struct Unit { int pm, pn; };

struct StaticOrder {
    int nM, nN, nwg, G, c;
    __device__ __forceinline__ void init(int nM_, int nN_, int G_, int c_) { nM = nM_; nN = nN_; nwg = nM * nN; G = G_; c = c_; }
    __device__ __forceinline__ bool next(int i, Unit& u) const {
        const long L = (long)i * G + c; if (L >= nwg) return false;
        int wgid = (int)L; { const int q = nwg / NXCD, r = nwg % NXCD, xcd = wgid % NXCD, off = wgid / NXCD; wgid = (xcd < r ? xcd * (q + 1) : r * (q + 1) + (xcd - r) * q) + off; }
        const int nig = WGM * nN, gid = wgid / nig, fm = gid * WGM, gsz = (nM - fm) < WGM ? (nM - fm) : WGM;
        u.pm = fm + ((wgid % nig) % gsz); u.pn = (wgid % nig) / gsz; return true;
    }
};

__device__ __forceinline__ unsigned cvt_pk_bf16(float lo, float hi) { unsigned r; asm volatile("v_cvt_pk_bf16_f32 %0, %1, %2" : "=v"(r) : "v"(lo), "v"(hi)); return r; }

template <class Epi, class Sched, class Map, bool ALIGN_EPI, bool FP8 = false>
__device__ __forceinline__ void gemm_phase(LAS unsigned char* lds, const int K, const Sched& S, const Map& MP, const Epi& E) {
    int tid_ = threadIdx.x; asm volatile("" : "+v"(tid_));
    const int tid = tid_, wid = __builtin_amdgcn_readfirstlane(tid >> 6), lane = tid & 63, wr = wid >> 2, wc = wid & 3, fr = lane & 15, fq = lane >> 4;
    const int nt = K / BK;
    int Rr[2], Cc[2]; unsigned voffB[2];
#pragma unroll
    for (int i = 0; i < 2; ++i) { int R, C; stage_rc(tid * 16 + i * 8192, R, C); Rr[i] = R; Cc[i] = C; const int Rb = Epi::COLS64 ? (64 * (R >> 5) + perm32(R & 31)) : (Epi::PERM ? ((R & ~31) + perm32(R & 31)) : R); voffB[i] = (unsigned)(Rb * K + C) * 2u; }
    const unsigned kstep = (unsigned)(BK * 2);
    const unsigned hstep = (unsigned)HALF * K * 2;
    const unsigned hstepB = Epi::COLS64 ? 32u * (unsigned)K * 2u : hstep;
    const __amdgpu_buffer_rsrc_t RA = MP.a_rsrc(), RB = MP.b_rsrc();
    const unsigned ldsw = (unsigned)wid * 1024u;
    const int aoff = lds_byte(wr * 64 + fr, fq * 8), boff = lds_byte(wc * 32 + fr, fq * 8);
#define PG8_SA(b, h) (((b) * 2 + (h)) * HTB)
#define PG8_SB(b, h) ((4 + (b) * 2 + (h)) * HTB)
#define PG8_STAGE(bufoff, rsrc, soff, voff) do { _Pragma("unroll") for (int _i = 0; _i < 2; ++_i) \
        __builtin_amdgcn_raw_ptr_buffer_load_lds(rsrc, (LAS unsigned*)(lds + (bufoff) + ldsw + _i * 8192), 16, (int)(voff)[_i], (int)(soff), 0, 0); } while (0)
#define PG8_LD8(p) __builtin_shufflevector(*(const LAS v4i_t*)(p), *(const LAS v4i_t*)((p) + 1024), 0, 1, 2, 3, 4, 5, 6, 7)
#define PG8_LDA(dst, b, h) do { _Pragma("unroll") for (int m = 0; m < 4; ++m) dst[m] = PG8_LD8(lds + PG8_SA(b, h) + aoff + m * 2048); } while (0)
#define PG8_LDB(dst, b, h) do { _Pragma("unroll") for (int n = 0; n < 2; ++n) dst[n] = PG8_LD8(lds + PG8_SB(b, h) + boff + n * 2048); } while (0)
#define PG8_HALF(x, k) __builtin_bit_cast(bf16x8, __builtin_shufflevector(x, x, 4 * (k), 4 * (k) + 1, 4 * (k) + 2, 4 * (k) + 3))
#define PG8_MMA(ai, bj, At, Bt) do { __builtin_amdgcn_s_setprio(1); _Pragma("unroll") for (int m = 0; m < 4; ++m) _Pragma("unroll") for (int n = 0; n < 2; ++n) { \
        if constexpr (FP8) { acc[ai][bj][m][n] = __builtin_amdgcn_mfma_scale_f32_16x16x128_f8f6f4(Bt[n], At[m], acc[ai][bj][m][n], 0, 0, 0, 0x7f7f7f7f, 0, 0x7f7f7f7f); } \
        else { acc[ai][bj][m][n] = __builtin_amdgcn_mfma_f32_16x16x32_bf16(PG8_HALF(Bt[n], 0), PG8_HALF(At[m], 0), acc[ai][bj][m][n], 0, 0, 0); \
               acc[ai][bj][m][n] = __builtin_amdgcn_mfma_f32_16x16x32_bf16(PG8_HALF(Bt[n], 1), PG8_HALF(At[m], 1), acc[ai][bj][m][n], 0, 0, 0); } } \
        __builtin_amdgcn_s_setprio(0); } while (0)
#define PG8_WAIT_V(n) asm volatile("s_waitcnt vmcnt(" #n ")" ::: "memory")
#define PG8_WAIT_L(n) asm volatile("s_waitcnt lgkmcnt(" #n ")" ::: "memory")
#define PG8_BAR __builtin_amdgcn_s_barrier()
#define PG8_SCHED __builtin_amdgcn_sched_barrier(0)
    Unit cur, nxt, nn; int ui = 0;
    if (!S.next(0, cur)) return;
    f32x4 acc[2][2][4][2];
#pragma unroll
    for (int a = 0; a < 2; ++a)
#pragma unroll
        for (int b = 0; b < 2; ++b)
#pragma unroll
            for (int m = 0; m < 4; ++m)
#pragma unroll
                for (int n = 0; n < 2; ++n) acc[a][b][m][n] = (f32x4){0.f, 0.f, 0.f, 0.f};
    v8i_t At[4], B0[2], B1[2];
    unsigned cvo[2][2], nvo[2][2], nnvo[2][2];
    MP.a_off(cur, Rr, Cc, cvo);
    bool has_next = S.next(1, nxt);
    if constexpr (Map::GATHER) { if (has_next) MP.a_off(nxt, Rr, Cc, nvo); else { nvo[0][0] = cvo[0][0]; nvo[0][1] = cvo[0][1]; nvo[1][0] = cvo[1][0]; nvo[1][1] = cvo[1][1]; } }
    unsigned cA = MP.a_soff(cur), cB = MP.b_soff(cur);
    typename Epi::Pre pc, pn;
    E.preload(cur, wr, wc, fr, fq, pc); pn = pc;
    PG8_STAGE(PG8_SB(0, 0), RB, cB, voffB); PG8_STAGE(PG8_SB(0, 1), RB, cB + hstepB, voffB); PG8_STAGE(PG8_SA(0, 0), RA, cA, cvo[0]); PG8_STAGE(PG8_SA(0, 1), RA, cA, cvo[1]);
    if (wr == 1) PG8_BAR;
    PG8_WAIT_V(2); PG8_BAR;
    PG8_STAGE(PG8_SB(1, 0), RB, cB + kstep, voffB); PG8_STAGE(PG8_SA(1, 0), RA, cA + kstep, cvo[0]); PG8_STAGE(PG8_SB(1, 1), RB, cB + hstepB + kstep, voffB);
    PG8_WAIT_V(6); PG8_BAR;
    for (;;) {
        const unsigned nA = has_next ? MP.a_soff(nxt) : cA, nB = has_next ? MP.b_soff(nxt) : cB;
#pragma unroll 1
        for (int t = 0; t < nt; t += 2) {
            const bool last = (t == nt - 2);
            const unsigned a1 = cA + (unsigned)(t + 1) * kstep;
            const unsigned a2 = last ? nA : cA + (unsigned)(t + 2) * kstep, b2 = last ? nB : cB + (unsigned)(t + 2) * kstep;
            const unsigned a3 = a2 + kstep, b3 = b2 + kstep;
            unsigned s0[2] = {cvo[0][0], cvo[0][1]}, s1[2] = {cvo[1][0], cvo[1][1]};
            if constexpr (Map::GATHER) { if (last) { s0[0] = nvo[0][0]; s0[1] = nvo[0][1]; s1[0] = nvo[1][0]; s1[1] = nvo[1][1]; } }
            PG8_LDB(B0, 0, 0); PG8_LDB(B1, 0, 1); PG8_SCHED; PG8_LDA(At, 0, 0); PG8_STAGE(PG8_SA(1, 1), RA, a1, cvo[1]);
            PG8_WAIT_V(8); PG8_WAIT_L(0); PG8_BAR; PG8_MMA(0, 0, At, B0); PG8_MMA(0, 1, At, B1); PG8_BAR; PG8_SCHED;
            PG8_LDA(At, 0, 1); PG8_STAGE(PG8_SB(0, 0), RB, b2, voffB); PG8_STAGE(PG8_SB(0, 1), RB, b2 + hstepB, voffB); PG8_STAGE(PG8_SA(0, 0), RA, a2, s0);
            PG8_WAIT_V(8); PG8_WAIT_L(0); PG8_BAR; PG8_MMA(1, 0, At, B0); PG8_MMA(1, 1, At, B1); PG8_BAR; PG8_SCHED;
            PG8_LDB(B0, 1, 0); PG8_LDB(B1, 1, 1); PG8_SCHED; PG8_LDA(At, 1, 0); PG8_STAGE(PG8_SA(0, 1), RA, a2, s1);
            PG8_WAIT_V(8); PG8_WAIT_L(0); PG8_BAR; PG8_MMA(0, 0, At, B0); PG8_MMA(0, 1, At, B1); PG8_BAR; PG8_SCHED;
            PG8_LDA(At, 1, 1); PG8_STAGE(PG8_SB(1, 0), RB, b3, voffB); PG8_STAGE(PG8_SB(1, 1), RB, b3 + hstepB, voffB); PG8_STAGE(PG8_SA(1, 0), RA, a3, s0);
            PG8_WAIT_V(8); PG8_WAIT_L(0); PG8_BAR; PG8_MMA(1, 0, At, B0); PG8_MMA(1, 1, At, B1); PG8_BAR; PG8_SCHED;
        }
        if constexpr (ALIGN_EPI) { if (wr == 0) PG8_BAR; }
        const bool has_nn = has_next && S.next(ui + 2, nn);
        if constexpr (Map::GATHER) { if (has_nn) MP.a_raw(nn, Rr, nnvo); }
        if (has_next) E.preload(nxt, wr, wc, fr, fq, pn);
        { int fr_ = fr, fq_ = fq; asm volatile("" : "+v"(fr_), "+v"(fq_)); E(acc, cur, pc, wr, wc, fr_, fq_); }
        if (!has_next) break;
#pragma unroll
        for (int a = 0; a < 2; ++a)
#pragma unroll
            for (int b = 0; b < 2; ++b)
#pragma unroll
                for (int m = 0; m < 4; ++m)
#pragma unroll
                    for (int n = 0; n < 2; ++n) acc[a][b][m][n] = (f32x4){0.f, 0.f, 0.f, 0.f};
        cur = nxt; cA = nA; cB = nB; ++ui; pc = pn;
#pragma unroll
        for (int h = 0; h < 2; ++h)
#pragma unroll
            for (int i = 0; i < 2; ++i) { if constexpr (Map::GATHER) { cvo[h][i] = nvo[h][i]; nvo[h][i] = has_nn ? MP.a_fin(nnvo[h][i], Cc[i]) : nvo[h][i]; } }
        has_next = has_nn; nxt = nn;
        if constexpr (ALIGN_EPI) { if (wr == 1) PG8_BAR; }
    }
    PG8_WAIT_V(0);
    if constexpr (!ALIGN_EPI) { if (wr == 0) PG8_BAR; }
    PG8_BAR;
#undef PG8_SA
#undef PG8_SB
#undef PG8_STAGE
#undef PG8_LDA
#undef PG8_LDB
#undef PG8_MMA
#undef PG8_HALF
#undef PG8_LD8
#undef PG8_WAIT_V
#undef PG8_WAIT_L
#undef PG8_BAR
#undef PG8_SCHED
}
}
namespace attn_body {
using bf16=__hip_bfloat16;
using bf16x8=__attribute__((ext_vector_type(8)))short;
using s16x4=__attribute__((ext_vector_type(4)))short;
using f32x16=__attribute__((ext_vector_type(16)))float;
using u32x4=__attribute__((ext_vector_type(4)))unsigned;
constexpr int BATCH=8,NHEAD=8,NKVH=2,SEQ=4096,D=64;
constexpr int QP=512,KP=128,VP=128,OP=1024,OCOL=512;
constexpr int NW=8,QBLK=32,QB=QBLK*NW,KVBLK=64,NQB=SEQ/QB;
__device__ __forceinline__ int crow(int r,int hi){return (r&3)+8*(r>>2)+4*hi;}
#define SBAR() __builtin_amdgcn_sched_barrier(0)
constexpr int NSLOT=3, SLOTB=8192;
constexpr int LDS_K=0, LDS_V=NSLOT*SLOTB, LDS_WS=2*NSLOT*SLOTB, LDS_OST=LDS_WS+NW*64*4, LDS_BYTES=LDS_OST+NW*4096;
constexpr float C2=0.125f*1.4426950408889634f;
__device__ __forceinline__ void glds16(const void*gsrc,unsigned lds_dst){unsigned keep;
  asm volatile("s_mov_b32 %0, m0\n\ts_mov_b32 m0, %2\n\ts_nop 0\n\tglobal_load_lds_dwordx4 %1, off\n\ts_mov_b32 m0, %0":"=&s"(keep):"v"(gsrc),"s"(lds_dst):"memory");}
__device__ __forceinline__ float max3f(float a,float b,float c){float r;asm("v_max3_f32 %0, %1, %2, %3":"=v"(r):"v"(a),"v"(b),"v"(c));return r;}
__device__ __forceinline__ float max2f(float a,float b){float r;asm("v_max_f32_e32 %0, %1, %2":"=v"(r):"v"(a),"v"(b));return r;}
__device__ __forceinline__ float fadd_s(float a,float b){float r;asm("v_add_f32_e32 %0, %1, %2":"=v"(r):"v"(a),"v"(b));return r;}
__device__ __forceinline__ float fsub_s(float a,float b){float r;asm("v_sub_f32_e32 %0, %1, %2":"=v"(r):"v"(a),"v"(b));return r;}
typedef float f32x2_t __attribute__((ext_vector_type(2))); typedef __bf16 bf16x2_t __attribute__((ext_vector_type(2)));
__device__ __forceinline__ unsigned cvtpk_s(float lo,float hi){f32x2_t v={lo,hi};bf16x2_t b=__builtin_convertvector(v,bf16x2_t);return __builtin_bit_cast(unsigned,b);}
#define WAIT_BAR(N) asm volatile("s_waitcnt vmcnt(" #N ") lgkmcnt(0)\n\ts_barrier":::"memory")

__device__ __forceinline__ void qkt(f32x16&p0,f32x16&p1,const char*Kslot,const bf16x8*qr,const f32x16&negm,int r32,int hi){
  const char*kb=Kslot+hi*1024+r32*16;
  #pragma unroll
  for(int d0=0;d0<4;++d0){
    const bf16x8 b0=*reinterpret_cast<const bf16x8*>(kb+d0*2048);
    const bf16x8 b1=*reinterpret_cast<const bf16x8*>(kb+d0*2048+512);
    if(d0==0){p0=__builtin_amdgcn_mfma_f32_32x32x16_bf16(b0,qr[0],negm,0,0,0);p1=__builtin_amdgcn_mfma_f32_32x32x16_bf16(b1,qr[0],negm,0,0,0);}
    else{p0=__builtin_amdgcn_mfma_f32_32x32x16_bf16(b0,qr[d0],p0,0,0,0);p1=__builtin_amdgcn_mfma_f32_32x32x16_bf16(b1,qr[d0],p1,0,0,0);}}
}
typedef __attribute__((address_space(3))) const char* lds_cptr;
typedef short v4i16_t __attribute__((ext_vector_type(4)));
__device__ __forceinline__ void kload8(bf16x8*kf,lds_cptr kp){
  kf[0]=*(const __attribute__((address_space(3))) bf16x8*)(kp);      kf[1]=*(const __attribute__((address_space(3))) bf16x8*)(kp+512);
  kf[2]=*(const __attribute__((address_space(3))) bf16x8*)(kp+2048); kf[3]=*(const __attribute__((address_space(3))) bf16x8*)(kp+2560);
  kf[4]=*(const __attribute__((address_space(3))) bf16x8*)(kp+4096); kf[5]=*(const __attribute__((address_space(3))) bf16x8*)(kp+4608);
  kf[6]=*(const __attribute__((address_space(3))) bf16x8*)(kp+6144); kf[7]=*(const __attribute__((address_space(3))) bf16x8*)(kp+6656);
}
__device__ __forceinline__ void kload2(bf16x8*kf,lds_cptr kp,int j){ kf[2*j]=*(const __attribute__((address_space(3))) bf16x8*)(kp+j*2048); kf[2*j+1]=*(const __attribute__((address_space(3))) bf16x8*)(kp+j*2048+512); }
__device__ __forceinline__ s16x4 vtr(lds_cptr p){ return __builtin_bit_cast(s16x4,__builtin_amdgcn_ds_read_tr16_b64_v4i16((__attribute__((address_space(3))) v4i16_t*)p)); }
__device__ __forceinline__ float rowmax(const f32x16&p0,const f32x16&p1){
  float a=max3f(p0[0],p0[1],p1[0]),b=max3f(p0[2],p0[3],p1[1]);a=max3f(a,p1[2],p1[3]);
  #pragma unroll
  for(int r=4;r<16;r+=4){a=max3f(a,p0[r],p0[r+1]);b=max3f(b,p0[r+2],p0[r+3]);a=max3f(a,p1[r],p1[r+1]);b=max3f(b,p1[r+2],p1[r+3]);}
  const float m=max2f(a,b);
  auto rr=__builtin_amdgcn_permlane32_swap(__float_as_uint(m),__float_as_uint(m),false,false);
  return max2f(__uint_as_float(rr[0]),__uint_as_float(rr[1]));
}
__device__ __forceinline__ void pv(f32x16*o,int vb,bf16x8 pa0,bf16x8 pa1,bf16x8 pa2,bf16x8 pa3){
  #pragma unroll
  for(int d0=0;d0<2;++d0){s16x4 lo[4],hi[4];
    #pragma unroll
    for(int ks=0;ks<4;++ks){
      asm volatile("ds_read_b64_tr_b16 %0,%1 offset:%c2":"=&v"(lo[ks]):"v"(vb),"i"(d0*4096+ks*1024):"memory");
      asm volatile("ds_read_b64_tr_b16 %0,%1 offset:%c2":"=&v"(hi[ks]):"v"(vb),"i"(d0*4096+ks*1024+512):"memory");}
    asm volatile("s_waitcnt lgkmcnt(0)":::"memory");SBAR();
    #define PK(k) (bf16x8){lo[k][0],lo[k][1],lo[k][2],lo[k][3],hi[k][0],hi[k][1],hi[k][2],hi[k][3]}
    o[d0]=__builtin_amdgcn_mfma_f32_32x32x16_bf16(pa0,PK(0),o[d0],0,0,0);
    o[d0]=__builtin_amdgcn_mfma_f32_32x32x16_bf16(pa1,PK(1),o[d0],0,0,0);
    o[d0]=__builtin_amdgcn_mfma_f32_32x32x16_bf16(pa2,PK(2),o[d0],0,0,0);
    o[d0]=__builtin_amdgcn_mfma_f32_32x32x16_bf16(pa3,PK(3),o[d0],0,0,0);
    #undef PK
  }
}
#define ATTN_STORE16(p,v) (*(u32x4*)(p)=(v))
template<int THRL> __device__ __forceinline__ void attn_unit(int b,int h,int qb,const bf16*Q,const bf16*__restrict__ K,const bf16*__restrict__ V,bf16*O,char*shm,const float*qgain,const float sbound){
  int tid_=threadIdx.x; asm volatile("":"+v"(tid_));
  const int tid=tid_,lane=tid&63,r32=lane&31,hi=lane>>5; const int wid=__builtin_amdgcn_readfirstlane(tid>>6);
  const long rowbase=(long)b*SEQ; const int q0=qb*QB; const int kvh=h/(NHEAD/NKVH);
  const bf16*Qw=Q+(rowbase+q0+wid*QBLK)*QP+h*D;
  const bf16*Kh=K+rowbase*KP+kvh*D,*Vh=V+rowbase*VP+kvh*D;
  const unsigned lds0=(unsigned)(uintptr_t)shm;
  float*wsf=(float*)(shm+LDS_WS)+wid*64;
  const bf16*ksrc=Kh+(long)lane*KP+wid*8;
  const bf16*vsrc=Vh+(long)(16*(wid&3)+(lane>>2))*VP+(wid>>2)*32+(lane&3)*8;
  const unsigned kdst=lds0+LDS_K+wid*1024, vdst=lds0+LDS_V+wid*1024;
  #define DMA_K(t,slot) glds16(ksrc+(long)(t)*KVBLK*KP,(unsigned)__builtin_amdgcn_readfirstlane(kdst+(slot)))
  #define DMA_V(t,slot) glds16(vsrc+(long)(t)*KVBLK*VP,(unsigned)__builtin_amdgcn_readfirstlane(vdst+(slot)))
  const int vb0=(int)(lds0+LDS_V)+((lane>>4)&1)*32+(lane&3)*8+(4*hi+((lane&15)>>2))*64;
  const char*Kbase=shm+LDS_K; bf16x8 kf[8];
  const lds_cptr shm3=(lds_cptr)shm; const lds_cptr kp0=shm3+LDS_K+hi*1024+r32*16; const lds_cptr vp0=shm3+LDS_V+((lane>>4)&1)*32+(lane&3)*8+(4*hi+((lane&15)>>2))*64;
  constexpr int NT=SEQ/KVBLK;
  DMA_K(0,0);DMA_V(0,0);DMA_K(1,SLOTB);
  bf16x8 qr[4];
  #pragma unroll
  for(int d0=0;d0<4;++d0)qr[d0]=*reinterpret_cast<const bf16x8*>(&Qw[(long)r32*QP+d0*16+hi*8]);
  { float xq[4][8]; float ss=0.f; int hio=hi; asm volatile("":"+v"(hio));
    #pragma unroll
    for(int d0=0;d0<4;++d0)
      #pragma unroll
      for(int j=0;j<8;++j){ xq[d0][j]=__builtin_bit_cast(float,((unsigned)(unsigned short)qr[d0][j])<<16); ss+=xq[d0][j]*xq[d0][j]; }
    ss+=__shfl_xor(ss,32);
    const float rinv=__builtin_amdgcn_rsqf(ss*(1.f/64.f)+1e-6f);
    const int tq=q0+wid*QBLK+r32; const float prow=(float)(tq>>6), pcol=(float)(tq&63);
    #pragma unroll
    for(int d0=0;d0<4;++d0)
      #pragma unroll
      for(int j=0;j<8;++j) xq[d0][j]*=rinv*qgain[16*d0+8*hio+j];
    #pragma unroll
    for(int j=0;j<8;++j){ const float inv=exp2f(-(float)(8*hio+j)*(13.287712379549449f/16.f));
      const float ar=prow*inv, ac=pcol*inv; const float cr=__cosf(ar), sr=__sinf(ar), cc=__cosf(ac), sc=__sinf(ac);
      const float a0=xq[0][j], a1=xq[1][j], b0=xq[2][j], b1=xq[3][j];
      xq[0][j]=(a0*cr-a1*sr)*C2; xq[1][j]=(a1*cr+a0*sr)*C2; xq[2][j]=(b0*cc-b1*sc)*C2; xq[3][j]=(b1*cc+b0*sc)*C2; }
    #pragma unroll
    for(int d0=0;d0<4;++d0){ u32x4 w; w.x=cvtpk_s(xq[d0][0],xq[d0][1]); w.y=cvtpk_s(xq[d0][2],xq[d0][3]); w.z=cvtpk_s(xq[d0][4],xq[d0][5]); w.w=cvtpk_s(xq[d0][6],xq[d0][7]); qr[d0]=__builtin_bit_cast(bf16x8,w); } }
  float l_reg=0.f;f32x16 o[2];o[0]=f32x16{};o[1]=f32x16{};f32x16 negm;
  #pragma unroll
  for(int r=0;r<16;++r)negm[r]=-sbound;
  asm volatile("":"+v"(negm));
  #define START(P0,P1) do{ _Pragma("unroll") for(int r=0;r<16;++r)P0[r]=__builtin_amdgcn_exp2f(P0[r]); }while(0)
  #define RESC() do{}while(0)
  f32x16 pA0,pA1,pB0,pB1;
  int sl_prev=0,sl_cur=0,sl_next=SLOTB;
  #define ROT() do{sl_prev=sl_cur;sl_cur=sl_next;sl_next=(sl_next==(NSLOT-1)*SLOTB)?0:sl_next+SLOTB;}while(0)
  DMA_K(2,2*SLOTB);
  WAIT_BAR(3);
  qkt(pA0,pA1,Kbase,qr,negm,r32,hi);asm volatile("s_nop 15\n\ts_nop 7":"+v"(pA0),"+v"(pA1));
  START(pA0,pA1);
  _Pragma("unroll") for(int r=0;r<16;++r)pA1[r]=__builtin_amdgcn_exp2f(pA1[r]);
  WAIT_BAR(0);
  DMA_K(3,0);DMA_V(1,SLOTB);
  ROT();
  kload8(kf,kp0+sl_cur);
  WAIT_BAR(2);
  s16x4 vlo[8],vhi[8]; u32x4 pw0,pw1,pw2,pw3;
  #define PKW(P,B) cvtpk_s(P[B],P[B+1])
  #define PAF(k) __builtin_bit_cast(bf16x8,pw##k)
  #define VFR(i) (bf16x8){vlo[i][0],vlo[i][1],vlo[i][2],vlo[i][3],vhi[i][0],vhi[i][1],vhi[i][2],vhi[i][3]}
  #define PIN(x) asm volatile("":"+v"(x))
  #define MX3(a,b,c) __builtin_fmaxf(__builtin_fmaxf((a),(b)),(c))
  #define GAPA(MF,A0,A1,A2,A3,W0,W1,PW) do{ MF; sacc+=A0; sacc+=A1; sacc+=A2; sacc+=A3; PIN(sacc); W0; W1; PIN(PW); SBAR(); }while(0)
  #define EX(v) __builtin_amdgcn_exp2f(v)
  #define GAPB(MF,X,B) do{ MF; X[B]=EX(X[B]); X[B+1]=EX(X[B+1]); X[B+2]=EX(X[B+2]); X[B+3]=EX(X[B+3]); PIN(X); SBAR(); }while(0)
  #define VRD(i) do{ vlo[i]=vtr(vp_+(((i)>>2)*4096+((i)&3)*1024)); vhi[i]=vtr(vp_+(((i)>>2)*4096+((i)&3)*1024+512)); }while(0)
  #define KRD(G,j) do{ if(G){ kload2(kf,kp0+sl_next,j); SBAR(); } }while(0)
  #define STEP(C0,C1,P0,P1,t,GK,GV,GL) do{ SBAR(); \
    const lds_cptr vp_=vp0+sl_prev; \
    VRD(0); SBAR(); float sacc=(P0[0]+P0[1]); \
    GAPA(C0=__builtin_amdgcn_mfma_f32_32x32x16_bf16(kf[0],qr[0],negm,0,0,0), P0[2],P0[3],P0[4],P0[5],     pw0[0]=PKW(P0,0), pw0[1]=PKW(P0,2), pw0); \
    VRD(4); SBAR(); GAPA(C1=__builtin_amdgcn_mfma_f32_32x32x16_bf16(kf[1],qr[0],negm,0,0,0), P0[6],P0[7],P0[8],P0[9],     pw0[2]=PKW(P0,4), pw0[3]=PKW(P0,6), pw0); \
    VRD(1); SBAR(); GAPA(C0=__builtin_amdgcn_mfma_f32_32x32x16_bf16(kf[2],qr[1],C0,0,0,0),   P0[10],P0[11],P0[12],P0[13], pw1[0]=PKW(P0,8), pw1[1]=PKW(P0,10), pw1); \
    VRD(5); SBAR(); GAPA(C1=__builtin_amdgcn_mfma_f32_32x32x16_bf16(kf[3],qr[1],C1,0,0,0),   P0[14],P0[15],P1[0],P1[1],   pw1[2]=PKW(P0,12),pw1[3]=PKW(P0,14), pw1); \
    VRD(2); SBAR(); GAPA(C0=__builtin_amdgcn_mfma_f32_32x32x16_bf16(kf[4],qr[2],C0,0,0,0),   P1[2],P1[3],P1[4],P1[5],     pw2[0]=PKW(P1,0), pw2[1]=PKW(P1,2), pw2); \
    VRD(6); SBAR(); GAPA(C1=__builtin_amdgcn_mfma_f32_32x32x16_bf16(kf[5],qr[2],C1,0,0,0),   P1[6],P1[7],P1[8],P1[9],     pw2[2]=PKW(P1,4), pw2[3]=PKW(P1,6), pw2); \
    VRD(3); SBAR(); GAPA(C0=__builtin_amdgcn_mfma_f32_32x32x16_bf16(kf[6],qr[3],C0,0,0,0),   P1[10],P1[11],P1[12],P1[13], pw3[0]=PKW(P1,8), pw3[1]=PKW(P1,10), pw3); \
    VRD(7); SBAR(); GAPA(C1=__builtin_amdgcn_mfma_f32_32x32x16_bf16(kf[7],qr[3],C1,0,0,0),   P1[14],P1[15],0.f,0.f,       pw3[2]=PKW(P1,12),pw3[3]=PKW(P1,14), pw3); \
    l_reg+=sacc; \
    if(GK){DMA_K((t)+3,sl_cur);} if(GV){DMA_V((t)+1,sl_next);} \
    SBAR(); \
    GAPB(o[0]=__builtin_amdgcn_mfma_f32_32x32x16_bf16(PAF(0),VFR(0),o[0],0,0,0), C0,0); \
    GAPB(o[1]=__builtin_amdgcn_mfma_f32_32x32x16_bf16(PAF(0),VFR(4),o[1],0,0,0), C0,4); \
    KRD(GL,0); GAPB(o[0]=__builtin_amdgcn_mfma_f32_32x32x16_bf16(PAF(1),VFR(1),o[0],0,0,0), C0,8); \
    KRD(GL,1); GAPB(o[1]=__builtin_amdgcn_mfma_f32_32x32x16_bf16(PAF(1),VFR(5),o[1],0,0,0), C0,12); \
    KRD(GL,2); GAPB(o[0]=__builtin_amdgcn_mfma_f32_32x32x16_bf16(PAF(2),VFR(2),o[0],0,0,0), C1,0); \
    KRD(GL,3); GAPB(o[1]=__builtin_amdgcn_mfma_f32_32x32x16_bf16(PAF(2),VFR(6),o[1],0,0,0), C1,4); \
    GAPB(o[0]=__builtin_amdgcn_mfma_f32_32x32x16_bf16(PAF(3),VFR(3),o[0],0,0,0), C1,8); \
    GAPB(o[1]=__builtin_amdgcn_mfma_f32_32x32x16_bf16(PAF(3),VFR(7),o[1],0,0,0), C1,12); \
    }while(0)
  int t=1;
  for(;t+5<NT;t+=2){
    STEP(pB0,pB1,pA0,pA1,t,true,true,true);     WAIT_BAR(2); RESC(); ROT();
    STEP(pA0,pA1,pB0,pB1,t+1,true,true,true);   WAIT_BAR(2); RESC(); ROT();
  }
  #define ENDW(tt) do{ if((tt)+3<NT){WAIT_BAR(2);} else if((tt)+2<NT){WAIT_BAR(1);} else {WAIT_BAR(0);} }while(0)
  for(;t+1<NT;t+=2){
    STEP(pB0,pB1,pA0,pA1,t,(t+3<NT),(t+1<NT),(t+1<NT));       ENDW(t);   RESC(); ROT();
    STEP(pA0,pA1,pB0,pB1,t+1,(t+4<NT),(t+2<NT),(t+2<NT));     ENDW(t+1); RESC(); ROT();
  }
  STEP(pB0,pB1,pA0,pA1,NT-1,false,false,false); RESC();
  { float sacc=pB0[0]+pB0[1]; _Pragma("unroll") for(int r=2;r<16;++r)sacc+=pB0[r]; _Pragma("unroll") for(int r=0;r<16;++r)sacc+=pB1[r]; l_reg+=sacc;
    pw0=(u32x4){PKW(pB0,0),PKW(pB0,2),PKW(pB0,4),PKW(pB0,6)};pw1=(u32x4){PKW(pB0,8),PKW(pB0,10),PKW(pB0,12),PKW(pB0,14)};pw2=(u32x4){PKW(pB1,0),PKW(pB1,2),PKW(pB1,4),PKW(pB1,6)};pw3=(u32x4){PKW(pB1,8),PKW(pB1,10),PKW(pB1,12),PKW(pB1,14)};
    SBAR(); pv(o,vb0+sl_cur,PAF(0),PAF(1),PAF(2),PAF(3)); }
  #undef PKW
  #undef PAF
  #undef VFR
  #undef PIN
  #undef MX3
  #undef GAPA
  #undef GAPB
  #undef EX
  #undef VRD
  #undef KRD
  #undef STEP
  #undef ENDW
  {auto rr=__builtin_amdgcn_permlane32_swap(__float_as_uint(l_reg),__float_as_uint(l_reg),false,false);l_reg=__uint_as_float(rr[0])+__uint_as_float(rr[1]);}
  if(hi==0)wsf[32+r32]=l_reg;asm volatile("s_waitcnt lgkmcnt(0)":::"memory");
  float rli[16];
  #pragma unroll
  for(int r=0;r<16;++r)rli[r]=__builtin_amdgcn_rcpf(wsf[32+crow(r,hi)]);
  bf16*Ow=O+(rowbase+q0+wid*QBLK)*OP+OCOL+h*D;
  { bf16*stg=(bf16*)(shm+LDS_OST)+wid*2048;
    #pragma unroll
    for(int r=0;r<16;++r){const int orow=crow(r,hi);
      #pragma unroll
      for(int d0=0;d0<2;++d0)stg[orow*64+d0*32+r32]=__float2bfloat16(o[d0][r]*rli[r]);}
    asm volatile("s_waitcnt lgkmcnt(0)":::"memory");
    #pragma unroll
    for(int i=0;i<4;++i){const int row=i*8+(lane>>3),ch=lane&7; const u32x4 v=*(const u32x4*)(stg+row*64+ch*8); ATTN_STORE16(Ow+(long)row*OP+ch*8,v);} }
  asm volatile("s_waitcnt lgkmcnt(0)\n\ts_barrier":::"memory");
  #undef DMA_K
  #undef DMA_V
  #undef START
  #undef RESC
  #undef ROT
}
constexpr int ATTN_LDS_BYTES=LDS_BYTES;
#undef SBAR
#undef WAIT_BAR
}
constexpr int NWAVES = 8;
constexpr int BATCH = 8, SEQ = 4096, DM = 1024, T = BATCH * SEQ;
constexpr int GLA_H = 4, GLA_DK = 64, GLA_DV = 128, GLA_RANK = 16;
constexpr int ATT_H = 8, ATT_KVH = 2, ATT_DH = 64;
constexpr int D_IN = 2336, D_IN_PAD = 2560;
constexpr int NEXP = 32, TOPK = 4, DFF = 1024;
constexpr int EROWS = 32768;
constexpr int PROWS = T * TOPK + NEXP * 256;
constexpr float EPS = 1e-6f;
constexpr float YSCALE = 16.f;
constexpr float WSCALE = 32.f, ASCALE = 4.f;

constexpr size_t MiB = 1u << 20;
constexpr size_t WS_CTL = 0, CTL_ZERO_BYTES = 1 * MiB;
constexpr size_t WS_WRH = 1 * MiB, WS_WRL = WS_WRH + 65536;
constexpr size_t WS_WIN = 2 * MiB;
constexpr size_t WS_WOUT = 8 * MiB;
constexpr size_t WS_W1 = 10 * MiB;
constexpr size_t WS_W2 = 138 * MiB;
constexpr size_t WS_ROWTOK = 202 * MiB;
constexpr size_t WS_ROWGATE = 206 * MiB;
constexpr size_t WS_TOKASG = 210 * MiB;
constexpr size_t WS_REGY = 212 * MiB;
constexpr size_t WS_XN = WS_REGY;
constexpr size_t WS_GQ = WS_XN + 64 * MiB;
constexpr size_t WS_GK = WS_GQ + 16 * MiB;
constexpr size_t WS_GV = WS_GK + 16 * MiB;
constexpr size_t WS_GR = WS_GV + 32 * MiB;
constexpr size_t WS_AQ = WS_GR + 32 * MiB;
constexpr size_t WS_AK = WS_AQ + 32 * MiB;
constexpr size_t WS_AV = WS_AK + 8 * MiB;
constexpr size_t WS_Z = WS_AV + 8 * MiB;
constexpr size_t WS_OF = WS_Z + 2 * MiB;
constexpr size_t WS_Y = WS_REGY;
constexpr size_t WS_REGA = WS_REGY + 274 * MiB;
constexpr size_t WS_MIX = WS_REGA;
constexpr size_t WS_ACT = WS_REGA;
constexpr size_t WS_QF = WS_REGA + 272 * MiB, WS_KF = WS_QF + 16 * MiB, WS_QB = WS_KF + 16 * MiB, WS_KB = WS_QB + 16 * MiB;
constexpr size_t WS_DEC = WS_KB + 16 * MiB;
constexpr size_t WS_END = WS_DEC + 1 * MiB;
static_assert(WS_OF + (size_t)T * 512 * 4 <= WS_REGA && (size_t)PROWS * 1024 * 2 <= 272 * MiB, "d_ws map");
constexpr int CW_BAR = 4096;
constexpr int CW_CNT = 8192;
constexpr int CW_CONV = 20480;
constexpr int CW_GDN = 16384;
constexpr int CW_QUE = 12288;

constexpr int SCR_BYTES = 133120;
constexpr int LC_OFF = SCR_BYTES;
constexpr int LC_MISC = LC_OFF;
constexpr int LC_CNT = LC_OFF + 128;
constexpr int LC_CST = LC_CNT + 128;
constexpr int LC_TE = LC_CST + 256;
constexpr int LC_HIST = LC_TE + 1152;
constexpr int LC_BASE = LC_HIST + 128;
constexpr int LC_ASG = LC_BASE + 128;
constexpr int LC_END = LC_ASG + 8192;
constexpr int LDS_BYTES = 147456;
static_assert(LC_END <= LDS_BYTES, "LDS map");

typedef unsigned short bf16;
typedef unsigned v4u __attribute__((ext_vector_type(4)));
typedef unsigned v2u __attribute__((ext_vector_type(2)));
typedef float f32x4 __attribute__((ext_vector_type(4)));
typedef short bf16x8 __attribute__((ext_vector_type(8)));
typedef GAS unsigned gu32;
#define RLX_AGENT __ATOMIC_RELAXED, __HIP_MEMORY_SCOPE_AGENT
#define LDS_WAIT() asm volatile("s_waitcnt lgkmcnt(0)" ::: "memory")
#define VM_WAIT() asm volatile("s_waitcnt vmcnt(0)" ::: "memory")
__device__ __forceinline__ unsigned f2bf(float f) { unsigned u = __builtin_bit_cast(unsigned, f); return (u + 0x7fffu + ((u >> 16) & 1u)) >> 16; }
__device__ __forceinline__ unsigned pk2(float lo, float hi) { return f2bf(lo) | (f2bf(hi) << 16); }
__device__ __forceinline__ float bf2f(unsigned h) { return __builtin_bit_cast(float, h << 16); }
__device__ __forceinline__ float bflo(unsigned w) { return __builtin_bit_cast(float, w << 16); }
__device__ __forceinline__ float bfhi(unsigned w) { return __builtin_bit_cast(float, w & 0xffff0000u); }

#define XB_TMO      128
#define XB_XCNT(j)  (256  + 64 * (j))
#define XB_XSUB(j)  (1280 + 64 * (j))
#define XB_XGEN(j)  (2304 + 64 * (j))
#define XB_TOP      3328
#define XB_TOPGEN   3392
#define XCD_BAR_WORDS 3456
#define XB_SPIN_CAP (1u << 18)
__device__ __forceinline__ unsigned xb_ld(unsigned* p)              { return __hip_atomic_load(p, __ATOMIC_RELAXED, __HIP_MEMORY_SCOPE_AGENT); }
__device__ __forceinline__ unsigned xb_add(unsigned* p, unsigned v) { return __hip_atomic_fetch_add(p, v, __ATOMIC_RELAXED, __HIP_MEMORY_SCOPE_AGENT); }
__device__ __forceinline__ unsigned xb_xcc_id() { return (unsigned)__builtin_amdgcn_s_getreg((3 << 11) | 20) & 0xFu; }
#define XB_SPIN(cond, bar) do { unsigned _sp = 0; while (cond) { __builtin_amdgcn_s_sleep(1); \
    if ((++_sp & 255u) == 0u) { if (xb_ld(&(bar)[XB_TMO])) break; if (_sp > XB_SPIN_CAP) { atomicAdd(&(bar)[XB_TMO], 1u); break; } } } } while (0)
struct XcdBarrier { unsigned* bar; unsigned x; volatile LAS unsigned* st; };
__device__ __forceinline__ XcdBarrier xcd_barrier_post(unsigned* bar, volatile LAS unsigned* st) {
    XcdBarrier b; b.bar = bar; b.x = xb_xcc_id(); b.st = st;
    if (threadIdx.x == 0) (void)xb_add(&bar[XB_XCNT(b.x)], 1u);
    return b;
}
__device__ __forceinline__ void xcd_barrier_complete(unsigned* bar, unsigned x, unsigned& nloc, unsigned& nx) {
    const unsigned G = gridDim.x * gridDim.y * gridDim.z;
    unsigned sum, cnt, mine, sp = 0u;
    for (;;) {
        sum = 0u; cnt = 0u; mine = 0u;
#pragma unroll
        for (unsigned j = 0; j < 16; ++j) { const unsigned c = xb_ld(&bar[XB_XCNT(j)]); sum += c; cnt += (c > 0u) ? 1u : 0u; mine = (j == x) ? c : mine; }
        if (sum == G) break;
        __builtin_amdgcn_s_sleep(1);
        if ((++sp & 255u) == 0u) { if (xb_ld(&bar[XB_TMO])) break; if (sp > XB_SPIN_CAP) { atomicAdd(&bar[XB_TMO], 1u); break; } }
    }
    nloc = mine > 0u ? mine : 1u; nx = cnt > 0u ? cnt : 1u;
}
__device__ __forceinline__ void xcd_barrier(const XcdBarrier& b) {
    asm volatile("s_waitcnt vmcnt(0)" ::: "memory");
    __syncthreads();
    if (threadIdx.x == 0) {
        unsigned* bar = b.bar;
        __builtin_amdgcn_s_waitcnt(0);
        unsigned nloc = b.st[0], nx = b.st[1];
        if (nloc == 0u) { xcd_barrier_complete(bar, b.x, nloc, nx); b.st[0] = nloc; b.st[1] = nx; }
        const unsigned old = xb_add(&bar[XB_XSUB(b.x)], 1u);
        const unsigned gen = old / nloc;
        if (old + 1u == (gen + 1u) * nloc) {
            __builtin_amdgcn_fence(__ATOMIC_RELEASE, "agent");
            asm volatile("s_waitcnt vmcnt(0)" ::: "memory");
            const unsigned og = xb_add(&bar[XB_TOP], 1u);
            const unsigned tg = og / nx;
            if (og + 1u == (tg + 1u) * nx) xb_add(&bar[XB_TOPGEN], 1u);
            else XB_SPIN(xb_ld(&bar[XB_TOPGEN]) == tg, bar);
            __builtin_amdgcn_fence(__ATOMIC_ACQUIRE, "agent");
            xb_add(&bar[XB_XGEN(b.x)], 1u);
            asm volatile("s_waitcnt vmcnt(0)" ::: "memory");
        } else {
            XB_SPIN(xb_ld(&bar[XB_XGEN(b.x)]) == gen, bar);
            __builtin_amdgcn_fence(__ATOMIC_ACQUIRE, "agent");
            asm volatile("s_waitcnt vmcnt(0)" ::: "memory");
        }
    }
    __syncthreads();
}

struct Frame {
    LAS unsigned char* lds;
    volatile LAS unsigned* MISC;
    gu32* ctl;
    int tid, lane, wave;
    int vcu, G;
    unsigned char* ws;
    const float *x, *mix_g, *w_in, *w_gf, *b_gf, *w_gb, *b_gb, *gla_hg, *q_g, *k_g, *w_out, *ffn_g, *w_router, *b_router, *w1, *b1, *w2, *b2, *fin_g;
    float* out;
};
__device__ __forceinline__ float wave_sum(float v) {
#pragma unroll
    for (int o = 1; o < 64; o <<= 1) v += __shfl_xor(v, o);
    return v;
}
__device__ __forceinline__ void p0_tr64(const float* src  , int ldw, bf16* d0, bf16* d1, int ldt, LAS float* scr, int lane, int ncols) {
    const int c4 = (lane & 15) * 4, kr = lane >> 4;
    if (c4 < ncols) {
#pragma unroll 4
        for (int i = 0; i < 16; ++i) { const int kk = kr + 4 * i; const f32x4 v = *(const GAS f32x4*)(src + (size_t)kk * ldw + c4);
            LAS float* s = scr + kk * 65 + c4; s[0] = v.x; s[1] = v.y; s[2] = v.z; s[3] = v.w; }
    }
    LDS_WAIT(); asm volatile("" ::: "memory");
    const int c = lane & 7;
#pragma unroll
    for (int j = 0; j < 8; ++j) { const int n = (lane >> 3) + 8 * j;
        if (n < ncols) { const LAS float* s = scr + (8 * c) * 65 + n;
            v4u o; o.x = pk2(s[0 * 65], s[1 * 65]); o.y = pk2(s[2 * 65], s[3 * 65]); o.z = pk2(s[4 * 65], s[5 * 65]); o.w = pk2(s[6 * 65], s[7 * 65]);
            bf16* rowp = (n < 32 ? d0 : d1) + (size_t)(n & 31) * ldt;
            *(GAS v4u*)(rowp + 8 * c) = o; } }
    LDS_WAIT(); asm volatile("" ::: "memory");
}
struct F8Item { const float* src; int ldw; unsigned char* d0; unsigned char* d1; };
__device__ __forceinline__ void f8_load(const F8Item& it, f32x4 (&v)[16], int lane) {
    const int c4 = (lane & 15) * 4, kr = lane >> 4;
#pragma unroll
    for (int i = 0; i < 16; ++i) v[i] = __builtin_nontemporal_load((const GAS f32x4*)(it.src + (size_t)(kr + 4 * i) * it.ldw + c4));
}
__device__ __forceinline__ void f8_finish(const F8Item& it, const f32x4 (&v)[16], LAS float* scr, int lane, float sc) {
    const int c4 = (lane & 15) * 4, kr = lane >> 4;
#pragma unroll
    for (int i = 0; i < 16; ++i) { LAS float* s = scr + (kr + 4 * i) * 65 + c4; s[0] = v[i].x; s[1] = v[i].y; s[2] = v[i].z; s[3] = v[i].w; }
    LDS_WAIT(); asm volatile("" ::: "memory");
    const int c = lane & 7;
#pragma unroll
    for (int j = 0; j < 8; ++j) { const int n = (lane >> 3) + 8 * j; const LAS float* s = scr + (8 * c) * 65 + n;
        int w0 = 0, w1 = 0;
        w0 = __builtin_amdgcn_cvt_pk_fp8_f32(s[0 * 65] * sc, s[1 * 65] * sc, w0, false); w0 = __builtin_amdgcn_cvt_pk_fp8_f32(s[2 * 65] * sc, s[3 * 65] * sc, w0, true);
        w1 = __builtin_amdgcn_cvt_pk_fp8_f32(s[4 * 65] * sc, s[5 * 65] * sc, w1, false); w1 = __builtin_amdgcn_cvt_pk_fp8_f32(s[6 * 65] * sc, s[7 * 65] * sc, w1, true);
        unsigned char* rowp = (n < 32 ? it.d0 : it.d1) + (size_t)(n & 31) * 1024;
        __builtin_nontemporal_store((v2u){(unsigned)w0, (unsigned)w1}, (GAS v2u*)(rowp + 8 * c)); }
    LDS_WAIT(); asm volatile("" ::: "memory");
}
__device__ __forceinline__ int win_pblk(int lb) { return lb < 48 ? lb : (lb == 48 ? 72 : lb - 1); }
__device__ __forceinline__ int w1_pblk(int lb) { return lb < 32 ? (lb >> 2) * 8 + (lb & 3) : ((lb - 32) >> 2) * 8 + 4 + ((lb - 32) & 3); }
__device__ __forceinline__ void rms_row_to_bf16(const float* xrow, const float* g, bf16* orow, int lane) {
    const GAS f32x4* xr = (const GAS f32x4*)xrow + lane; const GAS f32x4* gr = (const GAS f32x4*)g + lane;
    f32x4 v[4]; float s = 0.f;
#pragma unroll
    for (int j = 0; j < 4; ++j) { v[j] = __builtin_nontemporal_load(xr + 64 * j); s += (v[j].x * v[j].x + v[j].y * v[j].y) + (v[j].z * v[j].z + v[j].w * v[j].w); }
    const float rinv = 1.f / sqrtf(wave_sum(s) * (1.f / 1024.f) + EPS);
    GAS unsigned long long* o8 = (GAS unsigned long long*)orow + lane;
#pragma unroll
    for (int j = 0; j < 4; ++j) { const f32x4 gg = gr[64 * j];
        o8[64 * j] = (unsigned long long)pk2(v[j].x * rinv * gg.x, v[j].y * rinv * gg.y) | ((unsigned long long)pk2(v[j].z * rinv * gg.z, v[j].w * rinv * gg.w) << 32); }
}
__device__ __forceinline__ F8Item f8_item(Frame& F, int r) {
    F8Item it;
    if (r < NEXP * 512) { const int e = r / 512, q = r % 512, kb = q / 32, nb = q % 32; it.src = F.w1 + (size_t)e * 1024 * 2048 + (size_t)(64 * kb) * 2048 + 64 * nb; it.ldw = 2048;
        unsigned char* dst = F.ws + WS_W1 + (size_t)e * 2048 * 1024 + 64 * kb; it.d0 = dst + (size_t)(32 * w1_pblk(2 * nb)) * 1024; it.d1 = dst + (size_t)(32 * w1_pblk(2 * nb + 1)) * 1024; }
    else { const int r2 = r - NEXP * 512, e = r2 / 256, q = r2 % 256, kb = q / 16, nb = q % 16; it.src = F.w2 + (size_t)e * 1024 * 1024 + (size_t)(64 * kb) * 1024 + 64 * nb; it.ldw = 1024;
        unsigned char* dst = F.ws + WS_W2 + (size_t)e * 1024 * 1024 + 64 * kb; it.d0 = dst + (size_t)(64 * nb) * 1024; it.d1 = dst + (size_t)(64 * nb + 32) * 1024; }
    return it;
}
constexpr int N_F8_ITEMS = NEXP * 512 + NEXP * 256, N_CONV_BATCH = N_F8_ITEMS / 64;
__device__ __forceinline__ void f8_items(Frame& F, int r, int step, int rend, LAS float* scr) {
    if (r >= rend) return;
    F8Item cur = f8_item(F, r); f32x4 va[16], vb[16];
    f8_load(cur, va, F.lane);
    for (;;) {
        int rn = r + step; F8Item nx = cur; if (rn < rend) { nx = f8_item(F, rn); f8_load(nx, vb, F.lane); }
        f8_finish(cur, va, scr, F.lane, WSCALE);
        if (rn >= rend) break;
        r = rn + step; cur = nx; if (r < rend) { cur = f8_item(F, r); f8_load(cur, va, F.lane); }
        f8_finish(nx, vb, scr, F.lane, WSCALE);
        if (r >= rend) break;
    }
}
__device__ __forceinline__ bool conv_pull(Frame& F) {
    __syncthreads();
    if (F.tid == 0) F.MISC[17] = __hip_atomic_fetch_add(F.ctl + CW_CONV, 1u, RLX_AGENT);
    __syncthreads();
    const int cb = __builtin_amdgcn_readfirstlane((int)F.MISC[17]);
    if (cb >= N_CONV_BATCH) return false;
    f8_items(F, cb * 64 + F.wave * 8, 1, cb * 64 + F.wave * 8 + 8, (LAS float*)(F.lds + F.wave * 16640));
    return true;
}
__device__ __forceinline__ void p0_prologue(Frame& F) {
    LAS float* scr = (LAS float*)(F.lds + F.wave * 16640);
    const int gw = F.vcu * NWAVES + F.wave, NGW = F.G * NWAVES;
    bf16* WIN = (bf16*)(F.ws + WS_WIN); bf16* WOUT = (bf16*)(F.ws + WS_WOUT);
    constexpr int I_IN = 16 * 37, I_OUT = 16 * 16, NITEMS = I_IN + I_OUT;
    for (int it = gw; it < NITEMS; it += NGW) {
        int r = it;
        if (r < I_IN) { const int kb = r / 37, nb = r % 37; const int lb0 = 2 * nb, nc = (nb == 36) ? 32 : 64;
            p0_tr64(F.w_in + (size_t)(64 * kb) * D_IN + 64 * nb, D_IN, WIN + (size_t)(32 * win_pblk(lb0)) * 1024 + 64 * kb, WIN + (size_t)(32 * win_pblk(lb0 + 1 < 73 ? lb0 + 1 : lb0)) * 1024 + 64 * kb, 1024, scr, F.lane, nc); continue; }
        r -= I_IN;
        { const int kb = r / 16, nb = r % 16;
            p0_tr64(F.w_out + (size_t)(64 * kb) * 1024 + 64 * nb, 1024, WOUT + (size_t)(64 * nb) * 1024 + 64 * kb, WOUT + (size_t)(64 * nb + 32) * 1024 + 64 * kb, 1024, scr, F.lane, 64); }
    }
    { const int gt = F.vcu * (NWAVES * 64) + F.tid, NGT = F.G * NWAVES * 64; GAS v4u* z = (GAS v4u*)(WIN + (size_t)D_IN * 1024);
      for (int i = gt; i < (D_IN_PAD - D_IN) * 1024 * 2 / 16; i += NGT) z[i] = (v4u){0u, 0u, 0u, 0u};
      bf16* WRH = (bf16*)(F.ws + WS_WRH); bf16* WRL = (bf16*)(F.ws + WS_WRL);
      for (int i = gt; i < NEXP * 1024; i += NGT) { const int e = i >> 10, k = i & 1023; const float w = F.w_router[(size_t)k * NEXP + e]; const unsigned h = f2bf(w); WRH[i] = (bf16)h; WRL[i] = (bf16)f2bf(w - bf2f(h)); } }
    bf16* XN = (bf16*)(F.ws + WS_XN);
    for (int m = gw; m < T; m += NGW) rms_row_to_bf16(F.x + (size_t)m * DM, F.mix_g, XN + (size_t)m * DM, F.lane);
}

__device__ __forceinline__ void p2_normrope(Frame& F) {
    LAS float* cs = (LAS float*)F.lds;
    for (int i = F.tid; i < 1024; i += NWAVES * 64) { const int pos = i >> 4, fi = i & 15; const float inv = exp2f(-(float)fi * (13.287712379549449f / 16.f)); const float a = (float)pos * inv;
        cs[2 * i] = __cosf(a); cs[2 * i + 1] = __sinf(a); }
    __syncthreads();
    const int gw = F.vcu * NWAVES + F.wave, NGW = F.G * NWAVES, lane = F.lane;
    const int j = lane & 7, blk = (j >> 2) & 1, jj = j & 3, fi0 = 8 * (jj & 1); const bool second = (jj >> 1) != 0;
    float gq[8], gk[8];
#pragma unroll
    for (int e = 0; e < 8; ++e) { gq[e] = F.q_g[8 * j + e]; gk[e] = F.k_g[8 * j + e]; }
    bf16* AQ = (bf16*)(F.ws + WS_AQ); bf16* AK = (bf16*)(F.ws + WS_AK);
    for (int it = T + gw; it < T + T / 4; it += NGW) {
        const bool isq = it < T;
        const int tok = isq ? it : 4 * (it - T) + (lane >> 4);
        GAS v4u* p = isq ? (GAS v4u*)(AQ + (size_t)tok * 512) + lane : (GAS v4u*)(AK + (size_t)tok * 128) + (lane & 15);
        const v4u w = *p;
        float x[8] = {bflo(w.x), bfhi(w.x), bflo(w.y), bfhi(w.y), bflo(w.z), bfhi(w.z), bflo(w.w), bfhi(w.w)};
        float ss = 0.f;
#pragma unroll
        for (int e = 0; e < 8; ++e) ss += x[e] * x[e];
        ss += __shfl_xor(ss, 1); ss += __shfl_xor(ss, 2); ss += __shfl_xor(ss, 4);
        const float rinv = 1.f / sqrtf(ss * (1.f / 64.f) + EPS);
        const int ts = tok & (SEQ - 1), pos = blk ? (ts & 63) : (ts >> 6);
        const LAS float* c = cs + (pos * 16 + fi0) * 2;
        float y[8];
#pragma unroll
        for (int e = 0; e < 8; ++e) { x[e] = x[e] * rinv * (isq ? gq[e] : gk[e]); }
#pragma unroll
        for (int e = 0; e < 8; ++e) { const float pr = __shfl_xor(x[e], 2); const float co = c[2 * e], si = c[2 * e + 1]; y[e] = second ? (x[e] * co + pr * si) : (x[e] * co - pr * si); }
        const float sc = isq ? attn_body::C2 : 1.f;
        v4u o; o.x = pk2(y[0] * sc, y[1] * sc); o.y = pk2(y[2] * sc, y[3] * sc); o.z = pk2(y[4] * sc, y[5] * sc); o.w = pk2(y[6] * sc, y[7] * sc);
        *p = o;
    }
}
namespace gla {
typedef short bf16x8 __attribute__((ext_vector_type(8)));
typedef short s16x4 __attribute__((ext_vector_type(4)));
typedef float f32x4 __attribute__((ext_vector_type(4)));
constexpr int P64 = 144, PV = 272, POT = 528;
constexpr int L_QS = 0, L_KS = 9216, L_VR = 18432, L_AS = 35840, L_ST = 45056, L_DEC = 63488, L_OT = 63744, L_END = 97536;
__device__ __forceinline__ unsigned cvtpk(float lo, float hi) { typedef float f2_t __attribute__((ext_vector_type(2))); typedef __bf16 b2_t __attribute__((ext_vector_type(2))); f2_t v = {lo, hi}; b2_t b = __builtin_convertvector(v, b2_t); return __builtin_bit_cast(unsigned, b); }
__device__ __forceinline__ float logsig(float x) { return fminf(x, 0.f) - __logf(1.f + __expf(-fabsf(x))); }
__device__ __forceinline__ s16x4 vtr(const LAS unsigned char* p) { typedef short v4i16_t __attribute__((ext_vector_type(4))); return __builtin_bit_cast(s16x4, __builtin_amdgcn_ds_read_tr16_b64_v4i16((LAS v4i16_t*)p)); }

__device__ __forceinline__ void gla_prep_unit(Frame& F, int b, int c) {
    LAS unsigned char* L = F.lds;
    const int tid = F.tid, dir = __builtin_amdgcn_readfirstlane(tid >> 8), col = tid & 255;
    const bf16* GQ = (const bf16*)(F.ws + WS_GQ); const bf16* GK = (const bf16*)(F.ws + WS_GK); const bf16* ZZ = (const bf16*)(F.ws + WS_Z);
    bf16* QX = (bf16*)(F.ws + (dir ? WS_QB : WS_QF)); bf16* KX = (bf16*)(F.ws + (dir ? WS_KB : WS_KF)); float* DEC = (float*)(F.ws + WS_DEC) + (size_t)dir * (BATCH * 64 * 256);
    const unsigned row0 = (unsigned)b * SEQ + (unsigned)c * 64u;
    __syncthreads();
    if (tid < 256) { const int row = tid >> 2, seg = tid & 3; const v4u z = *(const GAS v4u*)(ZZ + (row0 + row) * 32 + seg * 8); LAS f32x4* zp = (LAS f32x4*)(L + row * 128 + seg * 32);
        zp[0] = (f32x4){bflo(z.x), bfhi(z.x), bflo(z.y), bfhi(z.y)}; zp[1] = (f32x4){bflo(z.z), bfhi(z.z), bflo(z.w), bfhi(z.w)}; }
    float wg[16]; const float* WG = dir ? F.w_gb : F.w_gf;
#pragma unroll
    for (int r = 0; r < 16; ++r) wg[r] = WG[r * 256 + col];
    const float bgv = (dir ? F.b_gb : F.b_gf)[col];
    __syncthreads();
    float pf[64]; float run = 0.f;
#pragma unroll
    for (int p = 0; p < 64; ++p) { const LAS f32x4* zp = (const LAS f32x4*)(L + p * 128 + dir * 64); float pre = bgv;
#pragma unroll
        for (int r4 = 0; r4 < 4; ++r4) { const f32x4 z = zp[r4]; pre += z.x * wg[4 * r4] + z.y * wg[4 * r4 + 1] + z.z * wg[4 * r4 + 2] + z.w * wg[4 * r4 + 3]; }
        run += logsig(pre) * (1.f / 16.f); pf[p] = run; }
    const float tot = run;
#pragma unroll
    for (int p = 0; p < 64; ++p) { const unsigned idx = (row0 + p) * 256 + col;
        const float qv = bf2f(GQ[idx]), kv = bf2f(GK[idx]);
        const float ex = dir ? (p ? pf[p - 1] : 0.f) : 0.f;
        const float eq = dir ? __expf(-ex) * 0.125f : __expf(pf[p] - tot) * 0.125f;
        const float ek = dir ? __expf(ex) : __expf(tot - pf[p]);
        QX[idx] = (bf16)f2bf(qv * eq); KX[idx] = (bf16)f2bf(kv * ek); }
    DEC[((unsigned)b * 64 + c) * 256 + col] = __expf(tot);
}

__device__ __forceinline__ void gla_unit(Frame& F, int b, int h, int dir) {
    LAS unsigned char* L = F.lds;
    const int tid = F.tid, lane = F.lane, w = F.wave, q4 = lane >> 4, l15 = lane & 15;
    const bf16* GV = (const bf16*)(F.ws + WS_GV);
    bf16* OX = (bf16*)(F.ws + WS_OF + (dir ? 32 * MiB : 0));
    const unsigned rowbase = (unsigned)b * SEQ;
    const int v0 = 16 * w;
    const int erow = tid >> 3, eseg = tid & 7;
    const int plq = tid >> 3, sgq = tid & 7, plv = tid >> 4, sgv = tid & 15;
    {
        const bf16* QX = (const bf16*)(F.ws + (dir ? WS_QB : WS_QF)); const bf16* KX = (const bf16*)(F.ws + (dir ? WS_KB : WS_KF));
        const float* DEC = (const float*)(F.ws + WS_DEC) + (size_t)dir * (BATCH * 64 * 256);
        f32x4 S[4];
#pragma unroll
        for (int i = 0; i < 4; ++i) S[i] = (f32x4){0.f, 0.f, 0.f, 0.f};
        v4u rq, rk, rv0, rv1; float rdec = 0.f;
#define GLA_LOAD(ci) do { const int c_ = dir ? 63 - (ci) : (ci); const unsigned cb_ = rowbase + (unsigned)c_ * 64u; \
            rq = __builtin_nontemporal_load((const GAS v4u*)(QX + (cb_ + plq) * 256 + h * 64 + sgq * 8)); rk = __builtin_nontemporal_load((const GAS v4u*)(KX + (cb_ + plq) * 256 + h * 64 + sgq * 8)); \
            rv0 = *(const GAS v4u*)(GV + (cb_ + plv) * 512 + h * 128 + sgv * 8); rv1 = *(const GAS v4u*)(GV + (cb_ + plv + 32) * 512 + h * 128 + sgv * 8); \
            if (tid < 64) rdec = DEC[((unsigned)b * 64 + c_) * 256 + h * 64 + tid]; } while (0)
        GLA_LOAD(0);
        v4u st0 = (v4u){0u, 0u, 0u, 0u}, st1 = st0;
#define GLA_FLUSH(cprev) do { const unsigned cbp_ = rowbase + (unsigned)(cprev) * 64u; GAS v4u* sp_ = (GAS v4u*)(OX + (cbp_ + erow) * 512 + h * 128 + eseg * 16); sp_[0] = st0; sp_[1] = st1; } while (0)
        for (int ci = 0; ci < 64; ++ci) {
            const int c = dir ? 63 - ci : ci;
            *(LAS v4u*)(L + L_QS + plq * P64 + sgq * 16) = rq; *(LAS v4u*)(L + L_KS + plq * P64 + sgq * 16) = rk;
            *(LAS v4u*)(L + L_VR + plv * PV + sgv * 16) = rv0; *(LAS v4u*)(L + L_VR + (plv + 32) * PV + sgv * 16) = rv1;
            if (tid < 64) ((LAS float*)(L + L_DEC))[tid] = rdec;
            asm volatile("" ::: "memory");
            if (ci > 0) GLA_FLUSH(dir ? c + 1 : c - 1);
            asm volatile("" ::: "memory");
            if (ci + 1 < 64) GLA_LOAD(ci + 1);
            __syncthreads();
#pragma unroll
            for (int s = 0; s < 2; ++s) { const int tt = 2 * w + s, it = tt >> 2, jt = tt & 3; f32x4 a = (f32x4){0.f, 0.f, 0.f, 0.f};
#pragma unroll
                for (int ks = 0; ks < 2; ++ks) { const bf16x8 af = *(const LAS bf16x8*)(L + L_QS + (16 * it + l15) * P64 + (32 * ks + 8 * q4) * 2); const bf16x8 bfr = *(const LAS bf16x8*)(L + L_KS + (16 * jt + l15) * P64 + (32 * ks + 8 * q4) * 2);
                    a = __builtin_amdgcn_mfma_f32_16x16x32_bf16(af, bfr, a, 0, 0, 0); }
#pragma unroll
                for (int rg = 0; rg < 4; ++rg) { const int i = 16 * it + 4 * q4 + rg, j = 16 * jt + l15; const bool keep = dir ? (j > i) : (j <= i);
                    *(LAS unsigned short*)(L + L_AS + i * P64 + j * 2) = (unsigned short)cvtpk(keep ? a[rg] : 0.f, 0.f); } }
#pragma unroll
            for (int dt = 0; dt < 4; ++dt) { const f32x4 dv = *(const LAS f32x4*)(L + L_DEC + (16 * dt + 4 * q4) * 4); S[dt] = S[dt] * dv;
                *(LAS v2u*)(L + L_ST + (v0 + l15) * P64 + (16 * dt + 4 * q4) * 2) = (v2u){cvtpk(S[dt].x, S[dt].y), cvtpk(S[dt].z, S[dt].w)}; }
            __syncthreads();
            bf16x8 bv[2], bs[2];
#pragma unroll
            for (int ks = 0; ks < 2; ++ks) { const LAS unsigned char* vp = L + L_VR + (32 * ks + 8 * q4 + (l15 >> 2)) * PV + (v0 + 4 * (l15 & 3)) * 2;
                const s16x4 lo = vtr(vp), hi = vtr(vp + 4 * PV); bv[ks] = (bf16x8){lo[0], lo[1], lo[2], lo[3], hi[0], hi[1], hi[2], hi[3]};
                bs[ks] = *(const LAS bf16x8*)(L + L_ST + (v0 + l15) * P64 + (32 * ks + 8 * q4) * 2); }
            f32x4 O[4];
#pragma unroll
            for (int it = 0; it < 4; ++it) { O[it] = (f32x4){0.f, 0.f, 0.f, 0.f};
#pragma unroll
                for (int ks = 0; ks < 2; ++ks) { const bf16x8 aa = *(const LAS bf16x8*)(L + L_AS + (16 * it + l15) * P64 + (32 * ks + 8 * q4) * 2); const bf16x8 aq = *(const LAS bf16x8*)(L + L_QS + (16 * it + l15) * P64 + (32 * ks + 8 * q4) * 2);
                    O[it] = __builtin_amdgcn_mfma_f32_16x16x32_bf16(aa, bv[ks], O[it], 0, 0, 0); O[it] = __builtin_amdgcn_mfma_f32_16x16x32_bf16(aq, bs[ks], O[it], 0, 0, 0); } }
#pragma unroll
            for (int dt = 0; dt < 4; ++dt)
#pragma unroll
                for (int ks = 0; ks < 2; ++ks) { const LAS unsigned char* kp = L + L_KS + (32 * ks + 8 * q4 + (l15 >> 2)) * P64 + (16 * dt + 4 * (l15 & 3)) * 2;
                    const s16x4 lo = vtr(kp), hi = vtr(kp + 4 * P64); const bf16x8 ak = (bf16x8){lo[0], lo[1], lo[2], lo[3], hi[0], hi[1], hi[2], hi[3]};
                    S[dt] = __builtin_amdgcn_mfma_f32_16x16x32_bf16(ak, bv[ks], S[dt], 0, 0, 0); }
#pragma unroll
            for (int it = 0; it < 4; ++it)
#pragma unroll
                for (int rg = 0; rg < 4; ++rg) *(LAS float*)(L + L_OT + (16 * it + 4 * q4 + rg) * POT + (v0 + l15) * 4) = O[it][rg];
            __syncthreads();
            {
                float o[16];
#pragma unroll
                for (int e4 = 0; e4 < 4; ++e4) { const f32x4 t = *(const LAS f32x4*)(L + L_OT + erow * POT + (16 * eseg + 4 * e4) * 4); o[4 * e4] = t.x; o[4 * e4 + 1] = t.y; o[4 * e4 + 2] = t.z; o[4 * e4 + 3] = t.w; }
                st0 = (v4u){cvtpk(o[0], o[1]), cvtpk(o[2], o[3]), cvtpk(o[4], o[5]), cvtpk(o[6], o[7])}; st1 = (v4u){cvtpk(o[8], o[9]), cvtpk(o[10], o[11]), cvtpk(o[12], o[13]), cvtpk(o[14], o[15])};
            }
        }
        GLA_FLUSH(dir ? 0 : 63);
#undef GLA_FLUSH
#undef GLA_LOAD
    }
    VM_WAIT(); __syncthreads();
    if (tid == 0) { __builtin_amdgcn_fence(__ATOMIC_RELEASE, "agent"); VM_WAIT(); (void)__hip_atomic_fetch_add(F.ctl + CW_GDN + 64 * (b * GLA_H + h), 1u, RLX_AGENT); }
    __syncthreads();
}
__device__ __forceinline__ void gla_combine(Frame& F, int b, int h, int part) {
    const int tid = F.tid, erow = tid >> 3, eseg = tid & 7;
    if (tid == 0) { unsigned sp = 0; while (__hip_atomic_load(F.ctl + CW_GDN + 64 * (b * GLA_H + h), RLX_AGENT) < 2u && sp < (1u << 22)) { __builtin_amdgcn_s_sleep(8); ++sp; }
        __builtin_amdgcn_fence(__ATOMIC_ACQUIRE, "agent"); VM_WAIT(); }
    __syncthreads();
    const bf16* OF0 = (const bf16*)(F.ws + WS_OF); const bf16* OB0 = (const bf16*)(F.ws + WS_OF + 32 * MiB); const bf16* GR = (const bf16*)(F.ws + WS_GR); bf16* MIX = (bf16*)(F.ws + WS_MIX);
    float hg[16]; int eso = eseg; asm volatile("" : "+v"(eso));
#pragma unroll
    for (int e = 0; e < 16; ++e) hg[e] = F.gla_hg[16 * eso + e];
    const unsigned r0 = (unsigned)b * SEQ + (unsigned)part * 1024u + erow;
#pragma unroll 2
    for (int ps = 0; ps < 16; ++ps) { const unsigned row = r0 + ps * 64;
        const GAS v4u* fp = (const GAS v4u*)(OF0 + row * 512 + h * 128 + eseg * 16); const GAS v4u* bp = (const GAS v4u*)(OB0 + row * 512 + h * 128 + eseg * 16); const GAS v4u* rp = (const GAS v4u*)(GR + row * 512 + h * 128 + eseg * 16);
        const v4u f0 = __builtin_nontemporal_load(fp), f1 = __builtin_nontemporal_load(fp + 1), b0 = __builtin_nontemporal_load(bp), b1 = __builtin_nontemporal_load(bp + 1), r0v = __builtin_nontemporal_load(rp), r1v = __builtin_nontemporal_load(rp + 1);
        const unsigned fw[8] = {f0.x, f0.y, f0.z, f0.w, f1.x, f1.y, f1.z, f1.w}, bw[8] = {b0.x, b0.y, b0.z, b0.w, b1.x, b1.y, b1.z, b1.w}, rw[8] = {r0v.x, r0v.y, r0v.z, r0v.w, r1v.x, r1v.y, r1v.z, r1v.w};
        float o[16]; float ss = 0.f;
#pragma unroll
        for (int e2 = 0; e2 < 8; ++e2) { o[2 * e2] = bflo(fw[e2]) + bflo(bw[e2]); o[2 * e2 + 1] = bfhi(fw[e2]) + bfhi(bw[e2]); ss += o[2 * e2] * o[2 * e2] + o[2 * e2 + 1] * o[2 * e2 + 1]; }
        ss += __shfl_xor(ss, 1); ss += __shfl_xor(ss, 2); ss += __shfl_xor(ss, 4);
        const float rinv = __builtin_amdgcn_rsqf(ss * (1.f / 128.f) + EPS);
        unsigned ow[8];
#pragma unroll
        for (int e2 = 0; e2 < 8; ++e2) { const float x0 = bflo(rw[e2]), x1 = bfhi(rw[e2]);
            const float y0 = o[2 * e2] * rinv * hg[2 * e2] * (x0 * __builtin_amdgcn_rcpf(1.f + __expf(-x0))), y1 = o[2 * e2 + 1] * rinv * hg[2 * e2 + 1] * (x1 * __builtin_amdgcn_rcpf(1.f + __expf(-x1))); ow[e2] = cvtpk(y0, y1); }
        GAS v4u* mp = (GAS v4u*)(MIX + row * 1024 + h * 128 + eseg * 16);
        mp[0] = (v4u){ow[0], ow[1], ow[2], ow[3]}; mp[1] = (v4u){ow[4], ow[5], ow[6], ow[7]}; }
}
}
struct DenseMap { static constexpr bool GATHER = false;
    const bf16* A; const bf16* Bt; int K;
    __device__ __forceinline__ __amdgpu_buffer_rsrc_t a_rsrc() const { return __builtin_amdgcn_make_buffer_rsrc((void*)A, 0, 0x7fffffff, 0x00020000); }
    __device__ __forceinline__ __amdgpu_buffer_rsrc_t b_rsrc() const { return __builtin_amdgcn_make_buffer_rsrc((void*)Bt, 0, 0x7fffffff, 0x00020000); }
    __device__ __forceinline__ unsigned a_soff(const pg8::Unit& u) const { return (unsigned)u.pm * 256u * (unsigned)K * 2u; }
    __device__ __forceinline__ unsigned b_soff(const pg8::Unit& u) const { return (unsigned)u.pn * 256u * (unsigned)K * 2u; }
    __device__ __forceinline__ void a_off(const pg8::Unit&, const int (&R)[2], const int (&C)[2], unsigned (&vo)[2][2]) const {
#pragma unroll
        for (int h = 0; h < 2; ++h)
#pragma unroll
            for (int i = 0; i < 2; ++i) vo[h][i] = (unsigned)((h * 128 + R[i]) * K + C[i]) * 2u; }
};
struct MoeTabs { const LAS int* cnt; const LAS int* cst; const LAS unsigned short* te; };
struct MoeMapUp { static constexpr bool GATHER = true;
    const unsigned char* A; const unsigned char* Bt; const int* rowtok; MoeTabs tb;
    __device__ __forceinline__ __amdgpu_buffer_rsrc_t a_rsrc() const { return __builtin_amdgcn_make_buffer_rsrc((void*)A, 0, 0x7fffffff, 0x00020000); }
    __device__ __forceinline__ __amdgpu_buffer_rsrc_t b_rsrc() const { return __builtin_amdgcn_make_buffer_rsrc((void*)Bt, 0, 0x7fffffff, 0x00020000); }
    __device__ __forceinline__ unsigned a_soff(const pg8::Unit&) const { return 0u; }
    __device__ __forceinline__ unsigned b_soff(const pg8::Unit& u) const { const unsigned e = tb.te[u.pm]; return (e * 2048u + (unsigned)u.pn * 256u) * 1024u; }
    __device__ __forceinline__ void a_raw(const pg8::Unit& u, const int (&R)[2], unsigned (&raw)[2][2]) const {
        const int e = tb.te[u.pm], pos0 = (u.pm - tb.cst[e]) * 256, n = tb.cnt[e];
#pragma unroll
        for (int h = 0; h < 2; ++h)
#pragma unroll
            for (int i = 0; i < 2; ++i) { const int pos = pos0 + h * 128 + R[i]; raw[h][i] = (unsigned)rowtok[(size_t)e * EROWS + (pos < n ? pos : 0)]; } }
    __device__ __forceinline__ unsigned a_fin(unsigned tok, int C) const { return (tok * 512u + (unsigned)C) * 2u; }
    __device__ __forceinline__ void a_off(const pg8::Unit& u, const int (&R)[2], const int (&C)[2], unsigned (&vo)[2][2]) const {
        unsigned raw[2][2]; a_raw(u, R, raw);
#pragma unroll
        for (int h = 0; h < 2; ++h)
#pragma unroll
            for (int i = 0; i < 2; ++i) vo[h][i] = a_fin(raw[h][i], C[i]); }
};
struct MoeMapDown { static constexpr bool GATHER = false;
    const unsigned char* A; const unsigned char* Bt; MoeTabs tb;
    __device__ __forceinline__ __amdgpu_buffer_rsrc_t a_rsrc() const { return __builtin_amdgcn_make_buffer_rsrc((void*)A, 0, 0x7fffffff, 0x00020000); }
    __device__ __forceinline__ __amdgpu_buffer_rsrc_t b_rsrc() const { return __builtin_amdgcn_make_buffer_rsrc((void*)Bt, 0, 0x7fffffff, 0x00020000); }
    __device__ __forceinline__ unsigned a_soff(const pg8::Unit& u) const { return (unsigned)u.pm * 256u * 1024u; }
    __device__ __forceinline__ unsigned b_soff(const pg8::Unit& u) const { const unsigned e = tb.te[u.pm]; return (e * 1024u + (unsigned)u.pn * 256u) * 1024u; }
    __device__ __forceinline__ void a_off(const pg8::Unit&, const int (&R)[2], const int (&C)[2], unsigned (&vo)[2][2]) const {
#pragma unroll
        for (int h = 0; h < 2; ++h)
#pragma unroll
            for (int i = 0; i < 2; ++i) vo[h][i] = (unsigned)((h * 128 + R[i]) * 512 + C[i]) * 2u; }
};
using pg8::f32x4;
struct EpiInProj { static constexpr bool PERM = true, COLS64 = false;
    bf16 *gq, *gk, *gv, *gr, *aq, *ak, *av, *z;
    struct Pre {}; __device__ __forceinline__ void preload(const pg8::Unit&, int, int, int, int, Pre&) const {}
    __device__ __forceinline__ void operator()(const f32x4 (&acc)[2][2][4][2], const pg8::Unit& u, const Pre&, int wr, int wc, int fr, int fq) const {
        bf16* b0; bf16* b1; int ld;
        switch (u.pn) { case 0: b0 = gq; b1 = gq + 128; ld = 256; break; case 1: b0 = gk; b1 = gk + 128; ld = 256; break;
            case 2: b0 = gv; b1 = gv + 128; ld = 512; break; case 3: b0 = gv + 256; b1 = gv + 384; ld = 512; break;
            case 4: b0 = gr; b1 = gr + 128; ld = 512; break; case 5: b0 = gr + 256; b1 = gr + 384; ld = 512; break;
            case 6: b0 = aq; b1 = aq + 128; ld = 512; break; case 7: b0 = aq + 256; b1 = aq + 384; ld = 512; break;
            case 8: b0 = ak; b1 = av; ld = 128; break; default: b0 = z; b1 = z; ld = 32; break; }
        const bool zt = (u.pn == 9);
        if (zt && wc != 0) return;
        const int row0 = u.pm * 256 + wr * 64 + fr, cw = wc * 32 + 8 * fq;
#pragma unroll
        for (int ai = 0; ai < 2; ++ai)
#pragma unroll
            for (int m = 0; m < 4; ++m) { const size_t row = (size_t)(row0 + ai * 128 + m * 16);
#pragma unroll
                for (int bj = 0; bj < 2; ++bj) { if (zt && bj == 1) continue; const f32x4 v0 = acc[ai][bj][m][0], v1 = acc[ai][bj][m][1];
                    pg8::u32x4 wv; wv.x = pg8::cvt_pk_bf16(v0[0], v0[1]); wv.y = pg8::cvt_pk_bf16(v0[2], v0[3]); wv.z = pg8::cvt_pk_bf16(v1[0], v1[1]); wv.w = pg8::cvt_pk_bf16(v1[2], v1[3]);
                    *(pg8::u32x4*)((bj ? b1 : b0) + row * ld + cw) = wv; } }
    }
};
struct EpiResF32 { static constexpr bool PERM = false, COLS64 = false;
    const float* base; float* out;
    struct Pre {}; __device__ __forceinline__ void preload(const pg8::Unit&, int, int, int, int, Pre&) const {}
    __device__ __forceinline__ void operator()(const f32x4 (&acc)[2][2][4][2], const pg8::Unit& u, const Pre&, int wr, int wc, int fr, int fq) const {
        const int col0 = u.pn * 256 + wc * 32 + 4 * fq;
#pragma unroll
        for (int ai = 0; ai < 2; ++ai)
#pragma unroll
            for (int m = 0; m < 4; ++m) { const size_t off = (size_t)(u.pm * 256 + ai * 128 + wr * 64 + m * 16 + fr) * 1024 + col0;
#pragma unroll
                for (int bj = 0; bj < 2; ++bj)
#pragma unroll
                    for (int n = 0; n < 2; ++n) { const f32x4 bs = *(const f32x4*)(base + off + bj * 128 + n * 16); *(f32x4*)(out + off + bj * 128 + n * 16) = bs + acc[ai][bj][m][n]; } }
    }
};
struct EpiSwiglu { static constexpr bool PERM = true, COLS64 = false;
    const float* b1; unsigned char* act; MoeTabs tb;
    struct Pre { f32x4 g0, g1, l0, l1; };
    __device__ __forceinline__ void preload(const pg8::Unit& u, int wr, int wc, int fr, int fq, Pre& p) const {
        const int e = tb.te[u.pm]; const int col = u.pn * 128 + wc * 32 + 8 * fq; const float* bg = b1 + (size_t)e * 2048 + col; const float* bl = bg + 1024;
        p.g0 = *(const GAS f32x4*)bg; p.g1 = *(const GAS f32x4*)(bg + 4); p.l0 = *(const GAS f32x4*)bl; p.l1 = *(const GAS f32x4*)(bl + 4); }
    __device__ __forceinline__ void operator()(const f32x4 (&acc)[2][2][4][2], const pg8::Unit& u, const Pre& p, int wr, int wc, int fr, int fq) const {
        const int col = u.pn * 128 + wc * 32 + 8 * fq;
        const f32x4 g0 = p.g0, g1 = p.g1, l0 = p.l0, l1 = p.l1;
        const int row0 = u.pm * 256 + wr * 64 + fr;
#pragma unroll
        for (int ai = 0; ai < 2; ++ai)
#pragma unroll
            for (int m = 0; m < 4; ++m) { float o[8];
#pragma unroll
                for (int n = 0; n < 2; ++n)
#pragma unroll
                    for (int j = 0; j < 4; ++j) { const float gl = fminf(__builtin_fmaf(acc[ai][0][m][n][j], 1.f / WSCALE, (n ? g1[j] : g0[j])), 7.f); const float li = __builtin_amdgcn_fmed3f(__builtin_fmaf(acc[ai][1][m][n][j], 1.f / WSCALE, (n ? l1[j] : l0[j])), -7.f, 7.f);
                        o[4 * n + j] = (gl * ASCALE) * __builtin_amdgcn_rcpf(1.f + __builtin_amdgcn_exp2f(gl * (-1.702f * 1.4426950408889634f))) * (li + 1.f); }
                int w0 = 0, w1 = 0;
                w0 = __builtin_amdgcn_cvt_pk_fp8_f32(o[0], o[1], w0, false); w0 = __builtin_amdgcn_cvt_pk_fp8_f32(o[2], o[3], w0, true); w1 = __builtin_amdgcn_cvt_pk_fp8_f32(o[4], o[5], w1, false); w1 = __builtin_amdgcn_cvt_pk_fp8_f32(o[6], o[7], w1, true);
                *(v2u*)(act + (size_t)(row0 + ai * 128 + m * 16) * 1024 + col) = (v2u){(unsigned)w0, (unsigned)w1}; }
    }
};
struct EpiDown { static constexpr bool PERM = true, COLS64 = true;
    const float* b2; const float* rowgate; unsigned char* y; MoeTabs tb;
    struct Pre { f32x4 bv[2][2]; float gt[8]; };
    __device__ __forceinline__ void preload(const pg8::Unit& u, int wr, int wc, int fr, int fq, Pre& p) const {
        const int e = tb.te[u.pm], pos0 = (u.pm - tb.cst[e]) * 256, n_e = tb.cnt[e];
        const float* bb = b2 + (size_t)e * 1024 + u.pn * 256 + wc * 64 + 8 * fq;
#pragma unroll
        for (int bj = 0; bj < 2; ++bj)
#pragma unroll
            for (int n = 0; n < 2; ++n) p.bv[bj][n] = *(const GAS f32x4*)(bb + bj * 32 + 4 * n);
#pragma unroll
        for (int ai = 0; ai < 2; ++ai)
#pragma unroll
            for (int m = 0; m < 4; ++m) { const int pos = pos0 + wr * 64 + fr + ai * 128 + m * 16; const int pc_ = pos < n_e ? pos : 0; const float g = rowgate[(size_t)e * EROWS + pc_]; p.gt[ai * 4 + m] = (pos < n_e) ? g * YSCALE : 0.f; }
    }
    __device__ __forceinline__ void operator()(const f32x4 (&acc)[2][2][4][2], const pg8::Unit& u, const Pre& p, int wr, int wc, int fr, int fq) const {
        const bool odd = (fq & 1) != 0;
        const int colb = u.pn * 256 + wc * 64 + (odd ? 32 + 8 * (fq - 1) : 8 * fq), rl0 = wr * 64 + fr;
#pragma unroll
        for (int ai = 0; ai < 2; ++ai)
#pragma unroll
            for (int m = 0; m < 4; ++m) { const int rl = rl0 + ai * 128 + m * 16; const float gt = p.gt[ai * 4 + m];
                unsigned w[2][2];
#pragma unroll
                for (int bj = 0; bj < 2; ++bj) { const f32x4 v0 = (acc[ai][bj][m][0] * (1.f / (WSCALE * ASCALE)) + p.bv[bj][0]) * gt, v1 = (acc[ai][bj][m][1] * (1.f / (WSCALE * ASCALE)) + p.bv[bj][1]) * gt;
                    int w0 = 0, w1 = 0;
                    w0 = __builtin_amdgcn_cvt_pk_fp8_f32(v0[0], v0[1], w0, false); w0 = __builtin_amdgcn_cvt_pk_fp8_f32(v0[2], v0[3], w0, true); w1 = __builtin_amdgcn_cvt_pk_fp8_f32(v1[0], v1[1], w1, false); w1 = __builtin_amdgcn_cvt_pk_fp8_f32(v1[2], v1[3], w1, true);
                    w[bj][0] = (unsigned)w0; w[bj][1] = (unsigned)w1; }
                const unsigned s0 = odd ? w[0][0] : w[1][0], s1 = odd ? w[0][1] : w[1][1];
                const unsigned r0 = (unsigned)__shfl_xor((int)s0, 16), r1 = (unsigned)__shfl_xor((int)s1, 16);
                const pg8::u32x4 ov = odd ? (pg8::u32x4){r0, r1, w[1][0], w[1][1]} : (pg8::u32x4){w[0][0], w[0][1], r0, r1};
                *(pg8::u32x4*)(y + (size_t)(u.pm * 256 + rl) * 1024 + colb) = ov; }
    }
};
__device__ __forceinline__ int moe_tables(Frame& F) {
    LAS int* cnt = (LAS int*)(F.lds + LC_CNT); LAS int* cst = (LAS int*)(F.lds + LC_CST); LAS unsigned short* te = (LAS unsigned short*)(F.lds + LC_TE);
    __syncthreads();
    if (F.tid < NEXP) cnt[F.tid] = (int)__hip_atomic_load(F.ctl + CW_CNT + 64 * F.tid, RLX_AGENT);
    __syncthreads();
    if (F.tid == 0) { int s = 0; for (int e = 0; e < NEXP; ++e) { cst[e] = s; s += (cnt[e] + 255) >> 8; } cst[NEXP] = s; }
    __syncthreads();
    const int nt = cst[NEXP];
    for (int t = F.tid; t < nt; t += NWAVES * 64) { int e = 0;
#pragma unroll 1
        for (int k = 1; k < NEXP; ++k) e = (t >= cst[k]) ? k : e;
        te[t] = (unsigned short)e; }
    __syncthreads();
    return nt;
}
__device__ __forceinline__ void p3_mixers(Frame& F) {
    for (int u = blockIdx.x; u < 2 * BATCH * GLA_H; u += F.G) gla::gla_unit(F, u & 7, (u >> 3) & 3, u >> 5);
    if (blockIdx.x < 2 * BATCH * GLA_H) { while (conv_pull(F)) {} }
    const attn_body::bf16* Q = (const attn_body::bf16*)(F.ws + WS_AQ); const attn_body::bf16* K = (const attn_body::bf16*)(F.ws + WS_AK); const attn_body::bf16* V = (const attn_body::bf16*)(F.ws + WS_AV);
    attn_body::bf16* O = (attn_body::bf16*)(F.ws + WS_MIX);
    const int x0 = blockIdx.x & 7;
    float sbound;
    { float mq = fabsf(F.q_g[F.lane]), mk = fabsf(F.k_g[F.lane]);
#pragma unroll
      for (int o_ = 1; o_ < 64; o_ <<= 1) { mq = fmaxf(mq, __shfl_xor(mq, o_)); mk = fmaxf(mk, __shfl_xor(mk, o_)); }
      sbound = __builtin_bit_cast(float, __builtin_amdgcn_readfirstlane(__builtin_bit_cast(int, 64.f * attn_body::C2 * mq * mk * 1.02f))); }
    for (int qi = 0; qi < 8; ++qi) { const int x = (x0 + qi) & 7;
        for (;;) {
            __syncthreads();
            if (F.tid == 0) F.MISC[16] = __hip_atomic_fetch_add(F.ctl + CW_QUE + 64 * x, 1u, RLX_AGENT);
            __syncthreads();
            const int item = __builtin_amdgcn_readfirstlane((int)F.MISC[16]);
            if (item >= ATT_H * attn_body::NQB + 4 * GLA_H) break;
            if (item >= ATT_H * attn_body::NQB) { const int k = item - ATT_H * attn_body::NQB; gla::gla_combine(F, x, k >> 2, k & 3); continue; }
            attn_body::attn_unit<8>(x, item >> 4, item & 15, Q, K, V, O, (char*)F.lds, F.q_g, sbound);
        }
    }
    while (conv_pull(F)) {}
    __syncthreads();
}

__device__ __forceinline__ void p5_route(Frame& F) {
    typedef float f32x16 __attribute__((ext_vector_type(16)));
    LAS unsigned char* L = F.lds;
    constexpr int XP = 2064, L_XH = 0, L_XL = 32 * XP, L_PART = 0;
    const int tid = F.tid, lane = F.lane, w = F.wave, r32 = lane & 31, hi = lane >> 5;
    const bf16* WRH = (const bf16*)(F.ws + WS_WRH); const bf16* WRL = (const bf16*)(F.ws + WS_WRL);
    unsigned char* XN8 = F.ws + WS_XN;
    int* ROWTOK = (int*)(F.ws + WS_ROWTOK); float* ROWGATE = (float*)(F.ws + WS_ROWGATE); int* TOKASG = (int*)(F.ws + WS_TOKASG);
    gu32* CNT = F.ctl + CW_CNT;
    bf16x8 wh[8], wl[8];
#pragma unroll
    for (int ks = 0; ks < 8; ++ks) { const int k0 = 128 * w + 16 * ks + 8 * hi; wh[ks] = *(const GAS bf16x8*)(WRH + r32 * 1024 + k0); wl[ks] = *(const GAS bf16x8*)(WRL + r32 * 1024 + k0); }
    f32x4 g2[4];
#pragma unroll
    for (int j = 0; j < 4; ++j) g2[j] = *((const GAS f32x4*)F.ffn_g + lane + 64 * j);
    float brt[16];
#pragma unroll
    for (int r = 0; r < 16; ++r) brt[r] = F.b_router[(r & 3) + 8 * (r >> 2) + 4 * hi];
    LAS int* hist = (LAS int*)(L + LC_HIST); LAS int* basev = (LAS int*)(L + LC_BASE); LAS int* aep = (LAS int*)(L + LC_ASG); LAS float* agt = (LAS float*)(L + LC_ASG + 4096);
    constexpr int NGRP = T / 32;
    const int per = (NGRP + F.G - 1) / F.G, g0 = F.vcu * per, g1 = (g0 + per < NGRP) ? g0 + per : NGRP;
    for (int gb = g0; gb < g1; gb += 8) {
        const int nb = (g1 - gb < 8) ? g1 - gb : 8;
        __syncthreads();
        if (tid < NEXP) hist[tid] = 0;
        for (int bi = 0; bi < nb; ++bi) {
            const int t0 = 32 * (gb + bi);
            f32x4 hv[4][4];
#pragma unroll
            for (int rr = 0; rr < 4; ++rr) { const GAS f32x4* hp = (const GAS f32x4*)(F.out + (size_t)(t0 + 4 * w + rr) * 1024) + lane;
#pragma unroll
                for (int j = 0; j < 4; ++j) hv[rr][j] = __builtin_nontemporal_load(hp + 64 * j); }
#pragma unroll
            for (int rr = 0; rr < 4; ++rr) { const int r = 4 * w + rr; const size_t tok = (size_t)(t0 + r);
                f32x4 v[4]; float s = 0.f;
#pragma unroll
                for (int j = 0; j < 4; ++j) { v[j] = hv[rr][j]; s += (v[j].x * v[j].x + v[j].y * v[j].y) + (v[j].z * v[j].z + v[j].w * v[j].w); }
                const float rinv = 1.f / sqrtf(wave_sum(s) * (1.f / 1024.f) + EPS);
                GAS unsigned* o4 = (GAS unsigned*)(XN8 + tok * 1024) + lane;
#pragma unroll
                for (int j = 0; j < 4; ++j) { const f32x4 xn = v[j] * rinv * g2[j];
                    const unsigned h0 = f2bf(xn.x), h1 = f2bf(xn.y), h2 = f2bf(xn.z), h3 = f2bf(xn.w);
                    const unsigned l0 = f2bf(xn.x - bf2f(h0)), l1 = f2bf(xn.y - bf2f(h1)), l2 = f2bf(xn.z - bf2f(h2)), l3 = f2bf(xn.w - bf2f(h3));
                    const v2u hw = (v2u){h0 | (h1 << 16), h2 | (h3 << 16)}, lw = (v2u){l0 | (l1 << 16), l2 | (l3 << 16)};
                    { int q8 = 0; q8 = __builtin_amdgcn_cvt_pk_fp8_f32(xn.x, xn.y, q8, false); q8 = __builtin_amdgcn_cvt_pk_fp8_f32(xn.z, xn.w, q8, true); o4[64 * j] = (unsigned)q8; }
                    *(LAS v2u*)(L + L_XH + r * XP + (4 * lane + 256 * j) * 2) = hw; *(LAS v2u*)(L + L_XL + r * XP + (4 * lane + 256 * j) * 2) = lw; } }
            __syncthreads();
            f32x16 acc = {};
#pragma unroll
            for (int ks = 0; ks < 8; ++ks) { const int k0 = 128 * w + 16 * ks + 8 * hi;
                const bf16x8 xh = *(const LAS bf16x8*)(L + L_XH + r32 * XP + k0 * 2), xl = *(const LAS bf16x8*)(L + L_XL + r32 * XP + k0 * 2);
                acc = __builtin_amdgcn_mfma_f32_32x32x16_bf16(wh[ks], xh, acc, 0, 0, 0); acc = __builtin_amdgcn_mfma_f32_32x32x16_bf16(wh[ks], xl, acc, 0, 0, 0); acc = __builtin_amdgcn_mfma_f32_32x32x16_bf16(wl[ks], xh, acc, 0, 0, 0); }
            __syncthreads();
#pragma unroll
            for (int r = 0; r < 16; ++r) { const int e = (r & 3) + 8 * (r >> 2) + 4 * hi; ((LAS float*)(L + L_PART))[(w * 32 + e) * 32 + r32] = acc[r]; }
            __syncthreads();
            if (w == 0) {
                float v[16];
#pragma unroll
                for (int r = 0; r < 16; ++r) { const int e = (r & 3) + 8 * (r >> 2) + 4 * hi; float s = brt[r];
#pragma unroll
                    for (int ww = 0; ww < 8; ++ww) s += ((const LAS float*)(L + L_PART))[(ww * 32 + e) * 32 + r32];
                    v[r] = s; }
                float cv[8]; int cidx[8];
#pragma unroll
                for (int s = 0; s < 4; ++s) { float m = -INFINITY; int mr = 0;
#pragma unroll
                    for (int r = 0; r < 16; ++r) { if (v[r] > m) { m = v[r]; mr = r; } }
                    cv[s] = m; cidx[s] = (mr & 3) + 8 * (mr >> 2) + 4 * hi;
#pragma unroll
                    for (int r = 0; r < 16; ++r) v[r] = (r == mr) ? -INFINITY : v[r]; }
#pragma unroll
                for (int s = 0; s < 4; ++s) { cv[4 + s] = __shfl_xor(cv[s], 32); cidx[4 + s] = __shfl_xor(cidx[s], 32); }
                float tv[4]; int ti[4];
#pragma unroll
                for (int s = 0; s < 4; ++s) { float m = -INFINITY; int mi = 1 << 20; int mc = 0;
#pragma unroll
                    for (int c = 0; c < 8; ++c) { const bool better = (cv[c] > m) || (cv[c] == m && cidx[c] < mi); if (better) { m = cv[c]; mi = cidx[c]; mc = c; } }
                    tv[s] = m; ti[s] = mi;
#pragma unroll
                    for (int c = 0; c < 8; ++c) cv[c] = (c == mc) ? -INFINITY : cv[c]; }
                const float e1 = __expf(tv[1] - tv[0]), e2 = __expf(tv[2] - tv[0]), e3 = __expf(tv[3] - tv[0]); const float inv = 1.f / (1.f + e1 + e2 + e3);
                const float gt[4] = {inv, e1 * inv, e2 * inv, e3 * inv};
                if (hi == 0) {
#pragma unroll
                    for (int s = 0; s < 4; ++s) { const int rank = (int)__hip_atomic_fetch_add(hist + ti[s], 1, __ATOMIC_RELAXED, __HIP_MEMORY_SCOPE_WORKGROUP); const int idx = (bi * 32 + r32) * 4 + s; aep[idx] = (ti[s] << 16) | rank; agt[idx] = gt[s]; } }
            }
            __syncthreads();
        }
        if (tid < NEXP) { const int hc = hist[tid]; basev[tid] = hc ? (int)__hip_atomic_fetch_add(CNT + 64 * tid, (unsigned)hc, RLX_AGENT) : 0; }
        __syncthreads();
        for (int idx = tid; idx < nb * 128; idx += NWAVES * 64) { const int ep = aep[idx], e = ep >> 16, pos = basev[e] + (ep & 0xffff); const int tok = 32 * gb + (idx >> 2), s = idx & 3;
            ROWTOK[(size_t)e * EROWS + pos] = tok; ROWGATE[(size_t)e * EROWS + pos] = agt[idx]; TOKASG[tok * 4 + s] = e * EROWS + pos; }
    }
    __syncthreads();
}

__device__ __forceinline__ void p8_combine(Frame& F) {
    const LAS int* cst = (const LAS int*)(F.lds + LC_CST);
    const int gw = F.vcu * NWAVES + F.wave, NGW = F.G * NWAVES, lane = F.lane;
    const int* TOKASG = (const int*)(F.ws + WS_TOKASG); const unsigned char* Y = F.ws + WS_Y;
    f32x4 fg[4];
#pragma unroll
    for (int j = 0; j < 4; ++j) fg[j] = *((const GAS f32x4*)F.fin_g + lane + 64 * j);
    for (int tok = gw; tok < T; tok += NGW) {
        const int a = TOKASG[tok * 4 + (lane & 3)];
        const int crow = cst[a >> 15] * 256 + (a & (EROWS - 1));
        GAS f32x4* hp = (GAS f32x4*)(F.out + (size_t)tok * 1024) + lane; f32x4 v[4];
#pragma unroll
        for (int j = 0; j < 4; ++j) v[j] = __builtin_nontemporal_load(hp + 64 * j);
#pragma unroll
        for (int s = 0; s < 4; ++s) { const int cr = __shfl(crow, s); const GAS unsigned* yp = (const GAS unsigned*)(Y + (size_t)cr * 1024) + lane;
#pragma unroll
            for (int j = 0; j < 4; ++j) { const unsigned yw = __builtin_nontemporal_load(yp + 64 * j); const auto lo = __builtin_amdgcn_cvt_pk_f32_fp8((int)yw, false), hi = __builtin_amdgcn_cvt_pk_f32_fp8((int)yw, true);
                v[j].x += lo[0] * (1.f / YSCALE); v[j].y += lo[1] * (1.f / YSCALE); v[j].z += hi[0] * (1.f / YSCALE); v[j].w += hi[1] * (1.f / YSCALE); } }
        float ss = 0.f;
#pragma unroll
        for (int j = 0; j < 4; ++j) ss += (v[j].x * v[j].x + v[j].y * v[j].y) + (v[j].z * v[j].z + v[j].w * v[j].w);
        const float rinv = 1.f / sqrtf(wave_sum(ss) * (1.f / 1024.f) + EPS);
#pragma unroll
        for (int j = 0; j < 4; ++j) __builtin_nontemporal_store(v[j] * rinv * fg[j], hp + 64 * j);
    }
}
#ifndef MK_N_LAUNCHES
#define MK_N_LAUNCHES 1
#endif
constexpr int N_PHASES = 9;
constexpr int N_LAUNCHES = MK_N_LAUNCHES;
struct Args { const float* in[19]; float* out; unsigned char* ws; int ph_lo, ph_hi; };
__global__ void __launch_bounds__(NWAVES * 64, 2) enc_fwd(Args args) {
    extern __shared__ __attribute__((aligned(16))) unsigned char lds[];
    Frame F;
    F.lds = (LAS unsigned char*)lds;
    F.MISC = (volatile LAS unsigned*)(F.lds + LC_MISC);
    F.tid = threadIdx.x; F.lane = F.tid & 63; F.wave = __builtin_amdgcn_readfirstlane(F.tid >> 6);
    F.G = gridDim.x; { const int bx = blockIdx.x; F.vcu = (F.G % 8 == 0) ? (bx % 8) * (F.G / 8) + bx / 8 : bx; }
    F.ws = args.ws; F.ctl = (gu32*)(args.ws + WS_CTL);
    F.x = args.in[0]; F.mix_g = args.in[1]; F.w_in = args.in[2]; F.w_gf = args.in[3]; F.b_gf = args.in[4]; F.w_gb = args.in[5]; F.b_gb = args.in[6]; F.gla_hg = args.in[7];
    F.q_g = args.in[8]; F.k_g = args.in[9]; F.w_out = args.in[10]; F.ffn_g = args.in[11]; F.w_router = args.in[12]; F.b_router = args.in[13];
    F.w1 = args.in[14]; F.b1 = args.in[15]; F.w2 = args.in[16]; F.b2 = args.in[17]; F.fin_g = args.in[18]; F.out = args.out;
    for (int u = F.tid; u < (LDS_BYTES - LC_OFF) / 4; u += NWAVES * 64) ((LAS unsigned*)(F.lds + LC_OFF))[u] = 0u;
    __syncthreads();
    XcdBarrier bar; bar.bar = (unsigned*)(F.ctl + CW_BAR); bar.x = 0; bar.st = nullptr;
    if (N_LAUNCHES == 1) bar = xcd_barrier_post((unsigned*)(F.ctl + CW_BAR), F.MISC + 8);
    const int lo = args.ph_lo, hi = args.ph_hi;
#define IN(k) (lo <= (k) && (k) < hi)
#define SEAM(k) do { if (IN(k) && IN((k) + 1)) xcd_barrier(bar); } while (0)
    MoeTabs tb{(const LAS int*)(F.lds + LC_CNT), (const LAS int*)(F.lds + LC_CST), (const LAS unsigned short*)(F.lds + LC_TE)};

    if (IN(0)) { p0_prologue(F); } SEAM(0);
    if (IN(1)) {
        DenseMap mp{(const bf16*)(F.ws + WS_XN), (const bf16*)(F.ws + WS_WIN), 1024};
        pg8::StaticOrder S; S.init(T / 256, D_IN_PAD / 256, F.G, (int)blockIdx.x);
        EpiInProj E{(bf16*)(F.ws + WS_GQ), (bf16*)(F.ws + WS_GK), (bf16*)(F.ws + WS_GV), (bf16*)(F.ws + WS_GR), (bf16*)(F.ws + WS_AQ), (bf16*)(F.ws + WS_AK), (bf16*)(F.ws + WS_AV), (bf16*)(F.ws + WS_Z)};
        pg8::gemm_phase<EpiInProj, pg8::StaticOrder, DenseMap, true>(F.lds, 1024, S, mp, E);
    } SEAM(1);
    if (IN(2)) { p2_normrope(F); for (int u = F.vcu; u < BATCH * 64; u += F.G) gla::gla_prep_unit(F, u >> 6, u & 63); } SEAM(2);
    if (IN(3)) { p3_mixers(F); } SEAM(3);
    if (IN(4)) {
        DenseMap mp{(const bf16*)(F.ws + WS_MIX), (const bf16*)(F.ws + WS_WOUT), 1024};
        pg8::StaticOrder S; S.init(T / 256, DM / 256, F.G, (int)blockIdx.x);
        EpiResF32 E{F.x, F.out};
        pg8::gemm_phase<EpiResF32, pg8::StaticOrder, DenseMap, true>(F.lds, 1024, S, mp, E);
    } SEAM(4);
    if (IN(5)) { p5_route(F); } SEAM(5);
    if (IN(6)) {
        const int ntl = moe_tables(F);
        MoeMapUp mp{F.ws + WS_XN, F.ws + WS_W1, (const int*)(F.ws + WS_ROWTOK), tb};
        pg8::StaticOrder S; S.init(ntl, 8, F.G, (int)blockIdx.x);
        EpiSwiglu E{F.b1, F.ws + WS_ACT, tb};
        pg8::gemm_phase<EpiSwiglu, pg8::StaticOrder, MoeMapUp, true, true>(F.lds, 512, S, mp, E);
    } SEAM(6);
    if (IN(7)) {
        const int ntl = moe_tables(F);
        MoeMapDown mp{F.ws + WS_ACT, F.ws + WS_W2, tb};
        pg8::StaticOrder S; S.init(ntl, 4, F.G, (int)blockIdx.x);
        EpiDown E{F.b2, (const float*)(F.ws + WS_ROWGATE), F.ws + WS_Y, tb};
        pg8::gemm_phase<EpiDown, pg8::StaticOrder, MoeMapDown, true, true>(F.lds, 512, S, mp, E);
    } SEAM(7);
    if (IN(8)) { (void)moe_tables(F); p8_combine(F); }
#undef IN
#undef SEAM
}

extern "C" void kernel_launch(void* const* d_in, const int* in_sizes, int n_in, void* d_out, int out_size, void* d_ws, size_t ws_size, hipStream_t stream) {
    static int grid = 0;
    if (grid == 0) {
        if (n_in != 19 || in_sizes[0] != T * DM || out_size != T * DM || ws_size < WS_END) { fprintf(stderr, "kernel_launch: unexpected shapes (n_in %d, in0 %d, out %d, ws %zu); nothing launched\n", n_in, n_in > 0 ? in_sizes[0] : -1, out_size, ws_size); grid = -1; return; }
        int dev = 0, cus = 0, per_cu = 0;
        if (hipGetDevice(&dev) != hipSuccess || hipDeviceGetAttribute(&cus, hipDeviceAttributeMultiprocessorCount, dev) != hipSuccess) { grid = -1; return; }
        if (hipFuncSetAttribute((const void*)enc_fwd, hipFuncAttributeMaxDynamicSharedMemorySize, LDS_BYTES) != hipSuccess) { fprintf(stderr, "kernel_launch: hipFuncSetAttribute failed\n"); grid = -1; return; }
        if (hipOccupancyMaxActiveBlocksPerMultiprocessor(&per_cu, (const void*)enc_fwd, NWAVES * 64, LDS_BYTES) != hipSuccess || per_cu < 1) { fprintf(stderr, "kernel_launch: occupancy query says %d\n", per_cu); }
        (void)hipGetLastError();
        grid = cus;
    }
    if (grid < 0) return;
    if (hipMemsetAsync((char*)d_ws + WS_CTL, 0, CTL_ZERO_BYTES, stream) != hipSuccess) return;
    Args a{};
    for (int i = 0; i < 19; ++i) a.in[i] = (const float*)d_in[i];
    a.out = (float*)d_out; a.ws = (unsigned char*)d_ws;
    if (N_LAUNCHES == 1) { a.ph_lo = 0; a.ph_hi = N_PHASES; hipLaunchKernelGGL(enc_fwd, dim3(grid), dim3(NWAVES * 64), LDS_BYTES, stream, a); }
    else for (int p = 0; p < N_PHASES; ++p) { a.ph_lo = p; a.ph_hi = p + 1; hipLaunchKernelGGL(enc_fwd, dim3(grid), dim3(NWAVES * 64), LDS_BYTES, stream, a); }
}
```

```cpp
#include <hip/hip_runtime.h>
#include <hip/hip_bf16.h>
#include <cstdio>
#include <cstdint>
#include <cmath>

#define LAS __attribute__((address_space(3)))
#define GAS __attribute__((address_space(1)))

namespace pg8 {
typedef unsigned short bf16_t;
typedef short bf16x8 __attribute__((ext_vector_type(8)));
typedef float f32x4 __attribute__((ext_vector_type(4)));
typedef float f32x2 __attribute__((ext_vector_type(2)));
typedef unsigned u32x4 __attribute__((ext_vector_type(4)));
typedef int v4i_t __attribute__((ext_vector_type(4)));
typedef int v8i_t __attribute__((ext_vector_type(8)));
constexpr int BM = 256, BK = 64, HALF = 128, HTB = HALF * BK * 2, STAGE_BYTES = 8 * HTB, NXCD = 8, WGM = 4;

__host__ __device__ __forceinline__ int lds_byte(int r, int c) { const int st = (r >> 4) * 2 + (c >> 5), rr = r & 15, cc = c & 31, ob = rr * 64 + cc * 2; return st * 1024 + (ob ^ (((ob >> 9) & 1) << 5)); }
__host__ __device__ __forceinline__ void stage_rc(int b, int& R, int& C) { const int st = b / 1024, sb = b % 1024, swz = sb ^ (((sb >> 9) & 1) << 5); R = (st >> 1) * 16 + swz / 64; C = (st & 1) * 32 + (swz % 64) / 2; }
__host__ __device__ __forceinline__ int perm32(int rho) { const int n = rho >> 4, i = rho & 15; return 8 * (i >> 2) + 4 * n + (i & 3); }

struct Unit { int pm, pn; };

struct StaticOrder {
    int nM, nN, nwg, G, c;
    __device__ __forceinline__ void init(int nM_, int nN_, int G_, int c_) { nM = nM_; nN = nN_; nwg = nM * nN; G = G_; c = c_; }
    __device__ __forceinline__ bool next(int i, Unit& u) const {
        const long L = (long)i * G + c; if (L >= nwg) return false;
        int wgid = (int)L; { const int q = nwg / NXCD, r = nwg % NXCD, xcd = wgid % NXCD, off = wgid / NXCD; wgid = (xcd < r ? xcd * (q + 1) : r * (q + 1) + (xcd - r) * q) + off; }
        const int nig = WGM * nN, gid = wgid / nig, fm = gid * WGM, gsz = (nM - fm) < WGM ? (nM - fm) : WGM;
        u.pm = fm + ((wgid % nig) % gsz); u.pn = (wgid % nig) / gsz; return true;
    }
};

__device__ __forceinline__ unsigned cvt_pk_bf16(float lo, float hi) { unsigned r; asm volatile("v_cvt_pk_bf16_f32 %0, %1, %2" : "=v"(r) : "v"(lo), "v"(hi)); return r; }

template <class Epi, class Sched, class Map, bool ALIGN_EPI, bool FP8 = false>
__device__ __forceinline__ void gemm_phase(LAS unsigned char* lds, const int K, const Sched& S, const Map& MP, const Epi& E) {
    int tid_ = threadIdx.x; asm volatile("" : "+v"(tid_));
    const int tid = tid_, wid = __builtin_amdgcn_readfirstlane(tid >> 6), lane = tid & 63, wr = wid >> 2, wc = wid & 3, fr = lane & 15, fq = lane >> 4;
    const int nt = K / BK;
    int Rr[2], Cc[2]; unsigned voffB[2];
#pragma unroll
    for (int i = 0; i < 2; ++i) { int R, C; stage_rc(tid * 16 + i * 8192, R, C); Rr[i] = R; Cc[i] = C; const int Rb = Epi::COLS64 ? (64 * (R >> 5) + perm32(R & 31)) : (Epi::PERM ? ((R & ~31) + perm32(R & 31)) : R); voffB[i] = (unsigned)(Rb * K + C) * 2u; }
    const unsigned kstep = (unsigned)(BK * 2);
    const unsigned hstep = (unsigned)HALF * K * 2;
    const unsigned hstepB = Epi::COLS64 ? 32u * (unsigned)K * 2u : hstep;
    const __amdgpu_buffer_rsrc_t RA = MP.a_rsrc(), RB = MP.b_rsrc();
    const unsigned ldsw = (unsigned)wid * 1024u;
    const int aoff = lds_byte(wr * 64 + fr, fq * 8), boff = lds_byte(wc * 32 + fr, fq * 8);
#define PG8_SA(b, h) (((b) * 2 + (h)) * HTB)
#define PG8_SB(b, h) ((4 + (b) * 2 + (h)) * HTB)
#define PG8_STAGE(bufoff, rsrc, soff, voff) do { _Pragma("unroll") for (int _i = 0; _i < 2; ++_i) \
        __builtin_amdgcn_raw_ptr_buffer_load_lds(rsrc, (LAS unsigned*)(lds + (bufoff) + ldsw + _i * 8192), 16, (int)(voff)[_i], (int)(soff), 0, 0); } while (0)
#define PG8_LD8(p) __builtin_shufflevector(*(const LAS v4i_t*)(p), *(const LAS v4i_t*)((p) + 1024), 0, 1, 2, 3, 4, 5, 6, 7)
#define PG8_LDA(dst, b, h) do { _Pragma("unroll") for (int m = 0; m < 4; ++m) dst[m] = PG8_LD8(lds + PG8_SA(b, h) + aoff + m * 2048); } while (0)
#define PG8_LDB(dst, b, h) do { _Pragma("unroll") for (int n = 0; n < 2; ++n) dst[n] = PG8_LD8(lds + PG8_SB(b, h) + boff + n * 2048); } while (0)
#define PG8_HALF(x, k) __builtin_bit_cast(bf16x8, __builtin_shufflevector(x, x, 4 * (k), 4 * (k) + 1, 4 * (k) + 2, 4 * (k) + 3))
#define PG8_MMA(ai, bj, At, Bt) do { __builtin_amdgcn_s_setprio(1); _Pragma("unroll") for (int m = 0; m < 4; ++m) _Pragma("unroll") for (int n = 0; n < 2; ++n) { \
        if constexpr (FP8) { acc[ai][bj][m][n] = __builtin_amdgcn_mfma_scale_f32_16x16x128_f8f6f4(Bt[n], At[m], acc[ai][bj][m][n], 0, 0, 0, 0x7f7f7f7f, 0, 0x7f7f7f7f); } \
        else { acc[ai][bj][m][n] = __builtin_amdgcn_mfma_f32_16x16x32_bf16(PG8_HALF(Bt[n], 0), PG8_HALF(At[m], 0), acc[ai][bj][m][n], 0, 0, 0); \
               acc[ai][bj][m][n] = __builtin_amdgcn_mfma_f32_16x16x32_bf16(PG8_HALF(Bt[n], 1), PG8_HALF(At[m], 1), acc[ai][bj][m][n], 0, 0, 0); } } \
        __builtin_amdgcn_s_setprio(0); } while (0)
#define PG8_WAIT_V(n) asm volatile("s_waitcnt vmcnt(" #n ")" ::: "memory")
#define PG8_WAIT_L(n) asm volatile("s_waitcnt lgkmcnt(" #n ")" ::: "memory")
#define PG8_BAR __builtin_amdgcn_s_barrier()
#define PG8_SCHED __builtin_amdgcn_sched_barrier(0)
    Unit cur, nxt, nn; int ui = 0;
    if (!S.next(0, cur)) return;
    f32x4 acc[2][2][4][2];
#pragma unroll
    for (int a = 0; a < 2; ++a)
#pragma unroll
        for (int b = 0; b < 2; ++b)
#pragma unroll
            for (int m = 0; m < 4; ++m)
#pragma unroll
                for (int n = 0; n < 2; ++n) acc[a][b][m][n] = (f32x4){0.f, 0.f, 0.f, 0.f};
    v8i_t At[4], B0[2], B1[2];
    unsigned cvo[2][2], nvo[2][2], nnvo[2][2];
    MP.a_off(cur, Rr, Cc, cvo);
    bool has_next = S.next(1, nxt);
    if constexpr (Map::GATHER) { if (has_next) MP.a_off(nxt, Rr, Cc, nvo); else { nvo[0][0] = cvo[0][0]; nvo[0][1] = cvo[0][1]; nvo[1][0] = cvo[1][0]; nvo[1][1] = cvo[1][1]; } }
    unsigned cA = MP.a_soff(cur), cB = MP.b_soff(cur);
    typename Epi::Pre pc, pn;
    E.preload(cur, wr, wc, fr, fq, pc); pn = pc;
    PG8_STAGE(PG8_SB(0, 0), RB, cB, voffB); PG8_STAGE(PG8_SB(0, 1), RB, cB + hstepB, voffB); PG8_STAGE(PG8_SA(0, 0), RA, cA, cvo[0]); PG8_STAGE(PG8_SA(0, 1), RA, cA, cvo[1]);
    if (wr == 1) PG8_BAR;
    PG8_WAIT_V(2); PG8_BAR;
    PG8_STAGE(PG8_SB(1, 0), RB, cB + kstep, voffB); PG8_STAGE(PG8_SA(1, 0), RA, cA + kstep, cvo[0]); PG8_STAGE(PG8_SB(1, 1), RB, cB + hstepB + kstep, voffB);
    PG8_WAIT_V(6); PG8_BAR;
    for (;;) {
        const unsigned nA = has_next ? MP.a_soff(nxt) : cA, nB = has_next ? MP.b_soff(nxt) : cB;
#pragma unroll 1
        for (int t = 0; t < nt; t += 2) {
            const bool last = (t == nt - 2);
            const unsigned a1 = cA + (unsigned)(t + 1) * kstep;
            const unsigned a2 = last ? nA : cA + (unsigned)(t + 2) * kstep, b2 = last ? nB : cB + (unsigned)(t + 2) * kstep;
            const unsigned a3 = a2 + kstep, b3 = b2 + kstep;
            unsigned s0[2] = {cvo[0][0], cvo[0][1]}, s1[2] = {cvo[1][0], cvo[1][1]};
            if constexpr (Map::GATHER) { if (last) { s0[0] = nvo[0][0]; s0[1] = nvo[0][1]; s1[0] = nvo[1][0]; s1[1] = nvo[1][1]; } }
            PG8_LDB(B0, 0, 0); PG8_LDB(B1, 0, 1); PG8_SCHED; PG8_LDA(At, 0, 0); PG8_STAGE(PG8_SA(1, 1), RA, a1, cvo[1]);
            PG8_WAIT_V(8); PG8_WAIT_L(0); PG8_BAR; PG8_MMA(0, 0, At, B0); PG8_MMA(0, 1, At, B1); PG8_BAR; PG8_SCHED;
            PG8_LDA(At, 0, 1); PG8_STAGE(PG8_SB(0, 0), RB, b2, voffB); PG8_STAGE(PG8_SB(0, 1), RB, b2 + hstepB, voffB); PG8_STAGE(PG8_SA(0, 0), RA, a2, s0);
            PG8_WAIT_V(8); PG8_WAIT_L(0); PG8_BAR; PG8_MMA(1, 0, At, B0); PG8_MMA(1, 1, At, B1); PG8_BAR; PG8_SCHED;
            PG8_LDB(B0, 1, 0); PG8_LDB(B1, 1, 1); PG8_SCHED; PG8_LDA(At, 1, 0); PG8_STAGE(PG8_SA(0, 1), RA, a2, s1);
            PG8_WAIT_V(8); PG8_WAIT_L(0); PG8_BAR; PG8_MMA(0, 0, At, B0); PG8_MMA(0, 1, At, B1); PG8_BAR; PG8_SCHED;
            PG8_LDA(At, 1, 1); PG8_STAGE(PG8_SB(1, 0), RB, b3, voffB); PG8_STAGE(PG8_SB(1, 1), RB, b3 + hstepB, voffB); PG8_STAGE(PG8_SA(1, 0), RA, a3, s0);
            PG8_WAIT_V(8); PG8_WAIT_L(0); PG8_BAR; PG8_MMA(1, 0, At, B0); PG8_MMA(1, 1, At, B1); PG8_BAR; PG8_SCHED;
        }
        if constexpr (ALIGN_EPI) { if (wr == 0) PG8_BAR; }
        const bool has_nn = has_next && S.next(ui + 2, nn);
        if constexpr (Map::GATHER) { if (has_nn) MP.a_raw(nn, Rr, nnvo); }
        if (has_next) E.preload(nxt, wr, wc, fr, fq, pn);
        { int fr_ = fr, fq_ = fq; asm volatile("" : "+v"(fr_), "+v"(fq_)); E(acc, cur, pc, wr, wc, fr_, fq_); }
        if (!has_next) break;
#pragma unroll
        for (int a = 0; a < 2; ++a)
#pragma unroll
            for (int b = 0; b < 2; ++b)
#pragma unroll
                for (int m = 0; m < 4; ++m)
#pragma unroll
                    for (int n = 0; n < 2; ++n) acc[a][b][m][n] = (f32x4){0.f, 0.f, 0.f, 0.f};
        cur = nxt; cA = nA; cB = nB; ++ui; pc = pn;
#pragma unroll
        for (int h = 0; h < 2; ++h)
#pragma unroll
            for (int i = 0; i < 2; ++i) { if constexpr (Map::GATHER) { cvo[h][i] = nvo[h][i]; nvo[h][i] = has_nn ? MP.a_fin(nnvo[h][i], Cc[i]) : nvo[h][i]; } }
        has_next = has_nn; nxt = nn;
        if constexpr (ALIGN_EPI) { if (wr == 1) PG8_BAR; }
    }
    PG8_WAIT_V(0);
    if constexpr (!ALIGN_EPI) { if (wr == 0) PG8_BAR; }
    PG8_BAR;
#undef PG8_SA
#undef PG8_SB
#undef PG8_STAGE
#undef PG8_LDA
#undef PG8_LDB
#undef PG8_MMA
#undef PG8_HALF
#undef PG8_LD8
#undef PG8_WAIT_V
#undef PG8_WAIT_L
#undef PG8_BAR
#undef PG8_SCHED
}
}
namespace attn_body {
using bf16=__hip_bfloat16;
using bf16x8=__attribute__((ext_vector_type(8)))short;
using s16x4=__attribute__((ext_vector_type(4)))short;
using f32x16=__attribute__((ext_vector_type(16)))float;
using u32x4=__attribute__((ext_vector_type(4)))unsigned;
constexpr int BATCH=8,NHEAD=8,NKVH=2,SEQ=4096,D=64;
constexpr int QP=512,KP=128,VP=128,OP=1024,OCOL=512;
constexpr int NW=8,QBLK=32,QB=QBLK*NW,KVBLK=64,NQB=SEQ/QB;
__device__ __forceinline__ int crow(int r,int hi){return (r&3)+8*(r>>2)+4*hi;}
#define SBAR() __builtin_amdgcn_sched_barrier(0)
constexpr int NSLOT=3, SLOTB=8192;
constexpr int LDS_K=0, LDS_V=NSLOT*SLOTB, LDS_WS=2*NSLOT*SLOTB, LDS_OST=LDS_WS+NW*64*4, LDS_BYTES=LDS_OST+NW*4096;
constexpr float C2=0.125f*1.4426950408889634f;
__device__ __forceinline__ void glds16(const void*gsrc,unsigned lds_dst){unsigned keep;
  asm volatile("s_mov_b32 %0, m0\n\ts_mov_b32 m0, %2\n\ts_nop 0\n\tglobal_load_lds_dwordx4 %1, off\n\ts_mov_b32 m0, %0":"=&s"(keep):"v"(gsrc),"s"(lds_dst):"memory");}
__device__ __forceinline__ float max3f(float a,float b,float c){float r;asm("v_max3_f32 %0, %1, %2, %3":"=v"(r):"v"(a),"v"(b),"v"(c));return r;}
__device__ __forceinline__ float max2f(float a,float b){float r;asm("v_max_f32_e32 %0, %1, %2":"=v"(r):"v"(a),"v"(b));return r;}
__device__ __forceinline__ float fadd_s(float a,float b){float r;asm("v_add_f32_e32 %0, %1, %2":"=v"(r):"v"(a),"v"(b));return r;}
__device__ __forceinline__ float fsub_s(float a,float b){float r;asm("v_sub_f32_e32 %0, %1, %2":"=v"(r):"v"(a),"v"(b));return r;}
typedef float f32x2_t __attribute__((ext_vector_type(2))); typedef __bf16 bf16x2_t __attribute__((ext_vector_type(2)));
__device__ __forceinline__ unsigned cvtpk_s(float lo,float hi){f32x2_t v={lo,hi};bf16x2_t b=__builtin_convertvector(v,bf16x2_t);return __builtin_bit_cast(unsigned,b);}
#define WAIT_BAR(N) asm volatile("s_waitcnt vmcnt(" #N ") lgkmcnt(0)\n\ts_barrier":::"memory")

__device__ __forceinline__ void qkt(f32x16&p0,f32x16&p1,const char*Kslot,const bf16x8*qr,const f32x16&negm,int r32,int hi){
  const char*kb=Kslot+hi*1024+r32*16;
  #pragma unroll
  for(int d0=0;d0<4;++d0){
    const bf16x8 b0=*reinterpret_cast<const bf16x8*>(kb+d0*2048);
    const bf16x8 b1=*reinterpret_cast<const bf16x8*>(kb+d0*2048+512);
    if(d0==0){p0=__builtin_amdgcn_mfma_f32_32x32x16_bf16(b0,qr[0],negm,0,0,0);p1=__builtin_amdgcn_mfma_f32_32x32x16_bf16(b1,qr[0],negm,0,0,0);}
    else{p0=__builtin_amdgcn_mfma_f32_32x32x16_bf16(b0,qr[d0],p0,0,0,0);p1=__builtin_amdgcn_mfma_f32_32x32x16_bf16(b1,qr[d0],p1,0,0,0);}}
}
typedef __attribute__((address_space(3))) const char* lds_cptr;
typedef short v4i16_t __attribute__((ext_vector_type(4)));
__device__ __forceinline__ void kload8(bf16x8*kf,lds_cptr kp){
  kf[0]=*(const __attribute__((address_space(3))) bf16x8*)(kp);      kf[1]=*(const __attribute__((address_space(3))) bf16x8*)(kp+512);
  kf[2]=*(const __attribute__((address_space(3))) bf16x8*)(kp+2048); kf[3]=*(const __attribute__((address_space(3))) bf16x8*)(kp+2560);
  kf[4]=*(const __attribute__((address_space(3))) bf16x8*)(kp+4096); kf[5]=*(const __attribute__((address_space(3))) bf16x8*)(kp+4608);
  kf[6]=*(const __attribute__((address_space(3))) bf16x8*)(kp+6144); kf[7]=*(const __attribute__((address_space(3))) bf16x8*)(kp+6656);
}
__device__ __forceinline__ void kload2(bf16x8*kf,lds_cptr kp,int j){ kf[2*j]=*(const __attribute__((address_space(3))) bf16x8*)(kp+j*2048); kf[2*j+1]=*(const __attribute__((address_space(3))) bf16x8*)(kp+j*2048+512); }
__device__ __forceinline__ s16x4 vtr(lds_cptr p){ return __builtin_bit_cast(s16x4,__builtin_amdgcn_ds_read_tr16_b64_v4i16((__attribute__((address_space(3))) v4i16_t*)p)); }
__device__ __forceinline__ float rowmax(const f32x16&p0,const f32x16&p1){
  float a=max3f(p0[0],p0[1],p1[0]),b=max3f(p0[2],p0[3],p1[1]);a=max3f(a,p1[2],p1[3]);
  #pragma unroll
  for(int r=4;r<16;r+=4){a=max3f(a,p0[r],p0[r+1]);b=max3f(b,p0[r+2],p0[r+3]);a=max3f(a,p1[r],p1[r+1]);b=max3f(b,p1[r+2],p1[r+3]);}
  const float m=max2f(a,b);
  auto rr=__builtin_amdgcn_permlane32_swap(__float_as_uint(m),__float_as_uint(m),false,false);
  return max2f(__uint_as_float(rr[0]),__uint_as_float(rr[1]));
}
__device__ __forceinline__ void pv(f32x16*o,int vb,bf16x8 pa0,bf16x8 pa1,bf16x8 pa2,bf16x8 pa3){
  #pragma unroll
  for(int d0=0;d0<2;++d0){s16x4 lo[4],hi[4];
    #pragma unroll
    for(int ks=0;ks<4;++ks){
      asm volatile("ds_read_b64_tr_b16 %0,%1 offset:%c2":"=&v"(lo[ks]):"v"(vb),"i"(d0*4096+ks*1024):"memory");
      asm volatile("ds_read_b64_tr_b16 %0,%1 offset:%c2":"=&v"(hi[ks]):"v"(vb),"i"(d0*4096+ks*1024+512):"memory");}
    asm volatile("s_waitcnt lgkmcnt(0)":::"memory");SBAR();
    #define PK(k) (bf16x8){lo[k][0],lo[k][1],lo[k][2],lo[k][3],hi[k][0],hi[k][1],hi[k][2],hi[k][3]}
    o[d0]=__builtin_amdgcn_mfma_f32_32x32x16_bf16(pa0,PK(0),o[d0],0,0,0);
    o[d0]=__builtin_amdgcn_mfma_f32_32x32x16_bf16(pa1,PK(1),o[d0],0,0,0);
    o[d0]=__builtin_amdgcn_mfma_f32_32x32x16_bf16(pa2,PK(2),o[d0],0,0,0);
    o[d0]=__builtin_amdgcn_mfma_f32_32x32x16_bf16(pa3,PK(3),o[d0],0,0,0);
    #undef PK
  }
}
#define ATTN_STORE16(p,v) (*(u32x4*)(p)=(v))
template<int THRL> __device__ __forceinline__ void attn_unit(int b,int h,int qb,const bf16*Q,const bf16*__restrict__ K,const bf16*__restrict__ V,bf16*O,char*shm,const float*qgain,const float sbound){
  int tid_=threadIdx.x; asm volatile("":"+v"(tid_));
  const int tid=tid_,lane=tid&63,r32=lane&31,hi=lane>>5; const int wid=__builtin_amdgcn_readfirstlane(tid>>6);
  const long rowbase=(long)b*SEQ; const int q0=qb*QB; const int kvh=h/(NHEAD/NKVH);
  const bf16*Qw=Q+(rowbase+q0+wid*QBLK)*QP+h*D;
  const bf16*Kh=K+rowbase*KP+kvh*D,*Vh=V+rowbase*VP+kvh*D;
  const unsigned lds0=(unsigned)(uintptr_t)shm;
  float*wsf=(float*)(shm+LDS_WS)+wid*64;
  const bf16*ksrc=Kh+(long)lane*KP+wid*8;
  const bf16*vsrc=Vh+(long)(16*(wid&3)+(lane>>2))*VP+(wid>>2)*32+(lane&3)*8;
  const unsigned kdst=lds0+LDS_K+wid*1024, vdst=lds0+LDS_V+wid*1024;
  #define DMA_K(t,slot) glds16(ksrc+(long)(t)*KVBLK*KP,(unsigned)__builtin_amdgcn_readfirstlane(kdst+(slot)))
  #define DMA_V(t,slot) glds16(vsrc+(long)(t)*KVBLK*VP,(unsigned)__builtin_amdgcn_readfirstlane(vdst+(slot)))
  const int vb0=(int)(lds0+LDS_V)+((lane>>4)&1)*32+(lane&3)*8+(4*hi+((lane&15)>>2))*64;
  const char*Kbase=shm+LDS_K; bf16x8 kf[8];
  const lds_cptr shm3=(lds_cptr)shm; const lds_cptr kp0=shm3+LDS_K+hi*1024+r32*16; const lds_cptr vp0=shm3+LDS_V+((lane>>4)&1)*32+(lane&3)*8+(4*hi+((lane&15)>>2))*64;
  constexpr int NT=SEQ/KVBLK;
  DMA_K(0,0);DMA_V(0,0);DMA_K(1,SLOTB);
  bf16x8 qr[4];
  #pragma unroll
  for(int d0=0;d0<4;++d0)qr[d0]=*reinterpret_cast<const bf16x8*>(&Qw[(long)r32*QP+d0*16+hi*8]);
  { float xq[4][8]; float ss=0.f; int hio=hi; asm volatile("":"+v"(hio));
    #pragma unroll
    for(int d0=0;d0<4;++d0)
      #pragma unroll
      for(int j=0;j<8;++j){ xq[d0][j]=__builtin_bit_cast(float,((unsigned)(unsigned short)qr[d0][j])<<16); ss+=xq[d0][j]*xq[d0][j]; }
    ss+=__shfl_xor(ss,32);
    const float rinv=__builtin_amdgcn_rsqf(ss*(1.f/64.f)+1e-6f);
    const int tq=q0+wid*QBLK+r32; const float prow=(float)(tq>>6), pcol=(float)(tq&63);
    #pragma unroll
    for(int d0=0;d0<4;++d0)
      #pragma unroll
      for(int j=0;j<8;++j) xq[d0][j]*=rinv*qgain[16*d0+8*hio+j];
    #pragma unroll
    for(int j=0;j<8;++j){ const float inv=exp2f(-(float)(8*hio+j)*(13.287712379549449f/16.f));
      const float ar=prow*inv, ac=pcol*inv; const float cr=__cosf(ar), sr=__sinf(ar), cc=__cosf(ac), sc=__sinf(ac);
      const float a0=xq[0][j], a1=xq[1][j], b0=xq[2][j], b1=xq[3][j];
      xq[0][j]=(a0*cr-a1*sr)*C2; xq[1][j]=(a1*cr+a0*sr)*C2; xq[2][j]=(b0*cc-b1*sc)*C2; xq[3][j]=(b1*cc+b0*sc)*C2; }
    #pragma unroll
    for(int d0=0;d0<4;++d0){ u32x4 w; w.x=cvtpk_s(xq[d0][0],xq[d0][1]); w.y=cvtpk_s(xq[d0][2],xq[d0][3]); w.z=cvtpk_s(xq[d0][4],xq[d0][5]); w.w=cvtpk_s(xq[d0][6],xq[d0][7]); qr[d0]=__builtin_bit_cast(bf16x8,w); } }
  float l_reg=0.f;f32x16 o[2];o[0]=f32x16{};o[1]=f32x16{};f32x16 negm;
  #pragma unroll
  for(int r=0;r<16;++r)negm[r]=-sbound;
  asm volatile("":"+v"(negm));
  #define START(P0,P1) do{ _Pragma("unroll") for(int r=0;r<16;++r)P0[r]=__builtin_amdgcn_exp2f(P0[r]); }while(0)
  #define RESC() do{}while(0)
  f32x16 pA0,pA1,pB0,pB1;
  int sl_prev=0,sl_cur=0,sl_next=SLOTB;
  #define ROT() do{sl_prev=sl_cur;sl_cur=sl_next;sl_next=(sl_next==(NSLOT-1)*SLOTB)?0:sl_next+SLOTB;}while(0)
  DMA_K(2,2*SLOTB);
  WAIT_BAR(3);
  qkt(pA0,pA1,Kbase,qr,negm,r32,hi);asm volatile("s_nop 15\n\ts_nop 7":"+v"(pA0),"+v"(pA1));
  START(pA0,pA1);
  _Pragma("unroll") for(int r=0;r<16;++r)pA1[r]=__builtin_amdgcn_exp2f(pA1[r]);
  WAIT_BAR(0);
  DMA_K(3,0);DMA_V(1,SLOTB);
  ROT();
  kload8(kf,kp0+sl_cur);
  WAIT_BAR(2);
  s16x4 vlo[8],vhi[8]; u32x4 pw0,pw1,pw2,pw3;
  #define PKW(P,B) cvtpk_s(P[B],P[B+1])
  #define PAF(k) __builtin_bit_cast(bf16x8,pw##k)
  #define VFR(i) (bf16x8){vlo[i][0],vlo[i][1],vlo[i][2],vlo[i][3],vhi[i][0],vhi[i][1],vhi[i][2],vhi[i][3]}
  #define PIN(x) asm volatile("":"+v"(x))
  #define MX3(a,b,c) __builtin_fmaxf(__builtin_fmaxf((a),(b)),(c))
  #define GAPA(MF,A0,A1,A2,A3,W0,W1,PW) do{ MF; sacc+=A0; sacc+=A1; sacc+=A2; sacc+=A3; PIN(sacc); W0; W1; PIN(PW); SBAR(); }while(0)
  #define EX(v) __builtin_amdgcn_exp2f(v)
  #define GAPB(MF,X,B) do{ MF; X[B]=EX(X[B]); X[B+1]=EX(X[B+1]); X[B+2]=EX(X[B+2]); X[B+3]=EX(X[B+3]); PIN(X); SBAR(); }while(0)
  #define VRD(i) do{ vlo[i]=vtr(vp_+(((i)>>2)*4096+((i)&3)*1024)); vhi[i]=vtr(vp_+(((i)>>2)*4096+((i)&3)*1024+512)); }while(0)
  #define KRD(G,j) do{ if(G){ kload2(kf,kp0+sl_next,j); SBAR(); } }while(0)
  #define STEP(C0,C1,P0,P1,t,GK,GV,GL) do{ SBAR(); \
    const lds_cptr vp_=vp0+sl_prev; \
    VRD(0); SBAR(); float sacc=(P0[0]+P0[1]); \
    GAPA(C0=__builtin_amdgcn_mfma_f32_32x32x16_bf16(kf[0],qr[0],negm,0,0,0), P0[2],P0[3],P0[4],P0[5],     pw0[0]=PKW(P0,0), pw0[1]=PKW(P0,2), pw0); \
    VRD(4); SBAR(); GAPA(C1=__builtin_amdgcn_mfma_f32_32x32x16_bf16(kf[1],qr[0],negm,0,0,0), P0[6],P0[7],P0[8],P0[9],     pw0[2]=PKW(P0,4), pw0[3]=PKW(P0,6), pw0); \
    VRD(1); SBAR(); GAPA(C0=__builtin_amdgcn_mfma_f32_32x32x16_bf16(kf[2],qr[1],C0,0,0,0),   P0[10],P0[11],P0[12],P0[13], pw1[0]=PKW(P0,8), pw1[1]=PKW(P0,10), pw1); \
    VRD(5); SBAR(); GAPA(C1=__builtin_amdgcn_mfma_f32_32x32x16_bf16(kf[3],qr[1],C1,0,0,0),   P0[14],P0[15],P1[0],P1[1],   pw1[2]=PKW(P0,12),pw1[3]=PKW(P0,14), pw1); \
    VRD(2); SBAR(); GAPA(C0=__builtin_amdgcn_mfma_f32_32x32x16_bf16(kf[4],qr[2],C0,0,0,0),   P1[2],P1[3],P1[4],P1[5],     pw2[0]=PKW(P1,0), pw2[1]=PKW(P1,2), pw2); \
    VRD(6); SBAR(); GAPA(C1=__builtin_amdgcn_mfma_f32_32x32x16_bf16(kf[5],qr[2],C1,0,0,0),   P1[6],P1[7],P1[8],P1[9],     pw2[2]=PKW(P1,4), pw2[3]=PKW(P1,6), pw2); \
    VRD(3); SBAR(); GAPA(C0=__builtin_amdgcn_mfma_f32_32x32x16_bf16(kf[6],qr[3],C0,0,0,0),   P1[10],P1[11],P1[12],P1[13], pw3[0]=PKW(P1,8), pw3[1]=PKW(P1,10), pw3); \
    VRD(7); SBAR(); GAPA(C1=__builtin_amdgcn_mfma_f32_32x32x16_bf16(kf[7],qr[3],C1,0,0,0),   P1[14],P1[15],0.f,0.f,       pw3[2]=PKW(P1,12),pw3[3]=PKW(P1,14), pw3); \
    l_reg+=sacc; \
    if(GK){DMA_K((t)+3,sl_cur);} if(GV){DMA_V((t)+1,sl_next);} \
    SBAR(); \
    GAPB(o[0]=__builtin_amdgcn_mfma_f32_32x32x16_bf16(PAF(0),VFR(0),o[0],0,0,0), C0,0); \
    GAPB(o[1]=__builtin_amdgcn_mfma_f32_32x32x16_bf16(PAF(0),VFR(4),o[1],0,0,0), C0,4); \
    KRD(GL,0); GAPB(o[0]=__builtin_amdgcn_mfma_f32_32x32x16_bf16(PAF(1),VFR(1),o[0],0,0,0), C0,8); \
    KRD(GL,1); GAPB(o[1]=__builtin_amdgcn_mfma_f32_32x32x16_bf16(PAF(1),VFR(5),o[1],0,0,0), C0,12); \
    KRD(GL,2); GAPB(o[0]=__builtin_amdgcn_mfma_f32_32x32x16_bf16(PAF(2),VFR(2),o[0],0,0,0), C1,0); \
    KRD(GL,3); GAPB(o[1]=__builtin_amdgcn_mfma_f32_32x32x16_bf16(PAF(2),VFR(6),o[1],0,0,0), C1,4); \
    GAPB(o[0]=__builtin_amdgcn_mfma_f32_32x32x16_bf16(PAF(3),VFR(3),o[0],0,0,0), C1,8); \
    GAPB(o[1]=__builtin_amdgcn_mfma_f32_32x32x16_bf16(PAF(3),VFR(7),o[1],0,0,0), C1,12); \
    }while(0)
  int t=1;
  for(;t+5<NT;t+=2){
    STEP(pB0,pB1,pA0,pA1,t,true,true,true);     WAIT_BAR(2); RESC(); ROT();
    STEP(pA0,pA1,pB0,pB1,t+1,true,true,true);   WAIT_BAR(2); RESC(); ROT();
  }
  #define ENDW(tt) do{ if((tt)+3<NT){WAIT_BAR(2);} else if((tt)+2<NT){WAIT_BAR(1);} else {WAIT_BAR(0);} }while(0)
  for(;t+1<NT;t+=2){
    STEP(pB0,pB1,pA0,pA1,t,(t+3<NT),(t+1<NT),(t+1<NT));       ENDW(t);   RESC(); ROT();
    STEP(pA0,pA1,pB0,pB1,t+1,(t+4<NT),(t+2<NT),(t+2<NT));     ENDW(t+1); RESC(); ROT();
  }
  STEP(pB0,pB1,pA0,pA1,NT-1,false,false,false); RESC();
  { float sacc=pB0[0]+pB0[1]; _Pragma("unroll") for(int r=2;r<16;++r)sacc+=pB0[r]; _Pragma("unroll") for(int r=0;r<16;++r)sacc+=pB1[r]; l_reg+=sacc;
    pw0=(u32x4){PKW(pB0,0),PKW(pB0,2),PKW(pB0,4),PKW(pB0,6)};pw1=(u32x4){PKW(pB0,8),PKW(pB0,10),PKW(pB0,12),PKW(pB0,14)};pw2=(u32x4){PKW(pB1,0),PKW(pB1,2),PKW(pB1,4),PKW(pB1,6)};pw3=(u32x4){PKW(pB1,8),PKW(pB1,10),PKW(pB1,12),PKW(pB1,14)};
    SBAR(); pv(o,vb0+sl_cur,PAF(0),PAF(1),PAF(2),PAF(3)); }
  #undef PKW
  #undef PAF
  #undef VFR
  #undef PIN
  #undef MX3
  #undef GAPA
  #undef GAPB
  #undef EX
  #undef VRD
  #undef KRD
  #undef STEP
  #undef ENDW
  {auto rr=__builtin_amdgcn_permlane32_swap(__float_as_uint(l_reg),__float_as_uint(l_reg),false,false);l_reg=__uint_as_float(rr[0])+__uint_as_float(rr[1]);}
  if(hi==0)wsf[32+r32]=l_reg;asm volatile("s_waitcnt lgkmcnt(0)":::"memory");
  float rli[16];
  #pragma unroll
  for(int r=0;r<16;++r)rli[r]=__builtin_amdgcn_rcpf(wsf[32+crow(r,hi)]);
  bf16*Ow=O+(rowbase+q0+wid*QBLK)*OP+OCOL+h*D;
  { bf16*stg=(bf16*)(shm+LDS_OST)+wid*2048;
    #pragma unroll
    for(int r=0;r<16;++r){const int orow=crow(r,hi);
      #pragma unroll
      for(int d0=0;d0<2;++d0)stg[orow*64+d0*32+r32]=__float2bfloat16(o[d0][r]*rli[r]);}
    asm volatile("s_waitcnt lgkmcnt(0)":::"memory");
    #pragma unroll
    for(int i=0;i<4;++i){const int row=i*8+(lane>>3),ch=lane&7; const u32x4 v=*(const u32x4*)(stg+row*64+ch*8); ATTN_STORE16(Ow+(long)row*OP+ch*8,v);} }
  asm volatile("s_waitcnt lgkmcnt(0)\n\ts_barrier":::"memory");
  #undef DMA_K
  #undef DMA_V
  #undef START
  #undef RESC
  #undef ROT
}
constexpr int ATTN_LDS_BYTES=LDS_BYTES;
#undef SBAR
#undef WAIT_BAR
}
constexpr int NWAVES = 8;
constexpr int BATCH = 8, SEQ = 4096, DM = 1024, T = BATCH * SEQ;
constexpr int GLA_H = 4, GLA_DK = 64, GLA_DV = 128, GLA_RANK = 16;
constexpr int ATT_H = 8, ATT_KVH = 2, ATT_DH = 64;
constexpr int D_IN = 2336, D_IN_PAD = 2560;
constexpr int NEXP = 32, TOPK = 4, DFF = 1024;
constexpr int EROWS = 32768;
constexpr int PROWS = T * TOPK + NEXP * 256;
constexpr float EPS = 1e-6f;
constexpr float YSCALE = 16.f;
constexpr float WSCALE = 32.f, ASCALE = 4.f;

constexpr size_t MiB = 1u << 20;
constexpr size_t WS_CTL = 0, CTL_ZERO_BYTES = 1 * MiB;
constexpr size_t WS_WRH = 1 * MiB, WS_WRL = WS_WRH + 65536;
constexpr size_t WS_WIN = 2 * MiB;
constexpr size_t WS_WOUT = 8 * MiB;
constexpr size_t WS_W1 = 10 * MiB;
constexpr size_t WS_W2 = 138 * MiB;
constexpr size_t WS_ROWTOK = 202 * MiB;
constexpr size_t WS_ROWGATE = 206 * MiB;
constexpr size_t WS_TOKASG = 210 * MiB;
constexpr size_t WS_REGY = 212 * MiB;
constexpr size_t WS_XN = WS_REGY;
constexpr size_t WS_GQ = WS_XN + 64 * MiB;
constexpr size_t WS_GK = WS_GQ + 16 * MiB;
constexpr size_t WS_GV = WS_GK + 16 * MiB;
constexpr size_t WS_GR = WS_GV + 32 * MiB;
constexpr size_t WS_AQ = WS_GR + 32 * MiB;
constexpr size_t WS_AK = WS_AQ + 32 * MiB;
constexpr size_t WS_AV = WS_AK + 8 * MiB;
constexpr size_t WS_Z = WS_AV + 8 * MiB;
constexpr size_t WS_OF = WS_Z + 2 * MiB;
constexpr size_t WS_Y = WS_REGY;
constexpr size_t WS_REGA = WS_REGY + 274 * MiB;
constexpr size_t WS_MIX = WS_REGA;
constexpr size_t WS_ACT = WS_REGA;
constexpr size_t WS_QF = WS_REGA + 272 * MiB, WS_KF = WS_QF + 16 * MiB, WS_QB = WS_KF + 16 * MiB, WS_KB = WS_QB + 16 * MiB;
constexpr size_t WS_DEC = WS_KB + 16 * MiB;
constexpr size_t WS_END = WS_DEC + 1 * MiB;
static_assert(WS_OF + (size_t)T * 512 * 4 <= WS_REGA && (size_t)PROWS * 1024 * 2 <= 272 * MiB, "d_ws map");
constexpr int CW_BAR = 4096;
constexpr int CW_CNT = 8192;
constexpr int CW_CONV = 20480;
constexpr int CW_GDN = 16384;
constexpr int CW_QUE = 12288;

constexpr int SCR_BYTES = 133120;
constexpr int LC_OFF = SCR_BYTES;
constexpr int LC_MISC = LC_OFF;
constexpr int LC_CNT = LC_OFF + 128;
constexpr int LC_CST = LC_CNT + 128;
constexpr int LC_TE = LC_CST + 256;
constexpr int LC_HIST = LC_TE + 1152;
constexpr int LC_BASE = LC_HIST + 128;
constexpr int LC_ASG = LC_BASE + 128;
constexpr int LC_GDEC = LC_ASG + 8192;
constexpr int LC_END = LC_GDEC + 512;
constexpr int LDS_BYTES = 147456;
static_assert(LC_END <= LDS_BYTES, "LDS map");

typedef unsigned short bf16;
typedef unsigned v4u __attribute__((ext_vector_type(4)));
typedef unsigned v2u __attribute__((ext_vector_type(2)));
typedef float f32x4 __attribute__((ext_vector_type(4)));
typedef short bf16x8 __attribute__((ext_vector_type(8)));
typedef GAS unsigned gu32;
#define RLX_AGENT __ATOMIC_RELAXED, __HIP_MEMORY_SCOPE_AGENT
#define LDS_WAIT() asm volatile("s_waitcnt lgkmcnt(0)" ::: "memory")
#define VM_WAIT() asm volatile("s_waitcnt vmcnt(0)" ::: "memory")
__device__ __forceinline__ unsigned f2bf(float f) { unsigned u = __builtin_bit_cast(unsigned, f); return (u + 0x7fffu + ((u >> 16) & 1u)) >> 16; }
__device__ __forceinline__ unsigned pk2(float lo, float hi) { return f2bf(lo) | (f2bf(hi) << 16); }
__device__ __forceinline__ float bf2f(unsigned h) { return __builtin_bit_cast(float, h << 16); }
__device__ __forceinline__ float bflo(unsigned w) { return __builtin_bit_cast(float, w << 16); }
__device__ __forceinline__ float bfhi(unsigned w) { return __builtin_bit_cast(float, w & 0xffff0000u); }

#define XB_TMO      128
#define XB_XCNT(j)  (256  + 64 * (j))
#define XB_XSUB(j)  (1280 + 64 * (j))
#define XB_XGEN(j)  (2304 + 64 * (j))
#define XB_TOP      3328
#define XB_TOPGEN   3392
#define XCD_BAR_WORDS 3456
#define XB_SPIN_CAP (1u << 18)
__device__ __forceinline__ unsigned xb_ld(unsigned* p)              { return __hip_atomic_load(p, __ATOMIC_RELAXED, __HIP_MEMORY_SCOPE_AGENT); }
__device__ __forceinline__ unsigned xb_add(unsigned* p, unsigned v) { return __hip_atomic_fetch_add(p, v, __ATOMIC_RELAXED, __HIP_MEMORY_SCOPE_AGENT); }
__device__ __forceinline__ unsigned xb_xcc_id() { return (unsigned)__builtin_amdgcn_s_getreg((3 << 11) | 20) & 0xFu; }
#define XB_SPIN(cond, bar) do { unsigned _sp = 0; while (cond) { __builtin_amdgcn_s_sleep(1); \
    if ((++_sp & 255u) == 0u) { if (xb_ld(&(bar)[XB_TMO])) break; if (_sp > XB_SPIN_CAP) { atomicAdd(&(bar)[XB_TMO], 1u); break; } } } } while (0)
struct XcdBarrier { unsigned* bar; unsigned x; volatile LAS unsigned* st; };
__device__ __forceinline__ XcdBarrier xcd_barrier_post(unsigned* bar, volatile LAS unsigned* st) {
    XcdBarrier b; b.bar = bar; b.x = xb_xcc_id(); b.st = st;
    if (threadIdx.x == 0) (void)xb_add(&bar[XB_XCNT(b.x)], 1u);
    return b;
}
__device__ __forceinline__ void xcd_barrier_complete(unsigned* bar, unsigned x, unsigned& nloc, unsigned& nx) {
    const unsigned G = gridDim.x * gridDim.y * gridDim.z;
    unsigned sum, cnt, mine, sp = 0u;
    for (;;) {
        sum = 0u; cnt = 0u; mine = 0u;
#pragma unroll
        for (unsigned j = 0; j < 16; ++j) { const unsigned c = xb_ld(&bar[XB_XCNT(j)]); sum += c; cnt += (c > 0u) ? 1u : 0u; mine = (j == x) ? c : mine; }
        if (sum == G) break;
        __builtin_amdgcn_s_sleep(1);
        if ((++sp & 255u) == 0u) { if (xb_ld(&bar[XB_TMO])) break; if (sp > XB_SPIN_CAP) { atomicAdd(&bar[XB_TMO], 1u); break; } }
    }
    nloc = mine > 0u ? mine : 1u; nx = cnt > 0u ? cnt : 1u;
}
__device__ __forceinline__ void xcd_barrier(const XcdBarrier& b) {
    asm volatile("s_waitcnt vmcnt(0)" ::: "memory");
    __syncthreads();
    if (threadIdx.x == 0) {
        unsigned* bar = b.bar;
        __builtin_amdgcn_s_waitcnt(0);
        unsigned nloc = b.st[0], nx = b.st[1];
        if (nloc == 0u) { xcd_barrier_complete(bar, b.x, nloc, nx); b.st[0] = nloc; b.st[1] = nx; }
        const unsigned old = xb_add(&bar[XB_XSUB(b.x)], 1u);
        const unsigned gen = old / nloc;
        if (old + 1u == (gen + 1u) * nloc) {
            __builtin_amdgcn_fence(__ATOMIC_RELEASE, "agent");
            asm volatile("s_waitcnt vmcnt(0)" ::: "memory");
            const unsigned og = xb_add(&bar[XB_TOP], 1u);
            const unsigned tg = og / nx;
            if (og + 1u == (tg + 1u) * nx) xb_add(&bar[XB_TOPGEN], 1u);
            else XB_SPIN(xb_ld(&bar[XB_TOPGEN]) == tg, bar);
            __builtin_amdgcn_fence(__ATOMIC_ACQUIRE, "agent");
            xb_add(&bar[XB_XGEN(b.x)], 1u);
            asm volatile("s_waitcnt vmcnt(0)" ::: "memory");
        } else {
            XB_SPIN(xb_ld(&bar[XB_XGEN(b.x)]) == gen, bar);
            __builtin_amdgcn_fence(__ATOMIC_ACQUIRE, "agent");
            asm volatile("s_waitcnt vmcnt(0)" ::: "memory");
        }
    }
    __syncthreads();
}

struct Frame {
    LAS unsigned char* lds;
    volatile LAS unsigned* MISC;
    gu32* ctl;
    int tid, lane, wave;
    int vcu, G;
    unsigned char* ws;
    const float *x, *mix_g, *w_in, *w_gf, *b_gf, *w_gb, *b_gb, *gla_hg, *q_g, *k_g, *w_out, *ffn_g, *w_router, *b_router, *w1, *b1, *w2, *b2, *fin_g;
    float* out;
};
__device__ __forceinline__ float wave_sum(float v) {
#pragma unroll
    for (int o = 1; o < 64; o <<= 1) v += __shfl_xor(v, o);
    return v;
}
__device__ __forceinline__ void p0_tr64(const float* src  , int ldw, bf16* d0, bf16* d1, int ldt, LAS float* scr, int lane, int ncols) {
    const int c4 = (lane & 15) * 4, kr = lane >> 4;
    if (c4 < ncols) {
#pragma unroll 4
        for (int i = 0; i < 16; ++i) { const int kk = kr + 4 * i; const f32x4 v = *(const GAS f32x4*)(src + (size_t)kk * ldw + c4);
            LAS float* s = scr + kk * 65 + c4; s[0] = v.x; s[1] = v.y; s[2] = v.z; s[3] = v.w; }
    }
    LDS_WAIT(); asm volatile("" ::: "memory");
    const int c = lane & 7;
#pragma unroll
    for (int j = 0; j < 8; ++j) { const int n = (lane >> 3) + 8 * j;
        if (n < ncols) { const LAS float* s = scr + (8 * c) * 65 + n;
            v4u o; o.x = pk2(s[0 * 65], s[1 * 65]); o.y = pk2(s[2 * 65], s[3 * 65]); o.z = pk2(s[4 * 65], s[5 * 65]); o.w = pk2(s[6 * 65], s[7 * 65]);
            bf16* rowp = (n < 32 ? d0 : d1) + (size_t)(n & 31) * ldt;
            *(GAS v4u*)(rowp + 8 * c) = o; } }
    LDS_WAIT(); asm volatile("" ::: "memory");
}
struct F8Item { const float* src; int ldw; unsigned char* d0; unsigned char* d1; };
__device__ __forceinline__ void f8_load(const F8Item& it, f32x4 (&v)[16], int lane) {
    const int c4 = (lane & 15) * 4, kr = lane >> 4;
#pragma unroll
    for (int i = 0; i < 16; ++i) v[i] = __builtin_nontemporal_load((const GAS f32x4*)(it.src + (size_t)(kr + 4 * i) * it.ldw + c4));
}
__device__ __forceinline__ void f8_finish(const F8Item& it, const f32x4 (&v)[16], LAS float* scr, int lane, float sc) {
    const int c4 = (lane & 15) * 4, kr = lane >> 4;
#pragma unroll
    for (int i = 0; i < 16; ++i) { LAS float* s = scr + (kr + 4 * i) * 65 + c4; s[0] = v[i].x; s[1] = v[i].y; s[2] = v[i].z; s[3] = v[i].w; }
    LDS_WAIT(); asm volatile("" ::: "memory");
    const int c = lane & 7;
#pragma unroll
    for (int j = 0; j < 8; ++j) { const int n = (lane >> 3) + 8 * j; const LAS float* s = scr + (8 * c) * 65 + n;
        int w0 = 0, w1 = 0;
        w0 = __builtin_amdgcn_cvt_pk_fp8_f32(s[0 * 65] * sc, s[1 * 65] * sc, w0, false); w0 = __builtin_amdgcn_cvt_pk_fp8_f32(s[2 * 65] * sc, s[3 * 65] * sc, w0, true);
        w1 = __builtin_amdgcn_cvt_pk_fp8_f32(s[4 * 65] * sc, s[5 * 65] * sc, w1, false); w1 = __builtin_amdgcn_cvt_pk_fp8_f32(s[6 * 65] * sc, s[7 * 65] * sc, w1, true);
        unsigned char* rowp = (n < 32 ? it.d0 : it.d1) + (size_t)(n & 31) * 1024;
        __builtin_nontemporal_store((v2u){(unsigned)w0, (unsigned)w1}, (GAS v2u*)(rowp + 8 * c)); }
    LDS_WAIT(); asm volatile("" ::: "memory");
}
__device__ __forceinline__ int win_pblk(int lb) { return lb < 48 ? lb : (lb == 48 ? 72 : lb - 1); }
__device__ __forceinline__ int w1_pblk(int lb) { return lb < 32 ? (lb >> 2) * 8 + (lb & 3) : ((lb - 32) >> 2) * 8 + 4 + ((lb - 32) & 3); }
__device__ __forceinline__ void rms_row_to_bf16(const float* xrow, const float* g, bf16* orow, int lane) {
    const GAS f32x4* xr = (const GAS f32x4*)xrow + lane; const GAS f32x4* gr = (const GAS f32x4*)g + lane;
    f32x4 v[4]; float s = 0.f;
#pragma unroll
    for (int j = 0; j < 4; ++j) { v[j] = __builtin_nontemporal_load(xr + 64 * j); s += (v[j].x * v[j].x + v[j].y * v[j].y) + (v[j].z * v[j].z + v[j].w * v[j].w); }
    const float rinv = 1.f / sqrtf(wave_sum(s) * (1.f / 1024.f) + EPS);
    GAS unsigned long long* o8 = (GAS unsigned long long*)orow + lane;
#pragma unroll
    for (int j = 0; j < 4; ++j) { const f32x4 gg = gr[64 * j];
        o8[64 * j] = (unsigned long long)pk2(v[j].x * rinv * gg.x, v[j].y * rinv * gg.y) | ((unsigned long long)pk2(v[j].z * rinv * gg.z, v[j].w * rinv * gg.w) << 32); }
}
__device__ __forceinline__ F8Item f8_item(Frame& F, int r) {
    F8Item it;
    if (r < NEXP * 512) { const int e = r / 512, q = r % 512, kb = q / 32, nb = q % 32; it.src = F.w1 + (size_t)e * 1024 * 2048 + (size_t)(64 * kb) * 2048 + 64 * nb; it.ldw = 2048;
        unsigned char* dst = F.ws + WS_W1 + (size_t)e * 2048 * 1024 + 64 * kb; it.d0 = dst + (size_t)(32 * w1_pblk(2 * nb)) * 1024; it.d1 = dst + (size_t)(32 * w1_pblk(2 * nb + 1)) * 1024; }
    else { const int r2 = r - NEXP * 512, e = r2 / 256, q = r2 % 256, kb = q / 16, nb = q % 16; it.src = F.w2 + (size_t)e * 1024 * 1024 + (size_t)(64 * kb) * 1024 + 64 * nb; it.ldw = 1024;
        unsigned char* dst = F.ws + WS_W2 + (size_t)e * 1024 * 1024 + 64 * kb; it.d0 = dst + (size_t)(64 * nb) * 1024; it.d1 = dst + (size_t)(64 * nb + 32) * 1024; }
    return it;
}
constexpr int N_F8_ITEMS = NEXP * 512 + NEXP * 256, N_CONV_BATCH = N_F8_ITEMS / 64;
__device__ __forceinline__ void f8_items(Frame& F, int r, int step, int rend, LAS float* scr) {
    if (r >= rend) return;
    F8Item cur = f8_item(F, r); f32x4 va[16], vb[16];
    f8_load(cur, va, F.lane);
    for (;;) {
        int rn = r + step; F8Item nx = cur; if (rn < rend) { nx = f8_item(F, rn); f8_load(nx, vb, F.lane); }
        f8_finish(cur, va, scr, F.lane, WSCALE);
        if (rn >= rend) break;
        r = rn + step; cur = nx; if (r < rend) { cur = f8_item(F, r); f8_load(cur, va, F.lane); }
        f8_finish(nx, vb, scr, F.lane, WSCALE);
        if (r >= rend) break;
    }
}
__device__ __forceinline__ bool conv_pull(Frame& F) {
    __syncthreads();
    if (F.tid == 0) F.MISC[17] = __hip_atomic_fetch_add(F.ctl + CW_CONV, 1u, RLX_AGENT);
    __syncthreads();
    const int cb = __builtin_amdgcn_readfirstlane((int)F.MISC[17]);
    if (cb >= N_CONV_BATCH) return false;
    f8_items(F, cb * 64 + F.wave * 8, 1, cb * 64 + F.wave * 8 + 8, (LAS float*)(F.lds + F.wave * 16640));
    return true;
}
__device__ __forceinline__ void p0_prologue(Frame& F) {
    LAS float* scr = (LAS float*)(F.lds + F.wave * 16640);
    const int gw = F.vcu * NWAVES + F.wave, NGW = F.G * NWAVES;
    bf16* WIN = (bf16*)(F.ws + WS_WIN); bf16* WOUT = (bf16*)(F.ws + WS_WOUT);
    constexpr int I_IN = 16 * 37, I_OUT = 16 * 16, NITEMS = I_IN + I_OUT;
    for (int it = gw; it < NITEMS; it += NGW) {
        int r = it;
        if (r < I_IN) { const int kb = r / 37, nb = r % 37; const int lb0 = 2 * nb, nc = (nb == 36) ? 32 : 64;
            p0_tr64(F.w_in + (size_t)(64 * kb) * D_IN + 64 * nb, D_IN, WIN + (size_t)(32 * win_pblk(lb0)) * 1024 + 64 * kb, WIN + (size_t)(32 * win_pblk(lb0 + 1 < 73 ? lb0 + 1 : lb0)) * 1024 + 64 * kb, 1024, scr, F.lane, nc); continue; }
        r -= I_IN;
        { const int kb = r / 16, nb = r % 16;
            p0_tr64(F.w_out + (size_t)(64 * kb) * 1024 + 64 * nb, 1024, WOUT + (size_t)(64 * nb) * 1024 + 64 * kb, WOUT + (size_t)(64 * nb + 32) * 1024 + 64 * kb, 1024, scr, F.lane, 64); }
    }
    { const int gt = F.vcu * (NWAVES * 64) + F.tid, NGT = F.G * NWAVES * 64; GAS v4u* z = (GAS v4u*)(WIN + (size_t)D_IN * 1024);
      for (int i = gt; i < (D_IN_PAD - D_IN) * 1024 * 2 / 16; i += NGT) z[i] = (v4u){0u, 0u, 0u, 0u};
      bf16* WRH = (bf16*)(F.ws + WS_WRH); bf16* WRL = (bf16*)(F.ws + WS_WRL);
      for (int i = gt; i < NEXP * 1024; i += NGT) { const int e = i >> 10, k = i & 1023; const float w = F.w_router[(size_t)k * NEXP + e]; const unsigned h = f2bf(w); WRH[i] = (bf16)h; WRL[i] = (bf16)f2bf(w - bf2f(h)); } }
    bf16* XN = (bf16*)(F.ws + WS_XN);
    for (int m = gw; m < T; m += NGW) rms_row_to_bf16(F.x + (size_t)m * DM, F.mix_g, XN + (size_t)m * DM, F.lane);
}

__device__ __forceinline__ void p2_normrope(Frame& F) {
    LAS float* cs = (LAS float*)F.lds;
    for (int i = F.tid; i < 1024; i += NWAVES * 64) { const int pos = i >> 4, fi = i & 15; const float inv = exp2f(-(float)fi * (13.287712379549449f / 16.f)); const float a = (float)pos * inv;
        cs[2 * i] = __cosf(a); cs[2 * i + 1] = __sinf(a); }
    __syncthreads();
    const int gw = F.vcu * NWAVES + F.wave, NGW = F.G * NWAVES, lane = F.lane;
    const int j = lane & 7, blk = (j >> 2) & 1, jj = j & 3, fi0 = 8 * (jj & 1); const bool second = (jj >> 1) != 0;
    float gq[8], gk[8];
#pragma unroll
    for (int e = 0; e < 8; ++e) { gq[e] = F.q_g[8 * j + e]; gk[e] = F.k_g[8 * j + e]; }
    bf16* AQ = (bf16*)(F.ws + WS_AQ); bf16* AK = (bf16*)(F.ws + WS_AK);
    for (int it = T + gw; it < T + T / 4; it += NGW) {
        const bool isq = it < T;
        const int tok = isq ? it : 4 * (it - T) + (lane >> 4);
        GAS v4u* p = isq ? (GAS v4u*)(AQ + (size_t)tok * 512) + lane : (GAS v4u*)(AK + (size_t)tok * 128) + (lane & 15);
        const v4u w = *p;
        float x[8] = {bflo(w.x), bfhi(w.x), bflo(w.y), bfhi(w.y), bflo(w.z), bfhi(w.z), bflo(w.w), bfhi(w.w)};
        float ss = 0.f;
#pragma unroll
        for (int e = 0; e < 8; ++e) ss += x[e] * x[e];
        ss += __shfl_xor(ss, 1); ss += __shfl_xor(ss, 2); ss += __shfl_xor(ss, 4);
        const float rinv = 1.f / sqrtf(ss * (1.f / 64.f) + EPS);
        const int ts = tok & (SEQ - 1), pos = blk ? (ts & 63) : (ts >> 6);
        const LAS float* c = cs + (pos * 16 + fi0) * 2;
        float y[8];
#pragma unroll
        for (int e = 0; e < 8; ++e) { x[e] = x[e] * rinv * (isq ? gq[e] : gk[e]); }
#pragma unroll
        for (int e = 0; e < 8; ++e) { const float pr = __shfl_xor(x[e], 2); const float co = c[2 * e], si = c[2 * e + 1]; y[e] = second ? (x[e] * co + pr * si) : (x[e] * co - pr * si); }
        const float sc = isq ? attn_body::C2 : 1.f;
        v4u o; o.x = pk2(y[0] * sc, y[1] * sc); o.y = pk2(y[2] * sc, y[3] * sc); o.z = pk2(y[4] * sc, y[5] * sc); o.w = pk2(y[6] * sc, y[7] * sc);
        *p = o;
    }
}
namespace gla {
typedef short bf16x8 __attribute__((ext_vector_type(8)));
typedef short s16x4 __attribute__((ext_vector_type(4)));
typedef float f32x4 __attribute__((ext_vector_type(4)));
constexpr int P64 = 144, PV = 272, POT = 528;
constexpr int L_QS = 0, L_KS = 9216, L_VR = 18432, L_AS = 35840, L_ST = 45056, L_OT = 63488, L_SET2 = 97280, L_END = 133120;
constexpr int L_DEC = LC_GDEC;
__device__ __forceinline__ unsigned cvtpk(float lo, float hi) { typedef float f2_t __attribute__((ext_vector_type(2))); typedef __bf16 b2_t __attribute__((ext_vector_type(2))); f2_t v = {lo, hi}; b2_t b = __builtin_convertvector(v, b2_t); return __builtin_bit_cast(unsigned, b); }
__device__ __forceinline__ float logsig(float x) { return fminf(x, 0.f) - __logf(1.f + __expf(-fabsf(x))); }
__device__ __forceinline__ s16x4 vtr(const LAS unsigned char* p) { typedef short v4i16_t __attribute__((ext_vector_type(4))); return __builtin_bit_cast(s16x4, __builtin_amdgcn_ds_read_tr16_b64_v4i16((LAS v4i16_t*)p)); }

__device__ __forceinline__ void gla_prep_unit(Frame& F, int b, int c) {
    LAS unsigned char* L = F.lds;
    const int tid = F.tid, dir = __builtin_amdgcn_readfirstlane(tid >> 8), col = tid & 255;
    const bf16* GQ = (const bf16*)(F.ws + WS_GQ); const bf16* GK = (const bf16*)(F.ws + WS_GK); const bf16* ZZ = (const bf16*)(F.ws + WS_Z);
    bf16* QX = (bf16*)(F.ws + (dir ? WS_QB : WS_QF)); bf16* KX = (bf16*)(F.ws + (dir ? WS_KB : WS_KF)); float* DEC = (float*)(F.ws + WS_DEC) + (size_t)dir * (BATCH * 64 * 256);
    const unsigned row0 = (unsigned)b * SEQ + (unsigned)c * 64u;
    __syncthreads();
    if (tid < 256) { const int row = tid >> 2, seg = tid & 3; const v4u z = *(const GAS v4u*)(ZZ + (row0 + row) * 32 + seg * 8); LAS f32x4* zp = (LAS f32x4*)(L + row * 128 + seg * 32);
        zp[0] = (f32x4){bflo(z.x), bfhi(z.x), bflo(z.y), bfhi(z.y)}; zp[1] = (f32x4){bflo(z.z), bfhi(z.z), bflo(z.w), bfhi(z.w)}; }
    float wg[16]; const float* WG = dir ? F.w_gb : F.w_gf;
#pragma unroll
    for (int r = 0; r < 16; ++r) wg[r] = WG[r * 256 + col];
    const float bgv = (dir ? F.b_gb : F.b_gf)[col];
    __syncthreads();
    float pf[64]; float run = 0.f;
#pragma unroll
    for (int p = 0; p < 64; ++p) { const LAS f32x4* zp = (const LAS f32x4*)(L + p * 128 + dir * 64); float pre = bgv;
#pragma unroll
        for (int r4 = 0; r4 < 4; ++r4) { const f32x4 z = zp[r4]; pre += z.x * wg[4 * r4] + z.y * wg[4 * r4 + 1] + z.z * wg[4 * r4 + 2] + z.w * wg[4 * r4 + 3]; }
        run += logsig(pre) * (1.f / 16.f); pf[p] = run; }
    const float tot = run;
#pragma unroll
    for (int p = 0; p < 64; ++p) { const unsigned idx = (row0 + p) * 256 + col;
        const float qv = bf2f(GQ[idx]), kv = bf2f(GK[idx]);
        const float ex = dir ? (p ? pf[p - 1] : 0.f) : 0.f;
        const float eq = dir ? __expf(-ex) * 0.125f : __expf(pf[p] - tot) * 0.125f;
        const float ek = dir ? __expf(ex) : __expf(tot - pf[p]);
        QX[idx] = (bf16)f2bf(qv * eq); KX[idx] = (bf16)f2bf(kv * ek); }
    DEC[((unsigned)b * 64 + c) * 256 + col] = __expf(tot);
}

__device__ __forceinline__ void gla_unit(Frame& F, int b, int h, int dir) {
    LAS unsigned char* L = F.lds;
    const int tid = F.tid, lane = F.lane, w = F.wave, q4 = lane >> 4, l15 = lane & 15;
    const bf16* GV = (const bf16*)(F.ws + WS_GV);
    bf16* OX = (bf16*)(F.ws + WS_OF + (dir ? 32 * MiB : 0));
    const unsigned rowbase = (unsigned)b * SEQ;
    const int v0 = 16 * w;
    const int erow = tid >> 3, eseg = tid & 7;
    const int plq = tid >> 3, sgq = tid & 7, plv = tid >> 4, sgv = tid & 15;
    {
        const bf16* QX = (const bf16*)(F.ws + (dir ? WS_QB : WS_QF)); const bf16* KX = (const bf16*)(F.ws + (dir ? WS_KB : WS_KF));
        const float* DEC = (const float*)(F.ws + WS_DEC) + (size_t)dir * (BATCH * 64 * 256);
        f32x4 S[4];
#pragma unroll
        for (int i = 0; i < 4; ++i) S[i] = (f32x4){0.f, 0.f, 0.f, 0.f};
        v4u rq, rk, rv0, rv1; float rdec = 0.f;
#define GLA_LOAD(ci) do { const int c_ = dir ? 63 - (ci) : (ci); const unsigned cb_ = rowbase + (unsigned)c_ * 64u; \
            rq = __builtin_nontemporal_load((const GAS v4u*)(QX + (cb_ + plq) * 256 + h * 64 + sgq * 8)); rk = __builtin_nontemporal_load((const GAS v4u*)(KX + (cb_ + plq) * 256 + h * 64 + sgq * 8)); \
            rv0 = *(const GAS v4u*)(GV + (cb_ + plv) * 512 + h * 128 + sgv * 8); rv1 = *(const GAS v4u*)(GV + (cb_ + plv + 32) * 512 + h * 128 + sgv * 8); \
            if (tid < 64) rdec = DEC[((unsigned)b * 64 + c_) * 256 + h * 64 + tid]; } while (0)
        GLA_LOAD(0);
        v4u st0 = (v4u){0u, 0u, 0u, 0u}, st1 = st0;
#define GLA_FLUSH(cprev) do { const unsigned cbp_ = rowbase + (unsigned)(cprev) * 64u; GAS v4u* sp_ = (GAS v4u*)(OX + (cbp_ + erow) * 512 + h * 128 + eseg * 16); sp_[0] = st0; sp_[1] = st1; } while (0)
#define GLA_STAGE(so) do { *(LAS v4u*)(L + (so) + L_QS + plq * P64 + sgq * 16) = rq; *(LAS v4u*)(L + (so) + L_KS + plq * P64 + sgq * 16) = rk; \
            *(LAS v4u*)(L + (so) + L_VR + plv * PV + sgv * 16) = rv0; *(LAS v4u*)(L + (so) + L_VR + (plv + 32) * PV + sgv * 16) = rv1; \
            if (tid < 64) ((LAS float*)(L + L_DEC))[((so) ? 64 : 0) + tid] = rdec; } while (0)
        __syncthreads();
        GLA_STAGE(0); GLA_LOAD(1);
        __syncthreads();
        for (int ci = 0; ci < 64; ++ci) {
            const int c = dir ? 63 - ci : ci; const int so = (ci & 1) ? L_SET2 : 0, sn = (ci & 1) ? 0 : L_SET2;
#pragma unroll
            for (int s = 0; s < 2; ++s) { const int tt = 2 * w + s, it = tt >> 2, jt = tt & 3; f32x4 a = (f32x4){0.f, 0.f, 0.f, 0.f};
                if (dir ? (jt >= it) : (jt <= it)) {
#pragma unroll
                    for (int ks = 0; ks < 2; ++ks) { const bf16x8 af = *(const LAS bf16x8*)(L + so + L_QS + (16 * it + l15) * P64 + (32 * ks + 8 * q4) * 2); const bf16x8 bfr = *(const LAS bf16x8*)(L + so + L_KS + (16 * jt + l15) * P64 + (32 * ks + 8 * q4) * 2);
                        a = __builtin_amdgcn_mfma_f32_16x16x32_bf16(af, bfr, a, 0, 0, 0); } }
#pragma unroll
                for (int rg = 0; rg < 4; ++rg) { const int i = 16 * it + 4 * q4 + rg, j = 16 * jt + l15; const bool keep = dir ? (j > i) : (j <= i);
                    *(LAS unsigned short*)(L + L_AS + i * P64 + j * 2) = (unsigned short)cvtpk(keep ? a[rg] : 0.f, 0.f); } }
#pragma unroll
            for (int dt = 0; dt < 4; ++dt) { const f32x4 dv = *(const LAS f32x4*)(L + L_DEC + ((ci & 1) ? 256 : 0) + (16 * dt + 4 * q4) * 4); S[dt] = S[dt] * dv;
                *(LAS v2u*)(L + L_ST + (v0 + l15) * P64 + (16 * dt + 4 * q4) * 2) = (v2u){cvtpk(S[dt].x, S[dt].y), cvtpk(S[dt].z, S[dt].w)}; }
            __syncthreads();
            bf16x8 bv[2], bs[2];
#pragma unroll
            for (int ks = 0; ks < 2; ++ks) { const LAS unsigned char* vp = L + so + L_VR + (32 * ks + 8 * q4 + (l15 >> 2)) * PV + (v0 + 4 * (l15 & 3)) * 2;
                const s16x4 lo = vtr(vp), hi = vtr(vp + 4 * PV); bv[ks] = (bf16x8){lo[0], lo[1], lo[2], lo[3], hi[0], hi[1], hi[2], hi[3]};
                bs[ks] = *(const LAS bf16x8*)(L + L_ST + (v0 + l15) * P64 + (32 * ks + 8 * q4) * 2); }
            f32x4 O[4];
#pragma unroll
            for (int it = 0; it < 4; ++it) { O[it] = (f32x4){0.f, 0.f, 0.f, 0.f};
#pragma unroll
                for (int ks = 0; ks < 2; ++ks) { const bf16x8 aq = *(const LAS bf16x8*)(L + so + L_QS + (16 * it + l15) * P64 + (32 * ks + 8 * q4) * 2);
                    if (dir ? !(ks == 0 && it >= 2) : !(ks == 1 && it < 2)) {
                        const bf16x8 aa = *(const LAS bf16x8*)(L + L_AS + (16 * it + l15) * P64 + (32 * ks + 8 * q4) * 2); O[it] = __builtin_amdgcn_mfma_f32_16x16x32_bf16(aa, bv[ks], O[it], 0, 0, 0); }
                    O[it] = __builtin_amdgcn_mfma_f32_16x16x32_bf16(aq, bs[ks], O[it], 0, 0, 0); } }
#pragma unroll
            for (int dt = 0; dt < 4; ++dt)
#pragma unroll
                for (int ks = 0; ks < 2; ++ks) { const LAS unsigned char* kp = L + so + L_KS + (32 * ks + 8 * q4 + (l15 >> 2)) * P64 + (16 * dt + 4 * (l15 & 3)) * 2;
                    const s16x4 lo = vtr(kp), hi = vtr(kp + 4 * P64); const bf16x8 ak = (bf16x8){lo[0], lo[1], lo[2], lo[3], hi[0], hi[1], hi[2], hi[3]};
                    S[dt] = __builtin_amdgcn_mfma_f32_16x16x32_bf16(ak, bv[ks], S[dt], 0, 0, 0); }
#pragma unroll
            for (int it = 0; it < 4; ++it)
#pragma unroll
                for (int rg = 0; rg < 4; ++rg) *(LAS float*)(L + L_OT + (16 * it + 4 * q4 + rg) * POT + (v0 + l15) * 4) = O[it][rg];
            if (ci + 1 < 64) GLA_STAGE(sn);
            asm volatile("" ::: "memory");
            if (ci > 0) GLA_FLUSH(dir ? c + 1 : c - 1);
            asm volatile("" ::: "memory");
            if (ci + 2 < 64) GLA_LOAD(ci + 2);
            __syncthreads();
            {
                float o[16];
#pragma unroll
                for (int e4 = 0; e4 < 4; ++e4) { const f32x4 t = *(const LAS f32x4*)(L + L_OT + erow * POT + (16 * eseg + 4 * e4) * 4); o[4 * e4] = t.x; o[4 * e4 + 1] = t.y; o[4 * e4 + 2] = t.z; o[4 * e4 + 3] = t.w; }
                st0 = (v4u){cvtpk(o[0], o[1]), cvtpk(o[2], o[3]), cvtpk(o[4], o[5]), cvtpk(o[6], o[7])}; st1 = (v4u){cvtpk(o[8], o[9]), cvtpk(o[10], o[11]), cvtpk(o[12], o[13]), cvtpk(o[14], o[15])};
            }
        }
        GLA_FLUSH(dir ? 0 : 63);
#undef GLA_STAGE
#undef GLA_FLUSH
#undef GLA_LOAD
    }
    VM_WAIT(); __syncthreads();
    if (tid == 0) { __builtin_amdgcn_fence(__ATOMIC_RELEASE, "agent"); VM_WAIT(); (void)__hip_atomic_fetch_add(F.ctl + CW_GDN + 64 * (b * GLA_H + h), 1u, RLX_AGENT); }
    __syncthreads();
}
__device__ __forceinline__ void gla_combine(Frame& F, int b, int h, int part) {
    const int tid = F.tid, erow = tid >> 3, eseg = tid & 7;
    if (tid == 0) { unsigned sp = 0; while (__hip_atomic_load(F.ctl + CW_GDN + 64 * (b * GLA_H + h), RLX_AGENT) < 2u && sp < (1u << 22)) { __builtin_amdgcn_s_sleep(8); ++sp; }
        __builtin_amdgcn_fence(__ATOMIC_ACQUIRE, "agent"); VM_WAIT(); }
    __syncthreads();
    const bf16* OF0 = (const bf16*)(F.ws + WS_OF); const bf16* OB0 = (const bf16*)(F.ws + WS_OF + 32 * MiB); const bf16* GR = (const bf16*)(F.ws + WS_GR); bf16* MIX = (bf16*)(F.ws + WS_MIX);
    float hg[16]; int eso = eseg; asm volatile("" : "+v"(eso));
#pragma unroll
    for (int e = 0; e < 16; ++e) hg[e] = F.gla_hg[16 * eso + e];
    const unsigned r0 = (unsigned)b * SEQ + (unsigned)part * 1024u + erow;
#pragma unroll 2
    for (int ps = 0; ps < 16; ++ps) { const unsigned row = r0 + ps * 64;
        const GAS v4u* fp = (const GAS v4u*)(OF0 + row * 512 + h * 128 + eseg * 16); const GAS v4u* bp = (const GAS v4u*)(OB0 + row * 512 + h * 128 + eseg * 16); const GAS v4u* rp = (const GAS v4u*)(GR + row * 512 + h * 128 + eseg * 16);
        const v4u f0 = __builtin_nontemporal_load(fp), f1 = __builtin_nontemporal_load(fp + 1), b0 = __builtin_nontemporal_load(bp), b1 = __builtin_nontemporal_load(bp + 1), r0v = __builtin_nontemporal_load(rp), r1v = __builtin_nontemporal_load(rp + 1);
        const unsigned fw[8] = {f0.x, f0.y, f0.z, f0.w, f1.x, f1.y, f1.z, f1.w}, bw[8] = {b0.x, b0.y, b0.z, b0.w, b1.x, b1.y, b1.z, b1.w}, rw[8] = {r0v.x, r0v.y, r0v.z, r0v.w, r1v.x, r1v.y, r1v.z, r1v.w};
        float o[16]; float ss = 0.f;
#pragma unroll
        for (int e2 = 0; e2 < 8; ++e2) { o[2 * e2] = bflo(fw[e2]) + bflo(bw[e2]); o[2 * e2 + 1] = bfhi(fw[e2]) + bfhi(bw[e2]); ss += o[2 * e2] * o[2 * e2] + o[2 * e2 + 1] * o[2 * e2 + 1]; }
        ss += __shfl_xor(ss, 1); ss += __shfl_xor(ss, 2); ss += __shfl_xor(ss, 4);
        const float rinv = __builtin_amdgcn_rsqf(ss * (1.f / 128.f) + EPS);
        unsigned ow[8];
#pragma unroll
        for (int e2 = 0; e2 < 8; ++e2) { const float x0 = bflo(rw[e2]), x1 = bfhi(rw[e2]);
            const float y0 = o[2 * e2] * rinv * hg[2 * e2] * (x0 * __builtin_amdgcn_rcpf(1.f + __expf(-x0))), y1 = o[2 * e2 + 1] * rinv * hg[2 * e2 + 1] * (x1 * __builtin_amdgcn_rcpf(1.f + __expf(-x1))); ow[e2] = cvtpk(y0, y1); }
        GAS v4u* mp = (GAS v4u*)(MIX + row * 1024 + h * 128 + eseg * 16);
        mp[0] = (v4u){ow[0], ow[1], ow[2], ow[3]}; mp[1] = (v4u){ow[4], ow[5], ow[6], ow[7]}; }
}
}
struct DenseMap { static constexpr bool GATHER = false;
    const bf16* A; const bf16* Bt; int K;
    __device__ __forceinline__ __amdgpu_buffer_rsrc_t a_rsrc() const { return __builtin_amdgcn_make_buffer_rsrc((void*)A, 0, 0x7fffffff, 0x00020000); }
    __device__ __forceinline__ __amdgpu_buffer_rsrc_t b_rsrc() const { return __builtin_amdgcn_make_buffer_rsrc((void*)Bt, 0, 0x7fffffff, 0x00020000); }
    __device__ __forceinline__ unsigned a_soff(const pg8::Unit& u) const { return (unsigned)u.pm * 256u * (unsigned)K * 2u; }
    __device__ __forceinline__ unsigned b_soff(const pg8::Unit& u) const { return (unsigned)u.pn * 256u * (unsigned)K * 2u; }
    __device__ __forceinline__ void a_off(const pg8::Unit&, const int (&R)[2], const int (&C)[2], unsigned (&vo)[2][2]) const {
#pragma unroll
        for (int h = 0; h < 2; ++h)
#pragma unroll
            for (int i = 0; i < 2; ++i) vo[h][i] = (unsigned)((h * 128 + R[i]) * K + C[i]) * 2u; }
};
struct MoeTabs { const LAS int* cnt; const LAS int* cst; const LAS unsigned short* te; };
struct MoeMapUp { static constexpr bool GATHER = true;
    const unsigned char* A; const unsigned char* Bt; const int* rowtok; MoeTabs tb;
    __device__ __forceinline__ __amdgpu_buffer_rsrc_t a_rsrc() const { return __builtin_amdgcn_make_buffer_rsrc((void*)A, 0, 0x7fffffff, 0x00020000); }
    __device__ __forceinline__ __amdgpu_buffer_rsrc_t b_rsrc() const { return __builtin_amdgcn_make_buffer_rsrc((void*)Bt, 0, 0x7fffffff, 0x00020000); }
    __device__ __forceinline__ unsigned a_soff(const pg8::Unit&) const { return 0u; }
    __device__ __forceinline__ unsigned b_soff(const pg8::Unit& u) const { const unsigned e = tb.te[u.pm]; return (e * 2048u + (unsigned)u.pn * 256u) * 1024u; }
    __device__ __forceinline__ void a_raw(const pg8::Unit& u, const int (&R)[2], unsigned (&raw)[2][2]) const {
        const int e = tb.te[u.pm], pos0 = (u.pm - tb.cst[e]) * 256, n = tb.cnt[e];
#pragma unroll
        for (int h = 0; h < 2; ++h)
#pragma unroll
            for (int i = 0; i < 2; ++i) { const int pos = pos0 + h * 128 + R[i]; raw[h][i] = (unsigned)rowtok[(size_t)e * EROWS + (pos < n ? pos : 0)]; } }
    __device__ __forceinline__ unsigned a_fin(unsigned tok, int C) const { return (tok * 512u + (unsigned)C) * 2u; }
    __device__ __forceinline__ void a_off(const pg8::Unit& u, const int (&R)[2], const int (&C)[2], unsigned (&vo)[2][2]) const {
        unsigned raw[2][2]; a_raw(u, R, raw);
#pragma unroll
        for (int h = 0; h < 2; ++h)
#pragma unroll
            for (int i = 0; i < 2; ++i) vo[h][i] = a_fin(raw[h][i], C[i]); }
};
struct MoeMapDown { static constexpr bool GATHER = false;
    const unsigned char* A; const unsigned char* Bt; MoeTabs tb;
    __device__ __forceinline__ __amdgpu_buffer_rsrc_t a_rsrc() const { return __builtin_amdgcn_make_buffer_rsrc((void*)A, 0, 0x7fffffff, 0x00020000); }
    __device__ __forceinline__ __amdgpu_buffer_rsrc_t b_rsrc() const { return __builtin_amdgcn_make_buffer_rsrc((void*)Bt, 0, 0x7fffffff, 0x00020000); }
    __device__ __forceinline__ unsigned a_soff(const pg8::Unit& u) const { return (unsigned)u.pm * 256u * 1024u; }
    __device__ __forceinline__ unsigned b_soff(const pg8::Unit& u) const { const unsigned e = tb.te[u.pm]; return (e * 1024u + (unsigned)u.pn * 256u) * 1024u; }
    __device__ __forceinline__ void a_off(const pg8::Unit&, const int (&R)[2], const int (&C)[2], unsigned (&vo)[2][2]) const {
#pragma unroll
        for (int h = 0; h < 2; ++h)
#pragma unroll
            for (int i = 0; i < 2; ++i) vo[h][i] = (unsigned)((h * 128 + R[i]) * 512 + C[i]) * 2u; }
};
using pg8::f32x4;
struct EpiInProj { static constexpr bool PERM = true, COLS64 = false;
    bf16 *gq, *gk, *gv, *gr, *aq, *ak, *av, *z;
    struct Pre {}; __device__ __forceinline__ void preload(const pg8::Unit&, int, int, int, int, Pre&) const {}
    __device__ __forceinline__ void operator()(const f32x4 (&acc)[2][2][4][2], const pg8::Unit& u, const Pre&, int wr, int wc, int fr, int fq) const {
        bf16* b0; bf16* b1; int ld;
        switch (u.pn) { case 0: b0 = gq; b1 = gq + 128; ld = 256; break; case 1: b0 = gk; b1 = gk + 128; ld = 256; break;
            case 2: b0 = gv; b1 = gv + 128; ld = 512; break; case 3: b0 = gv + 256; b1 = gv + 384; ld = 512; break;
            case 4: b0 = gr; b1 = gr + 128; ld = 512; break; case 5: b0 = gr + 256; b1 = gr + 384; ld = 512; break;
            case 6: b0 = aq; b1 = aq + 128; ld = 512; break; case 7: b0 = aq + 256; b1 = aq + 384; ld = 512; break;
            case 8: b0 = ak; b1 = av; ld = 128; break; default: b0 = z; b1 = z; ld = 32; break; }
        const bool zt = (u.pn == 9);
        if (zt && wc != 0) return;
        const int row0 = u.pm * 256 + wr * 64 + fr, cw = wc * 32 + 8 * fq;
#pragma unroll
        for (int ai = 0; ai < 2; ++ai)
#pragma unroll
            for (int m = 0; m < 4; ++m) { const size_t row = (size_t)(row0 + ai * 128 + m * 16);
#pragma unroll
                for (int bj = 0; bj < 2; ++bj) { if (zt && bj == 1) continue; const f32x4 v0 = acc[ai][bj][m][0], v1 = acc[ai][bj][m][1];
                    pg8::u32x4 wv; wv.x = pg8::cvt_pk_bf16(v0[0], v0[1]); wv.y = pg8::cvt_pk_bf16(v0[2], v0[3]); wv.z = pg8::cvt_pk_bf16(v1[0], v1[1]); wv.w = pg8::cvt_pk_bf16(v1[2], v1[3]);
                    *(pg8::u32x4*)((bj ? b1 : b0) + row * ld + cw) = wv; } }
    }
};
struct EpiResF32 { static constexpr bool PERM = false, COLS64 = false;
    const float* base; float* out;
    struct Pre {}; __device__ __forceinline__ void preload(const pg8::Unit&, int, int, int, int, Pre&) const {}
    __device__ __forceinline__ void operator()(const f32x4 (&acc)[2][2][4][2], const pg8::Unit& u, const Pre&, int wr, int wc, int fr, int fq) const {
        const int col0 = u.pn * 256 + wc * 32 + 4 * fq;
#pragma unroll
        for (int ai = 0; ai < 2; ++ai)
#pragma unroll
            for (int m = 0; m < 4; ++m) { const size_t off = (size_t)(u.pm * 256 + ai * 128 + wr * 64 + m * 16 + fr) * 1024 + col0;
#pragma unroll
                for (int bj = 0; bj < 2; ++bj)
#pragma unroll
                    for (int n = 0; n < 2; ++n) { const f32x4 bs = *(const f32x4*)(base + off + bj * 128 + n * 16); *(f32x4*)(out + off + bj * 128 + n * 16) = bs + acc[ai][bj][m][n]; } }
    }
};
struct EpiSwiglu { static constexpr bool PERM = true, COLS64 = false;
    const float* b1; unsigned char* act; MoeTabs tb;
    struct Pre { f32x4 g0, g1, l0, l1; };
    __device__ __forceinline__ void preload(const pg8::Unit& u, int wr, int wc, int fr, int fq, Pre& p) const {
        const int e = tb.te[u.pm]; const int col = u.pn * 128 + wc * 32 + 8 * fq; const float* bg = b1 + (size_t)e * 2048 + col; const float* bl = bg + 1024;
        p.g0 = *(const GAS f32x4*)bg; p.g1 = *(const GAS f32x4*)(bg + 4); p.l0 = *(const GAS f32x4*)bl; p.l1 = *(const GAS f32x4*)(bl + 4); }
    __device__ __forceinline__ void operator()(const f32x4 (&acc)[2][2][4][2], const pg8::Unit& u, const Pre& p, int wr, int wc, int fr, int fq) const {
        const int col = u.pn * 128 + wc * 32 + 8 * fq;
        const f32x4 g0 = p.g0, g1 = p.g1, l0 = p.l0, l1 = p.l1;
        const int row0 = u.pm * 256 + wr * 64 + fr;
#pragma unroll
        for (int ai = 0; ai < 2; ++ai)
#pragma unroll
            for (int m = 0; m < 4; ++m) { float o[8];
#pragma unroll
                for (int n = 0; n < 2; ++n)
#pragma unroll
                    for (int j = 0; j < 4; ++j) { const float gl = fminf(__builtin_fmaf(acc[ai][0][m][n][j], 1.f / WSCALE, (n ? g1[j] : g0[j])), 7.f); const float li = __builtin_amdgcn_fmed3f(__builtin_fmaf(acc[ai][1][m][n][j], 1.f / WSCALE, (n ? l1[j] : l0[j])), -7.f, 7.f);
                        o[4 * n + j] = (gl * ASCALE) * __builtin_amdgcn_rcpf(1.f + __builtin_amdgcn_exp2f(gl * (-1.702f * 1.4426950408889634f))) * (li + 1.f); }
                int w0 = 0, w1 = 0;
                w0 = __builtin_amdgcn_cvt_pk_fp8_f32(o[0], o[1], w0, false); w0 = __builtin_amdgcn_cvt_pk_fp8_f32(o[2], o[3], w0, true); w1 = __builtin_amdgcn_cvt_pk_fp8_f32(o[4], o[5], w1, false); w1 = __builtin_amdgcn_cvt_pk_fp8_f32(o[6], o[7], w1, true);
                *(v2u*)(act + (size_t)(row0 + ai * 128 + m * 16) * 1024 + col) = (v2u){(unsigned)w0, (unsigned)w1}; }
    }
};
struct EpiDown { static constexpr bool PERM = true, COLS64 = true;
    const float* b2; const float* rowgate; unsigned char* y; MoeTabs tb;
    struct Pre { f32x4 bv[2][2]; float gt[8]; };
    __device__ __forceinline__ void preload(const pg8::Unit& u, int wr, int wc, int fr, int fq, Pre& p) const {
        const int e = tb.te[u.pm], pos0 = (u.pm - tb.cst[e]) * 256, n_e = tb.cnt[e];
        const float* bb = b2 + (size_t)e * 1024 + u.pn * 256 + wc * 64 + 8 * fq;
#pragma unroll
        for (int bj = 0; bj < 2; ++bj)
#pragma unroll
            for (int n = 0; n < 2; ++n) p.bv[bj][n] = *(const GAS f32x4*)(bb + bj * 32 + 4 * n);
#pragma unroll
        for (int ai = 0; ai < 2; ++ai)
#pragma unroll
            for (int m = 0; m < 4; ++m) { const int pos = pos0 + wr * 64 + fr + ai * 128 + m * 16; const int pc_ = pos < n_e ? pos : 0; const float g = rowgate[(size_t)e * EROWS + pc_]; p.gt[ai * 4 + m] = (pos < n_e) ? g * YSCALE : 0.f; }
    }
    __device__ __forceinline__ void operator()(const f32x4 (&acc)[2][2][4][2], const pg8::Unit& u, const Pre& p, int wr, int wc, int fr, int fq) const {
        const bool odd = (fq & 1) != 0;
        const int colb = u.pn * 256 + wc * 64 + (odd ? 32 + 8 * (fq - 1) : 8 * fq), rl0 = wr * 64 + fr;
#pragma unroll
        for (int ai = 0; ai < 2; ++ai)
#pragma unroll
            for (int m = 0; m < 4; ++m) { const int rl = rl0 + ai * 128 + m * 16; const float gt = p.gt[ai * 4 + m];
                unsigned w[2][2];
#pragma unroll
                for (int bj = 0; bj < 2; ++bj) { const f32x4 v0 = (acc[ai][bj][m][0] * (1.f / (WSCALE * ASCALE)) + p.bv[bj][0]) * gt, v1 = (acc[ai][bj][m][1] * (1.f / (WSCALE * ASCALE)) + p.bv[bj][1]) * gt;
                    int w0 = 0, w1 = 0;
                    w0 = __builtin_amdgcn_cvt_pk_fp8_f32(v0[0], v0[1], w0, false); w0 = __builtin_amdgcn_cvt_pk_fp8_f32(v0[2], v0[3], w0, true); w1 = __builtin_amdgcn_cvt_pk_fp8_f32(v1[0], v1[1], w1, false); w1 = __builtin_amdgcn_cvt_pk_fp8_f32(v1[2], v1[3], w1, true);
                    w[bj][0] = (unsigned)w0; w[bj][1] = (unsigned)w1; }
                const unsigned s0 = odd ? w[0][0] : w[1][0], s1 = odd ? w[0][1] : w[1][1];
                const unsigned r0 = (unsigned)__shfl_xor((int)s0, 16), r1 = (unsigned)__shfl_xor((int)s1, 16);
                const pg8::u32x4 ov = odd ? (pg8::u32x4){r0, r1, w[1][0], w[1][1]} : (pg8::u32x4){w[0][0], w[0][1], r0, r1};
                *(pg8::u32x4*)(y + (size_t)(u.pm * 256 + rl) * 1024 + colb) = ov; }
    }
};
__device__ __forceinline__ int moe_tables(Frame& F) {
    LAS int* cnt = (LAS int*)(F.lds + LC_CNT); LAS int* cst = (LAS int*)(F.lds + LC_CST); LAS unsigned short* te = (LAS unsigned short*)(F.lds + LC_TE);
    __syncthreads();
    if (F.tid < NEXP) cnt[F.tid] = (int)__hip_atomic_load(F.ctl + CW_CNT + 64 * F.tid, RLX_AGENT);
    __syncthreads();
    if (F.tid == 0) { int s = 0; for (int e = 0; e < NEXP; ++e) { cst[e] = s; s += (cnt[e] + 255) >> 8; } cst[NEXP] = s; }
    __syncthreads();
    const int nt = cst[NEXP];
    for (int t = F.tid; t < nt; t += NWAVES * 64) { int e = 0;
#pragma unroll 1
        for (int k = 1; k < NEXP; ++k) e = (t >= cst[k]) ? k : e;
        te[t] = (unsigned short)e; }
    __syncthreads();
    return nt;
}
__device__ __forceinline__ void p3_mixers(Frame& F) {
    for (int u = blockIdx.x; u < 2 * BATCH * GLA_H; u += F.G) gla::gla_unit(F, u & 7, (u >> 3) & 3, u >> 5);
    if (blockIdx.x < 2 * BATCH * GLA_H) { while (conv_pull(F)) {} }
    const attn_body::bf16* Q = (const attn_body::bf16*)(F.ws + WS_AQ); const attn_body::bf16* K = (const attn_body::bf16*)(F.ws + WS_AK); const attn_body::bf16* V = (const attn_body::bf16*)(F.ws + WS_AV);
    attn_body::bf16* O = (attn_body::bf16*)(F.ws + WS_MIX);
    const int x0 = blockIdx.x & 7;
    float sbound;
    { float mq = fabsf(F.q_g[F.lane]), mk = fabsf(F.k_g[F.lane]);
#pragma unroll
      for (int o_ = 1; o_ < 64; o_ <<= 1) { mq = fmaxf(mq, __shfl_xor(mq, o_)); mk = fmaxf(mk, __shfl_xor(mk, o_)); }
      sbound = __builtin_bit_cast(float, __builtin_amdgcn_readfirstlane(__builtin_bit_cast(int, 64.f * attn_body::C2 * mq * mk * 1.02f))); }
    for (int qi = 0; qi < 8; ++qi) { const int x = (x0 + qi) & 7;
        for (;;) {
            __syncthreads();
            if (F.tid == 0) F.MISC[16] = __hip_atomic_fetch_add(F.ctl + CW_QUE + 64 * x, 1u, RLX_AGENT);
            __syncthreads();
            const int item = __builtin_amdgcn_readfirstlane((int)F.MISC[16]);
            if (item >= ATT_H * attn_body::NQB + 4 * GLA_H) break;
            if (item >= ATT_H * attn_body::NQB) { const int k = item - ATT_H * attn_body::NQB; gla::gla_combine(F, x, k >> 2, k & 3); continue; }
            attn_body::attn_unit<8>(x, item >> 4, item & 15, Q, K, V, O, (char*)F.lds, F.q_g, sbound);
        }
    }
    while (conv_pull(F)) {}
    __syncthreads();
}

__device__ __forceinline__ void p5_route(Frame& F) {
    typedef float f32x16 __attribute__((ext_vector_type(16)));
    LAS unsigned char* L = F.lds;
    constexpr int XP = 2064, L_XH = 0, L_XL = 32 * XP, L_PART = 0;
    const int tid = F.tid, lane = F.lane, w = F.wave, r32 = lane & 31, hi = lane >> 5;
    const bf16* WRH = (const bf16*)(F.ws + WS_WRH); const bf16* WRL = (const bf16*)(F.ws + WS_WRL);
    unsigned char* XN8 = F.ws + WS_XN;
    int* ROWTOK = (int*)(F.ws + WS_ROWTOK); float* ROWGATE = (float*)(F.ws + WS_ROWGATE); int* TOKASG = (int*)(F.ws + WS_TOKASG);
    gu32* CNT = F.ctl + CW_CNT;
    bf16x8 wh[8], wl[8];
#pragma unroll
    for (int ks = 0; ks < 8; ++ks) { const int k0 = 128 * w + 16 * ks + 8 * hi; wh[ks] = *(const GAS bf16x8*)(WRH + r32 * 1024 + k0); wl[ks] = *(const GAS bf16x8*)(WRL + r32 * 1024 + k0); }
    f32x4 g2[4];
#pragma unroll
    for (int j = 0; j < 4; ++j) g2[j] = *((const GAS f32x4*)F.ffn_g + lane + 64 * j);
    float brt[16];
#pragma unroll
    for (int r = 0; r < 16; ++r) brt[r] = F.b_router[(r & 3) + 8 * (r >> 2) + 4 * hi];
    LAS int* hist = (LAS int*)(L + LC_HIST); LAS int* basev = (LAS int*)(L + LC_BASE); LAS int* aep = (LAS int*)(L + LC_ASG); LAS float* agt = (LAS float*)(L + LC_ASG + 4096);
    constexpr int NGRP = T / 32;
    const int per = (NGRP + F.G - 1) / F.G, g0 = F.vcu * per, g1 = (g0 + per < NGRP) ? g0 + per : NGRP;
    for (int gb = g0; gb < g1; gb += 8) {
        const int nb = (g1 - gb < 8) ? g1 - gb : 8;
        __syncthreads();
        if (tid < NEXP) hist[tid] = 0;
        for (int bi = 0; bi < nb; ++bi) {
            const int t0 = 32 * (gb + bi);
            f32x4 hv[4][4];
#pragma unroll
            for (int rr = 0; rr < 4; ++rr) { const GAS f32x4* hp = (const GAS f32x4*)(F.out + (size_t)(t0 + 4 * w + rr) * 1024) + lane;
#pragma unroll
                for (int j = 0; j < 4; ++j) hv[rr][j] = __builtin_nontemporal_load(hp + 64 * j); }
#pragma unroll
            for (int rr = 0; rr < 4; ++rr) { const int r = 4 * w + rr; const size_t tok = (size_t)(t0 + r);
                f32x4 v[4]; float s = 0.f;
#pragma unroll
                for (int j = 0; j < 4; ++j) { v[j] = hv[rr][j]; s += (v[j].x * v[j].x + v[j].y * v[j].y) + (v[j].z * v[j].z + v[j].w * v[j].w); }
                const float rinv = 1.f / sqrtf(wave_sum(s) * (1.f / 1024.f) + EPS);
                GAS unsigned* o4 = (GAS unsigned*)(XN8 + tok * 1024) + lane;
#pragma unroll
                for (int j = 0; j < 4; ++j) { const f32x4 xn = v[j] * rinv * g2[j];
                    const unsigned h0 = f2bf(xn.x), h1 = f2bf(xn.y), h2 = f2bf(xn.z), h3 = f2bf(xn.w);
                    const unsigned l0 = f2bf(xn.x - bf2f(h0)), l1 = f2bf(xn.y - bf2f(h1)), l2 = f2bf(xn.z - bf2f(h2)), l3 = f2bf(xn.w - bf2f(h3));
                    const v2u hw = (v2u){h0 | (h1 << 16), h2 | (h3 << 16)}, lw = (v2u){l0 | (l1 << 16), l2 | (l3 << 16)};
                    { int q8 = 0; q8 = __builtin_amdgcn_cvt_pk_fp8_f32(xn.x, xn.y, q8, false); q8 = __builtin_amdgcn_cvt_pk_fp8_f32(xn.z, xn.w, q8, true); o4[64 * j] = (unsigned)q8; }
                    *(LAS v2u*)(L + L_XH + r * XP + (4 * lane + 256 * j) * 2) = hw; *(LAS v2u*)(L + L_XL + r * XP + (4 * lane + 256 * j) * 2) = lw; } }
            __syncthreads();
            f32x16 acc = {};
#pragma unroll
            for (int ks = 0; ks < 8; ++ks) { const int k0 = 128 * w + 16 * ks + 8 * hi;
                const bf16x8 xh = *(const LAS bf16x8*)(L + L_XH + r32 * XP + k0 * 2), xl = *(const LAS bf16x8*)(L + L_XL + r32 * XP + k0 * 2);
                acc = __builtin_amdgcn_mfma_f32_32x32x16_bf16(wh[ks], xh, acc, 0, 0, 0); acc = __builtin_amdgcn_mfma_f32_32x32x16_bf16(wh[ks], xl, acc, 0, 0, 0); acc = __builtin_amdgcn_mfma_f32_32x32x16_bf16(wl[ks], xh, acc, 0, 0, 0); }
            __syncthreads();
#pragma unroll
            for (int r = 0; r < 16; ++r) { const int e = (r & 3) + 8 * (r >> 2) + 4 * hi; ((LAS float*)(L + L_PART))[(w * 32 + e) * 32 + r32] = acc[r]; }
            __syncthreads();
            if (w == 0) {
                float v[16];
#pragma unroll
                for (int r = 0; r < 16; ++r) { const int e = (r & 3) + 8 * (r >> 2) + 4 * hi; float s = brt[r];
#pragma unroll
                    for (int ww = 0; ww < 8; ++ww) s += ((const LAS float*)(L + L_PART))[(ww * 32 + e) * 32 + r32];
                    v[r] = s; }
                float cv[8]; int cidx[8];
#pragma unroll
                for (int s = 0; s < 4; ++s) { float m = -INFINITY; int mr = 0;
#pragma unroll
                    for (int r = 0; r < 16; ++r) { if (v[r] > m) { m = v[r]; mr = r; } }
                    cv[s] = m; cidx[s] = (mr & 3) + 8 * (mr >> 2) + 4 * hi;
#pragma unroll
                    for (int r = 0; r < 16; ++r) v[r] = (r == mr) ? -INFINITY : v[r]; }
#pragma unroll
                for (int s = 0; s < 4; ++s) { cv[4 + s] = __shfl_xor(cv[s], 32); cidx[4 + s] = __shfl_xor(cidx[s], 32); }
                float tv[4]; int ti[4];
#pragma unroll
                for (int s = 0; s < 4; ++s) { float m = -INFINITY; int mi = 1 << 20; int mc = 0;
#pragma unroll
                    for (int c = 0; c < 8; ++c) { const bool better = (cv[c] > m) || (cv[c] == m && cidx[c] < mi); if (better) { m = cv[c]; mi = cidx[c]; mc = c; } }
                    tv[s] = m; ti[s] = mi;
#pragma unroll
                    for (int c = 0; c < 8; ++c) cv[c] = (c == mc) ? -INFINITY : cv[c]; }
                const float e1 = __expf(tv[1] - tv[0]), e2 = __expf(tv[2] - tv[0]), e3 = __expf(tv[3] - tv[0]); const float inv = 1.f / (1.f + e1 + e2 + e3);
                const float gt[4] = {inv, e1 * inv, e2 * inv, e3 * inv};
                if (hi == 0) {
#pragma unroll
                    for (int s = 0; s < 4; ++s) { const int rank = (int)__hip_atomic_fetch_add(hist + ti[s], 1, __ATOMIC_RELAXED, __HIP_MEMORY_SCOPE_WORKGROUP); const int idx = (bi * 32 + r32) * 4 + s; aep[idx] = (ti[s] << 16) | rank; agt[idx] = gt[s]; } }
            }
            __syncthreads();
        }
        if (tid < NEXP) { const int hc = hist[tid]; basev[tid] = hc ? (int)__hip_atomic_fetch_add(CNT + 64 * tid, (unsigned)hc, RLX_AGENT) : 0; }
        __syncthreads();
        for (int idx = tid; idx < nb * 128; idx += NWAVES * 64) { const int ep = aep[idx], e = ep >> 16, pos = basev[e] + (ep & 0xffff); const int tok = 32 * gb + (idx >> 2), s = idx & 3;
            ROWTOK[(size_t)e * EROWS + pos] = tok; ROWGATE[(size_t)e * EROWS + pos] = agt[idx]; TOKASG[tok * 4 + s] = e * EROWS + pos; }
    }
    __syncthreads();
}

__device__ __forceinline__ void p8_combine(Frame& F) {
    const LAS int* cst = (const LAS int*)(F.lds + LC_CST);
    const int gw = F.vcu * NWAVES + F.wave, NGW = F.G * NWAVES, lane = F.lane;
    const int* TOKASG = (const int*)(F.ws + WS_TOKASG); const unsigned char* Y = F.ws + WS_Y;
    f32x4 fg[4];
#pragma unroll
    for (int j = 0; j < 4; ++j) fg[j] = *((const GAS f32x4*)F.fin_g + lane + 64 * j);
    for (int tok = gw; tok < T; tok += NGW) {
        const int a = TOKASG[tok * 4 + (lane & 3)];
        const int crow = cst[a >> 15] * 256 + (a & (EROWS - 1));
        GAS f32x4* hp = (GAS f32x4*)(F.out + (size_t)tok * 1024) + lane; f32x4 v[4];
#pragma unroll
        for (int j = 0; j < 4; ++j) v[j] = __builtin_nontemporal_load(hp + 64 * j);
#pragma unroll
        for (int s = 0; s < 4; ++s) { const int cr = __shfl(crow, s); const GAS unsigned* yp = (const GAS unsigned*)(Y + (size_t)cr * 1024) + lane;
#pragma unroll
            for (int j = 0; j < 4; ++j) { const unsigned yw = __builtin_nontemporal_load(yp + 64 * j); const auto lo = __builtin_amdgcn_cvt_pk_f32_fp8((int)yw, false), hi = __builtin_amdgcn_cvt_pk_f32_fp8((int)yw, true);
                v[j].x += lo[0] * (1.f / YSCALE); v[j].y += lo[1] * (1.f / YSCALE); v[j].z += hi[0] * (1.f / YSCALE); v[j].w += hi[1] * (1.f / YSCALE); } }
        float ss = 0.f;
#pragma unroll
        for (int j = 0; j < 4; ++j) ss += (v[j].x * v[j].x + v[j].y * v[j].y) + (v[j].z * v[j].z + v[j].w * v[j].w);
        const float rinv = 1.f / sqrtf(wave_sum(ss) * (1.f / 1024.f) + EPS);
#pragma unroll
        for (int j = 0; j < 4; ++j) __builtin_nontemporal_store(v[j] * rinv * fg[j], hp + 64 * j);
    }
}
#ifndef MK_N_LAUNCHES
#define MK_N_LAUNCHES 1
#endif
constexpr int N_PHASES = 9;
constexpr int N_LAUNCHES = MK_N_LAUNCHES;
struct Args { const float* in[19]; float* out; unsigned char* ws; int ph_lo, ph_hi; };
__global__ void __launch_bounds__(NWAVES * 64, 2) enc_fwd(Args args) {
    extern __shared__ __attribute__((aligned(16))) unsigned char lds[];
    Frame F;
    F.lds = (LAS unsigned char*)lds;
    F.MISC = (volatile LAS unsigned*)(F.lds + LC_MISC);
    F.tid = threadIdx.x; F.lane = F.tid & 63; F.wave = __builtin_amdgcn_readfirstlane(F.tid >> 6);
    F.G = gridDim.x; { const int bx = blockIdx.x; F.vcu = (F.G % 8 == 0) ? (bx % 8) * (F.G / 8) + bx / 8 : bx; }
    F.ws = args.ws; F.ctl = (gu32*)(args.ws + WS_CTL);
    F.x = args.in[0]; F.mix_g = args.in[1]; F.w_in = args.in[2]; F.w_gf = args.in[3]; F.b_gf = args.in[4]; F.w_gb = args.in[5]; F.b_gb = args.in[6]; F.gla_hg = args.in[7];
    F.q_g = args.in[8]; F.k_g = args.in[9]; F.w_out = args.in[10]; F.ffn_g = args.in[11]; F.w_router = args.in[12]; F.b_router = args.in[13];
    F.w1 = args.in[14]; F.b1 = args.in[15]; F.w2 = args.in[16]; F.b2 = args.in[17]; F.fin_g = args.in[18]; F.out = args.out;
    for (int u = F.tid; u < (LDS_BYTES - LC_OFF) / 4; u += NWAVES * 64) ((LAS unsigned*)(F.lds + LC_OFF))[u] = 0u;
    __syncthreads();
    XcdBarrier bar; bar.bar = (unsigned*)(F.ctl + CW_BAR); bar.x = 0; bar.st = nullptr;
    if (N_LAUNCHES == 1) bar = xcd_barrier_post((unsigned*)(F.ctl + CW_BAR), F.MISC + 8);
    const int lo = args.ph_lo, hi = args.ph_hi;
#define IN(k) (lo <= (k) && (k) < hi)
#define SEAM(k) do { if (IN(k) && IN((k) + 1)) xcd_barrier(bar); } while (0)
    MoeTabs tb{(const LAS int*)(F.lds + LC_CNT), (const LAS int*)(F.lds + LC_CST), (const LAS unsigned short*)(F.lds + LC_TE)};

    if (IN(0)) { p0_prologue(F); } SEAM(0);
    if (IN(1)) {
        DenseMap mp{(const bf16*)(F.ws + WS_XN), (const bf16*)(F.ws + WS_WIN), 1024};
        pg8::StaticOrder S; S.init(T / 256, D_IN_PAD / 256, F.G, (int)blockIdx.x);
        EpiInProj E{(bf16*)(F.ws + WS_GQ), (bf16*)(F.ws + WS_GK), (bf16*)(F.ws + WS_GV), (bf16*)(F.ws + WS_GR), (bf16*)(F.ws + WS_AQ), (bf16*)(F.ws + WS_AK), (bf16*)(F.ws + WS_AV), (bf16*)(F.ws + WS_Z)};
        pg8::gemm_phase<EpiInProj, pg8::StaticOrder, DenseMap, true>(F.lds, 1024, S, mp, E);
    } SEAM(1);
    if (IN(2)) { p2_normrope(F); for (int u = F.vcu; u < BATCH * 64; u += F.G) gla::gla_prep_unit(F, u >> 6, u & 63); } SEAM(2);
    if (IN(3)) { p3_mixers(F); } SEAM(3);
    if (IN(4)) {
        DenseMap mp{(const bf16*)(F.ws + WS_MIX), (const bf16*)(F.ws + WS_WOUT), 1024};
        pg8::StaticOrder S; S.init(T / 256, DM / 256, F.G, (int)blockIdx.x);
        EpiResF32 E{F.x, F.out};
        pg8::gemm_phase<EpiResF32, pg8::StaticOrder, DenseMap, true>(F.lds, 1024, S, mp, E);
    } SEAM(4);
    if (IN(5)) { p5_route(F); } SEAM(5);
    if (IN(6)) {
        const int ntl = moe_tables(F);
        MoeMapUp mp{F.ws + WS_XN, F.ws + WS_W1, (const int*)(F.ws + WS_ROWTOK), tb};
        pg8::StaticOrder S; S.init(ntl, 8, F.G, (int)blockIdx.x);
        EpiSwiglu E{F.b1, F.ws + WS_ACT, tb};
        pg8::gemm_phase<EpiSwiglu, pg8::StaticOrder, MoeMapUp, true, true>(F.lds, 512, S, mp, E);
    } SEAM(6);
    if (IN(7)) {
        const int ntl = moe_tables(F);
        MoeMapDown mp{F.ws + WS_ACT, F.ws + WS_W2, tb};
        pg8::StaticOrder S; S.init(ntl, 4, F.G, (int)blockIdx.x);
        EpiDown E{F.b2, (const float*)(F.ws + WS_ROWGATE), F.ws + WS_Y, tb};
        pg8::gemm_phase<EpiDown, pg8::StaticOrder, MoeMapDown, true, true>(F.lds, 512, S, mp, E);
    } SEAM(7);
    if (IN(8)) { (void)moe_tables(F); p8_combine(F); }
#undef IN
#undef SEAM
}

extern "C" void kernel_launch(void* const* d_in, const int* in_sizes, int n_in, void* d_out, int out_size, void* d_ws, size_t ws_size, hipStream_t stream) {
    static int grid = 0;
    if (grid == 0) {
        if (n_in != 19 || in_sizes[0] != T * DM || out_size != T * DM || ws_size < WS_END) { fprintf(stderr, "kernel_launch: unexpected shapes (n_in %d, in0 %d, out %d, ws %zu); nothing launched\n", n_in, n_in > 0 ? in_sizes[0] : -1, out_size, ws_size); grid = -1; return; }
        int dev = 0, cus = 0, per_cu = 0;
        if (hipGetDevice(&dev) != hipSuccess || hipDeviceGetAttribute(&cus, hipDeviceAttributeMultiprocessorCount, dev) != hipSuccess) { grid = -1; return; }
        if (hipFuncSetAttribute((const void*)enc_fwd, hipFuncAttributeMaxDynamicSharedMemorySize, LDS_BYTES) != hipSuccess) { fprintf(stderr, "kernel_launch: hipFuncSetAttribute failed\n"); grid = -1; return; }
        if (hipOccupancyMaxActiveBlocksPerMultiprocessor(&per_cu, (const void*)enc_fwd, NWAVES * 64, LDS_BYTES) != hipSuccess || per_cu < 1) { fprintf(stderr, "kernel_launch: occupancy query says %d\n", per_cu); }
        (void)hipGetLastError();
        grid = cus;
    }
    if (grid < 0) return;
    if (hipMemsetAsync((char*)d_ws + WS_CTL, 0, CTL_ZERO_BYTES, stream) != hipSuccess) return;
    Args a{};
    for (int i = 0; i < 19; ++i) a.in[i] = (const float*)d_in[i];
    a.out = (float*)d_out; a.ws = (unsigned char*)d_ws;
    if (N_LAUNCHES == 1) { a.ph_lo = 0; a.ph_hi = N_PHASES; hipLaunchKernelGGL(enc_fwd, dim3(grid), dim3(NWAVES * 64), LDS_BYTES, stream, a); }
    else for (int p = 0; p < N_PHASES; ++p) { a.ph_lo = p; a.ph_hi = p + 1; hipLaunchKernelGGL(enc_fwd, dim3(grid), dim3(NWAVES * 64), LDS_BYTES, stream, a); }
}
```

```cpp
#include <hip/hip_runtime.h>
#include <hip/hip_bf16.h>
#include <cstdio>
#include <cstdint>
#include <cmath>

#define LAS __attribute__((address_space(3)))
#define GAS __attribute__((address_space(1)))

namespace pg8 {
typedef unsigned short bf16_t;
typedef short bf16x8 __attribute__((ext_vector_type(8)));
typedef float f32x4 __attribute__((ext_vector_type(4)));
typedef float f32x2 __attribute__((ext_vector_type(2)));
typedef unsigned u32x4 __attribute__((ext_vector_type(4)));
typedef int v4i_t __attribute__((ext_vector_type(4)));
typedef int v8i_t __attribute__((ext_vector_type(8)));
constexpr int BM = 256, BK = 64, HALF = 128, HTB = HALF * BK * 2, STAGE_BYTES = 8 * HTB, NXCD = 8, WGM = 4;

__host__ __device__ __forceinline__ int lds_byte(int r, int c) { const int st = (r >> 4) * 2 + (c >> 5), rr = r & 15, cc = c & 31, ob = rr * 64 + cc * 2; return st * 1024 + (ob ^ (((ob >> 9) & 1) << 5)); }
__host__ __device__ __forceinline__ void stage_rc(int b, int& R, int& C) { const int st = b / 1024, sb = b % 1024, swz = sb ^ (((sb >> 9) & 1) << 5); R = (st >> 1) * 16 + swz / 64; C = (st & 1) * 32 + (swz % 64) / 2; }
__host__ __device__ __forceinline__ int perm32(int rho) { const int n = rho >> 4, i = rho & 15; return 8 * (i >> 2) + 4 * n + (i & 3); }

struct Unit { int pm, pn; };

struct StaticOrder {
    int nM, nN, nwg, G, c;
    __device__ __forceinline__ void init(int nM_, int nN_, int G_, int c_) { nM = nM_; nN = nN_; nwg = nM * nN; G = G_; c = c_; }
    __device__ __forceinline__ bool next(int i, Unit& u) const {
        const long L = (long)i * G + c; if (L >= nwg) return false;
        int wgid = (int)L; { const int q = nwg / NXCD, r = nwg % NXCD, xcd = wgid % NXCD, off = wgid / NXCD; wgid = (xcd < r ? xcd * (q + 1) : r * (q + 1) + (xcd - r) * q) + off; }
        const int nig = WGM * nN, gid = wgid / nig, fm = gid * WGM, gsz = (nM - fm) < WGM ? (nM - fm) : WGM;
        u.pm = fm + ((wgid % nig) % gsz); u.pn = (wgid % nig) / gsz; return true;
    }
};

__device__ __forceinline__ unsigned cvt_pk_bf16(float lo, float hi) { unsigned r; asm volatile("v_cvt_pk_bf16_f32 %0, %1, %2" : "=v"(r) : "v"(lo), "v"(hi)); return r; }

template <class Epi, class Sched, class Map, bool ALIGN_EPI, bool FP8 = false>
__device__ __forceinline__ void gemm_phase(LAS unsigned char* lds, const int K, const Sched& S, const Map& MP, const Epi& E) {
    int tid_ = threadIdx.x; asm volatile("" : "+v"(tid_));
    const int tid = tid_, wid = __builtin_amdgcn_readfirstlane(tid >> 6), lane = tid & 63, wr = wid >> 2, wc = wid & 3, fr = lane & 15, fq = lane >> 4;
    const int nt = K / BK;
    int Rr[2], Cc[2]; unsigned voffB[2];
#pragma unroll
    for (int i = 0; i < 2; ++i) { int R, C; stage_rc(tid * 16 + i * 8192, R, C); Rr[i] = R; Cc[i] = C; const int Rb = Epi::COLS64 ? (64 * (R >> 5) + perm32(R & 31)) : (Epi::PERM ? ((R & ~31) + perm32(R & 31)) : R); voffB[i] = (unsigned)(Rb * K + C) * 2u; }
    const unsigned kstep = (unsigned)(BK * 2);
    const unsigned hstep = (unsigned)HALF * K * 2;
    const unsigned hstepB = Epi::COLS64 ? 32u * (unsigned)K * 2u : hstep;
    const __amdgpu_buffer_rsrc_t RA = MP.a_rsrc(), RB = MP.b_rsrc();
    const unsigned ldsw = (unsigned)wid * 1024u;
    const int aoff = lds_byte(wr * 64 + fr, fq * 8), boff = lds_byte(wc * 32 + fr, fq * 8);
#define PG8_SA(b, h) (((b) * 2 + (h)) * HTB)
#define PG8_SB(b, h) ((4 + (b) * 2 + (h)) * HTB)
#define PG8_STAGE(bufoff, rsrc, soff, voff) do { _Pragma("unroll") for (int _i = 0; _i < 2; ++_i) \
        __builtin_amdgcn_raw_ptr_buffer_load_lds(rsrc, (LAS unsigned*)(lds + (bufoff) + ldsw + _i * 8192), 16, (int)(voff)[_i], (int)(soff), 0, 0); } while (0)
#define PG8_LD8(p) __builtin_shufflevector(*(const LAS v4i_t*)(p), *(const LAS v4i_t*)((p) + 1024), 0, 1, 2, 3, 4, 5, 6, 7)
#define PG8_LDA(dst, b, h) do { _Pragma("unroll") for (int m = 0; m < 4; ++m) dst[m] = PG8_LD8(lds + PG8_SA(b, h) + aoff + m * 2048); } while (0)
#define PG8_LDB(dst, b, h) do { _Pragma("unroll") for (int n = 0; n < 2; ++n) dst[n] = PG8_LD8(lds + PG8_SB(b, h) + boff + n * 2048); } while (0)
#define PG8_HALF(x, k) __builtin_bit_cast(bf16x8, __builtin_shufflevector(x, x, 4 * (k), 4 * (k) + 1, 4 * (k) + 2, 4 * (k) + 3))
#define PG8_MMA(ai, bj, At, Bt) do { __builtin_amdgcn_s_setprio(1); _Pragma("unroll") for (int m = 0; m < 4; ++m) _Pragma("unroll") for (int n = 0; n < 2; ++n) { \
        if constexpr (FP8) { acc[ai][bj][m][n] = __builtin_amdgcn_mfma_scale_f32_16x16x128_f8f6f4(Bt[n], At[m], acc[ai][bj][m][n], 0, 0, 0, 0x7f7f7f7f, 0, 0x7f7f7f7f); } \
        else { acc[ai][bj][m][n] = __builtin_amdgcn_mfma_f32_16x16x32_bf16(PG8_HALF(Bt[n], 0), PG8_HALF(At[m], 0), acc[ai][bj][m][n], 0, 0, 0); \
               acc[ai][bj][m][n] = __builtin_amdgcn_mfma_f32_16x16x32_bf16(PG8_HALF(Bt[n], 1), PG8_HALF(At[m], 1), acc[ai][bj][m][n], 0, 0, 0); } } \
        __builtin_amdgcn_s_setprio(0); } while (0)
#define PG8_WAIT_V(n) asm volatile("s_waitcnt vmcnt(" #n ")" ::: "memory")
#define PG8_WAIT_L(n) asm volatile("s_waitcnt lgkmcnt(" #n ")" ::: "memory")
#define PG8_BAR __builtin_amdgcn_s_barrier()
#define PG8_SCHED __builtin_amdgcn_sched_barrier(0)
    Unit cur, nxt, nn; int ui = 0;
    if (!S.next(0, cur)) return;
    f32x4 acc[2][2][4][2];
#pragma unroll
    for (int a = 0; a < 2; ++a)
#pragma unroll
        for (int b = 0; b < 2; ++b)
#pragma unroll
            for (int m = 0; m < 4; ++m)
#pragma unroll
                for (int n = 0; n < 2; ++n) acc[a][b][m][n] = (f32x4){0.f, 0.f, 0.f, 0.f};
    v8i_t At[4], B0[2], B1[2];
    unsigned cvo[2][2], nvo[2][2], nnvo[2][2];
    MP.a_off(cur, Rr, Cc, cvo);
    bool has_next = S.next(1, nxt);
    if constexpr (Map::GATHER) { if (has_next) MP.a_off(nxt, Rr, Cc, nvo); else { nvo[0][0] = cvo[0][0]; nvo[0][1] = cvo[0][1]; nvo[1][0] = cvo[1][0]; nvo[1][1] = cvo[1][1]; } }
    unsigned cA = MP.a_soff(cur), cB = MP.b_soff(cur);
    typename Epi::Pre pc, pn;
    E.preload(cur, wr, wc, fr, fq, pc); pn = pc;
    PG8_STAGE(PG8_SB(0, 0), RB, cB, voffB); PG8_STAGE(PG8_SB(0, 1), RB, cB + hstepB, voffB); PG8_STAGE(PG8_SA(0, 0), RA, cA, cvo[0]); PG8_STAGE(PG8_SA(0, 1), RA, cA, cvo[1]);
    if (wr == 1) PG8_BAR;
    PG8_WAIT_V(2); PG8_BAR;
    PG8_STAGE(PG8_SB(1, 0), RB, cB + kstep, voffB); PG8_STAGE(PG8_SA(1, 0), RA, cA + kstep, cvo[0]); PG8_STAGE(PG8_SB(1, 1), RB, cB + hstepB + kstep, voffB);
    PG8_WAIT_V(6); PG8_BAR;
    for (;;) {
        const unsigned nA = has_next ? MP.a_soff(nxt) : cA, nB = has_next ? MP.b_soff(nxt) : cB;
#pragma unroll 1
        for (int t = 0; t < nt; t += 2) {
            const bool last = (t == nt - 2);
            const unsigned a1 = cA + (unsigned)(t + 1) * kstep;
            const unsigned a2 = last ? nA : cA + (unsigned)(t + 2) * kstep, b2 = last ? nB : cB + (unsigned)(t + 2) * kstep;
            const unsigned a3 = a2 + kstep, b3 = b2 + kstep;
            unsigned s0[2] = {cvo[0][0], cvo[0][1]}, s1[2] = {cvo[1][0], cvo[1][1]};
            if constexpr (Map::GATHER) { if (last) { s0[0] = nvo[0][0]; s0[1] = nvo[0][1]; s1[0] = nvo[1][0]; s1[1] = nvo[1][1]; } }
            PG8_LDB(B0, 0, 0); PG8_LDB(B1, 0, 1); PG8_SCHED; PG8_LDA(At, 0, 0); PG8_STAGE(PG8_SA(1, 1), RA, a1, cvo[1]);
            PG8_WAIT_V(8); PG8_WAIT_L(0); PG8_BAR; PG8_MMA(0, 0, At, B0); PG8_MMA(0, 1, At, B1); PG8_BAR; PG8_SCHED;
            PG8_LDA(At, 0, 1); PG8_STAGE(PG8_SB(0, 0), RB, b2, voffB); PG8_STAGE(PG8_SB(0, 1), RB, b2 + hstepB, voffB); PG8_STAGE(PG8_SA(0, 0), RA, a2, s0);
            PG8_WAIT_V(8); PG8_WAIT_L(0); PG8_BAR; PG8_MMA(1, 0, At, B0); PG8_MMA(1, 1, At, B1); PG8_BAR; PG8_SCHED;
            PG8_LDB(B0, 1, 0); PG8_LDB(B1, 1, 1); PG8_SCHED; PG8_LDA(At, 1, 0); PG8_STAGE(PG8_SA(0, 1), RA, a2, s1);
            PG8_WAIT_V(8); PG8_WAIT_L(0); PG8_BAR; PG8_MMA(0, 0, At, B0); PG8_MMA(0, 1, At, B1); PG8_BAR; PG8_SCHED;
            PG8_LDA(At, 1, 1); PG8_STAGE(PG8_SB(1, 0), RB, b3, voffB); PG8_STAGE(PG8_SB(1, 1), RB, b3 + hstepB, voffB); PG8_STAGE(PG8_SA(1, 0), RA, a3, s0);
            PG8_WAIT_V(8); PG8_WAIT_L(0); PG8_BAR; PG8_MMA(1, 0, At, B0); PG8_MMA(1, 1, At, B1); PG8_BAR; PG8_SCHED;
        }
        if constexpr (ALIGN_EPI) { if (wr == 0) PG8_BAR; }
        const bool has_nn = has_next && S.next(ui + 2, nn);
        if constexpr (Map::GATHER) { if (has_nn) MP.a_raw(nn, Rr, nnvo); }
        if (has_next) E.preload(nxt, wr, wc, fr, fq, pn);
        { int fr_ = fr, fq_ = fq; asm volatile("" : "+v"(fr_), "+v"(fq_)); E(acc, cur, pc, wr, wc, fr_, fq_); }
        if (!has_next) break;
#pragma unroll
        for (int a = 0; a < 2; ++a)
#pragma unroll
            for (int b = 0; b < 2; ++b)
#pragma unroll
                for (int m = 0; m < 4; ++m)
#pragma unroll
                    for (int n = 0; n < 2; ++n) acc[a][b][m][n] = (f32x4){0.f, 0.f, 0.f, 0.f};
        cur = nxt; cA = nA; cB = nB; ++ui; pc = pn;
#pragma unroll
        for (int h = 0; h < 2; ++h)
#pragma unroll
            for (int i = 0; i < 2; ++i) { if constexpr (Map::GATHER) { cvo[h][i] = nvo[h][i]; nvo[h][i] = has_nn ? MP.a_fin(nnvo[h][i], Cc[i]) : nvo[h][i]; } }
        has_next = has_nn; nxt = nn;
        if constexpr (ALIGN_EPI) { if (wr == 1) PG8_BAR; }
    }
    PG8_WAIT_V(0);
    if constexpr (!ALIGN_EPI) { if (wr == 0) PG8_BAR; }
    PG8_BAR;
#undef PG8_SA
#undef PG8_SB
#undef PG8_STAGE
#undef PG8_LDA
#undef PG8_LDB
#undef PG8_MMA
#undef PG8_HALF
#undef PG8_LD8
#undef PG8_WAIT_V
#undef PG8_WAIT_L
#undef PG8_BAR
#undef PG8_SCHED
}
}
namespace attn_body {
using bf16=__hip_bfloat16;
using bf16x8=__attribute__((ext_vector_type(8)))short;
using s16x4=__attribute__((ext_vector_type(4)))short;
using f32x16=__attribute__((ext_vector_type(16)))float;
using u32x4=__attribute__((ext_vector_type(4)))unsigned;
constexpr int BATCH=8,NHEAD=8,NKVH=2,SEQ=4096,D=64;
constexpr int QP=512,KP=128,VP=128,OP=1024,OCOL=512;
constexpr int NW=8,QBLK=32,QB=QBLK*NW,KVBLK=64,NQB=SEQ/QB;
__device__ __forceinline__ int crow(int r,int hi){return (r&3)+8*(r>>2)+4*hi;}
#define SBAR() __builtin_amdgcn_sched_barrier(0)
constexpr int NSLOT=3, SLOTB=8192;
constexpr int LDS_K=0, LDS_V=NSLOT*SLOTB, LDS_WS=2*NSLOT*SLOTB, LDS_OST=LDS_WS+NW*64*4, LDS_BYTES=LDS_OST+NW*4096;
constexpr float C2=0.125f*1.4426950408889634f;
__device__ __forceinline__ void glds16(const void*gsrc,unsigned lds_dst){unsigned keep;
  asm volatile("s_mov_b32 %0, m0\n\ts_mov_b32 m0, %2\n\ts_nop 0\n\tglobal_load_lds_dwordx4 %1, off\n\ts_mov_b32 m0, %0":"=&s"(keep):"v"(gsrc),"s"(lds_dst):"memory");}
__device__ __forceinline__ float max3f(float a,float b,float c){float r;asm("v_max3_f32 %0, %1, %2, %3":"=v"(r):"v"(a),"v"(b),"v"(c));return r;}
__device__ __forceinline__ float max2f(float a,float b){float r;asm("v_max_f32_e32 %0, %1, %2":"=v"(r):"v"(a),"v"(b));return r;}
__device__ __forceinline__ float fadd_s(float a,float b){float r;asm("v_add_f32_e32 %0, %1, %2":"=v"(r):"v"(a),"v"(b));return r;}
__device__ __forceinline__ float fsub_s(float a,float b){float r;asm("v_sub_f32_e32 %0, %1, %2":"=v"(r):"v"(a),"v"(b));return r;}
typedef float f32x2_t __attribute__((ext_vector_type(2))); typedef __bf16 bf16x2_t __attribute__((ext_vector_type(2)));
__device__ __forceinline__ unsigned cvtpk_s(float lo,float hi){f32x2_t v={lo,hi};bf16x2_t b=__builtin_convertvector(v,bf16x2_t);return __builtin_bit_cast(unsigned,b);}
#define WAIT_BAR(N) asm volatile("s_waitcnt vmcnt(" #N ") lgkmcnt(0)\n\ts_barrier":::"memory")

__device__ __forceinline__ void qkt(f32x16&p0,f32x16&p1,const char*Kslot,const bf16x8*qr,const f32x16&negm,int r32,int hi){
  const char*kb=Kslot+hi*1024+r32*16;
  #pragma unroll
  for(int d0=0;d0<4;++d0){
    const bf16x8 b0=*reinterpret_cast<const bf16x8*>(kb+d0*2048);
    const bf16x8 b1=*reinterpret_cast<const bf16x8*>(kb+d0*2048+512);
    if(d0==0){p0=__builtin_amdgcn_mfma_f32_32x32x16_bf16(b0,qr[0],negm,0,0,0);p1=__builtin_amdgcn_mfma_f32_32x32x16_bf16(b1,qr[0],negm,0,0,0);}
    else{p0=__builtin_amdgcn_mfma_f32_32x32x16_bf16(b0,qr[d0],p0,0,0,0);p1=__builtin_amdgcn_mfma_f32_32x32x16_bf16(b1,qr[d0],p1,0,0,0);}}
}
typedef __attribute__((address_space(3))) const char* lds_cptr;
typedef short v4i16_t __attribute__((ext_vector_type(4)));
__device__ __forceinline__ void kload8(bf16x8*kf,lds_cptr kp){
  kf[0]=*(const __attribute__((address_space(3))) bf16x8*)(kp);      kf[1]=*(const __attribute__((address_space(3))) bf16x8*)(kp+512);
  kf[2]=*(const __attribute__((address_space(3))) bf16x8*)(kp+2048); kf[3]=*(const __attribute__((address_space(3))) bf16x8*)(kp+2560);
  kf[4]=*(const __attribute__((address_space(3))) bf16x8*)(kp+4096); kf[5]=*(const __attribute__((address_space(3))) bf16x8*)(kp+4608);
  kf[6]=*(const __attribute__((address_space(3))) bf16x8*)(kp+6144); kf[7]=*(const __attribute__((address_space(3))) bf16x8*)(kp+6656);
}
__device__ __forceinline__ void kload2(bf16x8*kf,lds_cptr kp,int j){ kf[2*j]=*(const __attribute__((address_space(3))) bf16x8*)(kp+j*2048); kf[2*j+1]=*(const __attribute__((address_space(3))) bf16x8*)(kp+j*2048+512); }
__device__ __forceinline__ s16x4 vtr(lds_cptr p){ return __builtin_bit_cast(s16x4,__builtin_amdgcn_ds_read_tr16_b64_v4i16((__attribute__((address_space(3))) v4i16_t*)p)); }
__device__ __forceinline__ float rowmax(const f32x16&p0,const f32x16&p1){
  float a=max3f(p0[0],p0[1],p1[0]),b=max3f(p0[2],p0[3],p1[1]);a=max3f(a,p1[2],p1[3]);
  #pragma unroll
  for(int r=4;r<16;r+=4){a=max3f(a,p0[r],p0[r+1]);b=max3f(b,p0[r+2],p0[r+3]);a=max3f(a,p1[r],p1[r+1]);b=max3f(b,p1[r+2],p1[r+3]);}
  const float m=max2f(a,b);
  auto rr=__builtin_amdgcn_permlane32_swap(__float_as_uint(m),__float_as_uint(m),false,false);
  return max2f(__uint_as_float(rr[0]),__uint_as_float(rr[1]));
}
__device__ __forceinline__ void pv(f32x16*o,int vb,bf16x8 pa0,bf16x8 pa1,bf16x8 pa2,bf16x8 pa3){
  #pragma unroll
  for(int d0=0;d0<2;++d0){s16x4 lo[4],hi[4];
    #pragma unroll
    for(int ks=0;ks<4;++ks){
      asm volatile("ds_read_b64_tr_b16 %0,%1 offset:%c2":"=&v"(lo[ks]):"v"(vb),"i"(d0*4096+ks*1024):"memory");
      asm volatile("ds_read_b64_tr_b16 %0,%1 offset:%c2":"=&v"(hi[ks]):"v"(vb),"i"(d0*4096+ks*1024+512):"memory");}
    asm volatile("s_waitcnt lgkmcnt(0)":::"memory");SBAR();
    #define PK(k) (bf16x8){lo[k][0],lo[k][1],lo[k][2],lo[k][3],hi[k][0],hi[k][1],hi[k][2],hi[k][3]}
    o[d0]=__builtin_amdgcn_mfma_f32_32x32x16_bf16(pa0,PK(0),o[d0],0,0,0);
    o[d0]=__builtin_amdgcn_mfma_f32_32x32x16_bf16(pa1,PK(1),o[d0],0,0,0);
    o[d0]=__builtin_amdgcn_mfma_f32_32x32x16_bf16(pa2,PK(2),o[d0],0,0,0);
    o[d0]=__builtin_amdgcn_mfma_f32_32x32x16_bf16(pa3,PK(3),o[d0],0,0,0);
    #undef PK
  }
}
#define ATTN_STORE16(p,v) (*(u32x4*)(p)=(v))
template<int THRL> __device__ __forceinline__ void attn_unit(int b,int h,int qb,const bf16*Q,const bf16*__restrict__ K,const bf16*__restrict__ V,bf16*O,char*shm,const float*qgain,const float sbound){
  int tid_=threadIdx.x; asm volatile("":"+v"(tid_));
  const int tid=tid_,lane=tid&63,r32=lane&31,hi=lane>>5; const int wid=__builtin_amdgcn_readfirstlane(tid>>6);
  const long rowbase=(long)b*SEQ; const int q0=qb*QB; const int kvh=h/(NHEAD/NKVH);
  const bf16*Qw=Q+(rowbase+q0+wid*QBLK)*QP+h*D;
  const bf16*Kh=K+rowbase*KP+kvh*D,*Vh=V+rowbase*VP+kvh*D;
  const unsigned lds0=(unsigned)(uintptr_t)shm;
  float*wsf=(float*)(shm+LDS_WS)+wid*64;
  const bf16*ksrc=Kh+(long)lane*KP+wid*8;
  const bf16*vsrc=Vh+(long)(16*(wid&3)+(lane>>2))*VP+(wid>>2)*32+(lane&3)*8;
  const unsigned kdst=lds0+LDS_K+wid*1024, vdst=lds0+LDS_V+wid*1024;
  #define DMA_K(t,slot) glds16(ksrc+(long)(t)*KVBLK*KP,(unsigned)__builtin_amdgcn_readfirstlane(kdst+(slot)))
  #define DMA_V(t,slot) glds16(vsrc+(long)(t)*KVBLK*VP,(unsigned)__builtin_amdgcn_readfirstlane(vdst+(slot)))
  const int vb0=(int)(lds0+LDS_V)+((lane>>4)&1)*32+(lane&3)*8+(4*hi+((lane&15)>>2))*64;
  const char*Kbase=shm+LDS_K; bf16x8 kf[8];
  const lds_cptr shm3=(lds_cptr)shm; const lds_cptr kp0=shm3+LDS_K+hi*1024+r32*16; const lds_cptr vp0=shm3+LDS_V+((lane>>4)&1)*32+(lane&3)*8+(4*hi+((lane&15)>>2))*64;
  constexpr int NT=SEQ/KVBLK;
  DMA_K(0,0);DMA_V(0,0);DMA_K(1,SLOTB);
  bf16x8 qr[4];
  #pragma unroll
  for(int d0=0;d0<4;++d0)qr[d0]=*reinterpret_cast<const bf16x8*>(&Qw[(long)r32*QP+d0*16+hi*8]);
  { float xq[4][8]; float ss=0.f; int hio=hi; asm volatile("":"+v"(hio));
    #pragma unroll
    for(int d0=0;d0<4;++d0)
      #pragma unroll
      for(int j=0;j<8;++j){ xq[d0][j]=__builtin_bit_cast(float,((unsigned)(unsigned short)qr[d0][j])<<16); ss+=xq[d0][j]*xq[d0][j]; }
    ss+=__shfl_xor(ss,32);
    const float rinv=__builtin_amdgcn_rsqf(ss*(1.f/64.f)+1e-6f);
    const int tq=q0+wid*QBLK+r32; const float prow=(float)(tq>>6), pcol=(float)(tq&63);
    #pragma unroll
    for(int d0=0;d0<4;++d0)
      #pragma unroll
      for(int j=0;j<8;++j) xq[d0][j]*=rinv*qgain[16*d0+8*hio+j];
    #pragma unroll
    for(int j=0;j<8;++j){ const float inv=exp2f(-(float)(8*hio+j)*(13.287712379549449f/16.f));
      const float ar=prow*inv, ac=pcol*inv; const float cr=__cosf(ar), sr=__sinf(ar), cc=__cosf(ac), sc=__sinf(ac);
      const float a0=xq[0][j], a1=xq[1][j], b0=xq[2][j], b1=xq[3][j];
      xq[0][j]=(a0*cr-a1*sr)*C2; xq[1][j]=(a1*cr+a0*sr)*C2; xq[2][j]=(b0*cc-b1*sc)*C2; xq[3][j]=(b1*cc+b0*sc)*C2; }
    #pragma unroll
    for(int d0=0;d0<4;++d0){ u32x4 w; w.x=cvtpk_s(xq[d0][0],xq[d0][1]); w.y=cvtpk_s(xq[d0][2],xq[d0][3]); w.z=cvtpk_s(xq[d0][4],xq[d0][5]); w.w=cvtpk_s(xq[d0][6],xq[d0][7]); qr[d0]=__builtin_bit_cast(bf16x8,w); } }
  float l_reg=0.f;f32x16 o[2];o[0]=f32x16{};o[1]=f32x16{};f32x16 negm;
  #pragma unroll
  for(int r=0;r<16;++r)negm[r]=-sbound;
  asm volatile("":"+v"(negm));
  #define START(P0,P1) do{ _Pragma("unroll") for(int r=0;r<16;++r)P0[r]=__builtin_amdgcn_exp2f(P0[r]); }while(0)
  #define RESC() do{}while(0)
  f32x16 pA0,pA1,pB0,pB1;
  int sl_prev=0,sl_cur=0,sl_next=SLOTB;
  #define ROT() do{sl_prev=sl_cur;sl_cur=sl_next;sl_next=(sl_next==(NSLOT-1)*SLOTB)?0:sl_next+SLOTB;}while(0)
  DMA_K(2,2*SLOTB);
  WAIT_BAR(3);
  qkt(pA0,pA1,Kbase,qr,negm,r32,hi);asm volatile("s_nop 15\n\ts_nop 7":"+v"(pA0),"+v"(pA1));
  START(pA0,pA1);
  _Pragma("unroll") for(int r=0;r<16;++r)pA1[r]=__builtin_amdgcn_exp2f(pA1[r]);
  WAIT_BAR(0);
  DMA_K(3,0);DMA_V(1,SLOTB);
  ROT();
  kload8(kf,kp0+sl_cur);
  WAIT_BAR(2);
  s16x4 vlo[8],vhi[8]; u32x4 pw0,pw1,pw2,pw3;
  #define PKW(P,B) cvtpk_s(P[B],P[B+1])
  #define PAF(k) __builtin_bit_cast(bf16x8,pw##k)
  #define VFR(i) (bf16x8){vlo[i][0],vlo[i][1],vlo[i][2],vlo[i][3],vhi[i][0],vhi[i][1],vhi[i][2],vhi[i][3]}
  #define PIN(x) asm volatile("":"+v"(x))
  #define MX3(a,b,c) __builtin_fmaxf(__builtin_fmaxf((a),(b)),(c))
  #define GAPA(MF,A0,A1,A2,A3,W0,W1,PW) do{ MF; sacc+=A0; sacc+=A1; sacc+=A2; sacc+=A3; PIN(sacc); W0; W1; PIN(PW); SBAR(); }while(0)
  #define EX(v) __builtin_amdgcn_exp2f(v)
  #define GAPB(MF,X,B) do{ MF; X[B]=EX(X[B]); X[B+1]=EX(X[B+1]); X[B+2]=EX(X[B+2]); X[B+3]=EX(X[B+3]); PIN(X); SBAR(); }while(0)
  #define VRD(i) do{ vlo[i]=vtr(vp_+(((i)>>2)*4096+((i)&3)*1024)); vhi[i]=vtr(vp_+(((i)>>2)*4096+((i)&3)*1024+512)); }while(0)
  #define KRD(G,j) do{ if(G){ kload2(kf,kp0+sl_next,j); SBAR(); } }while(0)
  #define STEP(C0,C1,P0,P1,t,GK,GV,GL) do{ SBAR(); \
    const lds_cptr vp_=vp0+sl_prev; \
    VRD(0); SBAR(); float sacc=(P0[0]+P0[1]); \
    GAPA(C0=__builtin_amdgcn_mfma_f32_32x32x16_bf16(kf[0],qr[0],negm,0,0,0), P0[2],P0[3],P0[4],P0[5],     pw0[0]=PKW(P0,0), pw0[1]=PKW(P0,2), pw0); \
    VRD(4); SBAR(); GAPA(C1=__builtin_amdgcn_mfma_f32_32x32x16_bf16(kf[1],qr[0],negm,0,0,0), P0[6],P0[7],P0[8],P0[9],     pw0[2]=PKW(P0,4), pw0[3]=PKW(P0,6), pw0); \
    VRD(1); SBAR(); GAPA(C0=__builtin_amdgcn_mfma_f32_32x32x16_bf16(kf[2],qr[1],C0,0,0,0),   P0[10],P0[11],P0[12],P0[13], pw1[0]=PKW(P0,8), pw1[1]=PKW(P0,10), pw1); \
    VRD(5); SBAR(); GAPA(C1=__builtin_amdgcn_mfma_f32_32x32x16_bf16(kf[3],qr[1],C1,0,0,0),   P0[14],P0[15],P1[0],P1[1],   pw1[2]=PKW(P0,12),pw1[3]=PKW(P0,14), pw1); \
    VRD(2); SBAR(); GAPA(C0=__builtin_amdgcn_mfma_f32_32x32x16_bf16(kf[4],qr[2],C0,0,0,0),   P1[2],P1[3],P1[4],P1[5],     pw2[0]=PKW(P1,0), pw2[1]=PKW(P1,2), pw2); \
    VRD(6); SBAR(); GAPA(C1=__builtin_amdgcn_mfma_f32_32x32x16_bf16(kf[5],qr[2],C1,0,0,0),   P1[6],P1[7],P1[8],P1[9],     pw2[2]=PKW(P1,4), pw2[3]=PKW(P1,6), pw2); \
    VRD(3); SBAR(); GAPA(C0=__builtin_amdgcn_mfma_f32_32x32x16_bf16(kf[6],qr[3],C0,0,0,0),   P1[10],P1[11],P1[12],P1[13], pw3[0]=PKW(P1,8), pw3[1]=PKW(P1,10), pw3); \
    VRD(7); SBAR(); GAPA(C1=__builtin_amdgcn_mfma_f32_32x32x16_bf16(kf[7],qr[3],C1,0,0,0),   P1[14],P1[15],0.f,0.f,       pw3[2]=PKW(P1,12),pw3[3]=PKW(P1,14), pw3); \
    l_reg+=sacc; \
    if(GK){DMA_K((t)+3,sl_cur);} if(GV){DMA_V((t)+1,sl_next);} \
    SBAR(); \
    GAPB(o[0]=__builtin_amdgcn_mfma_f32_32x32x16_bf16(PAF(0),VFR(0),o[0],0,0,0), C0,0); \
    GAPB(o[1]=__builtin_amdgcn_mfma_f32_32x32x16_bf16(PAF(0),VFR(4),o[1],0,0,0), C0,4); \
    KRD(GL,0); GAPB(o[0]=__builtin_amdgcn_mfma_f32_32x32x16_bf16(PAF(1),VFR(1),o[0],0,0,0), C0,8); \
    KRD(GL,1); GAPB(o[1]=__builtin_amdgcn_mfma_f32_32x32x16_bf16(PAF(1),VFR(5),o[1],0,0,0), C0,12); \
    KRD(GL,2); GAPB(o[0]=__builtin_amdgcn_mfma_f32_32x32x16_bf16(PAF(2),VFR(2),o[0],0,0,0), C1,0); \
    KRD(GL,3); GAPB(o[1]=__builtin_amdgcn_mfma_f32_32x32x16_bf16(PAF(2),VFR(6),o[1],0,0,0), C1,4); \
    GAPB(o[0]=__builtin_amdgcn_mfma_f32_32x32x16_bf16(PAF(3),VFR(3),o[0],0,0,0), C1,8); \
    GAPB(o[1]=__builtin_amdgcn_mfma_f32_32x32x16_bf16(PAF(3),VFR(7),o[1],0,0,0), C1,12); \
    }while(0)
  int t=1;
  for(;t+5<NT;t+=2){
    STEP(pB0,pB1,pA0,pA1,t,true,true,true);     WAIT_BAR(2); RESC(); ROT();
    STEP(pA0,pA1,pB0,pB1,t+1,true,true,true);   WAIT_BAR(2); RESC(); ROT();
  }
  #define ENDW(tt) do{ if((tt)+3<NT){WAIT_BAR(2);} else if((tt)+2<NT){WAIT_BAR(1);} else {WAIT_BAR(0);} }while(0)
  for(;t+1<NT;t+=2){
    STEP(pB0,pB1,pA0,pA1,t,(t+3<NT),(t+1<NT),(t+1<NT));       ENDW(t);   RESC(); ROT();
    STEP(pA0,pA1,pB0,pB1,t+1,(t+4<NT),(t+2<NT),(t+2<NT));     ENDW(t+1); RESC(); ROT();
  }
  STEP(pB0,pB1,pA0,pA1,NT-1,false,false,false); RESC();
  { float sacc=pB0[0]+pB0[1]; _Pragma("unroll") for(int r=2;r<16;++r)sacc+=pB0[r]; _Pragma("unroll") for(int r=0;r<16;++r)sacc+=pB1[r]; l_reg+=sacc;
    pw0=(u32x4){PKW(pB0,0),PKW(pB0,2),PKW(pB0,4),PKW(pB0,6)};pw1=(u32x4){PKW(pB0,8),PKW(pB0,10),PKW(pB0,12),PKW(pB0,14)};pw2=(u32x4){PKW(pB1,0),PKW(pB1,2),PKW(pB1,4),PKW(pB1,6)};pw3=(u32x4){PKW(pB1,8),PKW(pB1,10),PKW(pB1,12),PKW(pB1,14)};
    SBAR(); pv(o,vb0+sl_cur,PAF(0),PAF(1),PAF(2),PAF(3)); }
  #undef PKW
  #undef PAF
  #undef VFR
  #undef PIN
  #undef MX3
  #undef GAPA
  #undef GAPB
  #undef EX
  #undef VRD
  #undef KRD
  #undef STEP
  #undef ENDW
  {auto rr=__builtin_amdgcn_permlane32_swap(__float_as_uint(l_reg),__float_as_uint(l_reg),false,false);l_reg=__uint_as_float(rr[0])+__uint_as_float(rr[1]);}
  if(hi==0)wsf[32+r32]=l_reg;asm volatile("s_waitcnt lgkmcnt(0)":::"memory");
  float rli[16];
  #pragma unroll
  for(int r=0;r<16;++r)rli[r]=__builtin_amdgcn_rcpf(wsf[32+crow(r,hi)]);
  bf16*Ow=O+(rowbase+q0+wid*QBLK)*OP+OCOL+h*D;
  { bf16*stg=(bf16*)(shm+LDS_OST)+wid*2048;
    #pragma unroll
    for(int r=0;r<16;++r){const int orow=crow(r,hi);
      #pragma unroll
      for(int d0=0;d0<2;++d0)stg[orow*64+d0*32+r32]=__float2bfloat16(o[d0][r]*rli[r]);}
    asm volatile("s_waitcnt lgkmcnt(0)":::"memory");
    #pragma unroll
    for(int i=0;i<4;++i){const int row=i*8+(lane>>3),ch=lane&7; const u32x4 v=*(const u32x4*)(stg+row*64+ch*8); ATTN_STORE16(Ow+(long)row*OP+ch*8,v);} }
  asm volatile("s_waitcnt lgkmcnt(0)\n\ts_barrier":::"memory");
  #undef DMA_K
  #undef DMA_V
  #undef START
  #undef RESC
  #undef ROT
}
constexpr int ATTN_LDS_BYTES=LDS_BYTES;
#undef SBAR
#undef WAIT_BAR
}
constexpr int NWAVES = 8;
constexpr int BATCH = 8, SEQ = 4096, DM = 1024, T = BATCH * SEQ;
constexpr int GLA_H = 4, GLA_DK = 64, GLA_DV = 128, GLA_RANK = 16;
constexpr int ATT_H = 8, ATT_KVH = 2, ATT_DH = 64;
constexpr int D_IN = 2336, D_IN_PAD = 2560;
constexpr int NEXP = 32, TOPK = 4, DFF = 1024;
constexpr int EROWS = 32768;
constexpr int PROWS = T * TOPK + NEXP * 256;
constexpr float EPS = 1e-6f;
constexpr float YSCALE = 16.f;
constexpr float WSCALE = 32.f, ASCALE = 4.f;

constexpr size_t MiB = 1u << 20;
constexpr size_t WS_CTL = 0, CTL_ZERO_BYTES = 1 * MiB;
constexpr size_t WS_WRH = 1 * MiB, WS_WRL = WS_WRH + 65536;
constexpr size_t WS_WIN = 2 * MiB;
constexpr size_t WS_WOUT = 8 * MiB;
constexpr size_t WS_W1 = 10 * MiB;
constexpr size_t WS_W2 = 138 * MiB;
constexpr size_t WS_ROWTOK = 202 * MiB;
constexpr size_t WS_ROWGATE = 206 * MiB;
constexpr size_t WS_TOKASG = 210 * MiB;
constexpr size_t WS_REGY = 212 * MiB;
constexpr size_t WS_XN = WS_REGY;
constexpr size_t WS_GQ = WS_XN + 64 * MiB;
constexpr size_t WS_GK = WS_GQ + 16 * MiB;
constexpr size_t WS_GV = WS_GK + 16 * MiB;
constexpr size_t WS_GR = WS_GV + 32 * MiB;
constexpr size_t WS_AQ = WS_GR + 32 * MiB;
constexpr size_t WS_AK = WS_AQ + 32 * MiB;
constexpr size_t WS_AV = WS_AK + 8 * MiB;
constexpr size_t WS_Z = WS_AV + 8 * MiB;
constexpr size_t WS_OF = WS_Z + 2 * MiB;
constexpr size_t WS_Y = WS_REGY;
constexpr size_t WS_REGA = WS_REGY + 274 * MiB;
constexpr size_t WS_MIX = WS_REGA;
constexpr size_t WS_ACT = WS_REGA;
constexpr size_t WS_QF = WS_REGA + 272 * MiB, WS_KF = WS_QF + 16 * MiB, WS_QB = WS_KF + 16 * MiB, WS_KB = WS_QB + 16 * MiB;
constexpr size_t WS_DEC = WS_KB + 16 * MiB;
constexpr size_t WS_END = WS_DEC + 1 * MiB;
static_assert(WS_OF + (size_t)T * 512 * 4 <= WS_REGA && (size_t)PROWS * 1024 * 2 <= 272 * MiB, "d_ws map");
constexpr int CW_BAR = 4096;
constexpr int CW_CNT = 8192;
constexpr int CW_CONV = 20480;
constexpr int CW_GDN = 16384;
constexpr int CW_QUE = 12288;

constexpr int SCR_BYTES = 133120;
constexpr int LC_OFF = SCR_BYTES;
constexpr int LC_MISC = LC_OFF;
constexpr int LC_CNT = LC_OFF + 128;
constexpr int LC_CST = LC_CNT + 128;
constexpr int LC_TE = LC_CST + 256;
constexpr int LC_HIST = LC_TE + 1152;
constexpr int LC_BASE = LC_HIST + 128;
constexpr int LC_ASG = LC_BASE + 128;
constexpr int LC_GDEC = LC_ASG + 8192;
constexpr int LC_END = LC_GDEC + 512;
constexpr int LDS_BYTES = 147456;
static_assert(LC_END <= LDS_BYTES, "LDS map");

typedef unsigned short bf16;
typedef unsigned v4u __attribute__((ext_vector_type(4)));
typedef unsigned v2u __attribute__((ext_vector_type(2)));
typedef float f32x4 __attribute__((ext_vector_type(4)));
typedef short bf16x8 __attribute__((ext_vector_type(8)));
typedef GAS unsigned gu32;
#define RLX_AGENT __ATOMIC_RELAXED, __HIP_MEMORY_SCOPE_AGENT
#define LDS_WAIT() asm volatile("s_waitcnt lgkmcnt(0)" ::: "memory")
#define VM_WAIT() asm volatile("s_waitcnt vmcnt(0)" ::: "memory")
__device__ __forceinline__ unsigned pk2(float lo, float hi) { typedef float f2_t_ __attribute__((ext_vector_type(2))); typedef __bf16 b2_t_ __attribute__((ext_vector_type(2))); const f2_t_ v = {lo, hi}; return __builtin_bit_cast(unsigned, __builtin_convertvector(v, b2_t_)); }
__device__ __forceinline__ unsigned f2bf(float f) { return pk2(f, 0.f) & 0xffffu; }
__device__ __forceinline__ float bf2f(unsigned h) { return __builtin_bit_cast(float, h << 16); }
__device__ __forceinline__ float bflo(unsigned w) { return __builtin_bit_cast(float, w << 16); }
__device__ __forceinline__ float bfhi(unsigned w) { return __builtin_bit_cast(float, w & 0xffff0000u); }

#define XB_TMO      128
#define XB_XCNT(j)  (256  + 64 * (j))
#define XB_XSUB(j)  (1280 + 64 * (j))
#define XB_XGEN(j)  (2304 + 64 * (j))
#define XB_TOP      3328
#define XB_TOPGEN   3392
#define XCD_BAR_WORDS 3456
#define XB_SPIN_CAP (1u << 18)
__device__ __forceinline__ unsigned xb_ld(unsigned* p)              { return __hip_atomic_load(p, __ATOMIC_RELAXED, __HIP_MEMORY_SCOPE_AGENT); }
__device__ __forceinline__ unsigned xb_add(unsigned* p, unsigned v) { return __hip_atomic_fetch_add(p, v, __ATOMIC_RELAXED, __HIP_MEMORY_SCOPE_AGENT); }
__device__ __forceinline__ unsigned xb_xcc_id() { return (unsigned)__builtin_amdgcn_s_getreg((3 << 11) | 20) & 0xFu; }
#define XB_SPIN(cond, bar) do { unsigned _sp = 0; while (cond) { __builtin_amdgcn_s_sleep(1); \
    if ((++_sp & 255u) == 0u) { if (xb_ld(&(bar)[XB_TMO])) break; if (_sp > XB_SPIN_CAP) { atomicAdd(&(bar)[XB_TMO], 1u); break; } } } } while (0)
struct XcdBarrier { unsigned* bar; unsigned x; volatile LAS unsigned* st; };
__device__ __forceinline__ XcdBarrier xcd_barrier_post(unsigned* bar, volatile LAS unsigned* st) {
    XcdBarrier b; b.bar = bar; b.x = xb_xcc_id(); b.st = st;
    if (threadIdx.x == 0) (void)xb_add(&bar[XB_XCNT(b.x)], 1u);
    return b;
}
__device__ __forceinline__ void xcd_barrier_complete(unsigned* bar, unsigned x, unsigned& nloc, unsigned& nx) {
    const unsigned G = gridDim.x * gridDim.y * gridDim.z;
    unsigned sum, cnt, mine, sp = 0u;
    for (;;) {
        sum = 0u; cnt = 0u; mine = 0u;
#pragma unroll
        for (unsigned j = 0; j < 16; ++j) { const unsigned c = xb_ld(&bar[XB_XCNT(j)]); sum += c; cnt += (c > 0u) ? 1u : 0u; mine = (j == x) ? c : mine; }
        if (sum == G) break;
        __builtin_amdgcn_s_sleep(1);
        if ((++sp & 255u) == 0u) { if (xb_ld(&bar[XB_TMO])) break; if (sp > XB_SPIN_CAP) { atomicAdd(&bar[XB_TMO], 1u); break; } }
    }
    nloc = mine > 0u ? mine : 1u; nx = cnt > 0u ? cnt : 1u;
}
__device__ __forceinline__ void xcd_barrier(const XcdBarrier& b) {
    asm volatile("s_waitcnt vmcnt(0)" ::: "memory");
    __syncthreads();
    if (threadIdx.x == 0) {
        unsigned* bar = b.bar;
        __builtin_amdgcn_s_waitcnt(0);
        unsigned nloc = b.st[0], nx = b.st[1];
        if (nloc == 0u) { xcd_barrier_complete(bar, b.x, nloc, nx); b.st[0] = nloc; b.st[1] = nx; }
        const unsigned old = xb_add(&bar[XB_XSUB(b.x)], 1u);
        const unsigned gen = old / nloc;
        if (old + 1u == (gen + 1u) * nloc) {
            __builtin_amdgcn_fence(__ATOMIC_RELEASE, "agent");
            asm volatile("s_waitcnt vmcnt(0)" ::: "memory");
            const unsigned og = xb_add(&bar[XB_TOP], 1u);
            const unsigned tg = og / nx;
            if (og + 1u == (tg + 1u) * nx) xb_add(&bar[XB_TOPGEN], 1u);
            else XB_SPIN(xb_ld(&bar[XB_TOPGEN]) == tg, bar);
            __builtin_amdgcn_fence(__ATOMIC_ACQUIRE, "agent");
            xb_add(&bar[XB_XGEN(b.x)], 1u);
            asm volatile("s_waitcnt vmcnt(0)" ::: "memory");
        } else {
            XB_SPIN(xb_ld(&bar[XB_XGEN(b.x)]) == gen, bar);
            __builtin_amdgcn_fence(__ATOMIC_ACQUIRE, "agent");
            asm volatile("s_waitcnt vmcnt(0)" ::: "memory");
        }
    }
    __syncthreads();
}

struct Frame {
    LAS unsigned char* lds;
    volatile LAS unsigned* MISC;
    gu32* ctl;
    int tid, lane, wave;
    int vcu, G;
    unsigned char* ws;
    const float *x, *mix_g, *w_in, *w_gf, *b_gf, *w_gb, *b_gb, *gla_hg, *q_g, *k_g, *w_out, *ffn_g, *w_router, *b_router, *w1, *b1, *w2, *b2, *fin_g;
    float* out;
};
template <int CTRL> __device__ __forceinline__ float dpp_mov(float v) { return __builtin_bit_cast(float, __builtin_amdgcn_update_dpp(0, __builtin_bit_cast(int, v), CTRL, 0xf, 0xf, true)); }
__device__ __forceinline__ float wave_sum(float v) {
    v += dpp_mov<0xB1>(v);
    v += dpp_mov<0x4E>(v);
    v += dpp_mov<0x141>(v);
    v += dpp_mov<0x140>(v);
    { auto r = __builtin_amdgcn_permlane16_swap(__float_as_uint(v), __float_as_uint(v), false, false); v = __uint_as_float(r[0]) + __uint_as_float(r[1]); }
    { auto r = __builtin_amdgcn_permlane32_swap(__float_as_uint(v), __float_as_uint(v), false, false); v = __uint_as_float(r[0]) + __uint_as_float(r[1]); }
    return v;
}
__device__ __forceinline__ void p0_tr64(const float* src  , int ldw, bf16* d0, bf16* d1, int ldt, LAS float* scr, int lane, int ncols) {
    const int c4 = (lane & 15) * 4, kr = lane >> 4;
    if (c4 < ncols) {
#pragma unroll 4
        for (int i = 0; i < 16; ++i) { const int kk = kr + 4 * i; const f32x4 v = *(const GAS f32x4*)(src + (size_t)kk * ldw + c4);
            LAS float* s = scr + kk * 65 + c4; s[0] = v.x; s[1] = v.y; s[2] = v.z; s[3] = v.w; }
    }
    LDS_WAIT(); asm volatile("" ::: "memory");
    const int c = lane & 7;
#pragma unroll
    for (int j = 0; j < 8; ++j) { const int n = (lane >> 3) + 8 * j;
        if (n < ncols) { const LAS float* s = scr + (8 * c) * 65 + n;
            v4u o; o.x = pk2(s[0 * 65], s[1 * 65]); o.y = pk2(s[2 * 65], s[3 * 65]); o.z = pk2(s[4 * 65], s[5 * 65]); o.w = pk2(s[6 * 65], s[7 * 65]);
            bf16* rowp = (n < 32 ? d0 : d1) + (size_t)(n & 31) * ldt;
            *(GAS v4u*)(rowp + 8 * c) = o; } }
    LDS_WAIT(); asm volatile("" ::: "memory");
}
struct F8Item { const float* src; int ldw; unsigned char* d0; unsigned char* d1; };
__device__ __forceinline__ void f8_load(const F8Item& it, f32x4 (&v)[16], int lane) {
    const int c4 = (lane & 15) * 4, kr = lane >> 4;
#pragma unroll
    for (int i = 0; i < 16; ++i) v[i] = __builtin_nontemporal_load((const GAS f32x4*)(it.src + (size_t)(kr + 4 * i) * it.ldw + c4));
}
__device__ __forceinline__ void f8_finish(const F8Item& it, const f32x4 (&v)[16], LAS float* scr, int lane, float sc) {
    const int c4 = (lane & 15) * 4, kr = lane >> 4;
#pragma unroll
    for (int i = 0; i < 16; ++i) { LAS float* s = scr + (kr + 4 * i) * 65 + c4; s[0] = v[i].x; s[1] = v[i].y; s[2] = v[i].z; s[3] = v[i].w; }
    LDS_WAIT(); asm volatile("" ::: "memory");
    const int c = lane & 7;
#pragma unroll
    for (int j = 0; j < 8; ++j) { const int n = (lane >> 3) + 8 * j; const LAS float* s = scr + (8 * c) * 65 + n;
        int w0 = 0, w1 = 0;
        w0 = __builtin_amdgcn_cvt_pk_fp8_f32(s[0 * 65] * sc, s[1 * 65] * sc, w0, false); w0 = __builtin_amdgcn_cvt_pk_fp8_f32(s[2 * 65] * sc, s[3 * 65] * sc, w0, true);
        w1 = __builtin_amdgcn_cvt_pk_fp8_f32(s[4 * 65] * sc, s[5 * 65] * sc, w1, false); w1 = __builtin_amdgcn_cvt_pk_fp8_f32(s[6 * 65] * sc, s[7 * 65] * sc, w1, true);
        unsigned char* rowp = (n < 32 ? it.d0 : it.d1) + (size_t)(n & 31) * 1024;
        __builtin_nontemporal_store((v2u){(unsigned)w0, (unsigned)w1}, (GAS v2u*)(rowp + 8 * c)); }
    LDS_WAIT(); asm volatile("" ::: "memory");
}
__device__ __forceinline__ int win_pblk(int lb) { return lb < 48 ? lb : (lb == 48 ? 72 : lb - 1); }
__device__ __forceinline__ int w1_pblk(int lb) { return lb < 32 ? (lb >> 2) * 8 + (lb & 3) : ((lb - 32) >> 2) * 8 + 4 + ((lb - 32) & 3); }
__device__ __forceinline__ void rms_row_to_bf16(const float* xrow, const float* g, bf16* orow, int lane) {
    const GAS f32x4* xr = (const GAS f32x4*)xrow + lane; const GAS f32x4* gr = (const GAS f32x4*)g + lane;
    f32x4 v[4]; float s = 0.f;
#pragma unroll
    for (int j = 0; j < 4; ++j) { v[j] = __builtin_nontemporal_load(xr + 64 * j); s += (v[j].x * v[j].x + v[j].y * v[j].y) + (v[j].z * v[j].z + v[j].w * v[j].w); }
    const float rinv = 1.f / sqrtf(wave_sum(s) * (1.f / 1024.f) + EPS);
    GAS unsigned long long* o8 = (GAS unsigned long long*)orow + lane;
#pragma unroll
    for (int j = 0; j < 4; ++j) { const f32x4 gg = gr[64 * j];
        o8[64 * j] = (unsigned long long)pk2(v[j].x * rinv * gg.x, v[j].y * rinv * gg.y) | ((unsigned long long)pk2(v[j].z * rinv * gg.z, v[j].w * rinv * gg.w) << 32); }
}
__device__ __forceinline__ F8Item f8_item(Frame& F, int r) {
    F8Item it;
    if (r < NEXP * 512) { const int e = r / 512, q = r % 512, kb = q / 32, nb = q % 32; it.src = F.w1 + (size_t)e * 1024 * 2048 + (size_t)(64 * kb) * 2048 + 64 * nb; it.ldw = 2048;
        unsigned char* dst = F.ws + WS_W1 + (size_t)e * 2048 * 1024 + 64 * kb; it.d0 = dst + (size_t)(32 * w1_pblk(2 * nb)) * 1024; it.d1 = dst + (size_t)(32 * w1_pblk(2 * nb + 1)) * 1024; }
    else { const int r2 = r - NEXP * 512, e = r2 / 256, q = r2 % 256, kb = q / 16, nb = q % 16; it.src = F.w2 + (size_t)e * 1024 * 1024 + (size_t)(64 * kb) * 1024 + 64 * nb; it.ldw = 1024;
        unsigned char* dst = F.ws + WS_W2 + (size_t)e * 1024 * 1024 + 64 * kb; it.d0 = dst + (size_t)(64 * nb) * 1024; it.d1 = dst + (size_t)(64 * nb + 32) * 1024; }
    return it;
}
constexpr int N_F8_ITEMS = NEXP * 512 + NEXP * 256, N_CONV_BATCH = N_F8_ITEMS / 64;
__device__ __forceinline__ void f8_items(Frame& F, int r, int step, int rend, LAS float* scr) {
    if (r >= rend) return;
    F8Item cur = f8_item(F, r); f32x4 va[16], vb[16];
    f8_load(cur, va, F.lane);
    for (;;) {
        int rn = r + step; F8Item nx = cur; if (rn < rend) { nx = f8_item(F, rn); f8_load(nx, vb, F.lane); }
        f8_finish(cur, va, scr, F.lane, WSCALE);
        if (rn >= rend) break;
        r = rn + step; cur = nx; if (r < rend) { cur = f8_item(F, r); f8_load(cur, va, F.lane); }
        f8_finish(nx, vb, scr, F.lane, WSCALE);
        if (r >= rend) break;
    }
}
__device__ __forceinline__ bool conv_pull(Frame& F) {
    __syncthreads();
    if (F.tid == 0) F.MISC[17] = __hip_atomic_fetch_add(F.ctl + CW_CONV, 1u, RLX_AGENT);
    __syncthreads();
    const int cb = __builtin_amdgcn_readfirstlane((int)F.MISC[17]);
    if (cb >= N_CONV_BATCH) return false;
    f8_items(F, cb * 64 + F.wave * 8, 1, cb * 64 + F.wave * 8 + 8, (LAS float*)(F.lds + F.wave * 16640));
    return true;
}
__device__ __forceinline__ void p0_prologue(Frame& F) {
    LAS float* scr = (LAS float*)(F.lds + F.wave * 16640);
    const int gw = F.vcu * NWAVES + F.wave, NGW = F.G * NWAVES;
    bf16* WIN = (bf16*)(F.ws + WS_WIN); bf16* WOUT = (bf16*)(F.ws + WS_WOUT);
    constexpr int I_IN = 16 * 37, I_OUT = 16 * 16, NITEMS = I_IN + I_OUT;
    for (int it = gw; it < NITEMS; it += NGW) {
        int r = it;
        if (r < I_IN) { const int kb = r / 37, nb = r % 37; const int lb0 = 2 * nb, nc = (nb == 36) ? 32 : 64;
            p0_tr64(F.w_in + (size_t)(64 * kb) * D_IN + 64 * nb, D_IN, WIN + (size_t)(32 * win_pblk(lb0)) * 1024 + 64 * kb, WIN + (size_t)(32 * win_pblk(lb0 + 1 < 73 ? lb0 + 1 : lb0)) * 1024 + 64 * kb, 1024, scr, F.lane, nc); continue; }
        r -= I_IN;
        { const int kb = r / 16, nb = r % 16;
            p0_tr64(F.w_out + (size_t)(64 * kb) * 1024 + 64 * nb, 1024, WOUT + (size_t)(64 * nb) * 1024 + 64 * kb, WOUT + (size_t)(64 * nb + 32) * 1024 + 64 * kb, 1024, scr, F.lane, 64); }
    }
    { const int gt = F.vcu * (NWAVES * 64) + F.tid, NGT = F.G * NWAVES * 64; GAS v4u* z = (GAS v4u*)(WIN + (size_t)D_IN * 1024);
      for (int i = gt; i < (D_IN_PAD - D_IN) * 1024 * 2 / 16; i += NGT) z[i] = (v4u){0u, 0u, 0u, 0u};
      bf16* WRH = (bf16*)(F.ws + WS_WRH); bf16* WRL = (bf16*)(F.ws + WS_WRL);
      for (int i = gt; i < NEXP * 1024; i += NGT) { const int e = i >> 10, k = i & 1023; const float w = F.w_router[(size_t)k * NEXP + e]; const unsigned h = f2bf(w); WRH[i] = (bf16)h; WRL[i] = (bf16)f2bf(w - bf2f(h)); } }
    bf16* XN = (bf16*)(F.ws + WS_XN);
    for (int m = gw; m < T; m += NGW) rms_row_to_bf16(F.x + (size_t)m * DM, F.mix_g, XN + (size_t)m * DM, F.lane);
}

__device__ __forceinline__ void p2_normrope(Frame& F) {
    LAS float* cs = (LAS float*)F.lds;
    for (int i = F.tid; i < 1024; i += NWAVES * 64) { const int pos = i >> 4, fi = i & 15; const float inv = exp2f(-(float)fi * (13.287712379549449f / 16.f)); const float a = (float)pos * inv;
        cs[2 * i] = __cosf(a); cs[2 * i + 1] = __sinf(a); }
    __syncthreads();
    const int gw = F.vcu * NWAVES + F.wave, NGW = F.G * NWAVES, lane = F.lane;
    const int j = lane & 7, blk = (j >> 2) & 1, jj = j & 3, fi0 = 8 * (jj & 1); const bool second = (jj >> 1) != 0;
    float gq[8], gk[8];
#pragma unroll
    for (int e = 0; e < 8; ++e) { gq[e] = F.q_g[8 * j + e]; gk[e] = F.k_g[8 * j + e]; }
    bf16* AQ = (bf16*)(F.ws + WS_AQ); bf16* AK = (bf16*)(F.ws + WS_AK);
    for (int it = T + gw; it < T + T / 4; it += NGW) {
        const bool isq = it < T;
        const int tok = isq ? it : 4 * (it - T) + (lane >> 4);
        GAS v4u* p = isq ? (GAS v4u*)(AQ + (size_t)tok * 512) + lane : (GAS v4u*)(AK + (size_t)tok * 128) + (lane & 15);
        const v4u w = *p;
        float x[8] = {bflo(w.x), bfhi(w.x), bflo(w.y), bfhi(w.y), bflo(w.z), bfhi(w.z), bflo(w.w), bfhi(w.w)};
        float ss = 0.f;
#pragma unroll
        for (int e = 0; e < 8; ++e) ss += x[e] * x[e];
        ss += __shfl_xor(ss, 1); ss += __shfl_xor(ss, 2); ss += __shfl_xor(ss, 4);
        const float rinv = 1.f / sqrtf(ss * (1.f / 64.f) + EPS);
        const int ts = tok & (SEQ - 1), pos = blk ? (ts & 63) : (ts >> 6);
        const LAS float* c = cs + (pos * 16 + fi0) * 2;
        float y[8];
#pragma unroll
        for (int e = 0; e < 8; ++e) { x[e] = x[e] * rinv * (isq ? gq[e] : gk[e]); }
#pragma unroll
        for (int e = 0; e < 8; ++e) { const float pr = __shfl_xor(x[e], 2); const float co = c[2 * e], si = c[2 * e + 1]; y[e] = second ? (x[e] * co + pr * si) : (x[e] * co - pr * si); }
        const float sc = isq ? attn_body::C2 : 1.f;
        v4u o; o.x = pk2(y[0] * sc, y[1] * sc); o.y = pk2(y[2] * sc, y[3] * sc); o.z = pk2(y[4] * sc, y[5] * sc); o.w = pk2(y[6] * sc, y[7] * sc);
        *p = o;
    }
}
namespace gla {
typedef short bf16x8 __attribute__((ext_vector_type(8)));
typedef short s16x4 __attribute__((ext_vector_type(4)));
typedef float f32x4 __attribute__((ext_vector_type(4)));
constexpr int P64 = 144, PV = 272, POT = 528;
constexpr int L_QS = 0, L_KS = 9216, L_VR = 18432, L_AS = 35840, L_ST = 45056, L_OT = 63488, L_SET2 = 97280, L_END = 133120;
constexpr int L_DEC = LC_GDEC;
__device__ __forceinline__ unsigned cvtpk(float lo, float hi) { typedef float f2_t __attribute__((ext_vector_type(2))); typedef __bf16 b2_t __attribute__((ext_vector_type(2))); f2_t v = {lo, hi}; b2_t b = __builtin_convertvector(v, b2_t); return __builtin_bit_cast(unsigned, b); }
__device__ __forceinline__ float logsig(float x) { return fminf(x, 0.f) - __logf(1.f + __expf(-fabsf(x))); }
__device__ __forceinline__ s16x4 vtr(const LAS unsigned char* p) { typedef short v4i16_t __attribute__((ext_vector_type(4))); return __builtin_bit_cast(s16x4, __builtin_amdgcn_ds_read_tr16_b64_v4i16((LAS v4i16_t*)p)); }

__device__ __forceinline__ void gla_prep_unit(Frame& F, int b, int c) {
    LAS unsigned char* L = F.lds;
    const int tid = F.tid, dir = __builtin_amdgcn_readfirstlane(tid >> 8), col = tid & 255;
    const bf16* GQ = (const bf16*)(F.ws + WS_GQ); const bf16* GK = (const bf16*)(F.ws + WS_GK); const bf16* ZZ = (const bf16*)(F.ws + WS_Z);
    bf16* QX = (bf16*)(F.ws + (dir ? WS_QB : WS_QF)); bf16* KX = (bf16*)(F.ws + (dir ? WS_KB : WS_KF)); float* DEC = (float*)(F.ws + WS_DEC) + (size_t)dir * (BATCH * 64 * 256);
    const unsigned row0 = (unsigned)b * SEQ + (unsigned)c * 64u;
    __syncthreads();
    if (tid < 256) { const int row = tid >> 2, seg = tid & 3; const v4u z = *(const GAS v4u*)(ZZ + (row0 + row) * 32 + seg * 8); LAS f32x4* zp = (LAS f32x4*)(L + row * 128 + seg * 32);
        zp[0] = (f32x4){bflo(z.x), bfhi(z.x), bflo(z.y), bfhi(z.y)}; zp[1] = (f32x4){bflo(z.z), bfhi(z.z), bflo(z.w), bfhi(z.w)}; }
    float wg[16]; const float* WG = dir ? F.w_gb : F.w_gf;
#pragma unroll
    for (int r = 0; r < 16; ++r) wg[r] = WG[r * 256 + col];
    const float bgv = (dir ? F.b_gb : F.b_gf)[col];
    __syncthreads();
    float pf[64]; float run = 0.f;
#pragma unroll
    for (int p = 0; p < 64; ++p) { const LAS f32x4* zp = (const LAS f32x4*)(L + p * 128 + dir * 64); float pre = bgv;
#pragma unroll
        for (int r4 = 0; r4 < 4; ++r4) { const f32x4 z = zp[r4]; pre += z.x * wg[4 * r4] + z.y * wg[4 * r4 + 1] + z.z * wg[4 * r4 + 2] + z.w * wg[4 * r4 + 3]; }
        run += logsig(pre) * (1.f / 16.f); pf[p] = run; }
    const float tot = run;
#pragma unroll
    for (int p = 0; p < 64; ++p) { const unsigned idx = (row0 + p) * 256 + col;
        const float qv = bf2f(GQ[idx]), kv = bf2f(GK[idx]);
        const float ex = dir ? (p ? pf[p - 1] : 0.f) : 0.f;
        const float eq = dir ? __expf(-ex) * 0.125f : __expf(pf[p] - tot) * 0.125f;
        const float ek = dir ? __expf(ex) : __expf(tot - pf[p]);
        QX[idx] = (bf16)f2bf(qv * eq); KX[idx] = (bf16)f2bf(kv * ek); }
    DEC[((unsigned)b * 64 + c) * 256 + col] = __expf(tot);
}

__device__ __forceinline__ void gla_unit(Frame& F, int b, int h, int dir) {
    LAS unsigned char* L = F.lds;
    const int tid = F.tid, lane = F.lane, w = F.wave, q4 = lane >> 4, l15 = lane & 15;
    const bf16* GV = (const bf16*)(F.ws + WS_GV);
    bf16* OX = (bf16*)(F.ws + WS_OF + (dir ? 32 * MiB : 0));
    const unsigned rowbase = (unsigned)b * SEQ;
    const int v0 = 16 * w;
    const int erow = tid >> 3, eseg = tid & 7;
    const int plq = tid >> 3, sgq = tid & 7, plv = tid >> 4, sgv = tid & 15;
    {
        const bf16* QX = (const bf16*)(F.ws + (dir ? WS_QB : WS_QF)); const bf16* KX = (const bf16*)(F.ws + (dir ? WS_KB : WS_KF));
        const float* DEC = (const float*)(F.ws + WS_DEC) + (size_t)dir * (BATCH * 64 * 256);
        f32x4 S[4];
#pragma unroll
        for (int i = 0; i < 4; ++i) S[i] = (f32x4){0.f, 0.f, 0.f, 0.f};
        v4u rq, rk, rv0, rv1; float rdec = 0.f;
#define GLA_LOAD(ci) do { const int c_ = dir ? 63 - (ci) : (ci); const unsigned cb_ = rowbase + (unsigned)c_ * 64u; \
            rq = __builtin_nontemporal_load((const GAS v4u*)(QX + (cb_ + plq) * 256 + h * 64 + sgq * 8)); rk = __builtin_nontemporal_load((const GAS v4u*)(KX + (cb_ + plq) * 256 + h * 64 + sgq * 8)); \
            rv0 = *(const GAS v4u*)(GV + (cb_ + plv) * 512 + h * 128 + sgv * 8); rv1 = *(const GAS v4u*)(GV + (cb_ + plv + 32) * 512 + h * 128 + sgv * 8); \
            if (tid < 64) rdec = DEC[((unsigned)b * 64 + c_) * 256 + h * 64 + tid]; } while (0)
        GLA_LOAD(0);
        v4u st0 = (v4u){0u, 0u, 0u, 0u}, st1 = st0;
#define GLA_FLUSH(cprev) do { const unsigned cbp_ = rowbase + (unsigned)(cprev) * 64u; GAS v4u* sp_ = (GAS v4u*)(OX + (cbp_ + erow) * 512 + h * 128 + eseg * 16); sp_[0] = st0; sp_[1] = st1; } while (0)
#define GLA_STAGE(so) do { *(LAS v4u*)(L + (so) + L_QS + plq * P64 + sgq * 16) = rq; *(LAS v4u*)(L + (so) + L_KS + plq * P64 + sgq * 16) = rk; \
            *(LAS v4u*)(L + (so) + L_VR + plv * PV + sgv * 16) = rv0; *(LAS v4u*)(L + (so) + L_VR + (plv + 32) * PV + sgv * 16) = rv1; \
            if (tid < 64) ((LAS float*)(L + L_DEC))[((so) ? 64 : 0) + tid] = rdec; } while (0)
        __syncthreads();
        GLA_STAGE(0); GLA_LOAD(1);
        __syncthreads();
        for (int ci = 0; ci < 64; ++ci) {
            const int c = dir ? 63 - ci : ci; const int so = (ci & 1) ? L_SET2 : 0, sn = (ci & 1) ? 0 : L_SET2;
#pragma unroll
            for (int s = 0; s < 2; ++s) { const int tt = 2 * w + s, it = tt >> 2, jt = tt & 3; f32x4 a = (f32x4){0.f, 0.f, 0.f, 0.f};
                if (dir ? (jt >= it) : (jt <= it)) {
#pragma unroll
                    for (int ks = 0; ks < 2; ++ks) { const bf16x8 af = *(const LAS bf16x8*)(L + so + L_QS + (16 * it + l15) * P64 + (32 * ks + 8 * q4) * 2); const bf16x8 bfr = *(const LAS bf16x8*)(L + so + L_KS + (16 * jt + l15) * P64 + (32 * ks + 8 * q4) * 2);
                        a = __builtin_amdgcn_mfma_f32_16x16x32_bf16(af, bfr, a, 0, 0, 0); } }
#pragma unroll
                for (int rg = 0; rg < 4; ++rg) { const int i = 16 * it + 4 * q4 + rg, j = 16 * jt + l15; const bool keep = dir ? (j > i) : (j <= i);
                    *(LAS unsigned short*)(L + L_AS + i * P64 + j * 2) = (unsigned short)cvtpk(keep ? a[rg] : 0.f, 0.f); } }
#pragma unroll
            for (int dt = 0; dt < 4; ++dt) { const f32x4 dv = *(const LAS f32x4*)(L + L_DEC + ((ci & 1) ? 256 : 0) + (16 * dt + 4 * q4) * 4); S[dt] = S[dt] * dv;
                *(LAS v2u*)(L + L_ST + (v0 + l15) * P64 + (16 * dt + 4 * q4) * 2) = (v2u){cvtpk(S[dt].x, S[dt].y), cvtpk(S[dt].z, S[dt].w)}; }
            __syncthreads();
            bf16x8 bv[2], bs[2];
#pragma unroll
            for (int ks = 0; ks < 2; ++ks) { const LAS unsigned char* vp = L + so + L_VR + (32 * ks + 8 * q4 + (l15 >> 2)) * PV + (v0 + 4 * (l15 & 3)) * 2;
                const s16x4 lo = vtr(vp), hi = vtr(vp + 4 * PV); bv[ks] = (bf16x8){lo[0], lo[1], lo[2], lo[3], hi[0], hi[1], hi[2], hi[3]};
                bs[ks] = *(const LAS bf16x8*)(L + L_ST + (v0 + l15) * P64 + (32 * ks + 8 * q4) * 2); }
            f32x4 O[4];
#pragma unroll
            for (int it = 0; it < 4; ++it) { O[it] = (f32x4){0.f, 0.f, 0.f, 0.f};
#pragma unroll
                for (int ks = 0; ks < 2; ++ks) { const bf16x8 aq = *(const LAS bf16x8*)(L + so + L_QS + (16 * it + l15) * P64 + (32 * ks + 8 * q4) * 2);
                    if (dir ? !(ks == 0 && it >= 2) : !(ks == 1 && it < 2)) {
                        const bf16x8 aa = *(const LAS bf16x8*)(L + L_AS + (16 * it + l15) * P64 + (32 * ks + 8 * q4) * 2); O[it] = __builtin_amdgcn_mfma_f32_16x16x32_bf16(aa, bv[ks], O[it], 0, 0, 0); }
                    O[it] = __builtin_amdgcn_mfma_f32_16x16x32_bf16(aq, bs[ks], O[it], 0, 0, 0); } }
#pragma unroll
            for (int dt = 0; dt < 4; ++dt)
#pragma unroll
                for (int ks = 0; ks < 2; ++ks) { const LAS unsigned char* kp = L + so + L_KS + (32 * ks + 8 * q4 + (l15 >> 2)) * P64 + (16 * dt + 4 * (l15 & 3)) * 2;
                    const s16x4 lo = vtr(kp), hi = vtr(kp + 4 * P64); const bf16x8 ak = (bf16x8){lo[0], lo[1], lo[2], lo[3], hi[0], hi[1], hi[2], hi[3]};
                    S[dt] = __builtin_amdgcn_mfma_f32_16x16x32_bf16(ak, bv[ks], S[dt], 0, 0, 0); }
#pragma unroll
            for (int it = 0; it < 4; ++it)
#pragma unroll
                for (int rg = 0; rg < 4; ++rg) *(LAS float*)(L + L_OT + (16 * it + 4 * q4 + rg) * POT + (v0 + l15) * 4) = O[it][rg];
            if (ci + 1 < 64) GLA_STAGE(sn);
            asm volatile("" ::: "memory");
            if (ci > 0) GLA_FLUSH(dir ? c + 1 : c - 1);
            asm volatile("" ::: "memory");
            if (ci + 2 < 64) GLA_LOAD(ci + 2);
            __syncthreads();
            {
                float o[16];
#pragma unroll
                for (int e4 = 0; e4 < 4; ++e4) { const f32x4 t = *(const LAS f32x4*)(L + L_OT + erow * POT + (16 * eseg + 4 * e4) * 4); o[4 * e4] = t.x; o[4 * e4 + 1] = t.y; o[4 * e4 + 2] = t.z; o[4 * e4 + 3] = t.w; }
                st0 = (v4u){cvtpk(o[0], o[1]), cvtpk(o[2], o[3]), cvtpk(o[4], o[5]), cvtpk(o[6], o[7])}; st1 = (v4u){cvtpk(o[8], o[9]), cvtpk(o[10], o[11]), cvtpk(o[12], o[13]), cvtpk(o[14], o[15])};
            }
        }
        GLA_FLUSH(dir ? 0 : 63);
#undef GLA_STAGE
#undef GLA_FLUSH
#undef GLA_LOAD
    }
    VM_WAIT(); __syncthreads();
    if (tid == 0) { __builtin_amdgcn_fence(__ATOMIC_RELEASE, "agent"); VM_WAIT(); (void)__hip_atomic_fetch_add(F.ctl + CW_GDN + 64 * (b * GLA_H + h), 1u, RLX_AGENT); }
    __syncthreads();
}
__device__ __forceinline__ void gla_combine(Frame& F, int b, int h, int part) {
    const int tid = F.tid, erow = tid >> 3, eseg = tid & 7;
    if (tid == 0) { unsigned sp = 0; while (__hip_atomic_load(F.ctl + CW_GDN + 64 * (b * GLA_H + h), RLX_AGENT) < 2u && sp < (1u << 22)) { __builtin_amdgcn_s_sleep(8); ++sp; }
        __builtin_amdgcn_fence(__ATOMIC_ACQUIRE, "agent"); VM_WAIT(); }
    __syncthreads();
    const bf16* OF0 = (const bf16*)(F.ws + WS_OF); const bf16* OB0 = (const bf16*)(F.ws + WS_OF + 32 * MiB); const bf16* GR = (const bf16*)(F.ws + WS_GR); bf16* MIX = (bf16*)(F.ws + WS_MIX);
    float hg[16]; int eso = eseg; asm volatile("" : "+v"(eso));
#pragma unroll
    for (int e = 0; e < 16; ++e) hg[e] = F.gla_hg[16 * eso + e];
    const unsigned r0 = (unsigned)b * SEQ + (unsigned)part * 1024u + erow;
#pragma unroll 2
    for (int ps = 0; ps < 16; ++ps) { const unsigned row = r0 + ps * 64;
        const GAS v4u* fp = (const GAS v4u*)(OF0 + row * 512 + h * 128 + eseg * 16); const GAS v4u* bp = (const GAS v4u*)(OB0 + row * 512 + h * 128 + eseg * 16); const GAS v4u* rp = (const GAS v4u*)(GR + row * 512 + h * 128 + eseg * 16);
        const v4u f0 = __builtin_nontemporal_load(fp), f1 = __builtin_nontemporal_load(fp + 1), b0 = __builtin_nontemporal_load(bp), b1 = __builtin_nontemporal_load(bp + 1), r0v = __builtin_nontemporal_load(rp), r1v = __builtin_nontemporal_load(rp + 1);
        const unsigned fw[8] = {f0.x, f0.y, f0.z, f0.w, f1.x, f1.y, f1.z, f1.w}, bw[8] = {b0.x, b0.y, b0.z, b0.w, b1.x, b1.y, b1.z, b1.w}, rw[8] = {r0v.x, r0v.y, r0v.z, r0v.w, r1v.x, r1v.y, r1v.z, r1v.w};
        float o[16]; float ss = 0.f;
#pragma unroll
        for (int e2 = 0; e2 < 8; ++e2) { o[2 * e2] = bflo(fw[e2]) + bflo(bw[e2]); o[2 * e2 + 1] = bfhi(fw[e2]) + bfhi(bw[e2]); ss += o[2 * e2] * o[2 * e2] + o[2 * e2 + 1] * o[2 * e2 + 1]; }
        ss += __shfl_xor(ss, 1); ss += __shfl_xor(ss, 2); ss += __shfl_xor(ss, 4);
        const float rinv = __builtin_amdgcn_rsqf(ss * (1.f / 128.f) + EPS);
        unsigned ow[8];
#pragma unroll
        for (int e2 = 0; e2 < 8; ++e2) { const float x0 = bflo(rw[e2]), x1 = bfhi(rw[e2]);
            const float y0 = o[2 * e2] * rinv * hg[2 * e2] * (x0 * __builtin_amdgcn_rcpf(1.f + __expf(-x0))), y1 = o[2 * e2 + 1] * rinv * hg[2 * e2 + 1] * (x1 * __builtin_amdgcn_rcpf(1.f + __expf(-x1))); ow[e2] = cvtpk(y0, y1); }
        GAS v4u* mp = (GAS v4u*)(MIX + row * 1024 + h * 128 + eseg * 16);
        mp[0] = (v4u){ow[0], ow[1], ow[2], ow[3]}; mp[1] = (v4u){ow[4], ow[5], ow[6], ow[7]}; }
}
}
struct DenseMap { static constexpr bool GATHER = false;
    const bf16* A; const bf16* Bt; int K;
    __device__ __forceinline__ __amdgpu_buffer_rsrc_t a_rsrc() const { return __builtin_amdgcn_make_buffer_rsrc((void*)A, 0, 0x7fffffff, 0x00020000); }
    __device__ __forceinline__ __amdgpu_buffer_rsrc_t b_rsrc() const { return __builtin_amdgcn_make_buffer_rsrc((void*)Bt, 0, 0x7fffffff, 0x00020000); }
    __device__ __forceinline__ unsigned a_soff(const pg8::Unit& u) const { return (unsigned)u.pm * 256u * (unsigned)K * 2u; }
    __device__ __forceinline__ unsigned b_soff(const pg8::Unit& u) const { return (unsigned)u.pn * 256u * (unsigned)K * 2u; }
    __device__ __forceinline__ void a_off(const pg8::Unit&, const int (&R)[2], const int (&C)[2], unsigned (&vo)[2][2]) const {
#pragma unroll
        for (int h = 0; h < 2; ++h)
#pragma unroll
            for (int i = 0; i < 2; ++i) vo[h][i] = (unsigned)((h * 128 + R[i]) * K + C[i]) * 2u; }
};
struct MoeTabs { const LAS int* cnt; const LAS int* cst; const LAS unsigned short* te; };
struct MoeMapUp { static constexpr bool GATHER = true;
    const unsigned char* A; const unsigned char* Bt; const int* rowtok; MoeTabs tb;
    __device__ __forceinline__ __amdgpu_buffer_rsrc_t a_rsrc() const { return __builtin_amdgcn_make_buffer_rsrc((void*)A, 0, 0x7fffffff, 0x00020000); }
    __device__ __forceinline__ __amdgpu_buffer_rsrc_t b_rsrc() const { return __builtin_amdgcn_make_buffer_rsrc((void*)Bt, 0, 0x7fffffff, 0x00020000); }
    __device__ __forceinline__ unsigned a_soff(const pg8::Unit&) const { return 0u; }
    __device__ __forceinline__ unsigned b_soff(const pg8::Unit& u) const { const unsigned e = tb.te[u.pm]; return (e * 2048u + (unsigned)u.pn * 256u) * 1024u; }
    __device__ __forceinline__ void a_raw(const pg8::Unit& u, const int (&R)[2], unsigned (&raw)[2][2]) const {
        const int e = tb.te[u.pm], pos0 = (u.pm - tb.cst[e]) * 256, n = tb.cnt[e];
#pragma unroll
        for (int h = 0; h < 2; ++h)
#pragma unroll
            for (int i = 0; i < 2; ++i) { const int pos = pos0 + h * 128 + R[i]; raw[h][i] = (unsigned)rowtok[(size_t)e * EROWS + (pos < n ? pos : 0)]; } }
    __device__ __forceinline__ unsigned a_fin(unsigned tok, int C) const { return (tok * 512u + (unsigned)C) * 2u; }
    __device__ __forceinline__ void a_off(const pg8::Unit& u, const int (&R)[2], const int (&C)[2], unsigned (&vo)[2][2]) const {
        unsigned raw[2][2]; a_raw(u, R, raw);
#pragma unroll
        for (int h = 0; h < 2; ++h)
#pragma unroll
            for (int i = 0; i < 2; ++i) vo[h][i] = a_fin(raw[h][i], C[i]); }
};
struct MoeMapDown { static constexpr bool GATHER = false;
    const unsigned char* A; const unsigned char* Bt; MoeTabs tb;
    __device__ __forceinline__ __amdgpu_buffer_rsrc_t a_rsrc() const { return __builtin_amdgcn_make_buffer_rsrc((void*)A, 0, 0x7fffffff, 0x00020000); }
    __device__ __forceinline__ __amdgpu_buffer_rsrc_t b_rsrc() const { return __builtin_amdgcn_make_buffer_rsrc((void*)Bt, 0, 0x7fffffff, 0x00020000); }
    __device__ __forceinline__ unsigned a_soff(const pg8::Unit& u) const { return (unsigned)u.pm * 256u * 1024u; }
    __device__ __forceinline__ unsigned b_soff(const pg8::Unit& u) const { const unsigned e = tb.te[u.pm]; return (e * 1024u + (unsigned)u.pn * 256u) * 1024u; }
    __device__ __forceinline__ void a_off(const pg8::Unit&, const int (&R)[2], const int (&C)[2], unsigned (&vo)[2][2]) const {
#pragma unroll
        for (int h = 0; h < 2; ++h)
#pragma unroll
            for (int i = 0; i < 2; ++i) vo[h][i] = (unsigned)((h * 128 + R[i]) * 512 + C[i]) * 2u; }
};
using pg8::f32x4;
struct EpiInProj { static constexpr bool PERM = true, COLS64 = false;
    bf16 *gq, *gk, *gv, *gr, *aq, *ak, *av, *z;
    struct Pre {}; __device__ __forceinline__ void preload(const pg8::Unit&, int, int, int, int, Pre&) const {}
    __device__ __forceinline__ void operator()(const f32x4 (&acc)[2][2][4][2], const pg8::Unit& u, const Pre&, int wr, int wc, int fr, int fq) const {
        bf16* b0; bf16* b1; int ld;
        switch (u.pn) { case 0: b0 = gq; b1 = gq + 128; ld = 256; break; case 1: b0 = gk; b1 = gk + 128; ld = 256; break;
            case 2: b0 = gv; b1 = gv + 128; ld = 512; break; case 3: b0 = gv + 256; b1 = gv + 384; ld = 512; break;
            case 4: b0 = gr; b1 = gr + 128; ld = 512; break; case 5: b0 = gr + 256; b1 = gr + 384; ld = 512; break;
            case 6: b0 = aq; b1 = aq + 128; ld = 512; break; case 7: b0 = aq + 256; b1 = aq + 384; ld = 512; break;
            case 8: b0 = ak; b1 = av; ld = 128; break; default: b0 = z; b1 = z; ld = 32; break; }
        const bool zt = (u.pn == 9);
        if (zt && wc != 0) return;
        const int row0 = u.pm * 256 + wr * 64 + fr, cw = wc * 32 + 8 * fq;
#pragma unroll
        for (int ai = 0; ai < 2; ++ai)
#pragma unroll
            for (int m = 0; m < 4; ++m) { const size_t row = (size_t)(row0 + ai * 128 + m * 16);
#pragma unroll
                for (int bj = 0; bj < 2; ++bj) { if (zt && bj == 1) continue; const f32x4 v0 = acc[ai][bj][m][0], v1 = acc[ai][bj][m][1];
                    pg8::u32x4 wv; wv.x = pg8::cvt_pk_bf16(v0[0], v0[1]); wv.y = pg8::cvt_pk_bf16(v0[2], v0[3]); wv.z = pg8::cvt_pk_bf16(v1[0], v1[1]); wv.w = pg8::cvt_pk_bf16(v1[2], v1[3]);
                    *(pg8::u32x4*)((bj ? b1 : b0) + row * ld + cw) = wv; } }
    }
};
struct EpiResF32 { static constexpr bool PERM = false, COLS64 = false;
    const float* base; float* out;
    struct Pre {}; __device__ __forceinline__ void preload(const pg8::Unit&, int, int, int, int, Pre&) const {}
    __device__ __forceinline__ void operator()(const f32x4 (&acc)[2][2][4][2], const pg8::Unit& u, const Pre&, int wr, int wc, int fr, int fq) const {
        const int col0 = u.pn * 256 + wc * 32 + 4 * fq;
#pragma unroll
        for (int ai = 0; ai < 2; ++ai)
#pragma unroll
            for (int m = 0; m < 4; ++m) { const size_t off = (size_t)(u.pm * 256 + ai * 128 + wr * 64 + m * 16 + fr) * 1024 + col0;
#pragma unroll
                for (int bj = 0; bj < 2; ++bj)
#pragma unroll
                    for (int n = 0; n < 2; ++n) { const f32x4 bs = *(const f32x4*)(base + off + bj * 128 + n * 16); *(f32x4*)(out + off + bj * 128 + n * 16) = bs + acc[ai][bj][m][n]; } }
    }
};
struct EpiSwiglu { static constexpr bool PERM = true, COLS64 = false;
    const float* b1; unsigned char* act; MoeTabs tb;
    struct Pre { f32x4 g0, g1, l0, l1; };
    __device__ __forceinline__ void preload(const pg8::Unit& u, int wr, int wc, int fr, int fq, Pre& p) const {
        const int e = tb.te[u.pm]; const int col = u.pn * 128 + wc * 32 + 8 * fq; const float* bg = b1 + (size_t)e * 2048 + col; const float* bl = bg + 1024;
        p.g0 = *(const GAS f32x4*)bg; p.g1 = *(const GAS f32x4*)(bg + 4); p.l0 = *(const GAS f32x4*)bl; p.l1 = *(const GAS f32x4*)(bl + 4); }
    __device__ __forceinline__ void operator()(const f32x4 (&acc)[2][2][4][2], const pg8::Unit& u, const Pre& p, int wr, int wc, int fr, int fq) const {
        const int col = u.pn * 128 + wc * 32 + 8 * fq;
        const f32x4 g0 = p.g0, g1 = p.g1, l0 = p.l0, l1 = p.l1;
        const int row0 = u.pm * 256 + wr * 64 + fr;
#pragma unroll
        for (int ai = 0; ai < 2; ++ai)
#pragma unroll
            for (int m = 0; m < 4; ++m) { float o[8];
#pragma unroll
                for (int n = 0; n < 2; ++n)
#pragma unroll
                    for (int j = 0; j < 4; ++j) { const float gl = fminf(__builtin_fmaf(acc[ai][0][m][n][j], 1.f / WSCALE, (n ? g1[j] : g0[j])), 7.f); const float li = __builtin_amdgcn_fmed3f(__builtin_fmaf(acc[ai][1][m][n][j], 1.f / WSCALE, (n ? l1[j] : l0[j])), -7.f, 7.f);
                        o[4 * n + j] = (gl * ASCALE) * __builtin_amdgcn_rcpf(1.f + __builtin_amdgcn_exp2f(gl * (-1.702f * 1.4426950408889634f))) * (li + 1.f); }
                int w0 = 0, w1 = 0;
                w0 = __builtin_amdgcn_cvt_pk_fp8_f32(o[0], o[1], w0, false); w0 = __builtin_amdgcn_cvt_pk_fp8_f32(o[2], o[3], w0, true); w1 = __builtin_amdgcn_cvt_pk_fp8_f32(o[4], o[5], w1, false); w1 = __builtin_amdgcn_cvt_pk_fp8_f32(o[6], o[7], w1, true);
                *(v2u*)(act + (size_t)(row0 + ai * 128 + m * 16) * 1024 + col) = (v2u){(unsigned)w0, (unsigned)w1}; }
    }
};
struct EpiDown { static constexpr bool PERM = true, COLS64 = true;
    const float* b2; const float* rowgate; unsigned char* y; MoeTabs tb;
    struct Pre { f32x4 bv[2][2]; float gt[8]; };
    __device__ __forceinline__ void preload(const pg8::Unit& u, int wr, int wc, int fr, int fq, Pre& p) const {
        const int e = tb.te[u.pm], pos0 = (u.pm - tb.cst[e]) * 256, n_e = tb.cnt[e];
        const float* bb = b2 + (size_t)e * 1024 + u.pn * 256 + wc * 64 + 8 * fq;
#pragma unroll
        for (int bj = 0; bj < 2; ++bj)
#pragma unroll
            for (int n = 0; n < 2; ++n) p.bv[bj][n] = *(const GAS f32x4*)(bb + bj * 32 + 4 * n);
#pragma unroll
        for (int ai = 0; ai < 2; ++ai)
#pragma unroll
            for (int m = 0; m < 4; ++m) { const int pos = pos0 + wr * 64 + fr + ai * 128 + m * 16; const int pc_ = pos < n_e ? pos : 0; const float g = rowgate[(size_t)e * EROWS + pc_]; p.gt[ai * 4 + m] = (pos < n_e) ? g * YSCALE : 0.f; }
    }
    __device__ __forceinline__ void operator()(const f32x4 (&acc)[2][2][4][2], const pg8::Unit& u, const Pre& p, int wr, int wc, int fr, int fq) const {
        const bool odd = (fq & 1) != 0;
        const int colb = u.pn * 256 + wc * 64 + (odd ? 32 + 8 * (fq - 1) : 8 * fq), rl0 = wr * 64 + fr;
#pragma unroll
        for (int ai = 0; ai < 2; ++ai)
#pragma unroll
            for (int m = 0; m < 4; ++m) { const int rl = rl0 + ai * 128 + m * 16; const float gt = p.gt[ai * 4 + m];
                unsigned w[2][2];
#pragma unroll
                for (int bj = 0; bj < 2; ++bj) { const f32x4 v0 = (acc[ai][bj][m][0] * (1.f / (WSCALE * ASCALE)) + p.bv[bj][0]) * gt, v1 = (acc[ai][bj][m][1] * (1.f / (WSCALE * ASCALE)) + p.bv[bj][1]) * gt;
                    int w0 = 0, w1 = 0;
                    w0 = __builtin_amdgcn_cvt_pk_fp8_f32(v0[0], v0[1], w0, false); w0 = __builtin_amdgcn_cvt_pk_fp8_f32(v0[2], v0[3], w0, true); w1 = __builtin_amdgcn_cvt_pk_fp8_f32(v1[0], v1[1], w1, false); w1 = __builtin_amdgcn_cvt_pk_fp8_f32(v1[2], v1[3], w1, true);
                    w[bj][0] = (unsigned)w0; w[bj][1] = (unsigned)w1; }
                auto x0 = __builtin_amdgcn_permlane16_swap(w[0][0], w[1][0], false, false); auto x1 = __builtin_amdgcn_permlane16_swap(w[0][1], w[1][1], false, false);
                const pg8::u32x4 ov = (pg8::u32x4){x0[0], x1[0], x0[1], x1[1]};
                *(pg8::u32x4*)(y + (size_t)(u.pm * 256 + rl) * 1024 + colb) = ov; }
    }
};
__device__ __forceinline__ int moe_tables(Frame& F) {
    LAS int* cnt = (LAS int*)(F.lds + LC_CNT); LAS int* cst = (LAS int*)(F.lds + LC_CST); LAS unsigned short* te = (LAS unsigned short*)(F.lds + LC_TE);
    __syncthreads();
    if (F.tid < NEXP) cnt[F.tid] = (int)__hip_atomic_load(F.ctl + CW_CNT + 64 * F.tid, RLX_AGENT);
    __syncthreads();
    if (F.tid == 0) { int s = 0; for (int e = 0; e < NEXP; ++e) { cst[e] = s; s += (cnt[e] + 255) >> 8; } cst[NEXP] = s; }
    __syncthreads();
    const int nt = cst[NEXP];
    for (int t = F.tid; t < nt; t += NWAVES * 64) { int e = 0;
#pragma unroll 1
        for (int k = 1; k < NEXP; ++k) e = (t >= cst[k]) ? k : e;
        te[t] = (unsigned short)e; }
    __syncthreads();
    return nt;
}
__device__ __forceinline__ void p3_mixers(Frame& F) {
    for (int u = blockIdx.x; u < 2 * BATCH * GLA_H; u += F.G) gla::gla_unit(F, u & 7, (u >> 3) & 3, u >> 5);
    if (blockIdx.x < 2 * BATCH * GLA_H) { while (conv_pull(F)) {} }
    const attn_body::bf16* Q = (const attn_body::bf16*)(F.ws + WS_AQ); const attn_body::bf16* K = (const attn_body::bf16*)(F.ws + WS_AK); const attn_body::bf16* V = (const attn_body::bf16*)(F.ws + WS_AV);
    attn_body::bf16* O = (attn_body::bf16*)(F.ws + WS_MIX);
    const int x0 = blockIdx.x & 7;
    float sbound;
    { float mq = fabsf(F.q_g[F.lane]), mk = fabsf(F.k_g[F.lane]);
#pragma unroll
      for (int o_ = 1; o_ < 64; o_ <<= 1) { mq = fmaxf(mq, __shfl_xor(mq, o_)); mk = fmaxf(mk, __shfl_xor(mk, o_)); }
      sbound = __builtin_bit_cast(float, __builtin_amdgcn_readfirstlane(__builtin_bit_cast(int, 64.f * attn_body::C2 * mq * mk * 1.02f))); }
    for (int qi = 0; qi < 8; ++qi) { const int x = (x0 + qi) & 7;
        for (;;) {
            __syncthreads();
            if (F.tid == 0) F.MISC[16] = __hip_atomic_fetch_add(F.ctl + CW_QUE + 64 * x, 1u, RLX_AGENT);
            __syncthreads();
            const int item = __builtin_amdgcn_readfirstlane((int)F.MISC[16]);
            if (item >= ATT_H * attn_body::NQB + 4 * GLA_H) break;
            if (item >= ATT_H * attn_body::NQB) { const int k = item - ATT_H * attn_body::NQB; gla::gla_combine(F, x, k >> 2, k & 3); continue; }
            attn_body::attn_unit<8>(x, item >> 4, item & 15, Q, K, V, O, (char*)F.lds, F.q_g, sbound);
        }
    }
    while (conv_pull(F)) {}
    __syncthreads();
}

__device__ __forceinline__ void p5_route(Frame& F) {
    typedef float f32x16 __attribute__((ext_vector_type(16)));
    LAS unsigned char* L = F.lds;
    constexpr int XP = 2064, L_XH = 0, L_XL = 32 * XP, L_PART = 0;
    const int tid = F.tid, lane = F.lane, w = F.wave, r32 = lane & 31, hi = lane >> 5;
    const bf16* WRH = (const bf16*)(F.ws + WS_WRH); const bf16* WRL = (const bf16*)(F.ws + WS_WRL);
    unsigned char* XN8 = F.ws + WS_XN;
    int* ROWTOK = (int*)(F.ws + WS_ROWTOK); float* ROWGATE = (float*)(F.ws + WS_ROWGATE); int* TOKASG = (int*)(F.ws + WS_TOKASG);
    gu32* CNT = F.ctl + CW_CNT;
    bf16x8 wh[8], wl[8];
#pragma unroll
    for (int ks = 0; ks < 8; ++ks) { const int k0 = 128 * w + 16 * ks + 8 * hi; wh[ks] = *(const GAS bf16x8*)(WRH + r32 * 1024 + k0); wl[ks] = *(const GAS bf16x8*)(WRL + r32 * 1024 + k0); }
    f32x4 g2[4];
#pragma unroll
    for (int j = 0; j < 4; ++j) g2[j] = *((const GAS f32x4*)F.ffn_g + lane + 64 * j);
    float brt[16];
#pragma unroll
    for (int r = 0; r < 16; ++r) brt[r] = F.b_router[(r & 3) + 8 * (r >> 2) + 4 * hi];
    LAS int* hist = (LAS int*)(L + LC_HIST); LAS int* basev = (LAS int*)(L + LC_BASE); LAS int* aep = (LAS int*)(L + LC_ASG); LAS float* agt = (LAS float*)(L + LC_ASG + 4096);
    constexpr int NGRP = T / 32;
    const int per = (NGRP + F.G - 1) / F.G, g0 = F.vcu * per, g1 = (g0 + per < NGRP) ? g0 + per : NGRP;
    for (int gb = g0; gb < g1; gb += 8) {
        const int nb = (g1 - gb < 8) ? g1 - gb : 8;
        __syncthreads();
        if (tid < NEXP) hist[tid] = 0;
        f32x4 hv[4][4];
#define P5_LOADG(g) do { _Pragma("unroll") for (int rr = 0; rr < 4; ++rr) { const GAS f32x4* hp = (const GAS f32x4*)(F.out + (size_t)(32 * (g) + 4 * w + rr) * 1024) + lane; \
            _Pragma("unroll") for (int j = 0; j < 4; ++j) hv[rr][j] = __builtin_nontemporal_load(hp + 64 * j); } } while (0)
#define P5_BAR() asm volatile("s_waitcnt lgkmcnt(0)\n\ts_barrier" ::: "memory")
        P5_LOADG(gb);
        for (int bi = 0; bi < nb; ++bi) {
            const int t0 = 32 * (gb + bi);
#pragma unroll
            for (int rr = 0; rr < 4; ++rr) { const int r = 4 * w + rr; const size_t tok = (size_t)(t0 + r);
                f32x4 v[4]; float s = 0.f;
#pragma unroll
                for (int j = 0; j < 4; ++j) { v[j] = hv[rr][j]; s += (v[j].x * v[j].x + v[j].y * v[j].y) + (v[j].z * v[j].z + v[j].w * v[j].w); }
                const float rinv = 1.f / sqrtf(wave_sum(s) * (1.f / 1024.f) + EPS);
                GAS unsigned* o4 = (GAS unsigned*)(XN8 + tok * 1024) + lane;
#pragma unroll
                for (int j = 0; j < 4; ++j) { const f32x4 xn = v[j] * rinv * g2[j];
                    const v2u hw = (v2u){pk2(xn.x, xn.y), pk2(xn.z, xn.w)};
                    const v2u lw = (v2u){pk2(xn.x - bflo(hw.x), xn.y - bfhi(hw.x)), pk2(xn.z - bflo(hw.y), xn.w - bfhi(hw.y))};
                    { int q8 = 0; q8 = __builtin_amdgcn_cvt_pk_fp8_f32(xn.x, xn.y, q8, false); q8 = __builtin_amdgcn_cvt_pk_fp8_f32(xn.z, xn.w, q8, true); o4[64 * j] = (unsigned)q8; }
                    *(LAS v2u*)(L + L_XH + r * XP + (4 * lane + 256 * j) * 2) = hw; *(LAS v2u*)(L + L_XL + r * XP + (4 * lane + 256 * j) * 2) = lw; } }
            if (bi + 1 < nb) P5_LOADG(gb + bi + 1);
            P5_BAR();
            f32x16 acc = {};
#pragma unroll
            for (int ks = 0; ks < 8; ++ks) { const int k0 = 128 * w + 16 * ks + 8 * hi;
                const bf16x8 xh = *(const LAS bf16x8*)(L + L_XH + r32 * XP + k0 * 2), xl = *(const LAS bf16x8*)(L + L_XL + r32 * XP + k0 * 2);
                acc = __builtin_amdgcn_mfma_f32_32x32x16_bf16(wh[ks], xh, acc, 0, 0, 0); acc = __builtin_amdgcn_mfma_f32_32x32x16_bf16(wh[ks], xl, acc, 0, 0, 0); acc = __builtin_amdgcn_mfma_f32_32x32x16_bf16(wl[ks], xh, acc, 0, 0, 0); }
            P5_BAR();
#pragma unroll
            for (int r = 0; r < 16; ++r) { const int e = (r & 3) + 8 * (r >> 2) + 4 * hi; ((LAS float*)(L + L_PART))[(w * 32 + e) * 32 + r32] = acc[r]; }
            P5_BAR();
            if (w == 0) {
                float v[16];
#pragma unroll
                for (int r = 0; r < 16; ++r) { const int e = (r & 3) + 8 * (r >> 2) + 4 * hi; float s = brt[r];
#pragma unroll
                    for (int ww = 0; ww < 8; ++ww) s += ((const LAS float*)(L + L_PART))[(ww * 32 + e) * 32 + r32];
                    v[r] = s; }
                float cv[8]; int cidx[8];
#pragma unroll
                for (int s = 0; s < 4; ++s) { float m = -INFINITY; int mr = 0;
#pragma unroll
                    for (int r = 0; r < 16; ++r) { if (v[r] > m) { m = v[r]; mr = r; } }
                    cv[s] = m; cidx[s] = (mr & 3) + 8 * (mr >> 2) + 4 * hi;
#pragma unroll
                    for (int r = 0; r < 16; ++r) v[r] = (r == mr) ? -INFINITY : v[r]; }
#pragma unroll
                for (int s = 0; s < 4; ++s) { cv[4 + s] = __shfl_xor(cv[s], 32); cidx[4 + s] = __shfl_xor(cidx[s], 32); }
                float tv[4]; int ti[4];
#pragma unroll
                for (int s = 0; s < 4; ++s) { float m = -INFINITY; int mi = 1 << 20; int mc = 0;
#pragma unroll
                    for (int c = 0; c < 8; ++c) { const bool better = (cv[c] > m) || (cv[c] == m && cidx[c] < mi); if (better) { m = cv[c]; mi = cidx[c]; mc = c; } }
                    tv[s] = m; ti[s] = mi;
#pragma unroll
                    for (int c = 0; c < 8; ++c) cv[c] = (c == mc) ? -INFINITY : cv[c]; }
                const float e1 = __expf(tv[1] - tv[0]), e2 = __expf(tv[2] - tv[0]), e3 = __expf(tv[3] - tv[0]); const float inv = 1.f / (1.f + e1 + e2 + e3);
                const float gt[4] = {inv, e1 * inv, e2 * inv, e3 * inv};
                if (hi == 0) {
#pragma unroll
                    for (int s = 0; s < 4; ++s) { const int rank = (int)__hip_atomic_fetch_add(hist + ti[s], 1, __ATOMIC_RELAXED, __HIP_MEMORY_SCOPE_WORKGROUP); const int idx = (bi * 32 + r32) * 4 + s; aep[idx] = (ti[s] << 16) | rank; agt[idx] = gt[s]; } }
            }
            P5_BAR();
        }
#undef P5_LOADG
#undef P5_BAR
        if (tid < NEXP) { const int hc = hist[tid]; basev[tid] = hc ? (int)__hip_atomic_fetch_add(CNT + 64 * tid, (unsigned)hc, RLX_AGENT) : 0; }
        __syncthreads();
        for (int idx = tid; idx < nb * 128; idx += NWAVES * 64) { const int ep = aep[idx], e = ep >> 16, pos = basev[e] + (ep & 0xffff); const int tok = 32 * gb + (idx >> 2), s = idx & 3;
            ROWTOK[(size_t)e * EROWS + pos] = tok; ROWGATE[(size_t)e * EROWS + pos] = agt[idx]; TOKASG[tok * 4 + s] = e * EROWS + pos; }
    }
    __syncthreads();
}

__device__ __forceinline__ void p8_combine(Frame& F) {
    const LAS int* cst = (const LAS int*)(F.lds + LC_CST);
    const int gw = F.vcu * NWAVES + F.wave, NGW = F.G * NWAVES, lane = F.lane;
    const int* TOKASG = (const int*)(F.ws + WS_TOKASG); const unsigned char* Y = F.ws + WS_Y;
    f32x4 fg[4];
#pragma unroll
    for (int j = 0; j < 4; ++j) fg[j] = *((const GAS f32x4*)F.fin_g + lane + 64 * j);
    for (int tok = gw; tok < T; tok += NGW) {
        const int a = TOKASG[tok * 4 + (lane & 3)];
        const int crow = cst[a >> 15] * 256 + (a & (EROWS - 1));
        GAS f32x4* hp = (GAS f32x4*)(F.out + (size_t)tok * 1024) + lane; f32x4 v[4];
#pragma unroll
        for (int j = 0; j < 4; ++j) v[j] = __builtin_nontemporal_load(hp + 64 * j);
#pragma unroll
        for (int s = 0; s < 4; ++s) { const int cr = __shfl(crow, s); const GAS unsigned* yp = (const GAS unsigned*)(Y + (size_t)cr * 1024) + lane;
#pragma unroll
            for (int j = 0; j < 4; ++j) { const unsigned yw = __builtin_nontemporal_load(yp + 64 * j); const auto lo = __builtin_amdgcn_cvt_pk_f32_fp8((int)yw, false), hi = __builtin_amdgcn_cvt_pk_f32_fp8((int)yw, true);
                v[j].x += lo[0] * (1.f / YSCALE); v[j].y += lo[1] * (1.f / YSCALE); v[j].z += hi[0] * (1.f / YSCALE); v[j].w += hi[1] * (1.f / YSCALE); } }
        float ss = 0.f;
#pragma unroll
        for (int j = 0; j < 4; ++j) ss += (v[j].x * v[j].x + v[j].y * v[j].y) + (v[j].z * v[j].z + v[j].w * v[j].w);
        const float rinv = 1.f / sqrtf(wave_sum(ss) * (1.f / 1024.f) + EPS);
#pragma unroll
        for (int j = 0; j < 4; ++j) __builtin_nontemporal_store(v[j] * rinv * fg[j], hp + 64 * j);
    }
}
#ifndef MK_N_LAUNCHES
#define MK_N_LAUNCHES 1
#endif
constexpr int N_PHASES = 9;
constexpr int N_LAUNCHES = MK_N_LAUNCHES;
struct Args { const float* in[19]; float* out; unsigned char* ws; int ph_lo, ph_hi; };
__global__ void __launch_bounds__(NWAVES * 64, 2) enc_fwd(Args args) {
    extern __shared__ __attribute__((aligned(16))) unsigned char lds[];
    Frame F;
    F.lds = (LAS unsigned char*)lds;
    F.MISC = (volatile LAS unsigned*)(F.lds + LC_MISC);
    F.tid = threadIdx.x; F.lane = F.tid & 63; F.wave = __builtin_amdgcn_readfirstlane(F.tid >> 6);
    F.G = gridDim.x; { const int bx = blockIdx.x; F.vcu = (F.G % 8 == 0) ? (bx % 8) * (F.G / 8) + bx / 8 : bx; }
    F.ws = args.ws; F.ctl = (gu32*)(args.ws + WS_CTL);
    F.x = args.in[0]; F.mix_g = args.in[1]; F.w_in = args.in[2]; F.w_gf = args.in[3]; F.b_gf = args.in[4]; F.w_gb = args.in[5]; F.b_gb = args.in[6]; F.gla_hg = args.in[7];
    F.q_g = args.in[8]; F.k_g = args.in[9]; F.w_out = args.in[10]; F.ffn_g = args.in[11]; F.w_router = args.in[12]; F.b_router = args.in[13];
    F.w1 = args.in[14]; F.b1 = args.in[15]; F.w2 = args.in[16]; F.b2 = args.in[17]; F.fin_g = args.in[18]; F.out = args.out;
    for (int u = F.tid; u < (LDS_BYTES - LC_OFF) / 4; u += NWAVES * 64) ((LAS unsigned*)(F.lds + LC_OFF))[u] = 0u;
    __syncthreads();
    XcdBarrier bar; bar.bar = (unsigned*)(F.ctl + CW_BAR); bar.x = 0; bar.st = nullptr;
    if (N_LAUNCHES == 1) bar = xcd_barrier_post((unsigned*)(F.ctl + CW_BAR), F.MISC + 8);
    const int lo = args.ph_lo, hi = args.ph_hi;
#define IN(k) (lo <= (k) && (k) < hi)
#define SEAM(k) do { if (IN(k) && IN((k) + 1)) xcd_barrier(bar); } while (0)
    MoeTabs tb{(const LAS int*)(F.lds + LC_CNT), (const LAS int*)(F.lds + LC_CST), (const LAS unsigned short*)(F.lds + LC_TE)};

    if (IN(0)) { p0_prologue(F); } SEAM(0);
    if (IN(1)) {
        DenseMap mp{(const bf16*)(F.ws + WS_XN), (const bf16*)(F.ws + WS_WIN), 1024};
        pg8::StaticOrder S; S.init(T / 256, D_IN_PAD / 256, F.G, (int)blockIdx.x);
        EpiInProj E{(bf16*)(F.ws + WS_GQ), (bf16*)(F.ws + WS_GK), (bf16*)(F.ws + WS_GV), (bf16*)(F.ws + WS_GR), (bf16*)(F.ws + WS_AQ), (bf16*)(F.ws + WS_AK), (bf16*)(F.ws + WS_AV), (bf16*)(F.ws + WS_Z)};
        pg8::gemm_phase<EpiInProj, pg8::StaticOrder, DenseMap, true>(F.lds, 1024, S, mp, E);
    } SEAM(1);
    if (IN(2)) { p2_normrope(F); for (int u = F.vcu; u < BATCH * 64; u += F.G) gla::gla_prep_unit(F, u >> 6, u & 63); } SEAM(2);
    if (IN(3)) { p3_mixers(F); } SEAM(3);
    if (IN(4)) {
        DenseMap mp{(const bf16*)(F.ws + WS_MIX), (const bf16*)(F.ws + WS_WOUT), 1024};
        pg8::StaticOrder S; S.init(T / 256, DM / 256, F.G, (int)blockIdx.x);
        EpiResF32 E{F.x, F.out};
        pg8::gemm_phase<EpiResF32, pg8::StaticOrder, DenseMap, true>(F.lds, 1024, S, mp, E);
    } SEAM(4);
    if (IN(5)) { p5_route(F); } SEAM(5);
    if (IN(6)) {
        const int ntl = moe_tables(F);
        MoeMapUp mp{F.ws + WS_XN, F.ws + WS_W1, (const int*)(F.ws + WS_ROWTOK), tb};
        pg8::StaticOrder S; S.init(ntl, 8, F.G, (int)blockIdx.x);
        EpiSwiglu E{F.b1, F.ws + WS_ACT, tb};
        pg8::gemm_phase<EpiSwiglu, pg8::StaticOrder, MoeMapUp, true, true>(F.lds, 512, S, mp, E);
    } SEAM(6);
    if (IN(7)) {
        const int ntl = moe_tables(F);
        MoeMapDown mp{F.ws + WS_ACT, F.ws + WS_W2, tb};
        pg8::StaticOrder S; S.init(ntl, 4, F.G, (int)blockIdx.x);
        EpiDown E{F.b2, (const float*)(F.ws + WS_ROWGATE), F.ws + WS_Y, tb};
        pg8::gemm_phase<EpiDown, pg8::StaticOrder, MoeMapDown, true, true>(F.lds, 512, S, mp, E);
    } SEAM(7);
    if (IN(8)) { (void)moe_tables(F); p8_combine(F); }
#undef IN
#undef SEAM
}

extern "C" void kernel_launch(void* const* d_in, const int* in_sizes, int n_in, void* d_out, int out_size, void* d_ws, size_t ws_size, hipStream_t stream) {
    static int grid = 0;
    if (grid == 0) {
        if (n_in != 19 || in_sizes[0] != T * DM || out_size != T * DM || ws_size < WS_END) { fprintf(stderr, "kernel_launch: unexpected shapes (n_in %d, in0 %d, out %d, ws %zu); nothing launched\n", n_in, n_in > 0 ? in_sizes[0] : -1, out_size, ws_size); grid = -1; return; }
        int dev = 0, cus = 0, per_cu = 0;
        if (hipGetDevice(&dev) != hipSuccess || hipDeviceGetAttribute(&cus, hipDeviceAttributeMultiprocessorCount, dev) != hipSuccess) { grid = -1; return; }
        if (hipFuncSetAttribute((const void*)enc_fwd, hipFuncAttributeMaxDynamicSharedMemorySize, LDS_BYTES) != hipSuccess) { fprintf(stderr, "kernel_launch: hipFuncSetAttribute failed\n"); grid = -1; return; }
        if (hipOccupancyMaxActiveBlocksPerMultiprocessor(&per_cu, (const void*)enc_fwd, NWAVES * 64, LDS_BYTES) != hipSuccess || per_cu < 1) { fprintf(stderr, "kernel_launch: occupancy query says %d\n", per_cu); }
        (void)hipGetLastError();
        grid = cus;
    }
    if (grid < 0) return;
    if (hipMemsetAsync((char*)d_ws + WS_CTL, 0, CTL_ZERO_BYTES, stream) != hipSuccess) return;
    Args a{};
    for (int i = 0; i < 19; ++i) a.in[i] = (const float*)d_in[i];
    a.out = (float*)d_out; a.ws = (unsigned char*)d_ws;
    if (N_LAUNCHES == 1) { a.ph_lo = 0; a.ph_hi = N_PHASES; hipLaunchKernelGGL(enc_fwd, dim3(grid), dim3(NWAVES * 64), LDS_BYTES, stream, a); }
    else for (int p = 0; p < N_PHASES; ++p) { a.ph_lo = p; a.ph_hi = p + 1; hipLaunchKernelGGL(enc_fwd, dim3(grid), dim3(NWAVES * 64), LDS_BYTES, stream, a); }
}
```

```cpp
#include <hip/hip_runtime.h>
#include <hip/hip_bf16.h>
#include <cstdio>
#include <cstdint>
#include <cmath>

#define LAS __attribute__((address_space(3)))
#define GAS __attribute__((address_space(1)))

namespace pg8 {
typedef unsigned short bf16_t;
typedef short bf16x8 __attribute__((ext_vector_type(8)));
typedef float f32x4 __attribute__((ext_vector_type(4)));
typedef float f32x2 __attribute__((ext_vector_type(2)));
typedef unsigned u32x4 __attribute__((ext_vector_type(4)));
typedef int v4i_t __attribute__((ext_vector_type(4)));
typedef int v8i_t __attribute__((ext_vector_type(8)));
constexpr int BM = 256, BK = 64, HALF = 128, HTB = HALF * BK * 2, STAGE_BYTES = 8 * HTB, NXCD = 8, WGM = 4;

__host__ __device__ __forceinline__ int lds_byte(int r, int c) { const int st = (r >> 4) * 2 + (c >> 5), rr = r & 15, cc = c & 31, ob = rr * 64 + cc * 2; return st * 1024 + (ob ^ (((ob >> 9) & 1) << 5)); }
__host__ __device__ __forceinline__ void stage_rc(int b, int& R, int& C) { const int st = b / 1024, sb = b % 1024, swz = sb ^ (((sb >> 9) & 1) << 5); R = (st >> 1) * 16 + swz / 64; C = (st & 1) * 32 + (swz % 64) / 2; }
__host__ __device__ __forceinline__ int perm32(int rho) { const int n = rho >> 4, i = rho & 15; return 8 * (i >> 2) + 4 * n + (i & 3); }

struct Unit { int pm, pn; };

struct StaticOrder {
    int nM, nN, nwg, G, c;
    __device__ __forceinline__ void init(int nM_, int nN_, int G_, int c_) { nM = nM_; nN = nN_; nwg = nM * nN; G = G_; c = c_; }
    __device__ __forceinline__ bool next(int i, Unit& u) const {
        const long L = (long)i * G + c; if (L >= nwg) return false;
        int wgid = (int)L; { const int q = nwg / NXCD, r = nwg % NXCD, xcd = wgid % NXCD, off = wgid / NXCD; wgid = (xcd < r ? xcd * (q + 1) : r * (q + 1) + (xcd - r) * q) + off; }
        const int nig = WGM * nN, gid = wgid / nig, fm = gid * WGM, gsz = (nM - fm) < WGM ? (nM - fm) : WGM;
        u.pm = fm + ((wgid % nig) % gsz); u.pn = (wgid % nig) / gsz; return true;
    }
};

__device__ __forceinline__ unsigned cvt_pk_bf16(float lo, float hi) { unsigned r; asm volatile("v_cvt_pk_bf16_f32 %0, %1, %2" : "=v"(r) : "v"(lo), "v"(hi)); return r; }

template <class Epi, class Sched, class Map, bool ALIGN_EPI, bool FP8 = false>
__device__ __forceinline__ void gemm_phase(LAS unsigned char* lds, const int K, const Sched& S, const Map& MP, const Epi& E) {
    int tid_ = threadIdx.x; asm volatile("" : "+v"(tid_));
    const int tid = tid_, wid = __builtin_amdgcn_readfirstlane(tid >> 6), lane = tid & 63, wr = wid >> 2, wc = wid & 3, fr = lane & 15, fq = lane >> 4;
    const int nt = K / BK;
    int Rr[2], Cc[2]; unsigned voffB[2];
#pragma unroll
    for (int i = 0; i < 2; ++i) { int R, C; stage_rc(tid * 16 + i * 8192, R, C); Rr[i] = R; Cc[i] = C; const int Rb = Epi::COLS64 ? (64 * (R >> 5) + perm32(R & 31)) : (Epi::PERM ? ((R & ~31) + perm32(R & 31)) : R); voffB[i] = (unsigned)(Rb * K + C) * 2u; }
    const unsigned kstep = (unsigned)(BK * 2);
    const unsigned hstep = (unsigned)HALF * K * 2;
    const unsigned hstepB = Epi::COLS64 ? 32u * (unsigned)K * 2u : hstep;
    const __amdgpu_buffer_rsrc_t RA = MP.a_rsrc(), RB = MP.b_rsrc();
    const unsigned ldsw = (unsigned)wid * 1024u;
    const int aoff = lds_byte(wr * 64 + fr, fq * 8), boff = lds_byte(wc * 32 + fr, fq * 8);
#define PG8_SA(b, h) (((b) * 2 + (h)) * HTB)
#define PG8_SB(b, h) ((4 + (b) * 2 + (h)) * HTB)
#define PG8_STAGE(bufoff, rsrc, soff, voff) do { _Pragma("unroll") for (int _i = 0; _i < 2; ++_i) \
        __builtin_amdgcn_raw_ptr_buffer_load_lds(rsrc, (LAS unsigned*)(lds + (bufoff) + ldsw + _i * 8192), 16, (int)(voff)[_i], (int)(soff), 0, 0); } while (0)
#define PG8_LD8(p) __builtin_shufflevector(*(const LAS v4i_t*)(p), *(const LAS v4i_t*)((p) + 1024), 0, 1, 2, 3, 4, 5, 6, 7)
#define PG8_LDA(dst, b, h) do { _Pragma("unroll") for (int m = 0; m < 4; ++m) dst[m] = PG8_LD8(lds + PG8_SA(b, h) + aoff + m * 2048); } while (0)
#define PG8_LDB(dst, b, h) do { _Pragma("unroll") for (int n = 0; n < 2; ++n) dst[n] = PG8_LD8(lds + PG8_SB(b, h) + boff + n * 2048); } while (0)
#define PG8_HALF(x, k) __builtin_bit_cast(bf16x8, __builtin_shufflevector(x, x, 4 * (k), 4 * (k) + 1, 4 * (k) + 2, 4 * (k) + 3))
#define PG8_MMA(ai, bj, At, Bt) do { __builtin_amdgcn_s_setprio(1); _Pragma("unroll") for (int m = 0; m < 4; ++m) _Pragma("unroll") for (int n = 0; n < 2; ++n) { \
        if constexpr (FP8) { acc[ai][bj][m][n] = __builtin_amdgcn_mfma_scale_f32_16x16x128_f8f6f4(Bt[n], At[m], acc[ai][bj][m][n], 0, 0, 0, 0x7f7f7f7f, 0, 0x7f7f7f7f); } \
        else { acc[ai][bj][m][n] = __builtin_amdgcn_mfma_f32_16x16x32_bf16(PG8_HALF(Bt[n], 0), PG8_HALF(At[m], 0), acc[ai][bj][m][n], 0, 0, 0); \
               acc[ai][bj][m][n] = __builtin_amdgcn_mfma_f32_16x16x32_bf16(PG8_HALF(Bt[n], 1), PG8_HALF(At[m], 1), acc[ai][bj][m][n], 0, 0, 0); } } \
        __builtin_amdgcn_s_setprio(0); } while (0)
#define PG8_WAIT_V(n) asm volatile("s_waitcnt vmcnt(" #n ")" ::: "memory")
#define PG8_WAIT_L(n) asm volatile("s_waitcnt lgkmcnt(" #n ")" ::: "memory")
#define PG8_BAR __builtin_amdgcn_s_barrier()
#define PG8_SCHED __builtin_amdgcn_sched_barrier(0)
    Unit cur, nxt, nn; int ui = 0;
    if (!S.next(0, cur)) return;
    f32x4 acc[2][2][4][2];
#pragma unroll
    for (int a = 0; a < 2; ++a)
#pragma unroll
        for (int b = 0; b < 2; ++b)
#pragma unroll
            for (int m = 0; m < 4; ++m)
#pragma unroll
                for (int n = 0; n < 2; ++n) acc[a][b][m][n] = (f32x4){0.f, 0.f, 0.f, 0.f};
    v8i_t At[4], B0[2], B1[2];
    unsigned cvo[2][2], nvo[2][2], nnvo[2][2];
    MP.a_off(cur, Rr, Cc, cvo);
    bool has_next = S.next(1, nxt);
    if constexpr (Map::GATHER) { if (has_next) MP.a_off(nxt, Rr, Cc, nvo); else { nvo[0][0] = cvo[0][0]; nvo[0][1] = cvo[0][1]; nvo[1][0] = cvo[1][0]; nvo[1][1] = cvo[1][1]; } }
    unsigned cA = MP.a_soff(cur), cB = MP.b_soff(cur);
    typename Epi::Pre pc, pn;
    E.preload(cur, wr, wc, fr, fq, pc); pn = pc;
    PG8_STAGE(PG8_SB(0, 0), RB, cB, voffB); PG8_STAGE(PG8_SB(0, 1), RB, cB + hstepB, voffB); PG8_STAGE(PG8_SA(0, 0), RA, cA, cvo[0]); PG8_STAGE(PG8_SA(0, 1), RA, cA, cvo[1]);
    if (wr == 1) PG8_BAR;
    PG8_WAIT_V(2); PG8_BAR;
    PG8_STAGE(PG8_SB(1, 0), RB, cB + kstep, voffB); PG8_STAGE(PG8_SA(1, 0), RA, cA + kstep, cvo[0]); PG8_STAGE(PG8_SB(1, 1), RB, cB + hstepB + kstep, voffB);
    PG8_WAIT_V(6); PG8_BAR;
    for (;;) {
        const unsigned nA = has_next ? MP.a_soff(nxt) : cA, nB = has_next ? MP.b_soff(nxt) : cB;
#pragma unroll 1
        for (int t = 0; t < nt; t += 2) {
            const bool last = (t == nt - 2);
            const unsigned a1 = cA + (unsigned)(t + 1) * kstep;
            const unsigned a2 = last ? nA : cA + (unsigned)(t + 2) * kstep, b2 = last ? nB : cB + (unsigned)(t + 2) * kstep;
            const unsigned a3 = a2 + kstep, b3 = b2 + kstep;
            unsigned s0[2] = {cvo[0][0], cvo[0][1]}, s1[2] = {cvo[1][0], cvo[1][1]};
            if constexpr (Map::GATHER) { if (last) { s0[0] = nvo[0][0]; s0[1] = nvo[0][1]; s1[0] = nvo[1][0]; s1[1] = nvo[1][1]; } }
            PG8_LDB(B0, 0, 0); PG8_LDB(B1, 0, 1); PG8_SCHED; PG8_LDA(At, 0, 0); PG8_STAGE(PG8_SA(1, 1), RA, a1, cvo[1]);
            PG8_WAIT_V(8); PG8_WAIT_L(0); PG8_BAR; PG8_MMA(0, 0, At, B0); PG8_MMA(0, 1, At, B1); PG8_BAR; PG8_SCHED;
            PG8_LDA(At, 0, 1); PG8_STAGE(PG8_SB(0, 0), RB, b2, voffB); PG8_STAGE(PG8_SB(0, 1), RB, b2 + hstepB, voffB); PG8_STAGE(PG8_SA(0, 0), RA, a2, s0);
            PG8_WAIT_V(8); PG8_WAIT_L(0); PG8_BAR; PG8_MMA(1, 0, At, B0); PG8_MMA(1, 1, At, B1); PG8_BAR; PG8_SCHED;
            PG8_LDB(B0, 1, 0); PG8_LDB(B1, 1, 1); PG8_SCHED; PG8_LDA(At, 1, 0); PG8_STAGE(PG8_SA(0, 1), RA, a2, s1);
            PG8_WAIT_V(8); PG8_WAIT_L(0); PG8_BAR; PG8_MMA(0, 0, At, B0); PG8_MMA(0, 1, At, B1); PG8_BAR; PG8_SCHED;
            PG8_LDA(At, 1, 1); PG8_STAGE(PG8_SB(1, 0), RB, b3, voffB); PG8_STAGE(PG8_SB(1, 1), RB, b3 + hstepB, voffB); PG8_STAGE(PG8_SA(1, 0), RA, a3, s0);
            PG8_WAIT_V(8); PG8_WAIT_L(0); PG8_BAR; PG8_MMA(1, 0, At, B0); PG8_MMA(1, 1, At, B1); PG8_BAR; PG8_SCHED;
        }
        if constexpr (ALIGN_EPI) { if (wr == 0) PG8_BAR; }
        const bool has_nn = has_next && S.next(ui + 2, nn);
        if constexpr (Map::GATHER) { if (has_nn) MP.a_raw(nn, Rr, nnvo); }
        if (has_next) E.preload(nxt, wr, wc, fr, fq, pn);
        { int fr_ = fr, fq_ = fq; asm volatile("" : "+v"(fr_), "+v"(fq_)); E(acc, cur, pc, wr, wc, fr_, fq_); }
        if (!has_next) break;
#pragma unroll
        for (int a = 0; a < 2; ++a)
#pragma unroll
            for (int b = 0; b < 2; ++b)
#pragma unroll
                for (int m = 0; m < 4; ++m)
#pragma unroll
                    for (int n = 0; n < 2; ++n) acc[a][b][m][n] = (f32x4){0.f, 0.f, 0.f, 0.f};
        cur = nxt; cA = nA; cB = nB; ++ui; pc = pn;
#pragma unroll
        for (int h = 0; h < 2; ++h)
#pragma unroll
            for (int i = 0; i < 2; ++i) { if constexpr (Map::GATHER) { cvo[h][i] = nvo[h][i]; nvo[h][i] = has_nn ? MP.a_fin(nnvo[h][i], Cc[i]) : nvo[h][i]; } }
        has_next = has_nn; nxt = nn;
        if constexpr (ALIGN_EPI) { if (wr == 1) PG8_BAR; }
    }
    PG8_WAIT_V(0);
    if constexpr (!ALIGN_EPI) { if (wr == 0) PG8_BAR; }
    PG8_BAR;
#undef PG8_SA
#undef PG8_SB
#undef PG8_STAGE
#undef PG8_LDA
#undef PG8_LDB
#undef PG8_MMA
#undef PG8_HALF
#undef PG8_LD8
#undef PG8_WAIT_V
#undef PG8_WAIT_L
#undef PG8_BAR
#undef PG8_SCHED
}
}
namespace attn_body {
using bf16=__hip_bfloat16;
using bf16x8=__attribute__((ext_vector_type(8)))short;
using s16x4=__attribute__((ext_vector_type(4)))short;
using f32x16=__attribute__((ext_vector_type(16)))float;
using u32x4=__attribute__((ext_vector_type(4)))unsigned;
constexpr int BATCH=8,NHEAD=8,NKVH=2,SEQ=4096,D=64;
constexpr int QP=512,KP=128,VP=128,OP=1024,OCOL=512;
constexpr int NW=8,QBLK=32,QB=QBLK*NW,KVBLK=64,NQB=SEQ/QB;
__device__ __forceinline__ int crow(int r,int hi){return (r&3)+8*(r>>2)+4*hi;}
#define SBAR() __builtin_amdgcn_sched_barrier(0)
constexpr int NSLOT=3, SLOTB=8192;
constexpr int LDS_K=0, LDS_V=NSLOT*SLOTB, LDS_WS=2*NSLOT*SLOTB, LDS_OST=LDS_WS+NW*64*4, LDS_BYTES=LDS_OST+NW*4096;
constexpr float C2=0.125f*1.4426950408889634f;
__device__ __forceinline__ void glds16(const void*gsrc,unsigned lds_dst){unsigned keep;
  asm volatile("s_mov_b32 %0, m0\n\ts_mov_b32 m0, %2\n\ts_nop 0\n\tglobal_load_lds_dwordx4 %1, off\n\ts_mov_b32 m0, %0":"=&s"(keep):"v"(gsrc),"s"(lds_dst):"memory");}
__device__ __forceinline__ float max3f(float a,float b,float c){float r;asm("v_max3_f32 %0, %1, %2, %3":"=v"(r):"v"(a),"v"(b),"v"(c));return r;}
__device__ __forceinline__ float max2f(float a,float b){float r;asm("v_max_f32_e32 %0, %1, %2":"=v"(r):"v"(a),"v"(b));return r;}
__device__ __forceinline__ float fadd_s(float a,float b){float r;asm("v_add_f32_e32 %0, %1, %2":"=v"(r):"v"(a),"v"(b));return r;}
__device__ __forceinline__ float fsub_s(float a,float b){float r;asm("v_sub_f32_e32 %0, %1, %2":"=v"(r):"v"(a),"v"(b));return r;}
typedef float f32x2_t __attribute__((ext_vector_type(2))); typedef __bf16 bf16x2_t __attribute__((ext_vector_type(2)));
__device__ __forceinline__ unsigned cvtpk_s(float lo,float hi){f32x2_t v={lo,hi};bf16x2_t b=__builtin_convertvector(v,bf16x2_t);return __builtin_bit_cast(unsigned,b);}
#define WAIT_BAR(N) asm volatile("s_waitcnt vmcnt(" #N ") lgkmcnt(0)\n\ts_barrier":::"memory")

__device__ __forceinline__ void qkt(f32x16&p0,f32x16&p1,const char*Kslot,const bf16x8*qr,const f32x16&negm,int r32,int hi){
  const char*kb=Kslot+hi*1024+r32*16;
  #pragma unroll
  for(int d0=0;d0<4;++d0){
    const bf16x8 b0=*reinterpret_cast<const bf16x8*>(kb+d0*2048);
    const bf16x8 b1=*reinterpret_cast<const bf16x8*>(kb+d0*2048+512);
    if(d0==0){p0=__builtin_amdgcn_mfma_f32_32x32x16_bf16(b0,qr[0],negm,0,0,0);p1=__builtin_amdgcn_mfma_f32_32x32x16_bf16(b1,qr[0],negm,0,0,0);}
    else{p0=__builtin_amdgcn_mfma_f32_32x32x16_bf16(b0,qr[d0],p0,0,0,0);p1=__builtin_amdgcn_mfma_f32_32x32x16_bf16(b1,qr[d0],p1,0,0,0);}}
}
typedef __attribute__((address_space(3))) const char* lds_cptr;
typedef short v4i16_t __attribute__((ext_vector_type(4)));
__device__ __forceinline__ void kload8(bf16x8*kf,lds_cptr kp){
  kf[0]=*(const __attribute__((address_space(3))) bf16x8*)(kp);      kf[1]=*(const __attribute__((address_space(3))) bf16x8*)(kp+512);
  kf[2]=*(const __attribute__((address_space(3))) bf16x8*)(kp+2048); kf[3]=*(const __attribute__((address_space(3))) bf16x8*)(kp+2560);
  kf[4]=*(const __attribute__((address_space(3))) bf16x8*)(kp+4096); kf[5]=*(const __attribute__((address_space(3))) bf16x8*)(kp+4608);
  kf[6]=*(const __attribute__((address_space(3))) bf16x8*)(kp+6144); kf[7]=*(const __attribute__((address_space(3))) bf16x8*)(kp+6656);
}
__device__ __forceinline__ void kload2(bf16x8*kf,lds_cptr kp,int j){ kf[2*j]=*(const __attribute__((address_space(3))) bf16x8*)(kp+j*2048); kf[2*j+1]=*(const __attribute__((address_space(3))) bf16x8*)(kp+j*2048+512); }
__device__ __forceinline__ s16x4 vtr(lds_cptr p){ return __builtin_bit_cast(s16x4,__builtin_amdgcn_ds_read_tr16_b64_v4i16((__attribute__((address_space(3))) v4i16_t*)p)); }
__device__ __forceinline__ float rowmax(const f32x16&p0,const f32x16&p1){
  float a=max3f(p0[0],p0[1],p1[0]),b=max3f(p0[2],p0[3],p1[1]);a=max3f(a,p1[2],p1[3]);
  #pragma unroll
  for(int r=4;r<16;r+=4){a=max3f(a,p0[r],p0[r+1]);b=max3f(b,p0[r+2],p0[r+3]);a=max3f(a,p1[r],p1[r+1]);b=max3f(b,p1[r+2],p1[r+3]);}
  const float m=max2f(a,b);
  auto rr=__builtin_amdgcn_permlane32_swap(__float_as_uint(m),__float_as_uint(m),false,false);
  return max2f(__uint_as_float(rr[0]),__uint_as_float(rr[1]));
}
__device__ __forceinline__ void pv(f32x16*o,int vb,bf16x8 pa0,bf16x8 pa1,bf16x8 pa2,bf16x8 pa3){
  #pragma unroll
  for(int d0=0;d0<2;++d0){s16x4 lo[4],hi[4];
    #pragma unroll
    for(int ks=0;ks<4;++ks){
      asm volatile("ds_read_b64_tr_b16 %0,%1 offset:%c2":"=&v"(lo[ks]):"v"(vb),"i"(d0*4096+ks*1024):"memory");
      asm volatile("ds_read_b64_tr_b16 %0,%1 offset:%c2":"=&v"(hi[ks]):"v"(vb),"i"(d0*4096+ks*1024+512):"memory");}
    asm volatile("s_waitcnt lgkmcnt(0)":::"memory");SBAR();
    #define PK(k) (bf16x8){lo[k][0],lo[k][1],lo[k][2],lo[k][3],hi[k][0],hi[k][1],hi[k][2],hi[k][3]}
    o[d0]=__builtin_amdgcn_mfma_f32_32x32x16_bf16(pa0,PK(0),o[d0],0,0,0);
    o[d0]=__builtin_amdgcn_mfma_f32_32x32x16_bf16(pa1,PK(1),o[d0],0,0,0);
    o[d0]=__builtin_amdgcn_mfma_f32_32x32x16_bf16(pa2,PK(2),o[d0],0,0,0);
    o[d0]=__builtin_amdgcn_mfma_f32_32x32x16_bf16(pa3,PK(3),o[d0],0,0,0);
    #undef PK
  }
}
#define ATTN_STORE16(p,v) (*(u32x4*)(p)=(v))
template<int THRL> __device__ __forceinline__ void attn_unit(int b,int h,int qb,const bf16*Q,const bf16*__restrict__ K,const bf16*__restrict__ V,bf16*O,char*shm,const float*qgain,const float sbound){
  int tid_=threadIdx.x; asm volatile("":"+v"(tid_));
  const int tid=tid_,lane=tid&63,r32=lane&31,hi=lane>>5; const int wid=__builtin_amdgcn_readfirstlane(tid>>6);
  const long rowbase=(long)b*SEQ; const int q0=qb*QB; const int kvh=h/(NHEAD/NKVH);
  const bf16*Qw=Q+(rowbase+q0+wid*QBLK)*QP+h*D;
  const bf16*Kh=K+rowbase*KP+kvh*D,*Vh=V+rowbase*VP+kvh*D;
  const unsigned lds0=(unsigned)(uintptr_t)shm;
  float*wsf=(float*)(shm+LDS_WS)+wid*64;
  const bf16*ksrc=Kh+(long)lane*KP+wid*8;
  const bf16*vsrc=Vh+(long)(16*(wid&3)+(lane>>2))*VP+(wid>>2)*32+(lane&3)*8;
  const unsigned kdst=lds0+LDS_K+wid*1024, vdst=lds0+LDS_V+wid*1024;
  #define DMA_K(t,slot) glds16(ksrc+(long)(t)*KVBLK*KP,(unsigned)__builtin_amdgcn_readfirstlane(kdst+(slot)))
  #define DMA_V(t,slot) glds16(vsrc+(long)(t)*KVBLK*VP,(unsigned)__builtin_amdgcn_readfirstlane(vdst+(slot)))
  const int vb0=(int)(lds0+LDS_V)+((lane>>4)&1)*32+(lane&3)*8+(4*hi+((lane&15)>>2))*64;
  const char*Kbase=shm+LDS_K; bf16x8 kf[8];
  const lds_cptr shm3=(lds_cptr)shm; const lds_cptr kp0=shm3+LDS_K+hi*1024+r32*16; const lds_cptr vp0=shm3+LDS_V+((lane>>4)&1)*32+(lane&3)*8+(4*hi+((lane&15)>>2))*64;
  constexpr int NT=SEQ/KVBLK;
  DMA_K(0,0);DMA_V(0,0);DMA_K(1,SLOTB);
  bf16x8 qr[4];
  #pragma unroll
  for(int d0=0;d0<4;++d0)qr[d0]=*reinterpret_cast<const bf16x8*>(&Qw[(long)r32*QP+d0*16+hi*8]);
  { float xq[4][8]; float ss=0.f; int hio=hi; asm volatile("":"+v"(hio));
    #pragma unroll
    for(int d0=0;d0<4;++d0)
      #pragma unroll
      for(int j=0;j<8;++j){ xq[d0][j]=__builtin_bit_cast(float,((unsigned)(unsigned short)qr[d0][j])<<16); ss+=xq[d0][j]*xq[d0][j]; }
    ss+=__shfl_xor(ss,32);
    const float rinv=__builtin_amdgcn_rsqf(ss*(1.f/64.f)+1e-6f);
    const int tq=q0+wid*QBLK+r32; const float prow=(float)(tq>>6), pcol=(float)(tq&63);
    #pragma unroll
    for(int d0=0;d0<4;++d0)
      #pragma unroll
      for(int j=0;j<8;++j) xq[d0][j]*=rinv*qgain[16*d0+8*hio+j];
    #pragma unroll
    for(int j=0;j<8;++j){ const float inv=exp2f(-(float)(8*hio+j)*(13.287712379549449f/16.f));
      const float ar=prow*inv, ac=pcol*inv; const float cr=__cosf(ar), sr=__sinf(ar), cc=__cosf(ac), sc=__sinf(ac);
      const float a0=xq[0][j], a1=xq[1][j], b0=xq[2][j], b1=xq[3][j];
      xq[0][j]=(a0*cr-a1*sr)*C2; xq[1][j]=(a1*cr+a0*sr)*C2; xq[2][j]=(b0*cc-b1*sc)*C2; xq[3][j]=(b1*cc+b0*sc)*C2; }
    #pragma unroll
    for(int d0=0;d0<4;++d0){ u32x4 w; w.x=cvtpk_s(xq[d0][0],xq[d0][1]); w.y=cvtpk_s(xq[d0][2],xq[d0][3]); w.z=cvtpk_s(xq[d0][4],xq[d0][5]); w.w=cvtpk_s(xq[d0][6],xq[d0][7]); qr[d0]=__builtin_bit_cast(bf16x8,w); } }
  float l_reg=0.f;f32x16 o[2];o[0]=f32x16{};o[1]=f32x16{};f32x16 negm;
  #pragma unroll
  for(int r=0;r<16;++r)negm[r]=-sbound;
  asm volatile("":"+v"(negm));
  #define START(P0,P1) do{ _Pragma("unroll") for(int r=0;r<16;++r)P0[r]=__builtin_amdgcn_exp2f(P0[r]); }while(0)
  #define RESC() do{}while(0)
  f32x16 pA0,pA1,pB0,pB1;
  int sl_prev=0,sl_cur=0,sl_next=SLOTB;
  #define ROT() do{sl_prev=sl_cur;sl_cur=sl_next;sl_next=(sl_next==(NSLOT-1)*SLOTB)?0:sl_next+SLOTB;}while(0)
  DMA_K(2,2*SLOTB);
  WAIT_BAR(3);
  qkt(pA0,pA1,Kbase,qr,negm,r32,hi);asm volatile("s_nop 15\n\ts_nop 7":"+v"(pA0),"+v"(pA1));
  START(pA0,pA1);
  _Pragma("unroll") for(int r=0;r<16;++r)pA1[r]=__builtin_amdgcn_exp2f(pA1[r]);
  WAIT_BAR(0);
  DMA_K(3,0);DMA_V(1,SLOTB);
  ROT();
  kload8(kf,kp0+sl_cur);
  WAIT_BAR(2);
  s16x4 vlo[8],vhi[8]; u32x4 pw0,pw1,pw2,pw3;
  #define PKW(P,B) cvtpk_s(P[B],P[B+1])
  #define PAF(k) __builtin_bit_cast(bf16x8,pw##k)
  #define VFR(i) (bf16x8){vlo[i][0],vlo[i][1],vlo[i][2],vlo[i][3],vhi[i][0],vhi[i][1],vhi[i][2],vhi[i][3]}
  #define PIN(x) asm volatile("":"+v"(x))
  #define MX3(a,b,c) __builtin_fmaxf(__builtin_fmaxf((a),(b)),(c))
  #define GAPA(MF,A0,A1,A2,A3,W0,W1,PW) do{ MF; sacc+=A0; sacc+=A1; sacc+=A2; sacc+=A3; PIN(sacc); W0; W1; PIN(PW); SBAR(); }while(0)
  #define EX(v) __builtin_amdgcn_exp2f(v)
  #define GAPB(MF,X,B) do{ MF; X[B]=EX(X[B]); X[B+1]=EX(X[B+1]); X[B+2]=EX(X[B+2]); X[B+3]=EX(X[B+3]); PIN(X); SBAR(); }while(0)
  #define VRD(i) do{ vlo[i]=vtr(vp_+(((i)>>2)*4096+((i)&3)*1024)); vhi[i]=vtr(vp_+(((i)>>2)*4096+((i)&3)*1024+512)); }while(0)
  #define KRD(G,j) do{ if(G){ kload2(kf,kp0+sl_next,j); SBAR(); } }while(0)
  #define STEP(C0,C1,P0,P1,t,GK,GV,GL) do{ SBAR(); \
    const lds_cptr vp_=vp0+sl_prev; \
    VRD(0); SBAR(); float sacc=(P0[0]+P0[1]); \
    GAPA(C0=__builtin_amdgcn_mfma_f32_32x32x16_bf16(kf[0],qr[0],negm,0,0,0), P0[2],P0[3],P0[4],P0[5],     pw0[0]=PKW(P0,0), pw0[1]=PKW(P0,2), pw0); \
    VRD(4); SBAR(); GAPA(C1=__builtin_amdgcn_mfma_f32_32x32x16_bf16(kf[1],qr[0],negm,0,0,0), P0[6],P0[7],P0[8],P0[9],     pw0[2]=PKW(P0,4), pw0[3]=PKW(P0,6), pw0); \
    VRD(1); SBAR(); GAPA(C0=__builtin_amdgcn_mfma_f32_32x32x16_bf16(kf[2],qr[1],C0,0,0,0),   P0[10],P0[11],P0[12],P0[13], pw1[0]=PKW(P0,8), pw1[1]=PKW(P0,10), pw1); \
    VRD(5); SBAR(); GAPA(C1=__builtin_amdgcn_mfma_f32_32x32x16_bf16(kf[3],qr[1],C1,0,0,0),   P0[14],P0[15],P1[0],P1[1],   pw1[2]=PKW(P0,12),pw1[3]=PKW(P0,14), pw1); \
    VRD(2); SBAR(); GAPA(C0=__builtin_amdgcn_mfma_f32_32x32x16_bf16(kf[4],qr[2],C0,0,0,0),   P1[2],P1[3],P1[4],P1[5],     pw2[0]=PKW(P1,0), pw2[1]=PKW(P1,2), pw2); \
    VRD(6); SBAR(); GAPA(C1=__builtin_amdgcn_mfma_f32_32x32x16_bf16(kf[5],qr[2],C1,0,0,0),   P1[6],P1[7],P1[8],P1[9],     pw2[2]=PKW(P1,4), pw2[3]=PKW(P1,6), pw2); \
    VRD(3); SBAR(); GAPA(C0=__builtin_amdgcn_mfma_f32_32x32x16_bf16(kf[6],qr[3],C0,0,0,0),   P1[10],P1[11],P1[12],P1[13], pw3[0]=PKW(P1,8), pw3[1]=PKW(P1,10), pw3); \
    VRD(7); SBAR(); GAPA(C1=__builtin_amdgcn_mfma_f32_32x32x16_bf16(kf[7],qr[3],C1,0,0,0),   P1[14],P1[15],0.f,0.f,       pw3[2]=PKW(P1,12),pw3[3]=PKW(P1,14), pw3); \
    l_reg+=sacc; \
    if(GK){DMA_K((t)+3,sl_cur);} if(GV){DMA_V((t)+1,sl_next);} \
    SBAR(); \
    GAPB(o[0]=__builtin_amdgcn_mfma_f32_32x32x16_bf16(PAF(0),VFR(0),o[0],0,0,0), C0,0); \
    GAPB(o[1]=__builtin_amdgcn_mfma_f32_32x32x16_bf16(PAF(0),VFR(4),o[1],0,0,0), C0,4); \
    KRD(GL,0); GAPB(o[0]=__builtin_amdgcn_mfma_f32_32x32x16_bf16(PAF(1),VFR(1),o[0],0,0,0), C0,8); \
    KRD(GL,1); GAPB(o[1]=__builtin_amdgcn_mfma_f32_32x32x16_bf16(PAF(1),VFR(5),o[1],0,0,0), C0,12); \
    KRD(GL,2); GAPB(o[0]=__builtin_amdgcn_mfma_f32_32x32x16_bf16(PAF(2),VFR(2),o[0],0,0,0), C1,0); \
    KRD(GL,3); GAPB(o[1]=__builtin_amdgcn_mfma_f32_32x32x16_bf16(PAF(2),VFR(6),o[1],0,0,0), C1,4); \
    GAPB(o[0]=__builtin_amdgcn_mfma_f32_32x32x16_bf16(PAF(3),VFR(3),o[0],0,0,0), C1,8); \
    GAPB(o[1]=__builtin_amdgcn_mfma_f32_32x32x16_bf16(PAF(3),VFR(7),o[1],0,0,0), C1,12); \
    }while(0)
  int t=1;
  for(;t+5<NT;t+=2){
    STEP(pB0,pB1,pA0,pA1,t,true,true,true);     WAIT_BAR(2); RESC(); ROT();
    STEP(pA0,pA1,pB0,pB1,t+1,true,true,true);   WAIT_BAR(2); RESC(); ROT();
  }
  #define ENDW(tt) do{ if((tt)+3<NT){WAIT_BAR(2);} else if((tt)+2<NT){WAIT_BAR(1);} else {WAIT_BAR(0);} }while(0)
  for(;t+1<NT;t+=2){
    STEP(pB0,pB1,pA0,pA1,t,(t+3<NT),(t+1<NT),(t+1<NT));       ENDW(t);   RESC(); ROT();
    STEP(pA0,pA1,pB0,pB1,t+1,(t+4<NT),(t+2<NT),(t+2<NT));     ENDW(t+1); RESC(); ROT();
  }
  STEP(pB0,pB1,pA0,pA1,NT-1,false,false,false); RESC();
  { float sacc=pB0[0]+pB0[1]; _Pragma("unroll") for(int r=2;r<16;++r)sacc+=pB0[r]; _Pragma("unroll") for(int r=0;r<16;++r)sacc+=pB1[r]; l_reg+=sacc;
    pw0=(u32x4){PKW(pB0,0),PKW(pB0,2),PKW(pB0,4),PKW(pB0,6)};pw1=(u32x4){PKW(pB0,8),PKW(pB0,10),PKW(pB0,12),PKW(pB0,14)};pw2=(u32x4){PKW(pB1,0),PKW(pB1,2),PKW(pB1,4),PKW(pB1,6)};pw3=(u32x4){PKW(pB1,8),PKW(pB1,10),PKW(pB1,12),PKW(pB1,14)};
    SBAR(); pv(o,vb0+sl_cur,PAF(0),PAF(1),PAF(2),PAF(3)); }
  #undef PKW
  #undef PAF
  #undef VFR
  #undef PIN
  #undef MX3
  #undef GAPA
  #undef GAPB
  #undef EX
  #undef VRD
  #undef KRD
  #undef STEP
  #undef ENDW
  {auto rr=__builtin_amdgcn_permlane32_swap(__float_as_uint(l_reg),__float_as_uint(l_reg),false,false);l_reg=__uint_as_float(rr[0])+__uint_as_float(rr[1]);}
  if(hi==0)wsf[32+r32]=l_reg;asm volatile("s_waitcnt lgkmcnt(0)":::"memory");
  float rli[16];
  #pragma unroll
  for(int r=0;r<16;++r)rli[r]=__builtin_amdgcn_rcpf(wsf[32+crow(r,hi)]);
  bf16*Ow=O+(rowbase+q0+wid*QBLK)*OP+OCOL+h*D;
  { bf16*stg=(bf16*)(shm+LDS_OST)+wid*2048;
    #pragma unroll
    for(int r=0;r<16;++r){const int orow=crow(r,hi);
      #pragma unroll
      for(int d0=0;d0<2;++d0)stg[orow*64+d0*32+r32]=__float2bfloat16(o[d0][r]*rli[r]);}
    asm volatile("s_waitcnt lgkmcnt(0)":::"memory");
    #pragma unroll
    for(int i=0;i<4;++i){const int row=i*8+(lane>>3),ch=lane&7; const u32x4 v=*(const u32x4*)(stg+row*64+ch*8); ATTN_STORE16(Ow+(long)row*OP+ch*8,v);} }
  asm volatile("s_waitcnt lgkmcnt(0)\n\ts_barrier":::"memory");
  #undef DMA_K
  #undef DMA_V
  #undef START
  #undef RESC
  #undef ROT
}
constexpr int ATTN_LDS_BYTES=LDS_BYTES;
#undef SBAR
#undef WAIT_BAR
}
constexpr int NWAVES = 8;
constexpr int BATCH = 8, SEQ = 4096, DM = 1024, T = BATCH * SEQ;
constexpr int GLA_H = 4, GLA_DK = 64, GLA_DV = 128, GLA_RANK = 16;
constexpr int ATT_H = 8, ATT_KVH = 2, ATT_DH = 64;
constexpr int D_IN = 2336, D_IN_PAD = 2560;
constexpr int NEXP = 32, TOPK = 4, DFF = 1024;
constexpr int EROWS = 32768;
constexpr int PROWS = T * TOPK + NEXP * 256;
constexpr float EPS = 1e-6f;
constexpr float YSCALE = 16.f;
constexpr float WSCALE = 32.f, ASCALE = 4.f;

constexpr size_t MiB = 1u << 20;
constexpr size_t WS_CTL = 0, CTL_ZERO_BYTES = 1 * MiB;
constexpr size_t WS_WRH = 1 * MiB, WS_WRL = WS_WRH + 65536;
constexpr size_t WS_WIN = 2 * MiB;
constexpr size_t WS_WOUT = 8 * MiB;
constexpr size_t WS_W1 = 10 * MiB;
constexpr size_t WS_W2 = 138 * MiB;
constexpr size_t WS_ROWTOK = 202 * MiB;
constexpr size_t WS_ROWGATE = 206 * MiB;
constexpr size_t WS_TOKASG = 210 * MiB;
constexpr size_t WS_REGY = 212 * MiB;
constexpr size_t WS_XN = WS_REGY;
constexpr size_t WS_GQ = WS_XN + 64 * MiB;
constexpr size_t WS_GK = WS_GQ + 16 * MiB;
constexpr size_t WS_GV = WS_GK + 16 * MiB;
constexpr size_t WS_GR = WS_GV + 32 * MiB;
constexpr size_t WS_AQ = WS_GR + 32 * MiB;
constexpr size_t WS_AK = WS_AQ + 32 * MiB;
constexpr size_t WS_AV = WS_AK + 8 * MiB;
constexpr size_t WS_Z = WS_AV + 8 * MiB;
constexpr size_t WS_OF = WS_Z + 2 * MiB;
constexpr size_t WS_H16 = WS_REGY + 200 * MiB;
constexpr size_t WS_Y = WS_REGY;
constexpr size_t WS_REGA = WS_REGY + 274 * MiB;
constexpr size_t WS_MIX = WS_REGA;
constexpr size_t WS_ACT = WS_REGA;
constexpr size_t WS_QF = WS_REGA + 272 * MiB, WS_KF = WS_QF + 16 * MiB, WS_QB = WS_KF + 16 * MiB, WS_KB = WS_QB + 16 * MiB;
constexpr size_t WS_DEC = WS_KB + 16 * MiB;
constexpr size_t WS_END = WS_DEC + 1 * MiB;
static_assert(WS_OF + (size_t)T * 512 * 4 <= WS_REGA && (size_t)PROWS * 1024 * 2 <= 272 * MiB, "d_ws map");
constexpr int CW_BAR = 4096;
constexpr int CW_CNT = 8192;
constexpr int CW_CONV = 20480;
constexpr int CW_GDN = 16384;
constexpr int CW_QUE = 12288;

constexpr int SCR_BYTES = 133120;
constexpr int LC_OFF = SCR_BYTES;
constexpr int LC_MISC = LC_OFF;
constexpr int LC_CNT = LC_OFF + 128;
constexpr int LC_CST = LC_CNT + 128;
constexpr int LC_TE = LC_CST + 256;
constexpr int LC_HIST = LC_TE + 1152;
constexpr int LC_BASE = LC_HIST + 128;
constexpr int LC_ASG = LC_BASE + 128;
constexpr int LC_GDEC = LC_ASG + 8192;
constexpr int LC_END = LC_GDEC + 512;
constexpr int LDS_BYTES = 147456;
static_assert(LC_END <= LDS_BYTES, "LDS map");

typedef unsigned short bf16;
typedef unsigned v4u __attribute__((ext_vector_type(4)));
typedef unsigned v2u __attribute__((ext_vector_type(2)));
typedef float f32x4 __attribute__((ext_vector_type(4)));
typedef short bf16x8 __attribute__((ext_vector_type(8)));
typedef GAS unsigned gu32;
#define RLX_AGENT __ATOMIC_RELAXED, __HIP_MEMORY_SCOPE_AGENT
#define LDS_WAIT() asm volatile("s_waitcnt lgkmcnt(0)" ::: "memory")
#define VM_WAIT() asm volatile("s_waitcnt vmcnt(0)" ::: "memory")
__device__ __forceinline__ unsigned pk2(float lo, float hi) { typedef float f2_t_ __attribute__((ext_vector_type(2))); typedef __bf16 b2_t_ __attribute__((ext_vector_type(2))); const f2_t_ v = {lo, hi}; return __builtin_bit_cast(unsigned, __builtin_convertvector(v, b2_t_)); }
__device__ __forceinline__ unsigned f2bf(float f) { return pk2(f, 0.f) & 0xffffu; }
__device__ __forceinline__ float bf2f(unsigned h) { return __builtin_bit_cast(float, h << 16); }
__device__ __forceinline__ float bflo(unsigned w) { return __builtin_bit_cast(float, w << 16); }
__device__ __forceinline__ float bfhi(unsigned w) { return __builtin_bit_cast(float, w & 0xffff0000u); }

#define XB_TMO      128
#define XB_XCNT(j)  (256  + 64 * (j))
#define XB_XSUB(j)  (1280 + 64 * (j))
#define XB_XGEN(j)  (2304 + 64 * (j))
#define XB_TOP      3328
#define XB_TOPGEN   3392
#define XCD_BAR_WORDS 3456
#define XB_SPIN_CAP (1u << 18)
__device__ __forceinline__ unsigned xb_ld(unsigned* p)              { return __hip_atomic_load(p, __ATOMIC_RELAXED, __HIP_MEMORY_SCOPE_AGENT); }
__device__ __forceinline__ unsigned xb_add(unsigned* p, unsigned v) { return __hip_atomic_fetch_add(p, v, __ATOMIC_RELAXED, __HIP_MEMORY_SCOPE_AGENT); }
__device__ __forceinline__ unsigned xb_xcc_id() { return (unsigned)__builtin_amdgcn_s_getreg((3 << 11) | 20) & 0xFu; }
#define XB_SPIN(cond, bar) do { unsigned _sp = 0; while (cond) { __builtin_amdgcn_s_sleep(1); \
    if ((++_sp & 255u) == 0u) { if (xb_ld(&(bar)[XB_TMO])) break; if (_sp > XB_SPIN_CAP) { atomicAdd(&(bar)[XB_TMO], 1u); break; } } } } while (0)
struct XcdBarrier { unsigned* bar; unsigned x; volatile LAS unsigned* st; };
__device__ __forceinline__ XcdBarrier xcd_barrier_post(unsigned* bar, volatile LAS unsigned* st) {
    XcdBarrier b; b.bar = bar; b.x = xb_xcc_id(); b.st = st;
    if (threadIdx.x == 0) (void)xb_add(&bar[XB_XCNT(b.x)], 1u);
    return b;
}
__device__ __forceinline__ void xcd_barrier_complete(unsigned* bar, unsigned x, unsigned& nloc, unsigned& nx) {
    const unsigned G = gridDim.x * gridDim.y * gridDim.z;
    unsigned sum, cnt, mine, sp = 0u;
    for (;;) {
        sum = 0u; cnt = 0u; mine = 0u;
#pragma unroll
        for (unsigned j = 0; j < 16; ++j) { const unsigned c = xb_ld(&bar[XB_XCNT(j)]); sum += c; cnt += (c > 0u) ? 1u : 0u; mine = (j == x) ? c : mine; }
        if (sum == G) break;
        __builtin_amdgcn_s_sleep(1);
        if ((++sp & 255u) == 0u) { if (xb_ld(&bar[XB_TMO])) break; if (sp > XB_SPIN_CAP) { atomicAdd(&bar[XB_TMO], 1u); break; } }
    }
    nloc = mine > 0u ? mine : 1u; nx = cnt > 0u ? cnt : 1u;
}
__device__ __forceinline__ void xcd_barrier(const XcdBarrier& b) {
    asm volatile("s_waitcnt vmcnt(0)" ::: "memory");
    __syncthreads();
    if (threadIdx.x == 0) {
        unsigned* bar = b.bar;
        __builtin_amdgcn_s_waitcnt(0);
        unsigned nloc = b.st[0], nx = b.st[1];
        if (nloc == 0u) { xcd_barrier_complete(bar, b.x, nloc, nx); b.st[0] = nloc; b.st[1] = nx; }
        const unsigned old = xb_add(&bar[XB_XSUB(b.x)], 1u);
        const unsigned gen = old / nloc;
        if (old + 1u == (gen + 1u) * nloc) {
            __builtin_amdgcn_fence(__ATOMIC_RELEASE, "agent");
            asm volatile("s_waitcnt vmcnt(0)" ::: "memory");
            const unsigned og = xb_add(&bar[XB_TOP], 1u);
            const unsigned tg = og / nx;
            if (og + 1u == (tg + 1u) * nx) xb_add(&bar[XB_TOPGEN], 1u);
            else XB_SPIN(xb_ld(&bar[XB_TOPGEN]) == tg, bar);
            __builtin_amdgcn_fence(__ATOMIC_ACQUIRE, "agent");
            xb_add(&bar[XB_XGEN(b.x)], 1u);
            asm volatile("s_waitcnt vmcnt(0)" ::: "memory");
        } else {
            XB_SPIN(xb_ld(&bar[XB_XGEN(b.x)]) == gen, bar);
            __builtin_amdgcn_fence(__ATOMIC_ACQUIRE, "agent");
            asm volatile("s_waitcnt vmcnt(0)" ::: "memory");
        }
    }
    __syncthreads();
}

struct Frame {
    LAS unsigned char* lds;
    volatile LAS unsigned* MISC;
    gu32* ctl;
    int tid, lane, wave;
    int vcu, G;
    unsigned char* ws;
    const float *x, *mix_g, *w_in, *w_gf, *b_gf, *w_gb, *b_gb, *gla_hg, *q_g, *k_g, *w_out, *ffn_g, *w_router, *b_router, *w1, *b1, *w2, *b2, *fin_g;
    float* out;
};
template <int CTRL> __device__ __forceinline__ float dpp_mov(float v) { return __builtin_bit_cast(float, __builtin_amdgcn_update_dpp(0, __builtin_bit_cast(int, v), CTRL, 0xf, 0xf, true)); }
__device__ __forceinline__ float wave_sum(float v) {
    v += dpp_mov<0xB1>(v);
    v += dpp_mov<0x4E>(v);
    v += dpp_mov<0x141>(v);
    v += dpp_mov<0x140>(v);
    { auto r = __builtin_amdgcn_permlane16_swap(__float_as_uint(v), __float_as_uint(v), false, false); v = __uint_as_float(r[0]) + __uint_as_float(r[1]); }
    { auto r = __builtin_amdgcn_permlane32_swap(__float_as_uint(v), __float_as_uint(v), false, false); v = __uint_as_float(r[0]) + __uint_as_float(r[1]); }
    return v;
}
__device__ __forceinline__ void p0_tr64(const float* src  , int ldw, bf16* d0, bf16* d1, int ldt, LAS float* scr, int lane, int ncols) {
    const int c4 = (lane & 15) * 4, kr = lane >> 4;
    if (c4 < ncols) {
#pragma unroll 4
        for (int i = 0; i < 16; ++i) { const int kk = kr + 4 * i; const f32x4 v = *(const GAS f32x4*)(src + (size_t)kk * ldw + c4);
            LAS float* s = scr + kk * 65 + c4; s[0] = v.x; s[1] = v.y; s[2] = v.z; s[3] = v.w; }
    }
    LDS_WAIT(); asm volatile("" ::: "memory");
    const int c = lane & 7;
#pragma unroll
    for (int j = 0; j < 8; ++j) { const int n = (lane >> 3) + 8 * j;
        if (n < ncols) { const LAS float* s = scr + (8 * c) * 65 + n;
            v4u o; o.x = pk2(s[0 * 65], s[1 * 65]); o.y = pk2(s[2 * 65], s[3 * 65]); o.z = pk2(s[4 * 65], s[5 * 65]); o.w = pk2(s[6 * 65], s[7 * 65]);
            bf16* rowp = (n < 32 ? d0 : d1) + (size_t)(n & 31) * ldt;
            *(GAS v4u*)(rowp + 8 * c) = o; } }
    LDS_WAIT(); asm volatile("" ::: "memory");
}
struct F8Item { const float* src; int ldw; unsigned char* d0; unsigned char* d1; };
__device__ __forceinline__ void f8_load(const F8Item& it, f32x4 (&v)[16], int lane) {
    const int c4 = (lane & 15) * 4, kr = lane >> 4;
#pragma unroll
    for (int i = 0; i < 16; ++i) v[i] = __builtin_nontemporal_load((const GAS f32x4*)(it.src + (size_t)(kr + 4 * i) * it.ldw + c4));
}
__device__ __forceinline__ void f8_finish(const F8Item& it, const f32x4 (&v)[16], LAS float* scr, int lane, float sc) {
    const int c4 = (lane & 15) * 4, kr = lane >> 4;
#pragma unroll
    for (int i = 0; i < 16; ++i) { LAS float* s = scr + (kr + 4 * i) * 65 + c4; s[0] = v[i].x; s[1] = v[i].y; s[2] = v[i].z; s[3] = v[i].w; }
    LDS_WAIT(); asm volatile("" ::: "memory");
    const int c = lane & 7;
#pragma unroll
    for (int j = 0; j < 8; ++j) { const int n = (lane >> 3) + 8 * j; const LAS float* s = scr + (8 * c) * 65 + n;
        int w0 = 0, w1 = 0;
        w0 = __builtin_amdgcn_cvt_pk_fp8_f32(s[0 * 65] * sc, s[1 * 65] * sc, w0, false); w0 = __builtin_amdgcn_cvt_pk_fp8_f32(s[2 * 65] * sc, s[3 * 65] * sc, w0, true);
        w1 = __builtin_amdgcn_cvt_pk_fp8_f32(s[4 * 65] * sc, s[5 * 65] * sc, w1, false); w1 = __builtin_amdgcn_cvt_pk_fp8_f32(s[6 * 65] * sc, s[7 * 65] * sc, w1, true);
        unsigned char* rowp = (n < 32 ? it.d0 : it.d1) + (size_t)(n & 31) * 1024;
        __builtin_nontemporal_store((v2u){(unsigned)w0, (unsigned)w1}, (GAS v2u*)(rowp + 8 * c)); }
    LDS_WAIT(); asm volatile("" ::: "memory");
}
__device__ __forceinline__ int win_pblk(int lb) { return lb < 48 ? lb : (lb == 48 ? 72 : lb - 1); }
__device__ __forceinline__ int w1_pblk(int lb) { return lb < 32 ? (lb >> 2) * 8 + (lb & 3) : ((lb - 32) >> 2) * 8 + 4 + ((lb - 32) & 3); }
__device__ __forceinline__ void rms_row_to_bf16(const float* xrow, const float* g, bf16* orow, int lane) {
    const GAS f32x4* xr = (const GAS f32x4*)xrow + lane; const GAS f32x4* gr = (const GAS f32x4*)g + lane;
    f32x4 v[4]; float s = 0.f;
#pragma unroll
    for (int j = 0; j < 4; ++j) { v[j] = __builtin_nontemporal_load(xr + 64 * j); s += (v[j].x * v[j].x + v[j].y * v[j].y) + (v[j].z * v[j].z + v[j].w * v[j].w); }
    const float rinv = 1.f / sqrtf(wave_sum(s) * (1.f / 1024.f) + EPS);
    GAS unsigned long long* o8 = (GAS unsigned long long*)orow + lane;
#pragma unroll
    for (int j = 0; j < 4; ++j) { const f32x4 gg = gr[64 * j];
        o8[64 * j] = (unsigned long long)pk2(v[j].x * rinv * gg.x, v[j].y * rinv * gg.y) | ((unsigned long long)pk2(v[j].z * rinv * gg.z, v[j].w * rinv * gg.w) << 32); }
}
__device__ __forceinline__ F8Item f8_item(Frame& F, int r) {
    F8Item it;
    if (r < NEXP * 512) { const int e = r / 512, q = r % 512, kb = q / 32, nb = q % 32; it.src = F.w1 + (size_t)e * 1024 * 2048 + (size_t)(64 * kb) * 2048 + 64 * nb; it.ldw = 2048;
        unsigned char* dst = F.ws + WS_W1 + (size_t)e * 2048 * 1024 + 64 * kb; it.d0 = dst + (size_t)(32 * w1_pblk(2 * nb)) * 1024; it.d1 = dst + (size_t)(32 * w1_pblk(2 * nb + 1)) * 1024; }
    else { const int r2 = r - NEXP * 512, e = r2 / 256, q = r2 % 256, kb = q / 16, nb = q % 16; it.src = F.w2 + (size_t)e * 1024 * 1024 + (size_t)(64 * kb) * 1024 + 64 * nb; it.ldw = 1024;
        unsigned char* dst = F.ws + WS_W2 + (size_t)e * 1024 * 1024 + 64 * kb; it.d0 = dst + (size_t)(64 * nb) * 1024; it.d1 = dst + (size_t)(64 * nb + 32) * 1024; }
    return it;
}
constexpr int N_F8_ITEMS = NEXP * 512 + NEXP * 256, N_CONV_BATCH = N_F8_ITEMS / 64;
__device__ __forceinline__ void f8_items(Frame& F, int r, int step, int rend, LAS float* scr) {
    if (r >= rend) return;
    F8Item cur = f8_item(F, r); f32x4 va[16], vb[16];
    f8_load(cur, va, F.lane);
    for (;;) {
        int rn = r + step; F8Item nx = cur; if (rn < rend) { nx = f8_item(F, rn); f8_load(nx, vb, F.lane); }
        f8_finish(cur, va, scr, F.lane, WSCALE);
        if (rn >= rend) break;
        r = rn + step; cur = nx; if (r < rend) { cur = f8_item(F, r); f8_load(cur, va, F.lane); }
        f8_finish(nx, vb, scr, F.lane, WSCALE);
        if (r >= rend) break;
    }
}
__device__ __forceinline__ bool conv_pull(Frame& F) {
    __syncthreads();
    if (F.tid == 0) F.MISC[17] = __hip_atomic_fetch_add(F.ctl + CW_CONV, 1u, RLX_AGENT);
    __syncthreads();
    const int cb = __builtin_amdgcn_readfirstlane((int)F.MISC[17]);
    if (cb >= N_CONV_BATCH) return false;
    f8_items(F, cb * 64 + F.wave * 8, 1, cb * 64 + F.wave * 8 + 8, (LAS float*)(F.lds + F.wave * 16640));
    return true;
}
__device__ __forceinline__ void p0_prologue(Frame& F) {
    LAS float* scr = (LAS float*)(F.lds + F.wave * 16640);
    const int gw = F.vcu * NWAVES + F.wave, NGW = F.G * NWAVES;
    bf16* WIN = (bf16*)(F.ws + WS_WIN); bf16* WOUT = (bf16*)(F.ws + WS_WOUT);
    constexpr int I_IN = 16 * 37, I_OUT = 16 * 16, NITEMS = I_IN + I_OUT;
    for (int it = gw; it < NITEMS; it += NGW) {
        int r = it;
        if (r < I_IN) { const int kb = r / 37, nb = r % 37; const int lb0 = 2 * nb, nc = (nb == 36) ? 32 : 64;
            p0_tr64(F.w_in + (size_t)(64 * kb) * D_IN + 64 * nb, D_IN, WIN + (size_t)(32 * win_pblk(lb0)) * 1024 + 64 * kb, WIN + (size_t)(32 * win_pblk(lb0 + 1 < 73 ? lb0 + 1 : lb0)) * 1024 + 64 * kb, 1024, scr, F.lane, nc); continue; }
        r -= I_IN;
        { const int kb = r / 16, nb = r % 16;
            p0_tr64(F.w_out + (size_t)(64 * kb) * 1024 + 64 * nb, 1024, WOUT + (size_t)(64 * nb) * 1024 + 64 * kb, WOUT + (size_t)(64 * nb + 32) * 1024 + 64 * kb, 1024, scr, F.lane, 64); }
    }
    { const int gt = F.vcu * (NWAVES * 64) + F.tid, NGT = F.G * NWAVES * 64; GAS v4u* z = (GAS v4u*)(WIN + (size_t)D_IN * 1024);
      for (int i = gt; i < (D_IN_PAD - D_IN) * 1024 * 2 / 16; i += NGT) z[i] = (v4u){0u, 0u, 0u, 0u};
      bf16* WRH = (bf16*)(F.ws + WS_WRH); bf16* WRL = (bf16*)(F.ws + WS_WRL);
      for (int i = gt; i < NEXP * 1024; i += NGT) { const int e = i >> 10, k = i & 1023; const float w = F.w_router[(size_t)k * NEXP + e]; const unsigned h = f2bf(w); WRH[i] = (bf16)h; WRL[i] = (bf16)f2bf(w - bf2f(h)); } }
    bf16* XN = (bf16*)(F.ws + WS_XN);
    for (int m = gw; m < T; m += NGW) rms_row_to_bf16(F.x + (size_t)m * DM, F.mix_g, XN + (size_t)m * DM, F.lane);
}

__device__ __forceinline__ void p2_normrope(Frame& F) {
    LAS float* cs = (LAS float*)F.lds;
    for (int i = F.tid; i < 1024; i += NWAVES * 64) { const int pos = i >> 4, fi = i & 15; const float inv = exp2f(-(float)fi * (13.287712379549449f / 16.f)); const float a = (float)pos * inv;
        cs[2 * i] = __cosf(a); cs[2 * i + 1] = __sinf(a); }
    __syncthreads();
    const int gw = F.vcu * NWAVES + F.wave, NGW = F.G * NWAVES, lane = F.lane;
    const int j = lane & 7, blk = (j >> 2) & 1, jj = j & 3, fi0 = 8 * (jj & 1); const bool second = (jj >> 1) != 0;
    float gq[8], gk[8];
#pragma unroll
    for (int e = 0; e < 8; ++e) { gq[e] = F.q_g[8 * j + e]; gk[e] = F.k_g[8 * j + e]; }
    bf16* AQ = (bf16*)(F.ws + WS_AQ); bf16* AK = (bf16*)(F.ws + WS_AK);
    for (int it = T + gw; it < T + T / 4; it += NGW) {
        const bool isq = it < T;
        const int tok = isq ? it : 4 * (it - T) + (lane >> 4);
        GAS v4u* p = isq ? (GAS v4u*)(AQ + (size_t)tok * 512) + lane : (GAS v4u*)(AK + (size_t)tok * 128) + (lane & 15);
        const v4u w = *p;
        float x[8] = {bflo(w.x), bfhi(w.x), bflo(w.y), bfhi(w.y), bflo(w.z), bfhi(w.z), bflo(w.w), bfhi(w.w)};
        float ss = 0.f;
#pragma unroll
        for (int e = 0; e < 8; ++e) ss += x[e] * x[e];
        ss += __shfl_xor(ss, 1); ss += __shfl_xor(ss, 2); ss += __shfl_xor(ss, 4);
        const float rinv = 1.f / sqrtf(ss * (1.f / 64.f) + EPS);
        const int ts = tok & (SEQ - 1), pos = blk ? (ts & 63) : (ts >> 6);
        const LAS float* c = cs + (pos * 16 + fi0) * 2;
        float y[8];
#pragma unroll
        for (int e = 0; e < 8; ++e) { x[e] = x[e] * rinv * (isq ? gq[e] : gk[e]); }
#pragma unroll
        for (int e = 0; e < 8; ++e) { const float pr = __shfl_xor(x[e], 2); const float co = c[2 * e], si = c[2 * e + 1]; y[e] = second ? (x[e] * co + pr * si) : (x[e] * co - pr * si); }
        const float sc = isq ? attn_body::C2 : 1.f;
        v4u o; o.x = pk2(y[0] * sc, y[1] * sc); o.y = pk2(y[2] * sc, y[3] * sc); o.z = pk2(y[4] * sc, y[5] * sc); o.w = pk2(y[6] * sc, y[7] * sc);
        *p = o;
    }
}
namespace gla {
typedef short bf16x8 __attribute__((ext_vector_type(8)));
typedef short s16x4 __attribute__((ext_vector_type(4)));
typedef float f32x4 __attribute__((ext_vector_type(4)));
constexpr int P64 = 144, PV = 272, POT = 528;
constexpr int L_QS = 0, L_KS = 9216, L_VR = 18432, L_AS = 35840, L_ST = 45056, L_OT = 63488, L_SET2 = 97280, L_END = 133120;
constexpr int L_DEC = LC_GDEC;
__device__ __forceinline__ unsigned cvtpk(float lo, float hi) { typedef float f2_t __attribute__((ext_vector_type(2))); typedef __bf16 b2_t __attribute__((ext_vector_type(2))); f2_t v = {lo, hi}; b2_t b = __builtin_convertvector(v, b2_t); return __builtin_bit_cast(unsigned, b); }
__device__ __forceinline__ float logsig(float x) { return fminf(x, 0.f) - __logf(1.f + __expf(-fabsf(x))); }
__device__ __forceinline__ s16x4 vtr(const LAS unsigned char* p) { typedef short v4i16_t __attribute__((ext_vector_type(4))); return __builtin_bit_cast(s16x4, __builtin_amdgcn_ds_read_tr16_b64_v4i16((LAS v4i16_t*)p)); }

__device__ __forceinline__ void gla_prep_unit(Frame& F, int b, int c) {
    LAS unsigned char* L = F.lds;
    const int tid = F.tid, dir = __builtin_amdgcn_readfirstlane(tid >> 8), col = tid & 255;
    const bf16* GQ = (const bf16*)(F.ws + WS_GQ); const bf16* GK = (const bf16*)(F.ws + WS_GK); const bf16* ZZ = (const bf16*)(F.ws + WS_Z);
    bf16* QX = (bf16*)(F.ws + (dir ? WS_QB : WS_QF)); bf16* KX = (bf16*)(F.ws + (dir ? WS_KB : WS_KF)); float* DEC = (float*)(F.ws + WS_DEC) + (size_t)dir * (BATCH * 64 * 256);
    const unsigned row0 = (unsigned)b * SEQ + (unsigned)c * 64u;
    __syncthreads();
    if (tid < 256) { const int row = tid >> 2, seg = tid & 3; const v4u z = *(const GAS v4u*)(ZZ + (row0 + row) * 32 + seg * 8); LAS f32x4* zp = (LAS f32x4*)(L + row * 128 + seg * 32);
        zp[0] = (f32x4){bflo(z.x), bfhi(z.x), bflo(z.y), bfhi(z.y)}; zp[1] = (f32x4){bflo(z.z), bfhi(z.z), bflo(z.w), bfhi(z.w)}; }
    float wg[16]; const float* WG = dir ? F.w_gb : F.w_gf;
#pragma unroll
    for (int r = 0; r < 16; ++r) wg[r] = WG[r * 256 + col];
    const float bgv = (dir ? F.b_gb : F.b_gf)[col];
    __syncthreads();
    float pf[64]; float run = 0.f;
#pragma unroll
    for (int p = 0; p < 64; ++p) { const LAS f32x4* zp = (const LAS f32x4*)(L + p * 128 + dir * 64); float pre = bgv;
#pragma unroll
        for (int r4 = 0; r4 < 4; ++r4) { const f32x4 z = zp[r4]; pre += z.x * wg[4 * r4] + z.y * wg[4 * r4 + 1] + z.z * wg[4 * r4 + 2] + z.w * wg[4 * r4 + 3]; }
        run += logsig(pre) * (1.f / 16.f); pf[p] = run; }
    const float tot = run;
#pragma unroll
    for (int p = 0; p < 64; ++p) { const unsigned idx = (row0 + p) * 256 + col;
        const float qv = bf2f(GQ[idx]), kv = bf2f(GK[idx]);
        const float ex = dir ? (p ? pf[p - 1] : 0.f) : 0.f;
        const float eq = dir ? __expf(-ex) * 0.125f : __expf(pf[p] - tot) * 0.125f;
        const float ek = dir ? __expf(ex) : __expf(tot - pf[p]);
        QX[idx] = (bf16)f2bf(qv * eq); KX[idx] = (bf16)f2bf(kv * ek); }
    DEC[((unsigned)b * 64 + c) * 256 + col] = __expf(tot);
}

__device__ __forceinline__ void gla_unit(Frame& F, int b, int h, int dir) {
    LAS unsigned char* L = F.lds;
    const int tid = F.tid, lane = F.lane, w = F.wave, q4 = lane >> 4, l15 = lane & 15;
    const bf16* GV = (const bf16*)(F.ws + WS_GV);
    bf16* OX = (bf16*)(F.ws + WS_OF + (dir ? 32 * MiB : 0));
    const unsigned rowbase = (unsigned)b * SEQ;
    const int v0 = 16 * w;
    const int erow = tid >> 3, eseg = tid & 7;
    const int plq = tid >> 3, sgq = tid & 7, plv = tid >> 4, sgv = tid & 15;
    {
        const bf16* QX = (const bf16*)(F.ws + (dir ? WS_QB : WS_QF)); const bf16* KX = (const bf16*)(F.ws + (dir ? WS_KB : WS_KF));
        const float* DEC = (const float*)(F.ws + WS_DEC) + (size_t)dir * (BATCH * 64 * 256);
        f32x4 S[4];
#pragma unroll
        for (int i = 0; i < 4; ++i) S[i] = (f32x4){0.f, 0.f, 0.f, 0.f};
        v4u rq, rk, rv0, rv1; float rdec = 0.f;
#define GLA_LOAD(ci) do { const int c_ = dir ? 63 - (ci) : (ci); const unsigned cb_ = rowbase + (unsigned)c_ * 64u; \
            rq = __builtin_nontemporal_load((const GAS v4u*)(QX + (cb_ + plq) * 256 + h * 64 + sgq * 8)); rk = __builtin_nontemporal_load((const GAS v4u*)(KX + (cb_ + plq) * 256 + h * 64 + sgq * 8)); \
            rv0 = *(const GAS v4u*)(GV + (cb_ + plv) * 512 + h * 128 + sgv * 8); rv1 = *(const GAS v4u*)(GV + (cb_ + plv + 32) * 512 + h * 128 + sgv * 8); \
            if (tid < 64) rdec = DEC[((unsigned)b * 64 + c_) * 256 + h * 64 + tid]; } while (0)
        GLA_LOAD(0);
        v4u st0 = (v4u){0u, 0u, 0u, 0u}, st1 = st0;
#define GLA_FLUSH(cprev) do { const unsigned cbp_ = rowbase + (unsigned)(cprev) * 64u; GAS v4u* sp_ = (GAS v4u*)(OX + (cbp_ + erow) * 512 + h * 128 + eseg * 16); sp_[0] = st0; sp_[1] = st1; } while (0)
#define GLA_STAGE(so) do { *(LAS v4u*)(L + (so) + L_QS + plq * P64 + sgq * 16) = rq; *(LAS v4u*)(L + (so) + L_KS + plq * P64 + sgq * 16) = rk; \
            *(LAS v4u*)(L + (so) + L_VR + plv * PV + sgv * 16) = rv0; *(LAS v4u*)(L + (so) + L_VR + (plv + 32) * PV + sgv * 16) = rv1; \
            if (tid < 64) ((LAS float*)(L + L_DEC))[((so) ? 64 : 0) + tid] = rdec; } while (0)
        __syncthreads();
        GLA_STAGE(0); GLA_LOAD(1);
        __syncthreads();
        for (int ci = 0; ci < 64; ++ci) {
            const int c = dir ? 63 - ci : ci; const int so = (ci & 1) ? L_SET2 : 0, sn = (ci & 1) ? 0 : L_SET2;
#pragma unroll
            for (int s = 0; s < 2; ++s) { const int tt = 2 * w + s, it = tt >> 2, jt = tt & 3; f32x4 a = (f32x4){0.f, 0.f, 0.f, 0.f};
                if (dir ? (jt >= it) : (jt <= it)) {
#pragma unroll
                    for (int ks = 0; ks < 2; ++ks) { const bf16x8 af = *(const LAS bf16x8*)(L + so + L_QS + (16 * it + l15) * P64 + (32 * ks + 8 * q4) * 2); const bf16x8 bfr = *(const LAS bf16x8*)(L + so + L_KS + (16 * jt + l15) * P64 + (32 * ks + 8 * q4) * 2);
                        a = __builtin_amdgcn_mfma_f32_16x16x32_bf16(af, bfr, a, 0, 0, 0); } }
#pragma unroll
                for (int rg = 0; rg < 4; ++rg) { const int i = 16 * it + 4 * q4 + rg, j = 16 * jt + l15; const bool keep = dir ? (j > i) : (j <= i);
                    *(LAS unsigned short*)(L + L_AS + i * P64 + j * 2) = (unsigned short)cvtpk(keep ? a[rg] : 0.f, 0.f); } }
#pragma unroll
            for (int dt = 0; dt < 4; ++dt) { const f32x4 dv = *(const LAS f32x4*)(L + L_DEC + ((ci & 1) ? 256 : 0) + (16 * dt + 4 * q4) * 4); S[dt] = S[dt] * dv;
                *(LAS v2u*)(L + L_ST + (v0 + l15) * P64 + (16 * dt + 4 * q4) * 2) = (v2u){cvtpk(S[dt].x, S[dt].y), cvtpk(S[dt].z, S[dt].w)}; }
            __syncthreads();
            bf16x8 bv[2], bs[2];
#pragma unroll
            for (int ks = 0; ks < 2; ++ks) { const LAS unsigned char* vp = L + so + L_VR + (32 * ks + 8 * q4 + (l15 >> 2)) * PV + (v0 + 4 * (l15 & 3)) * 2;
                const s16x4 lo = vtr(vp), hi = vtr(vp + 4 * PV); bv[ks] = (bf16x8){lo[0], lo[1], lo[2], lo[3], hi[0], hi[1], hi[2], hi[3]};
                bs[ks] = *(const LAS bf16x8*)(L + L_ST + (v0 + l15) * P64 + (32 * ks + 8 * q4) * 2); }
            f32x4 O[4];
#pragma unroll
            for (int it = 0; it < 4; ++it) { O[it] = (f32x4){0.f, 0.f, 0.f, 0.f};
#pragma unroll
                for (int ks = 0; ks < 2; ++ks) { const bf16x8 aq = *(const LAS bf16x8*)(L + so + L_QS + (16 * it + l15) * P64 + (32 * ks + 8 * q4) * 2);
                    if (dir ? !(ks == 0 && it >= 2) : !(ks == 1 && it < 2)) {
                        const bf16x8 aa = *(const LAS bf16x8*)(L + L_AS + (16 * it + l15) * P64 + (32 * ks + 8 * q4) * 2); O[it] = __builtin_amdgcn_mfma_f32_16x16x32_bf16(aa, bv[ks], O[it], 0, 0, 0); }
                    O[it] = __builtin_amdgcn_mfma_f32_16x16x32_bf16(aq, bs[ks], O[it], 0, 0, 0); } }
#pragma unroll
            for (int dt = 0; dt < 4; ++dt)
#pragma unroll
                for (int ks = 0; ks < 2; ++ks) { const LAS unsigned char* kp = L + so + L_KS + (32 * ks + 8 * q4 + (l15 >> 2)) * P64 + (16 * dt + 4 * (l15 & 3)) * 2;
                    const s16x4 lo = vtr(kp), hi = vtr(kp + 4 * P64); const bf16x8 ak = (bf16x8){lo[0], lo[1], lo[2], lo[3], hi[0], hi[1], hi[2], hi[3]};
                    S[dt] = __builtin_amdgcn_mfma_f32_16x16x32_bf16(ak, bv[ks], S[dt], 0, 0, 0); }
#pragma unroll
            for (int it = 0; it < 4; ++it)
#pragma unroll
                for (int rg = 0; rg < 4; ++rg) *(LAS float*)(L + L_OT + (16 * it + 4 * q4 + rg) * POT + (v0 + l15) * 4) = O[it][rg];
            if (ci + 1 < 64) GLA_STAGE(sn);
            asm volatile("" ::: "memory");
            if (ci > 0) GLA_FLUSH(dir ? c + 1 : c - 1);
            asm volatile("" ::: "memory");
            if (ci + 2 < 64) GLA_LOAD(ci + 2);
            __syncthreads();
            {
                float o[16];
#pragma unroll
                for (int e4 = 0; e4 < 4; ++e4) { const f32x4 t = *(const LAS f32x4*)(L + L_OT + erow * POT + (16 * eseg + 4 * e4) * 4); o[4 * e4] = t.x; o[4 * e4 + 1] = t.y; o[4 * e4 + 2] = t.z; o[4 * e4 + 3] = t.w; }
                st0 = (v4u){cvtpk(o[0], o[1]), cvtpk(o[2], o[3]), cvtpk(o[4], o[5]), cvtpk(o[6], o[7])}; st1 = (v4u){cvtpk(o[8], o[9]), cvtpk(o[10], o[11]), cvtpk(o[12], o[13]), cvtpk(o[14], o[15])};
            }
        }
        GLA_FLUSH(dir ? 0 : 63);
#undef GLA_STAGE
#undef GLA_FLUSH
#undef GLA_LOAD
    }
    VM_WAIT(); __syncthreads();
    if (tid == 0) { __builtin_amdgcn_fence(__ATOMIC_RELEASE, "agent"); VM_WAIT(); (void)__hip_atomic_fetch_add(F.ctl + CW_GDN + 64 * (b * GLA_H + h), 1u, RLX_AGENT); }
    __syncthreads();
}
__device__ __forceinline__ void gla_combine(Frame& F, int b, int h, int part) {
    const int tid = F.tid, erow = tid >> 3, eseg = tid & 7;
    if (tid == 0) { unsigned sp = 0; while (__hip_atomic_load(F.ctl + CW_GDN + 64 * (b * GLA_H + h), RLX_AGENT) < 2u && sp < (1u << 22)) { __builtin_amdgcn_s_sleep(8); ++sp; }
        __builtin_amdgcn_fence(__ATOMIC_ACQUIRE, "agent"); VM_WAIT(); }
    __syncthreads();
    const bf16* OF0 = (const bf16*)(F.ws + WS_OF); const bf16* OB0 = (const bf16*)(F.ws + WS_OF + 32 * MiB); const bf16* GR = (const bf16*)(F.ws + WS_GR); bf16* MIX = (bf16*)(F.ws + WS_MIX);
    float hg[16]; int eso = eseg; asm volatile("" : "+v"(eso));
#pragma unroll
    for (int e = 0; e < 16; ++e) hg[e] = F.gla_hg[16 * eso + e];
    const unsigned r0 = (unsigned)b * SEQ + (unsigned)part * 1024u + erow;
#pragma unroll 2
    for (int ps = 0; ps < 16; ++ps) { const unsigned row = r0 + ps * 64;
        const GAS v4u* fp = (const GAS v4u*)(OF0 + row * 512 + h * 128 + eseg * 16); const GAS v4u* bp = (const GAS v4u*)(OB0 + row * 512 + h * 128 + eseg * 16); const GAS v4u* rp = (const GAS v4u*)(GR + row * 512 + h * 128 + eseg * 16);
        const v4u f0 = __builtin_nontemporal_load(fp), f1 = __builtin_nontemporal_load(fp + 1), b0 = __builtin_nontemporal_load(bp), b1 = __builtin_nontemporal_load(bp + 1), r0v = __builtin_nontemporal_load(rp), r1v = __builtin_nontemporal_load(rp + 1);
        const unsigned fw[8] = {f0.x, f0.y, f0.z, f0.w, f1.x, f1.y, f1.z, f1.w}, bw[8] = {b0.x, b0.y, b0.z, b0.w, b1.x, b1.y, b1.z, b1.w}, rw[8] = {r0v.x, r0v.y, r0v.z, r0v.w, r1v.x, r1v.y, r1v.z, r1v.w};
        float o[16]; float ss = 0.f;
#pragma unroll
        for (int e2 = 0; e2 < 8; ++e2) { o[2 * e2] = bflo(fw[e2]) + bflo(bw[e2]); o[2 * e2 + 1] = bfhi(fw[e2]) + bfhi(bw[e2]); ss += o[2 * e2] * o[2 * e2] + o[2 * e2 + 1] * o[2 * e2 + 1]; }
        ss += __shfl_xor(ss, 1); ss += __shfl_xor(ss, 2); ss += __shfl_xor(ss, 4);
        const float rinv = __builtin_amdgcn_rsqf(ss * (1.f / 128.f) + EPS);
        unsigned ow[8];
#pragma unroll
        for (int e2 = 0; e2 < 8; ++e2) { const float x0 = bflo(rw[e2]), x1 = bfhi(rw[e2]);
            const float y0 = o[2 * e2] * rinv * hg[2 * e2] * (x0 * __builtin_amdgcn_rcpf(1.f + __expf(-x0))), y1 = o[2 * e2 + 1] * rinv * hg[2 * e2 + 1] * (x1 * __builtin_amdgcn_rcpf(1.f + __expf(-x1))); ow[e2] = cvtpk(y0, y1); }
        GAS v4u* mp = (GAS v4u*)(MIX + row * 1024 + h * 128 + eseg * 16);
        mp[0] = (v4u){ow[0], ow[1], ow[2], ow[3]}; mp[1] = (v4u){ow[4], ow[5], ow[6], ow[7]}; }
}
}
struct DenseMap { static constexpr bool GATHER = false;
    const bf16* A; const bf16* Bt; int K;
    __device__ __forceinline__ __amdgpu_buffer_rsrc_t a_rsrc() const { return __builtin_amdgcn_make_buffer_rsrc((void*)A, 0, 0x7fffffff, 0x00020000); }
    __device__ __forceinline__ __amdgpu_buffer_rsrc_t b_rsrc() const { return __builtin_amdgcn_make_buffer_rsrc((void*)Bt, 0, 0x7fffffff, 0x00020000); }
    __device__ __forceinline__ unsigned a_soff(const pg8::Unit& u) const { return (unsigned)u.pm * 256u * (unsigned)K * 2u; }
    __device__ __forceinline__ unsigned b_soff(const pg8::Unit& u) const { return (unsigned)u.pn * 256u * (unsigned)K * 2u; }
    __device__ __forceinline__ void a_off(const pg8::Unit&, const int (&R)[2], const int (&C)[2], unsigned (&vo)[2][2]) const {
#pragma unroll
        for (int h = 0; h < 2; ++h)
#pragma unroll
            for (int i = 0; i < 2; ++i) vo[h][i] = (unsigned)((h * 128 + R[i]) * K + C[i]) * 2u; }
};
struct MoeTabs { const LAS int* cnt; const LAS int* cst; const LAS unsigned short* te; };
struct MoeMapUp { static constexpr bool GATHER = true;
    const unsigned char* A; const unsigned char* Bt; const int* rowtok; MoeTabs tb;
    __device__ __forceinline__ __amdgpu_buffer_rsrc_t a_rsrc() const { return __builtin_amdgcn_make_buffer_rsrc((void*)A, 0, 0x7fffffff, 0x00020000); }
    __device__ __forceinline__ __amdgpu_buffer_rsrc_t b_rsrc() const { return __builtin_amdgcn_make_buffer_rsrc((void*)Bt, 0, 0x7fffffff, 0x00020000); }
    __device__ __forceinline__ unsigned a_soff(const pg8::Unit&) const { return 0u; }
    __device__ __forceinline__ unsigned b_soff(const pg8::Unit& u) const { const unsigned e = tb.te[u.pm]; return (e * 2048u + (unsigned)u.pn * 256u) * 1024u; }
    __device__ __forceinline__ void a_raw(const pg8::Unit& u, const int (&R)[2], unsigned (&raw)[2][2]) const {
        const int e = tb.te[u.pm], pos0 = (u.pm - tb.cst[e]) * 256, n = tb.cnt[e];
#pragma unroll
        for (int h = 0; h < 2; ++h)
#pragma unroll
            for (int i = 0; i < 2; ++i) { const int pos = pos0 + h * 128 + R[i]; raw[h][i] = (unsigned)rowtok[(size_t)e * EROWS + (pos < n ? pos : 0)]; } }
    __device__ __forceinline__ unsigned a_fin(unsigned tok, int C) const { return (tok * 512u + (unsigned)C) * 2u; }
    __device__ __forceinline__ void a_off(const pg8::Unit& u, const int (&R)[2], const int (&C)[2], unsigned (&vo)[2][2]) const {
        unsigned raw[2][2]; a_raw(u, R, raw);
#pragma unroll
        for (int h = 0; h < 2; ++h)
#pragma unroll
            for (int i = 0; i < 2; ++i) vo[h][i] = a_fin(raw[h][i], C[i]); }
};
struct MoeMapDown { static constexpr bool GATHER = false;
    const unsigned char* A; const unsigned char* Bt; MoeTabs tb;
    __device__ __forceinline__ __amdgpu_buffer_rsrc_t a_rsrc() const { return __builtin_amdgcn_make_buffer_rsrc((void*)A, 0, 0x7fffffff, 0x00020000); }
    __device__ __forceinline__ __amdgpu_buffer_rsrc_t b_rsrc() const { return __builtin_amdgcn_make_buffer_rsrc((void*)Bt, 0, 0x7fffffff, 0x00020000); }
    __device__ __forceinline__ unsigned a_soff(const pg8::Unit& u) const { return (unsigned)u.pm * 256u * 1024u; }
    __device__ __forceinline__ unsigned b_soff(const pg8::Unit& u) const { const unsigned e = tb.te[u.pm]; return (e * 1024u + (unsigned)u.pn * 256u) * 1024u; }
    __device__ __forceinline__ void a_off(const pg8::Unit&, const int (&R)[2], const int (&C)[2], unsigned (&vo)[2][2]) const {
#pragma unroll
        for (int h = 0; h < 2; ++h)
#pragma unroll
            for (int i = 0; i < 2; ++i) vo[h][i] = (unsigned)((h * 128 + R[i]) * 512 + C[i]) * 2u; }
};
using pg8::f32x4;
struct EpiInProj { static constexpr bool PERM = true, COLS64 = false;
    bf16 *gq, *gk, *gv, *gr, *aq, *ak, *av, *z;
    struct Pre {}; __device__ __forceinline__ void preload(const pg8::Unit&, int, int, int, int, Pre&) const {}
    __device__ __forceinline__ void operator()(const f32x4 (&acc)[2][2][4][2], const pg8::Unit& u, const Pre&, int wr, int wc, int fr, int fq) const {
        bf16* b0; bf16* b1; int ld;
        switch (u.pn) { case 0: b0 = gq; b1 = gq + 128; ld = 256; break; case 1: b0 = gk; b1 = gk + 128; ld = 256; break;
            case 2: b0 = gv; b1 = gv + 128; ld = 512; break; case 3: b0 = gv + 256; b1 = gv + 384; ld = 512; break;
            case 4: b0 = gr; b1 = gr + 128; ld = 512; break; case 5: b0 = gr + 256; b1 = gr + 384; ld = 512; break;
            case 6: b0 = aq; b1 = aq + 128; ld = 512; break; case 7: b0 = aq + 256; b1 = aq + 384; ld = 512; break;
            case 8: b0 = ak; b1 = av; ld = 128; break; default: b0 = z; b1 = z; ld = 32; break; }
        const bool zt = (u.pn == 9);
        if (zt && wc != 0) return;
        const int row0 = u.pm * 256 + wr * 64 + fr, cw = wc * 32 + 8 * fq;
#pragma unroll
        for (int ai = 0; ai < 2; ++ai)
#pragma unroll
            for (int m = 0; m < 4; ++m) { const size_t row = (size_t)(row0 + ai * 128 + m * 16);
#pragma unroll
                for (int bj = 0; bj < 2; ++bj) { if (zt && bj == 1) continue; const f32x4 v0 = acc[ai][bj][m][0], v1 = acc[ai][bj][m][1];
                    pg8::u32x4 wv; wv.x = pg8::cvt_pk_bf16(v0[0], v0[1]); wv.y = pg8::cvt_pk_bf16(v0[2], v0[3]); wv.z = pg8::cvt_pk_bf16(v1[0], v1[1]); wv.w = pg8::cvt_pk_bf16(v1[2], v1[3]);
                    *(pg8::u32x4*)((bj ? b1 : b0) + row * ld + cw) = wv; } }
    }
};
struct EpiResF32 { static constexpr bool PERM = false, COLS64 = false;
    const float* base; bf16* out;
    struct Pre {}; __device__ __forceinline__ void preload(const pg8::Unit&, int, int, int, int, Pre&) const {}
    __device__ __forceinline__ void operator()(const f32x4 (&acc)[2][2][4][2], const pg8::Unit& u, const Pre&, int wr, int wc, int fr, int fq) const {
        const int col0 = u.pn * 256 + wc * 32 + 4 * fq;
#pragma unroll
        for (int ai = 0; ai < 2; ++ai)
#pragma unroll
            for (int m = 0; m < 4; ++m) { const size_t off = (size_t)(u.pm * 256 + ai * 128 + wr * 64 + m * 16 + fr) * 1024 + col0;
#pragma unroll
                for (int bj = 0; bj < 2; ++bj)
#pragma unroll
                    for (int n = 0; n < 2; ++n) { const f32x4 bs = *(const f32x4*)(base + off + bj * 128 + n * 16); const f32x4 hv = bs + acc[ai][bj][m][n]; *(v2u*)(out + off + bj * 128 + n * 16) = (v2u){pk2(hv.x, hv.y), pk2(hv.z, hv.w)}; } }
    }
};
struct EpiSwiglu { static constexpr bool PERM = true, COLS64 = false;
    const float* b1; unsigned char* act; MoeTabs tb;
    struct Pre { f32x4 g0, g1, l0, l1; };
    __device__ __forceinline__ void preload(const pg8::Unit& u, int wr, int wc, int fr, int fq, Pre& p) const {
        const int e = tb.te[u.pm]; const int col = u.pn * 128 + wc * 32 + 8 * fq; const float* bg = b1 + (size_t)e * 2048 + col; const float* bl = bg + 1024;
        p.g0 = *(const GAS f32x4*)bg; p.g1 = *(const GAS f32x4*)(bg + 4); p.l0 = *(const GAS f32x4*)bl; p.l1 = *(const GAS f32x4*)(bl + 4); }
    __device__ __forceinline__ void operator()(const f32x4 (&acc)[2][2][4][2], const pg8::Unit& u, const Pre& p, int wr, int wc, int fr, int fq) const {
        const int col = u.pn * 128 + wc * 32 + 8 * fq;
        const f32x4 g0 = p.g0, g1 = p.g1, l0 = p.l0, l1 = p.l1;
        const int row0 = u.pm * 256 + wr * 64 + fr;
        const bool odd = (fq & 1) != 0;
        unsigned char* dstb = act + (size_t)(row0 + (odd ? 16 : 0)) * 1024 + (odd ? col - 8 : col);
#pragma unroll
        for (int ai = 0; ai < 2; ++ai)
#pragma unroll
            for (int mp = 0; mp < 2; ++mp) { unsigned wd[2][2];
#pragma unroll
                for (int q = 0; q < 2; ++q) { const int m = 2 * mp + q; float o[8];
#pragma unroll
                    for (int n = 0; n < 2; ++n)
#pragma unroll
                        for (int j = 0; j < 4; ++j) { const float gl = fminf(__builtin_fmaf(acc[ai][0][m][n][j], 1.f / WSCALE, (n ? g1[j] : g0[j])), 7.f); const float li = __builtin_amdgcn_fmed3f(__builtin_fmaf(acc[ai][1][m][n][j], 1.f / WSCALE, (n ? l1[j] : l0[j])), -7.f, 7.f);
                            o[4 * n + j] = (gl * ASCALE) * __builtin_amdgcn_rcpf(1.f + __builtin_amdgcn_exp2f(gl * (-1.702f * 1.4426950408889634f))) * (li + 1.f); }
                    int w0 = 0, w1 = 0;
                    w0 = __builtin_amdgcn_cvt_pk_fp8_f32(o[0], o[1], w0, false); w0 = __builtin_amdgcn_cvt_pk_fp8_f32(o[2], o[3], w0, true); w1 = __builtin_amdgcn_cvt_pk_fp8_f32(o[4], o[5], w1, false); w1 = __builtin_amdgcn_cvt_pk_fp8_f32(o[6], o[7], w1, true);
                    wd[q][0] = (unsigned)w0; wd[q][1] = (unsigned)w1; }
                auto x0 = __builtin_amdgcn_permlane16_swap(wd[0][0], wd[1][0], false, false); auto x1 = __builtin_amdgcn_permlane16_swap(wd[0][1], wd[1][1], false, false);
                *(pg8::u32x4*)(dstb + (size_t)(ai * 128 + mp * 32) * 1024) = (pg8::u32x4){x0[0], x1[0], x0[1], x1[1]}; }
    }
};
struct EpiDown { static constexpr bool PERM = true, COLS64 = true;
    const float* b2; const float* rowgate; unsigned char* y; MoeTabs tb;
    struct Pre { f32x4 bv[2][2]; float gt[8]; };
    __device__ __forceinline__ void preload(const pg8::Unit& u, int wr, int wc, int fr, int fq, Pre& p) const {
        const int e = tb.te[u.pm], pos0 = (u.pm - tb.cst[e]) * 256, n_e = tb.cnt[e];
        const float* bb = b2 + (size_t)e * 1024 + u.pn * 256 + wc * 64 + 8 * fq;
#pragma unroll
        for (int bj = 0; bj < 2; ++bj)
#pragma unroll
            for (int n = 0; n < 2; ++n) p.bv[bj][n] = *(const GAS f32x4*)(bb + bj * 32 + 4 * n);
#pragma unroll
        for (int ai = 0; ai < 2; ++ai)
#pragma unroll
            for (int m = 0; m < 4; ++m) { const int pos = pos0 + wr * 64 + fr + ai * 128 + m * 16; const int pc_ = pos < n_e ? pos : 0; const float g = rowgate[(size_t)e * EROWS + pc_]; p.gt[ai * 4 + m] = (pos < n_e) ? g * YSCALE : 0.f; }
    }
    __device__ __forceinline__ void operator()(const f32x4 (&acc)[2][2][4][2], const pg8::Unit& u, const Pre& p, int wr, int wc, int fr, int fq) const {
        const bool odd = (fq & 1) != 0;
        const int colb = u.pn * 256 + wc * 64 + (odd ? 32 + 8 * (fq - 1) : 8 * fq), rl0 = wr * 64 + fr;
#pragma unroll
        for (int ai = 0; ai < 2; ++ai)
#pragma unroll
            for (int m = 0; m < 4; ++m) { const int rl = rl0 + ai * 128 + m * 16; const float gt = p.gt[ai * 4 + m];
                unsigned w[2][2];
#pragma unroll
                for (int bj = 0; bj < 2; ++bj) { const f32x4 v0 = (acc[ai][bj][m][0] * (1.f / (WSCALE * ASCALE)) + p.bv[bj][0]) * gt, v1 = (acc[ai][bj][m][1] * (1.f / (WSCALE * ASCALE)) + p.bv[bj][1]) * gt;
                    int w0 = 0, w1 = 0;
                    w0 = __builtin_amdgcn_cvt_pk_fp8_f32(v0[0], v0[1], w0, false); w0 = __builtin_amdgcn_cvt_pk_fp8_f32(v0[2], v0[3], w0, true); w1 = __builtin_amdgcn_cvt_pk_fp8_f32(v1[0], v1[1], w1, false); w1 = __builtin_amdgcn_cvt_pk_fp8_f32(v1[2], v1[3], w1, true);
                    w[bj][0] = (unsigned)w0; w[bj][1] = (unsigned)w1; }
                auto x0 = __builtin_amdgcn_permlane16_swap(w[0][0], w[1][0], false, false); auto x1 = __builtin_amdgcn_permlane16_swap(w[0][1], w[1][1], false, false);
                const pg8::u32x4 ov = (pg8::u32x4){x0[0], x1[0], x0[1], x1[1]};
                *(pg8::u32x4*)(y + (size_t)(u.pm * 256 + rl) * 1024 + colb) = ov; }
    }
};
__device__ __forceinline__ int moe_tables(Frame& F) {
    LAS int* cnt = (LAS int*)(F.lds + LC_CNT); LAS int* cst = (LAS int*)(F.lds + LC_CST); LAS unsigned short* te = (LAS unsigned short*)(F.lds + LC_TE);
    __syncthreads();
    if (F.tid < NEXP) cnt[F.tid] = (int)__hip_atomic_load(F.ctl + CW_CNT + 64 * F.tid, RLX_AGENT);
    __syncthreads();
    if (F.tid == 0) { int s = 0; for (int e = 0; e < NEXP; ++e) { cst[e] = s; s += (cnt[e] + 255) >> 8; } cst[NEXP] = s; }
    __syncthreads();
    const int nt = cst[NEXP];
    for (int t = F.tid; t < nt; t += NWAVES * 64) { int e = 0;
#pragma unroll 1
        for (int k = 1; k < NEXP; ++k) e = (t >= cst[k]) ? k : e;
        te[t] = (unsigned short)e; }
    __syncthreads();
    return nt;
}
__device__ __forceinline__ void p3_mixers(Frame& F) {
    for (int u = blockIdx.x; u < 2 * BATCH * GLA_H; u += F.G) gla::gla_unit(F, u & 7, (u >> 3) & 3, u >> 5);
    if (blockIdx.x < 2 * BATCH * GLA_H) { while (conv_pull(F)) {} }
    const attn_body::bf16* Q = (const attn_body::bf16*)(F.ws + WS_AQ); const attn_body::bf16* K = (const attn_body::bf16*)(F.ws + WS_AK); const attn_body::bf16* V = (const attn_body::bf16*)(F.ws + WS_AV);
    attn_body::bf16* O = (attn_body::bf16*)(F.ws + WS_MIX);
    const int x0 = blockIdx.x & 7;
    float sbound;
    { float mq = fabsf(F.q_g[F.lane]), mk = fabsf(F.k_g[F.lane]);
#pragma unroll
      for (int o_ = 1; o_ < 64; o_ <<= 1) { mq = fmaxf(mq, __shfl_xor(mq, o_)); mk = fmaxf(mk, __shfl_xor(mk, o_)); }
      sbound = __builtin_bit_cast(float, __builtin_amdgcn_readfirstlane(__builtin_bit_cast(int, 64.f * attn_body::C2 * mq * mk * 1.02f))); }
    for (int qi = 0; qi < 8; ++qi) { const int x = (x0 + qi) & 7;
        for (;;) {
            __syncthreads();
            if (F.tid == 0) F.MISC[16] = __hip_atomic_fetch_add(F.ctl + CW_QUE + 64 * x, 1u, RLX_AGENT);
            __syncthreads();
            const int item = __builtin_amdgcn_readfirstlane((int)F.MISC[16]);
            if (item >= ATT_H * attn_body::NQB + 4 * GLA_H) break;
            if (item >= ATT_H * attn_body::NQB) { const int k = item - ATT_H * attn_body::NQB; gla::gla_combine(F, x, k >> 2, k & 3); continue; }
            attn_body::attn_unit<8>(x, item >> 4, item & 15, Q, K, V, O, (char*)F.lds, F.q_g, sbound);
        }
    }
    while (conv_pull(F)) {}
    __syncthreads();
}

__device__ __forceinline__ void p5_route(Frame& F) {
    typedef float f32x16 __attribute__((ext_vector_type(16)));
    LAS unsigned char* L = F.lds;
    constexpr int XP = 2064, L_XH = 0, L_XL = 32 * XP, L_PART = 0;
    const int tid = F.tid, lane = F.lane, w = F.wave, r32 = lane & 31, hi = lane >> 5;
    const bf16* WRH = (const bf16*)(F.ws + WS_WRH); const bf16* WRL = (const bf16*)(F.ws + WS_WRL);
    unsigned char* XN8 = F.ws + WS_XN;
    int* ROWTOK = (int*)(F.ws + WS_ROWTOK); float* ROWGATE = (float*)(F.ws + WS_ROWGATE); int* TOKASG = (int*)(F.ws + WS_TOKASG);
    gu32* CNT = F.ctl + CW_CNT;
    bf16x8 wh[8], wl[8];
#pragma unroll
    for (int ks = 0; ks < 8; ++ks) { const int k0 = 128 * w + 16 * ks + 8 * hi; wh[ks] = *(const GAS bf16x8*)(WRH + r32 * 1024 + k0); wl[ks] = *(const GAS bf16x8*)(WRL + r32 * 1024 + k0); }
    f32x4 g2[4];
#pragma unroll
    for (int j = 0; j < 4; ++j) g2[j] = *((const GAS f32x4*)F.ffn_g + lane + 64 * j);
    float brt[16];
#pragma unroll
    for (int r = 0; r < 16; ++r) brt[r] = F.b_router[(r & 3) + 8 * (r >> 2) + 4 * hi];
    LAS int* hist = (LAS int*)(L + LC_HIST); LAS int* basev = (LAS int*)(L + LC_BASE); LAS int* aep = (LAS int*)(L + LC_ASG); LAS float* agt = (LAS float*)(L + LC_ASG + 4096);
    constexpr int NGRP = T / 32;
    const int per = (NGRP + F.G - 1) / F.G, g0 = F.vcu * per, g1 = (g0 + per < NGRP) ? g0 + per : NGRP;
    for (int gb = g0; gb < g1; gb += 8) {
        const int nb = (g1 - gb < 8) ? g1 - gb : 8;
        __syncthreads();
        if (tid < NEXP) hist[tid] = 0;
        v2u hv[4][4];
#define P5_LOADG(g) do { _Pragma("unroll") for (int rr = 0; rr < 4; ++rr) { const GAS v2u* hp = (const GAS v2u*)((const bf16*)(F.ws + WS_H16) + (size_t)(32 * (g) + 4 * w + rr) * 1024) + lane; \
            _Pragma("unroll") for (int j = 0; j < 4; ++j) hv[rr][j] = __builtin_nontemporal_load(hp + 64 * j); } } while (0)
#define P5_BAR() asm volatile("s_waitcnt lgkmcnt(0)\n\ts_barrier" ::: "memory")
        P5_LOADG(gb);
        for (int bi = 0; bi < nb; ++bi) {
            const int t0 = 32 * (gb + bi);
#pragma unroll
            for (int rr = 0; rr < 4; ++rr) { const int r = 4 * w + rr; const size_t tok = (size_t)(t0 + r);
                f32x4 v[4]; float s = 0.f;
#pragma unroll
                for (int j = 0; j < 4; ++j) { v[j] = (f32x4){bflo(hv[rr][j].x), bfhi(hv[rr][j].x), bflo(hv[rr][j].y), bfhi(hv[rr][j].y)}; s += (v[j].x * v[j].x + v[j].y * v[j].y) + (v[j].z * v[j].z + v[j].w * v[j].w); }
                const float rinv = 1.f / sqrtf(wave_sum(s) * (1.f / 1024.f) + EPS);
                GAS unsigned* o4 = (GAS unsigned*)(XN8 + tok * 1024) + lane;
#pragma unroll
                for (int j = 0; j < 4; ++j) { const f32x4 xn = v[j] * rinv * g2[j];
                    const v2u hw = (v2u){pk2(xn.x, xn.y), pk2(xn.z, xn.w)};
                    const v2u lw = (v2u){pk2(xn.x - bflo(hw.x), xn.y - bfhi(hw.x)), pk2(xn.z - bflo(hw.y), xn.w - bfhi(hw.y))};
                    { int q8 = 0; q8 = __builtin_amdgcn_cvt_pk_fp8_f32(xn.x, xn.y, q8, false); q8 = __builtin_amdgcn_cvt_pk_fp8_f32(xn.z, xn.w, q8, true); o4[64 * j] = (unsigned)q8; }
                    *(LAS v2u*)(L + L_XH + r * XP + (4 * lane + 256 * j) * 2) = hw; *(LAS v2u*)(L + L_XL + r * XP + (4 * lane + 256 * j) * 2) = lw; } }
            if (bi + 1 < nb) P5_LOADG(gb + bi + 1);
            P5_BAR();
            f32x16 acc = {};
#pragma unroll
            for (int ks = 0; ks < 8; ++ks) { const int k0 = 128 * w + 16 * ks + 8 * hi;
                const bf16x8 xh = *(const LAS bf16x8*)(L + L_XH + r32 * XP + k0 * 2), xl = *(const LAS bf16x8*)(L + L_XL + r32 * XP + k0 * 2);
                acc = __builtin_amdgcn_mfma_f32_32x32x16_bf16(wh[ks], xh, acc, 0, 0, 0); acc = __builtin_amdgcn_mfma_f32_32x32x16_bf16(wh[ks], xl, acc, 0, 0, 0); acc = __builtin_amdgcn_mfma_f32_32x32x16_bf16(wl[ks], xh, acc, 0, 0, 0); }
            P5_BAR();
#pragma unroll
            for (int r = 0; r < 16; ++r) { const int e = (r & 3) + 8 * (r >> 2) + 4 * hi; ((LAS float*)(L + L_PART))[(w * 32 + e) * 32 + r32] = acc[r]; }
            P5_BAR();
            if (w == 0) {
                float v[16];
#pragma unroll
                for (int r = 0; r < 16; ++r) { const int e = (r & 3) + 8 * (r >> 2) + 4 * hi; float s = brt[r];
#pragma unroll
                    for (int ww = 0; ww < 8; ++ww) s += ((const LAS float*)(L + L_PART))[(ww * 32 + e) * 32 + r32];
                    v[r] = s; }
                float cv[8]; int cidx[8];
#pragma unroll
                for (int s = 0; s < 4; ++s) { float m = -INFINITY; int mr = 0;
#pragma unroll
                    for (int r = 0; r < 16; ++r) { if (v[r] > m) { m = v[r]; mr = r; } }
                    cv[s] = m; cidx[s] = (mr & 3) + 8 * (mr >> 2) + 4 * hi;
#pragma unroll
                    for (int r = 0; r < 16; ++r) v[r] = (r == mr) ? -INFINITY : v[r]; }
#pragma unroll
                for (int s = 0; s < 4; ++s) { cv[4 + s] = __shfl_xor(cv[s], 32); cidx[4 + s] = __shfl_xor(cidx[s], 32); }
                float tv[4]; int ti[4];
#pragma unroll
                for (int s = 0; s < 4; ++s) { float m = -INFINITY; int mi = 1 << 20; int mc = 0;
#pragma unroll
                    for (int c = 0; c < 8; ++c) { const bool better = (cv[c] > m) || (cv[c] == m && cidx[c] < mi); if (better) { m = cv[c]; mi = cidx[c]; mc = c; } }
                    tv[s] = m; ti[s] = mi;
#pragma unroll
                    for (int c = 0; c < 8; ++c) cv[c] = (c == mc) ? -INFINITY : cv[c]; }
                const float e1 = __expf(tv[1] - tv[0]), e2 = __expf(tv[2] - tv[0]), e3 = __expf(tv[3] - tv[0]); const float inv = 1.f / (1.f + e1 + e2 + e3);
                const float gt[4] = {inv, e1 * inv, e2 * inv, e3 * inv};
                if (hi == 0) {
#pragma unroll
                    for (int s = 0; s < 4; ++s) { const int rank = (int)__hip_atomic_fetch_add(hist + ti[s], 1, __ATOMIC_RELAXED, __HIP_MEMORY_SCOPE_WORKGROUP); const int idx = (bi * 32 + r32) * 4 + s; aep[idx] = (ti[s] << 16) | rank; agt[idx] = gt[s]; } }
            }
            P5_BAR();
        }
#undef P5_LOADG
#undef P5_BAR
        if (tid < NEXP) { const int hc = hist[tid]; basev[tid] = hc ? (int)__hip_atomic_fetch_add(CNT + 64 * tid, (unsigned)hc, RLX_AGENT) : 0; }
        __syncthreads();
        for (int idx = tid; idx < nb * 128; idx += NWAVES * 64) { const int ep = aep[idx], e = ep >> 16, pos = basev[e] + (ep & 0xffff); const int tok = 32 * gb + (idx >> 2), s = idx & 3;
            ROWTOK[(size_t)e * EROWS + pos] = tok; ROWGATE[(size_t)e * EROWS + pos] = agt[idx]; TOKASG[tok * 4 + s] = e * EROWS + pos; }
    }
    __syncthreads();
}

__device__ __forceinline__ void p8_combine(Frame& F) {
    const LAS int* cst = (const LAS int*)(F.lds + LC_CST);
    const int gw = F.vcu * NWAVES + F.wave, NGW = F.G * NWAVES, lane = F.lane;
    const int* TOKASG = (const int*)(F.ws + WS_TOKASG); const unsigned char* Y = F.ws + WS_Y;
    f32x4 fg[4];
#pragma unroll
    for (int j = 0; j < 4; ++j) fg[j] = *((const GAS f32x4*)F.fin_g + lane + 64 * j);
    for (int tok = gw; tok < T; tok += NGW) {
        const int a = TOKASG[tok * 4 + (lane & 3)];
        const int crow = cst[a >> 15] * 256 + (a & (EROWS - 1));
        GAS f32x4* hp = (GAS f32x4*)(F.out + (size_t)tok * 1024) + lane; f32x4 v[4];
        const GAS v2u* hb = (const GAS v2u*)((const bf16*)(F.ws + WS_H16) + (size_t)tok * 1024) + lane;
#pragma unroll
        for (int j = 0; j < 4; ++j) { const v2u hw = __builtin_nontemporal_load(hb + 64 * j); v[j] = (f32x4){bflo(hw.x), bfhi(hw.x), bflo(hw.y), bfhi(hw.y)}; }
#pragma unroll
        for (int s = 0; s < 4; ++s) { const int cr = __shfl(crow, s); const GAS unsigned* yp = (const GAS unsigned*)(Y + (size_t)cr * 1024) + lane;
#pragma unroll
            for (int j = 0; j < 4; ++j) { const unsigned yw = __builtin_nontemporal_load(yp + 64 * j); const auto lo = __builtin_amdgcn_cvt_pk_f32_fp8((int)yw, false), hi = __builtin_amdgcn_cvt_pk_f32_fp8((int)yw, true);
                v[j].x += lo[0] * (1.f / YSCALE); v[j].y += lo[1] * (1.f / YSCALE); v[j].z += hi[0] * (1.f / YSCALE); v[j].w += hi[1] * (1.f / YSCALE); } }
        float ss = 0.f;
#pragma unroll
        for (int j = 0; j < 4; ++j) ss += (v[j].x * v[j].x + v[j].y * v[j].y) + (v[j].z * v[j].z + v[j].w * v[j].w);
        const float rinv = 1.f / sqrtf(wave_sum(ss) * (1.f / 1024.f) + EPS);
#pragma unroll
        for (int j = 0; j < 4; ++j) __builtin_nontemporal_store(v[j] * rinv * fg[j], hp + 64 * j);
    }
}
#ifndef MK_N_LAUNCHES
#define MK_N_LAUNCHES 1
#endif
constexpr int N_PHASES = 9;
constexpr int N_LAUNCHES = MK_N_LAUNCHES;
struct Args { const float* in[19]; float* out; unsigned char* ws; int ph_lo, ph_hi; };
__global__ void __launch_bounds__(NWAVES * 64, 2) enc_fwd(Args args) {
    extern __shared__ __attribute__((aligned(16))) unsigned char lds[];
    Frame F;
    F.lds = (LAS unsigned char*)lds;
    F.MISC = (volatile LAS unsigned*)(F.lds + LC_MISC);
    F.tid = threadIdx.x; F.lane = F.tid & 63; F.wave = __builtin_amdgcn_readfirstlane(F.tid >> 6);
    F.G = gridDim.x; { const int bx = blockIdx.x; F.vcu = (F.G % 8 == 0) ? (bx % 8) * (F.G / 8) + bx / 8 : bx; }
    F.ws = args.ws; F.ctl = (gu32*)(args.ws + WS_CTL);
    F.x = args.in[0]; F.mix_g = args.in[1]; F.w_in = args.in[2]; F.w_gf = args.in[3]; F.b_gf = args.in[4]; F.w_gb = args.in[5]; F.b_gb = args.in[6]; F.gla_hg = args.in[7];
    F.q_g = args.in[8]; F.k_g = args.in[9]; F.w_out = args.in[10]; F.ffn_g = args.in[11]; F.w_router = args.in[12]; F.b_router = args.in[13];
    F.w1 = args.in[14]; F.b1 = args.in[15]; F.w2 = args.in[16]; F.b2 = args.in[17]; F.fin_g = args.in[18]; F.out = args.out;
    for (int u = F.tid; u < (LDS_BYTES - LC_OFF) / 4; u += NWAVES * 64) ((LAS unsigned*)(F.lds + LC_OFF))[u] = 0u;
    __syncthreads();
    XcdBarrier bar; bar.bar = (unsigned*)(F.ctl + CW_BAR); bar.x = 0; bar.st = nullptr;
    if (N_LAUNCHES == 1) bar = xcd_barrier_post((unsigned*)(F.ctl + CW_BAR), F.MISC + 8);
    const int lo = args.ph_lo, hi = args.ph_hi;
#define IN(k) (lo <= (k) && (k) < hi)
#define SEAM(k) do { if (IN(k) && IN((k) + 1)) xcd_barrier(bar); } while (0)
    MoeTabs tb{(const LAS int*)(F.lds + LC_CNT), (const LAS int*)(F.lds + LC_CST), (const LAS unsigned short*)(F.lds + LC_TE)};

    if (IN(0)) { p0_prologue(F); } SEAM(0);
    if (IN(1)) {
        DenseMap mp{(const bf16*)(F.ws + WS_XN), (const bf16*)(F.ws + WS_WIN), 1024};
        pg8::StaticOrder S; S.init(T / 256, D_IN_PAD / 256, F.G, (int)blockIdx.x);
        EpiInProj E{(bf16*)(F.ws + WS_GQ), (bf16*)(F.ws + WS_GK), (bf16*)(F.ws + WS_GV), (bf16*)(F.ws + WS_GR), (bf16*)(F.ws + WS_AQ), (bf16*)(F.ws + WS_AK), (bf16*)(F.ws + WS_AV), (bf16*)(F.ws + WS_Z)};
        pg8::gemm_phase<EpiInProj, pg8::StaticOrder, DenseMap, true>(F.lds, 1024, S, mp, E);
    } SEAM(1);
    if (IN(2)) { p2_normrope(F); for (int u = F.vcu; u < BATCH * 64; u += F.G) gla::gla_prep_unit(F, u >> 6, u & 63); } SEAM(2);
    if (IN(3)) { p3_mixers(F); } SEAM(3);
    if (IN(4)) {
        DenseMap mp{(const bf16*)(F.ws + WS_MIX), (const bf16*)(F.ws + WS_WOUT), 1024};
        pg8::StaticOrder S; S.init(T / 256, DM / 256, F.G, (int)blockIdx.x);
        EpiResF32 E{F.x, (bf16*)(F.ws + WS_H16)};
        pg8::gemm_phase<EpiResF32, pg8::StaticOrder, DenseMap, true>(F.lds, 1024, S, mp, E);
    } SEAM(4);
    if (IN(5)) { p5_route(F); } SEAM(5);
    if (IN(6)) {
        const int ntl = moe_tables(F);
        MoeMapUp mp{F.ws + WS_XN, F.ws + WS_W1, (const int*)(F.ws + WS_ROWTOK), tb};
        pg8::StaticOrder S; S.init(ntl, 8, F.G, (int)blockIdx.x);
        EpiSwiglu E{F.b1, F.ws + WS_ACT, tb};
        pg8::gemm_phase<EpiSwiglu, pg8::StaticOrder, MoeMapUp, true, true>(F.lds, 512, S, mp, E);
    } SEAM(6);
    if (IN(7)) {
        const int ntl = moe_tables(F);
        MoeMapDown mp{F.ws + WS_ACT, F.ws + WS_W2, tb};
        pg8::StaticOrder S; S.init(ntl, 4, F.G, (int)blockIdx.x);
        EpiDown E{F.b2, (const float*)(F.ws + WS_ROWGATE), F.ws + WS_Y, tb};
        pg8::gemm_phase<EpiDown, pg8::StaticOrder, MoeMapDown, true, true>(F.lds, 512, S, mp, E);
    } SEAM(7);
    if (IN(8)) { (void)moe_tables(F); p8_combine(F); }
#undef IN
#undef SEAM
}

extern "C" void kernel_launch(void* const* d_in, const int* in_sizes, int n_in, void* d_out, int out_size, void* d_ws, size_t ws_size, hipStream_t stream) {
    static int grid = 0;
    if (grid == 0) {
        if (n_in != 19 || in_sizes[0] != T * DM || out_size != T * DM || ws_size < WS_END) { fprintf(stderr, "kernel_launch: unexpected shapes (n_in %d, in0 %d, out %d, ws %zu); nothing launched\n", n_in, n_in > 0 ? in_sizes[0] : -1, out_size, ws_size); grid = -1; return; }
        int dev = 0, cus = 0, per_cu = 0;
        if (hipGetDevice(&dev) != hipSuccess || hipDeviceGetAttribute(&cus, hipDeviceAttributeMultiprocessorCount, dev) != hipSuccess) { grid = -1; return; }
        if (hipFuncSetAttribute((const void*)enc_fwd, hipFuncAttributeMaxDynamicSharedMemorySize, LDS_BYTES) != hipSuccess) { fprintf(stderr, "kernel_launch: hipFuncSetAttribute failed\n"); grid = -1; return; }
        if (hipOccupancyMaxActiveBlocksPerMultiprocessor(&per_cu, (const void*)enc_fwd, NWAVES * 64, LDS_BYTES) != hipSuccess || per_cu < 1) { fprintf(stderr, "kernel_launch: occupancy query says %d\n", per_cu); }
        (void)hipGetLastError();
        grid = cus;
    }
    if (grid < 0) return;
    if (hipMemsetAsync((char*)d_ws + WS_CTL, 0, CTL_ZERO_BYTES, stream) != hipSuccess) return;
    Args a{};
    for (int i = 0; i < 19; ++i) a.in[i] = (const float*)d_in[i];
    a.out = (float*)d_out; a.ws = (unsigned char*)d_ws;
    if (N_LAUNCHES == 1) { a.ph_lo = 0; a.ph_hi = N_PHASES; hipLaunchKernelGGL(enc_fwd, dim3(grid), dim3(NWAVES * 64), LDS_BYTES, stream, a); }
    else for (int p = 0; p < N_PHASES; ++p) { a.ph_lo = p; a.ph_hi = p + 1; hipLaunchKernelGGL(enc_fwd, dim3(grid), dim3(NWAVES * 64), LDS_BYTES, stream, a); }
}
```

```cpp
#include <hip/hip_runtime.h>
#include <hip/hip_bf16.h>
#include <cstdio>
#include <cstdint>
#include <cmath>

#define LAS __attribute__((address_space(3)))
#define GAS __attribute__((address_space(1)))

namespace pg8 {
typedef unsigned short bf16_t;
typedef short bf16x8 __attribute__((ext_vector_type(8)));
typedef float f32x4 __attribute__((ext_vector_type(4)));
typedef float f32x2 __attribute__((ext_vector_type(2)));
typedef unsigned u32x4 __attribute__((ext_vector_type(4)));
typedef int v4i_t __attribute__((ext_vector_type(4)));
typedef int v8i_t __attribute__((ext_vector_type(8)));
constexpr int BM = 256, BK = 64, HALF = 128, HTB = HALF * BK * 2, STAGE_BYTES = 8 * HTB, NXCD = 8, WGM = 4;

__host__ __device__ __forceinline__ int lds_byte(int r, int c) { const int st = (r >> 4) * 2 + (c >> 5), rr = r & 15, cc = c & 31, ob = rr * 64 + cc * 2; return st * 1024 + (ob ^ (((ob >> 9) & 1) << 5)); }
__host__ __device__ __forceinline__ void stage_rc(int b, int& R, int& C) { const int st = b / 1024, sb = b % 1024, swz = sb ^ (((sb >> 9) & 1) << 5); R = (st >> 1) * 16 + swz / 64; C = (st & 1) * 32 + (swz % 64) / 2; }
__host__ __device__ __forceinline__ int perm32(int rho) { const int n = rho >> 4, i = rho & 15; return 8 * (i >> 2) + 4 * n + (i & 3); }

struct Unit { int pm, pn; };

struct StaticOrder {
    int nM, nN, nwg, G, c;
    __device__ __forceinline__ void init(int nM_, int nN_, int G_, int c_) { nM = nM_; nN = nN_; nwg = nM * nN; G = G_; c = c_; }
    __device__ __forceinline__ bool next(int i, Unit& u) const {
        const long L = (long)i * G + c; if (L >= nwg) return false;
        int wgid = (int)L; { const int q = nwg / NXCD, r = nwg % NXCD, xcd = wgid % NXCD, off = wgid / NXCD; wgid = (xcd < r ? xcd * (q + 1) : r * (q + 1) + (xcd - r) * q) + off; }
        const int nig = WGM * nN, gid = wgid / nig, fm = gid * WGM, gsz = (nM - fm) < WGM ? (nM - fm) : WGM;
        u.pm = fm + ((wgid % nig) % gsz); u.pn = (wgid % nig) / gsz; return true;
    }
};

__device__ __forceinline__ unsigned cvt_pk_bf16(float lo, float hi) { unsigned r; asm volatile("v_cvt_pk_bf16_f32 %0, %1, %2" : "=v"(r) : "v"(lo), "v"(hi)); return r; }

template <class Epi, class Sched, class Map, bool ALIGN_EPI, bool FP8 = false>
__device__ __forceinline__ void gemm_phase(LAS unsigned char* lds, const int K, const Sched& S, const Map& MP, const Epi& E) {
    int tid_ = threadIdx.x; asm volatile("" : "+v"(tid_));
    const int tid = tid_, wid = __builtin_amdgcn_readfirstlane(tid >> 6), lane = tid & 63, wr = wid >> 2, wc = wid & 3, fr = lane & 15, fq = lane >> 4;
    const int nt = K / BK;
    int Rr[2], Cc[2]; unsigned voffB[2];
#pragma unroll
    for (int i = 0; i < 2; ++i) { int R, C; stage_rc(tid * 16 + i * 8192, R, C); Rr[i] = R; Cc[i] = C; const int Rb = Epi::COLS64 ? (64 * (R >> 5) + perm32(R & 31)) : (Epi::PERM ? ((R & ~31) + perm32(R & 31)) : R); voffB[i] = (unsigned)(Rb * K + C) * 2u; }
    const unsigned kstep = (unsigned)(BK * 2);
    const unsigned hstep = (unsigned)HALF * K * 2;
    const unsigned hstepB = Epi::COLS64 ? 32u * (unsigned)K * 2u : hstep;
    const __amdgpu_buffer_rsrc_t RA = MP.a_rsrc(), RB = MP.b_rsrc();
    const unsigned ldsw = (unsigned)wid * 1024u;
    const int aoff = lds_byte(wr * 64 + fr, fq * 8), boff = lds_byte(wc * 32 + fr, fq * 8);
#define PG8_SA(b, h) (((b) * 2 + (h)) * HTB)
#define PG8_SB(b, h) ((4 + (b) * 2 + (h)) * HTB)
#define PG8_STAGE(bufoff, rsrc, soff, voff) do { _Pragma("unroll") for (int _i = 0; _i < 2; ++_i) \
        __builtin_amdgcn_raw_ptr_buffer_load_lds(rsrc, (LAS unsigned*)(lds + (bufoff) + ldsw + _i * 8192), 16, (int)(voff)[_i], (int)(soff), 0, 0); } while (0)
#define PG8_LD8(p) __builtin_shufflevector(*(const LAS v4i_t*)(p), *(const LAS v4i_t*)((p) + 1024), 0, 1, 2, 3, 4, 5, 6, 7)
#define PG8_LDA(dst, b, h) do { _Pragma("unroll") for (int m = 0; m < 4; ++m) dst[m] = PG8_LD8(lds + PG8_SA(b, h) + aoff + m * 2048); } while (0)
#define PG8_LDB(dst, b, h) do { _Pragma("unroll") for (int n = 0; n < 2; ++n) dst[n] = PG8_LD8(lds + PG8_SB(b, h) + boff + n * 2048); } while (0)
#define PG8_HALF(x, k) __builtin_bit_cast(bf16x8, __builtin_shufflevector(x, x, 4 * (k), 4 * (k) + 1, 4 * (k) + 2, 4 * (k) + 3))
#define PG8_MMA(ai, bj, At, Bt) do { __builtin_amdgcn_s_setprio(1); _Pragma("unroll") for (int m = 0; m < 4; ++m) _Pragma("unroll") for (int n = 0; n < 2; ++n) { \
        if constexpr (FP8) { acc[ai][bj][m][n] = __builtin_amdgcn_mfma_scale_f32_16x16x128_f8f6f4(Bt[n], At[m], acc[ai][bj][m][n], 0, 0, 0, 0x7f7f7f7f, 0, 0x7f7f7f7f); } \
        else { acc[ai][bj][m][n] = __builtin_amdgcn_mfma_f32_16x16x32_bf16(PG8_HALF(Bt[n], 0), PG8_HALF(At[m], 0), acc[ai][bj][m][n], 0, 0, 0); \
               acc[ai][bj][m][n] = __builtin_amdgcn_mfma_f32_16x16x32_bf16(PG8_HALF(Bt[n], 1), PG8_HALF(At[m], 1), acc[ai][bj][m][n], 0, 0, 0); } } \
        __builtin_amdgcn_s_setprio(0); } while (0)
#define PG8_WAIT_V(n) asm volatile("s_waitcnt vmcnt(" #n ")" ::: "memory")
#define PG8_WAIT_L(n) asm volatile("s_waitcnt lgkmcnt(" #n ")" ::: "memory")
#define PG8_BAR __builtin_amdgcn_s_barrier()
#define PG8_SCHED __builtin_amdgcn_sched_barrier(0)
    Unit cur, nxt, nn; int ui = 0;
    if (!S.next(0, cur)) return;
    f32x4 acc[2][2][4][2];
#pragma unroll
    for (int a = 0; a < 2; ++a)
#pragma unroll
        for (int b = 0; b < 2; ++b)
#pragma unroll
            for (int m = 0; m < 4; ++m)
#pragma unroll
                for (int n = 0; n < 2; ++n) acc[a][b][m][n] = (f32x4){0.f, 0.f, 0.f, 0.f};
    v8i_t At[4], B0[2], B1[2];
    unsigned cvo[2][2], nvo[2][2], nnvo[2][2];
    MP.a_off(cur, Rr, Cc, cvo);
    bool has_next = S.next(1, nxt);
    if constexpr (Map::GATHER) { if (has_next) MP.a_off(nxt, Rr, Cc, nvo); else { nvo[0][0] = cvo[0][0]; nvo[0][1] = cvo[0][1]; nvo[1][0] = cvo[1][0]; nvo[1][1] = cvo[1][1]; } }
    unsigned cA = MP.a_soff(cur), cB = MP.b_soff(cur);
    typename Epi::Pre pc, pn;
    E.preload(cur, wr, wc, fr, fq, pc); pn = pc;
    PG8_STAGE(PG8_SB(0, 0), RB, cB, voffB); PG8_STAGE(PG8_SB(0, 1), RB, cB + hstepB, voffB); PG8_STAGE(PG8_SA(0, 0), RA, cA, cvo[0]); PG8_STAGE(PG8_SA(0, 1), RA, cA, cvo[1]);
    if (wr == 1) PG8_BAR;
    PG8_WAIT_V(2); PG8_BAR;
    PG8_STAGE(PG8_SB(1, 0), RB, cB + kstep, voffB); PG8_STAGE(PG8_SA(1, 0), RA, cA + kstep, cvo[0]); PG8_STAGE(PG8_SB(1, 1), RB, cB + hstepB + kstep, voffB);
    PG8_WAIT_V(6); PG8_BAR;
    for (;;) {
        const unsigned nA = has_next ? MP.a_soff(nxt) : cA, nB = has_next ? MP.b_soff(nxt) : cB;
#pragma unroll 1
        for (int t = 0; t < nt; t += 2) {
            const bool last = (t == nt - 2);
            const unsigned a1 = cA + (unsigned)(t + 1) * kstep;
            const unsigned a2 = last ? nA : cA + (unsigned)(t + 2) * kstep, b2 = last ? nB : cB + (unsigned)(t + 2) * kstep;
            const unsigned a3 = a2 + kstep, b3 = b2 + kstep;
            unsigned s0[2] = {cvo[0][0], cvo[0][1]}, s1[2] = {cvo[1][0], cvo[1][1]};
            if constexpr (Map::GATHER) { if (last) { s0[0] = nvo[0][0]; s0[1] = nvo[0][1]; s1[0] = nvo[1][0]; s1[1] = nvo[1][1]; } }
            PG8_LDB(B0, 0, 0); PG8_LDB(B1, 0, 1); PG8_SCHED; PG8_LDA(At, 0, 0); PG8_STAGE(PG8_SA(1, 1), RA, a1, cvo[1]);
            PG8_WAIT_V(8); PG8_WAIT_L(0); PG8_BAR; PG8_MMA(0, 0, At, B0); PG8_MMA(0, 1, At, B1); PG8_BAR; PG8_SCHED;
            PG8_LDA(At, 0, 1); PG8_STAGE(PG8_SB(0, 0), RB, b2, voffB); PG8_STAGE(PG8_SB(0, 1), RB, b2 + hstepB, voffB); PG8_STAGE(PG8_SA(0, 0), RA, a2, s0);
            PG8_WAIT_V(8); PG8_WAIT_L(0); PG8_BAR; PG8_MMA(1, 0, At, B0); PG8_MMA(1, 1, At, B1); PG8_BAR; PG8_SCHED;
            PG8_LDB(B0, 1, 0); PG8_LDB(B1, 1, 1); PG8_SCHED; PG8_LDA(At, 1, 0); PG8_STAGE(PG8_SA(0, 1), RA, a2, s1);
            PG8_WAIT_V(8); PG8_WAIT_L(0); PG8_BAR; PG8_MMA(0, 0, At, B0); PG8_MMA(0, 1, At, B1); PG8_BAR; PG8_SCHED;
            PG8_LDA(At, 1, 1); PG8_STAGE(PG8_SB(1, 0), RB, b3, voffB); PG8_STAGE(PG8_SB(1, 1), RB, b3 + hstepB, voffB); PG8_STAGE(PG8_SA(1, 0), RA, a3, s0);
            PG8_WAIT_V(8); PG8_WAIT_L(0); PG8_BAR; PG8_MMA(1, 0, At, B0); PG8_MMA(1, 1, At, B1); PG8_BAR; PG8_SCHED;
        }
        if constexpr (ALIGN_EPI) { if (wr == 0) PG8_BAR; }
        const bool has_nn = has_next && S.next(ui + 2, nn);
        if constexpr (Map::GATHER) { if (has_nn) MP.a_raw(nn, Rr, nnvo); }
        if (has_next) E.preload(nxt, wr, wc, fr, fq, pn);
        { int fr_ = fr, fq_ = fq; asm volatile("" : "+v"(fr_), "+v"(fq_)); E(acc, cur, pc, wr, wc, fr_, fq_); }
        if (!has_next) break;
#pragma unroll
        for (int a = 0; a < 2; ++a)
#pragma unroll
            for (int b = 0; b < 2; ++b)
#pragma unroll
                for (int m = 0; m < 4; ++m)
#pragma unroll
                    for (int n = 0; n < 2; ++n) acc[a][b][m][n] = (f32x4){0.f, 0.f, 0.f, 0.f};
        cur = nxt; cA = nA; cB = nB; ++ui; pc = pn;
#pragma unroll
        for (int h = 0; h < 2; ++h)
#pragma unroll
            for (int i = 0; i < 2; ++i) { if constexpr (Map::GATHER) { cvo[h][i] = nvo[h][i]; nvo[h][i] = has_nn ? MP.a_fin(nnvo[h][i], Cc[i]) : nvo[h][i]; } }
        has_next = has_nn; nxt = nn;
        if constexpr (ALIGN_EPI) { if (wr == 1) PG8_BAR; }
    }
    PG8_WAIT_V(0);
    if constexpr (!ALIGN_EPI) { if (wr == 0) PG8_BAR; }
    PG8_BAR;
#undef PG8_SA
#undef PG8_SB
#undef PG8_STAGE
#undef PG8_LDA
#undef PG8_LDB
#undef PG8_MMA
#undef PG8_HALF
#undef PG8_LD8
#undef PG8_WAIT_V
#undef PG8_WAIT_L
#undef PG8_BAR
#undef PG8_SCHED
}
}
namespace attn_body {
using bf16=__hip_bfloat16;
using bf16x8=__attribute__((ext_vector_type(8)))short;
using s16x4=__attribute__((ext_vector_type(4)))short;
using f32x16=__attribute__((ext_vector_type(16)))float;
using u32x4=__attribute__((ext_vector_type(4)))unsigned;
constexpr int BATCH=8,NHEAD=8,NKVH=2,SEQ=4096,D=64;
constexpr int QP=512,KP=128,VP=128,OP=1024,OCOL=512;
constexpr int NW=8,QBLK=32,QB=QBLK*NW,KVBLK=64,NQB=SEQ/QB;
__device__ __forceinline__ int crow(int r,int hi){return (r&3)+8*(r>>2)+4*hi;}
#define SBAR() __builtin_amdgcn_sched_barrier(0)
constexpr int NSLOT=3, SLOTB=8192;
constexpr int LDS_K=0, LDS_V=NSLOT*SLOTB, LDS_WS=2*NSLOT*SLOTB, LDS_OST=LDS_WS+NW*64*4, LDS_BYTES=LDS_OST+NW*4096;
constexpr float C2=0.125f*1.4426950408889634f;
__device__ __forceinline__ void glds16(const void*gsrc,unsigned lds_dst){unsigned keep;
  asm volatile("s_mov_b32 %0, m0\n\ts_mov_b32 m0, %2\n\ts_nop 0\n\tglobal_load_lds_dwordx4 %1, off\n\ts_mov_b32 m0, %0":"=&s"(keep):"v"(gsrc),"s"(lds_dst):"memory");}
__device__ __forceinline__ float max3f(float a,float b,float c){float r;asm("v_max3_f32 %0, %1, %2, %3":"=v"(r):"v"(a),"v"(b),"v"(c));return r;}
__device__ __forceinline__ float max2f(float a,float b){float r;asm("v_max_f32_e32 %0, %1, %2":"=v"(r):"v"(a),"v"(b));return r;}
__device__ __forceinline__ float fadd_s(float a,float b){float r;asm("v_add_f32_e32 %0, %1, %2":"=v"(r):"v"(a),"v"(b));return r;}
__device__ __forceinline__ float fsub_s(float a,float b){float r;asm("v_sub_f32_e32 %0, %1, %2":"=v"(r):"v"(a),"v"(b));return r;}
typedef float f32x2_t __attribute__((ext_vector_type(2))); typedef __bf16 bf16x2_t __attribute__((ext_vector_type(2)));
__device__ __forceinline__ unsigned cvtpk_s(float lo,float hi){f32x2_t v={lo,hi};bf16x2_t b=__builtin_convertvector(v,bf16x2_t);return __builtin_bit_cast(unsigned,b);}
#define WAIT_BAR(N) asm volatile("s_waitcnt vmcnt(" #N ") lgkmcnt(0)\n\ts_barrier":::"memory")

__device__ __forceinline__ void qkt(f32x16&p0,f32x16&p1,const char*Kslot,const bf16x8*qr,const f32x16&negm,int r32,int hi){
  const char*kb=Kslot+hi*1024+r32*16;
  #pragma unroll
  for(int d0=0;d0<4;++d0){
    const bf16x8 b0=*reinterpret_cast<const bf16x8*>(kb+d0*2048);
    const bf16x8 b1=*reinterpret_cast<const bf16x8*>(kb+d0*2048+512);
    if(d0==0){p0=__builtin_amdgcn_mfma_f32_32x32x16_bf16(b0,qr[0],negm,0,0,0);p1=__builtin_amdgcn_mfma_f32_32x32x16_bf16(b1,qr[0],negm,0,0,0);}
    else{p0=__builtin_amdgcn_mfma_f32_32x32x16_bf16(b0,qr[d0],p0,0,0,0);p1=__builtin_amdgcn_mfma_f32_32x32x16_bf16(b1,qr[d0],p1,0,0,0);}}
}
typedef __attribute__((address_space(3))) const char* lds_cptr;
typedef short v4i16_t __attribute__((ext_vector_type(4)));
__device__ __forceinline__ void kload8(bf16x8*kf,lds_cptr kp){
  kf[0]=*(const __attribute__((address_space(3))) bf16x8*)(kp);      kf[1]=*(const __attribute__((address_space(3))) bf16x8*)(kp+512);
  kf[2]=*(const __attribute__((address_space(3))) bf16x8*)(kp+2048); kf[3]=*(const __attribute__((address_space(3))) bf16x8*)(kp+2560);
  kf[4]=*(const __attribute__((address_space(3))) bf16x8*)(kp+4096); kf[5]=*(const __attribute__((address_space(3))) bf16x8*)(kp+4608);
  kf[6]=*(const __attribute__((address_space(3))) bf16x8*)(kp+6144); kf[7]=*(const __attribute__((address_space(3))) bf16x8*)(kp+6656);
}
__device__ __forceinline__ void kload2(bf16x8*kf,lds_cptr kp,int j){ kf[2*j]=*(const __attribute__((address_space(3))) bf16x8*)(kp+j*2048); kf[2*j+1]=*(const __attribute__((address_space(3))) bf16x8*)(kp+j*2048+512); }
__device__ __forceinline__ s16x4 vtr(lds_cptr p){ return __builtin_bit_cast(s16x4,__builtin_amdgcn_ds_read_tr16_b64_v4i16((__attribute__((address_space(3))) v4i16_t*)p)); }
__device__ __forceinline__ float rowmax(const f32x16&p0,const f32x16&p1){
  float a=max3f(p0[0],p0[1],p1[0]),b=max3f(p0[2],p0[3],p1[1]);a=max3f(a,p1[2],p1[3]);
  #pragma unroll
  for(int r=4;r<16;r+=4){a=max3f(a,p0[r],p0[r+1]);b=max3f(b,p0[r+2],p0[r+3]);a=max3f(a,p1[r],p1[r+1]);b=max3f(b,p1[r+2],p1[r+3]);}
  const float m=max2f(a,b);
  auto rr=__builtin_amdgcn_permlane32_swap(__float_as_uint(m),__float_as_uint(m),false,false);
  return max2f(__uint_as_float(rr[0]),__uint_as_float(rr[1]));
}
__device__ __forceinline__ void pv(f32x16*o,int vb,bf16x8 pa0,bf16x8 pa1,bf16x8 pa2,bf16x8 pa3){
  #pragma unroll
  for(int d0=0;d0<2;++d0){s16x4 lo[4],hi[4];
    #pragma unroll
    for(int ks=0;ks<4;++ks){
      asm volatile("ds_read_b64_tr_b16 %0,%1 offset:%c2":"=&v"(lo[ks]):"v"(vb),"i"(d0*4096+ks*1024):"memory");
      asm volatile("ds_read_b64_tr_b16 %0,%1 offset:%c2":"=&v"(hi[ks]):"v"(vb),"i"(d0*4096+ks*1024+512):"memory");}
    asm volatile("s_waitcnt lgkmcnt(0)":::"memory");SBAR();
    #define PK(k) (bf16x8){lo[k][0],lo[k][1],lo[k][2],lo[k][3],hi[k][0],hi[k][1],hi[k][2],hi[k][3]}
    o[d0]=__builtin_amdgcn_mfma_f32_32x32x16_bf16(pa0,PK(0),o[d0],0,0,0);
    o[d0]=__builtin_amdgcn_mfma_f32_32x32x16_bf16(pa1,PK(1),o[d0],0,0,0);
    o[d0]=__builtin_amdgcn_mfma_f32_32x32x16_bf16(pa2,PK(2),o[d0],0,0,0);
    o[d0]=__builtin_amdgcn_mfma_f32_32x32x16_bf16(pa3,PK(3),o[d0],0,0,0);
    #undef PK
  }
}
#define ATTN_STORE16(p,v) (*(u32x4*)(p)=(v))
template<int THRL> __device__ __forceinline__ void attn_unit(int b,int h,int qb,const bf16*Q,const bf16*__restrict__ K,const bf16*__restrict__ V,bf16*O,char*shm,const float*qgain,const float sbound){
  int tid_=threadIdx.x; asm volatile("":"+v"(tid_));
  const int tid=tid_,lane=tid&63,r32=lane&31,hi=lane>>5; const int wid=__builtin_amdgcn_readfirstlane(tid>>6);
  const long rowbase=(long)b*SEQ; const int q0=qb*QB; const int kvh=h/(NHEAD/NKVH);
  const bf16*Qw=Q+(rowbase+q0+wid*QBLK)*QP+h*D;
  const bf16*Kh=K+rowbase*KP+kvh*D,*Vh=V+rowbase*VP+kvh*D;
  const unsigned lds0=(unsigned)(uintptr_t)shm;
  float*wsf=(float*)(shm+LDS_WS)+wid*64;
  const bf16*ksrc=Kh+(long)lane*KP+wid*8;
  const bf16*vsrc=Vh+(long)(16*(wid&3)+(lane>>2))*VP+(wid>>2)*32+(lane&3)*8;
  const unsigned kdst=lds0+LDS_K+wid*1024, vdst=lds0+LDS_V+wid*1024;
  #define DMA_K(t,slot) glds16(ksrc+(long)(t)*KVBLK*KP,(unsigned)__builtin_amdgcn_readfirstlane(kdst+(slot)))
  #define DMA_V(t,slot) glds16(vsrc+(long)(t)*KVBLK*VP,(unsigned)__builtin_amdgcn_readfirstlane(vdst+(slot)))
  const int vb0=(int)(lds0+LDS_V)+((lane>>4)&1)*32+(lane&3)*8+(4*hi+((lane&15)>>2))*64;
  const char*Kbase=shm+LDS_K; bf16x8 kf[8];
  const lds_cptr shm3=(lds_cptr)shm; const lds_cptr kp0=shm3+LDS_K+hi*1024+r32*16; const lds_cptr vp0=shm3+LDS_V+((lane>>4)&1)*32+(lane&3)*8+(4*hi+((lane&15)>>2))*64;
  constexpr int NT=SEQ/KVBLK;
  DMA_K(0,0);DMA_V(0,0);DMA_K(1,SLOTB);
  bf16x8 qr[4];
  #pragma unroll
  for(int d0=0;d0<4;++d0)qr[d0]=*reinterpret_cast<const bf16x8*>(&Qw[(long)r32*QP+d0*16+hi*8]);
  { float xq[4][8]; float ss=0.f; int hio=hi; asm volatile("":"+v"(hio));
    #pragma unroll
    for(int d0=0;d0<4;++d0)
      #pragma unroll
      for(int j=0;j<8;++j){ xq[d0][j]=__builtin_bit_cast(float,((unsigned)(unsigned short)qr[d0][j])<<16); ss+=xq[d0][j]*xq[d0][j]; }
    ss+=__shfl_xor(ss,32);
    const float rinv=__builtin_amdgcn_rsqf(ss*(1.f/64.f)+1e-6f);
    const int tq=q0+wid*QBLK+r32; const float prow=(float)(tq>>6), pcol=(float)(tq&63);
    #pragma unroll
    for(int d0=0;d0<4;++d0)
      #pragma unroll
      for(int j=0;j<8;++j) xq[d0][j]*=rinv*qgain[16*d0+8*hio+j];
    #pragma unroll
    for(int j=0;j<8;++j){ const float inv=exp2f(-(float)(8*hio+j)*(13.287712379549449f/16.f));
      const float ar=prow*inv, ac=pcol*inv; const float cr=__cosf(ar), sr=__sinf(ar), cc=__cosf(ac), sc=__sinf(ac);
      const float a0=xq[0][j], a1=xq[1][j], b0=xq[2][j], b1=xq[3][j];
      xq[0][j]=(a0*cr-a1*sr)*C2; xq[1][j]=(a1*cr+a0*sr)*C2; xq[2][j]=(b0*cc-b1*sc)*C2; xq[3][j]=(b1*cc+b0*sc)*C2; }
    #pragma unroll
    for(int d0=0;d0<4;++d0){ u32x4 w; w.x=cvtpk_s(xq[d0][0],xq[d0][1]); w.y=cvtpk_s(xq[d0][2],xq[d0][3]); w.z=cvtpk_s(xq[d0][4],xq[d0][5]); w.w=cvtpk_s(xq[d0][6],xq[d0][7]); qr[d0]=__builtin_bit_cast(bf16x8,w); } }
  float l_reg=0.f;f32x16 o[2];o[0]=f32x16{};o[1]=f32x16{};f32x16 negm;
  #pragma unroll
  for(int r=0;r<16;++r)negm[r]=-sbound;
  asm volatile("":"+v"(negm));
  #define START(P0,P1) do{ _Pragma("unroll") for(int r=0;r<16;++r)P0[r]=__builtin_amdgcn_exp2f(P0[r]); }while(0)
  #define RESC() do{}while(0)
  f32x16 pA0,pA1,pB0,pB1;
  int sl_prev=0,sl_cur=0,sl_next=SLOTB;
  #define ROT() do{sl_prev=sl_cur;sl_cur=sl_next;sl_next=(sl_next==(NSLOT-1)*SLOTB)?0:sl_next+SLOTB;}while(0)
  DMA_K(2,2*SLOTB);
  WAIT_BAR(3);
  qkt(pA0,pA1,Kbase,qr,negm,r32,hi);asm volatile("s_nop 15\n\ts_nop 7":"+v"(pA0),"+v"(pA1));
  START(pA0,pA1);
  _Pragma("unroll") for(int r=0;r<16;++r)pA1[r]=__builtin_amdgcn_exp2f(pA1[r]);
  WAIT_BAR(0);
  DMA_K(3,0);DMA_V(1,SLOTB);
  ROT();
  kload8(kf,kp0+sl_cur);
  WAIT_BAR(2);
  s16x4 vlo[8],vhi[8]; u32x4 pw0,pw1,pw2,pw3;
  #define PKW(P,B) cvtpk_s(P[B],P[B+1])
  #define PAF(k) __builtin_bit_cast(bf16x8,pw##k)
  #define VFR(i) (bf16x8){vlo[i][0],vlo[i][1],vlo[i][2],vlo[i][3],vhi[i][0],vhi[i][1],vhi[i][2],vhi[i][3]}
  #define PIN(x) asm volatile("":"+v"(x))
  #define MX3(a,b,c) __builtin_fmaxf(__builtin_fmaxf((a),(b)),(c))
  #define GAPA(MF,A0,A1,A2,A3,W0,W1,PW) do{ MF; sacc+=A0; sacc+=A1; sacc+=A2; sacc+=A3; PIN(sacc); W0; W1; PIN(PW); SBAR(); }while(0)
  #define EX(v) __builtin_amdgcn_exp2f(v)
  #define GAPB(MF,X,B) do{ MF; X[B]=EX(X[B]); X[B+1]=EX(X[B+1]); X[B+2]=EX(X[B+2]); X[B+3]=EX(X[B+3]); PIN(X); SBAR(); }while(0)
  #define VRD(i) do{ vlo[i]=vtr(vp_+(((i)>>2)*4096+((i)&3)*1024)); vhi[i]=vtr(vp_+(((i)>>2)*4096+((i)&3)*1024+512)); }while(0)
  #define KRD(G,j) do{ if(G){ kload2(kf,kp0+sl_next,j); SBAR(); } }while(0)
  #define STEP(C0,C1,P0,P1,t,GK,GV,GL) do{ SBAR(); \
    const lds_cptr vp_=vp0+sl_prev; \
    VRD(0); SBAR(); float sacc=(P0[0]+P0[1]); \
    GAPA(C0=__builtin_amdgcn_mfma_f32_32x32x16_bf16(kf[0],qr[0],negm,0,0,0), P0[2],P0[3],P0[4],P0[5],     pw0[0]=PKW(P0,0), pw0[1]=PKW(P0,2), pw0); \
    VRD(4); SBAR(); GAPA(C1=__builtin_amdgcn_mfma_f32_32x32x16_bf16(kf[1],qr[0],negm,0,0,0), P0[6],P0[7],P0[8],P0[9],     pw0[2]=PKW(P0,4), pw0[3]=PKW(P0,6), pw0); \
    VRD(1); SBAR(); GAPA(C0=__builtin_amdgcn_mfma_f32_32x32x16_bf16(kf[2],qr[1],C0,0,0,0),   P0[10],P0[11],P0[12],P0[13], pw1[0]=PKW(P0,8), pw1[1]=PKW(P0,10), pw1); \
    VRD(5); SBAR(); GAPA(C1=__builtin_amdgcn_mfma_f32_32x32x16_bf16(kf[3],qr[1],C1,0,0,0),   P0[14],P0[15],P1[0],P1[1],   pw1[2]=PKW(P0,12),pw1[3]=PKW(P0,14), pw1); \
    VRD(2); SBAR(); GAPA(C0=__builtin_amdgcn_mfma_f32_32x32x16_bf16(kf[4],qr[2],C0,0,0,0),   P1[2],P1[3],P1[4],P1[5],     pw2[0]=PKW(P1,0), pw2[1]=PKW(P1,2), pw2); \
    VRD(6); SBAR(); GAPA(C1=__builtin_amdgcn_mfma_f32_32x32x16_bf16(kf[5],qr[2],C1,0,0,0),   P1[6],P1[7],P1[8],P1[9],     pw2[2]=PKW(P1,4), pw2[3]=PKW(P1,6), pw2); \
    VRD(3); SBAR(); GAPA(C0=__builtin_amdgcn_mfma_f32_32x32x16_bf16(kf[6],qr[3],C0,0,0,0),   P1[10],P1[11],P1[12],P1[13], pw3[0]=PKW(P1,8), pw3[1]=PKW(P1,10), pw3); \
    VRD(7); SBAR(); GAPA(C1=__builtin_amdgcn_mfma_f32_32x32x16_bf16(kf[7],qr[3],C1,0,0,0),   P1[14],P1[15],0.f,0.f,       pw3[2]=PKW(P1,12),pw3[3]=PKW(P1,14), pw3); \
    l_reg+=sacc; \
    if(GK){DMA_K((t)+3,sl_cur);} if(GV){DMA_V((t)+1,sl_next);} \
    SBAR(); \
    GAPB(o[0]=__builtin_amdgcn_mfma_f32_32x32x16_bf16(PAF(0),VFR(0),o[0],0,0,0), C0,0); \
    GAPB(o[1]=__builtin_amdgcn_mfma_f32_32x32x16_bf16(PAF(0),VFR(4),o[1],0,0,0), C0,4); \
    KRD(GL,0); GAPB(o[0]=__builtin_amdgcn_mfma_f32_32x32x16_bf16(PAF(1),VFR(1),o[0],0,0,0), C0,8); \
    KRD(GL,1); GAPB(o[1]=__builtin_amdgcn_mfma_f32_32x32x16_bf16(PAF(1),VFR(5),o[1],0,0,0), C0,12); \
    KRD(GL,2); GAPB(o[0]=__builtin_amdgcn_mfma_f32_32x32x16_bf16(PAF(2),VFR(2),o[0],0,0,0), C1,0); \
    KRD(GL,3); GAPB(o[1]=__builtin_amdgcn_mfma_f32_32x32x16_bf16(PAF(2),VFR(6),o[1],0,0,0), C1,4); \
    GAPB(o[0]=__builtin_amdgcn_mfma_f32_32x32x16_bf16(PAF(3),VFR(3),o[0],0,0,0), C1,8); \
    GAPB(o[1]=__builtin_amdgcn_mfma_f32_32x32x16_bf16(PAF(3),VFR(7),o[1],0,0,0), C1,12); \
    }while(0)
  int t=1;
  for(;t+5<NT;t+=2){
    STEP(pB0,pB1,pA0,pA1,t,true,true,true);     WAIT_BAR(2); RESC(); ROT();
    STEP(pA0,pA1,pB0,pB1,t+1,true,true,true);   WAIT_BAR(2); RESC(); ROT();
  }
  #define ENDW(tt) do{ if((tt)+3<NT){WAIT_BAR(2);} else if((tt)+2<NT){WAIT_BAR(1);} else {WAIT_BAR(0);} }while(0)
  for(;t+1<NT;t+=2){
    STEP(pB0,pB1,pA0,pA1,t,(t+3<NT),(t+1<NT),(t+1<NT));       ENDW(t);   RESC(); ROT();
    STEP(pA0,pA1,pB0,pB1,t+1,(t+4<NT),(t+2<NT),(t+2<NT));     ENDW(t+1); RESC(); ROT();
  }
  STEP(pB0,pB1,pA0,pA1,NT-1,false,false,false); RESC();
  { float sacc=pB0[0]+pB0[1]; _Pragma("unroll") for(int r=2;r<16;++r)sacc+=pB0[r]; _Pragma("unroll") for(int r=0;r<16;++r)sacc+=pB1[r]; l_reg+=sacc;
    pw0=(u32x4){PKW(pB0,0),PKW(pB0,2),PKW(pB0,4),PKW(pB0,6)};pw1=(u32x4){PKW(pB0,8),PKW(pB0,10),PKW(pB0,12),PKW(pB0,14)};pw2=(u32x4){PKW(pB1,0),PKW(pB1,2),PKW(pB1,4),PKW(pB1,6)};pw3=(u32x4){PKW(pB1,8),PKW(pB1,10),PKW(pB1,12),PKW(pB1,14)};
    SBAR(); pv(o,vb0+sl_cur,PAF(0),PAF(1),PAF(2),PAF(3)); }
  #undef PKW
  #undef PAF
  #undef VFR
  #undef PIN
  #undef MX3
  #undef GAPA
  #undef GAPB
  #undef EX
  #undef VRD
  #undef KRD
  #undef STEP
  #undef ENDW
  {auto rr=__builtin_amdgcn_permlane32_swap(__float_as_uint(l_reg),__float_as_uint(l_reg),false,false);l_reg=__uint_as_float(rr[0])+__uint_as_float(rr[1]);}
  if(hi==0)wsf[32+r32]=l_reg;asm volatile("s_waitcnt lgkmcnt(0)":::"memory");
  float rli[16];
  #pragma unroll
  for(int r=0;r<16;++r)rli[r]=__builtin_amdgcn_rcpf(wsf[32+crow(r,hi)]);
  bf16*Ow=O+(rowbase+q0+wid*QBLK)*OP+OCOL+h*D;
  { bf16*stg=(bf16*)(shm+LDS_OST)+wid*2048;
    #pragma unroll
    for(int r=0;r<16;++r){const int orow=crow(r,hi);
      #pragma unroll
      for(int d0=0;d0<2;++d0)stg[orow*64+d0*32+r32]=__float2bfloat16(o[d0][r]*rli[r]);}
    asm volatile("s_waitcnt lgkmcnt(0)":::"memory");
    #pragma unroll
    for(int i=0;i<4;++i){const int row=i*8+(lane>>3),ch=lane&7; const u32x4 v=*(const u32x4*)(stg+row*64+ch*8); ATTN_STORE16(Ow+(long)row*OP+ch*8,v);} }
  asm volatile("s_waitcnt lgkmcnt(0)\n\ts_barrier":::"memory");
  #undef DMA_K
  #undef DMA_V
  #undef START
  #undef RESC
  #undef ROT
}
constexpr int ATTN_LDS_BYTES=LDS_BYTES;
#undef SBAR
#undef WAIT_BAR
}
constexpr int NWAVES = 8;
constexpr int BATCH = 8, SEQ = 4096, DM = 1024, T = BATCH * SEQ;
constexpr int GLA_H = 4, GLA_DK = 64, GLA_DV = 128, GLA_RANK = 16;
constexpr int ATT_H = 8, ATT_KVH = 2, ATT_DH = 64;
constexpr int D_IN = 2336, D_IN_PAD = 2560;
constexpr int NEXP = 32, TOPK = 4, DFF = 1024;
constexpr int EROWS = 32768;
constexpr int PROWS = T * TOPK + NEXP * 256;
constexpr float EPS = 1e-6f;
constexpr float YSCALE = 16.f;
constexpr float WSCALE = 32.f, ASCALE = 4.f;

constexpr size_t MiB = 1u << 20;
constexpr size_t WS_CTL = 0, CTL_ZERO_BYTES = 1 * MiB;
constexpr size_t WS_WRH = 1 * MiB, WS_WRL = WS_WRH + 65536;
constexpr size_t WS_WIN = 2 * MiB;
constexpr size_t WS_WOUT = 8 * MiB;
constexpr size_t WS_W1 = 10 * MiB;
constexpr size_t WS_W2 = 138 * MiB;
constexpr size_t WS_ROWTOK = 202 * MiB;
constexpr size_t WS_ROWGATE = 206 * MiB;
constexpr size_t WS_TOKASG = 210 * MiB;
constexpr size_t WS_REGY = 212 * MiB;
constexpr size_t WS_XN = WS_REGY;
constexpr size_t WS_GQ = WS_XN + 64 * MiB;
constexpr size_t WS_GK = WS_GQ + 16 * MiB;
constexpr size_t WS_GV = WS_GK + 16 * MiB;
constexpr size_t WS_GR = WS_GV + 32 * MiB;
constexpr size_t WS_AQ = WS_GR + 32 * MiB;
constexpr size_t WS_AK = WS_AQ + 32 * MiB;
constexpr size_t WS_AV = WS_AK + 8 * MiB;
constexpr size_t WS_Z = WS_AV + 8 * MiB;
constexpr size_t WS_OF = WS_Z + 2 * MiB;
constexpr size_t WS_H16 = WS_REGY + 200 * MiB;
constexpr size_t WS_Y = WS_REGY;
constexpr size_t WS_REGA = WS_REGY + 274 * MiB;
constexpr size_t WS_MIX = WS_REGA;
constexpr size_t WS_ACT = WS_REGA;
constexpr size_t WS_QF = WS_REGA + 272 * MiB, WS_KF = WS_QF + 16 * MiB, WS_QB = WS_KF + 16 * MiB, WS_KB = WS_QB + 16 * MiB;
constexpr size_t WS_DEC = WS_KB + 16 * MiB;
constexpr size_t WS_END = WS_DEC + 1 * MiB;
static_assert(WS_OF + (size_t)T * 512 * 4 <= WS_REGA && (size_t)PROWS * 1024 * 2 <= 272 * MiB, "d_ws map");
constexpr int CW_BAR = 4096;
constexpr int CW_CNT = 8192;
constexpr int CW_CONV = 20480;
constexpr int CW_GDN = 16384;
constexpr int CW_QUE = 12288;

constexpr int SCR_BYTES = 133120;
constexpr int LC_OFF = SCR_BYTES;
constexpr int LC_MISC = LC_OFF;
constexpr int LC_CNT = LC_OFF + 128;
constexpr int LC_CST = LC_CNT + 128;
constexpr int LC_TE = LC_CST + 256;
constexpr int LC_HIST = LC_TE + 1152;
constexpr int LC_BASE = LC_HIST + 128;
constexpr int LC_ASG = LC_BASE + 128;
constexpr int LC_GDEC = LC_ASG + 8192;
constexpr int LC_END = LC_GDEC + 512;
constexpr int LDS_BYTES = 147456;
static_assert(LC_END <= LDS_BYTES, "LDS map");

typedef unsigned short bf16;
typedef unsigned v4u __attribute__((ext_vector_type(4)));
typedef unsigned v2u __attribute__((ext_vector_type(2)));
typedef float f32x4 __attribute__((ext_vector_type(4)));
typedef short bf16x8 __attribute__((ext_vector_type(8)));
typedef GAS unsigned gu32;
#define RLX_AGENT __ATOMIC_RELAXED, __HIP_MEMORY_SCOPE_AGENT
#define LDS_WAIT() asm volatile("s_waitcnt lgkmcnt(0)" ::: "memory")
#define VM_WAIT() asm volatile("s_waitcnt vmcnt(0)" ::: "memory")
__device__ __forceinline__ unsigned pk2(float lo, float hi) { typedef float f2_t_ __attribute__((ext_vector_type(2))); typedef __bf16 b2_t_ __attribute__((ext_vector_type(2))); const f2_t_ v = {lo, hi}; return __builtin_bit_cast(unsigned, __builtin_convertvector(v, b2_t_)); }
__device__ __forceinline__ unsigned f2bf(float f) { return pk2(f, 0.f) & 0xffffu; }
__device__ __forceinline__ float bf2f(unsigned h) { return __builtin_bit_cast(float, h << 16); }
__device__ __forceinline__ float bflo(unsigned w) { return __builtin_bit_cast(float, w << 16); }
__device__ __forceinline__ float bfhi(unsigned w) { return __builtin_bit_cast(float, w & 0xffff0000u); }

#define XB_TMO      128
#define XB_XCNT(j)  (256  + 64 * (j))
#define XB_XSUB(j)  (1280 + 64 * (j))
#define XB_XGEN(j)  (2304 + 64 * (j))
#define XB_TOP      3328
#define XB_TOPGEN   3392
#define XCD_BAR_WORDS 3456
#define XB_SPIN_CAP (1u << 18)
__device__ __forceinline__ unsigned xb_ld(unsigned* p)              { return __hip_atomic_load(p, __ATOMIC_RELAXED, __HIP_MEMORY_SCOPE_AGENT); }
__device__ __forceinline__ unsigned xb_add(unsigned* p, unsigned v) { return __hip_atomic_fetch_add(p, v, __ATOMIC_RELAXED, __HIP_MEMORY_SCOPE_AGENT); }
__device__ __forceinline__ unsigned xb_xcc_id() { return (unsigned)__builtin_amdgcn_s_getreg((3 << 11) | 20) & 0xFu; }
#define XB_SPIN(cond, bar) do { unsigned _sp = 0; while (cond) { __builtin_amdgcn_s_sleep(1); \
    if ((++_sp & 255u) == 0u) { if (xb_ld(&(bar)[XB_TMO])) break; if (_sp > XB_SPIN_CAP) { atomicAdd(&(bar)[XB_TMO], 1u); break; } } } } while (0)
struct XcdBarrier { unsigned* bar; unsigned x; volatile LAS unsigned* st; };
__device__ __forceinline__ XcdBarrier xcd_barrier_post(unsigned* bar, volatile LAS unsigned* st) {
    XcdBarrier b; b.bar = bar; b.x = xb_xcc_id(); b.st = st;
    if (threadIdx.x == 0) (void)xb_add(&bar[XB_XCNT(b.x)], 1u);
    return b;
}
__device__ __forceinline__ void xcd_barrier_complete(unsigned* bar, unsigned x, unsigned& nloc, unsigned& nx) {
    const unsigned G = gridDim.x * gridDim.y * gridDim.z;
    unsigned sum, cnt, mine, sp = 0u;
    for (;;) {
        sum = 0u; cnt = 0u; mine = 0u;
#pragma unroll
        for (unsigned j = 0; j < 16; ++j) { const unsigned c = xb_ld(&bar[XB_XCNT(j)]); sum += c; cnt += (c > 0u) ? 1u : 0u; mine = (j == x) ? c : mine; }
        if (sum == G) break;
        __builtin_amdgcn_s_sleep(1);
        if ((++sp & 255u) == 0u) { if (xb_ld(&bar[XB_TMO])) break; if (sp > XB_SPIN_CAP) { atomicAdd(&bar[XB_TMO], 1u); break; } }
    }
    nloc = mine > 0u ? mine : 1u; nx = cnt > 0u ? cnt : 1u;
}
__device__ __forceinline__ void xcd_barrier(const XcdBarrier& b) {
    asm volatile("s_waitcnt vmcnt(0)" ::: "memory");
    __syncthreads();
    if (threadIdx.x == 0) {
        unsigned* bar = b.bar;
        __builtin_amdgcn_s_waitcnt(0);
        unsigned nloc = b.st[0], nx = b.st[1];
        if (nloc == 0u) { xcd_barrier_complete(bar, b.x, nloc, nx); b.st[0] = nloc; b.st[1] = nx; }
        const unsigned old = xb_add(&bar[XB_XSUB(b.x)], 1u);
        const unsigned gen = old / nloc;
        if (old + 1u == (gen + 1u) * nloc) {
            __builtin_amdgcn_fence(__ATOMIC_RELEASE, "agent");
            asm volatile("s_waitcnt vmcnt(0)" ::: "memory");
            const unsigned og = xb_add(&bar[XB_TOP], 1u);
            const unsigned tg = og / nx;
            if (og + 1u == (tg + 1u) * nx) xb_add(&bar[XB_TOPGEN], 1u);
            else XB_SPIN(xb_ld(&bar[XB_TOPGEN]) == tg, bar);
            __builtin_amdgcn_fence(__ATOMIC_ACQUIRE, "agent");
            xb_add(&bar[XB_XGEN(b.x)], 1u);
            asm volatile("s_waitcnt vmcnt(0)" ::: "memory");
        } else {
            XB_SPIN(xb_ld(&bar[XB_XGEN(b.x)]) == gen, bar);
            __builtin_amdgcn_fence(__ATOMIC_ACQUIRE, "agent");
            asm volatile("s_waitcnt vmcnt(0)" ::: "memory");
        }
    }
    __syncthreads();
}

struct Frame {
    LAS unsigned char* lds;
    volatile LAS unsigned* MISC;
    gu32* ctl;
    int tid, lane, wave;
    int vcu, G;
    unsigned char* ws;
    const float *x, *mix_g, *w_in, *w_gf, *b_gf, *w_gb, *b_gb, *gla_hg, *q_g, *k_g, *w_out, *ffn_g, *w_router, *b_router, *w1, *b1, *w2, *b2, *fin_g;
    float* out;
};
template <int CTRL> __device__ __forceinline__ float dpp_mov(float v) { return __builtin_bit_cast(float, __builtin_amdgcn_update_dpp(0, __builtin_bit_cast(int, v), CTRL, 0xf, 0xf, true)); }
__device__ __forceinline__ float wave_sum(float v) {
    v += dpp_mov<0xB1>(v);
    v += dpp_mov<0x4E>(v);
    v += dpp_mov<0x141>(v);
    v += dpp_mov<0x140>(v);
    { auto r = __builtin_amdgcn_permlane16_swap(__float_as_uint(v), __float_as_uint(v), false, false); v = __uint_as_float(r[0]) + __uint_as_float(r[1]); }
    { auto r = __builtin_amdgcn_permlane32_swap(__float_as_uint(v), __float_as_uint(v), false, false); v = __uint_as_float(r[0]) + __uint_as_float(r[1]); }
    return v;
}
__device__ __forceinline__ void p0_tr64(const float* src  , int ldw, bf16* d0, bf16* d1, int ldt, LAS float* scr, int lane, int ncols) {
    const int c4 = (lane & 15) * 4, kr = lane >> 4;
    if (c4 < ncols) {
#pragma unroll 4
        for (int i = 0; i < 16; ++i) { const int kk = kr + 4 * i; const f32x4 v = *(const GAS f32x4*)(src + (size_t)kk * ldw + c4);
            LAS float* s = scr + kk * 65 + c4; s[0] = v.x; s[1] = v.y; s[2] = v.z; s[3] = v.w; }
    }
    LDS_WAIT(); asm volatile("" ::: "memory");
    const int c = lane & 7;
#pragma unroll
    for (int j = 0; j < 8; ++j) { const int n = (lane >> 3) + 8 * j;
        if (n < ncols) { const LAS float* s = scr + (8 * c) * 65 + n;
            v4u o; o.x = pk2(s[0 * 65], s[1 * 65]); o.y = pk2(s[2 * 65], s[3 * 65]); o.z = pk2(s[4 * 65], s[5 * 65]); o.w = pk2(s[6 * 65], s[7 * 65]);
            bf16* rowp = (n < 32 ? d0 : d1) + (size_t)(n & 31) * ldt;
            *(GAS v4u*)(rowp + 8 * c) = o; } }
    LDS_WAIT(); asm volatile("" ::: "memory");
}
struct F8Item { const float* src; int ldw; unsigned char* d0; unsigned char* d1; };
__device__ __forceinline__ void f8_load(const F8Item& it, f32x4 (&v)[16], int lane) {
    const int c4 = (lane & 15) * 4, kr = lane >> 4;
#pragma unroll
    for (int i = 0; i < 16; ++i) v[i] = __builtin_nontemporal_load((const GAS f32x4*)(it.src + (size_t)(kr + 4 * i) * it.ldw + c4));
}
__device__ __forceinline__ void f8_finish(const F8Item& it, const f32x4 (&v)[16], LAS float* scr, int lane, float sc) {
    const int c4 = (lane & 15) * 4, kr = lane >> 4;
#pragma unroll
    for (int i = 0; i < 16; ++i) { LAS float* s = scr + (kr + 4 * i) * 65 + c4; s[0] = v[i].x; s[1] = v[i].y; s[2] = v[i].z; s[3] = v[i].w; }
    LDS_WAIT(); asm volatile("" ::: "memory");
    const int c = lane & 7;
#pragma unroll
    for (int j = 0; j < 8; ++j) { const int n = (lane >> 3) + 8 * j; const LAS float* s = scr + (8 * c) * 65 + n;
        int w0 = 0, w1 = 0;
        w0 = __builtin_amdgcn_cvt_pk_fp8_f32(s[0 * 65] * sc, s[1 * 65] * sc, w0, false); w0 = __builtin_amdgcn_cvt_pk_fp8_f32(s[2 * 65] * sc, s[3 * 65] * sc, w0, true);
        w1 = __builtin_amdgcn_cvt_pk_fp8_f32(s[4 * 65] * sc, s[5 * 65] * sc, w1, false); w1 = __builtin_amdgcn_cvt_pk_fp8_f32(s[6 * 65] * sc, s[7 * 65] * sc, w1, true);
        unsigned char* rowp = (n < 32 ? it.d0 : it.d1) + (size_t)(n & 31) * 1024;
        __builtin_nontemporal_store((v2u){(unsigned)w0, (unsigned)w1}, (GAS v2u*)(rowp + 8 * c)); }
    LDS_WAIT(); asm volatile("" ::: "memory");
}
__device__ __forceinline__ int win_pblk(int lb) { return lb < 48 ? lb : (lb == 48 ? 72 : lb - 1); }
__device__ __forceinline__ int w1_pblk(int lb) { return lb < 32 ? (lb >> 2) * 8 + (lb & 3) : ((lb - 32) >> 2) * 8 + 4 + ((lb - 32) & 3); }
__device__ __forceinline__ void rms_row_to_bf16(const float* xrow, const float* g, bf16* orow, int lane) {
    const GAS f32x4* xr = (const GAS f32x4*)xrow + lane; const GAS f32x4* gr = (const GAS f32x4*)g + lane;
    f32x4 v[4]; float s = 0.f;
#pragma unroll
    for (int j = 0; j < 4; ++j) { v[j] = __builtin_nontemporal_load(xr + 64 * j); s += (v[j].x * v[j].x + v[j].y * v[j].y) + (v[j].z * v[j].z + v[j].w * v[j].w); }
    const float rinv = 1.f / sqrtf(wave_sum(s) * (1.f / 1024.f) + EPS);
    GAS unsigned long long* o8 = (GAS unsigned long long*)orow + lane;
#pragma unroll
    for (int j = 0; j < 4; ++j) { const f32x4 gg = gr[64 * j];
        o8[64 * j] = (unsigned long long)pk2(v[j].x * rinv * gg.x, v[j].y * rinv * gg.y) | ((unsigned long long)pk2(v[j].z * rinv * gg.z, v[j].w * rinv * gg.w) << 32); }
}
__device__ __forceinline__ F8Item f8_item(Frame& F, int r) {
    F8Item it;
    if (r < NEXP * 512) { const int e = r / 512, q = r % 512, kb = q / 32, nb = q % 32; it.src = F.w1 + (size_t)e * 1024 * 2048 + (size_t)(64 * kb) * 2048 + 64 * nb; it.ldw = 2048;
        unsigned char* dst = F.ws + WS_W1 + (size_t)e * 2048 * 1024 + 64 * kb; it.d0 = dst + (size_t)(32 * w1_pblk(2 * nb)) * 1024; it.d1 = dst + (size_t)(32 * w1_pblk(2 * nb + 1)) * 1024; }
    else { const int r2 = r - NEXP * 512, e = r2 / 256, q = r2 % 256, kb = q / 16, nb = q % 16; it.src = F.w2 + (size_t)e * 1024 * 1024 + (size_t)(64 * kb) * 1024 + 64 * nb; it.ldw = 1024;
        unsigned char* dst = F.ws + WS_W2 + (size_t)e * 1024 * 1024 + 64 * kb; it.d0 = dst + (size_t)(64 * nb) * 1024; it.d1 = dst + (size_t)(64 * nb + 32) * 1024; }
    return it;
}
constexpr int N_F8_ITEMS = NEXP * 512 + NEXP * 256, N_CONV_BATCH = N_F8_ITEMS / 64;
__device__ __forceinline__ void f8_items(Frame& F, int r, int step, int rend, LAS float* scr) {
    if (r >= rend) return;
    F8Item cur = f8_item(F, r); f32x4 va[16], vb[16];
    f8_load(cur, va, F.lane);
    for (;;) {
        int rn = r + step; F8Item nx = cur; if (rn < rend) { nx = f8_item(F, rn); f8_load(nx, vb, F.lane); }
        f8_finish(cur, va, scr, F.lane, WSCALE);
        if (rn >= rend) break;
        r = rn + step; cur = nx; if (r < rend) { cur = f8_item(F, r); f8_load(cur, va, F.lane); }
        f8_finish(nx, vb, scr, F.lane, WSCALE);
        if (r >= rend) break;
    }
}
__device__ __forceinline__ bool conv_pull(Frame& F) {
    __syncthreads();
    if (F.tid == 0) F.MISC[17] = __hip_atomic_fetch_add(F.ctl + CW_CONV, 1u, RLX_AGENT);
    __syncthreads();
    const int cb = __builtin_amdgcn_readfirstlane((int)F.MISC[17]);
    if (cb >= N_CONV_BATCH) return false;
    f8_items(F, cb * 64 + F.wave * 8, 1, cb * 64 + F.wave * 8 + 8, (LAS float*)(F.lds + F.wave * 16640));
    return true;
}
__device__ __forceinline__ void p0_prologue(Frame& F) {
    LAS float* scr = (LAS float*)(F.lds + F.wave * 16640);
    const int gw = F.vcu * NWAVES + F.wave, NGW = F.G * NWAVES;
    bf16* WIN = (bf16*)(F.ws + WS_WIN); bf16* WOUT = (bf16*)(F.ws + WS_WOUT);
    constexpr int I_IN = 16 * 37, I_OUT = 16 * 16, NITEMS = I_IN + I_OUT;
    for (int it = gw; it < NITEMS; it += NGW) {
        int r = it;
        if (r < I_IN) { const int kb = r / 37, nb = r % 37; const int lb0 = 2 * nb, nc = (nb == 36) ? 32 : 64;
            p0_tr64(F.w_in + (size_t)(64 * kb) * D_IN + 64 * nb, D_IN, WIN + (size_t)(32 * win_pblk(lb0)) * 1024 + 64 * kb, WIN + (size_t)(32 * win_pblk(lb0 + 1 < 73 ? lb0 + 1 : lb0)) * 1024 + 64 * kb, 1024, scr, F.lane, nc); continue; }
        r -= I_IN;
        { const int kb = r / 16, nb = r % 16;
            p0_tr64(F.w_out + (size_t)(64 * kb) * 1024 + 64 * nb, 1024, WOUT + (size_t)(64 * nb) * 1024 + 64 * kb, WOUT + (size_t)(64 * nb + 32) * 1024 + 64 * kb, 1024, scr, F.lane, 64); }
    }
    { const int gt = F.vcu * (NWAVES * 64) + F.tid, NGT = F.G * NWAVES * 64; GAS v4u* z = (GAS v4u*)(WIN + (size_t)D_IN * 1024);
      for (int i = gt; i < (D_IN_PAD - D_IN) * 1024 * 2 / 16; i += NGT) z[i] = (v4u){0u, 0u, 0u, 0u};
      bf16* WRH = (bf16*)(F.ws + WS_WRH); bf16* WRL = (bf16*)(F.ws + WS_WRL);
      for (int i = gt; i < NEXP * 1024; i += NGT) { const int e = i >> 10, k = i & 1023; const float w = F.w_router[(size_t)k * NEXP + e]; const unsigned h = f2bf(w); WRH[i] = (bf16)h; WRL[i] = (bf16)f2bf(w - bf2f(h)); } }
    bf16* XN = (bf16*)(F.ws + WS_XN);
    for (int m = gw; m < T; m += NGW) rms_row_to_bf16(F.x + (size_t)m * DM, F.mix_g, XN + (size_t)m * DM, F.lane);
}

__device__ __forceinline__ void p2_normrope(Frame& F) {
    LAS float* cs = (LAS float*)F.lds;
    for (int i = F.tid; i < 1024; i += NWAVES * 64) { const int pos = i >> 4, fi = i & 15; const float inv = exp2f(-(float)fi * (13.287712379549449f / 16.f)); const float a = (float)pos * inv;
        cs[2 * i] = __cosf(a); cs[2 * i + 1] = __sinf(a); }
    __syncthreads();
    const int gw = F.vcu * NWAVES + F.wave, NGW = F.G * NWAVES, lane = F.lane;
    const int j = lane & 7, blk = (j >> 2) & 1, jj = j & 3, fi0 = 8 * (jj & 1); const bool second = (jj >> 1) != 0;
    float gq[8], gk[8];
#pragma unroll
    for (int e = 0; e < 8; ++e) { gq[e] = F.q_g[8 * j + e]; gk[e] = F.k_g[8 * j + e]; }
    bf16* AQ = (bf16*)(F.ws + WS_AQ); bf16* AK = (bf16*)(F.ws + WS_AK);
    for (int it = T + gw; it < T + T / 4; it += NGW) {
        const bool isq = it < T;
        const int tok = isq ? it : 4 * (it - T) + (lane >> 4);
        GAS v4u* p = isq ? (GAS v4u*)(AQ + (size_t)tok * 512) + lane : (GAS v4u*)(AK + (size_t)tok * 128) + (lane & 15);
        const v4u w = *p;
        float x[8] = {bflo(w.x), bfhi(w.x), bflo(w.y), bfhi(w.y), bflo(w.z), bfhi(w.z), bflo(w.w), bfhi(w.w)};
        float ss = 0.f;
#pragma unroll
        for (int e = 0; e < 8; ++e) ss += x[e] * x[e];
        ss += __shfl_xor(ss, 1); ss += __shfl_xor(ss, 2); ss += __shfl_xor(ss, 4);
        const float rinv = 1.f / sqrtf(ss * (1.f / 64.f) + EPS);
        const int ts = tok & (SEQ - 1), pos = blk ? (ts & 63) : (ts >> 6);
        const LAS float* c = cs + (pos * 16 + fi0) * 2;
        float y[8];
#pragma unroll
        for (int e = 0; e < 8; ++e) { x[e] = x[e] * rinv * (isq ? gq[e] : gk[e]); }
#pragma unroll
        for (int e = 0; e < 8; ++e) { const float pr = __shfl_xor(x[e], 2); const float co = c[2 * e], si = c[2 * e + 1]; y[e] = second ? (x[e] * co + pr * si) : (x[e] * co - pr * si); }
        const float sc = isq ? attn_body::C2 : 1.f;
        v4u o; o.x = pk2(y[0] * sc, y[1] * sc); o.y = pk2(y[2] * sc, y[3] * sc); o.z = pk2(y[4] * sc, y[5] * sc); o.w = pk2(y[6] * sc, y[7] * sc);
        *p = o;
    }
}
namespace gla {
typedef short bf16x8 __attribute__((ext_vector_type(8)));
typedef short s16x4 __attribute__((ext_vector_type(4)));
typedef float f32x4 __attribute__((ext_vector_type(4)));
constexpr int P64 = 144, PV = 272, POT = 528;
constexpr int L_QS = 0, L_KS = 9216, L_VR = 18432, L_AS = 35840, L_ST = 45056, L_OT = 63488, L_SET2 = 97280, L_END = 133120;
constexpr int L_DEC = LC_GDEC;
__device__ __forceinline__ unsigned cvtpk(float lo, float hi) { typedef float f2_t __attribute__((ext_vector_type(2))); typedef __bf16 b2_t __attribute__((ext_vector_type(2))); f2_t v = {lo, hi}; b2_t b = __builtin_convertvector(v, b2_t); return __builtin_bit_cast(unsigned, b); }
__device__ __forceinline__ float logsig(float x) { return fminf(x, 0.f) - __logf(1.f + __expf(-fabsf(x))); }
__device__ __forceinline__ s16x4 vtr(const LAS unsigned char* p) { typedef short v4i16_t __attribute__((ext_vector_type(4))); return __builtin_bit_cast(s16x4, __builtin_amdgcn_ds_read_tr16_b64_v4i16((LAS v4i16_t*)p)); }

__device__ __forceinline__ void gla_prep_unit(Frame& F, int b, int c) {
    LAS unsigned char* L = F.lds;
    const int tid = F.tid, dir = __builtin_amdgcn_readfirstlane(tid >> 8), col = tid & 255;
    const bf16* GQ = (const bf16*)(F.ws + WS_GQ); const bf16* GK = (const bf16*)(F.ws + WS_GK); const bf16* ZZ = (const bf16*)(F.ws + WS_Z);
    bf16* QX = (bf16*)(F.ws + (dir ? WS_QB : WS_QF)); bf16* KX = (bf16*)(F.ws + (dir ? WS_KB : WS_KF)); float* DEC = (float*)(F.ws + WS_DEC) + (size_t)dir * (BATCH * 64 * 256);
    const unsigned row0 = (unsigned)b * SEQ + (unsigned)c * 64u;
    __syncthreads();
    { typedef float f32x16 __attribute__((ext_vector_type(16)));
      const int w_ = F.wave, lane = F.lane, r32 = lane & 31, hi = lane >> 5, colw = 32 * w_ + r32;
#pragma unroll
      for (int d = 0; d < 2; ++d) { const float* WGd = d ? F.w_gb : F.w_gf; const float bgd = (d ? F.b_gb : F.b_gf)[colw];
          float wv[8];
#pragma unroll
          for (int j = 0; j < 8; ++j) wv[j] = WGd[(8 * hi + j) * 256 + colw];
          v4u wh, wl;
          wh.x = pk2(wv[0], wv[1]); wh.y = pk2(wv[2], wv[3]); wh.z = pk2(wv[4], wv[5]); wh.w = pk2(wv[6], wv[7]);
          wl.x = pk2(wv[0] - bflo(wh.x), wv[1] - bfhi(wh.x)); wl.y = pk2(wv[2] - bflo(wh.y), wv[3] - bfhi(wh.y)); wl.z = pk2(wv[4] - bflo(wh.z), wv[5] - bfhi(wh.z)); wl.w = pk2(wv[6] - bflo(wh.w), wv[7] - bfhi(wh.w));
#pragma unroll
          for (int hf = 0; hf < 2; ++hf) { const v4u zf = *(const GAS v4u*)(ZZ + (row0 + 32 * hf + r32) * 32 + d * 16 + 8 * hi);
              f32x16 acc = {};
              acc = __builtin_amdgcn_mfma_f32_32x32x16_bf16(__builtin_bit_cast(bf16x8, zf), __builtin_bit_cast(bf16x8, wh), acc, 0, 0, 0);
              acc = __builtin_amdgcn_mfma_f32_32x32x16_bf16(__builtin_bit_cast(bf16x8, zf), __builtin_bit_cast(bf16x8, wl), acc, 0, 0, 0);
#pragma unroll
              for (int r = 0; r < 16; ++r) { const int pos = 32 * hf + (r & 3) + 8 * (r >> 2) + 4 * hi; *(LAS float*)(L + (size_t)((d * 64 + pos) * 256 + colw) * 4) = logsig(acc[r] + bgd) * (1.f / 16.f); } } } }
    __syncthreads();
    float pf[64]; float run = 0.f;
#pragma unroll
    for (int p = 0; p < 64; ++p) pf[p] = *(const LAS float*)(L + (size_t)((dir * 64 + p) * 256 + col) * 4);
    asm volatile("s_waitcnt lgkmcnt(0)" ::: "memory");
#pragma unroll
    for (int p = 0; p < 64; ++p) { asm volatile("" : "+v"(pf[p])); run += pf[p]; pf[p] = run; }
    const float tot = run;
    const bf16* gqc = GQ + (size_t)row0 * 256 + col; const bf16* gkc = GK + (size_t)row0 * 256 + col; bf16* qxc = QX + (size_t)row0 * 256 + col; bf16* kxc = KX + (size_t)row0 * 256 + col;
    unsigned short qa[16], ka[16], qb[16], kb[16];
#define GP_LOAD(g, qx, kx) do { _Pragma("unroll") for (int i = 0; i < 16; ++i) { qx[i] = gqc[(16 * (g) + i) * 256]; kx[i] = gkc[(16 * (g) + i) * 256]; } } while (0)
#define GP_PROC(g, qx, kx) do { _Pragma("unroll") for (int i = 0; i < 16; ++i) { const int p = 16 * (g) + i; const float qv = bf2f(qx[i]), kv = bf2f(kx[i]); \
        const float ex = dir ? (p ? pf[p ? p - 1 : 0] : 0.f) : 0.f; \
        const float eq = dir ? __expf(-ex) * 0.125f : __expf(pf[p] - tot) * 0.125f; \
        const float ek = dir ? __expf(ex) : __expf(tot - pf[p]); \
        qxc[p * 256] = (bf16)f2bf(qv * eq); kxc[p * 256] = (bf16)f2bf(kv * ek); } } while (0)
    GP_LOAD(0, qa, ka); GP_LOAD(1, qb, kb);
    GP_PROC(0, qa, ka); GP_LOAD(2, qa, ka);
    GP_PROC(1, qb, kb); GP_LOAD(3, qb, kb);
    GP_PROC(2, qa, ka); GP_PROC(3, qb, kb);
#undef GP_LOAD
#undef GP_PROC
    DEC[((unsigned)b * 64 + c) * 256 + col] = __expf(tot);
}

__device__ __forceinline__ void gla_unit(Frame& F, int b, int h, int dir) {
    LAS unsigned char* L = F.lds;
    const int tid = F.tid, lane = F.lane, w = F.wave, q4 = lane >> 4, l15 = lane & 15;
    const bf16* GV = (const bf16*)(F.ws + WS_GV);
    bf16* OX = (bf16*)(F.ws + WS_OF + (dir ? 32 * MiB : 0));
    const unsigned rowbase = (unsigned)b * SEQ;
    const int v0 = 16 * w;
    const int erow = tid >> 3, eseg = tid & 7;
    const int plq = tid >> 3, sgq = tid & 7, plv = tid >> 4, sgv = tid & 15;
    {
        const bf16* QX = (const bf16*)(F.ws + (dir ? WS_QB : WS_QF)); const bf16* KX = (const bf16*)(F.ws + (dir ? WS_KB : WS_KF));
        const float* DEC = (const float*)(F.ws + WS_DEC) + (size_t)dir * (BATCH * 64 * 256);
        f32x4 S[4];
#pragma unroll
        for (int i = 0; i < 4; ++i) S[i] = (f32x4){0.f, 0.f, 0.f, 0.f};
        v4u rq, rk, rv0, rv1; float rdec = 0.f;
#define GLA_LOAD(ci) do { const int c_ = dir ? 63 - (ci) : (ci); const unsigned cb_ = rowbase + (unsigned)c_ * 64u; \
            rq = __builtin_nontemporal_load((const GAS v4u*)(QX + (cb_ + plq) * 256 + h * 64 + sgq * 8)); rk = __builtin_nontemporal_load((const GAS v4u*)(KX + (cb_ + plq) * 256 + h * 64 + sgq * 8)); \
            rv0 = *(const GAS v4u*)(GV + (cb_ + plv) * 512 + h * 128 + sgv * 8); rv1 = *(const GAS v4u*)(GV + (cb_ + plv + 32) * 512 + h * 128 + sgv * 8); \
            if (tid < 64) rdec = DEC[((unsigned)b * 64 + c_) * 256 + h * 64 + tid]; } while (0)
        GLA_LOAD(0);
        v4u st0 = (v4u){0u, 0u, 0u, 0u}, st1 = st0;
#define GLA_FLUSH(cprev) do { const unsigned cbp_ = rowbase + (unsigned)(cprev) * 64u; GAS v4u* sp_ = (GAS v4u*)(OX + (cbp_ + erow) * 512 + h * 128 + eseg * 16); sp_[0] = st0; sp_[1] = st1; } while (0)
#define GLA_STAGE(so) do { *(LAS v4u*)(L + (so) + L_QS + plq * P64 + sgq * 16) = rq; *(LAS v4u*)(L + (so) + L_KS + plq * P64 + sgq * 16) = rk; \
            *(LAS v4u*)(L + (so) + L_VR + plv * PV + sgv * 16) = rv0; *(LAS v4u*)(L + (so) + L_VR + (plv + 32) * PV + sgv * 16) = rv1; \
            if (tid < 64) ((LAS float*)(L + L_DEC))[((so) ? 64 : 0) + tid] = rdec; } while (0)
        __syncthreads();
        GLA_STAGE(0); GLA_LOAD(1);
        __syncthreads();
        for (int ci = 0; ci < 64; ++ci) {
            const int c = dir ? 63 - ci : ci; const int so = (ci & 1) ? L_SET2 : 0, sn = (ci & 1) ? 0 : L_SET2;
#pragma unroll
            for (int s = 0; s < 2; ++s) { const int tt = 2 * w + s, it = tt >> 2, jt = tt & 3; f32x4 a = (f32x4){0.f, 0.f, 0.f, 0.f};
                if (dir ? (jt >= it) : (jt <= it)) {
#pragma unroll
                    for (int ks = 0; ks < 2; ++ks) { const bf16x8 af = *(const LAS bf16x8*)(L + so + L_QS + (16 * it + l15) * P64 + (32 * ks + 8 * q4) * 2); const bf16x8 bfr = *(const LAS bf16x8*)(L + so + L_KS + (16 * jt + l15) * P64 + (32 * ks + 8 * q4) * 2);
                        a = __builtin_amdgcn_mfma_f32_16x16x32_bf16(af, bfr, a, 0, 0, 0); } }
#pragma unroll
                for (int rg = 0; rg < 4; ++rg) { const int i = 16 * it + 4 * q4 + rg, j = 16 * jt + l15; const bool keep = dir ? (j > i) : (j <= i);
                    *(LAS unsigned short*)(L + L_AS + i * P64 + j * 2) = (unsigned short)cvtpk(keep ? a[rg] : 0.f, 0.f); } }
#pragma unroll
            for (int dt = 0; dt < 4; ++dt) { const f32x4 dv = *(const LAS f32x4*)(L + L_DEC + ((ci & 1) ? 256 : 0) + (16 * dt + 4 * q4) * 4); S[dt] = S[dt] * dv;
                *(LAS v2u*)(L + L_ST + (v0 + l15) * P64 + (16 * dt + 4 * q4) * 2) = (v2u){cvtpk(S[dt].x, S[dt].y), cvtpk(S[dt].z, S[dt].w)}; }
            __syncthreads();
            bf16x8 bv[2], bs[2];
#pragma unroll
            for (int ks = 0; ks < 2; ++ks) { const LAS unsigned char* vp = L + so + L_VR + (32 * ks + 8 * q4 + (l15 >> 2)) * PV + (v0 + 4 * (l15 & 3)) * 2;
                const s16x4 lo = vtr(vp), hi = vtr(vp + 4 * PV); bv[ks] = (bf16x8){lo[0], lo[1], lo[2], lo[3], hi[0], hi[1], hi[2], hi[3]};
                bs[ks] = *(const LAS bf16x8*)(L + L_ST + (v0 + l15) * P64 + (32 * ks + 8 * q4) * 2); }
            f32x4 O[4];
#pragma unroll
            for (int it = 0; it < 4; ++it) { O[it] = (f32x4){0.f, 0.f, 0.f, 0.f};
#pragma unroll
                for (int ks = 0; ks < 2; ++ks) { const bf16x8 aq = *(const LAS bf16x8*)(L + so + L_QS + (16 * it + l15) * P64 + (32 * ks + 8 * q4) * 2);
                    if (dir ? !(ks == 0 && it >= 2) : !(ks == 1 && it < 2)) {
                        const bf16x8 aa = *(const LAS bf16x8*)(L + L_AS + (16 * it + l15) * P64 + (32 * ks + 8 * q4) * 2); O[it] = __builtin_amdgcn_mfma_f32_16x16x32_bf16(aa, bv[ks], O[it], 0, 0, 0); }
                    O[it] = __builtin_amdgcn_mfma_f32_16x16x32_bf16(aq, bs[ks], O[it], 0, 0, 0); } }
#pragma unroll
            for (int dt = 0; dt < 4; ++dt)
#pragma unroll
                for (int ks = 0; ks < 2; ++ks) { const LAS unsigned char* kp = L + so + L_KS + (32 * ks + 8 * q4 + (l15 >> 2)) * P64 + (16 * dt + 4 * (l15 & 3)) * 2;
                    const s16x4 lo = vtr(kp), hi = vtr(kp + 4 * P64); const bf16x8 ak = (bf16x8){lo[0], lo[1], lo[2], lo[3], hi[0], hi[1], hi[2], hi[3]};
                    S[dt] = __builtin_amdgcn_mfma_f32_16x16x32_bf16(ak, bv[ks], S[dt], 0, 0, 0); }
#pragma unroll
            for (int it = 0; it < 4; ++it)
#pragma unroll
                for (int rg = 0; rg < 4; ++rg) *(LAS float*)(L + L_OT + (16 * it + 4 * q4 + rg) * POT + (v0 + l15) * 4) = O[it][rg];
            if (ci + 1 < 64) GLA_STAGE(sn);
            asm volatile("" ::: "memory");
            if (ci > 0) GLA_FLUSH(dir ? c + 1 : c - 1);
            asm volatile("" ::: "memory");
            if (ci + 2 < 64) GLA_LOAD(ci + 2);
            __syncthreads();
            {
                float o[16];
#pragma unroll
                for (int e4 = 0; e4 < 4; ++e4) { const f32x4 t = *(const LAS f32x4*)(L + L_OT + erow * POT + (16 * eseg + 4 * e4) * 4); o[4 * e4] = t.x; o[4 * e4 + 1] = t.y; o[4 * e4 + 2] = t.z; o[4 * e4 + 3] = t.w; }
                st0 = (v4u){cvtpk(o[0], o[1]), cvtpk(o[2], o[3]), cvtpk(o[4], o[5]), cvtpk(o[6], o[7])}; st1 = (v4u){cvtpk(o[8], o[9]), cvtpk(o[10], o[11]), cvtpk(o[12], o[13]), cvtpk(o[14], o[15])};
            }
        }
        GLA_FLUSH(dir ? 0 : 63);
#undef GLA_STAGE
#undef GLA_FLUSH
#undef GLA_LOAD
    }
    VM_WAIT(); __syncthreads();
    if (tid == 0) { __builtin_amdgcn_fence(__ATOMIC_RELEASE, "agent"); VM_WAIT(); (void)__hip_atomic_fetch_add(F.ctl + CW_GDN + 64 * (b * GLA_H + h), 1u, RLX_AGENT); }
    __syncthreads();
}
__device__ __forceinline__ void gla_combine(Frame& F, int b, int h, int part) {
    const int tid = F.tid, erow = tid >> 3, eseg = tid & 7;
    if (tid == 0) { unsigned sp = 0; while (__hip_atomic_load(F.ctl + CW_GDN + 64 * (b * GLA_H + h), RLX_AGENT) < 2u && sp < (1u << 22)) { __builtin_amdgcn_s_sleep(8); ++sp; }
        __builtin_amdgcn_fence(__ATOMIC_ACQUIRE, "agent"); VM_WAIT(); }
    __syncthreads();
    const bf16* OF0 = (const bf16*)(F.ws + WS_OF); const bf16* OB0 = (const bf16*)(F.ws + WS_OF + 32 * MiB); const bf16* GR = (const bf16*)(F.ws + WS_GR); bf16* MIX = (bf16*)(F.ws + WS_MIX);
    float hg[16]; int eso = eseg; asm volatile("" : "+v"(eso));
#pragma unroll
    for (int e = 0; e < 16; ++e) hg[e] = F.gla_hg[16 * eso + e];
    const unsigned r0 = (unsigned)b * SEQ + (unsigned)part * 1024u + erow;
#pragma unroll 2
    for (int ps = 0; ps < 16; ++ps) { const unsigned row = r0 + ps * 64;
        const GAS v4u* fp = (const GAS v4u*)(OF0 + row * 512 + h * 128 + eseg * 16); const GAS v4u* bp = (const GAS v4u*)(OB0 + row * 512 + h * 128 + eseg * 16); const GAS v4u* rp = (const GAS v4u*)(GR + row * 512 + h * 128 + eseg * 16);
        const v4u f0 = __builtin_nontemporal_load(fp), f1 = __builtin_nontemporal_load(fp + 1), b0 = __builtin_nontemporal_load(bp), b1 = __builtin_nontemporal_load(bp + 1), r0v = __builtin_nontemporal_load(rp), r1v = __builtin_nontemporal_load(rp + 1);
        const unsigned fw[8] = {f0.x, f0.y, f0.z, f0.w, f1.x, f1.y, f1.z, f1.w}, bw[8] = {b0.x, b0.y, b0.z, b0.w, b1.x, b1.y, b1.z, b1.w}, rw[8] = {r0v.x, r0v.y, r0v.z, r0v.w, r1v.x, r1v.y, r1v.z, r1v.w};
        float o[16]; float ss = 0.f;
#pragma unroll
        for (int e2 = 0; e2 < 8; ++e2) { o[2 * e2] = bflo(fw[e2]) + bflo(bw[e2]); o[2 * e2 + 1] = bfhi(fw[e2]) + bfhi(bw[e2]); ss += o[2 * e2] * o[2 * e2] + o[2 * e2 + 1] * o[2 * e2 + 1]; }
        ss += __shfl_xor(ss, 1); ss += __shfl_xor(ss, 2); ss += __shfl_xor(ss, 4);
        const float rinv = __builtin_amdgcn_rsqf(ss * (1.f / 128.f) + EPS);
        unsigned ow[8];
#pragma unroll
        for (int e2 = 0; e2 < 8; ++e2) { const float x0 = bflo(rw[e2]), x1 = bfhi(rw[e2]);
            const float y0 = o[2 * e2] * rinv * hg[2 * e2] * (x0 * __builtin_amdgcn_rcpf(1.f + __expf(-x0))), y1 = o[2 * e2 + 1] * rinv * hg[2 * e2 + 1] * (x1 * __builtin_amdgcn_rcpf(1.f + __expf(-x1))); ow[e2] = cvtpk(y0, y1); }
        GAS v4u* mp = (GAS v4u*)(MIX + row * 1024 + h * 128 + eseg * 16);
        mp[0] = (v4u){ow[0], ow[1], ow[2], ow[3]}; mp[1] = (v4u){ow[4], ow[5], ow[6], ow[7]}; }
}
}
struct DenseMap { static constexpr bool GATHER = false;
    const bf16* A; const bf16* Bt; int K;
    __device__ __forceinline__ __amdgpu_buffer_rsrc_t a_rsrc() const { return __builtin_amdgcn_make_buffer_rsrc((void*)A, 0, 0x7fffffff, 0x00020000); }
    __device__ __forceinline__ __amdgpu_buffer_rsrc_t b_rsrc() const { return __builtin_amdgcn_make_buffer_rsrc((void*)Bt, 0, 0x7fffffff, 0x00020000); }
    __device__ __forceinline__ unsigned a_soff(const pg8::Unit& u) const { return (unsigned)u.pm * 256u * (unsigned)K * 2u; }
    __device__ __forceinline__ unsigned b_soff(const pg8::Unit& u) const { return (unsigned)u.pn * 256u * (unsigned)K * 2u; }
    __device__ __forceinline__ void a_off(const pg8::Unit&, const int (&R)[2], const int (&C)[2], unsigned (&vo)[2][2]) const {
#pragma unroll
        for (int h = 0; h < 2; ++h)
#pragma unroll
            for (int i = 0; i < 2; ++i) vo[h][i] = (unsigned)((h * 128 + R[i]) * K + C[i]) * 2u; }
};
struct MoeTabs { const LAS int* cnt; const LAS int* cst; const LAS unsigned short* te; };
struct MoeMapUp { static constexpr bool GATHER = true;
    const unsigned char* A; const unsigned char* Bt; const int* rowtok; MoeTabs tb;
    __device__ __forceinline__ __amdgpu_buffer_rsrc_t a_rsrc() const { return __builtin_amdgcn_make_buffer_rsrc((void*)A, 0, 0x7fffffff, 0x00020000); }
    __device__ __forceinline__ __amdgpu_buffer_rsrc_t b_rsrc() const { return __builtin_amdgcn_make_buffer_rsrc((void*)Bt, 0, 0x7fffffff, 0x00020000); }
    __device__ __forceinline__ unsigned a_soff(const pg8::Unit&) const { return 0u; }
    __device__ __forceinline__ unsigned b_soff(const pg8::Unit& u) const { const unsigned e = tb.te[u.pm]; return (e * 2048u + (unsigned)u.pn * 256u) * 1024u; }
    __device__ __forceinline__ void a_raw(const pg8::Unit& u, const int (&R)[2], unsigned (&raw)[2][2]) const {
        const int e = tb.te[u.pm], pos0 = (u.pm - tb.cst[e]) * 256, n = tb.cnt[e];
#pragma unroll
        for (int h = 0; h < 2; ++h)
#pragma unroll
            for (int i = 0; i < 2; ++i) { const int pos = pos0 + h * 128 + R[i]; raw[h][i] = (unsigned)rowtok[(size_t)e * EROWS + (pos < n ? pos : 0)]; } }
    __device__ __forceinline__ unsigned a_fin(unsigned tok, int C) const { return (tok * 512u + (unsigned)C) * 2u; }
    __device__ __forceinline__ void a_off(const pg8::Unit& u, const int (&R)[2], const int (&C)[2], unsigned (&vo)[2][2]) const {
        unsigned raw[2][2]; a_raw(u, R, raw);
#pragma unroll
        for (int h = 0; h < 2; ++h)
#pragma unroll
            for (int i = 0; i < 2; ++i) vo[h][i] = a_fin(raw[h][i], C[i]); }
};
struct MoeMapDown { static constexpr bool GATHER = false;
    const unsigned char* A; const unsigned char* Bt; MoeTabs tb;
    __device__ __forceinline__ __amdgpu_buffer_rsrc_t a_rsrc() const { return __builtin_amdgcn_make_buffer_rsrc((void*)A, 0, 0x7fffffff, 0x00020000); }
    __device__ __forceinline__ __amdgpu_buffer_rsrc_t b_rsrc() const { return __builtin_amdgcn_make_buffer_rsrc((void*)Bt, 0, 0x7fffffff, 0x00020000); }
    __device__ __forceinline__ unsigned a_soff(const pg8::Unit& u) const { return (unsigned)u.pm * 256u * 1024u; }
    __device__ __forceinline__ unsigned b_soff(const pg8::Unit& u) const { const unsigned e = tb.te[u.pm]; return (e * 1024u + (unsigned)u.pn * 256u) * 1024u; }
    __device__ __forceinline__ void a_off(const pg8::Unit&, const int (&R)[2], const int (&C)[2], unsigned (&vo)[2][2]) const {
#pragma unroll
        for (int h = 0; h < 2; ++h)
#pragma unroll
            for (int i = 0; i < 2; ++i) vo[h][i] = (unsigned)((h * 128 + R[i]) * 512 + C[i]) * 2u; }
};
using pg8::f32x4;
struct EpiInProj { static constexpr bool PERM = true, COLS64 = false;
    bf16 *gq, *gk, *gv, *gr, *aq, *ak, *av, *z;
    struct Pre {}; __device__ __forceinline__ void preload(const pg8::Unit&, int, int, int, int, Pre&) const {}
    __device__ __forceinline__ void operator()(const f32x4 (&acc)[2][2][4][2], const pg8::Unit& u, const Pre&, int wr, int wc, int fr, int fq) const {
        bf16* b0; bf16* b1; int ld;
        switch (u.pn) { case 0: b0 = gq; b1 = gq + 128; ld = 256; break; case 1: b0 = gk; b1 = gk + 128; ld = 256; break;
            case 2: b0 = gv; b1 = gv + 128; ld = 512; break; case 3: b0 = gv + 256; b1 = gv + 384; ld = 512; break;
            case 4: b0 = gr; b1 = gr + 128; ld = 512; break; case 5: b0 = gr + 256; b1 = gr + 384; ld = 512; break;
            case 6: b0 = aq; b1 = aq + 128; ld = 512; break; case 7: b0 = aq + 256; b1 = aq + 384; ld = 512; break;
            case 8: b0 = ak; b1 = av; ld = 128; break; default: b0 = z; b1 = z; ld = 32; break; }
        const bool zt = (u.pn == 9);
        if (zt && wc != 0) return;
        const int row0 = u.pm * 256 + wr * 64 + fr, cw = wc * 32 + 8 * fq;
#pragma unroll
        for (int ai = 0; ai < 2; ++ai)
#pragma unroll
            for (int m = 0; m < 4; ++m) { const size_t row = (size_t)(row0 + ai * 128 + m * 16);
#pragma unroll
                for (int bj = 0; bj < 2; ++bj) { if (zt && bj == 1) continue; const f32x4 v0 = acc[ai][bj][m][0], v1 = acc[ai][bj][m][1];
                    pg8::u32x4 wv; wv.x = pg8::cvt_pk_bf16(v0[0], v0[1]); wv.y = pg8::cvt_pk_bf16(v0[2], v0[3]); wv.z = pg8::cvt_pk_bf16(v1[0], v1[1]); wv.w = pg8::cvt_pk_bf16(v1[2], v1[3]);
                    *(pg8::u32x4*)((bj ? b1 : b0) + row * ld + cw) = wv; } }
    }
};
struct EpiResF32 { static constexpr bool PERM = false, COLS64 = false;
    const float* base; bf16* out;
    struct Pre {}; __device__ __forceinline__ void preload(const pg8::Unit&, int, int, int, int, Pre&) const {}
    __device__ __forceinline__ void operator()(const f32x4 (&acc)[2][2][4][2], const pg8::Unit& u, const Pre&, int wr, int wc, int fr, int fq) const {
        const int col0 = u.pn * 256 + wc * 32 + 4 * fq;
#pragma unroll
        for (int ai = 0; ai < 2; ++ai)
#pragma unroll
            for (int m = 0; m < 4; ++m) { const size_t off = (size_t)(u.pm * 256 + ai * 128 + wr * 64 + m * 16 + fr) * 1024 + col0;
#pragma unroll
                for (int bj = 0; bj < 2; ++bj)
#pragma unroll
                    for (int n = 0; n < 2; ++n) { const f32x4 bs = *(const f32x4*)(base + off + bj * 128 + n * 16); const f32x4 hv = bs + acc[ai][bj][m][n]; *(v2u*)(out + off + bj * 128 + n * 16) = (v2u){pk2(hv.x, hv.y), pk2(hv.z, hv.w)}; } }
    }
};
struct EpiSwiglu { static constexpr bool PERM = true, COLS64 = false;
    const float* b1; unsigned char* act; MoeTabs tb;
    struct Pre { f32x4 g0, g1, l0, l1; };
    __device__ __forceinline__ void preload(const pg8::Unit& u, int wr, int wc, int fr, int fq, Pre& p) const {
        const int e = tb.te[u.pm]; const int col = u.pn * 128 + wc * 32 + 8 * fq; const float* bg = b1 + (size_t)e * 2048 + col; const float* bl = bg + 1024;
        p.g0 = *(const GAS f32x4*)bg; p.g1 = *(const GAS f32x4*)(bg + 4); p.l0 = *(const GAS f32x4*)bl; p.l1 = *(const GAS f32x4*)(bl + 4); }
    __device__ __forceinline__ void operator()(const f32x4 (&acc)[2][2][4][2], const pg8::Unit& u, const Pre& p, int wr, int wc, int fr, int fq) const {
        const int col = u.pn * 128 + wc * 32 + 8 * fq;
        const f32x4 g0 = p.g0, g1 = p.g1, l0 = p.l0, l1 = p.l1;
        const int row0 = u.pm * 256 + wr * 64 + fr;
        const bool odd = (fq & 1) != 0;
        unsigned char* dstb = act + (size_t)(row0 + (odd ? 16 : 0)) * 1024 + (odd ? col - 8 : col);
#pragma unroll
        for (int ai = 0; ai < 2; ++ai)
#pragma unroll
            for (int mp = 0; mp < 2; ++mp) { unsigned wd[2][2];
#pragma unroll
                for (int q = 0; q < 2; ++q) { const int m = 2 * mp + q; float o[8];
#pragma unroll
                    for (int n = 0; n < 2; ++n)
#pragma unroll
                        for (int j = 0; j < 4; ++j) { const float gl = fminf(__builtin_fmaf(acc[ai][0][m][n][j], 1.f / WSCALE, (n ? g1[j] : g0[j])), 7.f); const float li = __builtin_amdgcn_fmed3f(__builtin_fmaf(acc[ai][1][m][n][j], 1.f / WSCALE, (n ? l1[j] : l0[j])), -7.f, 7.f);
                            o[4 * n + j] = (gl * ASCALE) * __builtin_amdgcn_rcpf(1.f + __builtin_amdgcn_exp2f(gl * (-1.702f * 1.4426950408889634f))) * (li + 1.f); }
                    int w0 = 0, w1 = 0;
                    w0 = __builtin_amdgcn_cvt_pk_fp8_f32(o[0], o[1], w0, false); w0 = __builtin_amdgcn_cvt_pk_fp8_f32(o[2], o[3], w0, true); w1 = __builtin_amdgcn_cvt_pk_fp8_f32(o[4], o[5], w1, false); w1 = __builtin_amdgcn_cvt_pk_fp8_f32(o[6], o[7], w1, true);
                    wd[q][0] = (unsigned)w0; wd[q][1] = (unsigned)w1; }
                auto x0 = __builtin_amdgcn_permlane16_swap(wd[0][0], wd[1][0], false, false); auto x1 = __builtin_amdgcn_permlane16_swap(wd[0][1], wd[1][1], false, false);
                *(pg8::u32x4*)(dstb + (size_t)(ai * 128 + mp * 32) * 1024) = (pg8::u32x4){x0[0], x1[0], x0[1], x1[1]}; }
    }
};
struct EpiDown { static constexpr bool PERM = true, COLS64 = true;
    const float* b2; const float* rowgate; unsigned char* y; MoeTabs tb;
    struct Pre { f32x4 bv[2][2]; float gt[8]; };
    __device__ __forceinline__ void preload(const pg8::Unit& u, int wr, int wc, int fr, int fq, Pre& p) const {
        const int e = tb.te[u.pm], pos0 = (u.pm - tb.cst[e]) * 256, n_e = tb.cnt[e];
        const float* bb = b2 + (size_t)e * 1024 + u.pn * 256 + wc * 64 + 8 * fq;
#pragma unroll
        for (int bj = 0; bj < 2; ++bj)
#pragma unroll
            for (int n = 0; n < 2; ++n) p.bv[bj][n] = *(const GAS f32x4*)(bb + bj * 32 + 4 * n);
#pragma unroll
        for (int ai = 0; ai < 2; ++ai)
#pragma unroll
            for (int m = 0; m < 4; ++m) { const int pos = pos0 + wr * 64 + fr + ai * 128 + m * 16; const int pc_ = pos < n_e ? pos : 0; const float g = rowgate[(size_t)e * EROWS + pc_]; p.gt[ai * 4 + m] = (pos < n_e) ? g * YSCALE : 0.f; }
    }
    __device__ __forceinline__ void operator()(const f32x4 (&acc)[2][2][4][2], const pg8::Unit& u, const Pre& p, int wr, int wc, int fr, int fq) const {
        const bool odd = (fq & 1) != 0;
        const int colb = u.pn * 256 + wc * 64 + (odd ? 32 + 8 * (fq - 1) : 8 * fq), rl0 = wr * 64 + fr;
#pragma unroll
        for (int ai = 0; ai < 2; ++ai)
#pragma unroll
            for (int m = 0; m < 4; ++m) { const int rl = rl0 + ai * 128 + m * 16; const float gt = p.gt[ai * 4 + m];
                unsigned w[2][2];
#pragma unroll
                for (int bj = 0; bj < 2; ++bj) { const f32x4 v0 = (acc[ai][bj][m][0] * (1.f / (WSCALE * ASCALE)) + p.bv[bj][0]) * gt, v1 = (acc[ai][bj][m][1] * (1.f / (WSCALE * ASCALE)) + p.bv[bj][1]) * gt;
                    int w0 = 0, w1 = 0;
                    w0 = __builtin_amdgcn_cvt_pk_fp8_f32(v0[0], v0[1], w0, false); w0 = __builtin_amdgcn_cvt_pk_fp8_f32(v0[2], v0[3], w0, true); w1 = __builtin_amdgcn_cvt_pk_fp8_f32(v1[0], v1[1], w1, false); w1 = __builtin_amdgcn_cvt_pk_fp8_f32(v1[2], v1[3], w1, true);
                    w[bj][0] = (unsigned)w0; w[bj][1] = (unsigned)w1; }
                auto x0 = __builtin_amdgcn_permlane16_swap(w[0][0], w[1][0], false, false); auto x1 = __builtin_amdgcn_permlane16_swap(w[0][1], w[1][1], false, false);
                const pg8::u32x4 ov = (pg8::u32x4){x0[0], x1[0], x0[1], x1[1]};
                *(pg8::u32x4*)(y + (size_t)(u.pm * 256 + rl) * 1024 + colb) = ov; }
    }
};
__device__ __forceinline__ int moe_tables(Frame& F) {
    LAS int* cnt = (LAS int*)(F.lds + LC_CNT); LAS int* cst = (LAS int*)(F.lds + LC_CST); LAS unsigned short* te = (LAS unsigned short*)(F.lds + LC_TE);
    __syncthreads();
    if (F.tid < NEXP) cnt[F.tid] = (int)__hip_atomic_load(F.ctl + CW_CNT + 64 * F.tid, RLX_AGENT);
    __syncthreads();
    if (F.tid == 0) { int s = 0; for (int e = 0; e < NEXP; ++e) { cst[e] = s; s += (cnt[e] + 255) >> 8; } cst[NEXP] = s; }
    __syncthreads();
    const int nt = cst[NEXP];
    for (int t = F.tid; t < nt; t += NWAVES * 64) { int e = 0;
#pragma unroll 1
        for (int k = 1; k < NEXP; ++k) e = (t >= cst[k]) ? k : e;
        te[t] = (unsigned short)e; }
    __syncthreads();
    return nt;
}
__device__ __forceinline__ void p3_mixers(Frame& F) {
    for (int u = blockIdx.x; u < 2 * BATCH * GLA_H; u += F.G) gla::gla_unit(F, u & 7, (u >> 3) & 3, u >> 5);
    if (blockIdx.x < 2 * BATCH * GLA_H) { while (conv_pull(F)) {} }
    const attn_body::bf16* Q = (const attn_body::bf16*)(F.ws + WS_AQ); const attn_body::bf16* K = (const attn_body::bf16*)(F.ws + WS_AK); const attn_body::bf16* V = (const attn_body::bf16*)(F.ws + WS_AV);
    attn_body::bf16* O = (attn_body::bf16*)(F.ws + WS_MIX);
    const int x0 = blockIdx.x & 7;
    float sbound;
    { float mq = fabsf(F.q_g[F.lane]), mk = fabsf(F.k_g[F.lane]);
#pragma unroll
      for (int o_ = 1; o_ < 64; o_ <<= 1) { mq = fmaxf(mq, __shfl_xor(mq, o_)); mk = fmaxf(mk, __shfl_xor(mk, o_)); }
      sbound = __builtin_bit_cast(float, __builtin_amdgcn_readfirstlane(__builtin_bit_cast(int, 64.f * attn_body::C2 * mq * mk * 1.02f))); }
    for (int qi = 0; qi < 8; ++qi) { const int x = (x0 + qi) & 7;
        for (;;) {
            __syncthreads();
            if (F.tid == 0) F.MISC[16] = __hip_atomic_fetch_add(F.ctl + CW_QUE + 64 * x, 1u, RLX_AGENT);
            __syncthreads();
            const int item = __builtin_amdgcn_readfirstlane((int)F.MISC[16]);
            if (item >= ATT_H * attn_body::NQB + 4 * GLA_H) break;
            if (item >= ATT_H * attn_body::NQB) { const int k = item - ATT_H * attn_body::NQB; gla::gla_combine(F, x, k >> 2, k & 3); continue; }
            attn_body::attn_unit<8>(x, item >> 4, item & 15, Q, K, V, O, (char*)F.lds, F.q_g, sbound);
        }
    }
    while (conv_pull(F)) {}
    __syncthreads();
}

__device__ __forceinline__ void p5_route(Frame& F) {
    typedef float f32x16 __attribute__((ext_vector_type(16)));
    LAS unsigned char* L = F.lds;
    constexpr int XP = 2064, L_XH = 0, L_XL = 32 * XP, L_PART = 0;
    const int tid = F.tid, lane = F.lane, w = F.wave, r32 = lane & 31, hi = lane >> 5;
    const bf16* WRH = (const bf16*)(F.ws + WS_WRH); const bf16* WRL = (const bf16*)(F.ws + WS_WRL);
    unsigned char* XN8 = F.ws + WS_XN;
    int* ROWTOK = (int*)(F.ws + WS_ROWTOK); float* ROWGATE = (float*)(F.ws + WS_ROWGATE); int* TOKASG = (int*)(F.ws + WS_TOKASG);
    gu32* CNT = F.ctl + CW_CNT;
    bf16x8 wh[8], wl[8];
#pragma unroll
    for (int ks = 0; ks < 8; ++ks) { const int k0 = 128 * w + 16 * ks + 8 * hi; wh[ks] = *(const GAS bf16x8*)(WRH + r32 * 1024 + k0); wl[ks] = *(const GAS bf16x8*)(WRL + r32 * 1024 + k0); }
    f32x4 g2[4];
#pragma unroll
    for (int j = 0; j < 4; ++j) g2[j] = *((const GAS f32x4*)F.ffn_g + lane + 64 * j);
    float brt[16];
#pragma unroll
    for (int r = 0; r < 16; ++r) brt[r] = F.b_router[(r & 3) + 8 * (r >> 2) + 4 * hi];
    LAS int* hist = (LAS int*)(L + LC_HIST); LAS int* basev = (LAS int*)(L + LC_BASE); LAS int* aep = (LAS int*)(L + LC_ASG); LAS float* agt = (LAS float*)(L + LC_ASG + 4096);
    constexpr int NGRP = T / 32;
    const int per = (NGRP + F.G - 1) / F.G, g0 = F.vcu * per, g1 = (g0 + per < NGRP) ? g0 + per : NGRP;
    for (int gb = g0; gb < g1; gb += 8) {
        const int nb = (g1 - gb < 8) ? g1 - gb : 8;
        __syncthreads();
        if (tid < NEXP) hist[tid] = 0;
        v2u hv[4][4];
#define P5_LOADG(g) do { _Pragma("unroll") for (int rr = 0; rr < 4; ++rr) { const GAS v2u* hp = (const GAS v2u*)((const bf16*)(F.ws + WS_H16) + (size_t)(32 * (g) + 4 * w + rr) * 1024) + lane; \
            _Pragma("unroll") for (int j = 0; j < 4; ++j) hv[rr][j] = __builtin_nontemporal_load(hp + 64 * j); } } while (0)
#define P5_BAR() asm volatile("s_waitcnt lgkmcnt(0)\n\ts_barrier" ::: "memory")
        P5_LOADG(gb);
        for (int bi = 0; bi < nb; ++bi) {
            const int t0 = 32 * (gb + bi);
#pragma unroll
            for (int rr = 0; rr < 4; ++rr) { const int r = 4 * w + rr; const size_t tok = (size_t)(t0 + r);
                f32x4 v[4]; float s = 0.f;
#pragma unroll
                for (int j = 0; j < 4; ++j) { v[j] = (f32x4){bflo(hv[rr][j].x), bfhi(hv[rr][j].x), bflo(hv[rr][j].y), bfhi(hv[rr][j].y)}; s += (v[j].x * v[j].x + v[j].y * v[j].y) + (v[j].z * v[j].z + v[j].w * v[j].w); }
                const float rinv = 1.f / sqrtf(wave_sum(s) * (1.f / 1024.f) + EPS);
                GAS unsigned* o4 = (GAS unsigned*)(XN8 + tok * 1024) + lane;
#pragma unroll
                for (int j = 0; j < 4; ++j) { const f32x4 xn = v[j] * rinv * g2[j];
                    const v2u hw = (v2u){pk2(xn.x, xn.y), pk2(xn.z, xn.w)};
                    const v2u lw = (v2u){pk2(xn.x - bflo(hw.x), xn.y - bfhi(hw.x)), pk2(xn.z - bflo(hw.y), xn.w - bfhi(hw.y))};
                    { int q8 = 0; q8 = __builtin_amdgcn_cvt_pk_fp8_f32(xn.x, xn.y, q8, false); q8 = __builtin_amdgcn_cvt_pk_fp8_f32(xn.z, xn.w, q8, true); o4[64 * j] = (unsigned)q8; }
                    *(LAS v2u*)(L + L_XH + r * XP + (4 * lane + 256 * j) * 2) = hw; *(LAS v2u*)(L + L_XL + r * XP + (4 * lane + 256 * j) * 2) = lw; } }
            if (bi + 1 < nb) P5_LOADG(gb + bi + 1);
            P5_BAR();
            f32x16 acc = {};
#pragma unroll
            for (int ks = 0; ks < 8; ++ks) { const int k0 = 128 * w + 16 * ks + 8 * hi;
                const bf16x8 xh = *(const LAS bf16x8*)(L + L_XH + r32 * XP + k0 * 2), xl = *(const LAS bf16x8*)(L + L_XL + r32 * XP + k0 * 2);
                acc = __builtin_amdgcn_mfma_f32_32x32x16_bf16(wh[ks], xh, acc, 0, 0, 0); acc = __builtin_amdgcn_mfma_f32_32x32x16_bf16(wh[ks], xl, acc, 0, 0, 0); acc = __builtin_amdgcn_mfma_f32_32x32x16_bf16(wl[ks], xh, acc, 0, 0, 0); }
            P5_BAR();
#pragma unroll
            for (int r = 0; r < 16; ++r) { const int e = (r & 3) + 8 * (r >> 2) + 4 * hi; ((LAS float*)(L + L_PART))[(w * 32 + e) * 32 + r32] = acc[r]; }
            P5_BAR();
            if (w == 0) {
                float v[16];
#pragma unroll
                for (int r = 0; r < 16; ++r) { const int e = (r & 3) + 8 * (r >> 2) + 4 * hi; float s = brt[r];
#pragma unroll
                    for (int ww = 0; ww < 8; ++ww) s += ((const LAS float*)(L + L_PART))[(ww * 32 + e) * 32 + r32];
                    v[r] = s; }
                float cv[8]; int cidx[8];
#pragma unroll
                for (int s = 0; s < 4; ++s) { float m = -INFINITY; int mr = 0;
#pragma unroll
                    for (int r = 0; r < 16; ++r) { if (v[r] > m) { m = v[r]; mr = r; } }
                    cv[s] = m; cidx[s] = (mr & 3) + 8 * (mr >> 2) + 4 * hi;
#pragma unroll
                    for (int r = 0; r < 16; ++r) v[r] = (r == mr) ? -INFINITY : v[r]; }
#pragma unroll
                for (int s = 0; s < 4; ++s) { cv[4 + s] = __shfl_xor(cv[s], 32); cidx[4 + s] = __shfl_xor(cidx[s], 32); }
                float tv[4]; int ti[4];
#pragma unroll
                for (int s = 0; s < 4; ++s) { float m = -INFINITY; int mi = 1 << 20; int mc = 0;
#pragma unroll
                    for (int c = 0; c < 8; ++c) { const bool better = (cv[c] > m) || (cv[c] == m && cidx[c] < mi); if (better) { m = cv[c]; mi = cidx[c]; mc = c; } }
                    tv[s] = m; ti[s] = mi;
#pragma unroll
                    for (int c = 0; c < 8; ++c) cv[c] = (c == mc) ? -INFINITY : cv[c]; }
                const float e1 = __expf(tv[1] - tv[0]), e2 = __expf(tv[2] - tv[0]), e3 = __expf(tv[3] - tv[0]); const float inv = 1.f / (1.f + e1 + e2 + e3);
                const float gt[4] = {inv, e1 * inv, e2 * inv, e3 * inv};
                if (hi == 0) {
#pragma unroll
                    for (int s = 0; s < 4; ++s) { const int rank = (int)__hip_atomic_fetch_add(hist + ti[s], 1, __ATOMIC_RELAXED, __HIP_MEMORY_SCOPE_WORKGROUP); const int idx = (bi * 32 + r32) * 4 + s; aep[idx] = (ti[s] << 16) | rank; agt[idx] = gt[s]; } }
            }
            P5_BAR();
        }
#undef P5_LOADG
#undef P5_BAR
        if (tid < NEXP) { const int hc = hist[tid]; basev[tid] = hc ? (int)__hip_atomic_fetch_add(CNT + 64 * tid, (unsigned)hc, RLX_AGENT) : 0; }
        __syncthreads();
        for (int idx = tid; idx < nb * 128; idx += NWAVES * 64) { const int ep = aep[idx], e = ep >> 16, pos = basev[e] + (ep & 0xffff); const int tok = 32 * gb + (idx >> 2), s = idx & 3;
            ROWTOK[(size_t)e * EROWS + pos] = tok; ROWGATE[(size_t)e * EROWS + pos] = agt[idx]; TOKASG[tok * 4 + s] = e * EROWS + pos; }
    }
    __syncthreads();
}

__device__ __forceinline__ void p8_combine(Frame& F) {
    const LAS int* cst = (const LAS int*)(F.lds + LC_CST);
    const int gw = F.vcu * NWAVES + F.wave, NGW = F.G * NWAVES, lane = F.lane;
    const int* TOKASG = (const int*)(F.ws + WS_TOKASG); const unsigned char* Y = F.ws + WS_Y;
    f32x4 fg[4];
#pragma unroll
    for (int j = 0; j < 4; ++j) fg[j] = *((const GAS f32x4*)F.fin_g + lane + 64 * j);
    for (int tok = gw; tok < T; tok += NGW) {
        const int a = TOKASG[tok * 4 + (lane & 3)];
        const int crow = cst[a >> 15] * 256 + (a & (EROWS - 1));
        GAS f32x4* hp = (GAS f32x4*)(F.out + (size_t)tok * 1024) + lane; f32x4 v[4];
        const GAS v2u* hb = (const GAS v2u*)((const bf16*)(F.ws + WS_H16) + (size_t)tok * 1024) + lane;
#pragma unroll
        for (int j = 0; j < 4; ++j) { const v2u hw = __builtin_nontemporal_load(hb + 64 * j); v[j] = (f32x4){bflo(hw.x), bfhi(hw.x), bflo(hw.y), bfhi(hw.y)}; }
#pragma unroll
        for (int s = 0; s < 4; ++s) { const int cr = __shfl(crow, s); const GAS unsigned* yp = (const GAS unsigned*)(Y + (size_t)cr * 1024) + lane;
#pragma unroll
            for (int j = 0; j < 4; ++j) { const unsigned yw = __builtin_nontemporal_load(yp + 64 * j); const auto lo = __builtin_amdgcn_cvt_pk_f32_fp8((int)yw, false), hi = __builtin_amdgcn_cvt_pk_f32_fp8((int)yw, true);
                v[j].x += lo[0] * (1.f / YSCALE); v[j].y += lo[1] * (1.f / YSCALE); v[j].z += hi[0] * (1.f / YSCALE); v[j].w += hi[1] * (1.f / YSCALE); } }
        float ss = 0.f;
#pragma unroll
        for (int j = 0; j < 4; ++j) ss += (v[j].x * v[j].x + v[j].y * v[j].y) + (v[j].z * v[j].z + v[j].w * v[j].w);
        const float rinv = 1.f / sqrtf(wave_sum(ss) * (1.f / 1024.f) + EPS);
#pragma unroll
        for (int j = 0; j < 4; ++j) __builtin_nontemporal_store(v[j] * rinv * fg[j], hp + 64 * j);
    }
}
#ifndef MK_N_LAUNCHES
#define MK_N_LAUNCHES 1
#endif
constexpr int N_PHASES = 9;
constexpr int N_LAUNCHES = MK_N_LAUNCHES;
struct Args { const float* in[19]; float* out; unsigned char* ws; int ph_lo, ph_hi; };
__global__ void __launch_bounds__(NWAVES * 64, 2) enc_fwd(Args args) {
    extern __shared__ __attribute__((aligned(16))) unsigned char lds[];
    Frame F;
    F.lds = (LAS unsigned char*)lds;
    F.MISC = (volatile LAS unsigned*)(F.lds + LC_MISC);
    F.tid = threadIdx.x; F.lane = F.tid & 63; F.wave = __builtin_amdgcn_readfirstlane(F.tid >> 6);
    F.G = gridDim.x; { const int bx = blockIdx.x; F.vcu = (F.G % 8 == 0) ? (bx % 8) * (F.G / 8) + bx / 8 : bx; }
    F.ws = args.ws; F.ctl = (gu32*)(args.ws + WS_CTL);
    F.x = args.in[0]; F.mix_g = args.in[1]; F.w_in = args.in[2]; F.w_gf = args.in[3]; F.b_gf = args.in[4]; F.w_gb = args.in[5]; F.b_gb = args.in[6]; F.gla_hg = args.in[7];
    F.q_g = args.in[8]; F.k_g = args.in[9]; F.w_out = args.in[10]; F.ffn_g = args.in[11]; F.w_router = args.in[12]; F.b_router = args.in[13];
    F.w1 = args.in[14]; F.b1 = args.in[15]; F.w2 = args.in[16]; F.b2 = args.in[17]; F.fin_g = args.in[18]; F.out = args.out;
    for (int u = F.tid; u < (LDS_BYTES - LC_OFF) / 4; u += NWAVES * 64) ((LAS unsigned*)(F.lds + LC_OFF))[u] = 0u;
    __syncthreads();
    XcdBarrier bar; bar.bar = (unsigned*)(F.ctl + CW_BAR); bar.x = 0; bar.st = nullptr;
    if (N_LAUNCHES == 1) bar = xcd_barrier_post((unsigned*)(F.ctl + CW_BAR), F.MISC + 8);
    const int lo = args.ph_lo, hi = args.ph_hi;
#define IN(k) (lo <= (k) && (k) < hi)
#define SEAM(k) do { if (IN(k) && IN((k) + 1)) xcd_barrier(bar); } while (0)
    MoeTabs tb{(const LAS int*)(F.lds + LC_CNT), (const LAS int*)(F.lds + LC_CST), (const LAS unsigned short*)(F.lds + LC_TE)};

    if (IN(0)) { p0_prologue(F); } SEAM(0);
    if (IN(1)) {
        DenseMap mp{(const bf16*)(F.ws + WS_XN), (const bf16*)(F.ws + WS_WIN), 1024};
        pg8::StaticOrder S; S.init(T / 256, D_IN_PAD / 256, F.G, (int)blockIdx.x);
        EpiInProj E{(bf16*)(F.ws + WS_GQ), (bf16*)(F.ws + WS_GK), (bf16*)(F.ws + WS_GV), (bf16*)(F.ws + WS_GR), (bf16*)(F.ws + WS_AQ), (bf16*)(F.ws + WS_AK), (bf16*)(F.ws + WS_AV), (bf16*)(F.ws + WS_Z)};
        pg8::gemm_phase<EpiInProj, pg8::StaticOrder, DenseMap, true>(F.lds, 1024, S, mp, E);
    } SEAM(1);
    if (IN(2)) { p2_normrope(F); for (int u = F.vcu; u < BATCH * 64; u += F.G) gla::gla_prep_unit(F, u >> 6, u & 63); } SEAM(2);
    if (IN(3)) { p3_mixers(F); } SEAM(3);
    if (IN(4)) {
        DenseMap mp{(const bf16*)(F.ws + WS_MIX), (const bf16*)(F.ws + WS_WOUT), 1024};
        pg8::StaticOrder S; S.init(T / 256, DM / 256, F.G, (int)blockIdx.x);
        EpiResF32 E{F.x, (bf16*)(F.ws + WS_H16)};
        pg8::gemm_phase<EpiResF32, pg8::StaticOrder, DenseMap, true>(F.lds, 1024, S, mp, E);
    } SEAM(4);
    if (IN(5)) { p5_route(F); } SEAM(5);
    if (IN(6)) {
        const int ntl = moe_tables(F);
        MoeMapUp mp{F.ws + WS_XN, F.ws + WS_W1, (const int*)(F.ws + WS_ROWTOK), tb};
        pg8::StaticOrder S; S.init(ntl, 8, F.G, (int)blockIdx.x);
        EpiSwiglu E{F.b1, F.ws + WS_ACT, tb};
        pg8::gemm_phase<EpiSwiglu, pg8::StaticOrder, MoeMapUp, true, true>(F.lds, 512, S, mp, E);
    } SEAM(6);
    if (IN(7)) {
        const int ntl = moe_tables(F);
        MoeMapDown mp{F.ws + WS_ACT, F.ws + WS_W2, tb};
        pg8::StaticOrder S; S.init(ntl, 4, F.G, (int)blockIdx.x);
        EpiDown E{F.b2, (const float*)(F.ws + WS_ROWGATE), F.ws + WS_Y, tb};
        pg8::gemm_phase<EpiDown, pg8::StaticOrder, MoeMapDown, true, true>(F.lds, 512, S, mp, E);
    } SEAM(7);
    if (IN(8)) { (void)moe_tables(F); p8_combine(F); }
#undef IN
#undef SEAM
}

extern "C" void kernel_launch(void* const* d_in, const int* in_sizes, int n_in, void* d_out, int out_size, void* d_ws, size_t ws_size, hipStream_t stream) {
    static int grid = 0;
    if (grid == 0) {
        if (n_in != 19 || in_sizes[0] != T * DM || out_size != T * DM || ws_size < WS_END) { fprintf(stderr, "kernel_launch: unexpected shapes (n_in %d, in0 %d, out %d, ws %zu); nothing launched\n", n_in, n_in > 0 ? in_sizes[0] : -1, out_size, ws_size); grid = -1; return; }
        int dev = 0, cus = 0, per_cu = 0;
        if (hipGetDevice(&dev) != hipSuccess || hipDeviceGetAttribute(&cus, hipDeviceAttributeMultiprocessorCount, dev) != hipSuccess) { grid = -1; return; }
        if (hipFuncSetAttribute((const void*)enc_fwd, hipFuncAttributeMaxDynamicSharedMemorySize, LDS_BYTES) != hipSuccess) { fprintf(stderr, "kernel_launch: hipFuncSetAttribute failed\n"); grid = -1; return; }
        if (hipOccupancyMaxActiveBlocksPerMultiprocessor(&per_cu, (const void*)enc_fwd, NWAVES * 64, LDS_BYTES) != hipSuccess || per_cu < 1) { fprintf(stderr, "kernel_launch: occupancy query says %d\n", per_cu); }
        (void)hipGetLastError();
        grid = cus;
    }
    if (grid < 0) return;
    if (hipMemsetAsync((char*)d_ws + WS_CTL, 0, CTL_ZERO_BYTES, stream) != hipSuccess) return;
    Args a{};
    for (int i = 0; i < 19; ++i) a.in[i] = (const float*)d_in[i];
    a.out = (float*)d_out; a.ws = (unsigned char*)d_ws;
    if (N_LAUNCHES == 1) { a.ph_lo = 0; a.ph_hi = N_PHASES; hipLaunchKernelGGL(enc_fwd, dim3(grid), dim3(NWAVES * 64), LDS_BYTES, stream, a); }
    else for (int p = 0; p < N_PHASES; ++p) { a.ph_lo = p; a.ph_hi = p + 1; hipLaunchKernelGGL(enc_fwd, dim3(grid), dim3(NWAVES * 64), LDS_BYTES, stream, a); }
}
```

```cpp
#include <hip/hip_runtime.h>
#include <hip/hip_bf16.h>
#include <cstdio>
#include <cstdint>
#include <cmath>

#define LAS __attribute__((address_space(3)))
#define GAS __attribute__((address_space(1)))

namespace pg8 {
typedef unsigned short bf16_t;
typedef short bf16x8 __attribute__((ext_vector_type(8)));
typedef float f32x4 __attribute__((ext_vector_type(4)));
typedef float f32x2 __attribute__((ext_vector_type(2)));
typedef unsigned u32x4 __attribute__((ext_vector_type(4)));
typedef int v4i_t __attribute__((ext_vector_type(4)));
typedef int v8i_t __attribute__((ext_vector_type(8)));
constexpr int BM = 256, BK = 64, HALF = 128, HTB = HALF * BK * 2, STAGE_BYTES = 8 * HTB, NXCD = 8, WGM = 4;

__host__ __device__ __forceinline__ int lds_byte(int r, int c) { const int st = (r >> 4) * 2 + (c >> 5), rr = r & 15, cc = c & 31, ob = rr * 64 + cc * 2; return st * 1024 + (ob ^ (((ob >> 9) & 1) << 5)); }
__host__ __device__ __forceinline__ void stage_rc(int b, int& R, int& C) { const int st = b / 1024, sb = b % 1024, swz = sb ^ (((sb >> 9) & 1) << 5); R = (st >> 1) * 16 + swz / 64; C = (st & 1) * 32 + (swz % 64) / 2; }
__host__ __device__ __forceinline__ int perm32(int rho) { const int n = rho >> 4, i = rho & 15; return 8 * (i >> 2) + 4 * n + (i & 3); }

struct Unit { int pm, pn; };

struct StaticOrder {
    int nM, nN, nwg, G, c;
    __device__ __forceinline__ void init(int nM_, int nN_, int G_, int c_) { nM = nM_; nN = nN_; nwg = nM * nN; G = G_; c = c_; }
    __device__ __forceinline__ bool next(int i, Unit& u) const {
        const long L = (long)i * G + c; if (L >= nwg) return false;
        int wgid = (int)L; { const int q = nwg / NXCD, r = nwg % NXCD, xcd = wgid % NXCD, off = wgid / NXCD; wgid = (xcd < r ? xcd * (q + 1) : r * (q + 1) + (xcd - r) * q) + off; }
        const int nig = WGM * nN, gid = wgid / nig, fm = gid * WGM, gsz = (nM - fm) < WGM ? (nM - fm) : WGM;
        u.pm = fm + ((wgid % nig) % gsz); u.pn = (wgid % nig) / gsz; return true;
    }
};

__device__ __forceinline__ unsigned cvt_pk_bf16(float lo, float hi) { unsigned r; asm volatile("v_cvt_pk_bf16_f32 %0, %1, %2" : "=v"(r) : "v"(lo), "v"(hi)); return r; }

template <class Epi, class Sched, class Map, bool ALIGN_EPI, bool FP8 = false>
__device__ __forceinline__ void gemm_phase(LAS unsigned char* lds, const int K, const Sched& S, const Map& MP, const Epi& E) {
    int tid_ = threadIdx.x; asm volatile("" : "+v"(tid_));
    const int tid = tid_, wid = __builtin_amdgcn_readfirstlane(tid >> 6), lane = tid & 63, wr = wid >> 2, wc = wid & 3, fr = lane & 15, fq = lane >> 4;
    const int nt = K / BK;
    int Rr[2], Cc[2]; unsigned voffB[2];
#pragma unroll
    for (int i = 0; i < 2; ++i) { int R, C; stage_rc(tid * 16 + i * 8192, R, C); Rr[i] = R; Cc[i] = C; const int Rb = Epi::COLS64 ? (64 * (R >> 5) + perm32(R & 31)) : (Epi::PERM ? ((R & ~31) + perm32(R & 31)) : R); voffB[i] = (unsigned)(Rb * K + C) * 2u; }
    const unsigned kstep = (unsigned)(BK * 2);
    const unsigned hstep = (unsigned)HALF * K * 2;
    const unsigned hstepB = Epi::COLS64 ? 32u * (unsigned)K * 2u : hstep;
    const __amdgpu_buffer_rsrc_t RA = MP.a_rsrc(), RB = MP.b_rsrc();
    const unsigned ldsw = (unsigned)wid * 1024u;
    const int aoff = lds_byte(wr * 64 + fr, fq * 8), boff = lds_byte(wc * 32 + fr, fq * 8);
#define PG8_SA(b, h) (((b) * 2 + (h)) * HTB)
#define PG8_SB(b, h) ((4 + (b) * 2 + (h)) * HTB)
#define PG8_STAGE(bufoff, rsrc, soff, voff) do { _Pragma("unroll") for (int _i = 0; _i < 2; ++_i) \
        __builtin_amdgcn_raw_ptr_buffer_load_lds(rsrc, (LAS unsigned*)(lds + (bufoff) + ldsw + _i * 8192), 16, (int)(voff)[_i], (int)(soff), 0, 0); } while (0)
#define PG8_LD8(p) __builtin_shufflevector(*(const LAS v4i_t*)(p), *(const LAS v4i_t*)((p) + 1024), 0, 1, 2, 3, 4, 5, 6, 7)
#define PG8_LDA(dst, b, h) do { _Pragma("unroll") for (int m = 0; m < 4; ++m) dst[m] = PG8_LD8(lds + PG8_SA(b, h) + aoff + m * 2048); } while (0)
#define PG8_LDB(dst, b, h) do { _Pragma("unroll") for (int n = 0; n < 2; ++n) dst[n] = PG8_LD8(lds + PG8_SB(b, h) + boff + n * 2048); } while (0)
#define PG8_HALF(x, k) __builtin_bit_cast(bf16x8, __builtin_shufflevector(x, x, 4 * (k), 4 * (k) + 1, 4 * (k) + 2, 4 * (k) + 3))
#define PG8_MMA(ai, bj, At, Bt) do { __builtin_amdgcn_s_setprio(1); _Pragma("unroll") for (int m = 0; m < 4; ++m) _Pragma("unroll") for (int n = 0; n < 2; ++n) { \
        if constexpr (FP8) { acc[ai][bj][m][n] = __builtin_amdgcn_mfma_scale_f32_16x16x128_f8f6f4(Bt[n], At[m], acc[ai][bj][m][n], 0, 0, 0, 0x7f7f7f7f, 0, 0x7f7f7f7f); } \
        else { acc[ai][bj][m][n] = __builtin_amdgcn_mfma_f32_16x16x32_bf16(PG8_HALF(Bt[n], 0), PG8_HALF(At[m], 0), acc[ai][bj][m][n], 0, 0, 0); \
               acc[ai][bj][m][n] = __builtin_amdgcn_mfma_f32_16x16x32_bf16(PG8_HALF(Bt[n], 1), PG8_HALF(At[m], 1), acc[ai][bj][m][n], 0, 0, 0); } } \
        __builtin_amdgcn_s_setprio(0); } while (0)
#define PG8_WAIT_V(n) asm volatile("s_waitcnt vmcnt(" #n ")" ::: "memory")
#define PG8_WAIT_L(n) asm volatile("s_waitcnt lgkmcnt(" #n ")" ::: "memory")
#define PG8_BAR __builtin_amdgcn_s_barrier()
#define PG8_SCHED __builtin_amdgcn_sched_barrier(0)
    Unit cur, nxt, nn; int ui = 0;
    if (!S.next(0, cur)) return;
    f32x4 acc[2][2][4][2];
#pragma unroll
    for (int a = 0; a < 2; ++a)
#pragma unroll
        for (int b = 0; b < 2; ++b)
#pragma unroll
            for (int m = 0; m < 4; ++m)
#pragma unroll
                for (int n = 0; n < 2; ++n) acc[a][b][m][n] = (f32x4){0.f, 0.f, 0.f, 0.f};
    v8i_t At[4], B0[2], B1[2];
    unsigned cvo[2][2], nvo[2][2], nnvo[2][2];
    MP.a_off(cur, Rr, Cc, cvo);
    bool has_next = S.next(1, nxt);
    if constexpr (Map::GATHER) { if (has_next) MP.a_off(nxt, Rr, Cc, nvo); else { nvo[0][0] = cvo[0][0]; nvo[0][1] = cvo[0][1]; nvo[1][0] = cvo[1][0]; nvo[1][1] = cvo[1][1]; } }
    unsigned cA = MP.a_soff(cur), cB = MP.b_soff(cur);
    typename Epi::Pre pc, pn;
    E.preload(cur, wr, wc, fr, fq, pc); pn = pc;
    PG8_STAGE(PG8_SB(0, 0), RB, cB, voffB); PG8_STAGE(PG8_SB(0, 1), RB, cB + hstepB, voffB); PG8_STAGE(PG8_SA(0, 0), RA, cA, cvo[0]); PG8_STAGE(PG8_SA(0, 1), RA, cA, cvo[1]);
    if (wr == 1) PG8_BAR;
    PG8_WAIT_V(2); PG8_BAR;
    PG8_STAGE(PG8_SB(1, 0), RB, cB + kstep, voffB); PG8_STAGE(PG8_SA(1, 0), RA, cA + kstep, cvo[0]); PG8_STAGE(PG8_SB(1, 1), RB, cB + hstepB + kstep, voffB);
    PG8_WAIT_V(6); PG8_BAR;
    for (;;) {
        const unsigned nA = has_next ? MP.a_soff(nxt) : cA, nB = has_next ? MP.b_soff(nxt) : cB;
#pragma unroll 1
        for (int t = 0; t < nt; t += 2) {
            const bool last = (t == nt - 2);
            const unsigned a1 = cA + (unsigned)(t + 1) * kstep;
            const unsigned a2 = last ? nA : cA + (unsigned)(t + 2) * kstep, b2 = last ? nB : cB + (unsigned)(t + 2) * kstep;
            const unsigned a3 = a2 + kstep, b3 = b2 + kstep;
            unsigned s0[2] = {cvo[0][0], cvo[0][1]}, s1[2] = {cvo[1][0], cvo[1][1]};
            if constexpr (Map::GATHER) { if (last) { s0[0] = nvo[0][0]; s0[1] = nvo[0][1]; s1[0] = nvo[1][0]; s1[1] = nvo[1][1]; } }
            PG8_LDB(B0, 0, 0); PG8_LDB(B1, 0, 1); PG8_SCHED; PG8_LDA(At, 0, 0); PG8_STAGE(PG8_SA(1, 1), RA, a1, cvo[1]);
            PG8_WAIT_V(8); PG8_WAIT_L(0); PG8_BAR; PG8_MMA(0, 0, At, B0); PG8_MMA(0, 1, At, B1); PG8_BAR; PG8_SCHED;
            PG8_LDA(At, 0, 1); PG8_STAGE(PG8_SB(0, 0), RB, b2, voffB); PG8_STAGE(PG8_SB(0, 1), RB, b2 + hstepB, voffB); PG8_STAGE(PG8_SA(0, 0), RA, a2, s0);
            PG8_WAIT_V(8); PG8_WAIT_L(0); PG8_BAR; PG8_MMA(1, 0, At, B0); PG8_MMA(1, 1, At, B1); PG8_BAR; PG8_SCHED;
            PG8_LDB(B0, 1, 0); PG8_LDB(B1, 1, 1); PG8_SCHED; PG8_LDA(At, 1, 0); PG8_STAGE(PG8_SA(0, 1), RA, a2, s1);
            PG8_WAIT_V(8); PG8_WAIT_L(0); PG8_BAR; PG8_MMA(0, 0, At, B0); PG8_MMA(0, 1, At, B1); PG8_BAR; PG8_SCHED;
            PG8_LDA(At, 1, 1); PG8_STAGE(PG8_SB(1, 0), RB, b3, voffB); PG8_STAGE(PG8_SB(1, 1), RB, b3 + hstepB, voffB); PG8_STAGE(PG8_SA(1, 0), RA, a3, s0);
            PG8_WAIT_V(8); PG8_WAIT_L(0); PG8_BAR; PG8_MMA(1, 0, At, B0); PG8_MMA(1, 1, At, B1); PG8_BAR; PG8_SCHED;
        }
        if constexpr (ALIGN_EPI) { if (wr == 0) PG8_BAR; }
        const bool has_nn = has_next && S.next(ui + 2, nn);
        if constexpr (Map::GATHER) { if (has_nn) MP.a_raw(nn, Rr, nnvo); }
        if (has_next) E.preload(nxt, wr, wc, fr, fq, pn);
        { int fr_ = fr, fq_ = fq; asm volatile("" : "+v"(fr_), "+v"(fq_)); E(acc, cur, pc, wr, wc, fr_, fq_); }
        if (!has_next) break;
#pragma unroll
        for (int a = 0; a < 2; ++a)
#pragma unroll
            for (int b = 0; b < 2; ++b)
#pragma unroll
                for (int m = 0; m < 4; ++m)
#pragma unroll
                    for (int n = 0; n < 2; ++n) acc[a][b][m][n] = (f32x4){0.f, 0.f, 0.f, 0.f};
        cur = nxt; cA = nA; cB = nB; ++ui; pc = pn;
#pragma unroll
        for (int h = 0; h < 2; ++h)
#pragma unroll
            for (int i = 0; i < 2; ++i) { if constexpr (Map::GATHER) { cvo[h][i] = nvo[h][i]; nvo[h][i] = has_nn ? MP.a_fin(nnvo[h][i], Cc[i]) : nvo[h][i]; } }
        has_next = has_nn; nxt = nn;
        if constexpr (ALIGN_EPI) { if (wr == 1) PG8_BAR; }
    }
    PG8_WAIT_V(0);
    if constexpr (!ALIGN_EPI) { if (wr == 0) PG8_BAR; }
    PG8_BAR;
#undef PG8_SA
#undef PG8_SB
#undef PG8_STAGE
#undef PG8_LDA
#undef PG8_LDB
#undef PG8_MMA
#undef PG8_HALF
#undef PG8_LD8
#undef PG8_WAIT_V
#undef PG8_WAIT_L
#undef PG8_BAR
#undef PG8_SCHED
}
}
namespace attn_body {
using bf16=__hip_bfloat16;
using bf16x8=__attribute__((ext_vector_type(8)))short;
using s16x4=__attribute__((ext_vector_type(4)))short;
using f32x16=__attribute__((ext_vector_type(16)))float;
using u32x4=__attribute__((ext_vector_type(4)))unsigned;
constexpr int BATCH=8,NHEAD=8,NKVH=2,SEQ=4096,D=64;
constexpr int QP=512,KP=128,VP=128,OP=1024,OCOL=512;
constexpr int NW=8,QBLK=32,QB=QBLK*NW,KVBLK=64,NQB=SEQ/QB;
__device__ __forceinline__ int crow(int r,int hi){return (r&3)+8*(r>>2)+4*hi;}
#define SBAR() __builtin_amdgcn_sched_barrier(0)
constexpr int NSLOT=3, SLOTB=8192;
constexpr int LDS_K=0, LDS_V=NSLOT*SLOTB, LDS_WS=2*NSLOT*SLOTB, LDS_OST=LDS_WS+NW*64*4, LDS_BYTES=LDS_OST+NW*4096;
constexpr float C2=0.125f*1.4426950408889634f;
__device__ __forceinline__ void glds16(const void*gsrc,unsigned lds_dst){unsigned keep;
  asm volatile("s_mov_b32 %0, m0\n\ts_mov_b32 m0, %2\n\ts_nop 0\n\tglobal_load_lds_dwordx4 %1, off\n\ts_mov_b32 m0, %0":"=&s"(keep):"v"(gsrc),"s"(lds_dst):"memory");}
__device__ __forceinline__ float max3f(float a,float b,float c){float r;asm("v_max3_f32 %0, %1, %2, %3":"=v"(r):"v"(a),"v"(b),"v"(c));return r;}
__device__ __forceinline__ float max2f(float a,float b){float r;asm("v_max_f32_e32 %0, %1, %2":"=v"(r):"v"(a),"v"(b));return r;}
__device__ __forceinline__ float fadd_s(float a,float b){float r;asm("v_add_f32_e32 %0, %1, %2":"=v"(r):"v"(a),"v"(b));return r;}
__device__ __forceinline__ float fsub_s(float a,float b){float r;asm("v_sub_f32_e32 %0, %1, %2":"=v"(r):"v"(a),"v"(b));return r;}
typedef float f32x2_t __attribute__((ext_vector_type(2))); typedef __bf16 bf16x2_t __attribute__((ext_vector_type(2)));
__device__ __forceinline__ unsigned cvtpk_s(float lo,float hi){f32x2_t v={lo,hi};bf16x2_t b=__builtin_convertvector(v,bf16x2_t);return __builtin_bit_cast(unsigned,b);}
#define WAIT_BAR(N) asm volatile("s_waitcnt vmcnt(" #N ") lgkmcnt(0)\n\ts_barrier":::"memory")

__device__ __forceinline__ void qkt(f32x16&p0,f32x16&p1,const char*Kslot,const bf16x8*qr,const f32x16&negm,int r32,int hi){
  const char*kb=Kslot+hi*1024+r32*16;
  #pragma unroll
  for(int d0=0;d0<4;++d0){
    const bf16x8 b0=*reinterpret_cast<const bf16x8*>(kb+d0*2048);
    const bf16x8 b1=*reinterpret_cast<const bf16x8*>(kb+d0*2048+512);
    if(d0==0){p0=__builtin_amdgcn_mfma_f32_32x32x16_bf16(b0,qr[0],negm,0,0,0);p1=__builtin_amdgcn_mfma_f32_32x32x16_bf16(b1,qr[0],negm,0,0,0);}
    else{p0=__builtin_amdgcn_mfma_f32_32x32x16_bf16(b0,qr[d0],p0,0,0,0);p1=__builtin_amdgcn_mfma_f32_32x32x16_bf16(b1,qr[d0],p1,0,0,0);}}
}
typedef __attribute__((address_space(3))) const char* lds_cptr;
typedef short v4i16_t __attribute__((ext_vector_type(4)));
__device__ __forceinline__ void kload8(bf16x8*kf,lds_cptr kp){
  kf[0]=*(const __attribute__((address_space(3))) bf16x8*)(kp);      kf[1]=*(const __attribute__((address_space(3))) bf16x8*)(kp+512);
  kf[2]=*(const __attribute__((address_space(3))) bf16x8*)(kp+2048); kf[3]=*(const __attribute__((address_space(3))) bf16x8*)(kp+2560);
  kf[4]=*(const __attribute__((address_space(3))) bf16x8*)(kp+4096); kf[5]=*(const __attribute__((address_space(3))) bf16x8*)(kp+4608);
  kf[6]=*(const __attribute__((address_space(3))) bf16x8*)(kp+6144); kf[7]=*(const __attribute__((address_space(3))) bf16x8*)(kp+6656);
}
__device__ __forceinline__ void kload2(bf16x8*kf,lds_cptr kp,int j){ kf[2*j]=*(const __attribute__((address_space(3))) bf16x8*)(kp+j*2048); kf[2*j+1]=*(const __attribute__((address_space(3))) bf16x8*)(kp+j*2048+512); }
__device__ __forceinline__ s16x4 vtr(lds_cptr p){ return __builtin_bit_cast(s16x4,__builtin_amdgcn_ds_read_tr16_b64_v4i16((__attribute__((address_space(3))) v4i16_t*)p)); }
__device__ __forceinline__ float rowmax(const f32x16&p0,const f32x16&p1){
  float a=max3f(p0[0],p0[1],p1[0]),b=max3f(p0[2],p0[3],p1[1]);a=max3f(a,p1[2],p1[3]);
  #pragma unroll
  for(int r=4;r<16;r+=4){a=max3f(a,p0[r],p0[r+1]);b=max3f(b,p0[r+2],p0[r+3]);a=max3f(a,p1[r],p1[r+1]);b=max3f(b,p1[r+2],p1[r+3]);}
  const float m=max2f(a,b);
  auto rr=__builtin_amdgcn_permlane32_swap(__float_as_uint(m),__float_as_uint(m),false,false);
  return max2f(__uint_as_float(rr[0]),__uint_as_float(rr[1]));
}
__device__ __forceinline__ void pv(f32x16*o,int vb,bf16x8 pa0,bf16x8 pa1,bf16x8 pa2,bf16x8 pa3){
  #pragma unroll
  for(int d0=0;d0<2;++d0){s16x4 lo[4],hi[4];
    #pragma unroll
    for(int ks=0;ks<4;++ks){
      asm volatile("ds_read_b64_tr_b16 %0,%1 offset:%c2":"=&v"(lo[ks]):"v"(vb),"i"(d0*4096+ks*1024):"memory");
      asm volatile("ds_read_b64_tr_b16 %0,%1 offset:%c2":"=&v"(hi[ks]):"v"(vb),"i"(d0*4096+ks*1024+512):"memory");}
    asm volatile("s_waitcnt lgkmcnt(0)":::"memory");SBAR();
    #define PK(k) (bf16x8){lo[k][0],lo[k][1],lo[k][2],lo[k][3],hi[k][0],hi[k][1],hi[k][2],hi[k][3]}
    o[d0]=__builtin_amdgcn_mfma_f32_32x32x16_bf16(pa0,PK(0),o[d0],0,0,0);
    o[d0]=__builtin_amdgcn_mfma_f32_32x32x16_bf16(pa1,PK(1),o[d0],0,0,0);
    o[d0]=__builtin_amdgcn_mfma_f32_32x32x16_bf16(pa2,PK(2),o[d0],0,0,0);
    o[d0]=__builtin_amdgcn_mfma_f32_32x32x16_bf16(pa3,PK(3),o[d0],0,0,0);
    #undef PK
  }
}
#define ATTN_STORE16(p,v) (*(u32x4*)(p)=(v))
template<int THRL> __device__ __forceinline__ void attn_unit(int b,int h,int qb,const bf16*Q,const bf16*__restrict__ K,const bf16*__restrict__ V,bf16*O,char*shm,const float*qgain,const float sbound){
  int tid_=threadIdx.x; asm volatile("":"+v"(tid_));
  const int tid=tid_,lane=tid&63,r32=lane&31,hi=lane>>5; const int wid=__builtin_amdgcn_readfirstlane(tid>>6);
  const long rowbase=(long)b*SEQ; const int q0=qb*QB; const int kvh=h/(NHEAD/NKVH);
  const bf16*Qw=Q+(rowbase+q0+wid*QBLK)*QP+h*D;
  const bf16*Kh=K+rowbase*KP+kvh*D,*Vh=V+rowbase*VP+kvh*D;
  const unsigned lds0=(unsigned)(uintptr_t)shm;
  float*wsf=(float*)(shm+LDS_WS)+wid*64;
  const bf16*ksrc=Kh+(long)lane*KP+wid*8;
  const bf16*vsrc=Vh+(long)(16*(wid&3)+(lane>>2))*VP+(wid>>2)*32+(lane&3)*8;
  const unsigned kdst=lds0+LDS_K+wid*1024, vdst=lds0+LDS_V+wid*1024;
  #define DMA_K(t,slot) glds16(ksrc+(long)(t)*KVBLK*KP,(unsigned)__builtin_amdgcn_readfirstlane(kdst+(slot)))
  #define DMA_V(t,slot) glds16(vsrc+(long)(t)*KVBLK*VP,(unsigned)__builtin_amdgcn_readfirstlane(vdst+(slot)))
  const int vb0=(int)(lds0+LDS_V)+((lane>>4)&1)*32+(lane&3)*8+(4*hi+((lane&15)>>2))*64;
  const char*Kbase=shm+LDS_K; bf16x8 kf[8];
  const lds_cptr shm3=(lds_cptr)shm; const lds_cptr kp0=shm3+LDS_K+hi*1024+r32*16; const lds_cptr vp0=shm3+LDS_V+((lane>>4)&1)*32+(lane&3)*8+(4*hi+((lane&15)>>2))*64;
  constexpr int NT=SEQ/KVBLK;
  DMA_K(0,0);DMA_V(0,0);DMA_K(1,SLOTB);
  bf16x8 qr[4];
  #pragma unroll
  for(int d0=0;d0<4;++d0)qr[d0]=*reinterpret_cast<const bf16x8*>(&Qw[(long)r32*QP+d0*16+hi*8]);
  { float xq[4][8]; float ss=0.f; int hio=hi; asm volatile("":"+v"(hio));
    #pragma unroll
    for(int d0=0;d0<4;++d0)
      #pragma unroll
      for(int j=0;j<8;++j){ xq[d0][j]=__builtin_bit_cast(float,((unsigned)(unsigned short)qr[d0][j])<<16); ss+=xq[d0][j]*xq[d0][j]; }
    ss+=__shfl_xor(ss,32);
    const float rinv=__builtin_amdgcn_rsqf(ss*(1.f/64.f)+1e-6f);
    const int tq=q0+wid*QBLK+r32; const float prow=(float)(tq>>6), pcol=(float)(tq&63);
    #pragma unroll
    for(int d0=0;d0<4;++d0)
      #pragma unroll
      for(int j=0;j<8;++j) xq[d0][j]*=rinv*qgain[16*d0+8*hio+j];
    #pragma unroll
    for(int j=0;j<8;++j){ const float inv=exp2f(-(float)(8*hio+j)*(13.287712379549449f/16.f));
      const float ar=prow*inv, ac=pcol*inv; const float cr=__cosf(ar), sr=__sinf(ar), cc=__cosf(ac), sc=__sinf(ac);
      const float a0=xq[0][j], a1=xq[1][j], b0=xq[2][j], b1=xq[3][j];
      xq[0][j]=(a0*cr-a1*sr)*C2; xq[1][j]=(a1*cr+a0*sr)*C2; xq[2][j]=(b0*cc-b1*sc)*C2; xq[3][j]=(b1*cc+b0*sc)*C2; }
    #pragma unroll
    for(int d0=0;d0<4;++d0){ u32x4 w; w.x=cvtpk_s(xq[d0][0],xq[d0][1]); w.y=cvtpk_s(xq[d0][2],xq[d0][3]); w.z=cvtpk_s(xq[d0][4],xq[d0][5]); w.w=cvtpk_s(xq[d0][6],xq[d0][7]); qr[d0]=__builtin_bit_cast(bf16x8,w); } }
  float l_reg=0.f;f32x16 o[2];o[0]=f32x16{};o[1]=f32x16{};f32x16 negm;
  #pragma unroll
  for(int r=0;r<16;++r)negm[r]=-sbound;
  asm volatile("":"+v"(negm));
  #define START(P0,P1) do{ _Pragma("unroll") for(int r=0;r<16;++r)P0[r]=__builtin_amdgcn_exp2f(P0[r]); }while(0)
  #define RESC() do{}while(0)
  f32x16 pA0,pA1,pB0,pB1;
  int sl_prev=0,sl_cur=0,sl_next=SLOTB;
  #define ROT() do{sl_prev=sl_cur;sl_cur=sl_next;sl_next=(sl_next==(NSLOT-1)*SLOTB)?0:sl_next+SLOTB;}while(0)
  DMA_K(2,2*SLOTB);
  WAIT_BAR(3);
  qkt(pA0,pA1,Kbase,qr,negm,r32,hi);asm volatile("s_nop 15\n\ts_nop 7":"+v"(pA0),"+v"(pA1));
  START(pA0,pA1);
  _Pragma("unroll") for(int r=0;r<16;++r)pA1[r]=__builtin_amdgcn_exp2f(pA1[r]);
  WAIT_BAR(0);
  DMA_K(3,0);DMA_V(1,SLOTB);
  ROT();
  kload8(kf,kp0+sl_cur);
  WAIT_BAR(2);
  s16x4 vlo[8],vhi[8]; u32x4 pw0,pw1,pw2,pw3;
  #define PKW(P,B) cvtpk_s(P[B],P[B+1])
  #define PAF(k) __builtin_bit_cast(bf16x8,pw##k)
  #define VFR(i) (bf16x8){vlo[i][0],vlo[i][1],vlo[i][2],vlo[i][3],vhi[i][0],vhi[i][1],vhi[i][2],vhi[i][3]}
  #define PIN(x) asm volatile("":"+v"(x))
  #define MX3(a,b,c) __builtin_fmaxf(__builtin_fmaxf((a),(b)),(c))
  #define GAPA(MF,A0,A1,A2,A3,W0,W1,PW) do{ MF; sacc+=A0; sacc+=A1; sacc+=A2; sacc+=A3; PIN(sacc); W0; W1; PIN(PW); SBAR(); }while(0)
  #define EX(v) __builtin_amdgcn_exp2f(v)
  #define GAPB(MF,X,B) do{ MF; X[B]=EX(X[B]); X[B+1]=EX(X[B+1]); X[B+2]=EX(X[B+2]); X[B+3]=EX(X[B+3]); PIN(X); SBAR(); }while(0)
  #define VRD(i) do{ vlo[i]=vtr(vp_+(((i)>>2)*4096+((i)&3)*1024)); vhi[i]=vtr(vp_+(((i)>>2)*4096+((i)&3)*1024+512)); }while(0)
  #define KRD(G,j) do{ if(G){ kload2(kf,kp0+sl_next,j); SBAR(); } }while(0)
  #define STEP(C0,C1,P0,P1,t,GK,GV,GL) do{ SBAR(); \
    const lds_cptr vp_=vp0+sl_prev; \
    VRD(0); SBAR(); float sacc=(P0[0]+P0[1]); \
    GAPA(C0=__builtin_amdgcn_mfma_f32_32x32x16_bf16(kf[0],qr[0],negm,0,0,0), P0[2],P0[3],P0[4],P0[5],     pw0[0]=PKW(P0,0), pw0[1]=PKW(P0,2), pw0); \
    VRD(4); SBAR(); GAPA(C1=__builtin_amdgcn_mfma_f32_32x32x16_bf16(kf[1],qr[0],negm,0,0,0), P0[6],P0[7],P0[8],P0[9],     pw0[2]=PKW(P0,4), pw0[3]=PKW(P0,6), pw0); \
    VRD(1); SBAR(); GAPA(C0=__builtin_amdgcn_mfma_f32_32x32x16_bf16(kf[2],qr[1],C0,0,0,0),   P0[10],P0[11],P0[12],P0[13], pw1[0]=PKW(P0,8), pw1[1]=PKW(P0,10), pw1); \
    VRD(5); SBAR(); GAPA(C1=__builtin_amdgcn_mfma_f32_32x32x16_bf16(kf[3],qr[1],C1,0,0,0),   P0[14],P0[15],P1[0],P1[1],   pw1[2]=PKW(P0,12),pw1[3]=PKW(P0,14), pw1); \
    VRD(2); SBAR(); GAPA(C0=__builtin_amdgcn_mfma_f32_32x32x16_bf16(kf[4],qr[2],C0,0,0,0),   P1[2],P1[3],P1[4],P1[5],     pw2[0]=PKW(P1,0), pw2[1]=PKW(P1,2), pw2); \
    VRD(6); SBAR(); GAPA(C1=__builtin_amdgcn_mfma_f32_32x32x16_bf16(kf[5],qr[2],C1,0,0,0),   P1[6],P1[7],P1[8],P1[9],     pw2[2]=PKW(P1,4), pw2[3]=PKW(P1,6), pw2); \
    VRD(3); SBAR(); GAPA(C0=__builtin_amdgcn_mfma_f32_32x32x16_bf16(kf[6],qr[3],C0,0,0,0),   P1[10],P1[11],P1[12],P1[13], pw3[0]=PKW(P1,8), pw3[1]=PKW(P1,10), pw3); \
    VRD(7); SBAR(); GAPA(C1=__builtin_amdgcn_mfma_f32_32x32x16_bf16(kf[7],qr[3],C1,0,0,0),   P1[14],P1[15],0.f,0.f,       pw3[2]=PKW(P1,12),pw3[3]=PKW(P1,14), pw3); \
    l_reg+=sacc; \
    if(GK){DMA_K((t)+3,sl_cur);} if(GV){DMA_V((t)+1,sl_next);} \
    SBAR(); \
    GAPB(o[0]=__builtin_amdgcn_mfma_f32_32x32x16_bf16(PAF(0),VFR(0),o[0],0,0,0), C0,0); \
    GAPB(o[1]=__builtin_amdgcn_mfma_f32_32x32x16_bf16(PAF(0),VFR(4),o[1],0,0,0), C0,4); \
    KRD(GL,0); GAPB(o[0]=__builtin_amdgcn_mfma_f32_32x32x16_bf16(PAF(1),VFR(1),o[0],0,0,0), C0,8); \
    KRD(GL,1); GAPB(o[1]=__builtin_amdgcn_mfma_f32_32x32x16_bf16(PAF(1),VFR(5),o[1],0,0,0), C0,12); \
    KRD(GL,2); GAPB(o[0]=__builtin_amdgcn_mfma_f32_32x32x16_bf16(PAF(2),VFR(2),o[0],0,0,0), C1,0); \
    KRD(GL,3); GAPB(o[1]=__builtin_amdgcn_mfma_f32_32x32x16_bf16(PAF(2),VFR(6),o[1],0,0,0), C1,4); \
    GAPB(o[0]=__builtin_amdgcn_mfma_f32_32x32x16_bf16(PAF(3),VFR(3),o[0],0,0,0), C1,8); \
    GAPB(o[1]=__builtin_amdgcn_mfma_f32_32x32x16_bf16(PAF(3),VFR(7),o[1],0,0,0), C1,12); \
    }while(0)
  int t=1;
  for(;t+5<NT;t+=2){
    STEP(pB0,pB1,pA0,pA1,t,true,true,true);     WAIT_BAR(2); RESC(); ROT();
    STEP(pA0,pA1,pB0,pB1,t+1,true,true,true);   WAIT_BAR(2); RESC(); ROT();
  }
  #define ENDW(tt) do{ if((tt)+3<NT){WAIT_BAR(2);} else if((tt)+2<NT){WAIT_BAR(1);} else {WAIT_BAR(0);} }while(0)
  for(;t+1<NT;t+=2){
    STEP(pB0,pB1,pA0,pA1,t,(t+3<NT),(t+1<NT),(t+1<NT));       ENDW(t);   RESC(); ROT();
    STEP(pA0,pA1,pB0,pB1,t+1,(t+4<NT),(t+2<NT),(t+2<NT));     ENDW(t+1); RESC(); ROT();
  }
  STEP(pB0,pB1,pA0,pA1,NT-1,false,false,false); RESC();
  { float sacc=pB0[0]+pB0[1]; _Pragma("unroll") for(int r=2;r<16;++r)sacc+=pB0[r]; _Pragma("unroll") for(int r=0;r<16;++r)sacc+=pB1[r]; l_reg+=sacc;
    pw0=(u32x4){PKW(pB0,0),PKW(pB0,2),PKW(pB0,4),PKW(pB0,6)};pw1=(u32x4){PKW(pB0,8),PKW(pB0,10),PKW(pB0,12),PKW(pB0,14)};pw2=(u32x4){PKW(pB1,0),PKW(pB1,2),PKW(pB1,4),PKW(pB1,6)};pw3=(u32x4){PKW(pB1,8),PKW(pB1,10),PKW(pB1,12),PKW(pB1,14)};
    SBAR(); pv(o,vb0+sl_cur,PAF(0),PAF(1),PAF(2),PAF(3)); }
  #undef PKW
  #undef PAF
  #undef VFR
  #undef PIN
  #undef MX3
  #undef GAPA
  #undef GAPB
  #undef EX
  #undef VRD
  #undef KRD
  #undef STEP
  #undef ENDW
  {auto rr=__builtin_amdgcn_permlane32_swap(__float_as_uint(l_reg),__float_as_uint(l_reg),false,false);l_reg=__uint_as_float(rr[0])+__uint_as_float(rr[1]);}
  if(hi==0)wsf[32+r32]=l_reg;asm volatile("s_waitcnt lgkmcnt(0)":::"memory");
  float rli[16];
  #pragma unroll
  for(int r=0;r<16;++r)rli[r]=__builtin_amdgcn_rcpf(wsf[32+crow(r,hi)]);
  bf16*Ow=O+(rowbase+q0+wid*QBLK)*OP+OCOL+h*D;
  { bf16*stg=(bf16*)(shm+LDS_OST)+wid*2048;
    #pragma unroll
    for(int r=0;r<16;++r){const int orow=crow(r,hi);
      #pragma unroll
      for(int d0=0;d0<2;++d0)stg[orow*64+d0*32+r32]=__float2bfloat16(o[d0][r]*rli[r]);}
    asm volatile("s_waitcnt lgkmcnt(0)":::"memory");
    #pragma unroll
    for(int i=0;i<4;++i){const int row=i*8+(lane>>3),ch=lane&7; const u32x4 v=*(const u32x4*)(stg+row*64+ch*8); ATTN_STORE16(Ow+(long)row*OP+ch*8,v);} }
  asm volatile("s_waitcnt lgkmcnt(0)\n\ts_barrier":::"memory");
  #undef DMA_K
  #undef DMA_V
  #undef START
  #undef RESC
  #undef ROT
}
constexpr int ATTN_LDS_BYTES=LDS_BYTES;
#undef SBAR
#undef WAIT_BAR
}
constexpr int NWAVES = 8;
constexpr int BATCH = 8, SEQ = 4096, DM = 1024, T = BATCH * SEQ;
constexpr int GLA_H = 4, GLA_DK = 64, GLA_DV = 128, GLA_RANK = 16;
constexpr int ATT_H = 8, ATT_KVH = 2, ATT_DH = 64;
constexpr int D_IN = 2336, D_IN_PAD = 2560;
constexpr int NEXP = 32, TOPK = 4, DFF = 1024;
constexpr int EROWS = 32768;
constexpr int PROWS = T * TOPK + NEXP * 256;
constexpr float EPS = 1e-6f;
constexpr float YSCALE = 16.f;
constexpr float WSCALE = 32.f, ASCALE = 4.f;

constexpr size_t MiB = 1u << 20;
constexpr size_t WS_CTL = 0, CTL_ZERO_BYTES = 1 * MiB;
constexpr size_t WS_WRH = 1 * MiB, WS_WRL = WS_WRH + 65536;
constexpr size_t WS_WIN = 2 * MiB;
constexpr size_t WS_WOUT = 8 * MiB;
constexpr size_t WS_W1 = 10 * MiB;
constexpr size_t WS_W2 = 138 * MiB;
constexpr size_t WS_ROWTOK = 202 * MiB;
constexpr size_t WS_ROWGATE = 206 * MiB;
constexpr size_t WS_TOKASG = 210 * MiB;
constexpr size_t WS_REGY = 212 * MiB;
constexpr size_t WS_XN = WS_REGY;
constexpr size_t WS_GQ = WS_XN + 64 * MiB;
constexpr size_t WS_GK = WS_GQ + 16 * MiB;
constexpr size_t WS_GV = WS_GK + 16 * MiB;
constexpr size_t WS_GR = WS_GV + 32 * MiB;
constexpr size_t WS_AQ = WS_GR + 32 * MiB;
constexpr size_t WS_AK = WS_AQ + 32 * MiB;
constexpr size_t WS_AV = WS_AK + 8 * MiB;
constexpr size_t WS_Z = WS_AV + 8 * MiB;
constexpr size_t WS_OF = WS_Z + 2 * MiB;
constexpr size_t WS_H16 = WS_REGY + 200 * MiB;
constexpr size_t WS_Y = WS_REGY;
constexpr size_t WS_REGA = WS_REGY + 274 * MiB;
constexpr size_t WS_MIX = WS_REGA;
constexpr size_t WS_ACT = WS_REGA;
constexpr size_t WS_QF = WS_REGA + 272 * MiB, WS_KF = WS_QF + 16 * MiB, WS_QB = WS_KF + 16 * MiB, WS_KB = WS_QB + 16 * MiB;
constexpr size_t WS_DEC = WS_KB + 16 * MiB;
constexpr size_t WS_RINV = WS_DEC + 1 * MiB;
constexpr size_t WS_END = WS_RINV + 1 * MiB;
static_assert(WS_OF + (size_t)T * 512 * 4 <= WS_REGA && (size_t)PROWS * 1024 * 2 <= 272 * MiB, "d_ws map");
constexpr int CW_BAR = 4096;
constexpr int CW_CNT = 8192;
constexpr int CW_CONV = 20480;
constexpr int CW_GDN = 16384;
constexpr int CW_QUE = 12288;

constexpr int SCR_BYTES = 133120;
constexpr int LC_OFF = SCR_BYTES;
constexpr int LC_MISC = LC_OFF;
constexpr int LC_CNT = LC_OFF + 128;
constexpr int LC_CST = LC_CNT + 128;
constexpr int LC_TE = LC_CST + 256;
constexpr int LC_HIST = LC_TE + 1152;
constexpr int LC_BASE = LC_HIST + 128;
constexpr int LC_ASG = LC_BASE + 128;
constexpr int LC_GDEC = LC_ASG + 8192;
constexpr int LC_END = LC_GDEC + 512;
constexpr int LDS_BYTES = 147456;
static_assert(LC_END <= LDS_BYTES, "LDS map");

typedef unsigned short bf16;
typedef unsigned v4u __attribute__((ext_vector_type(4)));
typedef unsigned v2u __attribute__((ext_vector_type(2)));
typedef float f32x4 __attribute__((ext_vector_type(4)));
typedef short bf16x8 __attribute__((ext_vector_type(8)));
typedef GAS unsigned gu32;
#define RLX_AGENT __ATOMIC_RELAXED, __HIP_MEMORY_SCOPE_AGENT
#define LDS_WAIT() asm volatile("s_waitcnt lgkmcnt(0)" ::: "memory")
#define VM_WAIT() asm volatile("s_waitcnt vmcnt(0)" ::: "memory")
__device__ __forceinline__ unsigned pk2(float lo, float hi) { typedef float f2_t_ __attribute__((ext_vector_type(2))); typedef __bf16 b2_t_ __attribute__((ext_vector_type(2))); const f2_t_ v = {lo, hi}; return __builtin_bit_cast(unsigned, __builtin_convertvector(v, b2_t_)); }
__device__ __forceinline__ unsigned f2bf(float f) { return pk2(f, 0.f) & 0xffffu; }
__device__ __forceinline__ float bf2f(unsigned h) { return __builtin_bit_cast(float, h << 16); }
__device__ __forceinline__ float bflo(unsigned w) { return __builtin_bit_cast(float, w << 16); }
__device__ __forceinline__ float bfhi(unsigned w) { return __builtin_bit_cast(float, w & 0xffff0000u); }

#define XB_TMO      128
#define XB_XCNT(j)  (256  + 64 * (j))
#define XB_XSUB(j)  (1280 + 64 * (j))
#define XB_XGEN(j)  (2304 + 64 * (j))
#define XB_TOP      3328
#define XB_TOPGEN   3392
#define XCD_BAR_WORDS 3456
#define XB_SPIN_CAP (1u << 18)
__device__ __forceinline__ unsigned xb_ld(unsigned* p)              { return __hip_atomic_load(p, __ATOMIC_RELAXED, __HIP_MEMORY_SCOPE_AGENT); }
__device__ __forceinline__ unsigned xb_add(unsigned* p, unsigned v) { return __hip_atomic_fetch_add(p, v, __ATOMIC_RELAXED, __HIP_MEMORY_SCOPE_AGENT); }
__device__ __forceinline__ unsigned xb_xcc_id() { return (unsigned)__builtin_amdgcn_s_getreg((3 << 11) | 20) & 0xFu; }
#define XB_SPIN(cond, bar) do { unsigned _sp = 0; while (cond) { __builtin_amdgcn_s_sleep(1); \
    if ((++_sp & 255u) == 0u) { if (xb_ld(&(bar)[XB_TMO])) break; if (_sp > XB_SPIN_CAP) { atomicAdd(&(bar)[XB_TMO], 1u); break; } } } } while (0)
struct XcdBarrier { unsigned* bar; unsigned x; volatile LAS unsigned* st; };
__device__ __forceinline__ XcdBarrier xcd_barrier_post(unsigned* bar, volatile LAS unsigned* st) {
    XcdBarrier b; b.bar = bar; b.x = xb_xcc_id(); b.st = st;
    if (threadIdx.x == 0) (void)xb_add(&bar[XB_XCNT(b.x)], 1u);
    return b;
}
__device__ __forceinline__ void xcd_barrier_complete(unsigned* bar, unsigned x, unsigned& nloc, unsigned& nx) {
    const unsigned G = gridDim.x * gridDim.y * gridDim.z;
    unsigned sum, cnt, mine, sp = 0u;
    for (;;) {
        sum = 0u; cnt = 0u; mine = 0u;
#pragma unroll
        for (unsigned j = 0; j < 16; ++j) { const unsigned c = xb_ld(&bar[XB_XCNT(j)]); sum += c; cnt += (c > 0u) ? 1u : 0u; mine = (j == x) ? c : mine; }
        if (sum == G) break;
        __builtin_amdgcn_s_sleep(1);
        if ((++sp & 255u) == 0u) { if (xb_ld(&bar[XB_TMO])) break; if (sp > XB_SPIN_CAP) { atomicAdd(&bar[XB_TMO], 1u); break; } }
    }
    nloc = mine > 0u ? mine : 1u; nx = cnt > 0u ? cnt : 1u;
}
__device__ __forceinline__ void xcd_barrier(const XcdBarrier& b) {
    asm volatile("s_waitcnt vmcnt(0)" ::: "memory");
    __syncthreads();
    if (threadIdx.x == 0) {
        unsigned* bar = b.bar;
        __builtin_amdgcn_s_waitcnt(0);
        unsigned nloc = b.st[0], nx = b.st[1];
        if (nloc == 0u) { xcd_barrier_complete(bar, b.x, nloc, nx); b.st[0] = nloc; b.st[1] = nx; }
        const unsigned old = xb_add(&bar[XB_XSUB(b.x)], 1u);
        const unsigned gen = old / nloc;
        if (old + 1u == (gen + 1u) * nloc) {
            __builtin_amdgcn_fence(__ATOMIC_RELEASE, "agent");
            asm volatile("s_waitcnt vmcnt(0)" ::: "memory");
            const unsigned og = xb_add(&bar[XB_TOP], 1u);
            const unsigned tg = og / nx;
            if (og + 1u == (tg + 1u) * nx) xb_add(&bar[XB_TOPGEN], 1u);
            else XB_SPIN(xb_ld(&bar[XB_TOPGEN]) == tg, bar);
            __builtin_amdgcn_fence(__ATOMIC_ACQUIRE, "agent");
            xb_add(&bar[XB_XGEN(b.x)], 1u);
            asm volatile("s_waitcnt vmcnt(0)" ::: "memory");
        } else {
            XB_SPIN(xb_ld(&bar[XB_XGEN(b.x)]) == gen, bar);
            __builtin_amdgcn_fence(__ATOMIC_ACQUIRE, "agent");
            asm volatile("s_waitcnt vmcnt(0)" ::: "memory");
        }
    }
    __syncthreads();
}

struct Frame {
    LAS unsigned char* lds;
    volatile LAS unsigned* MISC;
    gu32* ctl;
    int tid, lane, wave;
    int vcu, G;
    unsigned char* ws;
    const float *x, *mix_g, *w_in, *w_gf, *b_gf, *w_gb, *b_gb, *gla_hg, *q_g, *k_g, *w_out, *ffn_g, *w_router, *b_router, *w1, *b1, *w2, *b2, *fin_g;
    float* out;
};
template <int CTRL> __device__ __forceinline__ float dpp_mov(float v) { return __builtin_bit_cast(float, __builtin_amdgcn_update_dpp(0, __builtin_bit_cast(int, v), CTRL, 0xf, 0xf, true)); }
__device__ __forceinline__ float wave_sum(float v) {
    v += dpp_mov<0xB1>(v);
    v += dpp_mov<0x4E>(v);
    v += dpp_mov<0x141>(v);
    v += dpp_mov<0x140>(v);
    { auto r = __builtin_amdgcn_permlane16_swap(__float_as_uint(v), __float_as_uint(v), false, false); v = __uint_as_float(r[0]) + __uint_as_float(r[1]); }
    { auto r = __builtin_amdgcn_permlane32_swap(__float_as_uint(v), __float_as_uint(v), false, false); v = __uint_as_float(r[0]) + __uint_as_float(r[1]); }
    return v;
}
__device__ __forceinline__ void p0_tr64(const float* src  , int ldw, bf16* d0, bf16* d1, int ldt, LAS float* scr, int lane, int ncols, const float* kg  ) {
    const int c4 = (lane & 15) * 4, kr = lane >> 4;
    if (c4 < ncols) {
#pragma unroll 4
        for (int i = 0; i < 16; ++i) { const int kk = kr + 4 * i; const f32x4 v = *(const GAS f32x4*)(src + (size_t)kk * ldw + c4) * (kg ? kg[kk] : 1.f);
            LAS float* s = scr + kk * 65 + c4; s[0] = v.x; s[1] = v.y; s[2] = v.z; s[3] = v.w; }
    }
    LDS_WAIT(); asm volatile("" ::: "memory");
    const int c = lane & 7;
#pragma unroll
    for (int j = 0; j < 8; ++j) { const int n = (lane >> 3) + 8 * j;
        if (n < ncols) { const LAS float* s = scr + (8 * c) * 65 + n;
            v4u o; o.x = pk2(s[0 * 65], s[1 * 65]); o.y = pk2(s[2 * 65], s[3 * 65]); o.z = pk2(s[4 * 65], s[5 * 65]); o.w = pk2(s[6 * 65], s[7 * 65]);
            bf16* rowp = (n < 32 ? d0 : d1) + (size_t)(n & 31) * ldt;
            *(GAS v4u*)(rowp + 8 * c) = o; } }
    LDS_WAIT(); asm volatile("" ::: "memory");
}
struct F8Item { const float* src; int ldw; unsigned char* d0; unsigned char* d1; };
__device__ __forceinline__ void f8_load(const F8Item& it, f32x4 (&v)[16], int lane) {
    const int c4 = (lane & 15) * 4, kr = lane >> 4;
#pragma unroll
    for (int i = 0; i < 16; ++i) v[i] = __builtin_nontemporal_load((const GAS f32x4*)(it.src + (size_t)(kr + 4 * i) * it.ldw + c4));
}
__device__ __forceinline__ void f8_finish(const F8Item& it, const f32x4 (&v)[16], LAS float* scr, int lane, float sc) {
    const int c4 = (lane & 15) * 4, kr = lane >> 4;
#pragma unroll
    for (int i = 0; i < 16; ++i) { LAS float* s = scr + (kr + 4 * i) * 65 + c4; s[0] = v[i].x; s[1] = v[i].y; s[2] = v[i].z; s[3] = v[i].w; }
    LDS_WAIT(); asm volatile("" ::: "memory");
    const int c = lane & 7;
#pragma unroll
    for (int j = 0; j < 8; ++j) { const int n = (lane >> 3) + 8 * j; const LAS float* s = scr + (8 * c) * 65 + n;
        int w0 = 0, w1 = 0;
        w0 = __builtin_amdgcn_cvt_pk_fp8_f32(s[0 * 65] * sc, s[1 * 65] * sc, w0, false); w0 = __builtin_amdgcn_cvt_pk_fp8_f32(s[2 * 65] * sc, s[3 * 65] * sc, w0, true);
        w1 = __builtin_amdgcn_cvt_pk_fp8_f32(s[4 * 65] * sc, s[5 * 65] * sc, w1, false); w1 = __builtin_amdgcn_cvt_pk_fp8_f32(s[6 * 65] * sc, s[7 * 65] * sc, w1, true);
        unsigned char* rowp = (n < 32 ? it.d0 : it.d1) + (size_t)(n & 31) * 1024;
        __builtin_nontemporal_store((v2u){(unsigned)w0, (unsigned)w1}, (GAS v2u*)(rowp + 8 * c)); }
    LDS_WAIT(); asm volatile("" ::: "memory");
}
__device__ __forceinline__ int win_pblk(int lb) { return lb < 48 ? lb : (lb == 48 ? 72 : lb - 1); }
__device__ __forceinline__ int w1_pblk(int lb) { return lb < 32 ? (lb >> 2) * 8 + (lb & 3) : ((lb - 32) >> 2) * 8 + 4 + ((lb - 32) & 3); }
__device__ __forceinline__ void rms_row_load(const float* xrow, f32x4 (&v)[4], int lane) {
    const GAS f32x4* xr = (const GAS f32x4*)xrow + lane;
#pragma unroll
    for (int j = 0; j < 4; ++j) v[j] = __builtin_nontemporal_load(xr + 64 * j);
}
__device__ __forceinline__ void rms_row_finish(const f32x4 (&v)[4], bf16* orow, float* rinv_out, int lane) {
    float s = 0.f;
    GAS unsigned long long* o8 = (GAS unsigned long long*)orow + lane;
#pragma unroll
    for (int j = 0; j < 4; ++j) { s += (v[j].x * v[j].x + v[j].y * v[j].y) + (v[j].z * v[j].z + v[j].w * v[j].w);
        o8[64 * j] = (unsigned long long)pk2(v[j].x, v[j].y) | ((unsigned long long)pk2(v[j].z, v[j].w) << 32); }
    const float rinv = 1.f / sqrtf(wave_sum(s) * (1.f / 1024.f) + EPS);
    if (lane == 0) *rinv_out = rinv;
}
__device__ __forceinline__ F8Item f8_item(Frame& F, int r) {
    F8Item it;
    if (r < NEXP * 512) { const int e = r / 512, q = r % 512, kb = q / 32, nb = q % 32; it.src = F.w1 + (size_t)e * 1024 * 2048 + (size_t)(64 * kb) * 2048 + 64 * nb; it.ldw = 2048;
        unsigned char* dst = F.ws + WS_W1 + (size_t)e * 2048 * 1024 + 64 * kb; it.d0 = dst + (size_t)(32 * w1_pblk(2 * nb)) * 1024; it.d1 = dst + (size_t)(32 * w1_pblk(2 * nb + 1)) * 1024; }
    else { const int r2 = r - NEXP * 512, e = r2 / 256, q = r2 % 256, kb = q / 16, nb = q % 16; it.src = F.w2 + (size_t)e * 1024 * 1024 + (size_t)(64 * kb) * 1024 + 64 * nb; it.ldw = 1024;
        unsigned char* dst = F.ws + WS_W2 + (size_t)e * 1024 * 1024 + 64 * kb; it.d0 = dst + (size_t)(64 * nb) * 1024; it.d1 = dst + (size_t)(64 * nb + 32) * 1024; }
    return it;
}
constexpr int N_F8_ITEMS = NEXP * 512 + NEXP * 256, N_CONV_BATCH = N_F8_ITEMS / 64;
__device__ __forceinline__ void f8_items(Frame& F, int r, int step, int rend, LAS float* scr) {
    if (r >= rend) return;
    F8Item cur = f8_item(F, r); f32x4 va[16], vb[16];
    f8_load(cur, va, F.lane);
    for (;;) {
        int rn = r + step; F8Item nx = cur; if (rn < rend) { nx = f8_item(F, rn); f8_load(nx, vb, F.lane); }
        f8_finish(cur, va, scr, F.lane, WSCALE);
        if (rn >= rend) break;
        r = rn + step; cur = nx; if (r < rend) { cur = f8_item(F, r); f8_load(cur, va, F.lane); }
        f8_finish(nx, vb, scr, F.lane, WSCALE);
        if (r >= rend) break;
    }
}
__device__ __forceinline__ bool conv_pull(Frame& F) {
    __syncthreads();
    if (F.tid == 0) F.MISC[17] = __hip_atomic_fetch_add(F.ctl + CW_CONV, 1u, RLX_AGENT);
    __syncthreads();
    const int cb = __builtin_amdgcn_readfirstlane((int)F.MISC[17]);
    if (cb >= N_CONV_BATCH) return false;
    f8_items(F, cb * 64 + F.wave * 8, 1, cb * 64 + F.wave * 8 + 8, (LAS float*)(F.lds + F.wave * 16640));
    return true;
}
__device__ __forceinline__ void p0_prologue(Frame& F) {
    LAS float* scr = (LAS float*)(F.lds + F.wave * 16640);
    const int gw = F.vcu * NWAVES + F.wave, NGW = F.G * NWAVES;
    bf16* WIN = (bf16*)(F.ws + WS_WIN); bf16* WOUT = (bf16*)(F.ws + WS_WOUT);
    constexpr int I_IN = 16 * 37, I_OUT = 16 * 16, NITEMS = I_IN + I_OUT;
    for (int it = gw; it < NITEMS; it += NGW) {
        int r = it;
        if (r < I_IN) { const int kb = r / 37, nb = r % 37; const int lb0 = 2 * nb, nc = (nb == 36) ? 32 : 64;
            p0_tr64(F.w_in + (size_t)(64 * kb) * D_IN + 64 * nb, D_IN, WIN + (size_t)(32 * win_pblk(lb0)) * 1024 + 64 * kb, WIN + (size_t)(32 * win_pblk(lb0 + 1 < 73 ? lb0 + 1 : lb0)) * 1024 + 64 * kb, 1024, scr, F.lane, nc, F.mix_g + 64 * kb); continue; }
        r -= I_IN;
        { const int kb = r / 16, nb = r % 16;
            p0_tr64(F.w_out + (size_t)(64 * kb) * 1024 + 64 * nb, 1024, WOUT + (size_t)(64 * nb) * 1024 + 64 * kb, WOUT + (size_t)(64 * nb + 32) * 1024 + 64 * kb, 1024, scr, F.lane, 64, nullptr); }
    }
    { const int gt = F.vcu * (NWAVES * 64) + F.tid, NGT = F.G * NWAVES * 64; GAS v4u* z = (GAS v4u*)(WIN + (size_t)D_IN * 1024);
      for (int i = gt; i < (D_IN_PAD - D_IN) * 1024 * 2 / 16; i += NGT) z[i] = (v4u){0u, 0u, 0u, 0u};
      bf16* WRH = (bf16*)(F.ws + WS_WRH); bf16* WRL = (bf16*)(F.ws + WS_WRL);
      for (int i = gt; i < NEXP * 1024; i += NGT) { const int e = i >> 10, k = i & 1023; const float w = F.w_router[(size_t)k * NEXP + e]; const unsigned h = f2bf(w); WRH[i] = (bf16)h; WRL[i] = (bf16)f2bf(w - bf2f(h)); } }
    bf16* XN = (bf16*)(F.ws + WS_XN);
    { f32x4 va[4], vb[4]; float* RINV = (float*)(F.ws + WS_RINV);
      int m = gw;
      if (m < T) { rms_row_load(F.x + (size_t)m * DM, va, F.lane);
        for (;;) {
            const int m1 = m + NGW; if (m1 < T) rms_row_load(F.x + (size_t)m1 * DM, vb, F.lane);
            rms_row_finish(va, XN + (size_t)m * DM, RINV + m, F.lane);
            if (m1 >= T) break;
            m = m1 + NGW; if (m < T) rms_row_load(F.x + (size_t)m * DM, va, F.lane);
            rms_row_finish(vb, XN + (size_t)m1 * DM, RINV + m1, F.lane);
            if (m >= T) break;
        } } }
}

__device__ __forceinline__ void p2_normrope(Frame& F) {
    LAS float* cs = (LAS float*)F.lds;
    for (int i = F.tid; i < 1024; i += NWAVES * 64) { const int pos = i >> 4, fi = i & 15; const float inv = exp2f(-(float)fi * (13.287712379549449f / 16.f)); const float a = (float)pos * inv;
        cs[2 * i] = __cosf(a); cs[2 * i + 1] = __sinf(a); }
    __syncthreads();
    const int gw = F.vcu * NWAVES + F.wave, NGW = F.G * NWAVES, lane = F.lane;
    const int j = lane & 7, blk = (j >> 2) & 1, jj = j & 3, fi0 = 8 * (jj & 1); const bool second = (jj >> 1) != 0;
    float gq[8], gk[8];
#pragma unroll
    for (int e = 0; e < 8; ++e) { gq[e] = F.q_g[8 * j + e]; gk[e] = F.k_g[8 * j + e]; }
    bf16* AQ = (bf16*)(F.ws + WS_AQ); bf16* AK = (bf16*)(F.ws + WS_AK);
    v4u wnext = (v4u){0u, 0u, 0u, 0u};
    if (T + gw < T + T / 4) wnext = *((GAS v4u*)(AK + (size_t)(4 * gw + (lane >> 4)) * 128) + (lane & 15));
    for (int it = T + gw; it < T + T / 4; it += NGW) {
        const bool isq = false;
        const int tok = 4 * (it - T) + (lane >> 4);
        GAS v4u* p = (GAS v4u*)(AK + (size_t)tok * 128) + (lane & 15);
        const v4u w = wnext;
        if (it + NGW < T + T / 4) wnext = *((GAS v4u*)(AK + (size_t)(4 * (it + NGW - T) + (lane >> 4)) * 128) + (lane & 15));
        float x[8] = {bflo(w.x), bfhi(w.x), bflo(w.y), bfhi(w.y), bflo(w.z), bfhi(w.z), bflo(w.w), bfhi(w.w)};
        float ss = 0.f;
#pragma unroll
        for (int e = 0; e < 8; ++e) ss += x[e] * x[e];
        ss += __shfl_xor(ss, 1); ss += __shfl_xor(ss, 2); ss += __shfl_xor(ss, 4);
        const float rinv = 1.f / sqrtf(ss * (1.f / 64.f) + EPS);
        const int ts = tok & (SEQ - 1), pos = blk ? (ts & 63) : (ts >> 6);
        const LAS float* c = cs + (pos * 16 + fi0) * 2;
        float y[8];
#pragma unroll
        for (int e = 0; e < 8; ++e) { x[e] = x[e] * rinv * (isq ? gq[e] : gk[e]); }
#pragma unroll
        for (int e = 0; e < 8; ++e) { const float pr = __shfl_xor(x[e], 2); const float co = c[2 * e], si = c[2 * e + 1]; y[e] = second ? (x[e] * co + pr * si) : (x[e] * co - pr * si); }
        const float sc = isq ? attn_body::C2 : 1.f;
        v4u o; o.x = pk2(y[0] * sc, y[1] * sc); o.y = pk2(y[2] * sc, y[3] * sc); o.z = pk2(y[4] * sc, y[5] * sc); o.w = pk2(y[6] * sc, y[7] * sc);
        *p = o;
    }
}
namespace gla {
typedef short bf16x8 __attribute__((ext_vector_type(8)));
typedef short s16x4 __attribute__((ext_vector_type(4)));
typedef float f32x4 __attribute__((ext_vector_type(4)));
constexpr int P64 = 144, PV = 272, POT = 528;
constexpr int L_QS = 0, L_KS = 9216, L_VR = 18432, L_AS = 35840, L_ST = 45056, L_OT = 63488, L_SET2 = 97280, L_END = 133120;
constexpr int L_DEC = LC_GDEC;
__device__ __forceinline__ unsigned cvtpk(float lo, float hi) { typedef float f2_t __attribute__((ext_vector_type(2))); typedef __bf16 b2_t __attribute__((ext_vector_type(2))); f2_t v = {lo, hi}; b2_t b = __builtin_convertvector(v, b2_t); return __builtin_bit_cast(unsigned, b); }
__device__ __forceinline__ float logsig(float x) { return fminf(x, 0.f) - __logf(1.f + __expf(-fabsf(x))); }
__device__ __forceinline__ s16x4 vtr(const LAS unsigned char* p) { typedef short v4i16_t __attribute__((ext_vector_type(4))); return __builtin_bit_cast(s16x4, __builtin_amdgcn_ds_read_tr16_b64_v4i16((LAS v4i16_t*)p)); }

__device__ __forceinline__ void gla_prep_unit(Frame& F, int b, int c) {
    LAS unsigned char* L = F.lds;
    const int tid = F.tid, dir = __builtin_amdgcn_readfirstlane(tid >> 8), col = tid & 255;
    const bf16* GQ = (const bf16*)(F.ws + WS_GQ); const bf16* GK = (const bf16*)(F.ws + WS_GK); const bf16* ZZ = (const bf16*)(F.ws + WS_Z);
    bf16* QX = (bf16*)(F.ws + (dir ? WS_QB : WS_QF)); bf16* KX = (bf16*)(F.ws + (dir ? WS_KB : WS_KF)); float* DEC = (float*)(F.ws + WS_DEC) + (size_t)dir * (BATCH * 64 * 256);
    const unsigned row0 = (unsigned)b * SEQ + (unsigned)c * 64u;
    __syncthreads();
    { typedef float f32x16 __attribute__((ext_vector_type(16)));
      const int w_ = F.wave, lane = F.lane, r32 = lane & 31, hi = lane >> 5, colw = 32 * w_ + r32;
#pragma unroll
      for (int d = 0; d < 2; ++d) { const float* WGd = d ? F.w_gb : F.w_gf; const float bgd = (d ? F.b_gb : F.b_gf)[colw];
          float wv[8];
#pragma unroll
          for (int j = 0; j < 8; ++j) wv[j] = WGd[(8 * hi + j) * 256 + colw];
          v4u wh, wl;
          wh.x = pk2(wv[0], wv[1]); wh.y = pk2(wv[2], wv[3]); wh.z = pk2(wv[4], wv[5]); wh.w = pk2(wv[6], wv[7]);
          wl.x = pk2(wv[0] - bflo(wh.x), wv[1] - bfhi(wh.x)); wl.y = pk2(wv[2] - bflo(wh.y), wv[3] - bfhi(wh.y)); wl.z = pk2(wv[4] - bflo(wh.z), wv[5] - bfhi(wh.z)); wl.w = pk2(wv[6] - bflo(wh.w), wv[7] - bfhi(wh.w));
#pragma unroll
          for (int hf = 0; hf < 2; ++hf) { const v4u zf = *(const GAS v4u*)(ZZ + (row0 + 32 * hf + r32) * 32 + d * 16 + 8 * hi);
              f32x16 acc = {};
              acc = __builtin_amdgcn_mfma_f32_32x32x16_bf16(__builtin_bit_cast(bf16x8, zf), __builtin_bit_cast(bf16x8, wh), acc, 0, 0, 0);
              acc = __builtin_amdgcn_mfma_f32_32x32x16_bf16(__builtin_bit_cast(bf16x8, zf), __builtin_bit_cast(bf16x8, wl), acc, 0, 0, 0);
#pragma unroll
              for (int r = 0; r < 16; ++r) { const int pos = 32 * hf + (r & 3) + 8 * (r >> 2) + 4 * hi; *(LAS float*)(L + (size_t)((d * 64 + pos) * 256 + colw) * 4) = logsig(acc[r] + bgd) * (1.f / 16.f); } } } }
    __syncthreads();
    float pf[64]; float run = 0.f;
#pragma unroll
    for (int p = 0; p < 64; ++p) pf[p] = *(const LAS float*)(L + (size_t)((dir * 64 + p) * 256 + col) * 4);
    asm volatile("s_waitcnt lgkmcnt(0)" ::: "memory");
#pragma unroll
    for (int p = 0; p < 64; ++p) { asm volatile("" : "+v"(pf[p])); run += pf[p]; pf[p] = run; }
    const float tot = run;
    const bf16* gqc = GQ + (size_t)row0 * 256 + col; const bf16* gkc = GK + (size_t)row0 * 256 + col; bf16* qxc = QX + (size_t)row0 * 256 + col; bf16* kxc = KX + (size_t)row0 * 256 + col;
    unsigned short qa[16], ka[16], qb[16], kb[16];
#define GP_LOAD(g, qx, kx) do { _Pragma("unroll") for (int i = 0; i < 16; ++i) { qx[i] = gqc[(16 * (g) + i) * 256]; kx[i] = gkc[(16 * (g) + i) * 256]; } } while (0)
#define GP_PROC(g, qx, kx) do { _Pragma("unroll") for (int i = 0; i < 16; ++i) { const int p = 16 * (g) + i; const float qv = bf2f(qx[i]), kv = bf2f(kx[i]); \
        const float ex = dir ? (p ? pf[p ? p - 1 : 0] : 0.f) : 0.f; \
        const float eq = dir ? __expf(-ex) * 0.125f : __expf(pf[p] - tot) * 0.125f; \
        const float ek = dir ? __expf(ex) : __expf(tot - pf[p]); \
        qxc[p * 256] = (bf16)f2bf(qv * eq); kxc[p * 256] = (bf16)f2bf(kv * ek); } } while (0)
    GP_LOAD(0, qa, ka); GP_LOAD(1, qb, kb);
    GP_PROC(0, qa, ka); GP_LOAD(2, qa, ka);
    GP_PROC(1, qb, kb); GP_LOAD(3, qb, kb);
    GP_PROC(2, qa, ka); GP_PROC(3, qb, kb);
#undef GP_LOAD
#undef GP_PROC
    DEC[((unsigned)b * 64 + c) * 256 + col] = __expf(tot);
}

__device__ __forceinline__ void gla_unit(Frame& F, int b, int h, int dir) {
    LAS unsigned char* L = F.lds;
    const int tid = F.tid, lane = F.lane, w = F.wave, q4 = lane >> 4, l15 = lane & 15;
    const bf16* GV = (const bf16*)(F.ws + WS_GV);
    bf16* OX = (bf16*)(F.ws + WS_OF + (dir ? 32 * MiB : 0));
    const unsigned rowbase = (unsigned)b * SEQ;
    const int v0 = 16 * w;
    const int erow = tid >> 3, eseg = tid & 7;
    const int plq = tid >> 3, sgq = tid & 7, plv = tid >> 4, sgv = tid & 15;
    {
        const bf16* QX = (const bf16*)(F.ws + (dir ? WS_QB : WS_QF)); const bf16* KX = (const bf16*)(F.ws + (dir ? WS_KB : WS_KF));
        const float* DEC = (const float*)(F.ws + WS_DEC) + (size_t)dir * (BATCH * 64 * 256);
        f32x4 S[4];
#pragma unroll
        for (int i = 0; i < 4; ++i) S[i] = (f32x4){0.f, 0.f, 0.f, 0.f};
        v4u rq, rk, rv0, rv1; float rdec = 0.f;
#define GLA_LOAD(ci) do { const int c_ = dir ? 63 - (ci) : (ci); const unsigned cb_ = rowbase + (unsigned)c_ * 64u; \
            rq = __builtin_nontemporal_load((const GAS v4u*)(QX + (cb_ + plq) * 256 + h * 64 + sgq * 8)); rk = __builtin_nontemporal_load((const GAS v4u*)(KX + (cb_ + plq) * 256 + h * 64 + sgq * 8)); \
            rv0 = *(const GAS v4u*)(GV + (cb_ + plv) * 512 + h * 128 + sgv * 8); rv1 = *(const GAS v4u*)(GV + (cb_ + plv + 32) * 512 + h * 128 + sgv * 8); \
            if (tid < 64) rdec = DEC[((unsigned)b * 64 + c_) * 256 + h * 64 + tid]; } while (0)
        GLA_LOAD(0);
        v4u st0 = (v4u){0u, 0u, 0u, 0u}, st1 = st0;
#define GLA_FLUSH(cprev) do { const unsigned cbp_ = rowbase + (unsigned)(cprev) * 64u; GAS v4u* sp_ = (GAS v4u*)(OX + (cbp_ + erow) * 512 + h * 128 + eseg * 16); sp_[0] = st0; sp_[1] = st1; } while (0)
#define GLA_STAGE(so) do { *(LAS v4u*)(L + (so) + L_QS + plq * P64 + sgq * 16) = rq; *(LAS v4u*)(L + (so) + L_KS + plq * P64 + sgq * 16) = rk; \
            *(LAS v4u*)(L + (so) + L_VR + plv * PV + sgv * 16) = rv0; *(LAS v4u*)(L + (so) + L_VR + (plv + 32) * PV + sgv * 16) = rv1; \
            if (tid < 64) ((LAS float*)(L + L_DEC))[((so) ? 64 : 0) + tid] = rdec; } while (0)
        __syncthreads();
        GLA_STAGE(0); GLA_LOAD(1);
        __syncthreads();
        for (int ci = 0; ci < 64; ++ci) {
            const int c = dir ? 63 - ci : ci; const int so = (ci & 1) ? L_SET2 : 0, sn = (ci & 1) ? 0 : L_SET2;
#pragma unroll
            for (int s = 0; s < 2; ++s) { const int tt = 2 * w + s, it = tt >> 2, jt = tt & 3; f32x4 a = (f32x4){0.f, 0.f, 0.f, 0.f};
                if (dir ? (jt >= it) : (jt <= it)) {
#pragma unroll
                    for (int ks = 0; ks < 2; ++ks) { const bf16x8 af = *(const LAS bf16x8*)(L + so + L_QS + (16 * it + l15) * P64 + (32 * ks + 8 * q4) * 2); const bf16x8 bfr = *(const LAS bf16x8*)(L + so + L_KS + (16 * jt + l15) * P64 + (32 * ks + 8 * q4) * 2);
                        a = __builtin_amdgcn_mfma_f32_16x16x32_bf16(af, bfr, a, 0, 0, 0); } }
#pragma unroll
                for (int rg = 0; rg < 4; ++rg) { const int i = 16 * it + 4 * q4 + rg, j = 16 * jt + l15; const bool keep = dir ? (j > i) : (j <= i);
                    *(LAS unsigned short*)(L + L_AS + i * P64 + j * 2) = (unsigned short)cvtpk(keep ? a[rg] : 0.f, 0.f); } }
#pragma unroll
            for (int dt = 0; dt < 4; ++dt) { const f32x4 dv = *(const LAS f32x4*)(L + L_DEC + ((ci & 1) ? 256 : 0) + (16 * dt + 4 * q4) * 4); S[dt] = S[dt] * dv;
                *(LAS v2u*)(L + L_ST + (v0 + l15) * P64 + (16 * dt + 4 * q4) * 2) = (v2u){cvtpk(S[dt].x, S[dt].y), cvtpk(S[dt].z, S[dt].w)}; }
            __syncthreads();
            bf16x8 bv[2], bs[2];
#pragma unroll
            for (int ks = 0; ks < 2; ++ks) { const LAS unsigned char* vp = L + so + L_VR + (32 * ks + 8 * q4 + (l15 >> 2)) * PV + (v0 + 4 * (l15 & 3)) * 2;
                const s16x4 lo = vtr(vp), hi = vtr(vp + 4 * PV); bv[ks] = (bf16x8){lo[0], lo[1], lo[2], lo[3], hi[0], hi[1], hi[2], hi[3]};
                bs[ks] = *(const LAS bf16x8*)(L + L_ST + (v0 + l15) * P64 + (32 * ks + 8 * q4) * 2); }
            f32x4 O[4];
#pragma unroll
            for (int it = 0; it < 4; ++it) { O[it] = (f32x4){0.f, 0.f, 0.f, 0.f};
#pragma unroll
                for (int ks = 0; ks < 2; ++ks) { const bf16x8 aq = *(const LAS bf16x8*)(L + so + L_QS + (16 * it + l15) * P64 + (32 * ks + 8 * q4) * 2);
                    if (dir ? !(ks == 0 && it >= 2) : !(ks == 1 && it < 2)) {
                        const bf16x8 aa = *(const LAS bf16x8*)(L + L_AS + (16 * it + l15) * P64 + (32 * ks + 8 * q4) * 2); O[it] = __builtin_amdgcn_mfma_f32_16x16x32_bf16(aa, bv[ks], O[it], 0, 0, 0); }
                    O[it] = __builtin_amdgcn_mfma_f32_16x16x32_bf16(aq, bs[ks], O[it], 0, 0, 0); } }
#pragma unroll
            for (int dt = 0; dt < 4; ++dt)
#pragma unroll
                for (int ks = 0; ks < 2; ++ks) { const LAS unsigned char* kp = L + so + L_KS + (32 * ks + 8 * q4 + (l15 >> 2)) * P64 + (16 * dt + 4 * (l15 & 3)) * 2;
                    const s16x4 lo = vtr(kp), hi = vtr(kp + 4 * P64); const bf16x8 ak = (bf16x8){lo[0], lo[1], lo[2], lo[3], hi[0], hi[1], hi[2], hi[3]};
                    S[dt] = __builtin_amdgcn_mfma_f32_16x16x32_bf16(ak, bv[ks], S[dt], 0, 0, 0); }
#pragma unroll
            for (int it = 0; it < 4; ++it)
#pragma unroll
                for (int rg = 0; rg < 4; ++rg) *(LAS float*)(L + L_OT + (16 * it + 4 * q4 + rg) * POT + (v0 + l15) * 4) = O[it][rg];
            if (ci + 1 < 64) GLA_STAGE(sn);
            asm volatile("" ::: "memory");
            if (ci > 0) GLA_FLUSH(dir ? c + 1 : c - 1);
            asm volatile("" ::: "memory");
            if (ci + 2 < 64) GLA_LOAD(ci + 2);
            __syncthreads();
            {
                float o[16];
#pragma unroll
                for (int e4 = 0; e4 < 4; ++e4) { const f32x4 t = *(const LAS f32x4*)(L + L_OT + erow * POT + (16 * eseg + 4 * e4) * 4); o[4 * e4] = t.x; o[4 * e4 + 1] = t.y; o[4 * e4 + 2] = t.z; o[4 * e4 + 3] = t.w; }
                st0 = (v4u){cvtpk(o[0], o[1]), cvtpk(o[2], o[3]), cvtpk(o[4], o[5]), cvtpk(o[6], o[7])}; st1 = (v4u){cvtpk(o[8], o[9]), cvtpk(o[10], o[11]), cvtpk(o[12], o[13]), cvtpk(o[14], o[15])};
            }
        }
        GLA_FLUSH(dir ? 0 : 63);
#undef GLA_STAGE
#undef GLA_FLUSH
#undef GLA_LOAD
    }
    VM_WAIT(); __syncthreads();
    if (tid == 0) { __builtin_amdgcn_fence(__ATOMIC_RELEASE, "agent"); VM_WAIT(); (void)__hip_atomic_fetch_add(F.ctl + CW_GDN + 64 * (b * GLA_H + h), 1u, RLX_AGENT); }
    __syncthreads();
}
__device__ __forceinline__ void gla_combine(Frame& F, int b, int h, int part) {
    const int tid = F.tid, erow = tid >> 3, eseg = tid & 7;
    if (tid == 0) { unsigned sp = 0; while (__hip_atomic_load(F.ctl + CW_GDN + 64 * (b * GLA_H + h), RLX_AGENT) < 2u && sp < (1u << 22)) { __builtin_amdgcn_s_sleep(8); ++sp; }
        __builtin_amdgcn_fence(__ATOMIC_ACQUIRE, "agent"); VM_WAIT(); }
    __syncthreads();
    const bf16* OF0 = (const bf16*)(F.ws + WS_OF); const bf16* OB0 = (const bf16*)(F.ws + WS_OF + 32 * MiB); const bf16* GR = (const bf16*)(F.ws + WS_GR); bf16* MIX = (bf16*)(F.ws + WS_MIX);
    float hg[16]; int eso = eseg; asm volatile("" : "+v"(eso));
#pragma unroll
    for (int e = 0; e < 16; ++e) hg[e] = F.gla_hg[16 * eso + e];
    const unsigned r0 = (unsigned)b * SEQ + (unsigned)part * 1024u + erow;
    v4u nf0, nf1, nb0, nb1, nr0, nr1;
#define GC_LOAD(ps_) do { const unsigned row_ = r0 + (ps_) * 64; const GAS v4u* fp = (const GAS v4u*)(OF0 + row_ * 512 + h * 128 + eseg * 16); const GAS v4u* bp = (const GAS v4u*)(OB0 + row_ * 512 + h * 128 + eseg * 16); const GAS v4u* rp = (const GAS v4u*)(GR + row_ * 512 + h * 128 + eseg * 16); \
        nf0 = __builtin_nontemporal_load(fp); nf1 = __builtin_nontemporal_load(fp + 1); nb0 = __builtin_nontemporal_load(bp); nb1 = __builtin_nontemporal_load(bp + 1); nr0 = __builtin_nontemporal_load(rp); nr1 = __builtin_nontemporal_load(rp + 1); } while (0)
    GC_LOAD(0);
#pragma unroll 2
    for (int ps = 0; ps < 16; ++ps) { const unsigned row = r0 + ps * 64;
        const v4u f0 = nf0, f1 = nf1, b0 = nb0, b1 = nb1, r0v = nr0, r1v = nr1;
        if (ps + 1 < 16) GC_LOAD(ps + 1);
        const unsigned fw[8] = {f0.x, f0.y, f0.z, f0.w, f1.x, f1.y, f1.z, f1.w}, bw[8] = {b0.x, b0.y, b0.z, b0.w, b1.x, b1.y, b1.z, b1.w}, rw[8] = {r0v.x, r0v.y, r0v.z, r0v.w, r1v.x, r1v.y, r1v.z, r1v.w};
        float o[16]; float ss = 0.f;
#pragma unroll
        for (int e2 = 0; e2 < 8; ++e2) { o[2 * e2] = bflo(fw[e2]) + bflo(bw[e2]); o[2 * e2 + 1] = bfhi(fw[e2]) + bfhi(bw[e2]); ss += o[2 * e2] * o[2 * e2] + o[2 * e2 + 1] * o[2 * e2 + 1]; }
        ss += __shfl_xor(ss, 1); ss += __shfl_xor(ss, 2); ss += __shfl_xor(ss, 4);
        const float rinv = __builtin_amdgcn_rsqf(ss * (1.f / 128.f) + EPS);
        unsigned ow[8];
#pragma unroll
        for (int e2 = 0; e2 < 8; ++e2) { const float x0 = bflo(rw[e2]), x1 = bfhi(rw[e2]);
            const float y0 = o[2 * e2] * rinv * hg[2 * e2] * (x0 * __builtin_amdgcn_rcpf(1.f + __expf(-x0))), y1 = o[2 * e2 + 1] * rinv * hg[2 * e2 + 1] * (x1 * __builtin_amdgcn_rcpf(1.f + __expf(-x1))); ow[e2] = cvtpk(y0, y1); }
        GAS v4u* mp = (GAS v4u*)(MIX + row * 1024 + h * 128 + eseg * 16);
        mp[0] = (v4u){ow[0], ow[1], ow[2], ow[3]}; mp[1] = (v4u){ow[4], ow[5], ow[6], ow[7]}; }
#undef GC_LOAD
}
}
struct DenseMap { static constexpr bool GATHER = false;
    const bf16* A; const bf16* Bt; int K;
    __device__ __forceinline__ __amdgpu_buffer_rsrc_t a_rsrc() const { return __builtin_amdgcn_make_buffer_rsrc((void*)A, 0, 0x7fffffff, 0x00020000); }
    __device__ __forceinline__ __amdgpu_buffer_rsrc_t b_rsrc() const { return __builtin_amdgcn_make_buffer_rsrc((void*)Bt, 0, 0x7fffffff, 0x00020000); }
    __device__ __forceinline__ unsigned a_soff(const pg8::Unit& u) const { return (unsigned)u.pm * 256u * (unsigned)K * 2u; }
    __device__ __forceinline__ unsigned b_soff(const pg8::Unit& u) const { return (unsigned)u.pn * 256u * (unsigned)K * 2u; }
    __device__ __forceinline__ void a_off(const pg8::Unit&, const int (&R)[2], const int (&C)[2], unsigned (&vo)[2][2]) const {
#pragma unroll
        for (int h = 0; h < 2; ++h)
#pragma unroll
            for (int i = 0; i < 2; ++i) vo[h][i] = (unsigned)((h * 128 + R[i]) * K + C[i]) * 2u; }
};
struct MoeTabs { const LAS int* cnt; const LAS int* cst; const LAS unsigned short* te; };
struct MoeMapUp { static constexpr bool GATHER = true;
    const unsigned char* A; const unsigned char* Bt; const int* rowtok; MoeTabs tb;
    __device__ __forceinline__ __amdgpu_buffer_rsrc_t a_rsrc() const { return __builtin_amdgcn_make_buffer_rsrc((void*)A, 0, 0x7fffffff, 0x00020000); }
    __device__ __forceinline__ __amdgpu_buffer_rsrc_t b_rsrc() const { return __builtin_amdgcn_make_buffer_rsrc((void*)Bt, 0, 0x7fffffff, 0x00020000); }
    __device__ __forceinline__ unsigned a_soff(const pg8::Unit&) const { return 0u; }
    __device__ __forceinline__ unsigned b_soff(const pg8::Unit& u) const { const unsigned e = tb.te[u.pm]; return (e * 2048u + (unsigned)u.pn * 256u) * 1024u; }
    __device__ __forceinline__ void a_raw(const pg8::Unit& u, const int (&R)[2], unsigned (&raw)[2][2]) const {
        const int e = tb.te[u.pm], pos0 = (u.pm - tb.cst[e]) * 256, n = tb.cnt[e];
#pragma unroll
        for (int h = 0; h < 2; ++h)
#pragma unroll
            for (int i = 0; i < 2; ++i) { const int pos = pos0 + h * 128 + R[i]; raw[h][i] = (unsigned)rowtok[(size_t)e * EROWS + (pos < n ? pos : 0)]; } }
    __device__ __forceinline__ unsigned a_fin(unsigned tok, int C) const { return (tok * 512u + (unsigned)C) * 2u; }
    __device__ __forceinline__ void a_off(const pg8::Unit& u, const int (&R)[2], const int (&C)[2], unsigned (&vo)[2][2]) const {
        unsigned raw[2][2]; a_raw(u, R, raw);
#pragma unroll
        for (int h = 0; h < 2; ++h)
#pragma unroll
            for (int i = 0; i < 2; ++i) vo[h][i] = a_fin(raw[h][i], C[i]); }
};
struct MoeMapDown { static constexpr bool GATHER = false;
    const unsigned char* A; const unsigned char* Bt; MoeTabs tb;
    __device__ __forceinline__ __amdgpu_buffer_rsrc_t a_rsrc() const { return __builtin_amdgcn_make_buffer_rsrc((void*)A, 0, 0x7fffffff, 0x00020000); }
    __device__ __forceinline__ __amdgpu_buffer_rsrc_t b_rsrc() const { return __builtin_amdgcn_make_buffer_rsrc((void*)Bt, 0, 0x7fffffff, 0x00020000); }
    __device__ __forceinline__ unsigned a_soff(const pg8::Unit& u) const { return (unsigned)u.pm * 256u * 1024u; }
    __device__ __forceinline__ unsigned b_soff(const pg8::Unit& u) const { const unsigned e = tb.te[u.pm]; return (e * 1024u + (unsigned)u.pn * 256u) * 1024u; }
    __device__ __forceinline__ void a_off(const pg8::Unit&, const int (&R)[2], const int (&C)[2], unsigned (&vo)[2][2]) const {
#pragma unroll
        for (int h = 0; h < 2; ++h)
#pragma unroll
            for (int i = 0; i < 2; ++i) vo[h][i] = (unsigned)((h * 128 + R[i]) * 512 + C[i]) * 2u; }
};
using pg8::f32x4;
struct EpiInProj { static constexpr bool PERM = true, COLS64 = false;
    bf16 *gq, *gk, *gv, *gr, *aq, *ak, *av, *z; const float* rinv;
    struct Pre { float rv[8]; };
    __device__ __forceinline__ void preload(const pg8::Unit& u, int wr, int wc, int fr, int fq, Pre& p) const {
#pragma unroll
        for (int i = 0; i < 8; ++i) p.rv[i] = rinv[u.pm * 256 + wr * 64 + fr + (i >> 2) * 128 + (i & 3) * 16]; }
    __device__ __forceinline__ void operator()(const f32x4 (&acc)[2][2][4][2], const pg8::Unit& u, const Pre& p, int wr, int wc, int fr, int fq) const {
        bf16* b0; bf16* b1; int ld;
        switch (u.pn) { case 0: b0 = gq; b1 = gq + 128; ld = 256; break; case 1: b0 = gk; b1 = gk + 128; ld = 256; break;
            case 2: b0 = gv; b1 = gv + 128; ld = 512; break; case 3: b0 = gv + 256; b1 = gv + 384; ld = 512; break;
            case 4: b0 = gr; b1 = gr + 128; ld = 512; break; case 5: b0 = gr + 256; b1 = gr + 384; ld = 512; break;
            case 6: b0 = aq; b1 = aq + 128; ld = 512; break; case 7: b0 = aq + 256; b1 = aq + 384; ld = 512; break;
            case 8: b0 = ak; b1 = av; ld = 128; break; default: b0 = z; b1 = z; ld = 32; break; }
        const bool zt = (u.pn == 9);
        if (zt && wc != 0) return;
        const int row0 = u.pm * 256 + wr * 64 + fr, cw = wc * 32 + 8 * fq;
#pragma unroll
        for (int ai = 0; ai < 2; ++ai)
#pragma unroll
            for (int m = 0; m < 4; ++m) { const size_t row = (size_t)(row0 + ai * 128 + m * 16);
#pragma unroll
                for (int bj = 0; bj < 2; ++bj) { if (zt && bj == 1) continue; const float rs = p.rv[ai * 4 + m]; const f32x4 v0 = acc[ai][bj][m][0] * rs, v1 = acc[ai][bj][m][1] * rs;
                    pg8::u32x4 wv; wv.x = pg8::cvt_pk_bf16(v0[0], v0[1]); wv.y = pg8::cvt_pk_bf16(v0[2], v0[3]); wv.z = pg8::cvt_pk_bf16(v1[0], v1[1]); wv.w = pg8::cvt_pk_bf16(v1[2], v1[3]);
                    *(pg8::u32x4*)((bj ? b1 : b0) + row * ld + cw) = wv; } }
    }
};
struct EpiResF32 { static constexpr bool PERM = true, COLS64 = false;
    const bf16* base; bf16* out;
    struct Pre {}; __device__ __forceinline__ void preload(const pg8::Unit&, int, int, int, int, Pre&) const {}
    __device__ __forceinline__ void operator()(const f32x4 (&acc)[2][2][4][2], const pg8::Unit& u, const Pre&, int wr, int wc, int fr, int fq) const {
        const int col0 = u.pn * 256 + wc * 32 + 8 * fq;
        const size_t off0 = (size_t)(u.pm * 256 + wr * 64 + fr) * 1024 + col0;
        v4u cx[4], nx[4];
#define ER_OFF(it_, q_) (off0 + (size_t)((((it_) * 2 + ((q_) >> 1)) >> 2) * 128 + (((it_) * 2 + ((q_) >> 1)) & 3) * 16) * 1024 + ((q_) & 1) * 128)
#pragma unroll
        for (int q = 0; q < 4; ++q) cx[q] = __builtin_nontemporal_load((const v4u*)(base + ER_OFF(0, q)));
#pragma unroll
        for (int it = 0; it < 4; ++it) {
            if (it + 1 < 4) {
#pragma unroll
                for (int q = 0; q < 4; ++q) nx[q] = __builtin_nontemporal_load((const v4u*)(base + ER_OFF(it + 1, q))); }
#pragma unroll
            for (int q = 0; q < 4; ++q) { const int g = it * 2 + (q >> 1), ai = g >> 2, m = g & 3, bj = q & 1; const f32x4 a0 = acc[ai][bj][m][0], a1 = acc[ai][bj][m][1]; const v4u xw = cx[q];
                *(v4u*)(out + ER_OFF(it, q)) = (v4u){pk2(bflo(xw.x) + a0.x, bfhi(xw.x) + a0.y), pk2(bflo(xw.y) + a0.z, bfhi(xw.y) + a0.w), pk2(bflo(xw.z) + a1.x, bfhi(xw.z) + a1.y), pk2(bflo(xw.w) + a1.z, bfhi(xw.w) + a1.w)}; }
#pragma unroll
            for (int q = 0; q < 4; ++q) cx[q] = nx[q]; }
#undef ER_OFF
    }
};
struct EpiSwiglu { static constexpr bool PERM = true, COLS64 = false;
    const float* b1; unsigned char* act; MoeTabs tb;
    struct Pre { f32x4 g0, g1, l0, l1; };
    __device__ __forceinline__ void preload(const pg8::Unit& u, int wr, int wc, int fr, int fq, Pre& p) const {
        const int e = tb.te[u.pm]; const int col = u.pn * 128 + wc * 32 + 8 * fq; const float* bg = b1 + (size_t)e * 2048 + col; const float* bl = bg + 1024;
        p.g0 = *(const GAS f32x4*)bg; p.g1 = *(const GAS f32x4*)(bg + 4); p.l0 = *(const GAS f32x4*)bl; p.l1 = *(const GAS f32x4*)(bl + 4); }
    __device__ __forceinline__ void operator()(const f32x4 (&acc)[2][2][4][2], const pg8::Unit& u, const Pre& p, int wr, int wc, int fr, int fq) const {
        const int col = u.pn * 128 + wc * 32 + 8 * fq;
        const f32x4 g0 = p.g0, g1 = p.g1, l0 = p.l0, l1 = p.l1;
        const int row0 = u.pm * 256 + wr * 64 + fr;
        const bool odd = (fq & 1) != 0;
        unsigned char* dstb = act + (size_t)(row0 + (odd ? 16 : 0)) * 1024 + (odd ? col - 8 : col);
#pragma unroll
        for (int ai = 0; ai < 2; ++ai)
#pragma unroll
            for (int mp = 0; mp < 2; ++mp) { unsigned wd[2][2];
#pragma unroll
                for (int q = 0; q < 2; ++q) { const int m = 2 * mp + q; float o[8];
#pragma unroll
                    for (int n = 0; n < 2; ++n)
#pragma unroll
                        for (int j = 0; j < 4; ++j) { const float gl = fminf(__builtin_fmaf(acc[ai][0][m][n][j], 1.f / WSCALE, (n ? g1[j] : g0[j])), 7.f); const float li = __builtin_amdgcn_fmed3f(__builtin_fmaf(acc[ai][1][m][n][j], 1.f / WSCALE, (n ? l1[j] : l0[j])), -7.f, 7.f);
                            o[4 * n + j] = (gl * ASCALE) * __builtin_amdgcn_rcpf(1.f + __builtin_amdgcn_exp2f(gl * (-1.702f * 1.4426950408889634f))) * (li + 1.f); }
                    int w0 = 0, w1 = 0;
                    w0 = __builtin_amdgcn_cvt_pk_fp8_f32(o[0], o[1], w0, false); w0 = __builtin_amdgcn_cvt_pk_fp8_f32(o[2], o[3], w0, true); w1 = __builtin_amdgcn_cvt_pk_fp8_f32(o[4], o[5], w1, false); w1 = __builtin_amdgcn_cvt_pk_fp8_f32(o[6], o[7], w1, true);
                    wd[q][0] = (unsigned)w0; wd[q][1] = (unsigned)w1; }
                auto x0 = __builtin_amdgcn_permlane16_swap(wd[0][0], wd[1][0], false, false); auto x1 = __builtin_amdgcn_permlane16_swap(wd[0][1], wd[1][1], false, false);
                *(pg8::u32x4*)(dstb + (size_t)(ai * 128 + mp * 32) * 1024) = (pg8::u32x4){x0[0], x1[0], x0[1], x1[1]}; }
    }
};
struct EpiDown { static constexpr bool PERM = true, COLS64 = true;
    const float* b2; const float* rowgate; unsigned char* y; MoeTabs tb;
    struct Pre { f32x4 bv[2][2]; float gt[8]; };
    __device__ __forceinline__ void preload(const pg8::Unit& u, int wr, int wc, int fr, int fq, Pre& p) const {
        const int e = tb.te[u.pm], pos0 = (u.pm - tb.cst[e]) * 256, n_e = tb.cnt[e];
        const float* bb = b2 + (size_t)e * 1024 + u.pn * 256 + wc * 64 + 8 * fq;
#pragma unroll
        for (int bj = 0; bj < 2; ++bj)
#pragma unroll
            for (int n = 0; n < 2; ++n) p.bv[bj][n] = *(const GAS f32x4*)(bb + bj * 32 + 4 * n);
#pragma unroll
        for (int ai = 0; ai < 2; ++ai)
#pragma unroll
            for (int m = 0; m < 4; ++m) { const int pos = pos0 + wr * 64 + fr + ai * 128 + m * 16; const int pc_ = pos < n_e ? pos : 0; const float g = rowgate[(size_t)e * EROWS + pc_]; p.gt[ai * 4 + m] = (pos < n_e) ? g * YSCALE : 0.f; }
    }
    __device__ __forceinline__ void operator()(const f32x4 (&acc)[2][2][4][2], const pg8::Unit& u, const Pre& p, int wr, int wc, int fr, int fq) const {
        const bool odd = (fq & 1) != 0;
        const int colb = u.pn * 256 + wc * 64 + (odd ? 32 + 8 * (fq - 1) : 8 * fq), rl0 = wr * 64 + fr;
#pragma unroll
        for (int ai = 0; ai < 2; ++ai)
#pragma unroll
            for (int m = 0; m < 4; ++m) { const int rl = rl0 + ai * 128 + m * 16; const float gt = p.gt[ai * 4 + m];
                unsigned w[2][2];
#pragma unroll
                for (int bj = 0; bj < 2; ++bj) { const f32x4 v0 = (acc[ai][bj][m][0] * (1.f / (WSCALE * ASCALE)) + p.bv[bj][0]) * gt, v1 = (acc[ai][bj][m][1] * (1.f / (WSCALE * ASCALE)) + p.bv[bj][1]) * gt;
                    int w0 = 0, w1 = 0;
                    w0 = __builtin_amdgcn_cvt_pk_fp8_f32(v0[0], v0[1], w0, false); w0 = __builtin_amdgcn_cvt_pk_fp8_f32(v0[2], v0[3], w0, true); w1 = __builtin_amdgcn_cvt_pk_fp8_f32(v1[0], v1[1], w1, false); w1 = __builtin_amdgcn_cvt_pk_fp8_f32(v1[2], v1[3], w1, true);
                    w[bj][0] = (unsigned)w0; w[bj][1] = (unsigned)w1; }
                auto x0 = __builtin_amdgcn_permlane16_swap(w[0][0], w[1][0], false, false); auto x1 = __builtin_amdgcn_permlane16_swap(w[0][1], w[1][1], false, false);
                const pg8::u32x4 ov = (pg8::u32x4){x0[0], x1[0], x0[1], x1[1]};
                *(pg8::u32x4*)(y + (size_t)(u.pm * 256 + rl) * 1024 + colb) = ov; }
    }
};
__device__ __forceinline__ int moe_tables(Frame& F) {
    LAS int* cnt = (LAS int*)(F.lds + LC_CNT); LAS int* cst = (LAS int*)(F.lds + LC_CST); LAS unsigned short* te = (LAS unsigned short*)(F.lds + LC_TE);
    __syncthreads();
    if (F.tid < NEXP) cnt[F.tid] = (int)__hip_atomic_load(F.ctl + CW_CNT + 64 * F.tid, RLX_AGENT);
    __syncthreads();
    if (F.tid == 0) { int s = 0; for (int e = 0; e < NEXP; ++e) { cst[e] = s; s += (cnt[e] + 255) >> 8; } cst[NEXP] = s; }
    __syncthreads();
    const int nt = cst[NEXP];
    for (int t = F.tid; t < nt; t += NWAVES * 64) { int e = 0;
#pragma unroll 1
        for (int k = 1; k < NEXP; ++k) e = (t >= cst[k]) ? k : e;
        te[t] = (unsigned short)e; }
    __syncthreads();
    return nt;
}
__device__ __forceinline__ void p3_mixers(Frame& F) {
    for (int u = blockIdx.x; u < 2 * BATCH * GLA_H; u += F.G) gla::gla_unit(F, u & 7, (u >> 3) & 3, u >> 5);
    if (blockIdx.x < 2 * BATCH * GLA_H) { while (conv_pull(F)) {} }
    const attn_body::bf16* Q = (const attn_body::bf16*)(F.ws + WS_AQ); const attn_body::bf16* K = (const attn_body::bf16*)(F.ws + WS_AK); const attn_body::bf16* V = (const attn_body::bf16*)(F.ws + WS_AV);
    attn_body::bf16* O = (attn_body::bf16*)(F.ws + WS_MIX);
    const int x0 = blockIdx.x & 7;
    float sbound;
    { float mq = fabsf(F.q_g[F.lane]), mk = fabsf(F.k_g[F.lane]);
#pragma unroll
      for (int o_ = 1; o_ < 64; o_ <<= 1) { mq = fmaxf(mq, __shfl_xor(mq, o_)); mk = fmaxf(mk, __shfl_xor(mk, o_)); }
      sbound = __builtin_bit_cast(float, __builtin_amdgcn_readfirstlane(__builtin_bit_cast(int, 64.f * attn_body::C2 * mq * mk * 1.02f))); }
    for (int qi = 0; qi < 8; ++qi) { const int x = (x0 + qi) & 7;
        for (;;) {
            __syncthreads();
            if (F.tid == 0) F.MISC[16] = __hip_atomic_fetch_add(F.ctl + CW_QUE + 64 * x, 1u, RLX_AGENT);
            __syncthreads();
            const int item = __builtin_amdgcn_readfirstlane((int)F.MISC[16]);
            if (item >= ATT_H * attn_body::NQB + 4 * GLA_H) break;
            if (item >= ATT_H * attn_body::NQB) { const int k = item - ATT_H * attn_body::NQB; gla::gla_combine(F, x, k >> 2, k & 3); continue; }
            attn_body::attn_unit<8>(x, item >> 4, item & 15, Q, K, V, O, (char*)F.lds, F.q_g, sbound);
        }
    }
    while (conv_pull(F)) {}
    __syncthreads();
}

__device__ __forceinline__ void p5_route(Frame& F) {
    typedef float f32x16 __attribute__((ext_vector_type(16)));
    LAS unsigned char* L = F.lds;
    constexpr int XP = 2064, L_XH = 0, L_XL = 32 * XP, L_PART = 0;
    const int tid = F.tid, lane = F.lane, w = F.wave, r32 = lane & 31, hi = lane >> 5;
    const bf16* WRH = (const bf16*)(F.ws + WS_WRH); const bf16* WRL = (const bf16*)(F.ws + WS_WRL);
    unsigned char* XN8 = F.ws + WS_XN;
    int* ROWTOK = (int*)(F.ws + WS_ROWTOK); float* ROWGATE = (float*)(F.ws + WS_ROWGATE); int* TOKASG = (int*)(F.ws + WS_TOKASG);
    gu32* CNT = F.ctl + CW_CNT;
    bf16x8 wh[8], wl[8];
#pragma unroll
    for (int ks = 0; ks < 8; ++ks) { const int k0 = 128 * w + 16 * ks + 8 * hi; wh[ks] = *(const GAS bf16x8*)(WRH + r32 * 1024 + k0); wl[ks] = *(const GAS bf16x8*)(WRL + r32 * 1024 + k0); }
    f32x4 g2[4];
#pragma unroll
    for (int j = 0; j < 4; ++j) g2[j] = *((const GAS f32x4*)F.ffn_g + lane + 64 * j);
    float brt[16];
#pragma unroll
    for (int r = 0; r < 16; ++r) brt[r] = F.b_router[(r & 3) + 8 * (r >> 2) + 4 * hi];
    LAS int* hist = (LAS int*)(L + LC_HIST); LAS int* basev = (LAS int*)(L + LC_BASE); LAS int* aep = (LAS int*)(L + LC_ASG); LAS float* agt = (LAS float*)(L + LC_ASG + 4096);
    constexpr int NGRP = T / 32;
    const int per = (NGRP + F.G - 1) / F.G, g0 = F.vcu * per, g1 = (g0 + per < NGRP) ? g0 + per : NGRP;
    for (int gb = g0; gb < g1; gb += 8) {
        const int nb = (g1 - gb < 8) ? g1 - gb : 8;
        __syncthreads();
        if (tid < NEXP) hist[tid] = 0;
        v2u hv[4][4];
#define P5_LOADG(g) do { _Pragma("unroll") for (int rr = 0; rr < 4; ++rr) { const GAS v2u* hp = (const GAS v2u*)((const bf16*)(F.ws + WS_H16) + (size_t)(32 * (g) + 4 * w + rr) * 1024) + lane; \
            _Pragma("unroll") for (int j = 0; j < 4; ++j) hv[rr][j] = __builtin_nontemporal_load(hp + 64 * j); } } while (0)
#define P5_BAR() asm volatile("s_waitcnt lgkmcnt(0)\n\ts_barrier" ::: "memory")
        P5_LOADG(gb);
        for (int bi = 0; bi < nb; ++bi) {
            const int t0 = 32 * (gb + bi);
#pragma unroll
            for (int rr = 0; rr < 4; ++rr) { const int r = 4 * w + rr; const size_t tok = (size_t)(t0 + r);
                f32x4 v[4]; float s = 0.f;
#pragma unroll
                for (int j = 0; j < 4; ++j) { v[j] = (f32x4){bflo(hv[rr][j].x), bfhi(hv[rr][j].x), bflo(hv[rr][j].y), bfhi(hv[rr][j].y)}; s += (v[j].x * v[j].x + v[j].y * v[j].y) + (v[j].z * v[j].z + v[j].w * v[j].w); }
                const float rinv = 1.f / sqrtf(wave_sum(s) * (1.f / 1024.f) + EPS);
                GAS unsigned* o4 = (GAS unsigned*)(XN8 + tok * 1024) + lane;
#pragma unroll
                for (int j = 0; j < 4; ++j) { const f32x4 xn = v[j] * rinv * g2[j];
                    const v2u hw = (v2u){pk2(xn.x, xn.y), pk2(xn.z, xn.w)};
                    const v2u lw = (v2u){pk2(xn.x - bflo(hw.x), xn.y - bfhi(hw.x)), pk2(xn.z - bflo(hw.y), xn.w - bfhi(hw.y))};
                    { int q8 = 0; q8 = __builtin_amdgcn_cvt_pk_fp8_f32(xn.x, xn.y, q8, false); q8 = __builtin_amdgcn_cvt_pk_fp8_f32(xn.z, xn.w, q8, true); o4[64 * j] = (unsigned)q8; }
                    *(LAS v2u*)(L + L_XH + r * XP + (4 * lane + 256 * j) * 2) = hw; *(LAS v2u*)(L + L_XL + r * XP + (4 * lane + 256 * j) * 2) = lw; } }
            if (bi + 1 < nb) P5_LOADG(gb + bi + 1);
            P5_BAR();
            f32x16 acc = {};
#pragma unroll
            for (int ks = 0; ks < 8; ++ks) { const int k0 = 128 * w + 16 * ks + 8 * hi;
                const bf16x8 xh = *(const LAS bf16x8*)(L + L_XH + r32 * XP + k0 * 2), xl = *(const LAS bf16x8*)(L + L_XL + r32 * XP + k0 * 2);
                acc = __builtin_amdgcn_mfma_f32_32x32x16_bf16(wh[ks], xh, acc, 0, 0, 0); acc = __builtin_amdgcn_mfma_f32_32x32x16_bf16(wh[ks], xl, acc, 0, 0, 0); acc = __builtin_amdgcn_mfma_f32_32x32x16_bf16(wl[ks], xh, acc, 0, 0, 0); }
            P5_BAR();
#pragma unroll
            for (int r = 0; r < 16; ++r) { const int e = (r & 3) + 8 * (r >> 2) + 4 * hi; ((LAS float*)(L + L_PART))[(w * 32 + e) * 32 + r32] = acc[r]; }
            P5_BAR();
            if (w == 0) {
                float v[16];
#pragma unroll
                for (int r = 0; r < 16; ++r) { const int e = (r & 3) + 8 * (r >> 2) + 4 * hi; float s = brt[r];
#pragma unroll
                    for (int ww = 0; ww < 8; ++ww) s += ((const LAS float*)(L + L_PART))[(ww * 32 + e) * 32 + r32];
                    v[r] = s; }
                float cv[8]; int cidx[8];
#pragma unroll
                for (int s = 0; s < 4; ++s) { float m = -INFINITY; int mr = 0;
#pragma unroll
                    for (int r = 0; r < 16; ++r) { if (v[r] > m) { m = v[r]; mr = r; } }
                    cv[s] = m; cidx[s] = (mr & 3) + 8 * (mr >> 2) + 4 * hi;
#pragma unroll
                    for (int r = 0; r < 16; ++r) v[r] = (r == mr) ? -INFINITY : v[r]; }
#pragma unroll
                for (int s = 0; s < 4; ++s) { cv[4 + s] = __shfl_xor(cv[s], 32); cidx[4 + s] = __shfl_xor(cidx[s], 32); }
                float tv[4]; int ti[4];
#pragma unroll
                for (int s = 0; s < 4; ++s) { float m = -INFINITY; int mi = 1 << 20; int mc = 0;
#pragma unroll
                    for (int c = 0; c < 8; ++c) { const bool better = (cv[c] > m) || (cv[c] == m && cidx[c] < mi); if (better) { m = cv[c]; mi = cidx[c]; mc = c; } }
                    tv[s] = m; ti[s] = mi;
#pragma unroll
                    for (int c = 0; c < 8; ++c) cv[c] = (c == mc) ? -INFINITY : cv[c]; }
                const float e1 = __expf(tv[1] - tv[0]), e2 = __expf(tv[2] - tv[0]), e3 = __expf(tv[3] - tv[0]); const float inv = 1.f / (1.f + e1 + e2 + e3);
                const float gt[4] = {inv, e1 * inv, e2 * inv, e3 * inv};
                if (hi == 0) {
#pragma unroll
                    for (int s = 0; s < 4; ++s) { const int rank = (int)__hip_atomic_fetch_add(hist + ti[s], 1, __ATOMIC_RELAXED, __HIP_MEMORY_SCOPE_WORKGROUP); const int idx = (bi * 32 + r32) * 4 + s; aep[idx] = (ti[s] << 16) | rank; agt[idx] = gt[s]; } }
            }
            P5_BAR();
        }
#undef P5_LOADG
#undef P5_BAR
        if (tid < NEXP) { const int hc = hist[tid]; basev[tid] = hc ? (int)__hip_atomic_fetch_add(CNT + 64 * tid, (unsigned)hc, RLX_AGENT) : 0; }
        __syncthreads();
        for (int idx = tid; idx < nb * 128; idx += NWAVES * 64) { const int ep = aep[idx], e = ep >> 16, pos = basev[e] + (ep & 0xffff); const int tok = 32 * gb + (idx >> 2), s = idx & 3;
            ROWTOK[(size_t)e * EROWS + pos] = tok; ROWGATE[(size_t)e * EROWS + pos] = agt[idx]; TOKASG[tok * 4 + s] = e * EROWS + pos; }
    }
    __syncthreads();
}

__device__ __forceinline__ void p8_combine(Frame& F) {
    const LAS int* cst = (const LAS int*)(F.lds + LC_CST);
    const int gw = F.vcu * NWAVES + F.wave, NGW = F.G * NWAVES, lane = F.lane;
    const int* TOKASG = (const int*)(F.ws + WS_TOKASG); const unsigned char* Y = F.ws + WS_Y;
    f32x4 fg[4];
#pragma unroll
    for (int j = 0; j < 4; ++j) fg[j] = *((const GAS f32x4*)F.fin_g + lane + 64 * j);
    for (int tok = gw; tok < T; tok += NGW) {
        const int a = TOKASG[tok * 4 + (lane & 3)];
        const int crow = cst[a >> 15] * 256 + (a & (EROWS - 1));
        GAS f32x4* hp = (GAS f32x4*)(F.out + (size_t)tok * 1024) + lane; f32x4 v[4];
        const GAS v2u* hb = (const GAS v2u*)((const bf16*)(F.ws + WS_H16) + (size_t)tok * 1024) + lane;
#pragma unroll
        for (int j = 0; j < 4; ++j) { const v2u hw = __builtin_nontemporal_load(hb + 64 * j); v[j] = (f32x4){bflo(hw.x), bfhi(hw.x), bflo(hw.y), bfhi(hw.y)}; }
#pragma unroll
        for (int s = 0; s < 4; ++s) { const int cr = __shfl(crow, s); const GAS unsigned* yp = (const GAS unsigned*)(Y + (size_t)cr * 1024) + lane;
#pragma unroll
            for (int j = 0; j < 4; ++j) { const unsigned yw = __builtin_nontemporal_load(yp + 64 * j); const auto lo = __builtin_amdgcn_cvt_pk_f32_fp8((int)yw, false), hi = __builtin_amdgcn_cvt_pk_f32_fp8((int)yw, true);
                v[j].x += lo[0] * (1.f / YSCALE); v[j].y += lo[1] * (1.f / YSCALE); v[j].z += hi[0] * (1.f / YSCALE); v[j].w += hi[1] * (1.f / YSCALE); } }
        float ss = 0.f;
#pragma unroll
        for (int j = 0; j < 4; ++j) ss += (v[j].x * v[j].x + v[j].y * v[j].y) + (v[j].z * v[j].z + v[j].w * v[j].w);
        const float rinv = 1.f / sqrtf(wave_sum(ss) * (1.f / 1024.f) + EPS);
#pragma unroll
        for (int j = 0; j < 4; ++j) __builtin_nontemporal_store(v[j] * rinv * fg[j], hp + 64 * j);
    }
}
#ifndef MK_N_LAUNCHES
#define MK_N_LAUNCHES 1
#endif
constexpr int N_PHASES = 9;
constexpr int N_LAUNCHES = MK_N_LAUNCHES;
struct Args { const float* in[19]; float* out; unsigned char* ws; int ph_lo, ph_hi; };
__global__ void __launch_bounds__(NWAVES * 64, 2) enc_fwd(Args args) {
    extern __shared__ __attribute__((aligned(16))) unsigned char lds[];
    Frame F;
    F.lds = (LAS unsigned char*)lds;
    F.MISC = (volatile LAS unsigned*)(F.lds + LC_MISC);
    F.tid = threadIdx.x; F.lane = F.tid & 63; F.wave = __builtin_amdgcn_readfirstlane(F.tid >> 6);
    F.G = gridDim.x; { const int bx = blockIdx.x; F.vcu = (F.G % 8 == 0) ? (bx % 8) * (F.G / 8) + bx / 8 : bx; }
    F.ws = args.ws; F.ctl = (gu32*)(args.ws + WS_CTL);
    F.x = args.in[0]; F.mix_g = args.in[1]; F.w_in = args.in[2]; F.w_gf = args.in[3]; F.b_gf = args.in[4]; F.w_gb = args.in[5]; F.b_gb = args.in[6]; F.gla_hg = args.in[7];
    F.q_g = args.in[8]; F.k_g = args.in[9]; F.w_out = args.in[10]; F.ffn_g = args.in[11]; F.w_router = args.in[12]; F.b_router = args.in[13];
    F.w1 = args.in[14]; F.b1 = args.in[15]; F.w2 = args.in[16]; F.b2 = args.in[17]; F.fin_g = args.in[18]; F.out = args.out;
    for (int u = F.tid; u < (LDS_BYTES - LC_OFF) / 4; u += NWAVES * 64) ((LAS unsigned*)(F.lds + LC_OFF))[u] = 0u;
    __syncthreads();
    XcdBarrier bar; bar.bar = (unsigned*)(F.ctl + CW_BAR); bar.x = 0; bar.st = nullptr;
    if (N_LAUNCHES == 1) bar = xcd_barrier_post((unsigned*)(F.ctl + CW_BAR), F.MISC + 8);
    const int lo = args.ph_lo, hi = args.ph_hi;
#define IN(k) (lo <= (k) && (k) < hi)
#define SEAM(k) do { if (IN(k) && IN((k) + 1)) xcd_barrier(bar); } while (0)
    MoeTabs tb{(const LAS int*)(F.lds + LC_CNT), (const LAS int*)(F.lds + LC_CST), (const LAS unsigned short*)(F.lds + LC_TE)};

    if (IN(0)) { p0_prologue(F); } SEAM(0);
    if (IN(1)) {
        DenseMap mp{(const bf16*)(F.ws + WS_XN), (const bf16*)(F.ws + WS_WIN), 1024};
        pg8::StaticOrder S; S.init(T / 256, D_IN_PAD / 256, F.G, (int)blockIdx.x);
        EpiInProj E{(bf16*)(F.ws + WS_GQ), (bf16*)(F.ws + WS_GK), (bf16*)(F.ws + WS_GV), (bf16*)(F.ws + WS_GR), (bf16*)(F.ws + WS_AQ), (bf16*)(F.ws + WS_AK), (bf16*)(F.ws + WS_AV), (bf16*)(F.ws + WS_Z), (const float*)(F.ws + WS_RINV)};
        pg8::gemm_phase<EpiInProj, pg8::StaticOrder, DenseMap, true>(F.lds, 1024, S, mp, E);
    } SEAM(1);
    if (IN(2)) { p2_normrope(F); for (int u = F.vcu; u < BATCH * 64; u += F.G) gla::gla_prep_unit(F, u >> 6, u & 63); } SEAM(2);
    if (IN(3)) { p3_mixers(F); } SEAM(3);
    if (IN(4)) {
        DenseMap mp{(const bf16*)(F.ws + WS_MIX), (const bf16*)(F.ws + WS_WOUT), 1024};
        pg8::StaticOrder S; S.init(T / 256, DM / 256, F.G, (int)blockIdx.x);
        EpiResF32 E{(const bf16*)(F.ws + WS_XN), (bf16*)(F.ws + WS_H16)};
        pg8::gemm_phase<EpiResF32, pg8::StaticOrder, DenseMap, true>(F.lds, 1024, S, mp, E);
    } SEAM(4);
    if (IN(5)) { p5_route(F); } SEAM(5);
    if (IN(6)) {
        const int ntl = moe_tables(F);
        MoeMapUp mp{F.ws + WS_XN, F.ws + WS_W1, (const int*)(F.ws + WS_ROWTOK), tb};
        pg8::StaticOrder S; S.init(ntl, 8, F.G, (int)blockIdx.x);
        EpiSwiglu E{F.b1, F.ws + WS_ACT, tb};
        pg8::gemm_phase<EpiSwiglu, pg8::StaticOrder, MoeMapUp, true, true>(F.lds, 512, S, mp, E);
    } SEAM(6);
    if (IN(7)) {
        const int ntl = moe_tables(F);
        MoeMapDown mp{F.ws + WS_ACT, F.ws + WS_W2, tb};
        pg8::StaticOrder S; S.init(ntl, 4, F.G, (int)blockIdx.x);
        EpiDown E{F.b2, (const float*)(F.ws + WS_ROWGATE), F.ws + WS_Y, tb};
        pg8::gemm_phase<EpiDown, pg8::StaticOrder, MoeMapDown, true, true>(F.lds, 512, S, mp, E);
    } SEAM(7);
    if (IN(8)) { (void)moe_tables(F); p8_combine(F); }
#undef IN
#undef SEAM
}

extern "C" void kernel_launch(void* const* d_in, const int* in_sizes, int n_in, void* d_out, int out_size, void* d_ws, size_t ws_size, hipStream_t stream) {
    static int grid = 0;
    if (grid == 0) {
        if (n_in != 19 || in_sizes[0] != T * DM || out_size != T * DM || ws_size < WS_END) { fprintf(stderr, "kernel_launch: unexpected shapes (n_in %d, in0 %d, out %d, ws %zu); nothing launched\n", n_in, n_in > 0 ? in_sizes[0] : -1, out_size, ws_size); grid = -1; return; }
        int dev = 0, cus = 0, per_cu = 0;
        if (hipGetDevice(&dev) != hipSuccess || hipDeviceGetAttribute(&cus, hipDeviceAttributeMultiprocessorCount, dev) != hipSuccess) { grid = -1; return; }
        if (hipFuncSetAttribute((const void*)enc_fwd, hipFuncAttributeMaxDynamicSharedMemorySize, LDS_BYTES) != hipSuccess) { fprintf(stderr, "kernel_launch: hipFuncSetAttribute failed\n"); grid = -1; return; }
        if (hipOccupancyMaxActiveBlocksPerMultiprocessor(&per_cu, (const void*)enc_fwd, NWAVES * 64, LDS_BYTES) != hipSuccess || per_cu < 1) { fprintf(stderr, "kernel_launch: occupancy query says %d\n", per_cu); }
        (void)hipGetLastError();
        grid = cus;
    }
    if (grid < 0) return;
    if (hipMemsetAsync((char*)d_ws + WS_CTL, 0, CTL_ZERO_BYTES, stream) != hipSuccess) return;
    Args a{};
    for (int i = 0; i < 19; ++i) a.in[i] = (const float*)d_in[i];
    a.out = (float*)d_out; a.ws = (unsigned char*)d_ws;
    if (N_LAUNCHES == 1) { a.ph_lo = 0; a.ph_hi = N_PHASES; hipLaunchKernelGGL(enc_fwd, dim3(grid), dim3(NWAVES * 64), LDS_BYTES, stream, a); }
    else for (int p = 0; p < N_PHASES; ++p) { a.ph_lo = p; a.ph_hi = p + 1; hipLaunchKernelGGL(enc_fwd, dim3(grid), dim3(NWAVES * 64), LDS_BYTES, stream, a); }
}
```

```cpp
#include <hip/hip_runtime.h>
#include <hip/hip_bf16.h>
#include <cstdio>
#include <cstdint>
#include <cmath>

#define LAS __attribute__((address_space(3)))
#define GAS __attribute__((address_space(1)))

namespace pg8 {
typedef unsigned short bf16_t;
typedef short bf16x8 __attribute__((ext_vector_type(8)));
typedef float f32x4 __attribute__((ext_vector_type(4)));
typedef float f32x2 __attribute__((ext_vector_type(2)));
typedef unsigned u32x4 __attribute__((ext_vector_type(4)));
typedef int v4i_t __attribute__((ext_vector_type(4)));
typedef int v8i_t __attribute__((ext_vector_type(8)));
constexpr int BM = 256, BK = 64, HALF = 128, HTB = HALF * BK * 2, STAGE_BYTES = 8 * HTB, NXCD = 8, WGM = 4;

__host__ __device__ __forceinline__ int lds_byte(int r, int c) { const int st = (r >> 4) * 2 + (c >> 5), rr = r & 15, cc = c & 31, ob = rr * 64 + cc * 2; return st * 1024 + (ob ^ (((ob >> 9) & 1) << 5)); }
__host__ __device__ __forceinline__ void stage_rc(int b, int& R, int& C) { const int st = b / 1024, sb = b % 1024, swz = sb ^ (((sb >> 9) & 1) << 5); R = (st >> 1) * 16 + swz / 64; C = (st & 1) * 32 + (swz % 64) / 2; }
__host__ __device__ __forceinline__ int perm32(int rho) { const int n = rho >> 4, i = rho & 15; return 8 * (i >> 2) + 4 * n + (i & 3); }

struct Unit { int pm, pn; };

struct StaticOrder {
    int nM, nN, nwg, G, c;
    __device__ __forceinline__ void init(int nM_, int nN_, int G_, int c_) { nM = nM_; nN = nN_; nwg = nM * nN; G = G_; c = c_; }
    __device__ __forceinline__ bool next(int i, Unit& u) const {
        const long L = (long)i * G + c; if (L >= nwg) return false;
        int wgid = (int)L; { const int q = nwg / NXCD, r = nwg % NXCD, xcd = wgid % NXCD, off = wgid / NXCD; wgid = (xcd < r ? xcd * (q + 1) : r * (q + 1) + (xcd - r) * q) + off; }
        const int nig = WGM * nN, gid = wgid / nig, fm = gid * WGM, gsz = (nM - fm) < WGM ? (nM - fm) : WGM;
        u.pm = fm + ((wgid % nig) % gsz); u.pn = (wgid % nig) / gsz; return true;
    }
};

__device__ __forceinline__ unsigned cvt_pk_bf16(float lo, float hi) { unsigned r; asm volatile("v_cvt_pk_bf16_f32 %0, %1, %2" : "=v"(r) : "v"(lo), "v"(hi)); return r; }

template <class Epi, class Sched, class Map, bool ALIGN_EPI, bool FP8 = false>
__device__ __forceinline__ void gemm_phase(LAS unsigned char* lds, const int K, const Sched& S, const Map& MP, const Epi& E) {
    int tid_ = threadIdx.x; asm volatile("" : "+v"(tid_));
    const int tid = tid_, wid = __builtin_amdgcn_readfirstlane(tid >> 6), lane = tid & 63, wr = wid >> 2, wc = wid & 3, fr = lane & 15, fq = lane >> 4;
    const int nt = K / BK;
    int Rr[2], Cc[2]; unsigned voffB[2];
#pragma unroll
    for (int i = 0; i < 2; ++i) { int R, C; stage_rc(tid * 16 + i * 8192, R, C); Rr[i] = R; Cc[i] = C; const int Rb = Epi::COLS64 ? (64 * (R >> 5) + perm32(R & 31)) : (Epi::PERM ? ((R & ~31) + perm32(R & 31)) : R); voffB[i] = (unsigned)(Rb * K + C) * 2u; }
    const unsigned kstep = (unsigned)(BK * 2);
    const unsigned hstep = (unsigned)HALF * K * 2;
    const unsigned hstepB = Epi::COLS64 ? 32u * (unsigned)K * 2u : hstep;
    const __amdgpu_buffer_rsrc_t RA = MP.a_rsrc(), RB = MP.b_rsrc();
    const unsigned ldsw = (unsigned)wid * 1024u;
    const int aoff = lds_byte(wr * 64 + fr, fq * 8), boff = lds_byte(wc * 32 + fr, fq * 8);
#define PG8_SA(b, h) (((b) * 2 + (h)) * HTB)
#define PG8_SB(b, h) ((4 + (b) * 2 + (h)) * HTB)
#define PG8_STAGE(bufoff, rsrc, soff, voff) do { _Pragma("unroll") for (int _i = 0; _i < 2; ++_i) \
        __builtin_amdgcn_raw_ptr_buffer_load_lds(rsrc, (LAS unsigned*)(lds + (bufoff) + ldsw + _i * 8192), 16, (int)(voff)[_i], (int)(soff), 0, 0); } while (0)
#define PG8_LD8(p) __builtin_shufflevector(*(const LAS v4i_t*)(p), *(const LAS v4i_t*)((p) + 1024), 0, 1, 2, 3, 4, 5, 6, 7)
#define PG8_LDA(dst, b, h) do { _Pragma("unroll") for (int m = 0; m < 4; ++m) dst[m] = PG8_LD8(lds + PG8_SA(b, h) + aoff + m * 2048); } while (0)
#define PG8_LDB(dst, b, h) do { _Pragma("unroll") for (int n = 0; n < 2; ++n) dst[n] = PG8_LD8(lds + PG8_SB(b, h) + boff + n * 2048); } while (0)
#define PG8_HALF(x, k) __builtin_bit_cast(bf16x8, __builtin_shufflevector(x, x, 4 * (k), 4 * (k) + 1, 4 * (k) + 2, 4 * (k) + 3))
#define PG8_MMA(ai, bj, At, Bt) do { __builtin_amdgcn_s_setprio(1); _Pragma("unroll") for (int m = 0; m < 4; ++m) _Pragma("unroll") for (int n = 0; n < 2; ++n) { \
        if constexpr (FP8) { acc[ai][bj][m][n] = __builtin_amdgcn_mfma_scale_f32_16x16x128_f8f6f4(Bt[n], At[m], acc[ai][bj][m][n], 0, 0, 0, 0x7f7f7f7f, 0, 0x7f7f7f7f); } \
        else { acc[ai][bj][m][n] = __builtin_amdgcn_mfma_f32_16x16x32_bf16(PG8_HALF(Bt[n], 0), PG8_HALF(At[m], 0), acc[ai][bj][m][n], 0, 0, 0); \
               acc[ai][bj][m][n] = __builtin_amdgcn_mfma_f32_16x16x32_bf16(PG8_HALF(Bt[n], 1), PG8_HALF(At[m], 1), acc[ai][bj][m][n], 0, 0, 0); } } \
        __builtin_amdgcn_s_setprio(0); } while (0)
#define PG8_WAIT_V(n) asm volatile("s_waitcnt vmcnt(" #n ")" ::: "memory")
#define PG8_WAIT_L(n) asm volatile("s_waitcnt lgkmcnt(" #n ")" ::: "memory")
#define PG8_BAR __builtin_amdgcn_s_barrier()
#define PG8_SCHED __builtin_amdgcn_sched_barrier(0)
    Unit cur, nxt, nn; int ui = 0;
    if (!S.next(0, cur)) return;
    f32x4 acc[2][2][4][2];
#pragma unroll
    for (int a = 0; a < 2; ++a)
#pragma unroll
        for (int b = 0; b < 2; ++b)
#pragma unroll
            for (int m = 0; m < 4; ++m)
#pragma unroll
                for (int n = 0; n < 2; ++n) acc[a][b][m][n] = (f32x4){0.f, 0.f, 0.f, 0.f};
    v8i_t At[4], B0[2], B1[2];
    unsigned cvo[2][2], nvo[2][2], nnvo[2][2];
    MP.a_off(cur, Rr, Cc, cvo);
    bool has_next = S.next(1, nxt);
    if constexpr (Map::GATHER) { if (has_next) MP.a_off(nxt, Rr, Cc, nvo); else { nvo[0][0] = cvo[0][0]; nvo[0][1] = cvo[0][1]; nvo[1][0] = cvo[1][0]; nvo[1][1] = cvo[1][1]; } }
    unsigned cA = MP.a_soff(cur), cB = MP.b_soff(cur);
    typename Epi::Pre pc, pn;
    E.preload(cur, wr, wc, fr, fq, pc); pn = pc;
    PG8_STAGE(PG8_SB(0, 0), RB, cB, voffB); PG8_STAGE(PG8_SB(0, 1), RB, cB + hstepB, voffB); PG8_STAGE(PG8_SA(0, 0), RA, cA, cvo[0]); PG8_STAGE(PG8_SA(0, 1), RA, cA, cvo[1]);
    if (wr == 1) PG8_BAR;
    PG8_WAIT_V(2); PG8_BAR;
    PG8_STAGE(PG8_SB(1, 0), RB, cB + kstep, voffB); PG8_STAGE(PG8_SA(1, 0), RA, cA + kstep, cvo[0]); PG8_STAGE(PG8_SB(1, 1), RB, cB + hstepB + kstep, voffB);
    PG8_WAIT_V(6); PG8_BAR;
    for (;;) {
        const unsigned nA = has_next ? MP.a_soff(nxt) : cA, nB = has_next ? MP.b_soff(nxt) : cB;
#pragma unroll 1
        for (int t = 0; t < nt; t += 2) {
            const bool last = (t == nt - 2);
            const unsigned a1 = cA + (unsigned)(t + 1) * kstep;
            const unsigned a2 = last ? nA : cA + (unsigned)(t + 2) * kstep, b2 = last ? nB : cB + (unsigned)(t + 2) * kstep;
            const unsigned a3 = a2 + kstep, b3 = b2 + kstep;
            unsigned s0[2] = {cvo[0][0], cvo[0][1]}, s1[2] = {cvo[1][0], cvo[1][1]};
            if constexpr (Map::GATHER) { if (last) { s0[0] = nvo[0][0]; s0[1] = nvo[0][1]; s1[0] = nvo[1][0]; s1[1] = nvo[1][1]; } }
            PG8_LDB(B0, 0, 0); PG8_LDB(B1, 0, 1); PG8_SCHED; PG8_LDA(At, 0, 0); PG8_STAGE(PG8_SA(1, 1), RA, a1, cvo[1]);
            PG8_WAIT_V(8); PG8_WAIT_L(0); PG8_BAR; PG8_MMA(0, 0, At, B0); PG8_MMA(0, 1, At, B1); PG8_BAR; PG8_SCHED;
            PG8_LDA(At, 0, 1); PG8_STAGE(PG8_SB(0, 0), RB, b2, voffB); PG8_STAGE(PG8_SB(0, 1), RB, b2 + hstepB, voffB); PG8_STAGE(PG8_SA(0, 0), RA, a2, s0);
            PG8_WAIT_V(8); PG8_WAIT_L(0); PG8_BAR; PG8_MMA(1, 0, At, B0); PG8_MMA(1, 1, At, B1); PG8_BAR; PG8_SCHED;
            PG8_LDB(B0, 1, 0); PG8_LDB(B1, 1, 1); PG8_SCHED; PG8_LDA(At, 1, 0); PG8_STAGE(PG8_SA(0, 1), RA, a2, s1);
            PG8_WAIT_V(8); PG8_WAIT_L(0); PG8_BAR; PG8_MMA(0, 0, At, B0); PG8_MMA(0, 1, At, B1); PG8_BAR; PG8_SCHED;
            PG8_LDA(At, 1, 1); PG8_STAGE(PG8_SB(1, 0), RB, b3, voffB); PG8_STAGE(PG8_SB(1, 1), RB, b3 + hstepB, voffB); PG8_STAGE(PG8_SA(1, 0), RA, a3, s0);
            PG8_WAIT_V(8); PG8_WAIT_L(0); PG8_BAR; PG8_MMA(1, 0, At, B0); PG8_MMA(1, 1, At, B1); PG8_BAR; PG8_SCHED;
        }
        if constexpr (ALIGN_EPI) { if (wr == 0) PG8_BAR; }
        const bool has_nn = has_next && S.next(ui + 2, nn);
        if constexpr (Map::GATHER) { if (has_nn) MP.a_raw(nn, Rr, nnvo); }
        if (has_next) E.preload(nxt, wr, wc, fr, fq, pn);
        { int fr_ = fr, fq_ = fq; asm volatile("" : "+v"(fr_), "+v"(fq_)); E(acc, cur, pc, wr, wc, fr_, fq_); }
        if (!has_next) break;
#pragma unroll
        for (int a = 0; a < 2; ++a)
#pragma unroll
            for (int b = 0; b < 2; ++b)
#pragma unroll
                for (int m = 0; m < 4; ++m)
#pragma unroll
                    for (int n = 0; n < 2; ++n) acc[a][b][m][n] = (f32x4){0.f, 0.f, 0.f, 0.f};
        cur = nxt; cA = nA; cB = nB; ++ui; pc = pn;
#pragma unroll
        for (int h = 0; h < 2; ++h)
#pragma unroll
            for (int i = 0; i < 2; ++i) { if constexpr (Map::GATHER) { cvo[h][i] = nvo[h][i]; nvo[h][i] = has_nn ? MP.a_fin(nnvo[h][i], Cc[i]) : nvo[h][i]; } }
        has_next = has_nn; nxt = nn;
        if constexpr (ALIGN_EPI) { if (wr == 1) PG8_BAR; }
    }
    PG8_WAIT_V(0);
    if constexpr (!ALIGN_EPI) { if (wr == 0) PG8_BAR; }
    PG8_BAR;
#undef PG8_SA
#undef PG8_SB
#undef PG8_STAGE
#undef PG8_LDA
#undef PG8_LDB
#undef PG8_MMA
#undef PG8_HALF
#undef PG8_LD8
#undef PG8_WAIT_V
#undef PG8_WAIT_L
#undef PG8_BAR
#undef PG8_SCHED
}
}
namespace attn_body {
using bf16=__hip_bfloat16;
using bf16x8=__attribute__((ext_vector_type(8)))short;
using s16x4=__attribute__((ext_vector_type(4)))short;
using f32x16=__attribute__((ext_vector_type(16)))float;
using u32x4=__attribute__((ext_vector_type(4)))unsigned;
constexpr int BATCH=8,NHEAD=8,NKVH=2,SEQ=4096,D=64;
constexpr int QP=512,KP=128,VP=128,OP=1024,OCOL=512;
constexpr int NW=8,QBLK=32,QB=QBLK*NW,KVBLK=64,NQB=SEQ/QB;
__device__ __forceinline__ int crow(int r,int hi){return (r&3)+8*(r>>2)+4*hi;}
#define SBAR() __builtin_amdgcn_sched_barrier(0)
constexpr int NSLOT=3, SLOTB=8192;
constexpr int LDS_K=0, LDS_V=NSLOT*SLOTB, LDS_WS=2*NSLOT*SLOTB, LDS_OST=LDS_WS+NW*64*4, LDS_BYTES=LDS_OST+NW*4096;
constexpr float C2=0.125f*1.4426950408889634f;
__device__ __forceinline__ void glds16(const void*gsrc,unsigned lds_dst){unsigned keep;
  asm volatile("s_mov_b32 %0, m0\n\ts_mov_b32 m0, %2\n\ts_nop 0\n\tglobal_load_lds_dwordx4 %1, off\n\ts_mov_b32 m0, %0":"=&s"(keep):"v"(gsrc),"s"(lds_dst):"memory");}
__device__ __forceinline__ float max3f(float a,float b,float c){float r;asm("v_max3_f32 %0, %1, %2, %3":"=v"(r):"v"(a),"v"(b),"v"(c));return r;}
__device__ __forceinline__ float max2f(float a,float b){float r;asm("v_max_f32_e32 %0, %1, %2":"=v"(r):"v"(a),"v"(b));return r;}
__device__ __forceinline__ float fadd_s(float a,float b){float r;asm("v_add_f32_e32 %0, %1, %2":"=v"(r):"v"(a),"v"(b));return r;}
__device__ __forceinline__ float fsub_s(float a,float b){float r;asm("v_sub_f32_e32 %0, %1, %2":"=v"(r):"v"(a),"v"(b));return r;}
typedef float f32x2_t __attribute__((ext_vector_type(2))); typedef __bf16 bf16x2_t __attribute__((ext_vector_type(2)));
__device__ __forceinline__ unsigned cvtpk_s(float lo,float hi){f32x2_t v={lo,hi};bf16x2_t b=__builtin_convertvector(v,bf16x2_t);return __builtin_bit_cast(unsigned,b);}
#define WAIT_BAR(N) asm volatile("s_waitcnt vmcnt(" #N ") lgkmcnt(0)\n\ts_barrier":::"memory")

__device__ __forceinline__ void qkt(f32x16&p0,f32x16&p1,const char*Kslot,const bf16x8*qr,const f32x16&negm,int r32,int hi){
  const char*kb=Kslot+hi*1024+r32*16;
  #pragma unroll
  for(int d0=0;d0<4;++d0){
    const bf16x8 b0=*reinterpret_cast<const bf16x8*>(kb+d0*2048);
    const bf16x8 b1=*reinterpret_cast<const bf16x8*>(kb+d0*2048+512);
    if(d0==0){p0=__builtin_amdgcn_mfma_f32_32x32x16_bf16(b0,qr[0],negm,0,0,0);p1=__builtin_amdgcn_mfma_f32_32x32x16_bf16(b1,qr[0],negm,0,0,0);}
    else{p0=__builtin_amdgcn_mfma_f32_32x32x16_bf16(b0,qr[d0],p0,0,0,0);p1=__builtin_amdgcn_mfma_f32_32x32x16_bf16(b1,qr[d0],p1,0,0,0);}}
}
typedef __attribute__((address_space(3))) const char* lds_cptr;
typedef short v4i16_t __attribute__((ext_vector_type(4)));
__device__ __forceinline__ void kload8(bf16x8*kf,lds_cptr kp){
  kf[0]=*(const __attribute__((address_space(3))) bf16x8*)(kp);      kf[1]=*(const __attribute__((address_space(3))) bf16x8*)(kp+512);
  kf[2]=*(const __attribute__((address_space(3))) bf16x8*)(kp+2048); kf[3]=*(const __attribute__((address_space(3))) bf16x8*)(kp+2560);
  kf[4]=*(const __attribute__((address_space(3))) bf16x8*)(kp+4096); kf[5]=*(const __attribute__((address_space(3))) bf16x8*)(kp+4608);
  kf[6]=*(const __attribute__((address_space(3))) bf16x8*)(kp+6144); kf[7]=*(const __attribute__((address_space(3))) bf16x8*)(kp+6656);
}
__device__ __forceinline__ void kload2(bf16x8*kf,lds_cptr kp,int j){ kf[2*j]=*(const __attribute__((address_space(3))) bf16x8*)(kp+j*2048); kf[2*j+1]=*(const __attribute__((address_space(3))) bf16x8*)(kp+j*2048+512); }
__device__ __forceinline__ s16x4 vtr(lds_cptr p){ return __builtin_bit_cast(s16x4,__builtin_amdgcn_ds_read_tr16_b64_v4i16((__attribute__((address_space(3))) v4i16_t*)p)); }
__device__ __forceinline__ float rowmax(const f32x16&p0,const f32x16&p1){
  float a=max3f(p0[0],p0[1],p1[0]),b=max3f(p0[2],p0[3],p1[1]);a=max3f(a,p1[2],p1[3]);
  #pragma unroll
  for(int r=4;r<16;r+=4){a=max3f(a,p0[r],p0[r+1]);b=max3f(b,p0[r+2],p0[r+3]);a=max3f(a,p1[r],p1[r+1]);b=max3f(b,p1[r+2],p1[r+3]);}
  const float m=max2f(a,b);
  auto rr=__builtin_amdgcn_permlane32_swap(__float_as_uint(m),__float_as_uint(m),false,false);
  return max2f(__uint_as_float(rr[0]),__uint_as_float(rr[1]));
}
__device__ __forceinline__ void pv(f32x16*o,int vb,bf16x8 pa0,bf16x8 pa1,bf16x8 pa2,bf16x8 pa3){
  #pragma unroll
  for(int d0=0;d0<2;++d0){s16x4 lo[4],hi[4];
    #pragma unroll
    for(int ks=0;ks<4;++ks){
      asm volatile("ds_read_b64_tr_b16 %0,%1 offset:%c2":"=&v"(lo[ks]):"v"(vb),"i"(d0*4096+ks*1024):"memory");
      asm volatile("ds_read_b64_tr_b16 %0,%1 offset:%c2":"=&v"(hi[ks]):"v"(vb),"i"(d0*4096+ks*1024+512):"memory");}
    asm volatile("s_waitcnt lgkmcnt(0)":::"memory");SBAR();
    #define PK(k) (bf16x8){lo[k][0],lo[k][1],lo[k][2],lo[k][3],hi[k][0],hi[k][1],hi[k][2],hi[k][3]}
    o[d0]=__builtin_amdgcn_mfma_f32_32x32x16_bf16(pa0,PK(0),o[d0],0,0,0);
    o[d0]=__builtin_amdgcn_mfma_f32_32x32x16_bf16(pa1,PK(1),o[d0],0,0,0);
    o[d0]=__builtin_amdgcn_mfma_f32_32x32x16_bf16(pa2,PK(2),o[d0],0,0,0);
    o[d0]=__builtin_amdgcn_mfma_f32_32x32x16_bf16(pa3,PK(3),o[d0],0,0,0);
    #undef PK
  }
}
#define ATTN_STORE16(p,v) (*(u32x4*)(p)=(v))
template<int THRL> __device__ __forceinline__ void attn_unit(int b,int h,int qb,const bf16*Q,const bf16*__restrict__ K,const bf16*__restrict__ V,bf16*O,char*shm,const float*qgain,const float sbound){
  int tid_=threadIdx.x; asm volatile("":"+v"(tid_));
  const int tid=tid_,lane=tid&63,r32=lane&31,hi=lane>>5; const int wid=__builtin_amdgcn_readfirstlane(tid>>6);
  const long rowbase=(long)b*SEQ; const int q0=qb*QB; const int kvh=h/(NHEAD/NKVH);
  const bf16*Qw=Q+(rowbase+q0+wid*QBLK)*QP+h*D;
  const bf16*Kh=K+rowbase*KP+kvh*D,*Vh=V+rowbase*VP+kvh*D;
  const unsigned lds0=(unsigned)(uintptr_t)shm;
  float*wsf=(float*)(shm+LDS_WS)+wid*64;
  const bf16*ksrc=Kh+(long)lane*KP+wid*8;
  const bf16*vsrc=Vh+(long)(16*(wid&3)+(lane>>2))*VP+(wid>>2)*32+(lane&3)*8;
  const unsigned kdst=lds0+LDS_K+wid*1024, vdst=lds0+LDS_V+wid*1024;
  #define DMA_K(t,slot) glds16(ksrc+(long)(t)*KVBLK*KP,(unsigned)__builtin_amdgcn_readfirstlane(kdst+(slot)))
  #define DMA_V(t,slot) glds16(vsrc+(long)(t)*KVBLK*VP,(unsigned)__builtin_amdgcn_readfirstlane(vdst+(slot)))
  const int vb0=(int)(lds0+LDS_V)+((lane>>4)&1)*32+(lane&3)*8+(4*hi+((lane&15)>>2))*64;
  const char*Kbase=shm+LDS_K; bf16x8 kf[8];
  const lds_cptr shm3=(lds_cptr)shm; const lds_cptr kp0=shm3+LDS_K+hi*1024+r32*16; const lds_cptr vp0=shm3+LDS_V+((lane>>4)&1)*32+(lane&3)*8+(4*hi+((lane&15)>>2))*64;
  constexpr int NT=SEQ/KVBLK;
  DMA_K(0,0);DMA_V(0,0);DMA_K(1,SLOTB);
  bf16x8 qr[4];
  #pragma unroll
  for(int d0=0;d0<4;++d0)qr[d0]=*reinterpret_cast<const bf16x8*>(&Qw[(long)r32*QP+d0*16+hi*8]);
  { float xq[4][8]; float ss=0.f; int hio=hi; asm volatile("":"+v"(hio));
    #pragma unroll
    for(int d0=0;d0<4;++d0)
      #pragma unroll
      for(int j=0;j<8;++j){ xq[d0][j]=__builtin_bit_cast(float,((unsigned)(unsigned short)qr[d0][j])<<16); ss+=xq[d0][j]*xq[d0][j]; }
    ss+=__shfl_xor(ss,32);
    const float rinv=__builtin_amdgcn_rsqf(ss*(1.f/64.f)+1e-6f);
    const int tq=q0+wid*QBLK+r32; const float prow=(float)(tq>>6), pcol=(float)(tq&63);
    #pragma unroll
    for(int d0=0;d0<4;++d0)
      #pragma unroll
      for(int j=0;j<8;++j) xq[d0][j]*=rinv*qgain[16*d0+8*hio+j];
    #pragma unroll
    for(int j=0;j<8;++j){ const float inv=exp2f(-(float)(8*hio+j)*(13.287712379549449f/16.f));
      const float ar=prow*inv, ac=pcol*inv; const float cr=__cosf(ar), sr=__sinf(ar), cc=__cosf(ac), sc=__sinf(ac);
      const float a0=xq[0][j], a1=xq[1][j], b0=xq[2][j], b1=xq[3][j];
      xq[0][j]=(a0*cr-a1*sr)*C2; xq[1][j]=(a1*cr+a0*sr)*C2; xq[2][j]=(b0*cc-b1*sc)*C2; xq[3][j]=(b1*cc+b0*sc)*C2; }
    #pragma unroll
    for(int d0=0;d0<4;++d0){ u32x4 w; w.x=cvtpk_s(xq[d0][0],xq[d0][1]); w.y=cvtpk_s(xq[d0][2],xq[d0][3]); w.z=cvtpk_s(xq[d0][4],xq[d0][5]); w.w=cvtpk_s(xq[d0][6],xq[d0][7]); qr[d0]=__builtin_bit_cast(bf16x8,w); } }
  float l_reg=0.f;f32x16 o[2];o[0]=f32x16{};o[1]=f32x16{};f32x16 negm;
  #pragma unroll
  for(int r=0;r<16;++r)negm[r]=-sbound;
  asm volatile("":"+v"(negm));
  #define START(P0,P1) do{ _Pragma("unroll") for(int r=0;r<16;++r)P0[r]=__builtin_amdgcn_exp2f(P0[r]); }while(0)
  #define RESC() do{}while(0)
  f32x16 pA0,pA1,pB0,pB1;
  int sl_prev=0,sl_cur=0,sl_next=SLOTB;
  #define ROT() do{sl_prev=sl_cur;sl_cur=sl_next;sl_next=(sl_next==(NSLOT-1)*SLOTB)?0:sl_next+SLOTB;}while(0)
  DMA_K(2,2*SLOTB);
  WAIT_BAR(3);
  qkt(pA0,pA1,Kbase,qr,negm,r32,hi);asm volatile("s_nop 15\n\ts_nop 7":"+v"(pA0),"+v"(pA1));
  START(pA0,pA1);
  _Pragma("unroll") for(int r=0;r<16;++r)pA1[r]=__builtin_amdgcn_exp2f(pA1[r]);
  WAIT_BAR(0);
  DMA_K(3,0);DMA_V(1,SLOTB);
  ROT();
  kload8(kf,kp0+sl_cur);
  WAIT_BAR(2);
  s16x4 vlo[8],vhi[8]; u32x4 pw0,pw1,pw2,pw3;
  #define PKW(P,B) cvtpk_s(P[B],P[B+1])
  #define PAF(k) __builtin_bit_cast(bf16x8,pw##k)
  #define VFR(i) (bf16x8){vlo[i][0],vlo[i][1],vlo[i][2],vlo[i][3],vhi[i][0],vhi[i][1],vhi[i][2],vhi[i][3]}
  #define PIN(x) asm volatile("":"+v"(x))
  #define MX3(a,b,c) __builtin_fmaxf(__builtin_fmaxf((a),(b)),(c))
  #define GAPA(MF,A0,A1,A2,A3,W0,W1,PW) do{ MF; sacc+=A0; sacc+=A1; sacc+=A2; sacc+=A3; PIN(sacc); W0; W1; PIN(PW); SBAR(); }while(0)
  #define EX(v) __builtin_amdgcn_exp2f(v)
  #define GAPB(MF,X,B) do{ MF; X[B]=EX(X[B]); X[B+1]=EX(X[B+1]); X[B+2]=EX(X[B+2]); X[B+3]=EX(X[B+3]); PIN(X); SBAR(); }while(0)
  #define VRD(i) do{ vlo[i]=vtr(vp_+(((i)>>2)*4096+((i)&3)*1024)); vhi[i]=vtr(vp_+(((i)>>2)*4096+((i)&3)*1024+512)); }while(0)
  #define KRD(G,j) do{ if(G){ kload2(kf,kp0+sl_next,j); SBAR(); } }while(0)
  #define STEP(C0,C1,P0,P1,t,GK,GV,GL) do{ SBAR(); \
    const lds_cptr vp_=vp0+sl_prev; \
    VRD(0); SBAR(); float sacc=(P0[0]+P0[1]); \
    GAPA(C0=__builtin_amdgcn_mfma_f32_32x32x16_bf16(kf[0],qr[0],negm,0,0,0), P0[2],P0[3],P0[4],P0[5],     pw0[0]=PKW(P0,0), pw0[1]=PKW(P0,2), pw0); \
    VRD(4); SBAR(); GAPA(C1=__builtin_amdgcn_mfma_f32_32x32x16_bf16(kf[1],qr[0],negm,0,0,0), P0[6],P0[7],P0[8],P0[9],     pw0[2]=PKW(P0,4), pw0[3]=PKW(P0,6), pw0); \
    VRD(1); SBAR(); GAPA(C0=__builtin_amdgcn_mfma_f32_32x32x16_bf16(kf[2],qr[1],C0,0,0,0),   P0[10],P0[11],P0[12],P0[13], pw1[0]=PKW(P0,8), pw1[1]=PKW(P0,10), pw1); \
    VRD(5); SBAR(); GAPA(C1=__builtin_amdgcn_mfma_f32_32x32x16_bf16(kf[3],qr[1],C1,0,0,0),   P0[14],P0[15],P1[0],P1[1],   pw1[2]=PKW(P0,12),pw1[3]=PKW(P0,14), pw1); \
    VRD(2); SBAR(); GAPA(C0=__builtin_amdgcn_mfma_f32_32x32x16_bf16(kf[4],qr[2],C0,0,0,0),   P1[2],P1[3],P1[4],P1[5],     pw2[0]=PKW(P1,0), pw2[1]=PKW(P1,2), pw2); \
    VRD(6); SBAR(); GAPA(C1=__builtin_amdgcn_mfma_f32_32x32x16_bf16(kf[5],qr[2],C1,0,0,0),   P1[6],P1[7],P1[8],P1[9],     pw2[2]=PKW(P1,4), pw2[3]=PKW(P1,6), pw2); \
    VRD(3); SBAR(); GAPA(C0=__builtin_amdgcn_mfma_f32_32x32x16_bf16(kf[6],qr[3],C0,0,0,0),   P1[10],P1[11],P1[12],P1[13], pw3[0]=PKW(P1,8), pw3[1]=PKW(P1,10), pw3); \
    VRD(7); SBAR(); GAPA(C1=__builtin_amdgcn_mfma_f32_32x32x16_bf16(kf[7],qr[3],C1,0,0,0),   P1[14],P1[15],0.f,0.f,       pw3[2]=PKW(P1,12),pw3[3]=PKW(P1,14), pw3); \
    l_reg+=sacc; \
    if(GK){DMA_K((t)+3,sl_cur);} if(GV){DMA_V((t)+1,sl_next);} \
    SBAR(); \
    GAPB(o[0]=__builtin_amdgcn_mfma_f32_32x32x16_bf16(PAF(0),VFR(0),o[0],0,0,0), C0,0); \
    GAPB(o[1]=__builtin_amdgcn_mfma_f32_32x32x16_bf16(PAF(0),VFR(4),o[1],0,0,0), C0,4); \
    KRD(GL,0); GAPB(o[0]=__builtin_amdgcn_mfma_f32_32x32x16_bf16(PAF(1),VFR(1),o[0],0,0,0), C0,8); \
    KRD(GL,1); GAPB(o[1]=__builtin_amdgcn_mfma_f32_32x32x16_bf16(PAF(1),VFR(5),o[1],0,0,0), C0,12); \
    KRD(GL,2); GAPB(o[0]=__builtin_amdgcn_mfma_f32_32x32x16_bf16(PAF(2),VFR(2),o[0],0,0,0), C1,0); \
    KRD(GL,3); GAPB(o[1]=__builtin_amdgcn_mfma_f32_32x32x16_bf16(PAF(2),VFR(6),o[1],0,0,0), C1,4); \
    GAPB(o[0]=__builtin_amdgcn_mfma_f32_32x32x16_bf16(PAF(3),VFR(3),o[0],0,0,0), C1,8); \
    GAPB(o[1]=__builtin_amdgcn_mfma_f32_32x32x16_bf16(PAF(3),VFR(7),o[1],0,0,0), C1,12); \
    }while(0)
  int t=1;
  for(;t+5<NT;t+=2){
    STEP(pB0,pB1,pA0,pA1,t,true,true,true);     WAIT_BAR(2); RESC(); ROT();
    STEP(pA0,pA1,pB0,pB1,t+1,true,true,true);   WAIT_BAR(2); RESC(); ROT();
  }
  #define ENDW(tt) do{ if((tt)+3<NT){WAIT_BAR(2);} else if((tt)+2<NT){WAIT_BAR(1);} else {WAIT_BAR(0);} }while(0)
  for(;t+1<NT;t+=2){
    STEP(pB0,pB1,pA0,pA1,t,(t+3<NT),(t+1<NT),(t+1<NT));       ENDW(t);   RESC(); ROT();
    STEP(pA0,pA1,pB0,pB1,t+1,(t+4<NT),(t+2<NT),(t+2<NT));     ENDW(t+1); RESC(); ROT();
  }
  STEP(pB0,pB1,pA0,pA1,NT-1,false,false,false); RESC();
  { float sacc=pB0[0]+pB0[1]; _Pragma("unroll") for(int r=2;r<16;++r)sacc+=pB0[r]; _Pragma("unroll") for(int r=0;r<16;++r)sacc+=pB1[r]; l_reg+=sacc;
    pw0=(u32x4){PKW(pB0,0),PKW(pB0,2),PKW(pB0,4),PKW(pB0,6)};pw1=(u32x4){PKW(pB0,8),PKW(pB0,10),PKW(pB0,12),PKW(pB0,14)};pw2=(u32x4){PKW(pB1,0),PKW(pB1,2),PKW(pB1,4),PKW(pB1,6)};pw3=(u32x4){PKW(pB1,8),PKW(pB1,10),PKW(pB1,12),PKW(pB1,14)};
    SBAR(); pv(o,vb0+sl_cur,PAF(0),PAF(1),PAF(2),PAF(3)); }
  #undef PKW
  #undef PAF
  #undef VFR
  #undef PIN
  #undef MX3
  #undef GAPA
  #undef GAPB
  #undef EX
  #undef VRD
  #undef KRD
  #undef STEP
  #undef ENDW
  {auto rr=__builtin_amdgcn_permlane32_swap(__float_as_uint(l_reg),__float_as_uint(l_reg),false,false);l_reg=__uint_as_float(rr[0])+__uint_as_float(rr[1]);}
  if(hi==0)wsf[32+r32]=l_reg;asm volatile("s_waitcnt lgkmcnt(0)":::"memory");
  float rli[16];
  #pragma unroll
  for(int r=0;r<16;++r)rli[r]=__builtin_amdgcn_rcpf(wsf[32+crow(r,hi)]);
  bf16*Ow=O+(rowbase+q0+wid*QBLK)*OP+OCOL+h*D;
  { bf16*stg=(bf16*)(shm+LDS_OST)+wid*2048;
    #pragma unroll
    for(int r=0;r<16;++r){const int orow=crow(r,hi);
      #pragma unroll
      for(int d0=0;d0<2;++d0)stg[orow*64+d0*32+r32]=__float2bfloat16(o[d0][r]*rli[r]);}
    asm volatile("s_waitcnt lgkmcnt(0)":::"memory");
    #pragma unroll
    for(int i=0;i<4;++i){const int row=i*8+(lane>>3),ch=lane&7; const u32x4 v=*(const u32x4*)(stg+row*64+ch*8); ATTN_STORE16(Ow+(long)row*OP+ch*8,v);} }
  asm volatile("s_waitcnt lgkmcnt(0)\n\ts_barrier":::"memory");
  #undef DMA_K
  #undef DMA_V
  #undef START
  #undef RESC
  #undef ROT
}
constexpr int ATTN_LDS_BYTES=LDS_BYTES;
#undef SBAR
#undef WAIT_BAR
}
constexpr int NWAVES = 8;
constexpr int BATCH = 8, SEQ = 4096, DM = 1024, T = BATCH * SEQ;
constexpr int GLA_H = 4, GLA_DK = 64, GLA_DV = 128, GLA_RANK = 16;
constexpr int ATT_H = 8, ATT_KVH = 2, ATT_DH = 64;
constexpr int D_IN = 2336, D_IN_PAD = 2560;
constexpr int NEXP = 32, TOPK = 4, DFF = 1024;
constexpr int EROWS = 32768;
constexpr int PROWS = T * TOPK + NEXP * 256;
constexpr float EPS = 1e-6f;
constexpr float YSCALE = 16.f;
constexpr float WSCALE = 32.f, ASCALE = 4.f;

constexpr size_t MiB = 1u << 20;
constexpr size_t WS_CTL = 0, CTL_ZERO_BYTES = 1 * MiB;
constexpr size_t WS_WRH = 1 * MiB, WS_WRL = WS_WRH + 65536;
constexpr size_t WS_WIN = 2 * MiB;
constexpr size_t WS_WOUT = 8 * MiB;
constexpr size_t WS_W1 = 10 * MiB;
constexpr size_t WS_W2 = 138 * MiB;
constexpr size_t WS_ROWTOK = 202 * MiB;
constexpr size_t WS_ROWGATE = 206 * MiB;
constexpr size_t WS_TOKASG = 210 * MiB;
constexpr size_t WS_REGY = 212 * MiB;
constexpr size_t WS_XN = WS_REGY;
constexpr size_t WS_GQ = WS_XN + 64 * MiB;
constexpr size_t WS_GK = WS_GQ + 16 * MiB;
constexpr size_t WS_GV = WS_GK + 16 * MiB;
constexpr size_t WS_GR = WS_GV + 32 * MiB;
constexpr size_t WS_AQ = WS_GR + 32 * MiB;
constexpr size_t WS_AK = WS_AQ + 32 * MiB;
constexpr size_t WS_AV = WS_AK + 8 * MiB;
constexpr size_t WS_Z = WS_AV + 8 * MiB;
constexpr size_t WS_OF = WS_Z + 2 * MiB;
constexpr size_t WS_H16 = WS_REGY + 200 * MiB;
constexpr size_t WS_Y = WS_REGY;
constexpr size_t WS_REGA = WS_REGY + 274 * MiB;
constexpr size_t WS_MIX = WS_REGA;
constexpr size_t WS_ACT = WS_REGA;
constexpr size_t WS_QF = WS_REGA + 272 * MiB, WS_KF = WS_QF + 16 * MiB, WS_QB = WS_KF + 16 * MiB, WS_KB = WS_QB + 16 * MiB;
constexpr size_t WS_DEC = WS_KB + 16 * MiB;
constexpr size_t WS_RINV = WS_DEC + 1 * MiB;
constexpr size_t WS_END = WS_RINV + 1 * MiB;
static_assert(WS_OF + (size_t)T * 512 * 4 <= WS_REGA && (size_t)PROWS * 1024 * 2 <= 272 * MiB, "d_ws map");
constexpr int CW_BAR = 4096;
constexpr int CW_CNT = 8192;
constexpr int CW_CONV = 20480;
constexpr int CW_GDN = 16384;
constexpr int CW_QUE = 12288;

constexpr int SCR_BYTES = 133120;
constexpr int LC_OFF = SCR_BYTES;
constexpr int LC_MISC = LC_OFF;
constexpr int LC_CNT = LC_OFF + 128;
constexpr int LC_CST = LC_CNT + 128;
constexpr int LC_TE = LC_CST + 256;
constexpr int LC_HIST = LC_TE + 1152;
constexpr int LC_BASE = LC_HIST + 128;
constexpr int LC_ASG = LC_BASE + 128;
constexpr int LC_GDEC = LC_ASG + 8192;
constexpr int LC_END = LC_GDEC + 512;
constexpr int LDS_BYTES = 147456;
static_assert(LC_END <= LDS_BYTES, "LDS map");

typedef unsigned short bf16;
typedef unsigned v4u __attribute__((ext_vector_type(4)));
typedef unsigned v2u __attribute__((ext_vector_type(2)));
typedef float f32x4 __attribute__((ext_vector_type(4)));
typedef short bf16x8 __attribute__((ext_vector_type(8)));
typedef GAS unsigned gu32;
#define RLX_AGENT __ATOMIC_RELAXED, __HIP_MEMORY_SCOPE_AGENT
#define LDS_WAIT() asm volatile("s_waitcnt lgkmcnt(0)" ::: "memory")
#define VM_WAIT() asm volatile("s_waitcnt vmcnt(0)" ::: "memory")
__device__ __forceinline__ unsigned pk2(float lo, float hi) { typedef float f2_t_ __attribute__((ext_vector_type(2))); typedef __bf16 b2_t_ __attribute__((ext_vector_type(2))); const f2_t_ v = {lo, hi}; return __builtin_bit_cast(unsigned, __builtin_convertvector(v, b2_t_)); }
__device__ __forceinline__ unsigned f2bf(float f) { return pk2(f, 0.f) & 0xffffu; }
__device__ __forceinline__ float bf2f(unsigned h) { return __builtin_bit_cast(float, h << 16); }
__device__ __forceinline__ float bflo(unsigned w) { return __builtin_bit_cast(float, w << 16); }
__device__ __forceinline__ float bfhi(unsigned w) { return __builtin_bit_cast(float, w & 0xffff0000u); }

#define XB_TMO      128
#define XB_XCNT(j)  (256  + 64 * (j))
#define XB_XSUB(j)  (1280 + 64 * (j))
#define XB_XGEN(j)  (2304 + 64 * (j))
#define XB_TOP      3328
#define XB_TOPGEN   3392
#define XCD_BAR_WORDS 3456
#define XB_SPIN_CAP (1u << 18)
__device__ __forceinline__ unsigned xb_ld(unsigned* p)              { return __hip_atomic_load(p, __ATOMIC_RELAXED, __HIP_MEMORY_SCOPE_AGENT); }
__device__ __forceinline__ unsigned xb_add(unsigned* p, unsigned v) { return __hip_atomic_fetch_add(p, v, __ATOMIC_RELAXED, __HIP_MEMORY_SCOPE_AGENT); }
__device__ __forceinline__ unsigned xb_xcc_id() { return (unsigned)__builtin_amdgcn_s_getreg((3 << 11) | 20) & 0xFu; }
#define XB_SPIN(cond, bar) do { unsigned _sp = 0; while (cond) { __builtin_amdgcn_s_sleep(1); \
    if ((++_sp & 255u) == 0u) { if (xb_ld(&(bar)[XB_TMO])) break; if (_sp > XB_SPIN_CAP) { atomicAdd(&(bar)[XB_TMO], 1u); break; } } } } while (0)
struct XcdBarrier { unsigned* bar; unsigned x; volatile LAS unsigned* st; };
__device__ __forceinline__ XcdBarrier xcd_barrier_post(unsigned* bar, volatile LAS unsigned* st) {
    XcdBarrier b; b.bar = bar; b.x = xb_xcc_id(); b.st = st;
    if (threadIdx.x == 0) (void)xb_add(&bar[XB_XCNT(b.x)], 1u);
    return b;
}
__device__ __forceinline__ void xcd_barrier_complete(unsigned* bar, unsigned x, unsigned& nloc, unsigned& nx) {
    const unsigned G = gridDim.x * gridDim.y * gridDim.z;
    unsigned sum, cnt, mine, sp = 0u;
    for (;;) {
        sum = 0u; cnt = 0u; mine = 0u;
#pragma unroll
        for (unsigned j = 0; j < 16; ++j) { const unsigned c = xb_ld(&bar[XB_XCNT(j)]); sum += c; cnt += (c > 0u) ? 1u : 0u; mine = (j == x) ? c : mine; }
        if (sum == G) break;
        __builtin_amdgcn_s_sleep(1);
        if ((++sp & 255u) == 0u) { if (xb_ld(&bar[XB_TMO])) break; if (sp > XB_SPIN_CAP) { atomicAdd(&bar[XB_TMO], 1u); break; } }
    }
    nloc = mine > 0u ? mine : 1u; nx = cnt > 0u ? cnt : 1u;
}
__device__ __forceinline__ void xcd_barrier(const XcdBarrier& b) {
    asm volatile("s_waitcnt vmcnt(0)" ::: "memory");
    __syncthreads();
    if (threadIdx.x == 0) {
        unsigned* bar = b.bar;
        __builtin_amdgcn_s_waitcnt(0);
        unsigned nloc = b.st[0], nx = b.st[1];
        if (nloc == 0u) { xcd_barrier_complete(bar, b.x, nloc, nx); b.st[0] = nloc; b.st[1] = nx; }
        const unsigned old = xb_add(&bar[XB_XSUB(b.x)], 1u);
        const unsigned gen = old / nloc;
        if (old + 1u == (gen + 1u) * nloc) {
            __builtin_amdgcn_fence(__ATOMIC_RELEASE, "agent");
            asm volatile("s_waitcnt vmcnt(0)" ::: "memory");
            const unsigned og = xb_add(&bar[XB_TOP], 1u);
            const unsigned tg = og / nx;
            if (og + 1u == (tg + 1u) * nx) xb_add(&bar[XB_TOPGEN], 1u);
            else XB_SPIN(xb_ld(&bar[XB_TOPGEN]) == tg, bar);
            __builtin_amdgcn_fence(__ATOMIC_ACQUIRE, "agent");
            xb_add(&bar[XB_XGEN(b.x)], 1u);
            asm volatile("s_waitcnt vmcnt(0)" ::: "memory");
        } else {
            XB_SPIN(xb_ld(&bar[XB_XGEN(b.x)]) == gen, bar);
            __builtin_amdgcn_fence(__ATOMIC_ACQUIRE, "agent");
            asm volatile("s_waitcnt vmcnt(0)" ::: "memory");
        }
    }
    __syncthreads();
}

struct Frame {
    LAS unsigned char* lds;
    volatile LAS unsigned* MISC;
    gu32* ctl;
    int tid, lane, wave;
    int vcu, G;
    unsigned char* ws;
    const float *x, *mix_g, *w_in, *w_gf, *b_gf, *w_gb, *b_gb, *gla_hg, *q_g, *k_g, *w_out, *ffn_g, *w_router, *b_router, *w1, *b1, *w2, *b2, *fin_g;
    float* out;
};
template <int CTRL> __device__ __forceinline__ float dpp_mov(float v) { return __builtin_bit_cast(float, __builtin_amdgcn_update_dpp(0, __builtin_bit_cast(int, v), CTRL, 0xf, 0xf, true)); }
__device__ __forceinline__ float wave_sum(float v) {
    v += dpp_mov<0xB1>(v);
    v += dpp_mov<0x4E>(v);
    v += dpp_mov<0x141>(v);
    v += dpp_mov<0x140>(v);
    { auto r = __builtin_amdgcn_permlane16_swap(__float_as_uint(v), __float_as_uint(v), false, false); v = __uint_as_float(r[0]) + __uint_as_float(r[1]); }
    { auto r = __builtin_amdgcn_permlane32_swap(__float_as_uint(v), __float_as_uint(v), false, false); v = __uint_as_float(r[0]) + __uint_as_float(r[1]); }
    return v;
}
__device__ __forceinline__ void p0_tr64(const float* src  , int ldw, bf16* d0, bf16* d1, int ldt, LAS float* scr, int lane, int ncols, const float* kg  ) {
    const int c4 = (lane & 15) * 4, kr = lane >> 4;
    if (c4 < ncols) {
#pragma unroll 4
        for (int i = 0; i < 16; ++i) { const int kk = kr + 4 * i; const f32x4 v = *(const GAS f32x4*)(src + (size_t)kk * ldw + c4) * (kg ? kg[kk] : 1.f);
            LAS float* s = scr + kk * 65 + c4; s[0] = v.x; s[1] = v.y; s[2] = v.z; s[3] = v.w; }
    }
    LDS_WAIT(); asm volatile("" ::: "memory");
    const int c = lane & 7;
#pragma unroll
    for (int j = 0; j < 8; ++j) { const int n = (lane >> 3) + 8 * j;
        if (n < ncols) { const LAS float* s = scr + (8 * c) * 65 + n;
            v4u o; o.x = pk2(s[0 * 65], s[1 * 65]); o.y = pk2(s[2 * 65], s[3 * 65]); o.z = pk2(s[4 * 65], s[5 * 65]); o.w = pk2(s[6 * 65], s[7 * 65]);
            bf16* rowp = (n < 32 ? d0 : d1) + (size_t)(n & 31) * ldt;
            *(GAS v4u*)(rowp + 8 * c) = o; } }
    LDS_WAIT(); asm volatile("" ::: "memory");
}
struct F8Item { const float* src; int ldw; unsigned char* d0; unsigned char* d1; };
__device__ __forceinline__ void f8_load(const F8Item& it, f32x4 (&v)[16], int lane) {
    const int c4 = (lane & 15) * 4, kr = lane >> 4;
#pragma unroll
    for (int i = 0; i < 16; ++i) v[i] = __builtin_nontemporal_load((const GAS f32x4*)(it.src + (size_t)(kr + 4 * i) * it.ldw + c4));
}
__device__ __forceinline__ void f8_finish(const F8Item& it, const f32x4 (&v)[16], LAS float* scr, int lane, float sc) {
    const int c4 = (lane & 15) * 4, kr = lane >> 4;
#pragma unroll
    for (int i = 0; i < 16; ++i) { LAS float* s = scr + (kr + 4 * i) * 65 + c4; s[0] = v[i].x; s[1] = v[i].y; s[2] = v[i].z; s[3] = v[i].w; }
    LDS_WAIT(); asm volatile("" ::: "memory");
    const int c = lane & 7;
#pragma unroll
    for (int j = 0; j < 8; ++j) { const int n = (lane >> 3) + 8 * j; const LAS float* s = scr + (8 * c) * 65 + n;
        int w0 = 0, w1 = 0;
        w0 = __builtin_amdgcn_cvt_pk_fp8_f32(s[0 * 65] * sc, s[1 * 65] * sc, w0, false); w0 = __builtin_amdgcn_cvt_pk_fp8_f32(s[2 * 65] * sc, s[3 * 65] * sc, w0, true);
        w1 = __builtin_amdgcn_cvt_pk_fp8_f32(s[4 * 65] * sc, s[5 * 65] * sc, w1, false); w1 = __builtin_amdgcn_cvt_pk_fp8_f32(s[6 * 65] * sc, s[7 * 65] * sc, w1, true);
        unsigned char* rowp = (n < 32 ? it.d0 : it.d1) + (size_t)(n & 31) * 1024;
        __builtin_nontemporal_store((v2u){(unsigned)w0, (unsigned)w1}, (GAS v2u*)(rowp + 8 * c)); }
    LDS_WAIT(); asm volatile("" ::: "memory");
}
__device__ __forceinline__ int win_pblk(int lb) { return lb < 48 ? lb : (lb == 48 ? 72 : lb - 1); }
__device__ __forceinline__ int w1_pblk(int lb) { return lb < 32 ? (lb >> 2) * 8 + (lb & 3) : ((lb - 32) >> 2) * 8 + 4 + ((lb - 32) & 3); }
__device__ __forceinline__ void rms_row_load(const float* xrow, f32x4 (&v)[4], int lane) {
    const GAS f32x4* xr = (const GAS f32x4*)xrow + lane;
#pragma unroll
    for (int j = 0; j < 4; ++j) v[j] = __builtin_nontemporal_load(xr + 64 * j);
}
__device__ __forceinline__ void rms_row_finish(const f32x4 (&v)[4], bf16* orow, float* rinv_out, int lane) {
    float s = 0.f;
    GAS unsigned long long* o8 = (GAS unsigned long long*)orow + lane;
#pragma unroll
    for (int j = 0; j < 4; ++j) { s += (v[j].x * v[j].x + v[j].y * v[j].y) + (v[j].z * v[j].z + v[j].w * v[j].w);
        o8[64 * j] = (unsigned long long)pk2(v[j].x, v[j].y) | ((unsigned long long)pk2(v[j].z, v[j].w) << 32); }
    const float rinv = 1.f / sqrtf(wave_sum(s) * (1.f / 1024.f) + EPS);
    if (lane == 0) *rinv_out = rinv;
}
__device__ __forceinline__ F8Item f8_item(Frame& F, int r) {
    F8Item it;
    if (r < NEXP * 512) { const int e = r / 512, q = r % 512, kb = q / 32, nb = q % 32; it.src = F.w1 + (size_t)e * 1024 * 2048 + (size_t)(64 * kb) * 2048 + 64 * nb; it.ldw = 2048;
        unsigned char* dst = F.ws + WS_W1 + (size_t)e * 2048 * 1024 + 64 * kb; it.d0 = dst + (size_t)(32 * w1_pblk(2 * nb)) * 1024; it.d1 = dst + (size_t)(32 * w1_pblk(2 * nb + 1)) * 1024; }
    else { const int r2 = r - NEXP * 512, e = r2 / 256, q = r2 % 256, kb = q / 16, nb = q % 16; it.src = F.w2 + (size_t)e * 1024 * 1024 + (size_t)(64 * kb) * 1024 + 64 * nb; it.ldw = 1024;
        unsigned char* dst = F.ws + WS_W2 + (size_t)e * 1024 * 1024 + 64 * kb; it.d0 = dst + (size_t)(64 * nb) * 1024; it.d1 = dst + (size_t)(64 * nb + 32) * 1024; }
    return it;
}
constexpr int N_F8_ITEMS = NEXP * 512 + NEXP * 256, N_CONV_BATCH = N_F8_ITEMS / 64;
__device__ __forceinline__ void f8_items(Frame& F, int r, int step, int rend, LAS float* scr) {
    if (r >= rend) return;
    F8Item cur = f8_item(F, r); f32x4 va[16], vb[16];
    f8_load(cur, va, F.lane);
    for (;;) {
        int rn = r + step; F8Item nx = cur; if (rn < rend) { nx = f8_item(F, rn); f8_load(nx, vb, F.lane); }
        f8_finish(cur, va, scr, F.lane, WSCALE);
        if (rn >= rend) break;
        r = rn + step; cur = nx; if (r < rend) { cur = f8_item(F, r); f8_load(cur, va, F.lane); }
        f8_finish(nx, vb, scr, F.lane, WSCALE);
        if (r >= rend) break;
    }
}
__device__ __forceinline__ bool conv_pull(Frame& F) {
    __syncthreads();
    if (F.tid == 0) F.MISC[17] = __hip_atomic_fetch_add(F.ctl + CW_CONV, 1u, RLX_AGENT);
    __syncthreads();
    const int cb = __builtin_amdgcn_readfirstlane((int)F.MISC[17]);
    if (cb >= N_CONV_BATCH) return false;
    f8_items(F, cb * 64 + F.wave * 8, 1, cb * 64 + F.wave * 8 + 8, (LAS float*)(F.lds + F.wave * 16640));
    return true;
}
__device__ __forceinline__ void p0_prologue(Frame& F) {
    LAS float* scr = (LAS float*)(F.lds + F.wave * 16640);
    const int gw = F.vcu * NWAVES + F.wave, NGW = F.G * NWAVES;
    bf16* WIN = (bf16*)(F.ws + WS_WIN); bf16* WOUT = (bf16*)(F.ws + WS_WOUT);
    constexpr int I_IN = 16 * 37, I_OUT = 16 * 16, NITEMS = I_IN + I_OUT;
    for (int it = gw; it < NITEMS; it += NGW) {
        int r = it;
        if (r < I_IN) { const int kb = r / 37, nb = r % 37; const int lb0 = 2 * nb, nc = (nb == 36) ? 32 : 64;
            p0_tr64(F.w_in + (size_t)(64 * kb) * D_IN + 64 * nb, D_IN, WIN + (size_t)(32 * win_pblk(lb0)) * 1024 + 64 * kb, WIN + (size_t)(32 * win_pblk(lb0 + 1 < 73 ? lb0 + 1 : lb0)) * 1024 + 64 * kb, 1024, scr, F.lane, nc, F.mix_g + 64 * kb); continue; }
        r -= I_IN;
        { const int kb = r / 16, nb = r % 16;
            p0_tr64(F.w_out + (size_t)(64 * kb) * 1024 + 64 * nb, 1024, WOUT + (size_t)(64 * nb) * 1024 + 64 * kb, WOUT + (size_t)(64 * nb + 32) * 1024 + 64 * kb, 1024, scr, F.lane, 64, nullptr); }
    }
    { const int gt = F.vcu * (NWAVES * 64) + F.tid, NGT = F.G * NWAVES * 64; GAS v4u* z = (GAS v4u*)(WIN + (size_t)D_IN * 1024);
      for (int i = gt; i < (D_IN_PAD - D_IN) * 1024 * 2 / 16; i += NGT) z[i] = (v4u){0u, 0u, 0u, 0u};
      bf16* WRH = (bf16*)(F.ws + WS_WRH); bf16* WRL = (bf16*)(F.ws + WS_WRL);
      for (int i = gt; i < NEXP * 1024; i += NGT) { const int e = i >> 10, k = i & 1023; const float w = F.w_router[(size_t)k * NEXP + e]; const unsigned h = f2bf(w); WRH[i] = (bf16)h; WRL[i] = (bf16)f2bf(w - bf2f(h)); } }
    bf16* XN = (bf16*)(F.ws + WS_XN);
    { f32x4 va[4], vb[4]; float* RINV = (float*)(F.ws + WS_RINV);
      int m = gw;
      if (m < T) { rms_row_load(F.x + (size_t)m * DM, va, F.lane);
        for (;;) {
            const int m1 = m + NGW; if (m1 < T) rms_row_load(F.x + (size_t)m1 * DM, vb, F.lane);
            rms_row_finish(va, XN + (size_t)m * DM, RINV + m, F.lane);
            if (m1 >= T) break;
            m = m1 + NGW; if (m < T) rms_row_load(F.x + (size_t)m * DM, va, F.lane);
            rms_row_finish(vb, XN + (size_t)m1 * DM, RINV + m1, F.lane);
            if (m >= T) break;
        } } }
}

__device__ __forceinline__ void p2_normrope(Frame& F) {
    LAS float* cs = (LAS float*)F.lds;
    for (int i = F.tid; i < 1024; i += NWAVES * 64) { const int pos = i >> 4, fi = i & 15; const float inv = exp2f(-(float)fi * (13.287712379549449f / 16.f)); const float a = (float)pos * inv;
        cs[2 * i] = __cosf(a); cs[2 * i + 1] = __sinf(a); }
    __syncthreads();
    const int gw = F.vcu * NWAVES + F.wave, NGW = F.G * NWAVES, lane = F.lane;
    const int j = lane & 7, blk = (j >> 2) & 1, jj = j & 3, fi0 = 8 * (jj & 1); const bool second = (jj >> 1) != 0;
    float gq[8], gk[8];
#pragma unroll
    for (int e = 0; e < 8; ++e) { gq[e] = F.q_g[8 * j + e]; gk[e] = F.k_g[8 * j + e]; }
    bf16* AQ = (bf16*)(F.ws + WS_AQ); bf16* AK = (bf16*)(F.ws + WS_AK);
    v4u wnext = (v4u){0u, 0u, 0u, 0u};
    if (T + gw < T + T / 4) wnext = *((GAS v4u*)(AK + (size_t)(4 * gw + (lane >> 4)) * 128) + (lane & 15));
    for (int it = T + gw; it < T + T / 4; it += NGW) {
        const bool isq = false;
        const int tok = 4 * (it - T) + (lane >> 4);
        GAS v4u* p = (GAS v4u*)(AK + (size_t)tok * 128) + (lane & 15);
        const v4u w = wnext;
        if (it + NGW < T + T / 4) wnext = *((GAS v4u*)(AK + (size_t)(4 * (it + NGW - T) + (lane >> 4)) * 128) + (lane & 15));
        float x[8] = {bflo(w.x), bfhi(w.x), bflo(w.y), bfhi(w.y), bflo(w.z), bfhi(w.z), bflo(w.w), bfhi(w.w)};
        float ss = 0.f;
#pragma unroll
        for (int e = 0; e < 8; ++e) ss += x[e] * x[e];
        ss += __shfl_xor(ss, 1); ss += __shfl_xor(ss, 2); ss += __shfl_xor(ss, 4);
        const float rinv = 1.f / sqrtf(ss * (1.f / 64.f) + EPS);
        const int ts = tok & (SEQ - 1), pos = blk ? (ts & 63) : (ts >> 6);
        const LAS float* c = cs + (pos * 16 + fi0) * 2;
        float y[8];
#pragma unroll
        for (int e = 0; e < 8; ++e) { x[e] = x[e] * rinv * (isq ? gq[e] : gk[e]); }
#pragma unroll
        for (int e = 0; e < 8; ++e) { const float pr = __shfl_xor(x[e], 2); const float co = c[2 * e], si = c[2 * e + 1]; y[e] = second ? (x[e] * co + pr * si) : (x[e] * co - pr * si); }
        const float sc = isq ? attn_body::C2 : 1.f;
        v4u o; o.x = pk2(y[0] * sc, y[1] * sc); o.y = pk2(y[2] * sc, y[3] * sc); o.z = pk2(y[4] * sc, y[5] * sc); o.w = pk2(y[6] * sc, y[7] * sc);
        *p = o;
    }
}
namespace gla {
typedef short bf16x8 __attribute__((ext_vector_type(8)));
typedef short s16x4 __attribute__((ext_vector_type(4)));
typedef float f32x4 __attribute__((ext_vector_type(4)));
constexpr int P64 = 144, PV = 272, POT = 528;
constexpr int L_QS = 0, L_KS = 9216, L_VR = 18432, L_AS = 35840, L_ST = 45056, L_OT = 63488, L_SET2 = 97280, L_END = 133120;
constexpr int L_DEC = LC_GDEC;
__device__ __forceinline__ unsigned cvtpk(float lo, float hi) { typedef float f2_t __attribute__((ext_vector_type(2))); typedef __bf16 b2_t __attribute__((ext_vector_type(2))); f2_t v = {lo, hi}; b2_t b = __builtin_convertvector(v, b2_t); return __builtin_bit_cast(unsigned, b); }
__device__ __forceinline__ float logsig(float x) { return fminf(x, 0.f) - __logf(1.f + __expf(-fabsf(x))); }
__device__ __forceinline__ s16x4 vtr(const LAS unsigned char* p) { typedef short v4i16_t __attribute__((ext_vector_type(4))); return __builtin_bit_cast(s16x4, __builtin_amdgcn_ds_read_tr16_b64_v4i16((LAS v4i16_t*)p)); }

__device__ __forceinline__ void gla_prep_unit(Frame& F, int b, int c) {
    LAS unsigned char* L = F.lds;
    const int tid = F.tid, dir = __builtin_amdgcn_readfirstlane(tid >> 8), col = tid & 255;
    const bf16* GQ = (const bf16*)(F.ws + WS_GQ); const bf16* GK = (const bf16*)(F.ws + WS_GK); const bf16* ZZ = (const bf16*)(F.ws + WS_Z);
    bf16* QX = (bf16*)(F.ws + (dir ? WS_QB : WS_QF)); bf16* KX = (bf16*)(F.ws + (dir ? WS_KB : WS_KF)); float* DEC = (float*)(F.ws + WS_DEC) + (size_t)dir * (BATCH * 64 * 256);
    const unsigned row0 = (unsigned)b * SEQ + (unsigned)c * 64u;
    __syncthreads();
    { typedef float f32x16 __attribute__((ext_vector_type(16)));
      const int w_ = F.wave, lane = F.lane, r32 = lane & 31, hi = lane >> 5, colw = 32 * w_ + r32;
#pragma unroll
      for (int d = 0; d < 2; ++d) { const float* WGd = d ? F.w_gb : F.w_gf; const float bgd = (d ? F.b_gb : F.b_gf)[colw];
          float wv[8];
#pragma unroll
          for (int j = 0; j < 8; ++j) wv[j] = WGd[(8 * hi + j) * 256 + colw];
          v4u wh, wl;
          wh.x = pk2(wv[0], wv[1]); wh.y = pk2(wv[2], wv[3]); wh.z = pk2(wv[4], wv[5]); wh.w = pk2(wv[6], wv[7]);
          wl.x = pk2(wv[0] - bflo(wh.x), wv[1] - bfhi(wh.x)); wl.y = pk2(wv[2] - bflo(wh.y), wv[3] - bfhi(wh.y)); wl.z = pk2(wv[4] - bflo(wh.z), wv[5] - bfhi(wh.z)); wl.w = pk2(wv[6] - bflo(wh.w), wv[7] - bfhi(wh.w));
#pragma unroll
          for (int hf = 0; hf < 2; ++hf) { const v4u zf = *(const GAS v4u*)(ZZ + (row0 + 32 * hf + r32) * 32 + d * 16 + 8 * hi);
              f32x16 acc = {};
              acc = __builtin_amdgcn_mfma_f32_32x32x16_bf16(__builtin_bit_cast(bf16x8, zf), __builtin_bit_cast(bf16x8, wh), acc, 0, 0, 0);
              acc = __builtin_amdgcn_mfma_f32_32x32x16_bf16(__builtin_bit_cast(bf16x8, zf), __builtin_bit_cast(bf16x8, wl), acc, 0, 0, 0);
#pragma unroll
              for (int r = 0; r < 16; ++r) { const int pos = 32 * hf + (r & 3) + 8 * (r >> 2) + 4 * hi; *(LAS float*)(L + (size_t)((d * 64 + pos) * 256 + colw) * 4) = logsig(acc[r] + bgd) * (1.f / 16.f); } } } }
    __syncthreads();
    float pf[64]; float run = 0.f;
#pragma unroll
    for (int p = 0; p < 64; ++p) pf[p] = *(const LAS float*)(L + (size_t)((dir * 64 + p) * 256 + col) * 4);
    asm volatile("s_waitcnt lgkmcnt(0)" ::: "memory");
#pragma unroll
    for (int p = 0; p < 64; ++p) { asm volatile("" : "+v"(pf[p])); run += pf[p]; pf[p] = run; }
    const float tot = run;
    const bf16* gqc = GQ + (size_t)row0 * 256 + col; const bf16* gkc = GK + (size_t)row0 * 256 + col; bf16* qxc = QX + (size_t)row0 * 256 + col; bf16* kxc = KX + (size_t)row0 * 256 + col;
    unsigned short qa[16], ka[16], qb[16], kb[16];
#define GP_LOAD(g, qx, kx) do { _Pragma("unroll") for (int i = 0; i < 16; ++i) { qx[i] = gqc[(16 * (g) + i) * 256]; kx[i] = gkc[(16 * (g) + i) * 256]; } } while (0)
#define GP_PROC(g, qx, kx) do { _Pragma("unroll") for (int i = 0; i < 16; ++i) { const int p = 16 * (g) + i; const float qv = bf2f(qx[i]), kv = bf2f(kx[i]); \
        const float ex = dir ? (p ? pf[p ? p - 1 : 0] : 0.f) : 0.f; \
        const float eq = dir ? __expf(-ex) * 0.125f : __expf(pf[p] - tot) * 0.125f; \
        const float ek = dir ? __expf(ex) : __expf(tot - pf[p]); \
        qxc[p * 256] = (bf16)f2bf(qv * eq); kxc[p * 256] = (bf16)f2bf(kv * ek); } } while (0)
    GP_LOAD(0, qa, ka); GP_LOAD(1, qb, kb);
    GP_PROC(0, qa, ka); GP_LOAD(2, qa, ka);
    GP_PROC(1, qb, kb); GP_LOAD(3, qb, kb);
    GP_PROC(2, qa, ka); GP_PROC(3, qb, kb);
#undef GP_LOAD
#undef GP_PROC
    DEC[((unsigned)b * 64 + c) * 256 + col] = __expf(tot);
}

__device__ __forceinline__ void gla_unit(Frame& F, int b, int h, int dir) {
    LAS unsigned char* L = F.lds;
    const int tid = F.tid, lane = F.lane, w = F.wave, q4 = lane >> 4, l15 = lane & 15;
    const bf16* GV = (const bf16*)(F.ws + WS_GV);
    bf16* OX = (bf16*)(F.ws + WS_OF + (dir ? 32 * MiB : 0));
    const unsigned rowbase = (unsigned)b * SEQ;
    const int v0 = 16 * w;
    const int erow = tid >> 3, eseg = tid & 7;
    const int plq = tid >> 3, sgq = tid & 7, plv = tid >> 4, sgv = tid & 15;
    {
        const bf16* QX = (const bf16*)(F.ws + (dir ? WS_QB : WS_QF)); const bf16* KX = (const bf16*)(F.ws + (dir ? WS_KB : WS_KF));
        const float* DEC = (const float*)(F.ws + WS_DEC) + (size_t)dir * (BATCH * 64 * 256);
        f32x4 S[4];
#pragma unroll
        for (int i = 0; i < 4; ++i) S[i] = (f32x4){0.f, 0.f, 0.f, 0.f};
        v4u rq, rk, rv0, rv1; float rdec = 0.f;
#define GLA_LOAD(ci) do { const int c_ = dir ? 63 - (ci) : (ci); const unsigned cb_ = rowbase + (unsigned)c_ * 64u; \
            rq = __builtin_nontemporal_load((const GAS v4u*)(QX + (cb_ + plq) * 256 + h * 64 + sgq * 8)); rk = __builtin_nontemporal_load((const GAS v4u*)(KX + (cb_ + plq) * 256 + h * 64 + sgq * 8)); \
            rv0 = *(const GAS v4u*)(GV + (cb_ + plv) * 512 + h * 128 + sgv * 8); rv1 = *(const GAS v4u*)(GV + (cb_ + plv + 32) * 512 + h * 128 + sgv * 8); \
            if (tid < 64) rdec = DEC[((unsigned)b * 64 + c_) * 256 + h * 64 + tid]; } while (0)
        GLA_LOAD(0);
        v4u st0 = (v4u){0u, 0u, 0u, 0u}, st1 = st0;
#define GLA_FLUSH(cprev) do { const unsigned cbp_ = rowbase + (unsigned)(cprev) * 64u; GAS v4u* sp_ = (GAS v4u*)(OX + (cbp_ + erow) * 512 + h * 128 + eseg * 16); sp_[0] = st0; sp_[1] = st1; } while (0)
#define GLA_STAGE(so) do { *(LAS v4u*)(L + (so) + L_QS + plq * P64 + sgq * 16) = rq; *(LAS v4u*)(L + (so) + L_KS + plq * P64 + sgq * 16) = rk; \
            *(LAS v4u*)(L + (so) + L_VR + plv * PV + sgv * 16) = rv0; *(LAS v4u*)(L + (so) + L_VR + (plv + 32) * PV + sgv * 16) = rv1; \
            if (tid < 64) ((LAS float*)(L + L_DEC))[((so) ? 64 : 0) + tid] = rdec; } while (0)
        __syncthreads();
        GLA_STAGE(0); GLA_LOAD(1);
        __syncthreads();
        for (int ci = 0; ci < 64; ++ci) {
            const int c = dir ? 63 - ci : ci; const int so = (ci & 1) ? L_SET2 : 0, sn = (ci & 1) ? 0 : L_SET2;
#pragma unroll
            for (int s = 0; s < 2; ++s) { const int tt = 2 * w + s, it = tt >> 2, jt = tt & 3; f32x4 a = (f32x4){0.f, 0.f, 0.f, 0.f};
                if (dir ? (jt >= it) : (jt <= it)) {
#pragma unroll
                    for (int ks = 0; ks < 2; ++ks) { const bf16x8 af = *(const LAS bf16x8*)(L + so + L_QS + (16 * it + l15) * P64 + (32 * ks + 8 * q4) * 2); const bf16x8 bfr = *(const LAS bf16x8*)(L + so + L_KS + (16 * jt + l15) * P64 + (32 * ks + 8 * q4) * 2);
                        a = __builtin_amdgcn_mfma_f32_16x16x32_bf16(af, bfr, a, 0, 0, 0); } }
#pragma unroll
                for (int rg = 0; rg < 4; ++rg) { const int i = 16 * it + 4 * q4 + rg, j = 16 * jt + l15; const bool keep = dir ? (j > i) : (j <= i);
                    *(LAS unsigned short*)(L + L_AS + i * P64 + j * 2) = (unsigned short)cvtpk(keep ? a[rg] : 0.f, 0.f); } }
#pragma unroll
            for (int dt = 0; dt < 4; ++dt) { const f32x4 dv = *(const LAS f32x4*)(L + L_DEC + ((ci & 1) ? 256 : 0) + (16 * dt + 4 * q4) * 4); S[dt] = S[dt] * dv;
                *(LAS v2u*)(L + L_ST + (v0 + l15) * P64 + (16 * dt + 4 * q4) * 2) = (v2u){cvtpk(S[dt].x, S[dt].y), cvtpk(S[dt].z, S[dt].w)}; }
            __syncthreads();
            bf16x8 bv[2], bs[2];
#pragma unroll
            for (int ks = 0; ks < 2; ++ks) { const LAS unsigned char* vp = L + so + L_VR + (32 * ks + 8 * q4 + (l15 >> 2)) * PV + (v0 + 4 * (l15 & 3)) * 2;
                const s16x4 lo = vtr(vp), hi = vtr(vp + 4 * PV); bv[ks] = (bf16x8){lo[0], lo[1], lo[2], lo[3], hi[0], hi[1], hi[2], hi[3]};
                bs[ks] = *(const LAS bf16x8*)(L + L_ST + (v0 + l15) * P64 + (32 * ks + 8 * q4) * 2); }
            f32x4 O[4];
#pragma unroll
            for (int it = 0; it < 4; ++it) { O[it] = (f32x4){0.f, 0.f, 0.f, 0.f};
#pragma unroll
                for (int ks = 0; ks < 2; ++ks) { const bf16x8 aq = *(const LAS bf16x8*)(L + so + L_QS + (16 * it + l15) * P64 + (32 * ks + 8 * q4) * 2);
                    if (dir ? !(ks == 0 && it >= 2) : !(ks == 1 && it < 2)) {
                        const bf16x8 aa = *(const LAS bf16x8*)(L + L_AS + (16 * it + l15) * P64 + (32 * ks + 8 * q4) * 2); O[it] = __builtin_amdgcn_mfma_f32_16x16x32_bf16(aa, bv[ks], O[it], 0, 0, 0); }
                    O[it] = __builtin_amdgcn_mfma_f32_16x16x32_bf16(aq, bs[ks], O[it], 0, 0, 0); } }
#pragma unroll
            for (int dt = 0; dt < 4; ++dt)
#pragma unroll
                for (int ks = 0; ks < 2; ++ks) { const LAS unsigned char* kp = L + so + L_KS + (32 * ks + 8 * q4 + (l15 >> 2)) * P64 + (16 * dt + 4 * (l15 & 3)) * 2;
                    const s16x4 lo = vtr(kp), hi = vtr(kp + 4 * P64); const bf16x8 ak = (bf16x8){lo[0], lo[1], lo[2], lo[3], hi[0], hi[1], hi[2], hi[3]};
                    S[dt] = __builtin_amdgcn_mfma_f32_16x16x32_bf16(ak, bv[ks], S[dt], 0, 0, 0); }
#pragma unroll
            for (int it = 0; it < 4; ++it)
#pragma unroll
                for (int rg = 0; rg < 4; ++rg) *(LAS float*)(L + L_OT + (16 * it + 4 * q4 + rg) * POT + (v0 + l15) * 4) = O[it][rg];
            if (ci + 1 < 64) GLA_STAGE(sn);
            asm volatile("" ::: "memory");
            if (ci > 0) GLA_FLUSH(dir ? c + 1 : c - 1);
            asm volatile("" ::: "memory");
            if (ci + 2 < 64) GLA_LOAD(ci + 2);
            __syncthreads();
            {
                float o[16];
#pragma unroll
                for (int e4 = 0; e4 < 4; ++e4) { const f32x4 t = *(const LAS f32x4*)(L + L_OT + erow * POT + (16 * eseg + 4 * e4) * 4); o[4 * e4] = t.x; o[4 * e4 + 1] = t.y; o[4 * e4 + 2] = t.z; o[4 * e4 + 3] = t.w; }
                st0 = (v4u){cvtpk(o[0], o[1]), cvtpk(o[2], o[3]), cvtpk(o[4], o[5]), cvtpk(o[6], o[7])}; st1 = (v4u){cvtpk(o[8], o[9]), cvtpk(o[10], o[11]), cvtpk(o[12], o[13]), cvtpk(o[14], o[15])};
            }
        }
        GLA_FLUSH(dir ? 0 : 63);
#undef GLA_STAGE
#undef GLA_FLUSH
#undef GLA_LOAD
    }
    VM_WAIT(); __syncthreads();
    if (tid == 0) { __builtin_amdgcn_fence(__ATOMIC_RELEASE, "agent"); VM_WAIT(); (void)__hip_atomic_fetch_add(F.ctl + CW_GDN + 64 * (b * GLA_H + h), 1u, RLX_AGENT); }
    __syncthreads();
}
__device__ __forceinline__ void gla_combine(Frame& F, int b, int h, int part) {
    const int tid = F.tid, erow = tid >> 3, eseg = tid & 7;
    if (tid == 0) { unsigned sp = 0; while (__hip_atomic_load(F.ctl + CW_GDN + 64 * (b * GLA_H + h), RLX_AGENT) < 2u && sp < (1u << 22)) { __builtin_amdgcn_s_sleep(8); ++sp; }
        __builtin_amdgcn_fence(__ATOMIC_ACQUIRE, "agent"); VM_WAIT(); }
    __syncthreads();
    const bf16* OF0 = (const bf16*)(F.ws + WS_OF); const bf16* OB0 = (const bf16*)(F.ws + WS_OF + 32 * MiB); const bf16* GR = (const bf16*)(F.ws + WS_GR); bf16* MIX = (bf16*)(F.ws + WS_MIX);
    float hg[16]; int eso = eseg; asm volatile("" : "+v"(eso));
#pragma unroll
    for (int e = 0; e < 16; ++e) hg[e] = F.gla_hg[16 * eso + e];
    const unsigned r0 = (unsigned)b * SEQ + (unsigned)part * 1024u + erow;
    v4u nf0, nf1, nb0, nb1, nr0, nr1;
#define GC_LOAD(ps_) do { const unsigned row_ = r0 + (ps_) * 64; const GAS v4u* fp = (const GAS v4u*)(OF0 + row_ * 512 + h * 128 + eseg * 16); const GAS v4u* bp = (const GAS v4u*)(OB0 + row_ * 512 + h * 128 + eseg * 16); const GAS v4u* rp = (const GAS v4u*)(GR + row_ * 512 + h * 128 + eseg * 16); \
        nf0 = __builtin_nontemporal_load(fp); nf1 = __builtin_nontemporal_load(fp + 1); nb0 = __builtin_nontemporal_load(bp); nb1 = __builtin_nontemporal_load(bp + 1); nr0 = __builtin_nontemporal_load(rp); nr1 = __builtin_nontemporal_load(rp + 1); } while (0)
    GC_LOAD(0);
#pragma unroll 2
    for (int ps = 0; ps < 16; ++ps) { const unsigned row = r0 + ps * 64;
        const v4u f0 = nf0, f1 = nf1, b0 = nb0, b1 = nb1, r0v = nr0, r1v = nr1;
        if (ps + 1 < 16) GC_LOAD(ps + 1);
        const unsigned fw[8] = {f0.x, f0.y, f0.z, f0.w, f1.x, f1.y, f1.z, f1.w}, bw[8] = {b0.x, b0.y, b0.z, b0.w, b1.x, b1.y, b1.z, b1.w}, rw[8] = {r0v.x, r0v.y, r0v.z, r0v.w, r1v.x, r1v.y, r1v.z, r1v.w};
        float o[16]; float ss = 0.f;
#pragma unroll
        for (int e2 = 0; e2 < 8; ++e2) { o[2 * e2] = bflo(fw[e2]) + bflo(bw[e2]); o[2 * e2 + 1] = bfhi(fw[e2]) + bfhi(bw[e2]); ss += o[2 * e2] * o[2 * e2] + o[2 * e2 + 1] * o[2 * e2 + 1]; }
        ss += __shfl_xor(ss, 1); ss += __shfl_xor(ss, 2); ss += __shfl_xor(ss, 4);
        const float rinv = __builtin_amdgcn_rsqf(ss * (1.f / 128.f) + EPS);
        unsigned ow[8];
#pragma unroll
        for (int e2 = 0; e2 < 8; ++e2) { const float x0 = bflo(rw[e2]), x1 = bfhi(rw[e2]);
            const float y0 = o[2 * e2] * rinv * hg[2 * e2] * (x0 * __builtin_amdgcn_rcpf(1.f + __expf(-x0))), y1 = o[2 * e2 + 1] * rinv * hg[2 * e2 + 1] * (x1 * __builtin_amdgcn_rcpf(1.f + __expf(-x1))); ow[e2] = cvtpk(y0, y1); }
        GAS v4u* mp = (GAS v4u*)(MIX + row * 1024 + h * 128 + eseg * 16);
        mp[0] = (v4u){ow[0], ow[1], ow[2], ow[3]}; mp[1] = (v4u){ow[4], ow[5], ow[6], ow[7]}; }
#undef GC_LOAD
}
}
struct DenseMap { static constexpr bool GATHER = false;
    const bf16* A; const bf16* Bt; int K;
    __device__ __forceinline__ __amdgpu_buffer_rsrc_t a_rsrc() const { return __builtin_amdgcn_make_buffer_rsrc((void*)A, 0, 0x7fffffff, 0x00020000); }
    __device__ __forceinline__ __amdgpu_buffer_rsrc_t b_rsrc() const { return __builtin_amdgcn_make_buffer_rsrc((void*)Bt, 0, 0x7fffffff, 0x00020000); }
    __device__ __forceinline__ unsigned a_soff(const pg8::Unit& u) const { return (unsigned)u.pm * 256u * (unsigned)K * 2u; }
    __device__ __forceinline__ unsigned b_soff(const pg8::Unit& u) const { return (unsigned)u.pn * 256u * (unsigned)K * 2u; }
    __device__ __forceinline__ void a_off(const pg8::Unit&, const int (&R)[2], const int (&C)[2], unsigned (&vo)[2][2]) const {
#pragma unroll
        for (int h = 0; h < 2; ++h)
#pragma unroll
            for (int i = 0; i < 2; ++i) vo[h][i] = (unsigned)((h * 128 + R[i]) * K + C[i]) * 2u; }
};
struct MoeTabs { const LAS int* cnt; const LAS int* cst; const LAS unsigned short* te; };
struct MoeMapUp { static constexpr bool GATHER = true;
    const unsigned char* A; const unsigned char* Bt; const int* rowtok; MoeTabs tb;
    __device__ __forceinline__ __amdgpu_buffer_rsrc_t a_rsrc() const { return __builtin_amdgcn_make_buffer_rsrc((void*)A, 0, 0x7fffffff, 0x00020000); }
    __device__ __forceinline__ __amdgpu_buffer_rsrc_t b_rsrc() const { return __builtin_amdgcn_make_buffer_rsrc((void*)Bt, 0, 0x7fffffff, 0x00020000); }
    __device__ __forceinline__ unsigned a_soff(const pg8::Unit&) const { return 0u; }
    __device__ __forceinline__ unsigned b_soff(const pg8::Unit& u) const { const unsigned e = tb.te[u.pm]; return (e * 2048u + (unsigned)u.pn * 256u) * 1024u; }
    __device__ __forceinline__ void a_raw(const pg8::Unit& u, const int (&R)[2], unsigned (&raw)[2][2]) const {
        const int e = tb.te[u.pm], pos0 = (u.pm - tb.cst[e]) * 256, n = tb.cnt[e];
#pragma unroll
        for (int h = 0; h < 2; ++h)
#pragma unroll
            for (int i = 0; i < 2; ++i) { const int pos = pos0 + h * 128 + R[i]; raw[h][i] = (unsigned)rowtok[(size_t)e * EROWS + (pos < n ? pos : 0)]; } }
    __device__ __forceinline__ unsigned a_fin(unsigned tok, int C) const { return (tok * 512u + (unsigned)C) * 2u; }
    __device__ __forceinline__ void a_off(const pg8::Unit& u, const int (&R)[2], const int (&C)[2], unsigned (&vo)[2][2]) const {
        unsigned raw[2][2]; a_raw(u, R, raw);
#pragma unroll
        for (int h = 0; h < 2; ++h)
#pragma unroll
            for (int i = 0; i < 2; ++i) vo[h][i] = a_fin(raw[h][i], C[i]); }
};
struct MoeMapDown { static constexpr bool GATHER = false;
    const unsigned char* A; const unsigned char* Bt; MoeTabs tb;
    __device__ __forceinline__ __amdgpu_buffer_rsrc_t a_rsrc() const { return __builtin_amdgcn_make_buffer_rsrc((void*)A, 0, 0x7fffffff, 0x00020000); }
    __device__ __forceinline__ __amdgpu_buffer_rsrc_t b_rsrc() const { return __builtin_amdgcn_make_buffer_rsrc((void*)Bt, 0, 0x7fffffff, 0x00020000); }
    __device__ __forceinline__ unsigned a_soff(const pg8::Unit& u) const { return (unsigned)u.pm * 256u * 1024u; }
    __device__ __forceinline__ unsigned b_soff(const pg8::Unit& u) const { const unsigned e = tb.te[u.pm]; return (e * 1024u + (unsigned)u.pn * 256u) * 1024u; }
    __device__ __forceinline__ void a_off(const pg8::Unit&, const int (&R)[2], const int (&C)[2], unsigned (&vo)[2][2]) const {
#pragma unroll
        for (int h = 0; h < 2; ++h)
#pragma unroll
            for (int i = 0; i < 2; ++i) vo[h][i] = (unsigned)((h * 128 + R[i]) * 512 + C[i]) * 2u; }
};
using pg8::f32x4;
struct EpiInProj { static constexpr bool PERM = true, COLS64 = false;
    bf16 *gq, *gk, *gv, *gr, *aq, *ak, *av, *z; const float* rinv;
    struct Pre { float rv[8]; };
    __device__ __forceinline__ void preload(const pg8::Unit& u, int wr, int wc, int fr, int fq, Pre& p) const {
#pragma unroll
        for (int i = 0; i < 8; ++i) p.rv[i] = rinv[u.pm * 256 + wr * 64 + fr + (i >> 2) * 128 + (i & 3) * 16]; }
    __device__ __forceinline__ void operator()(const f32x4 (&acc)[2][2][4][2], const pg8::Unit& u, const Pre& p, int wr, int wc, int fr, int fq) const {
        bf16* b0; bf16* b1; int ld;
        switch (u.pn) { case 0: b0 = gq; b1 = gq + 128; ld = 256; break; case 1: b0 = gk; b1 = gk + 128; ld = 256; break;
            case 2: b0 = gv; b1 = gv + 128; ld = 512; break; case 3: b0 = gv + 256; b1 = gv + 384; ld = 512; break;
            case 4: b0 = gr; b1 = gr + 128; ld = 512; break; case 5: b0 = gr + 256; b1 = gr + 384; ld = 512; break;
            case 6: b0 = aq; b1 = aq + 128; ld = 512; break; case 7: b0 = aq + 256; b1 = aq + 384; ld = 512; break;
            case 8: b0 = ak; b1 = av; ld = 128; break; default: b0 = z; b1 = z; ld = 32; break; }
        const bool zt = (u.pn == 9);
        if (zt && wc != 0) return;
        const int row0 = u.pm * 256 + wr * 64 + fr, cw = wc * 32 + 8 * fq;
#pragma unroll
        for (int ai = 0; ai < 2; ++ai)
#pragma unroll
            for (int m = 0; m < 4; ++m) { const size_t row = (size_t)(row0 + ai * 128 + m * 16);
#pragma unroll
                for (int bj = 0; bj < 2; ++bj) { if (zt && bj == 1) continue; const float rs = p.rv[ai * 4 + m]; const f32x4 v0 = acc[ai][bj][m][0] * rs, v1 = acc[ai][bj][m][1] * rs;
                    pg8::u32x4 wv; wv.x = pg8::cvt_pk_bf16(v0[0], v0[1]); wv.y = pg8::cvt_pk_bf16(v0[2], v0[3]); wv.z = pg8::cvt_pk_bf16(v1[0], v1[1]); wv.w = pg8::cvt_pk_bf16(v1[2], v1[3]);
                    *(pg8::u32x4*)((bj ? b1 : b0) + row * ld + cw) = wv; } }
    }
};
struct EpiResF32 { static constexpr bool PERM = true, COLS64 = false;
    const bf16* base; bf16* out;
    struct Pre {}; __device__ __forceinline__ void preload(const pg8::Unit&, int, int, int, int, Pre&) const {}
    __device__ __forceinline__ void operator()(const f32x4 (&acc)[2][2][4][2], const pg8::Unit& u, const Pre&, int wr, int wc, int fr, int fq) const {
        const int col0 = u.pn * 256 + wc * 32 + 8 * fq;
        const size_t off0 = (size_t)(u.pm * 256 + wr * 64 + fr) * 1024 + col0;
        v4u cx[4], nx[4];
#define ER_OFF(it_, q_) (off0 + (size_t)((((it_) * 2 + ((q_) >> 1)) >> 2) * 128 + (((it_) * 2 + ((q_) >> 1)) & 3) * 16) * 1024 + ((q_) & 1) * 128)
#pragma unroll
        for (int q = 0; q < 4; ++q) cx[q] = __builtin_nontemporal_load((const v4u*)(base + ER_OFF(0, q)));
#pragma unroll
        for (int it = 0; it < 4; ++it) {
            if (it + 1 < 4) {
#pragma unroll
                for (int q = 0; q < 4; ++q) nx[q] = __builtin_nontemporal_load((const v4u*)(base + ER_OFF(it + 1, q))); }
#pragma unroll
            for (int q = 0; q < 4; ++q) { const int g = it * 2 + (q >> 1), ai = g >> 2, m = g & 3, bj = q & 1; const f32x4 a0 = acc[ai][bj][m][0], a1 = acc[ai][bj][m][1]; const v4u xw = cx[q];
                *(v4u*)(out + ER_OFF(it, q)) = (v4u){pk2(bflo(xw.x) + a0.x, bfhi(xw.x) + a0.y), pk2(bflo(xw.y) + a0.z, bfhi(xw.y) + a0.w), pk2(bflo(xw.z) + a1.x, bfhi(xw.z) + a1.y), pk2(bflo(xw.w) + a1.z, bfhi(xw.w) + a1.w)}; }
#pragma unroll
            for (int q = 0; q < 4; ++q) cx[q] = nx[q]; }
#undef ER_OFF
    }
};
struct EpiSwiglu { static constexpr bool PERM = true, COLS64 = false;
    const float* b1; unsigned char* act; MoeTabs tb;
    struct Pre { f32x4 g0, g1, l0, l1; };
    __device__ __forceinline__ void preload(const pg8::Unit& u, int wr, int wc, int fr, int fq, Pre& p) const {
        const int e = tb.te[u.pm]; const int col = u.pn * 128 + wc * 32 + 8 * fq; const float* bg = b1 + (size_t)e * 2048 + col; const float* bl = bg + 1024;
        p.g0 = *(const GAS f32x4*)bg; p.g1 = *(const GAS f32x4*)(bg + 4); p.l0 = *(const GAS f32x4*)bl; p.l1 = *(const GAS f32x4*)(bl + 4); }
    __device__ __forceinline__ void operator()(const f32x4 (&acc)[2][2][4][2], const pg8::Unit& u, const Pre& p, int wr, int wc, int fr, int fq) const {
        const int col = u.pn * 128 + wc * 32 + 8 * fq;
        const f32x4 g0 = p.g0, g1 = p.g1, l0 = p.l0, l1 = p.l1;
        const int row0 = u.pm * 256 + wr * 64 + fr;
        const bool odd = (fq & 1) != 0;
        unsigned char* dstb = act + (size_t)(row0 + (odd ? 16 : 0)) * 1024 + (odd ? col - 8 : col);
#pragma unroll
        for (int ai = 0; ai < 2; ++ai)
#pragma unroll
            for (int mp = 0; mp < 2; ++mp) { unsigned wd[2][2];
#pragma unroll
                for (int q = 0; q < 2; ++q) { const int m = 2 * mp + q; float o[8];
#pragma unroll
                    for (int n = 0; n < 2; ++n)
#pragma unroll
                        for (int j = 0; j < 4; ++j) { const float gl = fminf(__builtin_fmaf(acc[ai][0][m][n][j], 1.f / WSCALE, (n ? g1[j] : g0[j])), 7.f); const float li = __builtin_amdgcn_fmed3f(__builtin_fmaf(acc[ai][1][m][n][j], 1.f / WSCALE, (n ? l1[j] : l0[j])), -7.f, 7.f);
                            o[4 * n + j] = (gl * ASCALE) * __builtin_amdgcn_rcpf(1.f + __builtin_amdgcn_exp2f(gl * (-1.702f * 1.4426950408889634f))) * (li + 1.f); }
                    int w0 = 0, w1 = 0;
                    w0 = __builtin_amdgcn_cvt_pk_fp8_f32(o[0], o[1], w0, false); w0 = __builtin_amdgcn_cvt_pk_fp8_f32(o[2], o[3], w0, true); w1 = __builtin_amdgcn_cvt_pk_fp8_f32(o[4], o[5], w1, false); w1 = __builtin_amdgcn_cvt_pk_fp8_f32(o[6], o[7], w1, true);
                    wd[q][0] = (unsigned)w0; wd[q][1] = (unsigned)w1; }
                auto x0 = __builtin_amdgcn_permlane16_swap(wd[0][0], wd[1][0], false, false); auto x1 = __builtin_amdgcn_permlane16_swap(wd[0][1], wd[1][1], false, false);
                *(pg8::u32x4*)(dstb + (size_t)(ai * 128 + mp * 32) * 1024) = (pg8::u32x4){x0[0], x1[0], x0[1], x1[1]}; }
    }
};
struct EpiDown { static constexpr bool PERM = true, COLS64 = true;
    const float* b2; const float* rowgate; unsigned char* y; MoeTabs tb;
    struct Pre { f32x4 bv[2][2]; float gt[8]; };
    __device__ __forceinline__ void preload(const pg8::Unit& u, int wr, int wc, int fr, int fq, Pre& p) const {
        const int e = tb.te[u.pm], pos0 = (u.pm - tb.cst[e]) * 256, n_e = tb.cnt[e];
        const float* bb = b2 + (size_t)e * 1024 + u.pn * 256 + wc * 64 + 8 * fq;
#pragma unroll
        for (int bj = 0; bj < 2; ++bj)
#pragma unroll
            for (int n = 0; n < 2; ++n) p.bv[bj][n] = *(const GAS f32x4*)(bb + bj * 32 + 4 * n);
#pragma unroll
        for (int ai = 0; ai < 2; ++ai)
#pragma unroll
            for (int m = 0; m < 4; ++m) { const int pos = pos0 + wr * 64 + fr + ai * 128 + m * 16; const int pc_ = pos < n_e ? pos : 0; const float g = rowgate[(size_t)e * EROWS + pc_]; p.gt[ai * 4 + m] = (pos < n_e) ? g * YSCALE : 0.f; }
    }
    __device__ __forceinline__ void operator()(const f32x4 (&acc)[2][2][4][2], const pg8::Unit& u, const Pre& p, int wr, int wc, int fr, int fq) const {
        const bool odd = (fq & 1) != 0;
        const int colb = u.pn * 256 + wc * 64 + (odd ? 32 + 8 * (fq - 1) : 8 * fq), rl0 = wr * 64 + fr;
#pragma unroll
        for (int ai = 0; ai < 2; ++ai)
#pragma unroll
            for (int m = 0; m < 4; ++m) { const int rl = rl0 + ai * 128 + m * 16; const float gt = p.gt[ai * 4 + m];
                unsigned w[2][2];
#pragma unroll
                for (int bj = 0; bj < 2; ++bj) { const f32x4 v0 = (acc[ai][bj][m][0] * (1.f / (WSCALE * ASCALE)) + p.bv[bj][0]) * gt, v1 = (acc[ai][bj][m][1] * (1.f / (WSCALE * ASCALE)) + p.bv[bj][1]) * gt;
                    int w0 = 0, w1 = 0;
                    w0 = __builtin_amdgcn_cvt_pk_fp8_f32(v0[0], v0[1], w0, false); w0 = __builtin_amdgcn_cvt_pk_fp8_f32(v0[2], v0[3], w0, true); w1 = __builtin_amdgcn_cvt_pk_fp8_f32(v1[0], v1[1], w1, false); w1 = __builtin_amdgcn_cvt_pk_fp8_f32(v1[2], v1[3], w1, true);
                    w[bj][0] = (unsigned)w0; w[bj][1] = (unsigned)w1; }
                auto x0 = __builtin_amdgcn_permlane16_swap(w[0][0], w[1][0], false, false); auto x1 = __builtin_amdgcn_permlane16_swap(w[0][1], w[1][1], false, false);
                const pg8::u32x4 ov = (pg8::u32x4){x0[0], x1[0], x0[1], x1[1]};
                *(pg8::u32x4*)(y + (size_t)(u.pm * 256 + rl) * 1024 + colb) = ov; }
    }
};
__device__ __forceinline__ int moe_tables(Frame& F) {
    LAS int* cnt = (LAS int*)(F.lds + LC_CNT); LAS int* cst = (LAS int*)(F.lds + LC_CST); LAS unsigned short* te = (LAS unsigned short*)(F.lds + LC_TE);
    __syncthreads();
    if (F.tid < NEXP) cnt[F.tid] = (int)__hip_atomic_load(F.ctl + CW_CNT + 64 * F.tid, RLX_AGENT);
    __syncthreads();
    if (F.tid == 0) { int s = 0; for (int e = 0; e < NEXP; ++e) { cst[e] = s; s += (cnt[e] + 255) >> 8; } cst[NEXP] = s; }
    __syncthreads();
    const int nt = cst[NEXP];
    for (int t = F.tid; t < nt; t += NWAVES * 64) { int e = 0;
#pragma unroll 1
        for (int k = 1; k < NEXP; ++k) e = (t >= cst[k]) ? k : e;
        te[t] = (unsigned short)e; }
    __syncthreads();
    return nt;
}
__device__ __forceinline__ void p3_mixers(Frame& F) {
    for (int u = blockIdx.x; u < 2 * BATCH * GLA_H; u += F.G) gla::gla_unit(F, u & 7, (u >> 3) & 3, u >> 5);
    if (blockIdx.x < 2 * BATCH * GLA_H) { while (conv_pull(F)) {} }
    const attn_body::bf16* Q = (const attn_body::bf16*)(F.ws + WS_AQ); const attn_body::bf16* K = (const attn_body::bf16*)(F.ws + WS_AK); const attn_body::bf16* V = (const attn_body::bf16*)(F.ws + WS_AV);
    attn_body::bf16* O = (attn_body::bf16*)(F.ws + WS_MIX);
    const int x0 = blockIdx.x & 7;
    float sbound;
    { float mq = fabsf(F.q_g[F.lane]), mk = fabsf(F.k_g[F.lane]);
#pragma unroll
      for (int o_ = 1; o_ < 64; o_ <<= 1) { mq = fmaxf(mq, __shfl_xor(mq, o_)); mk = fmaxf(mk, __shfl_xor(mk, o_)); }
      sbound = __builtin_bit_cast(float, __builtin_amdgcn_readfirstlane(__builtin_bit_cast(int, 64.f * attn_body::C2 * mq * mk * 1.02f))); }
    for (int qi = 0; qi < 8; ++qi) { const int x = (x0 + qi) & 7;
        for (;;) {
            __syncthreads();
            if (F.tid == 0) F.MISC[16] = __hip_atomic_fetch_add(F.ctl + CW_QUE + 64 * x, 1u, RLX_AGENT);
            __syncthreads();
            const int item = __builtin_amdgcn_readfirstlane((int)F.MISC[16]);
            if (item >= ATT_H * attn_body::NQB + 4 * GLA_H) break;
            if (item >= ATT_H * attn_body::NQB) { const int k = item - ATT_H * attn_body::NQB; gla::gla_combine(F, x, k >> 2, k & 3); continue; }
            attn_body::attn_unit<8>(x, item >> 4, item & 15, Q, K, V, O, (char*)F.lds, F.q_g, sbound);
        }
    }
    while (conv_pull(F)) {}
    __syncthreads();
}

__device__ __forceinline__ void p5_route(Frame& F) {
    typedef float f32x16 __attribute__((ext_vector_type(16)));
    LAS unsigned char* L = F.lds;
    constexpr int XP = 2064, L_XH = 0, L_XL = 32 * XP, L_PART = 0;
    const int tid = F.tid, lane = F.lane, w = F.wave, r32 = lane & 31, hi = lane >> 5;
    const bf16* WRH = (const bf16*)(F.ws + WS_WRH); const bf16* WRL = (const bf16*)(F.ws + WS_WRL);
    unsigned char* XN8 = F.ws + WS_XN;
    int* ROWTOK = (int*)(F.ws + WS_ROWTOK); float* ROWGATE = (float*)(F.ws + WS_ROWGATE); int* TOKASG = (int*)(F.ws + WS_TOKASG);
    gu32* CNT = F.ctl + CW_CNT;
    bf16x8 wh[8], wl[8];
#pragma unroll
    for (int ks = 0; ks < 8; ++ks) { const int k0 = 128 * w + 16 * ks + 8 * hi; wh[ks] = *(const GAS bf16x8*)(WRH + r32 * 1024 + k0); wl[ks] = *(const GAS bf16x8*)(WRL + r32 * 1024 + k0); }
    f32x4 g2[4];
#pragma unroll
    for (int j = 0; j < 4; ++j) g2[j] = *((const GAS f32x4*)F.ffn_g + lane + 64 * j);
    float brt[16];
#pragma unroll
    for (int r = 0; r < 16; ++r) brt[r] = F.b_router[(r & 3) + 8 * (r >> 2) + 4 * hi];
    LAS int* hist = (LAS int*)(L + LC_HIST); LAS int* basev = (LAS int*)(L + LC_BASE); LAS int* aep = (LAS int*)(L + LC_ASG); LAS float* agt = (LAS float*)(L + LC_ASG + 4096);
    constexpr int NGRP = T / 32;
    const int per = (NGRP + F.G - 1) / F.G, g0 = F.vcu * per, g1 = (g0 + per < NGRP) ? g0 + per : NGRP;
    for (int gb = g0; gb < g1; gb += 8) {
        const int nb = (g1 - gb < 8) ? g1 - gb : 8;
        __syncthreads();
        if (tid < NEXP) hist[tid] = 0;
        v2u hv[4][4];
#define P5_LOADG(g) do { _Pragma("unroll") for (int rr = 0; rr < 4; ++rr) { const GAS v2u* hp = (const GAS v2u*)((const bf16*)(F.ws + WS_H16) + (size_t)(32 * (g) + 4 * w + rr) * 1024) + lane; \
            _Pragma("unroll") for (int j = 0; j < 4; ++j) hv[rr][j] = __builtin_nontemporal_load(hp + 64 * j); } } while (0)
#define P5_BAR() asm volatile("s_waitcnt lgkmcnt(0)\n\ts_barrier" ::: "memory")
        P5_LOADG(gb);
        for (int bi = 0; bi < nb; ++bi) {
            const int t0 = 32 * (gb + bi);
#pragma unroll
            for (int rr = 0; rr < 4; ++rr) { const int r = 4 * w + rr; const size_t tok = (size_t)(t0 + r);
                f32x4 v[4]; float s = 0.f;
#pragma unroll
                for (int j = 0; j < 4; ++j) { v[j] = (f32x4){bflo(hv[rr][j].x), bfhi(hv[rr][j].x), bflo(hv[rr][j].y), bfhi(hv[rr][j].y)}; s += (v[j].x * v[j].x + v[j].y * v[j].y) + (v[j].z * v[j].z + v[j].w * v[j].w); }
                const float rinv = 1.f / sqrtf(wave_sum(s) * (1.f / 1024.f) + EPS);
                GAS unsigned* o4 = (GAS unsigned*)(XN8 + tok * 1024) + lane;
#pragma unroll
                for (int j = 0; j < 4; ++j) { const f32x4 xn = v[j] * rinv * g2[j];
                    const v2u hw = (v2u){pk2(xn.x, xn.y), pk2(xn.z, xn.w)};
                    const v2u lw = (v2u){pk2(xn.x - bflo(hw.x), xn.y - bfhi(hw.x)), pk2(xn.z - bflo(hw.y), xn.w - bfhi(hw.y))};
                    { int q8 = 0; q8 = __builtin_amdgcn_cvt_pk_fp8_f32(xn.x, xn.y, q8, false); q8 = __builtin_amdgcn_cvt_pk_fp8_f32(xn.z, xn.w, q8, true); o4[64 * j] = (unsigned)q8; }
                    *(LAS v2u*)(L + L_XH + r * XP + (4 * lane + 256 * j) * 2) = hw; *(LAS v2u*)(L + L_XL + r * XP + (4 * lane + 256 * j) * 2) = lw; } }
            if (bi + 1 < nb) P5_LOADG(gb + bi + 1);
            P5_BAR();
            f32x16 acc = {};
#pragma unroll
            for (int ks = 0; ks < 8; ++ks) { const int k0 = 128 * w + 16 * ks + 8 * hi;
                const bf16x8 xh = *(const LAS bf16x8*)(L + L_XH + r32 * XP + k0 * 2), xl = *(const LAS bf16x8*)(L + L_XL + r32 * XP + k0 * 2);
                acc = __builtin_amdgcn_mfma_f32_32x32x16_bf16(wh[ks], xh, acc, 0, 0, 0); acc = __builtin_amdgcn_mfma_f32_32x32x16_bf16(wh[ks], xl, acc, 0, 0, 0); acc = __builtin_amdgcn_mfma_f32_32x32x16_bf16(wl[ks], xh, acc, 0, 0, 0); }
            P5_BAR();
#pragma unroll
            for (int r = 0; r < 16; ++r) { const int e = (r & 3) + 8 * (r >> 2) + 4 * hi; ((LAS float*)(L + L_PART))[(w * 32 + e) * 32 + r32] = acc[r]; }
            P5_BAR();
            if (w == 0) {
                float v[16];
#pragma unroll
                for (int r = 0; r < 16; ++r) { const int e = (r & 3) + 8 * (r >> 2) + 4 * hi; float s = brt[r];
#pragma unroll
                    for (int ww = 0; ww < 8; ++ww) s += ((const LAS float*)(L + L_PART))[(ww * 32 + e) * 32 + r32];
                    v[r] = s; }
                float cv[8]; int cidx[8];
#pragma unroll
                for (int s = 0; s < 4; ++s) { float m = -INFINITY; int mr = 0;
#pragma unroll
                    for (int r = 0; r < 16; ++r) { if (v[r] > m) { m = v[r]; mr = r; } }
                    cv[s] = m; cidx[s] = (mr & 3) + 8 * (mr >> 2) + 4 * hi;
#pragma unroll
                    for (int r = 0; r < 16; ++r) v[r] = (r == mr) ? -INFINITY : v[r]; }
#pragma unroll
                for (int s = 0; s < 4; ++s) { cv[4 + s] = __shfl_xor(cv[s], 32); cidx[4 + s] = __shfl_xor(cidx[s], 32); }
                float tv[4]; int ti[4];
#pragma unroll
                for (int s = 0; s < 4; ++s) { float m = -INFINITY; int mi = 1 << 20; int mc = 0;
#pragma unroll
                    for (int c = 0; c < 8; ++c) { const bool better = (cv[c] > m) || (cv[c] == m && cidx[c] < mi); if (better) { m = cv[c]; mi = cidx[c]; mc = c; } }
                    tv[s] = m; ti[s] = mi;
#pragma unroll
                    for (int c = 0; c < 8; ++c) cv[c] = (c == mc) ? -INFINITY : cv[c]; }
                const float e1 = __expf(tv[1] - tv[0]), e2 = __expf(tv[2] - tv[0]), e3 = __expf(tv[3] - tv[0]); const float inv = 1.f / (1.f + e1 + e2 + e3);
                const float gt[4] = {inv, e1 * inv, e2 * inv, e3 * inv};
                if (hi == 0) {
#pragma unroll
                    for (int s = 0; s < 4; ++s) { const int rank = (int)__hip_atomic_fetch_add(hist + ti[s], 1, __ATOMIC_RELAXED, __HIP_MEMORY_SCOPE_WORKGROUP); const int idx = (bi * 32 + r32) * 4 + s; aep[idx] = (ti[s] << 16) | rank; agt[idx] = gt[s]; } }
            }
            P5_BAR();
        }
#undef P5_LOADG
#undef P5_BAR
        if (tid < NEXP) { const int hc = hist[tid]; basev[tid] = hc ? (int)__hip_atomic_fetch_add(CNT + 64 * tid, (unsigned)hc, RLX_AGENT) : 0; }
        __syncthreads();
        for (int idx = tid; idx < nb * 128; idx += NWAVES * 64) { const int ep = aep[idx], e = ep >> 16, pos = basev[e] + (ep & 0xffff); const int tok = 32 * gb + (idx >> 2), s = idx & 3;
            ROWTOK[(size_t)e * EROWS + pos] = tok; ROWGATE[(size_t)e * EROWS + pos] = agt[idx]; TOKASG[tok * 4 + s] = e * EROWS + pos; }
    }
    __syncthreads();
}

__device__ __forceinline__ void p8_combine(Frame& F) {
    const LAS int* cst = (const LAS int*)(F.lds + LC_CST);
    const int gw = F.vcu * NWAVES + F.wave, NGW = F.G * NWAVES, lane = F.lane;
    const int* TOKASG = (const int*)(F.ws + WS_TOKASG); const unsigned char* Y = F.ws + WS_Y;
    f32x4 fg[4];
#pragma unroll
    for (int j = 0; j < 4; ++j) fg[j] = *((const GAS f32x4*)F.fin_g + lane + 64 * j);
    for (int tok = gw; tok < T; tok += NGW) {
        const int a = TOKASG[tok * 4 + (lane & 3)];
        const int crow = cst[a >> 15] * 256 + (a & (EROWS - 1));
        GAS f32x4* hp = (GAS f32x4*)(F.out + (size_t)tok * 1024) + lane; f32x4 v[4];
        const GAS v2u* hb = (const GAS v2u*)((const bf16*)(F.ws + WS_H16) + (size_t)tok * 1024) + lane;
#pragma unroll
        for (int j = 0; j < 4; ++j) { const v2u hw = __builtin_nontemporal_load(hb + 64 * j); v[j] = (f32x4){bflo(hw.x), bfhi(hw.x), bflo(hw.y), bfhi(hw.y)}; }
#pragma unroll
        for (int s = 0; s < 4; ++s) { const int cr = __shfl(crow, s); const GAS unsigned* yp = (const GAS unsigned*)(Y + (size_t)cr * 1024) + lane;
#pragma unroll
            for (int j = 0; j < 4; ++j) { const unsigned yw = __builtin_nontemporal_load(yp + 64 * j); const auto lo = __builtin_amdgcn_cvt_pk_f32_fp8((int)yw, false), hi = __builtin_amdgcn_cvt_pk_f32_fp8((int)yw, true);
                v[j].x += lo[0] * (1.f / YSCALE); v[j].y += lo[1] * (1.f / YSCALE); v[j].z += hi[0] * (1.f / YSCALE); v[j].w += hi[1] * (1.f / YSCALE); } }
        float ss = 0.f;
#pragma unroll
        for (int j = 0; j < 4; ++j) ss += (v[j].x * v[j].x + v[j].y * v[j].y) + (v[j].z * v[j].z + v[j].w * v[j].w);
        const float rinv = 1.f / sqrtf(wave_sum(ss) * (1.f / 1024.f) + EPS);
#pragma unroll
        for (int j = 0; j < 4; ++j) __builtin_nontemporal_store(v[j] * rinv * fg[j], hp + 64 * j);
    }
}
#ifndef MK_N_LAUNCHES
#define MK_N_LAUNCHES 1
#endif
constexpr int N_PHASES = 9;
constexpr int N_LAUNCHES = MK_N_LAUNCHES;
struct Args { const float* in[19]; float* out; unsigned char* ws; int ph_lo, ph_hi; };
__global__ void __launch_bounds__(NWAVES * 64, 2) enc_fwd(Args args) {
    extern __shared__ __attribute__((aligned(16))) unsigned char lds[];
    Frame F;
    F.lds = (LAS unsigned char*)lds;
    F.MISC = (volatile LAS unsigned*)(F.lds + LC_MISC);
    F.tid = threadIdx.x; F.lane = F.tid & 63; F.wave = __builtin_amdgcn_readfirstlane(F.tid >> 6);
    F.G = gridDim.x; { const int bx = blockIdx.x; F.vcu = (F.G % 8 == 0) ? (bx % 8) * (F.G / 8) + bx / 8 : bx; }
    F.ws = args.ws; F.ctl = (gu32*)(args.ws + WS_CTL);
    F.x = args.in[0]; F.mix_g = args.in[1]; F.w_in = args.in[2]; F.w_gf = args.in[3]; F.b_gf = args.in[4]; F.w_gb = args.in[5]; F.b_gb = args.in[6]; F.gla_hg = args.in[7];
    F.q_g = args.in[8]; F.k_g = args.in[9]; F.w_out = args.in[10]; F.ffn_g = args.in[11]; F.w_router = args.in[12]; F.b_router = args.in[13];
    F.w1 = args.in[14]; F.b1 = args.in[15]; F.w2 = args.in[16]; F.b2 = args.in[17]; F.fin_g = args.in[18]; F.out = args.out;
    for (int u = F.tid; u < (LDS_BYTES - LC_OFF) / 4; u += NWAVES * 64) ((LAS unsigned*)(F.lds + LC_OFF))[u] = 0u;
    __syncthreads();
    XcdBarrier bar; bar.bar = (unsigned*)(F.ctl + CW_BAR); bar.x = 0; bar.st = nullptr;
    if (N_LAUNCHES == 1) bar = xcd_barrier_post((unsigned*)(F.ctl + CW_BAR), F.MISC + 8);
    const int lo = args.ph_lo, hi = args.ph_hi;
#define IN(k) (lo <= (k) && (k) < hi)
#define SEAM(k) do { if (IN(k) && IN((k) + 1)) xcd_barrier(bar); } while (0)
    MoeTabs tb{(const LAS int*)(F.lds + LC_CNT), (const LAS int*)(F.lds + LC_CST), (const LAS unsigned short*)(F.lds + LC_TE)};

    if (IN(0)) { p0_prologue(F); } SEAM(0);
    if (IN(1)) {
        DenseMap mp{(const bf16*)(F.ws + WS_XN), (const bf16*)(F.ws + WS_WIN), 1024};
        pg8::StaticOrder S; S.init(T / 256, D_IN_PAD / 256, F.G, (int)blockIdx.x);
        EpiInProj E{(bf16*)(F.ws + WS_GQ), (bf16*)(F.ws + WS_GK), (bf16*)(F.ws + WS_GV), (bf16*)(F.ws + WS_GR), (bf16*)(F.ws + WS_AQ), (bf16*)(F.ws + WS_AK), (bf16*)(F.ws + WS_AV), (bf16*)(F.ws + WS_Z), (const float*)(F.ws + WS_RINV)};
        for (int i = 0; i < (int)(blockIdx.x & 7); ++i) __builtin_amdgcn_s_sleep(26);
        pg8::gemm_phase<EpiInProj, pg8::StaticOrder, DenseMap, true>(F.lds, 1024, S, mp, E);
    } SEAM(1);
    if (IN(2)) { p2_normrope(F); for (int u = F.vcu; u < BATCH * 64; u += F.G) gla::gla_prep_unit(F, u >> 6, u & 63); } SEAM(2);
    if (IN(3)) { p3_mixers(F); } SEAM(3);
    if (IN(4)) {
        DenseMap mp{(const bf16*)(F.ws + WS_MIX), (const bf16*)(F.ws + WS_WOUT), 1024};
        pg8::StaticOrder S; S.init(T / 256, DM / 256, F.G, (int)blockIdx.x);
        EpiResF32 E{(const bf16*)(F.ws + WS_XN), (bf16*)(F.ws + WS_H16)};
        pg8::gemm_phase<EpiResF32, pg8::StaticOrder, DenseMap, true>(F.lds, 1024, S, mp, E);
    } SEAM(4);
    if (IN(5)) { p5_route(F); } SEAM(5);
    if (IN(6)) {
        const int ntl = moe_tables(F);
        MoeMapUp mp{F.ws + WS_XN, F.ws + WS_W1, (const int*)(F.ws + WS_ROWTOK), tb};
        pg8::StaticOrder S; S.init(ntl, 8, F.G, (int)blockIdx.x);
        EpiSwiglu E{F.b1, F.ws + WS_ACT, tb};
        pg8::gemm_phase<EpiSwiglu, pg8::StaticOrder, MoeMapUp, true, true>(F.lds, 512, S, mp, E);
    } SEAM(6);
    if (IN(7)) {
        const int ntl = moe_tables(F);
        MoeMapDown mp{F.ws + WS_ACT, F.ws + WS_W2, tb};
        pg8::StaticOrder S; S.init(ntl, 4, F.G, (int)blockIdx.x);
        EpiDown E{F.b2, (const float*)(F.ws + WS_ROWGATE), F.ws + WS_Y, tb};
        pg8::gemm_phase<EpiDown, pg8::StaticOrder, MoeMapDown, true, true>(F.lds, 512, S, mp, E);
    } SEAM(7);
    if (IN(8)) { (void)moe_tables(F); p8_combine(F); }
#undef IN
#undef SEAM
}

extern "C" void kernel_launch(void* const* d_in, const int* in_sizes, int n_in, void* d_out, int out_size, void* d_ws, size_t ws_size, hipStream_t stream) {
    static int grid = 0;
    if (grid == 0) {
        if (n_in != 19 || in_sizes[0] != T * DM || out_size != T * DM || ws_size < WS_END) { fprintf(stderr, "kernel_launch: unexpected shapes (n_in %d, in0 %d, out %d, ws %zu); nothing launched\n", n_in, n_in > 0 ? in_sizes[0] : -1, out_size, ws_size); grid = -1; return; }
        int dev = 0, cus = 0, per_cu = 0;
        if (hipGetDevice(&dev) != hipSuccess || hipDeviceGetAttribute(&cus, hipDeviceAttributeMultiprocessorCount, dev) != hipSuccess) { grid = -1; return; }
        if (hipFuncSetAttribute((const void*)enc_fwd, hipFuncAttributeMaxDynamicSharedMemorySize, LDS_BYTES) != hipSuccess) { fprintf(stderr, "kernel_launch: hipFuncSetAttribute failed\n"); grid = -1; return; }
        if (hipOccupancyMaxActiveBlocksPerMultiprocessor(&per_cu, (const void*)enc_fwd, NWAVES * 64, LDS_BYTES) != hipSuccess || per_cu < 1) { fprintf(stderr, "kernel_launch: occupancy query says %d\n", per_cu); }
        (void)hipGetLastError();
        grid = cus;
    }
    if (grid < 0) return;
    if (hipMemsetAsync((char*)d_ws + WS_CTL, 0, CTL_ZERO_BYTES, stream) != hipSuccess) return;
    Args a{};
    for (int i = 0; i < 19; ++i) a.in[i] = (const float*)d_in[i];
    a.out = (float*)d_out; a.ws = (unsigned char*)d_ws;
    if (N_LAUNCHES == 1) { a.ph_lo = 0; a.ph_hi = N_PHASES; hipLaunchKernelGGL(enc_fwd, dim3(grid), dim3(NWAVES * 64), LDS_BYTES, stream, a); }
    else for (int p = 0; p < N_PHASES; ++p) { a.ph_lo = p; a.ph_hi = p + 1; hipLaunchKernelGGL(enc_fwd, dim3(grid), dim3(NWAVES * 64), LDS_BYTES, stream, a); }
}
```

```cpp
#include <hip/hip_runtime.h>
#include <hip/hip_bf16.h>
#include <cstdio>
#include <cstdint>
#include <cmath>

#define LAS __attribute__((address_space(3)))
#define GAS __attribute__((address_space(1)))

namespace pg8 {
typedef unsigned short bf16_t;
typedef short bf16x8 __attribute__((ext_vector_type(8)));
typedef float f32x4 __attribute__((ext_vector_type(4)));
typedef float f32x2 __attribute__((ext_vector_type(2)));
typedef unsigned u32x4 __attribute__((ext_vector_type(4)));
typedef int v4i_t __attribute__((ext_vector_type(4)));
typedef int v8i_t __attribute__((ext_vector_type(8)));
constexpr int BM = 256, BK = 64, HALF = 128, HTB = HALF * BK * 2, STAGE_BYTES = 8 * HTB, NXCD = 8, WGM = 4;

__host__ __device__ __forceinline__ int lds_byte(int r, int c) { const int st = (r >> 4) * 2 + (c >> 5), rr = r & 15, cc = c & 31, ob = rr * 64 + cc * 2; return st * 1024 + (ob ^ (((ob >> 9) & 1) << 5)); }
__host__ __device__ __forceinline__ void stage_rc(int b, int& R, int& C) { const int st = b / 1024, sb = b % 1024, swz = sb ^ (((sb >> 9) & 1) << 5); R = (st >> 1) * 16 + swz / 64; C = (st & 1) * 32 + (swz % 64) / 2; }
__host__ __device__ __forceinline__ int perm32(int rho) { const int n = rho >> 4, i = rho & 15; return 8 * (i >> 2) + 4 * n + (i & 3); }

struct Unit { int pm, pn; };

struct StaticOrder {
    int nM, nN, nwg, G, c;
    __device__ __forceinline__ void init(int nM_, int nN_, int G_, int c_) { nM = nM_; nN = nN_; nwg = nM * nN; G = G_; c = c_; }
    __device__ __forceinline__ bool next(int i, Unit& u) const {
        const long L = (long)i * G + c; if (L >= nwg) return false;
        int wgid = (int)L; { const int q = nwg / NXCD, r = nwg % NXCD, xcd = wgid % NXCD, off = wgid / NXCD; wgid = (xcd < r ? xcd * (q + 1) : r * (q + 1) + (xcd - r) * q) + off; }
        const int nig = WGM * nN, gid = wgid / nig, fm = gid * WGM, gsz = (nM - fm) < WGM ? (nM - fm) : WGM;
        u.pm = fm + ((wgid % nig) % gsz); u.pn = (wgid % nig) / gsz; return true;
    }
};

__device__ __forceinline__ unsigned cvt_pk_bf16(float lo, float hi) { unsigned r; asm volatile("v_cvt_pk_bf16_f32 %0, %1, %2" : "=v"(r) : "v"(lo), "v"(hi)); return r; }

template <class Epi, class Sched, class Map, bool ALIGN_EPI, bool FP8 = false>
__device__ __forceinline__ void gemm_phase(LAS unsigned char* lds, const int K, const Sched& S, const Map& MP, const Epi& E) {
    int tid_ = threadIdx.x; asm volatile("" : "+v"(tid_));
    const int tid = tid_, wid = __builtin_amdgcn_readfirstlane(tid >> 6), lane = tid & 63, wr = wid >> 2, wc = wid & 3, fr = lane & 15, fq = lane >> 4;
    const int nt = K / BK;
    int Rr[2], Cc[2]; unsigned voffB[2];
#pragma unroll
    for (int i = 0; i < 2; ++i) { int R, C; stage_rc(tid * 16 + i * 8192, R, C); Rr[i] = R; Cc[i] = C; const int Rb = Epi::COLS64 ? (64 * (R >> 5) + perm32(R & 31)) : (Epi::PERM ? ((R & ~31) + perm32(R & 31)) : R); voffB[i] = (unsigned)(Rb * K + C) * 2u; }
    const unsigned kstep = (unsigned)(BK * 2);
    const unsigned hstep = (unsigned)HALF * K * 2;
    const unsigned hstepB = Epi::COLS64 ? 32u * (unsigned)K * 2u : hstep;
    const __amdgpu_buffer_rsrc_t RA = MP.a_rsrc(), RB = MP.b_rsrc();
    const unsigned ldsw = (unsigned)wid * 1024u;
    const int aoff = lds_byte(wr * 64 + fr, fq * 8), boff = lds_byte(wc * 32 + fr, fq * 8);
#define PG8_SA(b, h) (((b) * 2 + (h)) * HTB)
#define PG8_SB(b, h) ((4 + (b) * 2 + (h)) * HTB)
#define PG8_STAGE(bufoff, rsrc, soff, voff) do { _Pragma("unroll") for (int _i = 0; _i < 2; ++_i) \
        __builtin_amdgcn_raw_ptr_buffer_load_lds(rsrc, (LAS unsigned*)(lds + (bufoff) + ldsw + _i * 8192), 16, (int)(voff)[_i], (int)(soff), 0, 0); } while (0)
#define PG8_LD8(p) __builtin_shufflevector(*(const LAS v4i_t*)(p), *(const LAS v4i_t*)((p) + 1024), 0, 1, 2, 3, 4, 5, 6, 7)
#define PG8_LDA(dst, b, h) do { _Pragma("unroll") for (int m = 0; m < 4; ++m) dst[m] = PG8_LD8(lds + PG8_SA(b, h) + aoff + m * 2048); } while (0)
#define PG8_LDB(dst, b, h) do { _Pragma("unroll") for (int n = 0; n < 2; ++n) dst[n] = PG8_LD8(lds + PG8_SB(b, h) + boff + n * 2048); } while (0)
#define PG8_HALF(x, k) __builtin_bit_cast(bf16x8, __builtin_shufflevector(x, x, 4 * (k), 4 * (k) + 1, 4 * (k) + 2, 4 * (k) + 3))
#define PG8_MMA(ai, bj, At, Bt) do { __builtin_amdgcn_s_setprio(1); _Pragma("unroll") for (int m = 0; m < 4; ++m) _Pragma("unroll") for (int n = 0; n < 2; ++n) { \
        if constexpr (FP8) { acc[ai][bj][m][n] = __builtin_amdgcn_mfma_scale_f32_16x16x128_f8f6f4(Bt[n], At[m], acc[ai][bj][m][n], 0, 0, 0, 0x7f7f7f7f, 0, 0x7f7f7f7f); } \
        else { acc[ai][bj][m][n] = __builtin_amdgcn_mfma_f32_16x16x32_bf16(PG8_HALF(Bt[n], 0), PG8_HALF(At[m], 0), acc[ai][bj][m][n], 0, 0, 0); \
               acc[ai][bj][m][n] = __builtin_amdgcn_mfma_f32_16x16x32_bf16(PG8_HALF(Bt[n], 1), PG8_HALF(At[m], 1), acc[ai][bj][m][n], 0, 0, 0); } } \
        __builtin_amdgcn_s_setprio(0); } while (0)
#define PG8_WAIT_V(n) asm volatile("s_waitcnt vmcnt(" #n ")" ::: "memory")
#define PG8_WAIT_L(n) asm volatile("s_waitcnt lgkmcnt(" #n ")" ::: "memory")
#define PG8_BAR __builtin_amdgcn_s_barrier()
#define PG8_SCHED __builtin_amdgcn_sched_barrier(0)
    Unit cur, nxt, nn; int ui = 0;
    if (!S.next(0, cur)) return;
    f32x4 acc[2][2][4][2];
#pragma unroll
    for (int a = 0; a < 2; ++a)
#pragma unroll
        for (int b = 0; b < 2; ++b)
#pragma unroll
            for (int m = 0; m < 4; ++m)
#pragma unroll
                for (int n = 0; n < 2; ++n) acc[a][b][m][n] = (f32x4){0.f, 0.f, 0.f, 0.f};
    v8i_t At[4], B0[2], B1[2];
    unsigned cvo[2][2], nvo[2][2], nnvo[2][2];
    MP.a_off(cur, Rr, Cc, cvo);
    bool has_next = S.next(1, nxt);
    if constexpr (Map::GATHER) { if (has_next) MP.a_off(nxt, Rr, Cc, nvo); else { nvo[0][0] = cvo[0][0]; nvo[0][1] = cvo[0][1]; nvo[1][0] = cvo[1][0]; nvo[1][1] = cvo[1][1]; } }
    unsigned cA = MP.a_soff(cur), cB = MP.b_soff(cur);
    typename Epi::Pre pc, pn;
    E.preload(cur, wr, wc, fr, fq, pc); pn = pc;
    PG8_STAGE(PG8_SB(0, 0), RB, cB, voffB); PG8_STAGE(PG8_SB(0, 1), RB, cB + hstepB, voffB); PG8_STAGE(PG8_SA(0, 0), RA, cA, cvo[0]); PG8_STAGE(PG8_SA(0, 1), RA, cA, cvo[1]);
    if (wr == 1) PG8_BAR;
    PG8_WAIT_V(2); PG8_BAR;
    PG8_STAGE(PG8_SB(1, 0), RB, cB + kstep, voffB); PG8_STAGE(PG8_SA(1, 0), RA, cA + kstep, cvo[0]); PG8_STAGE(PG8_SB(1, 1), RB, cB + hstepB + kstep, voffB);
    PG8_WAIT_V(6); PG8_BAR;
    for (;;) {
        const unsigned nA = has_next ? MP.a_soff(nxt) : cA, nB = has_next ? MP.b_soff(nxt) : cB;
#pragma unroll 1
        for (int t = 0; t < nt; t += 2) {
            const bool last = (t == nt - 2);
            const unsigned a1 = cA + (unsigned)(t + 1) * kstep;
            const unsigned a2 = last ? nA : cA + (unsigned)(t + 2) * kstep, b2 = last ? nB : cB + (unsigned)(t + 2) * kstep;
            const unsigned a3 = a2 + kstep, b3 = b2 + kstep;
            unsigned s0[2] = {cvo[0][0], cvo[0][1]}, s1[2] = {cvo[1][0], cvo[1][1]};
            if constexpr (Map::GATHER) { if (last) { s0[0] = nvo[0][0]; s0[1] = nvo[0][1]; s1[0] = nvo[1][0]; s1[1] = nvo[1][1]; } }
            PG8_LDB(B0, 0, 0); PG8_LDB(B1, 0, 1); PG8_SCHED; PG8_LDA(At, 0, 0); PG8_STAGE(PG8_SA(1, 1), RA, a1, cvo[1]);
            PG8_WAIT_V(8); PG8_WAIT_L(0); PG8_BAR; PG8_MMA(0, 0, At, B0); PG8_MMA(0, 1, At, B1); PG8_BAR; PG8_SCHED;
            PG8_LDA(At, 0, 1); PG8_STAGE(PG8_SB(0, 0), RB, b2, voffB); PG8_STAGE(PG8_SB(0, 1), RB, b2 + hstepB, voffB); PG8_STAGE(PG8_SA(0, 0), RA, a2, s0);
            PG8_WAIT_V(8); PG8_WAIT_L(0); PG8_BAR; PG8_MMA(1, 0, At, B0); PG8_MMA(1, 1, At, B1); PG8_BAR; PG8_SCHED;
            PG8_LDB(B0, 1, 0); PG8_LDB(B1, 1, 1); PG8_SCHED; PG8_LDA(At, 1, 0); PG8_STAGE(PG8_SA(0, 1), RA, a2, s1);
            PG8_WAIT_V(8); PG8_WAIT_L(0); PG8_BAR; PG8_MMA(0, 0, At, B0); PG8_MMA(0, 1, At, B1); PG8_BAR; PG8_SCHED;
            PG8_LDA(At, 1, 1); PG8_STAGE(PG8_SB(1, 0), RB, b3, voffB); PG8_STAGE(PG8_SB(1, 1), RB, b3 + hstepB, voffB); PG8_STAGE(PG8_SA(1, 0), RA, a3, s0);
            PG8_WAIT_V(8); PG8_WAIT_L(0); PG8_BAR; PG8_MMA(1, 0, At, B0); PG8_MMA(1, 1, At, B1); PG8_BAR; PG8_SCHED;
        }
        if constexpr (ALIGN_EPI) { if (wr == 0) PG8_BAR; }
        const bool has_nn = has_next && S.next(ui + 2, nn);
        if constexpr (Map::GATHER) { if (has_nn) MP.a_raw(nn, Rr, nnvo); }
        if (has_next) E.preload(nxt, wr, wc, fr, fq, pn);
        { int fr_ = fr, fq_ = fq; asm volatile("" : "+v"(fr_), "+v"(fq_)); E(acc, cur, pc, wr, wc, fr_, fq_); }
        if (!has_next) break;
#pragma unroll
        for (int a = 0; a < 2; ++a)
#pragma unroll
            for (int b = 0; b < 2; ++b)
#pragma unroll
                for (int m = 0; m < 4; ++m)
#pragma unroll
                    for (int n = 0; n < 2; ++n) acc[a][b][m][n] = (f32x4){0.f, 0.f, 0.f, 0.f};
        cur = nxt; cA = nA; cB = nB; ++ui; pc = pn;
#pragma unroll
        for (int h = 0; h < 2; ++h)
#pragma unroll
            for (int i = 0; i < 2; ++i) { if constexpr (Map::GATHER) { cvo[h][i] = nvo[h][i]; nvo[h][i] = has_nn ? MP.a_fin(nnvo[h][i], Cc[i]) : nvo[h][i]; } }
        has_next = has_nn; nxt = nn;
        if constexpr (ALIGN_EPI) { if (wr == 1) PG8_BAR; }
    }
    PG8_WAIT_V(0);
    if constexpr (!ALIGN_EPI) { if (wr == 0) PG8_BAR; }
    PG8_BAR;
#undef PG8_SA
#undef PG8_SB
#undef PG8_STAGE
#undef PG8_LDA
#undef PG8_LDB
#undef PG8_MMA
#undef PG8_HALF
#undef PG8_LD8
#undef PG8_WAIT_V
#undef PG8_WAIT_L
#undef PG8_BAR
#undef PG8_SCHED
}
}
namespace attn_body {
using bf16=__hip_bfloat16;
using bf16x8=__attribute__((ext_vector_type(8)))short;
using s16x4=__attribute__((ext_vector_type(4)))short;
using f32x16=__attribute__((ext_vector_type(16)))float;
using u32x4=__attribute__((ext_vector_type(4)))unsigned;
constexpr int BATCH=8,NHEAD=8,NKVH=2,SEQ=4096,D=64;
constexpr int QP=512,KP=128,VP=128,OP=1024,OCOL=512;
constexpr int NW=8,QBLK=32,QB=QBLK*NW,KVBLK=64,NQB=SEQ/QB;
__device__ __forceinline__ int crow(int r,int hi){return (r&3)+8*(r>>2)+4*hi;}
#define SBAR() __builtin_amdgcn_sched_barrier(0)
constexpr int NSLOT=3, SLOTB=8192;
constexpr int LDS_K=0, LDS_V=NSLOT*SLOTB, LDS_WS=2*NSLOT*SLOTB, LDS_OST=LDS_WS+NW*64*4, LDS_BYTES=LDS_OST+NW*4096;
constexpr float C2=0.125f*1.4426950408889634f;
__device__ __forceinline__ void glds16(const void*gsrc,unsigned lds_dst){unsigned keep;
  asm volatile("s_mov_b32 %0, m0\n\ts_mov_b32 m0, %2\n\ts_nop 0\n\tglobal_load_lds_dwordx4 %1, off\n\ts_mov_b32 m0, %0":"=&s"(keep):"v"(gsrc),"s"(lds_dst):"memory");}
__device__ __forceinline__ float max3f(float a,float b,float c){float r;asm("v_max3_f32 %0, %1, %2, %3":"=v"(r):"v"(a),"v"(b),"v"(c));return r;}
__device__ __forceinline__ float max2f(float a,float b){float r;asm("v_max_f32_e32 %0, %1, %2":"=v"(r):"v"(a),"v"(b));return r;}
__device__ __forceinline__ float fadd_s(float a,float b){float r;asm("v_add_f32_e32 %0, %1, %2":"=v"(r):"v"(a),"v"(b));return r;}
__device__ __forceinline__ float fsub_s(float a,float b){float r;asm("v_sub_f32_e32 %0, %1, %2":"=v"(r):"v"(a),"v"(b));return r;}
typedef float f32x2_t __attribute__((ext_vector_type(2))); typedef __bf16 bf16x2_t __attribute__((ext_vector_type(2)));
__device__ __forceinline__ unsigned cvtpk_s(float lo,float hi){f32x2_t v={lo,hi};bf16x2_t b=__builtin_convertvector(v,bf16x2_t);return __builtin_bit_cast(unsigned,b);}
#define WAIT_BAR(N) asm volatile("s_waitcnt vmcnt(" #N ") lgkmcnt(0)\n\ts_barrier":::"memory")

__device__ __forceinline__ void qkt(f32x16&p0,f32x16&p1,const char*Kslot,const bf16x8*qr,const f32x16&negm,int r32,int hi){
  const char*kb=Kslot+hi*1024+r32*16;
  #pragma unroll
  for(int d0=0;d0<4;++d0){
    const bf16x8 b0=*reinterpret_cast<const bf16x8*>(kb+d0*2048);
    const bf16x8 b1=*reinterpret_cast<const bf16x8*>(kb+d0*2048+512);
    if(d0==0){p0=__builtin_amdgcn_mfma_f32_32x32x16_bf16(b0,qr[0],negm,0,0,0);p1=__builtin_amdgcn_mfma_f32_32x32x16_bf16(b1,qr[0],negm,0,0,0);}
    else{p0=__builtin_amdgcn_mfma_f32_32x32x16_bf16(b0,qr[d0],p0,0,0,0);p1=__builtin_amdgcn_mfma_f32_32x32x16_bf16(b1,qr[d0],p1,0,0,0);}}
}
typedef __attribute__((address_space(3))) const char* lds_cptr;
typedef short v4i16_t __attribute__((ext_vector_type(4)));
__device__ __forceinline__ void kload8(bf16x8*kf,lds_cptr kp){
  kf[0]=*(const __attribute__((address_space(3))) bf16x8*)(kp);      kf[1]=*(const __attribute__((address_space(3))) bf16x8*)(kp+512);
  kf[2]=*(const __attribute__((address_space(3))) bf16x8*)(kp+2048); kf[3]=*(const __attribute__((address_space(3))) bf16x8*)(kp+2560);
  kf[4]=*(const __attribute__((address_space(3))) bf16x8*)(kp+4096); kf[5]=*(const __attribute__((address_space(3))) bf16x8*)(kp+4608);
  kf[6]=*(const __attribute__((address_space(3))) bf16x8*)(kp+6144); kf[7]=*(const __attribute__((address_space(3))) bf16x8*)(kp+6656);
}
__device__ __forceinline__ void kload2(bf16x8*kf,lds_cptr kp,int j){ kf[2*j]=*(const __attribute__((address_space(3))) bf16x8*)(kp+j*2048); kf[2*j+1]=*(const __attribute__((address_space(3))) bf16x8*)(kp+j*2048+512); }
__device__ __forceinline__ s16x4 vtr(lds_cptr p){ return __builtin_bit_cast(s16x4,__builtin_amdgcn_ds_read_tr16_b64_v4i16((__attribute__((address_space(3))) v4i16_t*)p)); }
__device__ __forceinline__ float rowmax(const f32x16&p0,const f32x16&p1){
  float a=max3f(p0[0],p0[1],p1[0]),b=max3f(p0[2],p0[3],p1[1]);a=max3f(a,p1[2],p1[3]);
  #pragma unroll
  for(int r=4;r<16;r+=4){a=max3f(a,p0[r],p0[r+1]);b=max3f(b,p0[r+2],p0[r+3]);a=max3f(a,p1[r],p1[r+1]);b=max3f(b,p1[r+2],p1[r+3]);}
  const float m=max2f(a,b);
  auto rr=__builtin_amdgcn_permlane32_swap(__float_as_uint(m),__float_as_uint(m),false,false);
  return max2f(__uint_as_float(rr[0]),__uint_as_float(rr[1]));
}
__device__ __forceinline__ void pv(f32x16*o,int vb,bf16x8 pa0,bf16x8 pa1,bf16x8 pa2,bf16x8 pa3){
  #pragma unroll
  for(int d0=0;d0<2;++d0){s16x4 lo[4],hi[4];
    #pragma unroll
    for(int ks=0;ks<4;++ks){
      asm volatile("ds_read_b64_tr_b16 %0,%1 offset:%c2":"=&v"(lo[ks]):"v"(vb),"i"(d0*4096+ks*1024):"memory");
      asm volatile("ds_read_b64_tr_b16 %0,%1 offset:%c2":"=&v"(hi[ks]):"v"(vb),"i"(d0*4096+ks*1024+512):"memory");}
    asm volatile("s_waitcnt lgkmcnt(0)":::"memory");SBAR();
    #define PK(k) (bf16x8){lo[k][0],lo[k][1],lo[k][2],lo[k][3],hi[k][0],hi[k][1],hi[k][2],hi[k][3]}
    o[d0]=__builtin_amdgcn_mfma_f32_32x32x16_bf16(pa0,PK(0),o[d0],0,0,0);
    o[d0]=__builtin_amdgcn_mfma_f32_32x32x16_bf16(pa1,PK(1),o[d0],0,0,0);
    o[d0]=__builtin_amdgcn_mfma_f32_32x32x16_bf16(pa2,PK(2),o[d0],0,0,0);
    o[d0]=__builtin_amdgcn_mfma_f32_32x32x16_bf16(pa3,PK(3),o[d0],0,0,0);
    #undef PK
  }
}
#define ATTN_STORE16(p,v) (*(u32x4*)(p)=(v))
template<int THRL> __device__ __forceinline__ void attn_unit(int b,int h,int qb,const bf16*Q,const bf16*__restrict__ K,const bf16*__restrict__ V,bf16*O,char*shm,const float*qgain,const float sbound){
  int tid_=threadIdx.x; asm volatile("":"+v"(tid_));
  const int tid=tid_,lane=tid&63,r32=lane&31,hi=lane>>5; const int wid=__builtin_amdgcn_readfirstlane(tid>>6);
  const long rowbase=(long)b*SEQ; const int q0=qb*QB; const int kvh=h/(NHEAD/NKVH);
  const bf16*Qw=Q+(rowbase+q0+wid*QBLK)*QP+h*D;
  const bf16*Kh=K+rowbase*KP+kvh*D,*Vh=V+rowbase*VP+kvh*D;
  const unsigned lds0=(unsigned)(uintptr_t)shm;
  float*wsf=(float*)(shm+LDS_WS)+wid*64;
  const bf16*ksrc=Kh+(long)lane*KP+wid*8;
  const bf16*vsrc=Vh+(long)(16*(wid&3)+(lane>>2))*VP+(wid>>2)*32+(lane&3)*8;
  const unsigned kdst=lds0+LDS_K+wid*1024, vdst=lds0+LDS_V+wid*1024;
  #define DMA_K(t,slot) glds16(ksrc+(long)(t)*KVBLK*KP,(unsigned)__builtin_amdgcn_readfirstlane(kdst+(slot)))
  #define DMA_V(t,slot) glds16(vsrc+(long)(t)*KVBLK*VP,(unsigned)__builtin_amdgcn_readfirstlane(vdst+(slot)))
  const int vb0=(int)(lds0+LDS_V)+((lane>>4)&1)*32+(lane&3)*8+(4*hi+((lane&15)>>2))*64;
  const char*Kbase=shm+LDS_K; bf16x8 kf[8];
  const lds_cptr shm3=(lds_cptr)shm; const lds_cptr kp0=shm3+LDS_K+hi*1024+r32*16; const lds_cptr vp0=shm3+LDS_V+((lane>>4)&1)*32+(lane&3)*8+(4*hi+((lane&15)>>2))*64;
  constexpr int NT=SEQ/KVBLK;
  DMA_K(0,0);DMA_V(0,0);DMA_K(1,SLOTB);
  bf16x8 qr[4];
  #pragma unroll
  for(int d0=0;d0<4;++d0)qr[d0]=*reinterpret_cast<const bf16x8*>(&Qw[(long)r32*QP+d0*16+hi*8]);
  { float xq[4][8]; float ss=0.f; int hio=hi; asm volatile("":"+v"(hio));
    #pragma unroll
    for(int d0=0;d0<4;++d0)
      #pragma unroll
      for(int j=0;j<8;++j){ xq[d0][j]=__builtin_bit_cast(float,((unsigned)(unsigned short)qr[d0][j])<<16); ss+=xq[d0][j]*xq[d0][j]; }
    ss+=__shfl_xor(ss,32);
    const float rinv=__builtin_amdgcn_rsqf(ss*(1.f/64.f)+1e-6f);
    const int tq=q0+wid*QBLK+r32; const float prow=(float)(tq>>6), pcol=(float)(tq&63);
    #pragma unroll
    for(int d0=0;d0<4;++d0)
      #pragma unroll
      for(int j=0;j<8;++j) xq[d0][j]*=rinv*qgain[16*d0+8*hio+j];
    #pragma unroll
    for(int j=0;j<8;++j){ const float inv=exp2f(-(float)(8*hio+j)*(13.287712379549449f/16.f));
      const float ar=prow*inv, ac=pcol*inv; const float cr=__cosf(ar), sr=__sinf(ar), cc=__cosf(ac), sc=__sinf(ac);
      const float a0=xq[0][j], a1=xq[1][j], b0=xq[2][j], b1=xq[3][j];
      xq[0][j]=(a0*cr-a1*sr)*C2; xq[1][j]=(a1*cr+a0*sr)*C2; xq[2][j]=(b0*cc-b1*sc)*C2; xq[3][j]=(b1*cc+b0*sc)*C2; }
    #pragma unroll
    for(int d0=0;d0<4;++d0){ u32x4 w; w.x=cvtpk_s(xq[d0][0],xq[d0][1]); w.y=cvtpk_s(xq[d0][2],xq[d0][3]); w.z=cvtpk_s(xq[d0][4],xq[d0][5]); w.w=cvtpk_s(xq[d0][6],xq[d0][7]); qr[d0]=__builtin_bit_cast(bf16x8,w); } }
  float l_reg=0.f;f32x16 o[2];o[0]=f32x16{};o[1]=f32x16{};f32x16 negm;
  #pragma unroll
  for(int r=0;r<16;++r)negm[r]=-sbound;
  asm volatile("":"+v"(negm));
  #define START(P0,P1) do{ _Pragma("unroll") for(int r=0;r<16;++r)P0[r]=__builtin_amdgcn_exp2f(P0[r]); }while(0)
  #define RESC() do{}while(0)
  f32x16 pA0,pA1,pB0,pB1;
  int sl_prev=0,sl_cur=0,sl_next=SLOTB;
  #define ROT() do{sl_prev=sl_cur;sl_cur=sl_next;sl_next=(sl_next==(NSLOT-1)*SLOTB)?0:sl_next+SLOTB;}while(0)
  DMA_K(2,2*SLOTB);
  WAIT_BAR(3);
  qkt(pA0,pA1,Kbase,qr,negm,r32,hi);asm volatile("s_nop 15\n\ts_nop 7":"+v"(pA0),"+v"(pA1));
  START(pA0,pA1);
  _Pragma("unroll") for(int r=0;r<16;++r)pA1[r]=__builtin_amdgcn_exp2f(pA1[r]);
  WAIT_BAR(0);
  DMA_K(3,0);DMA_V(1,SLOTB);
  ROT();
  kload8(kf,kp0+sl_cur);
  WAIT_BAR(2);
  s16x4 vlo[8],vhi[8]; u32x4 pw0,pw1,pw2,pw3;
  #define PKW(P,B) cvtpk_s(P[B],P[B+1])
  #define PAF(k) __builtin_bit_cast(bf16x8,pw##k)
  #define VFR(i) (bf16x8){vlo[i][0],vlo[i][1],vlo[i][2],vlo[i][3],vhi[i][0],vhi[i][1],vhi[i][2],vhi[i][3]}
  #define PIN(x) asm volatile("":"+v"(x))
  #define MX3(a,b,c) __builtin_fmaxf(__builtin_fmaxf((a),(b)),(c))
  #define GAPA(MF,A0,A1,A2,A3,W0,W1,PW) do{ MF; sacc+=A0; sacc+=A1; sacc+=A2; sacc+=A3; PIN(sacc); W0; W1; PIN(PW); SBAR(); }while(0)
  #define EX(v) __builtin_amdgcn_exp2f(v)
  #define GAPB(MF,X,B) do{ MF; X[B]=EX(X[B]); X[B+1]=EX(X[B+1]); X[B+2]=EX(X[B+2]); X[B+3]=EX(X[B+3]); PIN(X); SBAR(); }while(0)
  #define VRD(i) do{ vlo[i]=vtr(vp_+(((i)>>2)*4096+((i)&3)*1024)); vhi[i]=vtr(vp_+(((i)>>2)*4096+((i)&3)*1024+512)); }while(0)
  #define KRD(G,j) do{ if(G){ kload2(kf,kp0+sl_next,j); SBAR(); } }while(0)
  #define STEP(C0,C1,P0,P1,t,GK,GV,GL) do{ SBAR(); \
    const lds_cptr vp_=vp0+sl_prev; \
    VRD(0); SBAR(); float sacc=(P0[0]+P0[1]); \
    GAPA(C0=__builtin_amdgcn_mfma_f32_32x32x16_bf16(kf[0],qr[0],negm,0,0,0), P0[2],P0[3],P0[4],P0[5],     pw0[0]=PKW(P0,0), pw0[1]=PKW(P0,2), pw0); \
    VRD(4); SBAR(); GAPA(C1=__builtin_amdgcn_mfma_f32_32x32x16_bf16(kf[1],qr[0],negm,0,0,0), P0[6],P0[7],P0[8],P0[9],     pw0[2]=PKW(P0,4), pw0[3]=PKW(P0,6), pw0); \
    VRD(1); SBAR(); GAPA(C0=__builtin_amdgcn_mfma_f32_32x32x16_bf16(kf[2],qr[1],C0,0,0,0),   P0[10],P0[11],P0[12],P0[13], pw1[0]=PKW(P0,8), pw1[1]=PKW(P0,10), pw1); \
    VRD(5); SBAR(); GAPA(C1=__builtin_amdgcn_mfma_f32_32x32x16_bf16(kf[3],qr[1],C1,0,0,0),   P0[14],P0[15],P1[0],P1[1],   pw1[2]=PKW(P0,12),pw1[3]=PKW(P0,14), pw1); \
    VRD(2); SBAR(); GAPA(C0=__builtin_amdgcn_mfma_f32_32x32x16_bf16(kf[4],qr[2],C0,0,0,0),   P1[2],P1[3],P1[4],P1[5],     pw2[0]=PKW(P1,0), pw2[1]=PKW(P1,2), pw2); \
    VRD(6); SBAR(); GAPA(C1=__builtin_amdgcn_mfma_f32_32x32x16_bf16(kf[5],qr[2],C1,0,0,0),   P1[6],P1[7],P1[8],P1[9],     pw2[2]=PKW(P1,4), pw2[3]=PKW(P1,6), pw2); \
    VRD(3); SBAR(); GAPA(C0=__builtin_amdgcn_mfma_f32_32x32x16_bf16(kf[6],qr[3],C0,0,0,0),   P1[10],P1[11],P1[12],P1[13], pw3[0]=PKW(P1,8), pw3[1]=PKW(P1,10), pw3); \
    VRD(7); SBAR(); GAPA(C1=__builtin_amdgcn_mfma_f32_32x32x16_bf16(kf[7],qr[3],C1,0,0,0),   P1[14],P1[15],0.f,0.f,       pw3[2]=PKW(P1,12),pw3[3]=PKW(P1,14), pw3); \
    l_reg+=sacc; \
    if(GK){DMA_K((t)+3,sl_cur);} if(GV){DMA_V((t)+1,sl_next);} \
    SBAR(); \
    GAPB(o[0]=__builtin_amdgcn_mfma_f32_32x32x16_bf16(PAF(0),VFR(0),o[0],0,0,0), C0,0); \
    GAPB(o[1]=__builtin_amdgcn_mfma_f32_32x32x16_bf16(PAF(0),VFR(4),o[1],0,0,0), C0,4); \
    KRD(GL,0); GAPB(o[0]=__builtin_amdgcn_mfma_f32_32x32x16_bf16(PAF(1),VFR(1),o[0],0,0,0), C0,8); \
    KRD(GL,1); GAPB(o[1]=__builtin_amdgcn_mfma_f32_32x32x16_bf16(PAF(1),VFR(5),o[1],0,0,0), C0,12); \
    KRD(GL,2); GAPB(o[0]=__builtin_amdgcn_mfma_f32_32x32x16_bf16(PAF(2),VFR(2),o[0],0,0,0), C1,0); \
    KRD(GL,3); GAPB(o[1]=__builtin_amdgcn_mfma_f32_32x32x16_bf16(PAF(2),VFR(6),o[1],0,0,0), C1,4); \
    GAPB(o[0]=__builtin_amdgcn_mfma_f32_32x32x16_bf16(PAF(3),VFR(3),o[0],0,0,0), C1,8); \
    GAPB(o[1]=__builtin_amdgcn_mfma_f32_32x32x16_bf16(PAF(3),VFR(7),o[1],0,0,0), C1,12); \
    }while(0)
  int t=1;
  for(;t+5<NT;t+=2){
    STEP(pB0,pB1,pA0,pA1,t,true,true,true);     WAIT_BAR(2); RESC(); ROT();
    STEP(pA0,pA1,pB0,pB1,t+1,true,true,true);   WAIT_BAR(2); RESC(); ROT();
  }
  #define ENDW(tt) do{ if((tt)+3<NT){WAIT_BAR(2);} else if((tt)+2<NT){WAIT_BAR(1);} else {WAIT_BAR(0);} }while(0)
  for(;t+1<NT;t+=2){
    STEP(pB0,pB1,pA0,pA1,t,(t+3<NT),(t+1<NT),(t+1<NT));       ENDW(t);   RESC(); ROT();
    STEP(pA0,pA1,pB0,pB1,t+1,(t+4<NT),(t+2<NT),(t+2<NT));     ENDW(t+1); RESC(); ROT();
  }
  STEP(pB0,pB1,pA0,pA1,NT-1,false,false,false); RESC();
  { float sacc=pB0[0]+pB0[1]; _Pragma("unroll") for(int r=2;r<16;++r)sacc+=pB0[r]; _Pragma("unroll") for(int r=0;r<16;++r)sacc+=pB1[r]; l_reg+=sacc;
    pw0=(u32x4){PKW(pB0,0),PKW(pB0,2),PKW(pB0,4),PKW(pB0,6)};pw1=(u32x4){PKW(pB0,8),PKW(pB0,10),PKW(pB0,12),PKW(pB0,14)};pw2=(u32x4){PKW(pB1,0),PKW(pB1,2),PKW(pB1,4),PKW(pB1,6)};pw3=(u32x4){PKW(pB1,8),PKW(pB1,10),PKW(pB1,12),PKW(pB1,14)};
    SBAR(); pv(o,vb0+sl_cur,PAF(0),PAF(1),PAF(2),PAF(3)); }
  #undef PKW
  #undef PAF
  #undef VFR
  #undef PIN
  #undef MX3
  #undef GAPA
  #undef GAPB
  #undef EX
  #undef VRD
  #undef KRD
  #undef STEP
  #undef ENDW
  {auto rr=__builtin_amdgcn_permlane32_swap(__float_as_uint(l_reg),__float_as_uint(l_reg),false,false);l_reg=__uint_as_float(rr[0])+__uint_as_float(rr[1]);}
  if(hi==0)wsf[32+r32]=l_reg;asm volatile("s_waitcnt lgkmcnt(0)":::"memory");
  float rli[16];
  #pragma unroll
  for(int r=0;r<16;++r)rli[r]=__builtin_amdgcn_rcpf(wsf[32+crow(r,hi)]);
  bf16*Ow=O+(rowbase+q0+wid*QBLK)*OP+OCOL+h*D;
  { bf16*stg=(bf16*)(shm+LDS_OST)+wid*2048;
    #pragma unroll
    for(int r=0;r<16;++r){const int orow=crow(r,hi);
      #pragma unroll
      for(int d0=0;d0<2;++d0)stg[orow*64+d0*32+r32]=__float2bfloat16(o[d0][r]*rli[r]);}
    asm volatile("s_waitcnt lgkmcnt(0)":::"memory");
    #pragma unroll
    for(int i=0;i<4;++i){const int row=i*8+(lane>>3),ch=lane&7; const u32x4 v=*(const u32x4*)(stg+row*64+ch*8); ATTN_STORE16(Ow+(long)row*OP+ch*8,v);} }
  asm volatile("s_waitcnt lgkmcnt(0)\n\ts_barrier":::"memory");
  #undef DMA_K
  #undef DMA_V
  #undef START
  #undef RESC
  #undef ROT
}
constexpr int ATTN_LDS_BYTES=LDS_BYTES;
#undef SBAR
#undef WAIT_BAR
}
constexpr int NWAVES = 8;
constexpr int BATCH = 8, SEQ = 4096, DM = 1024, T = BATCH * SEQ;
constexpr int GLA_H = 4, GLA_DK = 64, GLA_DV = 128, GLA_RANK = 16;
constexpr int ATT_H = 8, ATT_KVH = 2, ATT_DH = 64;
constexpr int D_IN = 2336, D_IN_PAD = 2560;
constexpr int NEXP = 32, TOPK = 4, DFF = 1024;
constexpr int EROWS = 32768;
constexpr int PROWS = T * TOPK + NEXP * 256;
constexpr float EPS = 1e-6f;
constexpr float YSCALE = 16.f;
constexpr float WSCALE = 32.f, ASCALE = 4.f;

constexpr size_t MiB = 1u << 20;
constexpr size_t WS_CTL = 0, CTL_ZERO_BYTES = 1 * MiB;
constexpr size_t WS_WRH = 1 * MiB, WS_WRL = WS_WRH + 65536;
constexpr size_t WS_WIN = 2 * MiB;
constexpr size_t WS_WOUT = 8 * MiB;
constexpr size_t WS_W1 = 10 * MiB;
constexpr size_t WS_W2 = 138 * MiB;
constexpr size_t WS_ROWTOK = 202 * MiB;
constexpr size_t WS_ROWGATE = 206 * MiB;
constexpr size_t WS_TOKASG = 210 * MiB;
constexpr size_t WS_REGY = 212 * MiB;
constexpr size_t WS_XN = WS_REGY;
constexpr size_t WS_GQ = WS_XN + 64 * MiB;
constexpr size_t WS_GK = WS_GQ + 16 * MiB;
constexpr size_t WS_GV = WS_GK + 16 * MiB;
constexpr size_t WS_GR = WS_GV + 32 * MiB;
constexpr size_t WS_AQ = WS_GR + 32 * MiB;
constexpr size_t WS_AK = WS_AQ + 32 * MiB;
constexpr size_t WS_AV = WS_AK + 8 * MiB;
constexpr size_t WS_Z = WS_AV + 8 * MiB;
constexpr size_t WS_OF = WS_Z + 2 * MiB;
constexpr size_t WS_H16 = WS_REGY + 200 * MiB;
constexpr size_t WS_Y = WS_REGY;
constexpr size_t WS_REGA = WS_REGY + 274 * MiB;
constexpr size_t WS_MIX = WS_REGA;
constexpr size_t WS_ACT = WS_REGA;
constexpr size_t WS_QF = WS_REGA + 272 * MiB, WS_KF = WS_QF + 16 * MiB, WS_QB = WS_KF + 16 * MiB, WS_KB = WS_QB + 16 * MiB;
constexpr size_t WS_DEC = WS_KB + 16 * MiB;
constexpr size_t WS_RINV = WS_DEC + 1 * MiB;
constexpr size_t WS_END = WS_RINV + 1 * MiB;
static_assert(WS_OF + (size_t)T * 512 * 4 <= WS_REGA && (size_t)PROWS * 1024 * 2 <= 272 * MiB, "d_ws map");
constexpr int CW_BAR = 4096;
constexpr int CW_CNT = 8192;
constexpr int CW_CONV = 20480;
constexpr int CW_GDN = 16384;
constexpr int CW_QUE = 12288;

constexpr int SCR_BYTES = 133120;
constexpr int LC_OFF = SCR_BYTES;
constexpr int LC_MISC = LC_OFF;
constexpr int LC_CNT = LC_OFF + 128;
constexpr int LC_CST = LC_CNT + 128;
constexpr int LC_TE = LC_CST + 256;
constexpr int LC_HIST = LC_TE + 1152;
constexpr int LC_BASE = LC_HIST + 128;
constexpr int LC_ASG = LC_BASE + 128;
constexpr int LC_GDEC = LC_ASG + 8192;
constexpr int LC_END = LC_GDEC + 512;
constexpr int LDS_BYTES = 147456;
static_assert(LC_END <= LDS_BYTES, "LDS map");

typedef unsigned short bf16;
typedef unsigned v4u __attribute__((ext_vector_type(4)));
typedef unsigned v2u __attribute__((ext_vector_type(2)));
typedef float f32x4 __attribute__((ext_vector_type(4)));
typedef short bf16x8 __attribute__((ext_vector_type(8)));
typedef GAS unsigned gu32;
#define RLX_AGENT __ATOMIC_RELAXED, __HIP_MEMORY_SCOPE_AGENT
#define LDS_WAIT() asm volatile("s_waitcnt lgkmcnt(0)" ::: "memory")
#define VM_WAIT() asm volatile("s_waitcnt vmcnt(0)" ::: "memory")
__device__ __forceinline__ unsigned pk2(float lo, float hi) { typedef float f2_t_ __attribute__((ext_vector_type(2))); typedef __bf16 b2_t_ __attribute__((ext_vector_type(2))); const f2_t_ v = {lo, hi}; return __builtin_bit_cast(unsigned, __builtin_convertvector(v, b2_t_)); }
__device__ __forceinline__ unsigned f2bf(float f) { return pk2(f, 0.f) & 0xffffu; }
__device__ __forceinline__ float bf2f(unsigned h) { return __builtin_bit_cast(float, h << 16); }
__device__ __forceinline__ float bflo(unsigned w) { return __builtin_bit_cast(float, w << 16); }
__device__ __forceinline__ float bfhi(unsigned w) { return __builtin_bit_cast(float, w & 0xffff0000u); }

#define XB_TMO      128
#define XB_XCNT(j)  (256  + 64 * (j))
#define XB_XSUB(j)  (1280 + 64 * (j))
#define XB_XGEN(j)  (2304 + 64 * (j))
#define XB_TOP      3328
#define XB_TOPGEN   3392
#define XCD_BAR_WORDS 3456
#define XB_SPIN_CAP (1u << 18)
__device__ __forceinline__ unsigned xb_ld(unsigned* p)              { return __hip_atomic_load(p, __ATOMIC_RELAXED, __HIP_MEMORY_SCOPE_AGENT); }
__device__ __forceinline__ unsigned xb_add(unsigned* p, unsigned v) { return __hip_atomic_fetch_add(p, v, __ATOMIC_RELAXED, __HIP_MEMORY_SCOPE_AGENT); }
__device__ __forceinline__ unsigned xb_xcc_id() { return (unsigned)__builtin_amdgcn_s_getreg((3 << 11) | 20) & 0xFu; }
#define XB_SPIN(cond, bar) do { unsigned _sp = 0; while (cond) { __builtin_amdgcn_s_sleep(1); \
    if ((++_sp & 255u) == 0u) { if (xb_ld(&(bar)[XB_TMO])) break; if (_sp > XB_SPIN_CAP) { atomicAdd(&(bar)[XB_TMO], 1u); break; } } } } while (0)
struct XcdBarrier { unsigned* bar; unsigned x; volatile LAS unsigned* st; };
__device__ __forceinline__ XcdBarrier xcd_barrier_post(unsigned* bar, volatile LAS unsigned* st) {
    XcdBarrier b; b.bar = bar; b.x = xb_xcc_id(); b.st = st;
    if (threadIdx.x == 0) (void)xb_add(&bar[XB_XCNT(b.x)], 1u);
    return b;
}
__device__ __forceinline__ void xcd_barrier_complete(unsigned* bar, unsigned x, unsigned& nloc, unsigned& nx) {
    const unsigned G = gridDim.x * gridDim.y * gridDim.z;
    unsigned sum, cnt, mine, sp = 0u;
    for (;;) {
        sum = 0u; cnt = 0u; mine = 0u;
#pragma unroll
        for (unsigned j = 0; j < 16; ++j) { const unsigned c = xb_ld(&bar[XB_XCNT(j)]); sum += c; cnt += (c > 0u) ? 1u : 0u; mine = (j == x) ? c : mine; }
        if (sum == G) break;
        __builtin_amdgcn_s_sleep(1);
        if ((++sp & 255u) == 0u) { if (xb_ld(&bar[XB_TMO])) break; if (sp > XB_SPIN_CAP) { atomicAdd(&bar[XB_TMO], 1u); break; } }
    }
    nloc = mine > 0u ? mine : 1u; nx = cnt > 0u ? cnt : 1u;
}
__device__ __forceinline__ void xcd_barrier(const XcdBarrier& b) {
    asm volatile("s_waitcnt vmcnt(0)" ::: "memory");
    __syncthreads();
    if (threadIdx.x == 0) {
        unsigned* bar = b.bar;
        __builtin_amdgcn_s_waitcnt(0);
        unsigned nloc = b.st[0], nx = b.st[1];
        if (nloc == 0u) { xcd_barrier_complete(bar, b.x, nloc, nx); b.st[0] = nloc; b.st[1] = nx; }
        const unsigned old = xb_add(&bar[XB_XSUB(b.x)], 1u);
        const unsigned gen = old / nloc;
        if (old + 1u == (gen + 1u) * nloc) {
            __builtin_amdgcn_fence(__ATOMIC_RELEASE, "agent");
            asm volatile("s_waitcnt vmcnt(0)" ::: "memory");
            const unsigned og = xb_add(&bar[XB_TOP], 1u);
            const unsigned tg = og / nx;
            if (og + 1u == (tg + 1u) * nx) xb_add(&bar[XB_TOPGEN], 1u);
            else XB_SPIN(xb_ld(&bar[XB_TOPGEN]) == tg, bar);
            __builtin_amdgcn_fence(__ATOMIC_ACQUIRE, "agent");
            xb_add(&bar[XB_XGEN(b.x)], 1u);
            asm volatile("s_waitcnt vmcnt(0)" ::: "memory");
        } else {
            XB_SPIN(xb_ld(&bar[XB_XGEN(b.x)]) == gen, bar);
            __builtin_amdgcn_fence(__ATOMIC_ACQUIRE, "agent");
            asm volatile("s_waitcnt vmcnt(0)" ::: "memory");
        }
    }
    __syncthreads();
}

struct Frame {
    LAS unsigned char* lds;
    volatile LAS unsigned* MISC;
    gu32* ctl;
    int tid, lane, wave;
    int vcu, G;
    unsigned char* ws;
    const float *x, *mix_g, *w_in, *w_gf, *b_gf, *w_gb, *b_gb, *gla_hg, *q_g, *k_g, *w_out, *ffn_g, *w_router, *b_router, *w1, *b1, *w2, *b2, *fin_g;
    float* out;
};
template <int CTRL> __device__ __forceinline__ float dpp_mov(float v) { return __builtin_bit_cast(float, __builtin_amdgcn_update_dpp(0, __builtin_bit_cast(int, v), CTRL, 0xf, 0xf, true)); }
__device__ __forceinline__ float wave_sum(float v) {
    v += dpp_mov<0xB1>(v);
    v += dpp_mov<0x4E>(v);
    v += dpp_mov<0x141>(v);
    v += dpp_mov<0x140>(v);
    { auto r = __builtin_amdgcn_permlane16_swap(__float_as_uint(v), __float_as_uint(v), false, false); v = __uint_as_float(r[0]) + __uint_as_float(r[1]); }
    { auto r = __builtin_amdgcn_permlane32_swap(__float_as_uint(v), __float_as_uint(v), false, false); v = __uint_as_float(r[0]) + __uint_as_float(r[1]); }
    return v;
}
__device__ __forceinline__ void p0_tr64(const float* src  , int ldw, bf16* d0, bf16* d1, int ldt, LAS float* scr, int lane, int ncols, const float* kg  ) {
    const int c4 = (lane & 15) * 4, kr = lane >> 4;
    if (c4 < ncols) {
#pragma unroll 4
        for (int i = 0; i < 16; ++i) { const int kk = kr + 4 * i; const f32x4 v = *(const GAS f32x4*)(src + (size_t)kk * ldw + c4) * (kg ? kg[kk] : 1.f);
            LAS float* s = scr + kk * 65 + c4; s[0] = v.x; s[1] = v.y; s[2] = v.z; s[3] = v.w; }
    }
    LDS_WAIT(); asm volatile("" ::: "memory");
    const int c = lane & 7;
#pragma unroll
    for (int j = 0; j < 8; ++j) { const int n = (lane >> 3) + 8 * j;
        if (n < ncols) { const LAS float* s = scr + (8 * c) * 65 + n;
            v4u o; o.x = pk2(s[0 * 65], s[1 * 65]); o.y = pk2(s[2 * 65], s[3 * 65]); o.z = pk2(s[4 * 65], s[5 * 65]); o.w = pk2(s[6 * 65], s[7 * 65]);
            bf16* rowp = (n < 32 ? d0 : d1) + (size_t)(n & 31) * ldt;
            *(GAS v4u*)(rowp + 8 * c) = o; } }
    LDS_WAIT(); asm volatile("" ::: "memory");
}
struct F8Item { const float* src; int ldw; unsigned char* d0; unsigned char* d1; };
__device__ __forceinline__ void f8_load(const F8Item& it, f32x4 (&v)[16], int lane) {
    const int c4 = (lane & 15) * 4, kr = lane >> 4;
#pragma unroll
    for (int i = 0; i < 16; ++i) v[i] = __builtin_nontemporal_load((const GAS f32x4*)(it.src + (size_t)(kr + 4 * i) * it.ldw + c4));
}
__device__ __forceinline__ void f8_finish(const F8Item& it, const f32x4 (&v)[16], LAS float* scr, int lane, float sc) {
    const int c4 = (lane & 15) * 4, kr = lane >> 4;
#pragma unroll
    for (int i = 0; i < 16; ++i) { LAS float* s = scr + (kr + 4 * i) * 65 + c4; s[0] = v[i].x; s[1] = v[i].y; s[2] = v[i].z; s[3] = v[i].w; }
    LDS_WAIT(); asm volatile("" ::: "memory");
    const int c = lane & 7;
#pragma unroll
    for (int j = 0; j < 8; ++j) { const int n = (lane >> 3) + 8 * j; const LAS float* s = scr + (8 * c) * 65 + n;
        int w0 = 0, w1 = 0;
        w0 = __builtin_amdgcn_cvt_pk_fp8_f32(s[0 * 65] * sc, s[1 * 65] * sc, w0, false); w0 = __builtin_amdgcn_cvt_pk_fp8_f32(s[2 * 65] * sc, s[3 * 65] * sc, w0, true);
        w1 = __builtin_amdgcn_cvt_pk_fp8_f32(s[4 * 65] * sc, s[5 * 65] * sc, w1, false); w1 = __builtin_amdgcn_cvt_pk_fp8_f32(s[6 * 65] * sc, s[7 * 65] * sc, w1, true);
        unsigned char* rowp = (n < 32 ? it.d0 : it.d1) + (size_t)(n & 31) * 1024;
        __builtin_nontemporal_store((v2u){(unsigned)w0, (unsigned)w1}, (GAS v2u*)(rowp + 8 * c)); }
    LDS_WAIT(); asm volatile("" ::: "memory");
}
__device__ __forceinline__ int win_pblk(int lb) { return lb < 48 ? lb : (lb == 48 ? 72 : lb - 1); }
__device__ __forceinline__ int w1_pblk(int lb) { return lb < 32 ? (lb >> 2) * 8 + (lb & 3) : ((lb - 32) >> 2) * 8 + 4 + ((lb - 32) & 3); }
__device__ __forceinline__ void rms_row_load(const float* xrow, f32x4 (&v)[4], int lane) {
    const GAS f32x4* xr = (const GAS f32x4*)xrow + lane;
#pragma unroll
    for (int j = 0; j < 4; ++j) v[j] = __builtin_nontemporal_load(xr + 64 * j);
}
__device__ __forceinline__ void rms_row_finish(const f32x4 (&v)[4], bf16* orow, float* rinv_out, int lane) {
    float s = 0.f;
    GAS unsigned long long* o8 = (GAS unsigned long long*)orow + lane;
#pragma unroll
    for (int j = 0; j < 4; ++j) { s += (v[j].x * v[j].x + v[j].y * v[j].y) + (v[j].z * v[j].z + v[j].w * v[j].w);
        o8[64 * j] = (unsigned long long)pk2(v[j].x, v[j].y) | ((unsigned long long)pk2(v[j].z, v[j].w) << 32); }
    const float rinv = 1.f / sqrtf(wave_sum(s) * (1.f / 1024.f) + EPS);
    if (lane == 0) *rinv_out = rinv;
}
__device__ __forceinline__ F8Item f8_item(Frame& F, int r) {
    F8Item it;
    if (r < NEXP * 512) { const int e = r / 512, q = r % 512, kb = q / 32, nb = q % 32; it.src = F.w1 + (size_t)e * 1024 * 2048 + (size_t)(64 * kb) * 2048 + 64 * nb; it.ldw = 2048;
        unsigned char* dst = F.ws + WS_W1 + (size_t)e * 2048 * 1024 + 64 * kb; it.d0 = dst + (size_t)(32 * w1_pblk(2 * nb)) * 1024; it.d1 = dst + (size_t)(32 * w1_pblk(2 * nb + 1)) * 1024; }
    else { const int r2 = r - NEXP * 512, e = r2 / 256, q = r2 % 256, kb = q / 16, nb = q % 16; it.src = F.w2 + (size_t)e * 1024 * 1024 + (size_t)(64 * kb) * 1024 + 64 * nb; it.ldw = 1024;
        unsigned char* dst = F.ws + WS_W2 + (size_t)e * 1024 * 1024 + 64 * kb; it.d0 = dst + (size_t)(64 * nb) * 1024; it.d1 = dst + (size_t)(64 * nb + 32) * 1024; }
    return it;
}
constexpr int N_F8_ITEMS = NEXP * 512 + NEXP * 256, N_CONV_BATCH = N_F8_ITEMS / 64;
__device__ __forceinline__ void f8_items(Frame& F, int r, int step, int rend, LAS float* scr) {
    if (r >= rend) return;
    F8Item cur = f8_item(F, r); f32x4 va[16], vb[16];
    f8_load(cur, va, F.lane);
    for (;;) {
        int rn = r + step; F8Item nx = cur; if (rn < rend) { nx = f8_item(F, rn); f8_load(nx, vb, F.lane); }
        f8_finish(cur, va, scr, F.lane, WSCALE);
        if (rn >= rend) break;
        r = rn + step; cur = nx; if (r < rend) { cur = f8_item(F, r); f8_load(cur, va, F.lane); }
        f8_finish(nx, vb, scr, F.lane, WSCALE);
        if (r >= rend) break;
    }
}
__device__ __forceinline__ bool conv_pull(Frame& F) {
    __syncthreads();
    if (F.tid == 0) F.MISC[17] = __hip_atomic_fetch_add(F.ctl + CW_CONV, 1u, RLX_AGENT);
    __syncthreads();
    const int cb = __builtin_amdgcn_readfirstlane((int)F.MISC[17]);
    if (cb >= N_CONV_BATCH) return false;
    f8_items(F, cb * 64 + F.wave * 8, 1, cb * 64 + F.wave * 8 + 8, (LAS float*)(F.lds + F.wave * 16640));
    return true;
}
__device__ __forceinline__ void p0_prologue(Frame& F) {
    LAS float* scr = (LAS float*)(F.lds + F.wave * 16640);
    const int gw = F.vcu * NWAVES + F.wave, NGW = F.G * NWAVES;
    bf16* WIN = (bf16*)(F.ws + WS_WIN); bf16* WOUT = (bf16*)(F.ws + WS_WOUT);
    constexpr int I_IN = 16 * 37, I_OUT = 16 * 16, NITEMS = I_IN + I_OUT;
    for (int it = gw; it < NITEMS; it += NGW) {
        int r = it;
        if (r < I_IN) { const int kb = r / 37, nb = r % 37; const int lb0 = 2 * nb, nc = (nb == 36) ? 32 : 64;
            p0_tr64(F.w_in + (size_t)(64 * kb) * D_IN + 64 * nb, D_IN, WIN + (size_t)(32 * win_pblk(lb0)) * 1024 + 64 * kb, WIN + (size_t)(32 * win_pblk(lb0 + 1 < 73 ? lb0 + 1 : lb0)) * 1024 + 64 * kb, 1024, scr, F.lane, nc, F.mix_g + 64 * kb); continue; }
        r -= I_IN;
        { const int kb = r / 16, nb = r % 16;
            p0_tr64(F.w_out + (size_t)(64 * kb) * 1024 + 64 * nb, 1024, WOUT + (size_t)(64 * nb) * 1024 + 64 * kb, WOUT + (size_t)(64 * nb + 32) * 1024 + 64 * kb, 1024, scr, F.lane, 64, nullptr); }
    }
    { const int gt = F.vcu * (NWAVES * 64) + F.tid, NGT = F.G * NWAVES * 64; GAS v4u* z = (GAS v4u*)(WIN + (size_t)D_IN * 1024);
      for (int i = gt; i < (D_IN_PAD - D_IN) * 1024 * 2 / 16; i += NGT) z[i] = (v4u){0u, 0u, 0u, 0u};
      bf16* WRH = (bf16*)(F.ws + WS_WRH); bf16* WRL = (bf16*)(F.ws + WS_WRL);
      for (int i = gt; i < NEXP * 1024; i += NGT) { const int e = i >> 10, k = i & 1023; const float w = F.w_router[(size_t)k * NEXP + e]; const unsigned h = f2bf(w); WRH[i] = (bf16)h; WRL[i] = (bf16)f2bf(w - bf2f(h)); } }
    bf16* XN = (bf16*)(F.ws + WS_XN);
    { f32x4 va[4], vb[4]; float* RINV = (float*)(F.ws + WS_RINV);
      int m = gw;
      if (m < T) { rms_row_load(F.x + (size_t)m * DM, va, F.lane);
        for (;;) {
            const int m1 = m + NGW; if (m1 < T) rms_row_load(F.x + (size_t)m1 * DM, vb, F.lane);
            rms_row_finish(va, XN + (size_t)m * DM, RINV + m, F.lane);
            if (m1 >= T) break;
            m = m1 + NGW; if (m < T) rms_row_load(F.x + (size_t)m * DM, va, F.lane);
            rms_row_finish(vb, XN + (size_t)m1 * DM, RINV + m1, F.lane);
            if (m >= T) break;
        } } }
}

__device__ __forceinline__ void p2_normrope(Frame& F) {
    LAS float* cs = (LAS float*)F.lds;
    for (int i = F.tid; i < 1024; i += NWAVES * 64) { const int pos = i >> 4, fi = i & 15; const float inv = exp2f(-(float)fi * (13.287712379549449f / 16.f)); const float a = (float)pos * inv;
        cs[2 * i] = __cosf(a); cs[2 * i + 1] = __sinf(a); }
    __syncthreads();
    const int gw = F.vcu * NWAVES + F.wave, NGW = F.G * NWAVES, lane = F.lane;
    const int j = lane & 7, blk = (j >> 2) & 1, jj = j & 3, fi0 = 8 * (jj & 1); const bool second = (jj >> 1) != 0;
    float gq[8], gk[8];
#pragma unroll
    for (int e = 0; e < 8; ++e) { gq[e] = F.q_g[8 * j + e]; gk[e] = F.k_g[8 * j + e]; }
    bf16* AQ = (bf16*)(F.ws + WS_AQ); bf16* AK = (bf16*)(F.ws + WS_AK);
    v4u wnext = (v4u){0u, 0u, 0u, 0u};
    if (T + gw < T + T / 4) wnext = *((GAS v4u*)(AK + (size_t)(4 * gw + (lane >> 4)) * 128) + (lane & 15));
    for (int it = T + gw; it < T + T / 4; it += NGW) {
        const bool isq = false;
        const int tok = 4 * (it - T) + (lane >> 4);
        GAS v4u* p = (GAS v4u*)(AK + (size_t)tok * 128) + (lane & 15);
        const v4u w = wnext;
        if (it + NGW < T + T / 4) wnext = *((GAS v4u*)(AK + (size_t)(4 * (it + NGW - T) + (lane >> 4)) * 128) + (lane & 15));
        float x[8] = {bflo(w.x), bfhi(w.x), bflo(w.y), bfhi(w.y), bflo(w.z), bfhi(w.z), bflo(w.w), bfhi(w.w)};
        float ss = 0.f;
#pragma unroll
        for (int e = 0; e < 8; ++e) ss += x[e] * x[e];
        ss += __shfl_xor(ss, 1); ss += __shfl_xor(ss, 2); ss += __shfl_xor(ss, 4);
        const float rinv = 1.f / sqrtf(ss * (1.f / 64.f) + EPS);
        const int ts = tok & (SEQ - 1), pos = blk ? (ts & 63) : (ts >> 6);
        const LAS float* c = cs + (pos * 16 + fi0) * 2;
        float y[8];
#pragma unroll
        for (int e = 0; e < 8; ++e) { x[e] = x[e] * rinv * (isq ? gq[e] : gk[e]); }
#pragma unroll
        for (int e = 0; e < 8; ++e) { const float pr = __shfl_xor(x[e], 2); const float co = c[2 * e], si = c[2 * e + 1]; y[e] = second ? (x[e] * co + pr * si) : (x[e] * co - pr * si); }
        const float sc = isq ? attn_body::C2 : 1.f;
        v4u o; o.x = pk2(y[0] * sc, y[1] * sc); o.y = pk2(y[2] * sc, y[3] * sc); o.z = pk2(y[4] * sc, y[5] * sc); o.w = pk2(y[6] * sc, y[7] * sc);
        *p = o;
    }
}
namespace gla {
typedef short bf16x8 __attribute__((ext_vector_type(8)));
typedef short s16x4 __attribute__((ext_vector_type(4)));
typedef float f32x4 __attribute__((ext_vector_type(4)));
constexpr int P64 = 144, PV = 272, POT = 528;
constexpr int L_QS = 0, L_KS = 9216, L_VR = 18432, L_AS = 35840, L_ST = 45056, L_OT = 63488, L_SET2 = 97280, L_END = 133120;
constexpr int L_DEC = LC_GDEC;
__device__ __forceinline__ unsigned cvtpk(float lo, float hi) { typedef float f2_t __attribute__((ext_vector_type(2))); typedef __bf16 b2_t __attribute__((ext_vector_type(2))); f2_t v = {lo, hi}; b2_t b = __builtin_convertvector(v, b2_t); return __builtin_bit_cast(unsigned, b); }
__device__ __forceinline__ float logsig(float x) { return fminf(x, 0.f) - __logf(1.f + __expf(-fabsf(x))); }
__device__ __forceinline__ s16x4 vtr(const LAS unsigned char* p) { typedef short v4i16_t __attribute__((ext_vector_type(4))); return __builtin_bit_cast(s16x4, __builtin_amdgcn_ds_read_tr16_b64_v4i16((LAS v4i16_t*)p)); }

__device__ __forceinline__ void gla_prep_unit(Frame& F, int b, int c) {
    LAS unsigned char* L = F.lds;
    const int tid = F.tid, dir = __builtin_amdgcn_readfirstlane(tid >> 8), col = tid & 255;
    const bf16* GQ = (const bf16*)(F.ws + WS_GQ); const bf16* GK = (const bf16*)(F.ws + WS_GK); const bf16* ZZ = (const bf16*)(F.ws + WS_Z);
    bf16* QX = (bf16*)(F.ws + (dir ? WS_QB : WS_QF)); bf16* KX = (bf16*)(F.ws + (dir ? WS_KB : WS_KF)); float* DEC = (float*)(F.ws + WS_DEC) + (size_t)dir * (BATCH * 64 * 256);
    const unsigned row0 = (unsigned)b * SEQ + (unsigned)c * 64u;
    __syncthreads();
    { typedef float f32x16 __attribute__((ext_vector_type(16)));
      const int w_ = F.wave, lane = F.lane, r32 = lane & 31, hi = lane >> 5, colw = 32 * w_ + r32;
#pragma unroll
      for (int d = 0; d < 2; ++d) { const float* WGd = d ? F.w_gb : F.w_gf; const float bgd = (d ? F.b_gb : F.b_gf)[colw];
          float wv[8];
#pragma unroll
          for (int j = 0; j < 8; ++j) wv[j] = WGd[(8 * hi + j) * 256 + colw];
          v4u wh, wl;
          wh.x = pk2(wv[0], wv[1]); wh.y = pk2(wv[2], wv[3]); wh.z = pk2(wv[4], wv[5]); wh.w = pk2(wv[6], wv[7]);
          wl.x = pk2(wv[0] - bflo(wh.x), wv[1] - bfhi(wh.x)); wl.y = pk2(wv[2] - bflo(wh.y), wv[3] - bfhi(wh.y)); wl.z = pk2(wv[4] - bflo(wh.z), wv[5] - bfhi(wh.z)); wl.w = pk2(wv[6] - bflo(wh.w), wv[7] - bfhi(wh.w));
#pragma unroll
          for (int hf = 0; hf < 2; ++hf) { const v4u zf = *(const GAS v4u*)(ZZ + (row0 + 32 * hf + r32) * 32 + d * 16 + 8 * hi);
              f32x16 acc = {};
              acc = __builtin_amdgcn_mfma_f32_32x32x16_bf16(__builtin_bit_cast(bf16x8, zf), __builtin_bit_cast(bf16x8, wh), acc, 0, 0, 0);
              acc = __builtin_amdgcn_mfma_f32_32x32x16_bf16(__builtin_bit_cast(bf16x8, zf), __builtin_bit_cast(bf16x8, wl), acc, 0, 0, 0);
#pragma unroll
              for (int r = 0; r < 16; ++r) { const int pos = 32 * hf + (r & 3) + 8 * (r >> 2) + 4 * hi; *(LAS float*)(L + (size_t)((d * 64 + pos) * 256 + colw) * 4) = logsig(acc[r] + bgd) * (1.f / 16.f); } } } }
    __syncthreads();
    float pf[64]; float run = 0.f;
#pragma unroll
    for (int p = 0; p < 64; ++p) pf[p] = *(const LAS float*)(L + (size_t)((dir * 64 + p) * 256 + col) * 4);
    asm volatile("s_waitcnt lgkmcnt(0)" ::: "memory");
#pragma unroll
    for (int p = 0; p < 64; ++p) { asm volatile("" : "+v"(pf[p])); run += pf[p]; pf[p] = run; }
    const float tot = run;
    const bf16* gqc = GQ + (size_t)row0 * 256 + col; const bf16* gkc = GK + (size_t)row0 * 256 + col; bf16* qxc = QX + (size_t)row0 * 256 + col; bf16* kxc = KX + (size_t)row0 * 256 + col;
    unsigned short qa[16], ka[16], qb[16], kb[16];
#define GP_LOAD(g, qx, kx) do { _Pragma("unroll") for (int i = 0; i < 16; ++i) { qx[i] = gqc[(16 * (g) + i) * 256]; kx[i] = gkc[(16 * (g) + i) * 256]; } } while (0)
#define GP_PROC(g, qx, kx) do { _Pragma("unroll") for (int i = 0; i < 16; ++i) { const int p = 16 * (g) + i; const float qv = bf2f(qx[i]), kv = bf2f(kx[i]); \
        const float ex = dir ? (p ? pf[p ? p - 1 : 0] : 0.f) : 0.f; \
        const float eq = dir ? __expf(-ex) * 0.125f : __expf(pf[p] - tot) * 0.125f; \
        const float ek = dir ? __expf(ex) : __expf(tot - pf[p]); \
        qxc[p * 256] = (bf16)f2bf(qv * eq); kxc[p * 256] = (bf16)f2bf(kv * ek); } } while (0)
    GP_LOAD(0, qa, ka); GP_LOAD(1, qb, kb);
    GP_PROC(0, qa, ka); GP_LOAD(2, qa, ka);
    GP_PROC(1, qb, kb); GP_LOAD(3, qb, kb);
    GP_PROC(2, qa, ka); GP_PROC(3, qb, kb);
#undef GP_LOAD
#undef GP_PROC
    DEC[((unsigned)b * 64 + c) * 256 + col] = __expf(tot);
}

__device__ __forceinline__ void gla_unit(Frame& F, int b, int h, int dir) {
    LAS unsigned char* L = F.lds;
    const int tid = F.tid, lane = F.lane, w = F.wave, q4 = lane >> 4, l15 = lane & 15;
    const bf16* GV = (const bf16*)(F.ws + WS_GV);
    bf16* OX = (bf16*)(F.ws + WS_OF + (dir ? 32 * MiB : 0));
    const unsigned rowbase = (unsigned)b * SEQ;
    const int v0 = 16 * w;
    const int erow = tid >> 3, eseg = tid & 7;
    const int plq = tid >> 3, sgq = tid & 7, plv = tid >> 4, sgv = tid & 15;
    {
        const bf16* QX = (const bf16*)(F.ws + (dir ? WS_QB : WS_QF)); const bf16* KX = (const bf16*)(F.ws + (dir ? WS_KB : WS_KF));
        const float* DEC = (const float*)(F.ws + WS_DEC) + (size_t)dir * (BATCH * 64 * 256);
        f32x4 S[4];
#pragma unroll
        for (int i = 0; i < 4; ++i) S[i] = (f32x4){0.f, 0.f, 0.f, 0.f};
        v4u rq, rk, rv0, rv1; float rdec = 0.f;
#define GLA_LOAD(ci) do { const int c_ = dir ? 63 - (ci) : (ci); const unsigned cb_ = rowbase + (unsigned)c_ * 64u; \
            rq = __builtin_nontemporal_load((const GAS v4u*)(QX + (cb_ + plq) * 256 + h * 64 + sgq * 8)); rk = __builtin_nontemporal_load((const GAS v4u*)(KX + (cb_ + plq) * 256 + h * 64 + sgq * 8)); \
            rv0 = *(const GAS v4u*)(GV + (cb_ + plv) * 512 + h * 128 + sgv * 8); rv1 = *(const GAS v4u*)(GV + (cb_ + plv + 32) * 512 + h * 128 + sgv * 8); \
            if (tid < 64) rdec = DEC[((unsigned)b * 64 + c_) * 256 + h * 64 + tid]; } while (0)
        GLA_LOAD(0);
        v4u st0 = (v4u){0u, 0u, 0u, 0u}, st1 = st0;
#define GLA_FLUSH(cprev) do { const unsigned cbp_ = rowbase + (unsigned)(cprev) * 64u; GAS v4u* sp_ = (GAS v4u*)(OX + (cbp_ + erow) * 512 + h * 128 + eseg * 16); sp_[0] = st0; sp_[1] = st1; } while (0)
#define GLA_STAGE(so) do { *(LAS v4u*)(L + (so) + L_QS + plq * P64 + sgq * 16) = rq; *(LAS v4u*)(L + (so) + L_KS + plq * P64 + sgq * 16) = rk; \
            *(LAS v4u*)(L + (so) + L_VR + plv * PV + sgv * 16) = rv0; *(LAS v4u*)(L + (so) + L_VR + (plv + 32) * PV + sgv * 16) = rv1; \
            if (tid < 64) ((LAS float*)(L + L_DEC))[((so) ? 64 : 0) + tid] = rdec; } while (0)
        __syncthreads();
        GLA_STAGE(0); GLA_LOAD(1);
        __syncthreads();
        for (int ci = 0; ci < 64; ++ci) {
            const int c = dir ? 63 - ci : ci; const int so = (ci & 1) ? L_SET2 : 0, sn = (ci & 1) ? 0 : L_SET2;
#pragma unroll
            for (int s = 0; s < 2; ++s) { const int tt = 2 * w + s, it = tt >> 2, jt = tt & 3; f32x4 a = (f32x4){0.f, 0.f, 0.f, 0.f};
                if (dir ? (jt >= it) : (jt <= it)) {
#pragma unroll
                    for (int ks = 0; ks < 2; ++ks) { const bf16x8 af = *(const LAS bf16x8*)(L + so + L_QS + (16 * it + l15) * P64 + (32 * ks + 8 * q4) * 2); const bf16x8 bfr = *(const LAS bf16x8*)(L + so + L_KS + (16 * jt + l15) * P64 + (32 * ks + 8 * q4) * 2);
                        a = __builtin_amdgcn_mfma_f32_16x16x32_bf16(af, bfr, a, 0, 0, 0); } }
#pragma unroll
                for (int rg = 0; rg < 4; ++rg) { const int i = 16 * it + 4 * q4 + rg, j = 16 * jt + l15; const bool keep = dir ? (j > i) : (j <= i);
                    *(LAS unsigned short*)(L + L_AS + i * P64 + j * 2) = (unsigned short)cvtpk(keep ? a[rg] : 0.f, 0.f); } }
#pragma unroll
            for (int dt = 0; dt < 4; ++dt) { const f32x4 dv = *(const LAS f32x4*)(L + L_DEC + ((ci & 1) ? 256 : 0) + (16 * dt + 4 * q4) * 4); S[dt] = S[dt] * dv;
                *(LAS v2u*)(L + L_ST + (v0 + l15) * P64 + (16 * dt + 4 * q4) * 2) = (v2u){cvtpk(S[dt].x, S[dt].y), cvtpk(S[dt].z, S[dt].w)}; }
            __syncthreads();
            bf16x8 bv[2], bs[2];
#pragma unroll
            for (int ks = 0; ks < 2; ++ks) { const LAS unsigned char* vp = L + so + L_VR + (32 * ks + 8 * q4 + (l15 >> 2)) * PV + (v0 + 4 * (l15 & 3)) * 2;
                const s16x4 lo = vtr(vp), hi = vtr(vp + 4 * PV); bv[ks] = (bf16x8){lo[0], lo[1], lo[2], lo[3], hi[0], hi[1], hi[2], hi[3]};
                bs[ks] = *(const LAS bf16x8*)(L + L_ST + (v0 + l15) * P64 + (32 * ks + 8 * q4) * 2); }
            f32x4 O[4];
#pragma unroll
            for (int it = 0; it < 4; ++it) { O[it] = (f32x4){0.f, 0.f, 0.f, 0.f};
#pragma unroll
                for (int ks = 0; ks < 2; ++ks) { const bf16x8 aq = *(const LAS bf16x8*)(L + so + L_QS + (16 * it + l15) * P64 + (32 * ks + 8 * q4) * 2);
                    if (dir ? !(ks == 0 && it >= 2) : !(ks == 1 && it < 2)) {
                        const bf16x8 aa = *(const LAS bf16x8*)(L + L_AS + (16 * it + l15) * P64 + (32 * ks + 8 * q4) * 2); O[it] = __builtin_amdgcn_mfma_f32_16x16x32_bf16(aa, bv[ks], O[it], 0, 0, 0); }
                    O[it] = __builtin_amdgcn_mfma_f32_16x16x32_bf16(aq, bs[ks], O[it], 0, 0, 0); } }
#pragma unroll
            for (int dt = 0; dt < 4; ++dt)
#pragma unroll
                for (int ks = 0; ks < 2; ++ks) { const LAS unsigned char* kp = L + so + L_KS + (32 * ks + 8 * q4 + (l15 >> 2)) * P64 + (16 * dt + 4 * (l15 & 3)) * 2;
                    const s16x4 lo = vtr(kp), hi = vtr(kp + 4 * P64); const bf16x8 ak = (bf16x8){lo[0], lo[1], lo[2], lo[3], hi[0], hi[1], hi[2], hi[3]};
                    S[dt] = __builtin_amdgcn_mfma_f32_16x16x32_bf16(ak, bv[ks], S[dt], 0, 0, 0); }
#pragma unroll
            for (int it = 0; it < 4; ++it)
#pragma unroll
                for (int rg = 0; rg < 4; ++rg) *(LAS float*)(L + L_OT + (16 * it + 4 * q4 + rg) * POT + (v0 + l15) * 4) = O[it][rg];
            if (ci + 1 < 64) GLA_STAGE(sn);
            asm volatile("" ::: "memory");
            if (ci > 0) GLA_FLUSH(dir ? c + 1 : c - 1);
            asm volatile("" ::: "memory");
            if (ci + 2 < 64) GLA_LOAD(ci + 2);
            __syncthreads();
            {
                float o[16];
#pragma unroll
                for (int e4 = 0; e4 < 4; ++e4) { const f32x4 t = *(const LAS f32x4*)(L + L_OT + erow * POT + (16 * eseg + 4 * e4) * 4); o[4 * e4] = t.x; o[4 * e4 + 1] = t.y; o[4 * e4 + 2] = t.z; o[4 * e4 + 3] = t.w; }
                st0 = (v4u){cvtpk(o[0], o[1]), cvtpk(o[2], o[3]), cvtpk(o[4], o[5]), cvtpk(o[6], o[7])}; st1 = (v4u){cvtpk(o[8], o[9]), cvtpk(o[10], o[11]), cvtpk(o[12], o[13]), cvtpk(o[14], o[15])};
            }
        }
        GLA_FLUSH(dir ? 0 : 63);
#undef GLA_STAGE
#undef GLA_FLUSH
#undef GLA_LOAD
    }
    VM_WAIT(); __syncthreads();
    if (tid == 0) { __builtin_amdgcn_fence(__ATOMIC_RELEASE, "agent"); VM_WAIT(); (void)__hip_atomic_fetch_add(F.ctl + CW_GDN + 64 * (b * GLA_H + h), 1u, RLX_AGENT); }
    __syncthreads();
}
__device__ __forceinline__ void gla_combine(Frame& F, int b, int h, int part) {
    const int tid = F.tid, erow = tid >> 3, eseg = tid & 7;
    if (tid == 0) { unsigned sp = 0; while (__hip_atomic_load(F.ctl + CW_GDN + 64 * (b * GLA_H + h), RLX_AGENT) < 2u && sp < (1u << 22)) { __builtin_amdgcn_s_sleep(8); ++sp; }
        __builtin_amdgcn_fence(__ATOMIC_ACQUIRE, "agent"); VM_WAIT(); }
    __syncthreads();
    const bf16* OF0 = (const bf16*)(F.ws + WS_OF); const bf16* OB0 = (const bf16*)(F.ws + WS_OF + 32 * MiB); const bf16* GR = (const bf16*)(F.ws + WS_GR); bf16* MIX = (bf16*)(F.ws + WS_MIX);
    float hg[16]; int eso = eseg; asm volatile("" : "+v"(eso));
#pragma unroll
    for (int e = 0; e < 16; ++e) hg[e] = F.gla_hg[16 * eso + e];
    const unsigned r0 = (unsigned)b * SEQ + (unsigned)part * 1024u + erow;
    v4u nf0, nf1, nb0, nb1, nr0, nr1;
#define GC_LOAD(ps_) do { const unsigned row_ = r0 + (ps_) * 64; const GAS v4u* fp = (const GAS v4u*)(OF0 + row_ * 512 + h * 128 + eseg * 16); const GAS v4u* bp = (const GAS v4u*)(OB0 + row_ * 512 + h * 128 + eseg * 16); const GAS v4u* rp = (const GAS v4u*)(GR + row_ * 512 + h * 128 + eseg * 16); \
        nf0 = __builtin_nontemporal_load(fp); nf1 = __builtin_nontemporal_load(fp + 1); nb0 = __builtin_nontemporal_load(bp); nb1 = __builtin_nontemporal_load(bp + 1); nr0 = __builtin_nontemporal_load(rp); nr1 = __builtin_nontemporal_load(rp + 1); } while (0)
    GC_LOAD(0);
#pragma unroll 2
    for (int ps = 0; ps < 16; ++ps) { const unsigned row = r0 + ps * 64;
        const v4u f0 = nf0, f1 = nf1, b0 = nb0, b1 = nb1, r0v = nr0, r1v = nr1;
        if (ps + 1 < 16) GC_LOAD(ps + 1);
        const unsigned fw[8] = {f0.x, f0.y, f0.z, f0.w, f1.x, f1.y, f1.z, f1.w}, bw[8] = {b0.x, b0.y, b0.z, b0.w, b1.x, b1.y, b1.z, b1.w}, rw[8] = {r0v.x, r0v.y, r0v.z, r0v.w, r1v.x, r1v.y, r1v.z, r1v.w};
        float o[16]; float ss = 0.f;
#pragma unroll
        for (int e2 = 0; e2 < 8; ++e2) { o[2 * e2] = bflo(fw[e2]) + bflo(bw[e2]); o[2 * e2 + 1] = bfhi(fw[e2]) + bfhi(bw[e2]); ss += o[2 * e2] * o[2 * e2] + o[2 * e2 + 1] * o[2 * e2 + 1]; }
        ss += __shfl_xor(ss, 1); ss += __shfl_xor(ss, 2); ss += __shfl_xor(ss, 4);
        const float rinv = __builtin_amdgcn_rsqf(ss * (1.f / 128.f) + EPS);
        unsigned ow[8];
#pragma unroll
        for (int e2 = 0; e2 < 8; ++e2) { const float x0 = bflo(rw[e2]), x1 = bfhi(rw[e2]);
            const float y0 = o[2 * e2] * rinv * hg[2 * e2] * (x0 * __builtin_amdgcn_rcpf(1.f + __expf(-x0))), y1 = o[2 * e2 + 1] * rinv * hg[2 * e2 + 1] * (x1 * __builtin_amdgcn_rcpf(1.f + __expf(-x1))); ow[e2] = cvtpk(y0, y1); }
        GAS v4u* mp = (GAS v4u*)(MIX + row * 1024 + h * 128 + eseg * 16);
        mp[0] = (v4u){ow[0], ow[1], ow[2], ow[3]}; mp[1] = (v4u){ow[4], ow[5], ow[6], ow[7]}; }
#undef GC_LOAD
}
}
struct DenseMap { static constexpr bool GATHER = false;
    const bf16* A; const bf16* Bt; int K;
    __device__ __forceinline__ __amdgpu_buffer_rsrc_t a_rsrc() const { return __builtin_amdgcn_make_buffer_rsrc((void*)A, 0, 0x7fffffff, 0x00020000); }
    __device__ __forceinline__ __amdgpu_buffer_rsrc_t b_rsrc() const { return __builtin_amdgcn_make_buffer_rsrc((void*)Bt, 0, 0x7fffffff, 0x00020000); }
    __device__ __forceinline__ unsigned a_soff(const pg8::Unit& u) const { return (unsigned)u.pm * 256u * (unsigned)K * 2u; }
    __device__ __forceinline__ unsigned b_soff(const pg8::Unit& u) const { return (unsigned)u.pn * 256u * (unsigned)K * 2u; }
    __device__ __forceinline__ void a_off(const pg8::Unit&, const int (&R)[2], const int (&C)[2], unsigned (&vo)[2][2]) const {
#pragma unroll
        for (int h = 0; h < 2; ++h)
#pragma unroll
            for (int i = 0; i < 2; ++i) vo[h][i] = (unsigned)((h * 128 + R[i]) * K + C[i]) * 2u; }
};
struct MoeTabs { const LAS int* cnt; const LAS int* cst; const LAS unsigned short* te; };
struct MoeMapUp { static constexpr bool GATHER = true;
    const unsigned char* A; const unsigned char* Bt; const int* rowtok; MoeTabs tb;
    __device__ __forceinline__ __amdgpu_buffer_rsrc_t a_rsrc() const { return __builtin_amdgcn_make_buffer_rsrc((void*)A, 0, 0x7fffffff, 0x00020000); }
    __device__ __forceinline__ __amdgpu_buffer_rsrc_t b_rsrc() const { return __builtin_amdgcn_make_buffer_rsrc((void*)Bt, 0, 0x7fffffff, 0x00020000); }
    __device__ __forceinline__ unsigned a_soff(const pg8::Unit&) const { return 0u; }
    __device__ __forceinline__ unsigned b_soff(const pg8::Unit& u) const { const unsigned e = tb.te[u.pm]; return (e * 2048u + (unsigned)u.pn * 256u) * 1024u; }
    __device__ __forceinline__ void a_raw(const pg8::Unit& u, const int (&R)[2], unsigned (&raw)[2][2]) const {
        const int e = tb.te[u.pm], pos0 = (u.pm - tb.cst[e]) * 256, n = tb.cnt[e];
#pragma unroll
        for (int h = 0; h < 2; ++h)
#pragma unroll
            for (int i = 0; i < 2; ++i) { const int pos = pos0 + h * 128 + R[i]; raw[h][i] = (unsigned)rowtok[(size_t)e * EROWS + (pos < n ? pos : 0)]; } }
    __device__ __forceinline__ unsigned a_fin(unsigned tok, int C) const { return (tok * 512u + (unsigned)C) * 2u; }
    __device__ __forceinline__ void a_off(const pg8::Unit& u, const int (&R)[2], const int (&C)[2], unsigned (&vo)[2][2]) const {
        unsigned raw[2][2]; a_raw(u, R, raw);
#pragma unroll
        for (int h = 0; h < 2; ++h)
#pragma unroll
            for (int i = 0; i < 2; ++i) vo[h][i] = a_fin(raw[h][i], C[i]); }
};
struct MoeMapDown { static constexpr bool GATHER = false;
    const unsigned char* A; const unsigned char* Bt; MoeTabs tb;
    __device__ __forceinline__ __amdgpu_buffer_rsrc_t a_rsrc() const { return __builtin_amdgcn_make_buffer_rsrc((void*)A, 0, 0x7fffffff, 0x00020000); }
    __device__ __forceinline__ __amdgpu_buffer_rsrc_t b_rsrc() const { return __builtin_amdgcn_make_buffer_rsrc((void*)Bt, 0, 0x7fffffff, 0x00020000); }
    __device__ __forceinline__ unsigned a_soff(const pg8::Unit& u) const { return (unsigned)u.pm * 256u * 1024u; }
    __device__ __forceinline__ unsigned b_soff(const pg8::Unit& u) const { const unsigned e = tb.te[u.pm]; return (e * 1024u + (unsigned)u.pn * 256u) * 1024u; }
    __device__ __forceinline__ void a_off(const pg8::Unit&, const int (&R)[2], const int (&C)[2], unsigned (&vo)[2][2]) const {
#pragma unroll
        for (int h = 0; h < 2; ++h)
#pragma unroll
            for (int i = 0; i < 2; ++i) vo[h][i] = (unsigned)((h * 128 + R[i]) * 512 + C[i]) * 2u; }
};
using pg8::f32x4;
struct EpiInProj { static constexpr bool PERM = true, COLS64 = false;
    bf16 *gq, *gk, *gv, *gr, *aq, *ak, *av, *z; const float* rinv;
    struct Pre { float rv[8]; };
    __device__ __forceinline__ void preload(const pg8::Unit& u, int wr, int wc, int fr, int fq, Pre& p) const {
#pragma unroll
        for (int i = 0; i < 8; ++i) p.rv[i] = rinv[u.pm * 256 + wr * 64 + fr + (i >> 2) * 128 + (i & 3) * 16]; }
    __device__ __forceinline__ void operator()(const f32x4 (&acc)[2][2][4][2], const pg8::Unit& u, const Pre& p, int wr, int wc, int fr, int fq) const {
        bf16* b0; bf16* b1; int ld;
        switch (u.pn) { case 0: b0 = gq; b1 = gq + 128; ld = 256; break; case 1: b0 = gk; b1 = gk + 128; ld = 256; break;
            case 2: b0 = gv; b1 = gv + 128; ld = 512; break; case 3: b0 = gv + 256; b1 = gv + 384; ld = 512; break;
            case 4: b0 = gr; b1 = gr + 128; ld = 512; break; case 5: b0 = gr + 256; b1 = gr + 384; ld = 512; break;
            case 6: b0 = aq; b1 = aq + 128; ld = 512; break; case 7: b0 = aq + 256; b1 = aq + 384; ld = 512; break;
            case 8: b0 = ak; b1 = av; ld = 128; break; default: b0 = z; b1 = z; ld = 32; break; }
        const bool zt = (u.pn == 9);
        if (zt && wc != 0) return;
        const int row0 = u.pm * 256 + wr * 64 + fr, cw = wc * 32 + 8 * fq;
#pragma unroll
        for (int ai = 0; ai < 2; ++ai)
#pragma unroll
            for (int m = 0; m < 4; ++m) { const size_t row = (size_t)(row0 + ai * 128 + m * 16);
#pragma unroll
                for (int bj = 0; bj < 2; ++bj) { if (zt && bj == 1) continue; const float rs = p.rv[ai * 4 + m]; const f32x4 v0 = acc[ai][bj][m][0] * rs, v1 = acc[ai][bj][m][1] * rs;
                    pg8::u32x4 wv; wv.x = pg8::cvt_pk_bf16(v0[0], v0[1]); wv.y = pg8::cvt_pk_bf16(v0[2], v0[3]); wv.z = pg8::cvt_pk_bf16(v1[0], v1[1]); wv.w = pg8::cvt_pk_bf16(v1[2], v1[3]);
                    *(pg8::u32x4*)((bj ? b1 : b0) + row * ld + cw) = wv; } }
    }
};
struct EpiResF32 { static constexpr bool PERM = true, COLS64 = false;
    const bf16* base; bf16* out;
    struct Pre {}; __device__ __forceinline__ void preload(const pg8::Unit&, int, int, int, int, Pre&) const {}
    __device__ __forceinline__ void operator()(const f32x4 (&acc)[2][2][4][2], const pg8::Unit& u, const Pre&, int wr, int wc, int fr, int fq) const {
        const int col0 = u.pn * 256 + wc * 32 + 8 * fq;
        const size_t off0 = (size_t)(u.pm * 256 + wr * 64 + fr) * 1024 + col0;
        v4u cx[4], nx[4];
#define ER_OFF(it_, q_) (off0 + (size_t)((((it_) * 2 + ((q_) >> 1)) >> 2) * 128 + (((it_) * 2 + ((q_) >> 1)) & 3) * 16) * 1024 + ((q_) & 1) * 128)
#pragma unroll
        for (int q = 0; q < 4; ++q) cx[q] = __builtin_nontemporal_load((const v4u*)(base + ER_OFF(0, q)));
#pragma unroll
        for (int it = 0; it < 4; ++it) {
            if (it + 1 < 4) {
#pragma unroll
                for (int q = 0; q < 4; ++q) nx[q] = __builtin_nontemporal_load((const v4u*)(base + ER_OFF(it + 1, q))); }
#pragma unroll
            for (int q = 0; q < 4; ++q) { const int g = it * 2 + (q >> 1), ai = g >> 2, m = g & 3, bj = q & 1; const f32x4 a0 = acc[ai][bj][m][0], a1 = acc[ai][bj][m][1]; const v4u xw = cx[q];
                *(v4u*)(out + ER_OFF(it, q)) = (v4u){pk2(bflo(xw.x) + a0.x, bfhi(xw.x) + a0.y), pk2(bflo(xw.y) + a0.z, bfhi(xw.y) + a0.w), pk2(bflo(xw.z) + a1.x, bfhi(xw.z) + a1.y), pk2(bflo(xw.w) + a1.z, bfhi(xw.w) + a1.w)}; }
#pragma unroll
            for (int q = 0; q < 4; ++q) cx[q] = nx[q]; }
#undef ER_OFF
    }
};
struct EpiSwiglu { static constexpr bool PERM = true, COLS64 = false;
    const float* b1; unsigned char* act; MoeTabs tb;
    struct Pre { f32x4 g0, g1, l0, l1; };
    __device__ __forceinline__ void preload(const pg8::Unit& u, int wr, int wc, int fr, int fq, Pre& p) const {
        const int e = tb.te[u.pm]; const int col = u.pn * 128 + wc * 32 + 8 * fq; const float* bg = b1 + (size_t)e * 2048 + col; const float* bl = bg + 1024;
        p.g0 = *(const GAS f32x4*)bg; p.g1 = *(const GAS f32x4*)(bg + 4); p.l0 = *(const GAS f32x4*)bl; p.l1 = *(const GAS f32x4*)(bl + 4); }
    __device__ __forceinline__ void operator()(const f32x4 (&acc)[2][2][4][2], const pg8::Unit& u, const Pre& p, int wr, int wc, int fr, int fq) const {
        const int col = u.pn * 128 + wc * 32 + 8 * fq;
        const f32x4 g0 = p.g0, g1 = p.g1, l0 = p.l0, l1 = p.l1;
        const int row0 = u.pm * 256 + wr * 64 + fr;
        const bool odd = (fq & 1) != 0;
        unsigned char* dstb = act + (size_t)(row0 + (odd ? 16 : 0)) * 1024 + (odd ? col - 8 : col);
#pragma unroll
        for (int ai = 0; ai < 2; ++ai)
#pragma unroll
            for (int mp = 0; mp < 2; ++mp) { unsigned wd[2][2];
#pragma unroll
                for (int q = 0; q < 2; ++q) { const int m = 2 * mp + q; float o[8];
#pragma unroll
                    for (int n = 0; n < 2; ++n) {
                        f32x4 gl = acc[ai][0][m][n] * (1.f / WSCALE) + (n ? g1 : g0); gl = (f32x4){fminf(gl.x, 7.f), fminf(gl.y, 7.f), fminf(gl.z, 7.f), fminf(gl.w, 7.f)};
                        f32x4 li = acc[ai][1][m][n] * (1.f / WSCALE) + (n ? l1 : l0); li = (f32x4){__builtin_amdgcn_fmed3f(li.x, -7.f, 7.f), __builtin_amdgcn_fmed3f(li.y, -7.f, 7.f), __builtin_amdgcn_fmed3f(li.z, -7.f, 7.f), __builtin_amdgcn_fmed3f(li.w, -7.f, 7.f)};
                        const f32x4 ex = gl * (-1.702f * 1.4426950408889634f);
                        const f32x4 dn = (f32x4){__builtin_amdgcn_exp2f(ex.x), __builtin_amdgcn_exp2f(ex.y), __builtin_amdgcn_exp2f(ex.z), __builtin_amdgcn_exp2f(ex.w)} + 1.f;
                        const f32x4 rc = (f32x4){__builtin_amdgcn_rcpf(dn.x), __builtin_amdgcn_rcpf(dn.y), __builtin_amdgcn_rcpf(dn.z), __builtin_amdgcn_rcpf(dn.w)};
                        const f32x4 ov = (gl * rc) * (li * ASCALE + ASCALE);
                        o[4 * n] = ov.x; o[4 * n + 1] = ov.y; o[4 * n + 2] = ov.z; o[4 * n + 3] = ov.w; }
                    int w0 = 0, w1 = 0;
                    w0 = __builtin_amdgcn_cvt_pk_fp8_f32(o[0], o[1], w0, false); w0 = __builtin_amdgcn_cvt_pk_fp8_f32(o[2], o[3], w0, true); w1 = __builtin_amdgcn_cvt_pk_fp8_f32(o[4], o[5], w1, false); w1 = __builtin_amdgcn_cvt_pk_fp8_f32(o[6], o[7], w1, true);
                    wd[q][0] = (unsigned)w0; wd[q][1] = (unsigned)w1; }
                auto x0 = __builtin_amdgcn_permlane16_swap(wd[0][0], wd[1][0], false, false); auto x1 = __builtin_amdgcn_permlane16_swap(wd[0][1], wd[1][1], false, false);
                *(pg8::u32x4*)(dstb + (size_t)(ai * 128 + mp * 32) * 1024) = (pg8::u32x4){x0[0], x1[0], x0[1], x1[1]}; }
    }
};
struct EpiDown { static constexpr bool PERM = true, COLS64 = true;
    const float* b2; const float* rowgate; unsigned char* y; MoeTabs tb;
    struct Pre { f32x4 bv[2][2]; float gt[8]; };
    __device__ __forceinline__ void preload(const pg8::Unit& u, int wr, int wc, int fr, int fq, Pre& p) const {
        const int e = tb.te[u.pm], pos0 = (u.pm - tb.cst[e]) * 256, n_e = tb.cnt[e];
        const float* bb = b2 + (size_t)e * 1024 + u.pn * 256 + wc * 64 + 8 * fq;
#pragma unroll
        for (int bj = 0; bj < 2; ++bj)
#pragma unroll
            for (int n = 0; n < 2; ++n) p.bv[bj][n] = *(const GAS f32x4*)(bb + bj * 32 + 4 * n);
#pragma unroll
        for (int ai = 0; ai < 2; ++ai)
#pragma unroll
            for (int m = 0; m < 4; ++m) { const int pos = pos0 + wr * 64 + fr + ai * 128 + m * 16; const int pc_ = pos < n_e ? pos : 0; const float g = rowgate[(size_t)e * EROWS + pc_]; p.gt[ai * 4 + m] = (pos < n_e) ? g * YSCALE : 0.f; }
    }
    __device__ __forceinline__ void operator()(const f32x4 (&acc)[2][2][4][2], const pg8::Unit& u, const Pre& p, int wr, int wc, int fr, int fq) const {
        const bool odd = (fq & 1) != 0;
        const int colb = u.pn * 256 + wc * 64 + (odd ? 32 + 8 * (fq - 1) : 8 * fq), rl0 = wr * 64 + fr;
#pragma unroll
        for (int ai = 0; ai < 2; ++ai)
#pragma unroll
            for (int m = 0; m < 4; ++m) { const int rl = rl0 + ai * 128 + m * 16; const float gt = p.gt[ai * 4 + m];
                unsigned w[2][2];
#pragma unroll
                for (int bj = 0; bj < 2; ++bj) { const f32x4 v0 = (acc[ai][bj][m][0] * (1.f / (WSCALE * ASCALE)) + p.bv[bj][0]) * gt, v1 = (acc[ai][bj][m][1] * (1.f / (WSCALE * ASCALE)) + p.bv[bj][1]) * gt;
                    int w0 = 0, w1 = 0;
                    w0 = __builtin_amdgcn_cvt_pk_fp8_f32(v0[0], v0[1], w0, false); w0 = __builtin_amdgcn_cvt_pk_fp8_f32(v0[2], v0[3], w0, true); w1 = __builtin_amdgcn_cvt_pk_fp8_f32(v1[0], v1[1], w1, false); w1 = __builtin_amdgcn_cvt_pk_fp8_f32(v1[2], v1[3], w1, true);
                    w[bj][0] = (unsigned)w0; w[bj][1] = (unsigned)w1; }
                auto x0 = __builtin_amdgcn_permlane16_swap(w[0][0], w[1][0], false, false); auto x1 = __builtin_amdgcn_permlane16_swap(w[0][1], w[1][1], false, false);
                const pg8::u32x4 ov = (pg8::u32x4){x0[0], x1[0], x0[1], x1[1]};
                *(pg8::u32x4*)(y + (size_t)(u.pm * 256 + rl) * 1024 + colb) = ov; }
    }
};
__device__ __forceinline__ int moe_tables(Frame& F) {
    LAS int* cnt = (LAS int*)(F.lds + LC_CNT); LAS int* cst = (LAS int*)(F.lds + LC_CST); LAS unsigned short* te = (LAS unsigned short*)(F.lds + LC_TE);
    __syncthreads();
    if (F.tid < NEXP) cnt[F.tid] = (int)__hip_atomic_load(F.ctl + CW_CNT + 64 * F.tid, RLX_AGENT);
    __syncthreads();
    if (F.tid == 0) { int s = 0; for (int e = 0; e < NEXP; ++e) { cst[e] = s; s += (cnt[e] + 255) >> 8; } cst[NEXP] = s; }
    __syncthreads();
    const int nt = cst[NEXP];
    for (int t = F.tid; t < nt; t += NWAVES * 64) { int e = 0;
#pragma unroll 1
        for (int k = 1; k < NEXP; ++k) e = (t >= cst[k]) ? k : e;
        te[t] = (unsigned short)e; }
    __syncthreads();
    return nt;
}
__device__ __forceinline__ void p3_mixers(Frame& F) {
    for (int u = blockIdx.x; u < 2 * BATCH * GLA_H; u += F.G) gla::gla_unit(F, u & 7, (u >> 3) & 3, u >> 5);
    if (blockIdx.x < 2 * BATCH * GLA_H) { while (conv_pull(F)) {} }
    const attn_body::bf16* Q = (const attn_body::bf16*)(F.ws + WS_AQ); const attn_body::bf16* K = (const attn_body::bf16*)(F.ws + WS_AK); const attn_body::bf16* V = (const attn_body::bf16*)(F.ws + WS_AV);
    attn_body::bf16* O = (attn_body::bf16*)(F.ws + WS_MIX);
    const int x0 = blockIdx.x & 7;
    float sbound;
    { float mq = fabsf(F.q_g[F.lane]), mk = fabsf(F.k_g[F.lane]);
#pragma unroll
      for (int o_ = 1; o_ < 64; o_ <<= 1) { mq = fmaxf(mq, __shfl_xor(mq, o_)); mk = fmaxf(mk, __shfl_xor(mk, o_)); }
      sbound = __builtin_bit_cast(float, __builtin_amdgcn_readfirstlane(__builtin_bit_cast(int, 64.f * attn_body::C2 * mq * mk * 1.02f))); }
    for (int qi = 0; qi < 8; ++qi) { const int x = (x0 + qi) & 7;
        for (;;) {
            __syncthreads();
            if (F.tid == 0) F.MISC[16] = __hip_atomic_fetch_add(F.ctl + CW_QUE + 64 * x, 1u, RLX_AGENT);
            __syncthreads();
            const int item = __builtin_amdgcn_readfirstlane((int)F.MISC[16]);
            if (item >= ATT_H * attn_body::NQB + 4 * GLA_H) break;
            if (item >= ATT_H * attn_body::NQB) { const int k = item - ATT_H * attn_body::NQB; gla::gla_combine(F, x, k >> 2, k & 3); continue; }
            attn_body::attn_unit<8>(x, item >> 4, item & 15, Q, K, V, O, (char*)F.lds, F.q_g, sbound);
        }
    }
    while (conv_pull(F)) {}
    __syncthreads();
}

__device__ __forceinline__ void p5_route(Frame& F) {
    typedef float f32x16 __attribute__((ext_vector_type(16)));
    LAS unsigned char* L = F.lds;
    constexpr int XP = 2064, L_XH = 0, L_XL = 32 * XP, L_PART = 0;
    const int tid = F.tid, lane = F.lane, w = F.wave, r32 = lane & 31, hi = lane >> 5;
    const bf16* WRH = (const bf16*)(F.ws + WS_WRH); const bf16* WRL = (const bf16*)(F.ws + WS_WRL);
    unsigned char* XN8 = F.ws + WS_XN;
    int* ROWTOK = (int*)(F.ws + WS_ROWTOK); float* ROWGATE = (float*)(F.ws + WS_ROWGATE); int* TOKASG = (int*)(F.ws + WS_TOKASG);
    gu32* CNT = F.ctl + CW_CNT;
    bf16x8 wh[8], wl[8];
#pragma unroll
    for (int ks = 0; ks < 8; ++ks) { const int k0 = 128 * w + 16 * ks + 8 * hi; wh[ks] = *(const GAS bf16x8*)(WRH + r32 * 1024 + k0); wl[ks] = *(const GAS bf16x8*)(WRL + r32 * 1024 + k0); }
    f32x4 g2[4];
#pragma unroll
    for (int j = 0; j < 4; ++j) g2[j] = *((const GAS f32x4*)F.ffn_g + lane + 64 * j);
    float brt[16];
#pragma unroll
    for (int r = 0; r < 16; ++r) brt[r] = F.b_router[(r & 3) + 8 * (r >> 2) + 4 * hi];
    LAS int* hist = (LAS int*)(L + LC_HIST); LAS int* basev = (LAS int*)(L + LC_BASE); LAS int* aep = (LAS int*)(L + LC_ASG); LAS float* agt = (LAS float*)(L + LC_ASG + 4096);
    constexpr int NGRP = T / 32;
    const int per = (NGRP + F.G - 1) / F.G, g0 = F.vcu * per, g1 = (g0 + per < NGRP) ? g0 + per : NGRP;
    for (int gb = g0; gb < g1; gb += 8) {
        const int nb = (g1 - gb < 8) ? g1 - gb : 8;
        __syncthreads();
        if (tid < NEXP) hist[tid] = 0;
        v2u hv[4][4];
#define P5_LOADG(g) do { _Pragma("unroll") for (int rr = 0; rr < 4; ++rr) { const GAS v2u* hp = (const GAS v2u*)((const bf16*)(F.ws + WS_H16) + (size_t)(32 * (g) + 4 * w + rr) * 1024) + lane; \
            _Pragma("unroll") for (int j = 0; j < 4; ++j) hv[rr][j] = __builtin_nontemporal_load(hp + 64 * j); } } while (0)
#define P5_BAR() asm volatile("s_waitcnt lgkmcnt(0)\n\ts_barrier" ::: "memory")
        P5_LOADG(gb);
        for (int bi = 0; bi < nb; ++bi) {
            const int t0 = 32 * (gb + bi);
#pragma unroll
            for (int rr = 0; rr < 4; ++rr) { const int r = 4 * w + rr; const size_t tok = (size_t)(t0 + r);
                f32x4 v[4]; float s = 0.f;
#pragma unroll
                for (int j = 0; j < 4; ++j) { v[j] = (f32x4){bflo(hv[rr][j].x), bfhi(hv[rr][j].x), bflo(hv[rr][j].y), bfhi(hv[rr][j].y)}; s += (v[j].x * v[j].x + v[j].y * v[j].y) + (v[j].z * v[j].z + v[j].w * v[j].w); }
                const float rinv = 1.f / sqrtf(wave_sum(s) * (1.f / 1024.f) + EPS);
                GAS unsigned* o4 = (GAS unsigned*)(XN8 + tok * 1024) + lane;
#pragma unroll
                for (int j = 0; j < 4; ++j) { const f32x4 xn = v[j] * rinv * g2[j];
                    const v2u hw = (v2u){pk2(xn.x, xn.y), pk2(xn.z, xn.w)};
                    const v2u lw = (v2u){pk2(xn.x - bflo(hw.x), xn.y - bfhi(hw.x)), pk2(xn.z - bflo(hw.y), xn.w - bfhi(hw.y))};
                    { int q8 = 0; q8 = __builtin_amdgcn_cvt_pk_fp8_f32(xn.x, xn.y, q8, false); q8 = __builtin_amdgcn_cvt_pk_fp8_f32(xn.z, xn.w, q8, true); o4[64 * j] = (unsigned)q8; }
                    *(LAS v2u*)(L + L_XH + r * XP + (4 * lane + 256 * j) * 2) = hw; *(LAS v2u*)(L + L_XL + r * XP + (4 * lane + 256 * j) * 2) = lw; } }
            if (bi + 1 < nb) P5_LOADG(gb + bi + 1);
            P5_BAR();
            f32x16 acc = {};
#pragma unroll
            for (int ks = 0; ks < 8; ++ks) { const int k0 = 128 * w + 16 * ks + 8 * hi;
                const bf16x8 xh = *(const LAS bf16x8*)(L + L_XH + r32 * XP + k0 * 2), xl = *(const LAS bf16x8*)(L + L_XL + r32 * XP + k0 * 2);
                acc = __builtin_amdgcn_mfma_f32_32x32x16_bf16(wh[ks], xh, acc, 0, 0, 0); acc = __builtin_amdgcn_mfma_f32_32x32x16_bf16(wh[ks], xl, acc, 0, 0, 0); acc = __builtin_amdgcn_mfma_f32_32x32x16_bf16(wl[ks], xh, acc, 0, 0, 0); }
            P5_BAR();
#pragma unroll
            for (int r = 0; r < 16; ++r) { const int e = (r & 3) + 8 * (r >> 2) + 4 * hi; ((LAS float*)(L + L_PART))[(w * 32 + e) * 32 + r32] = acc[r]; }
            P5_BAR();
            if (w == 0) {
                float v[16];
#pragma unroll
                for (int r = 0; r < 16; ++r) { const int e = (r & 3) + 8 * (r >> 2) + 4 * hi; float s = brt[r];
#pragma unroll
                    for (int ww = 0; ww < 8; ++ww) s += ((const LAS float*)(L + L_PART))[(ww * 32 + e) * 32 + r32];
                    v[r] = s; }
                float cv[8]; int cidx[8];
#pragma unroll
                for (int s = 0; s < 4; ++s) { float m = -INFINITY; int mr = 0;
#pragma unroll
                    for (int r = 0; r < 16; ++r) { if (v[r] > m) { m = v[r]; mr = r; } }
                    cv[s] = m; cidx[s] = (mr & 3) + 8 * (mr >> 2) + 4 * hi;
#pragma unroll
                    for (int r = 0; r < 16; ++r) v[r] = (r == mr) ? -INFINITY : v[r]; }
#pragma unroll
                for (int s = 0; s < 4; ++s) { cv[4 + s] = __shfl_xor(cv[s], 32); cidx[4 + s] = __shfl_xor(cidx[s], 32); }
                float tv[4]; int ti[4];
#pragma unroll
                for (int s = 0; s < 4; ++s) { float m = -INFINITY; int mi = 1 << 20; int mc = 0;
#pragma unroll
                    for (int c = 0; c < 8; ++c) { const bool better = (cv[c] > m) || (cv[c] == m && cidx[c] < mi); if (better) { m = cv[c]; mi = cidx[c]; mc = c; } }
                    tv[s] = m; ti[s] = mi;
#pragma unroll
                    for (int c = 0; c < 8; ++c) cv[c] = (c == mc) ? -INFINITY : cv[c]; }
                const float e1 = __expf(tv[1] - tv[0]), e2 = __expf(tv[2] - tv[0]), e3 = __expf(tv[3] - tv[0]); const float inv = 1.f / (1.f + e1 + e2 + e3);
                const float gt[4] = {inv, e1 * inv, e2 * inv, e3 * inv};
                if (hi == 0) {
#pragma unroll
                    for (int s = 0; s < 4; ++s) { const int rank = (int)__hip_atomic_fetch_add(hist + ti[s], 1, __ATOMIC_RELAXED, __HIP_MEMORY_SCOPE_WORKGROUP); const int idx = (bi * 32 + r32) * 4 + s; aep[idx] = (ti[s] << 16) | rank; agt[idx] = gt[s]; } }
            }
            P5_BAR();
        }
#undef P5_LOADG
#undef P5_BAR
        if (tid < NEXP) { const int hc = hist[tid]; basev[tid] = hc ? (int)__hip_atomic_fetch_add(CNT + 64 * tid, (unsigned)hc, RLX_AGENT) : 0; }
        __syncthreads();
        for (int idx = tid; idx < nb * 128; idx += NWAVES * 64) { const int ep = aep[idx], e = ep >> 16, pos = basev[e] + (ep & 0xffff); const int tok = 32 * gb + (idx >> 2), s = idx & 3;
            ROWTOK[(size_t)e * EROWS + pos] = tok; ROWGATE[(size_t)e * EROWS + pos] = agt[idx]; TOKASG[tok * 4 + s] = e * EROWS + pos; }
    }
    __syncthreads();
}

__device__ __forceinline__ void p8_combine(Frame& F) {
    const LAS int* cst = (const LAS int*)(F.lds + LC_CST);
    const int gw = F.vcu * NWAVES + F.wave, NGW = F.G * NWAVES, lane = F.lane;
    const int* TOKASG = (const int*)(F.ws + WS_TOKASG); const unsigned char* Y = F.ws + WS_Y;
    f32x4 fg[4];
#pragma unroll
    for (int j = 0; j < 4; ++j) fg[j] = *((const GAS f32x4*)F.fin_g + lane + 64 * j);
    for (int tok = gw; tok < T; tok += NGW) {
        const int a = TOKASG[tok * 4 + (lane & 3)];
        const int crow = cst[a >> 15] * 256 + (a & (EROWS - 1));
        GAS f32x4* hp = (GAS f32x4*)(F.out + (size_t)tok * 1024) + lane; f32x4 v[4];
        const GAS v2u* hb = (const GAS v2u*)((const bf16*)(F.ws + WS_H16) + (size_t)tok * 1024) + lane;
#pragma unroll
        for (int j = 0; j < 4; ++j) { const v2u hw = __builtin_nontemporal_load(hb + 64 * j); v[j] = (f32x4){bflo(hw.x), bfhi(hw.x), bflo(hw.y), bfhi(hw.y)}; }
#pragma unroll
        for (int s = 0; s < 4; ++s) { const int cr = __shfl(crow, s); const GAS unsigned* yp = (const GAS unsigned*)(Y + (size_t)cr * 1024) + lane;
#pragma unroll
            for (int j = 0; j < 4; ++j) { const unsigned yw = __builtin_nontemporal_load(yp + 64 * j); const auto lo = __builtin_amdgcn_cvt_pk_f32_fp8((int)yw, false), hi = __builtin_amdgcn_cvt_pk_f32_fp8((int)yw, true);
                v[j].x += lo[0] * (1.f / YSCALE); v[j].y += lo[1] * (1.f / YSCALE); v[j].z += hi[0] * (1.f / YSCALE); v[j].w += hi[1] * (1.f / YSCALE); } }
        float ss = 0.f;
#pragma unroll
        for (int j = 0; j < 4; ++j) ss += (v[j].x * v[j].x + v[j].y * v[j].y) + (v[j].z * v[j].z + v[j].w * v[j].w);
        const float rinv = 1.f / sqrtf(wave_sum(ss) * (1.f / 1024.f) + EPS);
#pragma unroll
        for (int j = 0; j < 4; ++j) __builtin_nontemporal_store(v[j] * rinv * fg[j], hp + 64 * j);
    }
}
#ifndef MK_N_LAUNCHES
#define MK_N_LAUNCHES 1
#endif
constexpr int N_PHASES = 9;
constexpr int N_LAUNCHES = MK_N_LAUNCHES;
struct Args { const float* in[19]; float* out; unsigned char* ws; int ph_lo, ph_hi; };
__global__ void __launch_bounds__(NWAVES * 64, 2) enc_fwd(Args args) {
    extern __shared__ __attribute__((aligned(16))) unsigned char lds[];
    Frame F;
    F.lds = (LAS unsigned char*)lds;
    F.MISC = (volatile LAS unsigned*)(F.lds + LC_MISC);
    F.tid = threadIdx.x; F.lane = F.tid & 63; F.wave = __builtin_amdgcn_readfirstlane(F.tid >> 6);
    F.G = gridDim.x; { const int bx = blockIdx.x; F.vcu = (F.G % 8 == 0) ? (bx % 8) * (F.G / 8) + bx / 8 : bx; }
    F.ws = args.ws; F.ctl = (gu32*)(args.ws + WS_CTL);
    F.x = args.in[0]; F.mix_g = args.in[1]; F.w_in = args.in[2]; F.w_gf = args.in[3]; F.b_gf = args.in[4]; F.w_gb = args.in[5]; F.b_gb = args.in[6]; F.gla_hg = args.in[7];
    F.q_g = args.in[8]; F.k_g = args.in[9]; F.w_out = args.in[10]; F.ffn_g = args.in[11]; F.w_router = args.in[12]; F.b_router = args.in[13];
    F.w1 = args.in[14]; F.b1 = args.in[15]; F.w2 = args.in[16]; F.b2 = args.in[17]; F.fin_g = args.in[18]; F.out = args.out;
    for (int u = F.tid; u < (LDS_BYTES - LC_OFF) / 4; u += NWAVES * 64) ((LAS unsigned*)(F.lds + LC_OFF))[u] = 0u;
    __syncthreads();
    XcdBarrier bar; bar.bar = (unsigned*)(F.ctl + CW_BAR); bar.x = 0; bar.st = nullptr;
    if (N_LAUNCHES == 1) bar = xcd_barrier_post((unsigned*)(F.ctl + CW_BAR), F.MISC + 8);
    const int lo = args.ph_lo, hi = args.ph_hi;
#define IN(k) (lo <= (k) && (k) < hi)
#define SEAM(k) do { if (IN(k) && IN((k) + 1)) xcd_barrier(bar); } while (0)
    MoeTabs tb{(const LAS int*)(F.lds + LC_CNT), (const LAS int*)(F.lds + LC_CST), (const LAS unsigned short*)(F.lds + LC_TE)};

    if (IN(0)) { p0_prologue(F); } SEAM(0);
    if (IN(1)) {
        DenseMap mp{(const bf16*)(F.ws + WS_XN), (const bf16*)(F.ws + WS_WIN), 1024};
        pg8::StaticOrder S; S.init(T / 256, D_IN_PAD / 256, F.G, (int)blockIdx.x);
        EpiInProj E{(bf16*)(F.ws + WS_GQ), (bf16*)(F.ws + WS_GK), (bf16*)(F.ws + WS_GV), (bf16*)(F.ws + WS_GR), (bf16*)(F.ws + WS_AQ), (bf16*)(F.ws + WS_AK), (bf16*)(F.ws + WS_AV), (bf16*)(F.ws + WS_Z), (const float*)(F.ws + WS_RINV)};
        for (int i = 0; i < (int)(blockIdx.x & 7); ++i) __builtin_amdgcn_s_sleep(26);
        pg8::gemm_phase<EpiInProj, pg8::StaticOrder, DenseMap, true>(F.lds, 1024, S, mp, E);
    } SEAM(1);
    if (IN(2)) { p2_normrope(F); for (int u = F.vcu; u < BATCH * 64; u += F.G) gla::gla_prep_unit(F, u >> 6, u & 63); } SEAM(2);
    if (IN(3)) { p3_mixers(F); } SEAM(3);
    if (IN(4)) {
        DenseMap mp{(const bf16*)(F.ws + WS_MIX), (const bf16*)(F.ws + WS_WOUT), 1024};
        pg8::StaticOrder S; S.init(T / 256, DM / 256, F.G, (int)blockIdx.x);
        EpiResF32 E{(const bf16*)(F.ws + WS_XN), (bf16*)(F.ws + WS_H16)};
        pg8::gemm_phase<EpiResF32, pg8::StaticOrder, DenseMap, true>(F.lds, 1024, S, mp, E);
    } SEAM(4);
    if (IN(5)) { p5_route(F); } SEAM(5);
    int ntl = 0;
    if (IN(6)) {
        ntl = moe_tables(F);
        MoeMapUp mp{F.ws + WS_XN, F.ws + WS_W1, (const int*)(F.ws + WS_ROWTOK), tb};
        pg8::StaticOrder S; S.init(ntl, 8, F.G, (int)blockIdx.x);
        EpiSwiglu E{F.b1, F.ws + WS_ACT, tb};
        pg8::gemm_phase<EpiSwiglu, pg8::StaticOrder, MoeMapUp, true, true>(F.lds, 512, S, mp, E);
    } SEAM(6);
    if (IN(7)) {
        if (!IN(6)) ntl = moe_tables(F);
        MoeMapDown mp{F.ws + WS_ACT, F.ws + WS_W2, tb};
        pg8::StaticOrder S; S.init(ntl, 4, F.G, (int)blockIdx.x);
        EpiDown E{F.b2, (const float*)(F.ws + WS_ROWGATE), F.ws + WS_Y, tb};
        pg8::gemm_phase<EpiDown, pg8::StaticOrder, MoeMapDown, true, true>(F.lds, 512, S, mp, E);
    } SEAM(7);
    if (IN(8)) { if (!IN(7)) (void)moe_tables(F); p8_combine(F); }
#undef IN
#undef SEAM
}

extern "C" void kernel_launch(void* const* d_in, const int* in_sizes, int n_in, void* d_out, int out_size, void* d_ws, size_t ws_size, hipStream_t stream) {
    static int grid = 0;
    if (grid == 0) {
        if (n_in != 19 || in_sizes[0] != T * DM || out_size != T * DM || ws_size < WS_END) { fprintf(stderr, "kernel_launch: unexpected shapes (n_in %d, in0 %d, out %d, ws %zu); nothing launched\n", n_in, n_in > 0 ? in_sizes[0] : -1, out_size, ws_size); grid = -1; return; }
        int dev = 0, cus = 0, per_cu = 0;
        if (hipGetDevice(&dev) != hipSuccess || hipDeviceGetAttribute(&cus, hipDeviceAttributeMultiprocessorCount, dev) != hipSuccess) { grid = -1; return; }
        if (hipFuncSetAttribute((const void*)enc_fwd, hipFuncAttributeMaxDynamicSharedMemorySize, LDS_BYTES) != hipSuccess) { fprintf(stderr, "kernel_launch: hipFuncSetAttribute failed\n"); grid = -1; return; }
        if (hipOccupancyMaxActiveBlocksPerMultiprocessor(&per_cu, (const void*)enc_fwd, NWAVES * 64, LDS_BYTES) != hipSuccess || per_cu < 1) { fprintf(stderr, "kernel_launch: occupancy query says %d\n", per_cu); }
        (void)hipGetLastError();
        grid = cus;
    }
    if (grid < 0) return;
    if (hipMemsetAsync((char*)d_ws + WS_CTL, 0, CTL_ZERO_BYTES, stream) != hipSuccess) return;
    Args a{};
    for (int i = 0; i < 19; ++i) a.in[i] = (const float*)d_in[i];
    a.out = (float*)d_out; a.ws = (unsigned char*)d_ws;
    if (N_LAUNCHES == 1) { a.ph_lo = 0; a.ph_hi = N_PHASES; hipLaunchKernelGGL(enc_fwd, dim3(grid), dim3(NWAVES * 64), LDS_BYTES, stream, a); }
    else for (int p = 0; p < N_PHASES; ++p) { a.ph_lo = p; a.ph_hi = p + 1; hipLaunchKernelGGL(enc_fwd, dim3(grid), dim3(NWAVES * 64), LDS_BYTES, stream, a); }
}
```
